# Optimizing an MI355X kernel written in HIP

```python
import math
import jax, jax.numpy as jnp
from jax import lax
import numpy as np

D_MODEL = 1024
BATCH = 8
SEQ = 2048
DEPTH = 2

HEAD_DIM = 64
NORM_EPS = 1e-6
NEG_INF = -1e30
SWA_PATTERNS = ((128, 1), (512, 4), (2048, 16))
SWA_HEADS_PER_GROUP = 4
SWA_HEADS = SWA_HEADS_PER_GROUP * len(SWA_PATTERNS)
SWA_WIDTH = SWA_HEADS * HEAD_DIM
SWA_OUT_WIDTH = SWA_HEADS_PER_GROUP * HEAD_DIM
RWKV_HEADS = 12
RWKV_WIDTH = RWKV_HEADS * HEAD_DIM
DECAY_LORA = 64
ICLR_LORA = 64
GATE_LORA = 128
RWKV_STREAM = 3 * RWKV_WIDTH + 2 * DECAY_LORA + 2 * ICLR_LORA + GATE_LORA
RWKV_GN_EPS = 64e-5
DIFF_HEADS = 6
DIFF_WIDTH = DIFF_HEADS * 2 * HEAD_DIM
DIFF_Q_BLOCK = 128
DIFF_SUBLN_EPS = 1e-5
REL_BUCKETS = 32
REL_MAX_DIST = 128
REL_HEADS = SWA_HEADS + DIFF_HEADS
IN_COLS = 3 * SWA_WIDTH + RWKV_STREAM + 3 * DIFF_WIDTH + 3 * D_MODEL
N_EXPERTS = 32
TOP_K = 4
D_EXPERT = 1024
SWIGLU_LIMIT = 7.0
SWIGLU_ALPHA = 1.702

kernel_name = 'hybrid_gated_dilated_rwkv7_diffattn_moe_encoder'


def _split(t, sizes):
    out, off = [], 0
    for s in sizes:
        out.append(t[..., off:off + s])
        off += s
    return out


def _rmsnorm(x, g, eps=NORM_EPS):
    xf = x.astype(jnp.float32)
    y = xf * lax.rsqrt(jnp.mean(xf * xf, axis=-1, keepdims=True) + eps)
    return (y * g.astype(jnp.float32)).astype(x.dtype)


def _t5_bucket(rel):
    nb = REL_BUCKETS // 2
    max_exact = nb // 2
    ret = jnp.where(rel > 0, nb, 0)
    n = jnp.abs(rel)
    nf = jnp.maximum(n, 1).astype(jnp.float32)
    large = max_exact + (jnp.log(nf / max_exact) / math.log(REL_MAX_DIST / max_exact) * (nb - max_exact)).astype(jnp.int32)
    large = jnp.minimum(large, nb - 1)
    return ret + jnp.where(n < max_exact, n, large)


def _dilated_window_attn(q, k, v, bias, dilation, half):
    B, T, H, Dh = q.shape
    L = T // dilation
    nb = -(-L // half)
    Lp = nb * half
    Z = B * dilation

    def to_strided(t):
        return t.reshape(B, L, dilation, H, Dh).transpose(0, 2, 3, 1, 4).reshape(Z, H, L, Dh)

    qs = jnp.pad(to_strided(q), ((0, 0), (0, 0), (0, Lp - L), (0, 0))).reshape(Z, H, nb, half, Dh)

    def windows(t):
        t = jnp.pad(to_strided(t), ((0, 0), (0, 0), (half, half + Lp - L), (0, 0))).reshape(Z, H, nb + 2, half, Dh)
        return jnp.concatenate([t[:, :, 0:nb], t[:, :, 1:nb + 1], t[:, :, 2:nb + 2]], axis=3)

    kw, vw = windows(k), windows(v)
    s = jnp.einsum('zhnqd,zhnkd->zhnqk', qs, kw).astype(jnp.float32) * (Dh ** -0.5)
    a_idx = jnp.arange(half)[:, None]
    c_idx = jnp.arange(3 * half)[None, :]
    j = c_idx - half - a_idx
    key_m = jnp.arange(nb)[:, None] * half - half + jnp.arange(3 * half)[None, :]
    mask = (jnp.abs(j) <= half)[None] & ((key_m >= 0) & (key_m < L))[:, None, :]
    b = bias[:, jnp.clip(j + half, 0, 2 * half)].astype(jnp.float32)
    s = jnp.where(mask, s + b[:, None], NEG_INF)
    lse = jax.nn.logsumexp(s, axis=-1)
    p = jnp.exp(s - lse[..., None])
    o = jnp.einsum('zhnqk,zhnkd->zhnqd', p.astype(v.dtype), vw)
    o = o.reshape(B, dilation, H, Lp, Dh)[:, :, :, :L].transpose(0, 3, 1, 2, 4).reshape(B, T, H, Dh)
    lse = lse.reshape(B, dilation, H, Lp)[..., :L].transpose(0, 3, 1, 2).reshape(B, T, H)
    return o, lse


def _centred_shift(p, mu):
    prev = jnp.pad(p[:, :-1], ((0, 0), (1, 0), (0, 0)))
    nxt = jnp.pad(p[:, 1:], ((0, 0), (0, 1), (0, 0)))
    return p + mu[0] * (prev - p) + mu[1] * (nxt - p)


def _wkv7_scan(r, w, k, v, kk, a, reverse):
    B, T, H, N = r.shape

    def step(S, inp):
        r_t, w_t, k_t, v_t, kk_t, a_t = inp
        sa = jnp.einsum('bhvk,bhk->bhv', S, -kk_t)
        S = S * w_t[:, :, None, :] + sa[..., None] * (kk_t * a_t)[:, :, None, :] + v_t[..., None] * k_t[:, :, None, :]
        return S, jnp.einsum('bhvk,bhk->bhv', S, r_t)

    xs = tuple(jnp.moveaxis(t.astype(jnp.float32), 1, 0) for t in (r, w, k, v, kk, a))
    S0 = jnp.zeros((B, H, N, N), jnp.float32)
    _, y = lax.scan(step, S0, xs, reverse=reverse)
    return jnp.moveaxis(y, 0, 1)


def _rwkv7_bidir(stream, mu, w0, w_up, a0, a_up, g_up, k_k, k_a, r_k, ln_g, ln_b):
    B, T, _ = stream.shape
    H, N = RWKV_HEADS, HEAD_DIM
    s = _centred_shift(stream, mu)
    r, k, v, wd, ad, gd = _split(s, (RWKV_WIDTH, RWKV_WIDTH, RWKV_WIDTH, 2 * DECAY_LORA, 2 * ICLR_LORA, GATE_LORA))
    wd = wd.reshape(B, T, 2, DECAY_LORA)
    ad = ad.reshape(B, T, 2, ICLR_LORA)

    def heads(t):
        return t.reshape(B, T, H, N)

    rh, vh = heads(r), heads(v)
    y = jnp.zeros((B, T, H, N), jnp.float32)
    bonus = jnp.zeros((B, T, H, N), jnp.float32)
    for di, rev in enumerate((False, True)):
        w_log = -jax.nn.softplus(-(w0[di] + jnp.tanh(wd[:, :, di]) @ w_up[di])) - 0.5
        decay = jnp.exp(-jnp.exp(w_log.astype(jnp.float32)))
        a = jax.nn.sigmoid(a0[di] + ad[:, :, di] @ a_up[di])
        kk = heads(k * k_k[di]).astype(jnp.float32)
        kk = kk * lax.rsqrt(jnp.maximum(jnp.sum(kk * kk, axis=-1, keepdims=True), 1e-24))
        kd = heads(k * (1 + (a - 1) * k_a[di]))
        y = y + _wkv7_scan(rh, heads(decay), kd, vh, kk, heads(a), rev)
        bonus = bonus + jnp.sum((rh * kd * r_k).astype(jnp.float32), axis=-1, keepdims=True) * vh.astype(jnp.float32)
    mean = jnp.mean(y, axis=-1, keepdims=True)
    var = jnp.mean(jnp.square(y - mean), axis=-1, keepdims=True)
    y = ((y - mean) * lax.rsqrt(var + RWKV_GN_EPS)).reshape(B, T, RWKV_WIDTH) * ln_g.astype(jnp.float32) + ln_b.astype(jnp.float32)
    g = jax.nn.sigmoid(gd) @ g_up
    return ((y + bonus.reshape(B, T, RWKV_WIDTH)) * g.astype(jnp.float32)).astype(stream.dtype)


def _diff_attention(q, k, v, table, lam, lambda_init, subln_g):
    B, T, H, _, Dh = q.shape
    nqb = T // DIFF_Q_BLOCK
    qb = jnp.moveaxis(q.reshape(B, nqb, DIFF_Q_BLOCK, H, 2, Dh), 1, 0)
    kpos = jnp.arange(T)

    def block(args):
        q_blk, i = args
        qpos = i * DIFF_Q_BLOCK + jnp.arange(DIFF_Q_BLOCK)
        bias = table[_t5_bucket(kpos[None, :] - qpos[:, None])]
        s = jnp.einsum('bqhcd,bkhcd->bchqk', q_blk, k).astype(jnp.float32) * (Dh ** -0.5)
        p = jax.nn.softmax(s + jnp.transpose(bias, (2, 0, 1)).astype(jnp.float32)[None, None], axis=-1)
        attn = p[:, 0] - lam * p[:, 1]
        return jnp.einsum('bhqk,bkhd->bqhd', attn.astype(v.dtype), v)

    o = lax.map(block, (qb, jnp.arange(nqb)))
    o = jnp.moveaxis(o, 0, 1).reshape(B, T, H, 2 * Dh)
    o = _rmsnorm(o, subln_g, DIFF_SUBLN_EPS) * (1.0 - lambda_init)
    return o.reshape(B, T, DIFF_WIDTH)


def _moe(h, router_w, router_b, w1, b1, w2, b2):
    B, T, D = h.shape
    ht = h.reshape(B * T, D)
    logits = (ht @ router_w + router_b).astype(jnp.float32)
    top_v, top_i = lax.top_k(logits, TOP_K)
    probs = jax.nn.softmax(top_v, axis=-1)
    gates = jnp.sum(jax.nn.one_hot(top_i, N_EXPERTS, dtype=jnp.float32) * probs[..., None], axis=1)

    def expert(acc, params):
        w1e, b1e, w2e, b2e, ge = params
        hh = ht @ w1e + b1e
        x_glu = jnp.minimum(hh[:, ::2], SWIGLU_LIMIT)
        x_lin = jnp.clip(hh[:, 1::2], -SWIGLU_LIMIT, SWIGLU_LIMIT)
        act = x_glu * jax.nn.sigmoid(SWIGLU_ALPHA * x_glu) * (x_lin + 1)
        out = act @ w2e + b2e
        return acc + ge[:, None] * out.astype(jnp.float32), None

    acc0 = jnp.zeros((B * T, D), jnp.float32)
    acc, _ = lax.scan(expert, acc0, (w1, b1, w2, b2, gates.T))
    return acc.reshape(B, T, D).astype(h.dtype)


def setup_inputs(seed: int = 0) -> dict:
    key = jax.random.key(seed)
    ks = iter(jax.random.split(key, 40))
    L, D, W, F, E = DEPTH, D_MODEL, RWKV_WIDTH, D_EXPERT, N_EXPERTS

    def nrm(shape, scale):
        return jax.random.normal(next(ks), shape, jnp.float32) * scale

    def uni(shape, lo, hi):
        return jax.random.uniform(next(ks), shape, jnp.float32, lo, hi)

    return {
        'x': nrm((BATCH, SEQ, D), 1.0),
        'c': nrm((BATCH, D), 1.0),
        'w_mod': nrm((L, D, 6 * D), 0.3 * D ** -0.5),
        'b_mod': nrm((L, 6 * D), 0.1),
        'norm1_g': 1.0 + nrm((L, D), 0.05),
        'norm2_g': 1.0 + nrm((L, D), 0.05),
        'w_in': nrm((L, D, IN_COLS), D ** -0.5),
        'rwkv_mu': uni((L, 2, RWKV_STREAM), 0.0, 0.5),
        'rwkv_w0': uni((L, 2, W), -6.0, 1.0),
        'rwkv_w_up': nrm((L, 2, DECAY_LORA, W), 0.5 * DECAY_LORA ** -0.5),
        'rwkv_a0': nrm((L, 2, W), 0.5),
        'rwkv_a_up': nrm((L, 2, ICLR_LORA, W), 0.5 * ICLR_LORA ** -0.5),
        'rwkv_g_up': nrm((L, GATE_LORA, W), GATE_LORA ** -0.5),
        'rwkv_k_k': 0.85 + nrm((L, 2, W), 0.05),
        'rwkv_k_a': 1.0 + nrm((L, 2, W), 0.05),
        'rwkv_r_k': nrm((L, RWKV_HEADS, HEAD_DIM), 0.1),
        'rwkv_ln_g': 1.0 + nrm((L, W), 0.05),
        'rwkv_ln_b': nrm((L, W), 0.02),
        'diff_lambda': nrm((L, 4, HEAD_DIM), 0.1),
        'diff_subln_g': 1.0 + nrm((L, 2 * HEAD_DIM), 0.05),
        'rel_bias': nrm((REL_BUCKETS, REL_HEADS), 0.5),
        'w_branch_a': nrm((L, SWA_OUT_WIDTH, D), SWA_OUT_WIDTH ** -0.5),
        'w_branch_b': nrm((L, RWKV_WIDTH, D), RWKV_WIDTH ** -0.5),
        'w_branch_c': nrm((L, DIFF_WIDTH, D), DIFF_WIDTH ** -0.5),
        'w_out': nrm((L, D, D), D ** -0.5),
        'router_w': nrm((L, D, E), D ** -0.5),
        'router_b': nrm((L, E), 0.01),
        'moe_w1': nrm((L, E, D, 2 * F), D ** -0.5),
        'moe_b1': nrm((L, E, 2 * F), 0.01),
        'moe_w2': nrm((L, E, F, D), F ** -0.5),
        'moe_b2': nrm((L, E, D), 0.01),
        'final_norm_g': 1.0 + nrm((D,), 0.05),
    }


def reference(x, c, w_mod, b_mod, norm1_g, norm2_g, w_in, rwkv_mu, rwkv_w0, rwkv_w_up, rwkv_a0, rwkv_a_up, rwkv_g_up, rwkv_k_k, rwkv_k_a, rwkv_r_k, rwkv_ln_g, rwkv_ln_b, diff_lambda, diff_subln_g, rel_bias, w_branch_a, w_branch_b, w_branch_c, w_out, router_w, router_b, moe_w1, moe_b1, moe_w2, moe_b2, final_norm_g):
    B, T, D = x.shape
    n_groups = len(SWA_PATTERNS)
    bias_a = []
    for g, (window, dil) in enumerate(SWA_PATTERNS):
        half = window // (2 * dil)
        offs = jnp.arange(-half, half + 1) * dil
        bias_a.append(rel_bias[_t5_bucket(offs)][:, g * SWA_HEADS_PER_GROUP:(g + 1) * SWA_HEADS_PER_GROUP].T)
    table_c = rel_bias[:, SWA_HEADS:]
    cond = jax.nn.silu(c)

    for l in range(DEPTH):
        mod = (cond @ w_mod[l] + b_mod[l])[:, None, :]
        sh1, sc1, gt1, sh2, sc2, gt2 = jnp.split(mod, 6, axis=-1)

        h = _rmsnorm(x, norm1_g[l]) * (1 + sc1) + sh1
        proj = h @ w_in[l]
        a_qkv, b_stream, c_qkv, gate_logits = _split(proj, (3 * SWA_WIDTH, RWKV_STREAM, 3 * DIFF_WIDTH, 3 * D))

        aq, ak, av = [t.reshape(B, T, n_groups, SWA_HEADS_PER_GROUP, HEAD_DIM) for t in _split(a_qkv, (SWA_WIDTH, SWA_WIDTH, SWA_WIDTH))]
        outs, lses = [], []
        for g, (window, dil) in enumerate(SWA_PATTERNS):
            o_g, lse_g = _dilated_window_attn(aq[:, :, g], ak[:, :, g], av[:, :, g], bias_a[g], dil, window // (2 * dil))
            outs.append(o_g.astype(jnp.float32))
            lses.append(lse_g)
        wts = jax.nn.softmax(jnp.stack(lses, axis=0), axis=0)
        o_a = jnp.sum(wts[..., None] * jnp.stack(outs, axis=0), axis=0).reshape(B, T, SWA_OUT_WIDTH).astype(x.dtype)

        o_b = _rwkv7_bidir(b_stream, rwkv_mu[l], rwkv_w0[l], rwkv_w_up[l], rwkv_a0[l], rwkv_a_up[l], rwkv_g_up[l], rwkv_k_k[l], rwkv_k_a[l], rwkv_r_k[l], rwkv_ln_g[l], rwkv_ln_b[l])

        cq, ck, cv = _split(c_qkv, (DIFF_WIDTH, DIFF_WIDTH, DIFF_WIDTH))
        dl = diff_lambda[l].astype(jnp.float32)
        lambda_init = 0.8 - 0.6 * math.exp(-0.3 * l)
        lam = jnp.exp(jnp.sum(dl[0] * dl[1])) - jnp.exp(jnp.sum(dl[2] * dl[3])) + lambda_init
        o_c = _diff_attention(cq.reshape(B, T, DIFF_HEADS, 2, HEAD_DIM), ck.reshape(B, T, DIFF_HEADS, 2, HEAD_DIM), cv.reshape(B, T, DIFF_HEADS, 2 * HEAD_DIM), table_c, lam, lambda_init, diff_subln_g[l])

        g_a, g_b, g_c = jnp.split(jax.nn.sigmoid(gate_logits), 3, axis=-1)
        merged = g_a * (o_a @ w_branch_a[l]) + g_b * (o_b @ w_branch_b[l]) + g_c * (o_c @ w_branch_c[l])
        x = x + gt1 * (merged @ w_out[l])

        h2 = _rmsnorm(x, norm2_g[l]) * (1 + sc2) + sh2
        x = x + gt2 * _moe(h2, router_w[l], router_b[l], moe_w1[l], moe_b1[l], moe_w2[l], moe_b2[l])

    return _rmsnorm(x, final_norm_g)
```

```cpp
#include <hip/hip_runtime.h>
#include <stdint.h>
#include <stdio.h>

#define LAS __attribute__((address_space(3)))
typedef unsigned short bf16_t;
typedef short bf16x8 __attribute__((ext_vector_type(8)));
typedef short s16x4 __attribute__((ext_vector_type(4)));
typedef float f32x2 __attribute__((ext_vector_type(2)));
typedef float f32x4 __attribute__((ext_vector_type(4)));
typedef float f32x16 __attribute__((ext_vector_type(16)));
typedef unsigned u32x2 __attribute__((ext_vector_type(2)));
typedef unsigned u32x4 __attribute__((ext_vector_type(4)));
typedef __bf16 bf16x2_t __attribute__((ext_vector_type(2)));
typedef short v4i16_t __attribute__((ext_vector_type(4)));

constexpr int NB = 8, NT = 2048, DM = 1024, NTOK = NB * NT, DEPTH = 2;
constexpr int IN_COLS = 10368, PLD = 10496;
constexpr int C_AQ = 0, C_AK = 768, C_AV = 1536, C_BS = 2304, C_CQ = 5120, C_CK = 5888, C_CV = 6656, C_G = 7424;
constexpr int RSTR = 2688, RW = 768, NE = 32, FF = 1024;
constexpr float LOG2E = 1.4426950408889634f;

constexpr size_t al256(size_t x) { return (x + 255) & ~(size_t)255; }
constexpr size_t WS_CTL = 0;
constexpr size_t CTL_BYTES = 65536;
constexpr size_t WS_MISC = WS_CTL + CTL_BYTES;
constexpr size_t MISC_MOD = 0, MISC_LAM = 393216, MISC_BIASA = 393472, MISC_BIASC = 399872, MISC_BYTES = 1 << 20;
constexpr size_t WS_WIN = WS_MISC + MISC_BYTES;
constexpr size_t WS_WA = WS_WIN + (size_t)DEPTH * PLD * DM * 2;
constexpr size_t WS_WB = WS_WA + (size_t)DEPTH * DM * 256 * 2;
constexpr size_t WS_WC = WS_WB + (size_t)DEPTH * DM * 768 * 2;
constexpr size_t WS_WO = WS_WC + (size_t)DEPTH * DM * 768 * 2;
constexpr size_t WS_W1 = WS_WO + (size_t)DEPTH * DM * DM * 2;
constexpr size_t WS_W2 = WS_W1 + (size_t)DEPTH * NE * 2 * FF * DM * 2;
constexpr size_t WS_H = WS_W2 + (size_t)DEPTH * NE * DM * FF * 2;
constexpr size_t WS_X = WS_H + (size_t)NTOK * DM * 2;
constexpr size_t WS_OA = WS_X + (size_t)NTOK * DM * 4;
constexpr size_t WS_OB = WS_OA + (size_t)NTOK * 256 * 2;
constexpr size_t WS_OC = WS_OB + (size_t)NTOK * 768 * 2;
constexpr size_t WS_MERGED = WS_OC + (size_t)NTOK * 768 * 2;
constexpr size_t WS_LIST = WS_MERGED + (size_t)NTOK * DM * 2;
constexpr size_t WS_TOKE = WS_LIST + (size_t)NE * NTOK * 4;
constexpr size_t WS_TOKP = WS_TOKE + (size_t)NTOK * 4 * 4;
constexpr size_t WS_U = WS_TOKP + (size_t)NTOK * 4 * 4;
constexpr size_t WS_PROJ = WS_U;
constexpr size_t WS_RR = WS_PROJ + (size_t)NTOK * PLD * 2;
constexpr size_t WS_RV = WS_RR + (size_t)NTOK * RW * 4;
constexpr size_t WS_RWD = WS_RV + (size_t)NTOK * RW * 4;
constexpr size_t WS_RKK = WS_RWD + (size_t)2 * NTOK * RW * 4;
constexpr size_t WS_RKKA = WS_RKK + (size_t)2 * NTOK * RW * 4;
constexpr size_t WS_RKD = WS_RKKA + (size_t)2 * NTOK * RW * 4;
constexpr size_t WS_GS = WS_RKD + (size_t)2 * NTOK * RW * 4;
constexpr size_t WS_Y = WS_GS + (size_t)NTOK * 128 * 4;
constexpr size_t WS_OAG = WS_Y + (size_t)2 * NTOK * RW * 4;
constexpr size_t WS_LSE = WS_OAG + (size_t)3 * NTOK * 256 * 4;
constexpr size_t WS_MF = WS_LSE + (size_t)3 * NTOK * 4 * 4;
constexpr size_t WS_END1 = WS_MF + (size_t)NTOK * DM * 4;
constexpr int SLOT_ROWS = 4 * NTOK + NE * 256;
constexpr size_t WS_ACT = WS_U;
constexpr size_t WS_YMOE = WS_ACT + (size_t)SLOT_ROWS * FF * 2;
constexpr size_t WS_END2 = WS_YMOE + (size_t)SLOT_ROWS * DM * 2;
constexpr size_t WS_END = WS_END1 > WS_END2 ? WS_END1 : WS_END2;

constexpr int CW_BAR = 0;
constexpr int CW_CNT = 4096;
constexpr int CW_QH = 4224;

constexpr int LDS_STAGE = 131072;
constexpr int LDS_CTL_OFF = LDS_STAGE;
constexpr int LDS_BYTES = LDS_STAGE + 16384;

__device__ __forceinline__ int otid() { int t = threadIdx.x; asm volatile("" : "+v"(t)); return t; }
__device__ __forceinline__ int obid() { int t = blockIdx.x; asm volatile("" : "+s"(t)); return t; }
__device__ __forceinline__ unsigned pk2(float lo, float hi) { f32x2 v = {lo, hi}; bf16x2_t b = __builtin_convertvector(v, bf16x2_t); return __builtin_bit_cast(unsigned, b); }
__device__ __forceinline__ float bflo(unsigned u) { return __builtin_bit_cast(float, u << 16); }
__device__ __forceinline__ float bfhi(unsigned u) { return __builtin_bit_cast(float, u & 0xffff0000u); }
__device__ __forceinline__ float bf2f(bf16_t h) { return __builtin_bit_cast(float, (unsigned)h << 16); }
__device__ __forceinline__ float wave_sum(float v) {
#pragma unroll
    for (int o = 1; o < 64; o <<= 1) v += __shfl_xor(v, o);
    return v;
}
__device__ __forceinline__ float sigmoidf_(float x) { return 1.f / (1.f + __expf(-x)); }
__device__ __forceinline__ int crow(int r, int hi) { return (r & 3) + 8 * (r >> 2) + 4 * hi; }
__device__ __forceinline__ s16x4 vtr(const LAS unsigned char* p) { return __builtin_bit_cast(s16x4, __builtin_amdgcn_ds_read_tr16_b64_v4i16((LAS v4i16_t*)p)); }
__device__ __forceinline__ float dpp_sum8(float x) {
    int v = __builtin_bit_cast(int, x);
    x += __builtin_bit_cast(float, __builtin_amdgcn_update_dpp(0, v, 0xB1, 0xF, 0xF, true));
    v = __builtin_bit_cast(int, x);
    x += __builtin_bit_cast(float, __builtin_amdgcn_update_dpp(0, v, 0x4E, 0xF, 0xF, true));
    v = __builtin_bit_cast(int, x);
    x += __builtin_bit_cast(float, __builtin_amdgcn_update_dpp(0, v, 0x141, 0xF, 0xF, true));
    return x;
}

#define XB_TMO      128
#define XB_XCNT(j)  (256  + 64 * (j))
#define XB_XSUB(j)  (1280 + 64 * (j))
#define XB_XGEN(j)  (2304 + 64 * (j))
#define XB_TOP      3328
#define XB_TOPGEN   3392
#define XCD_BAR_WORDS 3456
#define XB_SPIN_CAP (1u << 18)
__device__ __forceinline__ unsigned xb_ld(unsigned* p)              { return __hip_atomic_load(p, __ATOMIC_RELAXED, __HIP_MEMORY_SCOPE_AGENT); }
__device__ __forceinline__ unsigned xb_add(unsigned* p, unsigned v) { return __hip_atomic_fetch_add(p, v, __ATOMIC_RELAXED, __HIP_MEMORY_SCOPE_AGENT); }
__device__ __forceinline__ unsigned xb_xcc_id() { return (unsigned)__builtin_amdgcn_s_getreg((3 << 11) | 20) & 0xFu; }
#define XB_SPIN(cond, bar) do { unsigned _sp = 0; while (cond) { __builtin_amdgcn_s_sleep(1); \
    if ((++_sp & 255u) == 0u) { if (xb_ld(&(bar)[XB_TMO])) break; if (_sp > XB_SPIN_CAP) { atomicAdd(&(bar)[XB_TMO], 1u); break; } } } } while (0)
struct XcdBarrier { unsigned* bar; unsigned x; volatile LAS unsigned* st; };
__device__ __forceinline__ XcdBarrier xcd_barrier_post(unsigned* bar, volatile LAS unsigned* st) {
    XcdBarrier b; b.bar = bar; b.x = xb_xcc_id(); b.st = st;
    if (threadIdx.x == 0) (void)xb_add(&bar[XB_XCNT(b.x)], 1u);
    return b;
}
__device__ __forceinline__ void xcd_barrier_complete(unsigned* bar, unsigned x, unsigned& nloc, unsigned& nx) {
    const unsigned G = gridDim.x * gridDim.y * gridDim.z;
    unsigned sum, cnt, mine, sp = 0u;
    for (;;) {
        sum = 0u; cnt = 0u; mine = 0u;
#pragma unroll
        for (unsigned j = 0; j < 16; ++j) { const unsigned c = xb_ld(&bar[XB_XCNT(j)]); sum += c; cnt += (c > 0u) ? 1u : 0u; mine = (j == x) ? c : mine; }
        if (sum == G) break;
        __builtin_amdgcn_s_sleep(1);
        if ((++sp & 255u) == 0u) { if (xb_ld(&bar[XB_TMO])) break; if (sp > XB_SPIN_CAP) { atomicAdd(&bar[XB_TMO], 1u); break; } }
    }
    nloc = mine > 0u ? mine : 1u; nx = cnt > 0u ? cnt : 1u;
}
__device__ __forceinline__ void xcd_barrier(const XcdBarrier& b) {
    asm volatile("s_waitcnt vmcnt(0)" ::: "memory");
    __syncthreads();
    if (threadIdx.x == 0) {
        unsigned* bar = b.bar;
        __builtin_amdgcn_s_waitcnt(0);
        unsigned nloc = b.st[0], nx = b.st[1];
        if (nloc == 0u) { xcd_barrier_complete(bar, b.x, nloc, nx); b.st[0] = nloc; b.st[1] = nx; }
        const unsigned old = xb_add(&bar[XB_XSUB(b.x)], 1u);
        const unsigned gen = old / nloc;
        if (old + 1u == (gen + 1u) * nloc) {
            __builtin_amdgcn_fence(__ATOMIC_RELEASE, "agent");
            asm volatile("s_waitcnt vmcnt(0)" ::: "memory");
            const unsigned og = xb_add(&bar[XB_TOP], 1u);
            const unsigned tg = og / nx;
            if (og + 1u == (tg + 1u) * nx) xb_add(&bar[XB_TOPGEN], 1u);
            else XB_SPIN(xb_ld(&bar[XB_TOPGEN]) == tg, bar);
            __builtin_amdgcn_fence(__ATOMIC_ACQUIRE, "agent");
            xb_add(&bar[XB_XGEN(b.x)], 1u);
            asm volatile("s_waitcnt vmcnt(0)" ::: "memory");
        } else {
            XB_SPIN(xb_ld(&bar[XB_XGEN(b.x)]) == gen, bar);
            __builtin_amdgcn_fence(__ATOMIC_ACQUIRE, "agent");
            asm volatile("s_waitcnt vmcnt(0)" ::: "memory");
        }
    }
    __syncthreads();
}

namespace pg8 {
constexpr int BM = 256, BK = 64, HALF = 128, HTB = HALF * BK * 2, STAGE_BYTES = 8 * HTB, NXCD = 8, WGM = 8;
__device__ __forceinline__ int lds_byte(int r, int c) { const int st = (r >> 4) * 2 + (c >> 5), rr = r & 15, cc = c & 31, ob = rr * 64 + cc * 2; return st * 1024 + (ob ^ (((ob >> 9) & 1) << 5)); }
__device__ __forceinline__ void stage_rc(int b, int& R, int& C) { const int st = b / 1024, sb = b % 1024, swz = sb ^ (((sb >> 9) & 1) << 5); R = (st >> 1) * 16 + swz / 64; C = (st & 1) * 32 + (swz % 64) / 2; }
__device__ __forceinline__ int perm32(int rho) { const int n = rho >> 4, i = rho & 15; return 8 * (i >> 2) + 4 * n + (i & 3); }

struct Unit { int pm, pn, e, lt; };

struct StaticOrder {
    static constexpr bool GATHER = false;
    int nM, nN, nwg, G, c;
    __device__ void init(int M, int N, int G_, int c_) { nM = M / BM; nN = N / BM; nwg = nM * nN; G = G_; c = c_; }
    __device__ __forceinline__ bool next(int i, Unit& u) const {
        const long L = (long)i * G + c; if (L >= nwg) return false;
        int wgid = (int)L; { const int q = nwg / NXCD, r = nwg % NXCD, xcd = wgid % NXCD, off = wgid / NXCD; wgid = (xcd < r ? xcd * (q + 1) : r * (q + 1) + (xcd - r) * q) + off; }
        const int nig = WGM * nN, gid = wgid / nig, fm = gid * WGM, gsz = (nM - fm) < WGM ? (nM - fm) : WGM;
        u.pm = fm + ((wgid % nig) % gsz); u.pn = (wgid % nig) / gsz; u.e = 0; u.lt = 0; return true;
    }
    __device__ __forceinline__ int arow(const Unit& u, int r) const { return u.pm * BM + r; }
};
template <bool GATHER_> struct MoeOrder {
    static constexpr bool GATHER = GATHER_;
    const LAS int* tab;
    const int* list;
    int ncol, G, c;
    __device__ __forceinline__ bool next(int i, Unit& u) const {
        const int L = i * G + c; const int total = tab[32] * ncol; if (L >= total) return false;
        const int rt = L / ncol; u.pn = L - rt * ncol; u.pm = rt;
        int e = 0;
#pragma unroll 1
        for (int j = 1; j < 32; ++j) e = (tab[j] <= rt) ? j : e;
        u.e = e; u.lt = rt - tab[e]; return true;
    }
    __device__ __forceinline__ int arow(const Unit& u, int r) const {
        if (!GATHER_) return u.pm * BM + r;
        const int pos = u.lt * BM + r; const int cnt = tab[64 + u.e];
        return pos < cnt ? list[(size_t)u.e * NTOK + pos] : 0;
    }
};

template <class Epi, class Sched>
__device__ __forceinline__ void gemm_phase(LAS unsigned char* lds, const bf16_t* A, const bf16_t* Bt, const int K, const size_t b_estride_bytes, const Sched& S, const Epi& E) {
    constexpr bool GATHER = Sched::GATHER;
    const int tid = otid(), wid = __builtin_amdgcn_readfirstlane(tid >> 6), lane = tid & 63, wr = wid >> 2, wc = wid & 3, fr = lane & 15, fq = lane >> 4;
    const int nt = K / BK;
    int Rr[2], Cc[2]; unsigned voffA[2], voffB[2];
#pragma unroll
    for (int i = 0; i < 2; ++i) { int R, C; stage_rc(tid * 16 + i * 8192, R, C); const int Rb = Epi::PERM ? ((R & ~31) + perm32(R & 31)) : R;
        Rr[i] = R; Cc[i] = C; voffA[i] = (unsigned)(R * K + C) * 2u; voffB[i] = (unsigned)(Rb * K + C) * 2u; }
    const size_t kstep = (size_t)(BK * 2);
    const size_t hstep = (size_t)HALF * K * 2;
    const size_t tstep = 2 * hstep;
    const unsigned ldsw = (unsigned)wid * 1024u;
    const int aoff = lds_byte(wr * 64 + fr, fq * 8), boff = lds_byte(wc * 32 + fr, fq * 8);
#define PG8_SA(b, h) (((b) * 2 + (h)) * HTB)
#define PG8_SB(b, h) ((4 + (b) * 2 + (h)) * HTB)
#define PG8_STAGE(bufoff, gbase, voff) do { _Pragma("unroll") for (int _i = 0; _i < 2; ++_i) \
        __builtin_amdgcn_global_load_lds((const unsigned*)((const char*)(gbase) + (voff)[_i]), (LAS unsigned*)(lds + (bufoff) + ldsw + _i * 8192), 16, 0, 0); } while (0)
#define PG8_STAGEA(bufoff, uptr, offs, h, kb) do { _Pragma("unroll") for (int _i = 0; _i < 2; ++_i) { const char* _src; \
        if constexpr (GATHER) _src = (const char*)A + (size_t)(offs)[h][_i] + (size_t)(kb); else _src = (uptr) + (size_t)(h) * hstep + (size_t)(kb) + voffA[_i]; \
        __builtin_amdgcn_global_load_lds((const unsigned*)_src, (LAS unsigned*)(lds + (bufoff) + ldsw + _i * 8192), 16, 0, 0); } } while (0)
#define PG8_LDA(dst, b, h) do { _Pragma("unroll") for (int m = 0; m < 4; ++m) _Pragma("unroll") for (int k = 0; k < 2; ++k) dst[m][k] = *(const LAS bf16x8*)(lds + PG8_SA(b, h) + aoff + m * 2048 + k * 1024); } while (0)
#define PG8_LDB(dst, b, h) do { _Pragma("unroll") for (int n = 0; n < 2; ++n) _Pragma("unroll") for (int k = 0; k < 2; ++k) dst[n][k] = *(const LAS bf16x8*)(lds + PG8_SB(b, h) + boff + n * 2048 + k * 1024); } while (0)
#define PG8_MMA(ai, bj, At, Bt_) do { __builtin_amdgcn_s_setprio(1); _Pragma("unroll") for (int m = 0; m < 4; ++m) _Pragma("unroll") for (int n = 0; n < 2; ++n) _Pragma("unroll") for (int k = 0; k < 2; ++k) \
        acc[ai][bj][m][n] = __builtin_amdgcn_mfma_f32_16x16x32_bf16(Bt_[n][k], At[m][k], acc[ai][bj][m][n], 0, 0, 0); __builtin_amdgcn_s_setprio(0); } while (0)
#define PG8_WAIT_V(n) asm volatile("s_waitcnt vmcnt(" #n ")" ::: "memory")
#define PG8_WAIT_L(n) asm volatile("s_waitcnt lgkmcnt(" #n ")" ::: "memory")
#define PG8_BAR __builtin_amdgcn_s_barrier()
#define PG8_SCHED __builtin_amdgcn_sched_barrier(0)
#define PG8_AOFFS(dst, u) do { if constexpr (GATHER) { _Pragma("unroll") for (int _h = 0; _h < 2; ++_h) _Pragma("unroll") for (int _i = 0; _i < 2; ++_i) \
        dst[_h][_i] = ((unsigned)S.arow(u, _h * HALF + Rr[_i]) * (unsigned)K + (unsigned)Cc[_i]) * 2u; } } while (0)
    Unit cur, nxt; int ui = 0;
    if (!S.next(0, cur)) return;
    f32x4 acc[2][2][4][2];
#pragma unroll
    for (int a = 0; a < 2; ++a)
#pragma unroll
        for (int b = 0; b < 2; ++b)
#pragma unroll
            for (int m = 0; m < 4; ++m)
#pragma unroll
                for (int n = 0; n < 2; ++n) acc[a][b][m][n] = (f32x4){0.f, 0.f, 0.f, 0.f};
    bf16x8 At[4][2], B0[2][2], B1[2][2];
    unsigned aoc[2][2] = {{0u, 0u}, {0u, 0u}}, aon[2][2] = {{0u, 0u}, {0u, 0u}};
    PG8_AOFFS(aoc, cur);
    const char* cA = (const char*)A + (size_t)cur.pm * tstep;
    const char* cB = (const char*)Bt + (size_t)cur.e * b_estride_bytes + (size_t)cur.pn * tstep;
    PG8_STAGE(PG8_SB(0, 0), cB, voffB); PG8_STAGEA(PG8_SA(0, 0), cA, aoc, 0, 0); PG8_STAGE(PG8_SB(0, 1), cB + hstep, voffB); PG8_STAGEA(PG8_SA(0, 1), cA, aoc, 1, 0);
    if (wr == 1) PG8_BAR;
    PG8_WAIT_V(4); PG8_BAR;
    PG8_STAGE(PG8_SB(1, 0), cB + kstep, voffB); PG8_STAGEA(PG8_SA(1, 0), cA, aoc, 0, kstep); PG8_STAGE(PG8_SB(1, 1), cB + hstep + kstep, voffB);
    PG8_WAIT_V(6); PG8_BAR;
    for (;;) {
        const bool has_next = S.next(ui + 1, nxt);
        const char* nA = has_next ? (const char*)A + (size_t)nxt.pm * tstep : cA;
        const char* nB = has_next ? (const char*)Bt + (size_t)nxt.e * b_estride_bytes + (size_t)nxt.pn * tstep : cB;
        if constexpr (GATHER) {
            if (has_next) { PG8_AOFFS(aon, nxt); } else {
#pragma unroll
                for (int h = 0; h < 2; ++h)
#pragma unroll
                    for (int i = 0; i < 2; ++i) aon[h][i] = aoc[h][i]; } }
#pragma unroll 1
        for (int t = 0; t < nt; t += 2) {
            const bool last = (t == nt - 2);
            const size_t k1 = (size_t)(t + 1) * kstep;
            const size_t k2 = last ? (size_t)0 : (size_t)(t + 2) * kstep;
            const size_t k3 = k2 + kstep;
            const char* a2p = last ? nA : cA;
            unsigned a2o[2][2];
#pragma unroll
            for (int h = 0; h < 2; ++h)
#pragma unroll
                for (int i = 0; i < 2; ++i) a2o[h][i] = last ? aon[h][i] : aoc[h][i];
            const char* b2 = last ? nB : cB + (size_t)(t + 2) * kstep; const char* b3 = b2 + kstep;
            PG8_LDB(B0, 0, 0); PG8_SCHED; PG8_LDA(At, 0, 0); PG8_STAGEA(PG8_SA(1, 1), cA, aoc, 1, k1);
            PG8_WAIT_L(8); PG8_BAR; PG8_WAIT_L(0); PG8_MMA(0, 0, At, B0); PG8_BAR; PG8_SCHED;
            PG8_LDB(B1, 0, 1); PG8_STAGE(PG8_SB(0, 0), b2, voffB);
            PG8_BAR; PG8_WAIT_L(0); PG8_MMA(0, 1, At, B1); PG8_BAR;
            PG8_LDA(At, 0, 1); PG8_STAGEA(PG8_SA(0, 0), a2p, a2o, 0, k2);
            PG8_BAR; PG8_WAIT_L(0); PG8_MMA(1, 0, At, B0); PG8_BAR; PG8_SCHED;
            PG8_STAGE(PG8_SB(0, 1), b2 + hstep, voffB);
            PG8_WAIT_V(6); PG8_BAR; PG8_MMA(1, 1, At, B1); PG8_BAR;
            PG8_LDB(B0, 1, 0); PG8_SCHED; PG8_LDA(At, 1, 0); PG8_STAGEA(PG8_SA(0, 1), a2p, a2o, 1, k2);
            PG8_WAIT_L(8); PG8_BAR; PG8_WAIT_L(0); PG8_MMA(0, 0, At, B0); PG8_BAR; PG8_SCHED;
            PG8_LDB(B1, 1, 1); PG8_STAGE(PG8_SB(1, 0), b3, voffB);
            PG8_BAR; PG8_WAIT_L(0); PG8_MMA(0, 1, At, B1); PG8_BAR;
            PG8_LDA(At, 1, 1); PG8_STAGEA(PG8_SA(1, 0), a2p, a2o, 0, k3);
            PG8_BAR; PG8_WAIT_L(0); PG8_MMA(1, 0, At, B0); PG8_BAR; PG8_SCHED;
            PG8_STAGE(PG8_SB(1, 1), b3 + hstep, voffB);
            PG8_WAIT_V(6); PG8_BAR; PG8_MMA(1, 1, At, B1); PG8_BAR;
        }
        E(acc, cur, wr, wc, fr, fq);
        if (!has_next) break;
#pragma unroll
        for (int a = 0; a < 2; ++a)
#pragma unroll
            for (int b = 0; b < 2; ++b)
#pragma unroll
                for (int m = 0; m < 4; ++m)
#pragma unroll
                    for (int n = 0; n < 2; ++n) acc[a][b][m][n] = (f32x4){0.f, 0.f, 0.f, 0.f};
        cur = nxt; cA = nA; cB = nB; ++ui;
#pragma unroll
        for (int h = 0; h < 2; ++h)
#pragma unroll
            for (int i = 0; i < 2; ++i) aoc[h][i] = aon[h][i];
    }
    PG8_WAIT_V(0);
    if (wr == 0) PG8_BAR;
    PG8_BAR;
#undef PG8_SA
#undef PG8_SB
#undef PG8_STAGE
#undef PG8_STAGEA
#undef PG8_LDA
#undef PG8_LDB
#undef PG8_MMA
#undef PG8_WAIT_V
#undef PG8_WAIT_L
#undef PG8_BAR
#undef PG8_SCHED
#undef PG8_AOFFS
}

typedef f32x4 Acc[2][2][4][2];

struct EpiProj {
    static constexpr bool PERM = true;
    bf16_t* O;
    __device__ __forceinline__ void operator()(const Acc& acc, const Unit& u, int wr, int wc, int fr, int fq) const {
        const int row0 = u.pm * BM + wr * 64 + fr, col0 = u.pn * BM + wc * 32 + 8 * fq; const bool sg = u.pn >= 29;
#pragma unroll
        for (int ai = 0; ai < 2; ++ai)
#pragma unroll
            for (int m = 0; m < 4; ++m) { bf16_t* rowp = O + (size_t)(row0 + ai * HALF + m * 16) * PLD + col0;
#pragma unroll
                for (int bj = 0; bj < 2; ++bj) { f32x4 v0 = acc[ai][bj][m][0], v1 = acc[ai][bj][m][1];
                    if (sg) {
#pragma unroll
                        for (int j = 0; j < 4; ++j) { v0[j] = sigmoidf_(v0[j]); v1[j] = sigmoidf_(v1[j]); } }
                    u32x4 w; w.x = pk2(v0[0], v0[1]); w.y = pk2(v0[2], v0[3]); w.z = pk2(v1[0], v1[1]); w.w = pk2(v1[2], v1[3]);
                    *(u32x4*)(rowp + bj * HALF) = w; } }
    }
};
template <int SEG> struct EpiBranch {
    static constexpr bool PERM = true;
    const bf16_t* P; float* MF; bf16_t* MG;
    __device__ __forceinline__ void operator()(const Acc& acc, const Unit& u, int wr, int wc, int fr, int fq) const {
        const int row0 = u.pm * BM + wr * 64 + fr, col0 = u.pn * BM + wc * 32 + 8 * fq;
#pragma unroll
        for (int ai = 0; ai < 2; ++ai)
#pragma unroll
            for (int m = 0; m < 4; ++m) { const size_t r = (size_t)(row0 + ai * HALF + m * 16);
                asm volatile("" ::: "memory");
#pragma unroll
                for (int bj = 0; bj < 2; ++bj) { const int c = col0 + bj * HALF;
                    const u32x4 g = *(const u32x4*)(P + r * PLD + C_G + SEG * 1024 + c);
                    f32x4 v0 = acc[ai][bj][m][0], v1 = acc[ai][bj][m][1];
                    v0[0] *= bflo(g.x); v0[1] *= bfhi(g.x); v0[2] *= bflo(g.y); v0[3] *= bfhi(g.y);
                    v1[0] *= bflo(g.z); v1[1] *= bfhi(g.z); v1[2] *= bflo(g.w); v1[3] *= bfhi(g.w);
                    float* mp = MF + r * DM + c;
                    if (SEG > 0) { v0 += *(const f32x4*)mp; v1 += *(const f32x4*)(mp + 4); }
                    if (SEG < 2) { *(f32x4*)mp = v0; *(f32x4*)(mp + 4) = v1; }
                    else { u32x4 w; w.x = pk2(v0[0], v0[1]); w.y = pk2(v0[2], v0[3]); w.z = pk2(v1[0], v1[1]); w.w = pk2(v1[2], v1[3]); *(u32x4*)(MG + r * DM + c) = w; } } }
    }
};
struct EpiOut {
    static constexpr bool PERM = false;
    const float* xsrc; float* X; const float* gt;
    __device__ __forceinline__ void operator()(const Acc& acc, const Unit& u, int wr, int wc, int fr, int fq) const {
        const int row0 = u.pm * BM + wr * 64 + fr, col0 = u.pn * BM + wc * 32 + 4 * fq;
        const float* gp = gt + (size_t)((u.pm * BM) >> 11) * 6144 + col0;
        f32x4 gv[2][2];
#pragma unroll
        for (int bj = 0; bj < 2; ++bj)
#pragma unroll
            for (int n = 0; n < 2; ++n) gv[bj][n] = *(const f32x4*)(gp + bj * HALF + n * 16);
#pragma unroll
        for (int ai = 0; ai < 2; ++ai)
#pragma unroll
            for (int m = 0; m < 4; ++m) { const size_t o = (size_t)(row0 + ai * HALF + m * 16) * DM + col0;
#pragma unroll
                for (int bj = 0; bj < 2; ++bj)
#pragma unroll
                    for (int n = 0; n < 2; ++n) { const f32x4 xv = *(const f32x4*)(xsrc + o + bj * HALF + n * 16);
                        *(f32x4*)(X + o + bj * HALF + n * 16) = xv + gv[bj][n] * acc[ai][bj][m][n]; } }
    }
};
struct EpiMoe1 {
    static constexpr bool PERM = true;
    bf16_t* ACT; const float* b1;
    __device__ __forceinline__ void operator()(const Acc& acc, const Unit& u, int wr, int wc, int fr, int fq) const {
        const int row0 = u.pm * BM + wr * 64 + fr, col0 = u.pn * BM + wc * 32 + 8 * fq;
        const float* bp = b1 + (size_t)u.e * (2 * FF) + col0;
        f32x4 bv[2][2];
#pragma unroll
        for (int bj = 0; bj < 2; ++bj)
#pragma unroll
            for (int n = 0; n < 2; ++n) bv[bj][n] = *(const f32x4*)(bp + bj * HALF + 4 * n);
#pragma unroll
        for (int ai = 0; ai < 2; ++ai)
#pragma unroll
            for (int m = 0; m < 4; ++m) { bf16_t* rowp = ACT + (size_t)(row0 + ai * HALF + m * 16) * FF + (col0 >> 1);
#pragma unroll
                for (int bj = 0; bj < 2; ++bj) { const f32x4 v0 = acc[ai][bj][m][0] + bv[bj][0], v1 = acc[ai][bj][m][1] + bv[bj][1];
                    float a[4];
#pragma unroll
                    for (int q = 0; q < 4; ++q) { const float gl = (q < 2) ? v0[2 * q] : v1[2 * q - 4], ln = (q < 2) ? v0[2 * q + 1] : v1[2 * q - 3];
                        const float xg = fminf(gl, 7.0f), xl = fminf(fmaxf(ln, -7.0f), 7.0f);
                        a[q] = xg * sigmoidf_(1.702f * xg) * (xl + 1.0f); }
                    u32x2 w; w.x = pk2(a[0], a[1]); w.y = pk2(a[2], a[3]);
                    *(u32x2*)(rowp + bj * (HALF / 2)) = w; } }
    }
};
struct EpiMoe2 {
    static constexpr bool PERM = true;
    bf16_t* Y; const float* b2;
    __device__ __forceinline__ void operator()(const Acc& acc, const Unit& u, int wr, int wc, int fr, int fq) const {
        const int row0 = u.pm * BM + wr * 64 + fr, col0 = u.pn * BM + wc * 32 + 8 * fq;
        const float* bp = b2 + (size_t)u.e * DM + col0;
        f32x4 bv[2][2];
#pragma unroll
        for (int bj = 0; bj < 2; ++bj)
#pragma unroll
            for (int n = 0; n < 2; ++n) bv[bj][n] = *(const f32x4*)(bp + bj * HALF + 4 * n);
#pragma unroll
        for (int ai = 0; ai < 2; ++ai)
#pragma unroll
            for (int m = 0; m < 4; ++m) { bf16_t* rowp = Y + (size_t)(row0 + ai * HALF + m * 16) * DM + col0;
#pragma unroll
                for (int bj = 0; bj < 2; ++bj) { const f32x4 v0 = acc[ai][bj][m][0] + bv[bj][0], v1 = acc[ai][bj][m][1] + bv[bj][1];
                    u32x4 w; w.x = pk2(v0[0], v0[1]); w.y = pk2(v0[2], v0[3]); w.z = pk2(v1[0], v1[1]); w.w = pk2(v1[2], v1[3]);
                    *(u32x4*)(rowp + bj * HALF) = w; } }
    }
};
}

struct Args { const float* in[32]; float* out; unsigned char* ws; int ph_lo, ph_hi; };
enum { I_X = 0, I_C, I_WMOD, I_BMOD, I_N1G, I_N2G, I_WIN, I_MU, I_W0, I_WUP, I_A0, I_AUP, I_GUP, I_KK, I_KA, I_RK, I_LNG, I_LNB, I_DLAM, I_SUBG, I_RELB, I_WBA, I_WBB, I_WBC, I_WOUT, I_RW, I_RB, I_W1, I_B1, I_W2, I_B2, I_FNG };

__device__ __forceinline__ void lds_fence() { asm volatile("s_waitcnt lgkmcnt(0)" ::: "memory"); }

__device__ __forceinline__ void tr_item(const float* W, int ldw, int ncols, bf16_t* WT, int K, LAS float* scr, int item, int lane) {
    const int nblk = ncols >> 5, kb = item / nblk, nb = item - kb * nblk, k0 = 64 * kb, n0 = 32 * nb;
#pragma unroll 8
    for (int i = 0; i < 32; ++i) { const int kk = 2 * i + (lane >> 5); scr[kk * 33 + (lane & 31)] = W[(size_t)(k0 + kk) * ldw + n0 + (lane & 31)]; }
    lds_fence();
    const int c = lane & 7;
#pragma unroll
    for (int j = 0; j < 4; ++j) { const int n = (lane >> 3) + 8 * j; const LAS float* s = scr + (8 * c) * 33 + n;
        u32x4 o; o.x = pk2(s[0 * 33], s[1 * 33]); o.y = pk2(s[2 * 33], s[3 * 33]); o.z = pk2(s[4 * 33], s[5 * 33]); o.w = pk2(s[6 * 33], s[7 * 33]);
        *(u32x4*)(WT + (size_t)(n0 + n) * K + k0 + 8 * c) = o; }
    lds_fence();
}
__device__ __forceinline__ int t5_bucket(int rel) {
    const int ret = rel > 0 ? 16 : 0; const int n = rel < 0 ? -rel : rel;
    int v;
    if (n < 8) v = n; else if (n < 12) v = 8; else if (n < 16) v = 9; else if (n < 23) v = 10; else if (n < 32) v = 11;
    else if (n < 46) v = 12; else if (n < 64) v = 13; else if (n < 91) v = 14; else v = 15;
    return ret + v;
}
__device__ __forceinline__ void phase_p0(const Args& a, LAS unsigned char* lds) {
    const int tid = otid(), lane = tid & 63, wave = tid >> 6, G = gridDim.x;
    unsigned char* ws = a.ws;
    {
        LAS float* scr = (LAS float*)(lds + wave * 8448);
        const int gw = blockIdx.x * 8 + wave, NGW = G * 8;
        constexpr int NITEMS = 65536 + 32768 + 2 * 6592;
        for (int it = gw; it < NITEMS; it += NGW) {
            int r = it;
            if (r < 65536) { const int mat = r >> 10; tr_item(a.in[I_W1] + (size_t)mat * DM * 2 * FF, 2 * FF, 2 * FF, (bf16_t*)(ws + WS_W1) + (size_t)mat * 2 * FF * DM, DM, scr, r & 1023, lane); continue; }
            r -= 65536;
            if (r < 32768) { const int mat = r >> 9; tr_item(a.in[I_W2] + (size_t)mat * FF * DM, DM, DM, (bf16_t*)(ws + WS_W2) + (size_t)mat * DM * FF, FF, scr, r & 511, lane); continue; }
            r -= 32768;
            const int l = r / 6592; r -= l * 6592;
            if (r < 2496) { tr_item(a.in[I_WIN] + (size_t)l * DM * IN_COLS, IN_COLS, 4992, (bf16_t*)(ws + WS_WIN) + (size_t)l * PLD * DM, DM, scr, r, lane); continue; }
            r -= 2496;
            if (r < 2688) { tr_item(a.in[I_WIN] + (size_t)l * DM * IN_COLS + 4992, IN_COLS, 5376, (bf16_t*)(ws + WS_WIN) + (size_t)l * PLD * DM + (size_t)5120 * DM, DM, scr, r, lane); continue; }
            r -= 2688;
            if (r < 128) { tr_item(a.in[I_WBA] + (size_t)l * 256 * DM, DM, DM, (bf16_t*)(ws + WS_WA) + (size_t)l * DM * 256, 256, scr, r, lane); continue; }
            r -= 128;
            if (r < 384) { tr_item(a.in[I_WBB] + (size_t)l * 768 * DM, DM, DM, (bf16_t*)(ws + WS_WB) + (size_t)l * DM * 768, 768, scr, r, lane); continue; }
            r -= 384;
            if (r < 384) { tr_item(a.in[I_WBC] + (size_t)l * 768 * DM, DM, DM, (bf16_t*)(ws + WS_WC) + (size_t)l * DM * 768, 768, scr, r, lane); continue; }
            r -= 384;
            tr_item(a.in[I_WOUT] + (size_t)l * DM * DM, DM, DM, (bf16_t*)(ws + WS_WO) + (size_t)l * DM * DM, DM, scr, r, lane);
        }
        for (int i = blockIdx.x * 512 + tid; i < 2 * 128 * DM / 8; i += G * 512) {
            const int l = i / (128 * DM / 8), o = i - l * (128 * DM / 8);
            *(u32x4*)((bf16_t*)(ws + WS_WIN) + (size_t)l * PLD * DM + (size_t)4992 * DM + (size_t)o * 8) = (u32x4){0u, 0u, 0u, 0u};
        }
    }
    __syncthreads();
    if ((int)blockIdx.x < 192) {
        LAS float* sc = (LAS float*)(lds + 69632);
        LAS float* red = (LAS float*)(lds + 102400);
        for (int i = tid; i < NB * DM; i += 512) { const float v = a.in[I_C][i]; sc[i] = v / (1.f + expf(-v)); }
        __syncthreads();
        float* mod = (float*)(ws + WS_MISC + MISC_MOD);
        for (int j = blockIdx.x; j < 192; j += G) {
            const int l = j / 96, n0 = (j - l * 96) * 64, jj = tid & 63, ks = tid >> 6;
            float acc[8];
#pragma unroll
            for (int b = 0; b < 8; ++b) acc[b] = 0.f;
            const float* wp = a.in[I_WMOD] + ((size_t)l * DM + ks * 128) * 6144 + n0 + jj;
            for (int k = 0; k < 128; ++k) { const float w = wp[(size_t)k * 6144];
#pragma unroll
                for (int b = 0; b < 8; ++b) acc[b] += sc[b * DM + ks * 128 + k] * w; }
#pragma unroll
            for (int b = 0; b < 8; ++b) red[(ks * 8 + b) * 64 + jj] = acc[b];
            __syncthreads();
            { const int b = tid >> 6; float s = 0.f;
#pragma unroll
              for (int k2 = 0; k2 < 8; ++k2) s += red[(k2 * 8 + b) * 64 + jj];
              mod[((size_t)l * 8 + b) * 6144 + n0 + jj] = s + a.in[I_BMOD][(size_t)l * 6144 + n0 + jj]; }
            __syncthreads();
        }
    }
    if ((int)blockIdx.x == G - 1) {
        float* lam = (float*)(ws + WS_MISC + MISC_LAM);
        if (tid < 2) { const int l = tid; const float* dl = a.in[I_DLAM] + (size_t)l * 256; float s01 = 0.f, s23 = 0.f;
            for (int d = 0; d < 64; ++d) { s01 += dl[d] * dl[64 + d]; s23 += dl[128 + d] * dl[192 + d]; }
            const float li = 0.8f - 0.6f * expf(-0.3f * (float)l);
            lam[l] = expf(s01) - expf(s23) + li; lam[2 + l] = li; }
        float* bA = (float*)(ws + WS_MISC + MISC_BIASA);
        for (int i = tid; i < 12 * 129; i += 512) { const int head = i / 129, jj = i - head * 129, g = head >> 2; const int dil = (g == 0) ? 1 : (g == 1) ? 4 : 16;
            bA[i] = a.in[I_RELB][t5_bucket((jj - 64) * dil) * 18 + head] * LOG2E; }
        float* bC = (float*)(ws + WS_MISC + MISC_BIASC);
        for (int i = tid; i < 6 * 257; i += 512) { const int h = i / 257, rel = i - h * 257 - 128;
            bC[i] = a.in[I_RELB][t5_bucket(rel) * 18 + 12 + h] * LOG2E; }
    }
}

__device__ __forceinline__ float row_rstd(const f32x4 (&v)[4], float eps) {
    float s = 0.f;
#pragma unroll
    for (int j = 0; j < 4; ++j) s += (v[j].x * v[j].x + v[j].y * v[j].y) + (v[j].z * v[j].z + v[j].w * v[j].w);
    return rsqrtf(wave_sum(s) * (1.f / DM) + eps);
}
__device__ __forceinline__ void norm_mod_store(const f32x4 (&v)[4], float rstd, const float* g, const float* sc, const float* sh, bf16_t* orow, int lane) {
#pragma unroll
    for (int j = 0; j < 4; ++j) { const int c = 4 * lane + 256 * j;
        const f32x4 gv = *(const f32x4*)(g + c), scv = *(const f32x4*)(sc + c), shv = *(const f32x4*)(sh + c);
        const f32x4 y = v[j] * rstd * gv * (scv + 1.0f) + shv;
        u32x2 w; w.x = pk2(y.x, y.y); w.y = pk2(y.z, y.w);
        *(u32x2*)(orow + c) = w; }
}
__device__ __forceinline__ void phase_norm1(const Args& a, int l) {
    const int tid = otid(), lane = tid & 63, wave = tid >> 6;
    const float* mod = (const float*)(a.ws + WS_MISC + MISC_MOD) + (size_t)l * 8 * 6144;
    bf16_t* H = (bf16_t*)(a.ws + WS_H);
    for (int t = blockIdx.x * 8 + wave; t < NTOK; t += gridDim.x * 8) {
        const float* xr = a.in[I_X] + (size_t)t * DM; f32x4 v[4];
#pragma unroll
        for (int j = 0; j < 4; ++j) v[j] = *(const f32x4*)(xr + 4 * lane + 256 * j);
        const float rstd = row_rstd(v, 1e-6f);
        const float* mb = mod + (size_t)(t >> 11) * 6144;
        norm_mod_store(v, rstd, a.in[I_N1G] + (size_t)l * DM, mb + 1024, mb, H + (size_t)t * DM, lane);
    }
}

__device__ __forceinline__ float shiftv(const bf16_t* P, int t, int col, const float* mu) {
    const int ts = t & (NT - 1); const bf16_t* p0 = P + (size_t)t * PLD + C_BS + col;
    const float p = bf2f(p0[0]);
    const float pm = ts > 0 ? bf2f(p0[-PLD]) : 0.f;
    const float pn = ts < NT - 1 ? bf2f(p0[PLD]) : 0.f;
    return p + mu[col] * (pm - p) + mu[RSTR + col] * (pn - p);
}
__device__ __forceinline__ void phase_rwkv_pre(const Args& a, int l, LAS unsigned char* lds) {
    const int tid = otid(), lane = tid & 63, wave = tid >> 6;
    unsigned char* ws = a.ws;
    const bf16_t* P = (const bf16_t*)(ws + WS_PROJ);
    const float* mu = a.in[I_MU] + (size_t)l * 2 * RSTR;
    LAS float* LW = (LAS float*)lds;
    float* GS = (float*)(ws + WS_GS);
    float* RR = (float*)(ws + WS_RR); float* RV = (float*)(ws + WS_RV);
    float* RWD = (float*)(ws + WS_RWD); float* RKK = (float*)(ws + WS_RKK); float* RKKA = (float*)(ws + WS_RKKA); float* RKD = (float*)(ws + WS_RKD);
    const float* w0 = a.in[I_W0] + (size_t)l * 2 * RW; const float* a0 = a.in[I_A0] + (size_t)l * 2 * RW;
    const float* wup = a.in[I_WUP] + (size_t)l * 2 * 64 * RW; const float* aup = a.in[I_AUP] + (size_t)l * 2 * 64 * RW;
    const float* kkp = a.in[I_KK] + (size_t)l * 2 * RW; const float* kap = a.in[I_KA] + (size_t)l * 2 * RW;
    for (int tile = blockIdx.x; tile < NTOK / 32; tile += gridDim.x) {
        const int t0 = tile * 32;
        for (int idx = tid; idx < 32 * 384; idx += 512) {
            const int i = idx / 384, cc = idx - i * 384;
            const float val = shiftv(P, t0 + i, 2304 + cc, mu);
            if (cc < 128) { const int di = cc >> 6, j = cc & 63; LW[(j * 32 + i) * 4 + di] = tanhf(val); }
            else if (cc < 256) { const int c2 = cc - 128, di = c2 >> 6, j = c2 & 63; LW[(j * 32 + i) * 4 + 2 + di] = val; }
            else GS[(size_t)(t0 + i) * 128 + cc - 256] = sigmoidf_(val);
        }
        __syncthreads();
        for (int q = wave; q < 48; q += 8) {
            const int hd = q % 12, tg = q / 12, c = hd * 64 + lane, tb = t0 + tg * 8;
            float kv[8];
#pragma unroll
            for (int tk = 0; tk < 8; ++tk) { const int t = tb + tk;
                kv[tk] = shiftv(P, t, 768 + c, mu);
                RR[(size_t)t * RW + c] = shiftv(P, t, c, mu);
                RV[(size_t)t * RW + c] = shiftv(P, t, 1536 + c, mu); }
            float aw0[8], aw1[8], aa0[8], aa1[8];
#pragma unroll
            for (int tk = 0; tk < 8; ++tk) { aw0[tk] = 0.f; aw1[tk] = 0.f; aa0[tk] = 0.f; aa1[tk] = 0.f; }
            for (int j = 0; j < 64; ++j) {
                const float wu0 = wup[(size_t)j * RW + c], wu1 = wup[(size_t)(64 + j) * RW + c], au0 = aup[(size_t)j * RW + c], au1 = aup[(size_t)(64 + j) * RW + c];
#pragma unroll
                for (int tk = 0; tk < 8; ++tk) { const f32x4 q4 = *(const LAS f32x4*)(LW + (j * 32 + tg * 8 + tk) * 4);
                    aw0[tk] += q4.x * wu0; aw1[tk] += q4.y * wu1; aa0[tk] += q4.z * au0; aa1[tk] += q4.w * au1; }
            }
#pragma unroll
            for (int di = 0; di < 2; ++di) {
                const float w0c = w0[di * RW + c], a0c = a0[di * RW + c], kkc = kkp[di * RW + c], kac = kap[di * RW + c];
#pragma unroll
                for (int tk = 0; tk < 8; ++tk) { const int t = tb + tk;
                    const float z = w0c + (di ? aw1[tk] : aw0[tk]);
                    const float u = -z; const float sp = fmaxf(u, 0.f) + log1pf(expf(-fabsf(u)));
                    const float wlog = -sp - 0.5f;
                    const float decay = expf(-expf(wlog));
                    const float av = sigmoidf_(a0c + (di ? aa1[tk] : aa0[tk]));
                    const float kr = kv[tk] * kkc;
                    const float nrm = wave_sum(kr * kr);
                    const float kk = kr * rsqrtf(fmaxf(nrm, 1e-24f));
                    const float kd = kv[tk] * (1.f + (av - 1.f) * kac);
                    const size_t o = ((size_t)di * NTOK + t) * RW + c;
                    RWD[o] = decay; RKK[o] = kk; RKKA[o] = kk * av; RKD[o] = kd; }
            }
        }
        __syncthreads();
    }
}

__device__ __forceinline__ void swa_wave_unit(const bf16_t* P, float* OAG, float* LSE, const LAS float* biasA, LAS unsigned char* vbuf, int u, int lane) {
    const int b = u / 768; const int rem = u - b * 768; const int head = rem >> 6, s = rem & 63;
    const int g = head >> 2, hh = head & 3;
    const int dsh = (g == 0) ? 0 : (g == 1) ? 2 : 4;
    const int L = NT >> dsh, nmbsh = 6 - dsh;
    const int r = s >> nmbsh, mb = s & ((1 << nmbsh) - 1);
    const int r32 = lane & 31, hi = lane >> 5;
    const size_t tq = (size_t)b * NT + ((mb * 32 + r32) << dsh) + r;
    bf16x8 qf[4];
    { const bf16_t* qp = P + tq * PLD + C_AQ + head * 64 + 8 * hi;
#pragma unroll
      for (int s4 = 0; s4 < 4; ++s4) qf[s4] = *(const bf16x8*)(qp + 16 * s4); }
    f32x16 o[2]; o[0] = (f32x16){}; o[1] = (f32x16){};
    float m = -1e30f, lsum = 0.f;
    const float SC = 0.125f * LOG2E;
    const LAS float* bh = biasA + head * 129 + 64;
    const int trbase = (4 * hi + ((lane & 15) >> 2)) * 144 + (16 * ((lane >> 4) & 1) + 4 * (lane & 3)) * 2;
    for (int kt = -2; kt <= 2; ++kt) {
        const int m0 = mb * 32 + kt * 32;
        if (m0 + 31 < 0 || m0 >= L) continue;
        bf16x8 kf[4];
        { int km = m0 + r32; km = km < 0 ? 0 : (km > L - 1 ? L - 1 : km);
          const bf16_t* kp = P + ((size_t)b * NT + (km << dsh) + r) * PLD + C_AK + head * 64 + 8 * hi;
#pragma unroll
          for (int s4 = 0; s4 < 4; ++s4) kf[s4] = *(const bf16x8*)(kp + 16 * s4); }
        asm volatile("" ::: "memory");
#pragma unroll
        for (int c4 = 0; c4 < 4; ++c4) { const int id = lane + 64 * c4, row = id >> 3, ch = id & 7;
            int vm = m0 + row; vm = vm < 0 ? 0 : (vm > L - 1 ? L - 1 : vm);
            const u32x4 val = *(const u32x4*)(P + ((size_t)b * NT + (vm << dsh) + r) * PLD + C_AV + head * 64 + ch * 8);
            *(LAS u32x4*)(vbuf + row * 144 + ch * 16) = val; }
        f32x16 sacc = (f32x16){};
#pragma unroll
        for (int s4 = 0; s4 < 4; ++s4) sacc = __builtin_amdgcn_mfma_f32_32x32x16_bf16(kf[s4], qf[s4], sacc, 0, 0, 0);
        float x[16]; float mx = -1e30f;
#pragma unroll
        for (int rg = 0; rg < 16; ++rg) { const int kvl = crow(rg, hi), km = m0 + kvl, j = kt * 32 + kvl - r32;
            const bool valid = (km >= 0) && (km < L) && (j >= -64) && (j <= 64);
            const int jc = j < -64 ? -64 : (j > 64 ? 64 : j);
            const float xv = sacc[rg] * SC + bh[jc];
            x[rg] = valid ? xv : -1e30f; mx = fmaxf(mx, x[rg]); }
        mx = fmaxf(mx, __shfl_xor(mx, 32));
        const float mn = fmaxf(m, mx), alpha = __builtin_amdgcn_exp2f(m - mn); m = mn;
        float ps = 0.f;
#pragma unroll
        for (int rg = 0; rg < 16; ++rg) { x[rg] = __builtin_amdgcn_exp2f(x[rg] - mn); ps += x[rg]; }
        lsum = lsum * alpha + ps;
#pragma unroll
        for (int rg = 0; rg < 16; ++rg) { o[0][rg] *= alpha; o[1][rg] *= alpha; }
        u32x4 pw[2];
#pragma unroll
        for (int s2 = 0; s2 < 2; ++s2) { pw[s2].x = pk2(x[8 * s2 + 0], x[8 * s2 + 1]); pw[s2].y = pk2(x[8 * s2 + 2], x[8 * s2 + 3]); pw[s2].z = pk2(x[8 * s2 + 4], x[8 * s2 + 5]); pw[s2].w = pk2(x[8 * s2 + 6], x[8 * s2 + 7]); }
        lds_fence();
#pragma unroll
        for (int db = 0; db < 2; ++db)
#pragma unroll
            for (int s2 = 0; s2 < 2; ++s2) {
                const s16x4 lo = vtr(vbuf + trbase + (16 * s2) * 144 + db * 64);
                const s16x4 hi4 = vtr(vbuf + trbase + (16 * s2 + 8) * 144 + db * 64);
                const bf16x8 af = (bf16x8){lo[0], lo[1], lo[2], lo[3], hi4[0], hi4[1], hi4[2], hi4[3]};
                o[db] = __builtin_amdgcn_mfma_f32_32x32x16_bf16(af, __builtin_bit_cast(bf16x8, pw[s2]), o[db], 0, 0, 0);
            }
        asm volatile("" ::: "memory");
    }
    const float lt = lsum + __shfl_xor(lsum, 32);
    const float inv = 1.f / lt;
    float* op = OAG + ((size_t)g * NTOK + tq) * 256 + hh * 64;
#pragma unroll
    for (int db = 0; db < 2; ++db)
#pragma unroll
        for (int i = 0; i < 4; ++i) { f32x4 v = (f32x4){o[db][4 * i], o[db][4 * i + 1], o[db][4 * i + 2], o[db][4 * i + 3]} * inv;
            *(f32x4*)(op + db * 32 + 8 * i + 4 * hi) = v; }
    if (hi == 0) LSE[((size_t)g * NTOK + tq) * 4 + hh] = m + __log2f(lt);
}
__device__ __forceinline__ void phase_swa(const Args& a, LAS unsigned char* lds) {
    const int tid = otid(), lane = tid & 63, wave = tid >> 6;
    LAS float* bA = (LAS float*)(lds + 40960);
    const float* bAg = (const float*)(a.ws + WS_MISC + MISC_BIASA);
    for (int i = tid; i < 12 * 129; i += 512) bA[i] = bAg[i];
    __syncthreads();
    for (int item = blockIdx.x; item < 768; item += gridDim.x)
        swa_wave_unit((const bf16_t*)(a.ws + WS_PROJ), (float*)(a.ws + WS_OAG), (float*)(a.ws + WS_LSE), bA, lds + wave * 4608, item * 8 + wave, lane);
    __syncthreads();
}

__device__ __forceinline__ void rwkv_scan_unit(const Args& a, int unit, LAS unsigned char* lds) {
    const int dir = unit & 1, bh = unit >> 1, h = bh % 12, b = bh / 12;
    const int tid = otid(), row = tid >> 3, kp = tid & 7;
    unsigned char* ws = a.ws;
    const size_t base_d = ((size_t)dir * NTOK + (size_t)b * NT) * RW + h * 64;
    const size_t base_s = ((size_t)b * NT) * RW + h * 64;
    const float* src[6] = { (const float*)(ws + WS_RWD) + base_d, (const float*)(ws + WS_RKK) + base_d, (const float*)(ws + WS_RKKA) + base_d, (const float*)(ws + WS_RKD) + base_d,
                            (const float*)(ws + WS_RR) + base_s, (const float*)(ws + WS_RV) + base_s };
    float* Y = (float*)(ws + WS_Y) + base_d;
    LAS float* ybuf = (LAS float*)(lds + 98304);
    const int li = tid >> 4, lc4 = tid & 15;
    float S[8];
#pragma unroll
    for (int i = 0; i < 8; ++i) S[i] = 0.f;
    f32x4 regs[6];
    { const int ts = dir ? NT - 32 : 0;
#pragma unroll
      for (int q = 0; q < 6; ++q) regs[q] = *(const f32x4*)(src[q] + (size_t)(ts + li) * RW + lc4 * 4);
#pragma unroll
      for (int q = 0; q < 6; ++q) *(LAS f32x4*)(lds + ((q * 32 + li) * 64 + lc4 * 4) * 4) = regs[q]; }
    __syncthreads();
    for (int c = 0; c < 64; ++c) {
        const int ts = dir ? NT - 32 * (c + 1) : 32 * c;
        if (c + 1 < 64) { const int tn = dir ? NT - 32 * (c + 2) : 32 * (c + 1);
#pragma unroll
            for (int q = 0; q < 6; ++q) regs[q] = *(const f32x4*)(src[q] + (size_t)(tn + li) * RW + lc4 * 4); }
        const LAS unsigned char* buf = lds + (c & 1) * 49152;
#pragma unroll 4
        for (int ii = 0; ii < 32; ++ii) {
            const int i = dir ? 31 - ii : ii;
            const LAS float* pw = (const LAS float*)(buf + ((0 * 32 + i) * 64 + 8 * kp) * 4);
            const f32x4 w0 = *(const LAS f32x4*)pw, w1 = *(const LAS f32x4*)(pw + 4);
            const f32x4 k0 = *(const LAS f32x4*)(pw + 2048), k1 = *(const LAS f32x4*)(pw + 2048 + 4);
            const f32x4 a0 = *(const LAS f32x4*)(pw + 4096), a1 = *(const LAS f32x4*)(pw + 4096 + 4);
            const f32x4 d0 = *(const LAS f32x4*)(pw + 6144), d1 = *(const LAS f32x4*)(pw + 6144 + 4);
            const f32x4 r0 = *(const LAS f32x4*)(pw + 8192), r1 = *(const LAS f32x4*)(pw + 8192 + 4);
            const float vv = *(const LAS float*)(buf + ((5 * 32 + i) * 64 + row) * 4);
            float sa = S[0] * k0.x + S[1] * k0.y + S[2] * k0.z + S[3] * k0.w + S[4] * k1.x + S[5] * k1.y + S[6] * k1.z + S[7] * k1.w;
            sa = -dpp_sum8(sa);
            S[0] = S[0] * w0.x + sa * a0.x + vv * d0.x; S[1] = S[1] * w0.y + sa * a0.y + vv * d0.y; S[2] = S[2] * w0.z + sa * a0.z + vv * d0.z; S[3] = S[3] * w0.w + sa * a0.w + vv * d0.w;
            S[4] = S[4] * w1.x + sa * a1.x + vv * d1.x; S[5] = S[5] * w1.y + sa * a1.y + vv * d1.y; S[6] = S[6] * w1.z + sa * a1.z + vv * d1.z; S[7] = S[7] * w1.w + sa * a1.w + vv * d1.w;
            float y = S[0] * r0.x + S[1] * r0.y + S[2] * r0.z + S[3] * r0.w + S[4] * r1.x + S[5] * r1.y + S[6] * r1.z + S[7] * r1.w;
            y = dpp_sum8(y);
            if (kp == 0) ybuf[i * 64 + row] = y;
        }
        __syncthreads();
        *(f32x4*)(Y + (size_t)(ts + li) * RW + lc4 * 4) = *(const LAS f32x4*)(ybuf + li * 64 + lc4 * 4);
        if (c + 1 < 64) { LAS unsigned char* nb = lds + ((c + 1) & 1) * 49152;
#pragma unroll
            for (int q = 0; q < 6; ++q) *(LAS f32x4*)(nb + ((q * 32 + li) * 64 + lc4 * 4) * 4) = regs[q]; }
        __syncthreads();
    }
}

__device__ __forceinline__ void diffattn_unit(const Args& a, int l, int unit, LAS unsigned char* lds) {
    constexpr int RS = 272;
    const int b = unit / 96; const int rem = unit - b * 96; const int h = rem >> 4, qb = rem & 15;
    const int tid = otid(), lane = tid & 63, wave = __builtin_amdgcn_readfirstlane(tid >> 6), r32 = lane & 31, hi = lane >> 5;
    const int c = wave & 1, qblk = wave >> 1;
    const int q0 = qb * 128 + qblk * 32;
    const bf16_t* P = (const bf16_t*)(a.ws + WS_PROJ);
    const size_t rowb = (size_t)b * NT;
    bf16x8 qf[4];
    { const bf16_t* qp = P + (rowb + q0 + r32) * PLD + C_CQ + h * 128 + c * 64 + 8 * hi;
#pragma unroll
      for (int s4 = 0; s4 < 4; ++s4) qf[s4] = *(const bf16x8*)(qp + 16 * s4); }
    LAS float* biasL = (LAS float*)(lds + 69632);
    { const float* bC = (const float*)(a.ws + WS_MISC + MISC_BIASC) + h * 257;
      for (int i = tid; i < 257; i += 512) biasL[i] = bC[i]; }
    const int srow0 = tid >> 4, sch = tid & 15;
    const bf16_t* kg = P + (rowb + srow0) * PLD + C_CK + h * 128 + sch * 8;
    const bf16_t* vg = P + (rowb + srow0) * PLD + C_CV + h * 128 + sch * 8;
    u32x4 kr[2], vr[2];
#pragma unroll
    for (int i = 0; i < 2; ++i) { kr[i] = *(const u32x4*)(kg + (size_t)(32 * i) * PLD); vr[i] = *(const u32x4*)(vg + (size_t)(32 * i) * PLD); }
#pragma unroll
    for (int i = 0; i < 2; ++i) { *(LAS u32x4*)(lds + (srow0 + 32 * i) * RS + sch * 16) = kr[i]; *(LAS u32x4*)(lds + 34816 + (srow0 + 32 * i) * RS + sch * 16) = vr[i]; }
    __syncthreads();
    f32x16 o[4];
#pragma unroll
    for (int db = 0; db < 4; ++db) o[db] = (f32x16){};
    float m = -1e30f, lsum = 0.f;
    const float SC = 0.125f * LOG2E;
    const int trb = (4 * hi + ((lane & 15) >> 2)) * RS + (16 * ((lane >> 4) & 1) + 4 * (lane & 3)) * 2;
    const int qabs = q0 + r32;
    for (int t = 0; t < 32; ++t) {
        if (t + 1 < 32) {
#pragma unroll
            for (int i = 0; i < 2; ++i) { kr[i] = *(const u32x4*)(kg + (size_t)(64 * (t + 1) + 32 * i) * PLD); vr[i] = *(const u32x4*)(vg + (size_t)(64 * (t + 1) + 32 * i) * PLD); } }
        const LAS unsigned char* Kb = lds + (t & 1) * 17408;
        const LAS unsigned char* Vb = lds + 34816 + (t & 1) * 17408;
        f32x16 sa0 = (f32x16){}, sa1 = (f32x16){};
#pragma unroll
        for (int s4 = 0; s4 < 4; ++s4) {
            const bf16x8 kf0 = *(const LAS bf16x8*)(Kb + r32 * RS + c * 128 + 32 * s4 + 16 * hi);
            const bf16x8 kf1 = *(const LAS bf16x8*)(Kb + (32 + r32) * RS + c * 128 + 32 * s4 + 16 * hi);
            sa0 = __builtin_amdgcn_mfma_f32_32x32x16_bf16(kf0, qf[s4], sa0, 0, 0, 0);
            sa1 = __builtin_amdgcn_mfma_f32_32x32x16_bf16(kf1, qf[s4], sa1, 0, 0, 0);
        }
        float x0[16], x1[16];
        const int kv0 = 64 * t;
        const bool farp = (kv0 >= q0 + 31 + 128), farn = (kv0 + 63 + 128 <= q0);
        if (farp || farn) { const float cb = farp ? biasL[256] : biasL[0];
#pragma unroll
            for (int rg = 0; rg < 16; ++rg) { x0[rg] = sa0[rg] * SC + cb; x1[rg] = sa1[rg] * SC + cb; }
        } else {
#pragma unroll
            for (int rg = 0; rg < 16; ++rg) { int rel = kv0 + crow(rg, hi) - qabs; int rc = rel < -128 ? -128 : (rel > 128 ? 128 : rel);
                x0[rg] = sa0[rg] * SC + biasL[rc + 128];
                rel += 32; rc = rel < -128 ? -128 : (rel > 128 ? 128 : rel);
                x1[rg] = sa1[rg] * SC + biasL[rc + 128]; }
        }
        float mx = fmaxf(x0[0], x1[0]);
#pragma unroll
        for (int rg = 1; rg < 16; ++rg) mx = fmaxf(mx, fmaxf(x0[rg], x1[rg]));
        mx = fmaxf(mx, __shfl_xor(mx, 32));
        const float mn = fmaxf(m, mx), alpha = __builtin_amdgcn_exp2f(m - mn); m = mn;
        float ps = 0.f;
#pragma unroll
        for (int rg = 0; rg < 16; ++rg) { x0[rg] = __builtin_amdgcn_exp2f(x0[rg] - mn); x1[rg] = __builtin_amdgcn_exp2f(x1[rg] - mn); ps += x0[rg] + x1[rg]; }
        lsum = lsum * alpha + ps;
#pragma unroll
        for (int db = 0; db < 4; ++db)
#pragma unroll
            for (int rg = 0; rg < 16; ++rg) o[db][rg] *= alpha;
        u32x4 pw[4];
#pragma unroll
        for (int s2 = 0; s2 < 2; ++s2) {
            pw[s2].x = pk2(x0[8 * s2 + 0], x0[8 * s2 + 1]); pw[s2].y = pk2(x0[8 * s2 + 2], x0[8 * s2 + 3]); pw[s2].z = pk2(x0[8 * s2 + 4], x0[8 * s2 + 5]); pw[s2].w = pk2(x0[8 * s2 + 6], x0[8 * s2 + 7]);
            pw[2 + s2].x = pk2(x1[8 * s2 + 0], x1[8 * s2 + 1]); pw[2 + s2].y = pk2(x1[8 * s2 + 2], x1[8 * s2 + 3]); pw[2 + s2].z = pk2(x1[8 * s2 + 4], x1[8 * s2 + 5]); pw[2 + s2].w = pk2(x1[8 * s2 + 6], x1[8 * s2 + 7]); }
#pragma unroll
        for (int db = 0; db < 4; ++db)
#pragma unroll
            for (int s = 0; s < 4; ++s) {
                const s16x4 lo = vtr(Vb + trb + (16 * s) * RS + db * 64);
                const s16x4 hi4 = vtr(Vb + trb + (16 * s + 8) * RS + db * 64);
                const bf16x8 af = (bf16x8){lo[0], lo[1], lo[2], lo[3], hi4[0], hi4[1], hi4[2], hi4[3]};
                o[db] = __builtin_amdgcn_mfma_f32_32x32x16_bf16(af, __builtin_bit_cast(bf16x8, pw[s]), o[db], 0, 0, 0);
            }
        if (t + 1 < 32) { LAS unsigned char* Kn = lds + ((t + 1) & 1) * 17408; LAS unsigned char* Vn = lds + 34816 + ((t + 1) & 1) * 17408;
#pragma unroll
            for (int i = 0; i < 2; ++i) { *(LAS u32x4*)(Kn + (srow0 + 32 * i) * RS + sch * 16) = kr[i]; *(LAS u32x4*)(Vn + (srow0 + 32 * i) * RS + sch * 16) = vr[i]; } }
        __syncthreads();
    }
    const float lt = lsum + __shfl_xor(lsum, 32);
    const float inv = 1.f / lt;
    const float* lamp = (const float*)(a.ws + WS_MISC + MISC_LAM);
    const float lam = lamp[l], linit = lamp[2 + l];
    LAS float* XO = (LAS float*)lds;
    if (c == 1) {
        const float f = inv * lam;
#pragma unroll
        for (int db = 0; db < 4; ++db)
#pragma unroll
            for (int rg = 0; rg < 16; ++rg) XO[(qblk * 64 + db * 16 + rg) * 64 + lane] = o[db][rg] * f;
    }
    __syncthreads();
    if (c == 0) {
        float ss = 0.f;
#pragma unroll
        for (int db = 0; db < 4; ++db)
#pragma unroll
            for (int rg = 0; rg < 16; ++rg) { const float v = o[db][rg] * inv - XO[(qblk * 64 + db * 16 + rg) * 64 + lane]; o[db][rg] = v; ss += v * v; }
        ss += __shfl_xor(ss, 32);
        const float sc = rsqrtf(ss * (1.f / 128.f) + 1e-5f) * (1.f - linit);
        const float* sg = a.in[I_SUBG] + (size_t)l * 128;
        bf16_t* op = (bf16_t*)(a.ws + WS_OC) + (rowb + q0 + r32) * 768 + h * 128;
#pragma unroll
        for (int db = 0; db < 4; ++db)
#pragma unroll
            for (int i = 0; i < 4; ++i) { const int d = db * 32 + 8 * i + 4 * hi; const f32x4 g4 = *(const f32x4*)(sg + d);
                u32x2 w; w.x = pk2(o[db][4 * i] * sc * g4.x, o[db][4 * i + 1] * sc * g4.y); w.y = pk2(o[db][4 * i + 2] * sc * g4.z, o[db][4 * i + 3] * sc * g4.w);
                *(u32x2*)(op + d) = w; }
    }
    __syncthreads();
}

__device__ __forceinline__ void phase_post(const Args& a, int l) {
    const int tid = otid(), lane = tid & 63, wave = tid >> 6;
    unsigned char* ws = a.ws;
    const float* OAG = (const float*)(ws + WS_OAG); const float* LSE = (const float*)(ws + WS_LSE);
    bf16_t* OA = (bf16_t*)(ws + WS_OA); bf16_t* OB = (bf16_t*)(ws + WS_OB);
    const float* GS = (const float*)(ws + WS_GS); const float* Y = (const float*)(ws + WS_Y);
    const float* RR = (const float*)(ws + WS_RR); const float* RV = (const float*)(ws + WS_RV); const float* RKD = (const float*)(ws + WS_RKD);
    const float* gup = a.in[I_GUP] + (size_t)l * 128 * RW;
    const float* rk = a.in[I_RK] + (size_t)l * RW; const float* lng = a.in[I_LNG] + (size_t)l * RW; const float* lnb = a.in[I_LNB] + (size_t)l * RW;
    for (int task = blockIdx.x * 8 + wave; task < NTOK / 4; task += gridDim.x * 8) {
        const int t0 = task * 4;
#pragma unroll
        for (int tk = 0; tk < 4; ++tk) { const size_t t = t0 + tk; const int hh = lane >> 4;
            const float l0 = LSE[((size_t)0 * NTOK + t) * 4 + hh], l1 = LSE[((size_t)1 * NTOK + t) * 4 + hh], l2 = LSE[((size_t)2 * NTOK + t) * 4 + hh];
            const float mx = fmaxf(l0, fmaxf(l1, l2));
            const float w0 = __builtin_amdgcn_exp2f(l0 - mx), w1 = __builtin_amdgcn_exp2f(l1 - mx), w2 = __builtin_amdgcn_exp2f(l2 - mx);
            const float inv = 1.f / (w0 + w1 + w2);
            const f32x4 o0 = *(const f32x4*)(OAG + ((size_t)0 * NTOK + t) * 256 + lane * 4), o1 = *(const f32x4*)(OAG + ((size_t)1 * NTOK + t) * 256 + lane * 4), o2 = *(const f32x4*)(OAG + ((size_t)2 * NTOK + t) * 256 + lane * 4);
            const f32x4 r = (o0 * w0 + o1 * w1 + o2 * w2) * inv;
            u32x2 w; w.x = pk2(r.x, r.y); w.y = pk2(r.z, r.w);
            *(u32x2*)(OA + t * 256 + lane * 4) = w; }
        float gsr[4][2];
#pragma unroll
        for (int tk = 0; tk < 4; ++tk) { gsr[tk][0] = GS[(size_t)(t0 + tk) * 128 + lane]; gsr[tk][1] = GS[(size_t)(t0 + tk) * 128 + 64 + lane]; }
        float gacc[12][4];
#pragma unroll
        for (int i = 0; i < 12; ++i)
#pragma unroll
            for (int tk = 0; tk < 4; ++tk) gacc[i][tk] = 0.f;
#pragma unroll
        for (int jh = 0; jh < 2; ++jh)
            for (int j = 0; j < 64; ++j) {
                float gv[4];
#pragma unroll
                for (int tk = 0; tk < 4; ++tk) gv[tk] = __builtin_bit_cast(float, __builtin_amdgcn_readlane(__builtin_bit_cast(int, gsr[tk][jh]), j));
                const float* gp = gup + (size_t)(jh * 64 + j) * RW + lane;
#pragma unroll
                for (int i = 0; i < 12; ++i) { const float gu = gp[i * 64];
#pragma unroll
                    for (int tk = 0; tk < 4; ++tk) gacc[i][tk] += gv[tk] * gu; }
            }
#pragma unroll
        for (int tk = 0; tk < 4; ++tk) { const size_t t = t0 + tk;
#pragma unroll
            for (int i = 0; i < 12; ++i) { const int c = i * 64 + lane;
                const float y = Y[t * RW + c] + Y[((size_t)NTOK + t) * RW + c];
                const float mean = wave_sum(y) * (1.f / 64.f);
                const float dv = y - mean;
                const float var = wave_sum(dv * dv) * (1.f / 64.f);
                const float yn = dv * rsqrtf(var + 64e-5f) * lng[c] + lnb[c];
                const float r = RR[t * RW + c], v = RV[t * RW + c], rkc = rk[c];
                const float s0 = wave_sum(r * RKD[t * RW + c] * rkc), s1 = wave_sum(r * RKD[((size_t)NTOK + t) * RW + c] * rkc);
                const float outv = (yn + (s0 + s1) * v) * gacc[i][tk];
                OB[t * RW + c] = (bf16_t)(pk2(outv, 0.f) & 0xffffu); } }
    }
}

__device__ __forceinline__ void phase_route(const Args& a, int l, LAS unsigned char* lds) {
    const int tid = otid(), lane = tid & 63, wave = tid >> 6;
    unsigned char* ws = a.ws;
    LAS float* rwT = (LAS float*)lds;
    { const float* rw = a.in[I_RW] + (size_t)l * DM * NE;
      for (int idx = tid; idx < NE * DM; idx += 512) { const int e = idx >> 10, k = idx & 1023; rwT[idx] = rw[k * NE + e]; } }
    __syncthreads();
    const float* X = (const float*)(ws + WS_X);
    const float* mod = (const float*)(ws + WS_MISC + MISC_MOD) + (size_t)l * 8 * 6144;
    bf16_t* H = (bf16_t*)(ws + WS_H);
    unsigned* cnt = (unsigned*)(ws + WS_CTL) + CW_CNT + l * 32;
    int* LIST = (int*)(ws + WS_LIST); unsigned* TOKE = (unsigned*)(ws + WS_TOKE); float* TOKP = (float*)(ws + WS_TOKP);
    const float* g2 = a.in[I_N2G] + (size_t)l * DM; const float* rb = a.in[I_RB] + (size_t)l * NE;
    for (int t = blockIdx.x * 8 + wave; t < NTOK; t += gridDim.x * 8) {
        f32x4 v[4];
#pragma unroll
        for (int j = 0; j < 4; ++j) v[j] = *(const f32x4*)(X + (size_t)t * DM + 4 * lane + 256 * j);
        const float rstd = row_rstd(v, 1e-6f);
        const float* mb = mod + (size_t)(t >> 11) * 6144;
        f32x4 hv[4];
#pragma unroll
        for (int j = 0; j < 4; ++j) { const int c = 4 * lane + 256 * j;
            const f32x4 gv = *(const f32x4*)(g2 + c), scv = *(const f32x4*)(mb + 4096 + c), shv = *(const f32x4*)(mb + 3072 + c);
            hv[j] = v[j] * rstd * gv * (scv + 1.0f) + shv;
            u32x2 w; w.x = pk2(hv[j].x, hv[j].y); w.y = pk2(hv[j].z, hv[j].w);
            *(u32x2*)(H + (size_t)t * DM + c) = w; }
        float p[32];
#pragma unroll
        for (int e = 0; e < 32; ++e) { float s = 0.f;
#pragma unroll
            for (int j = 0; j < 4; ++j) { const f32x4 w = *(const LAS f32x4*)(rwT + e * 1024 + 4 * lane + 256 * j);
                s += hv[j].x * w.x + hv[j].y * w.y + hv[j].z * w.z + hv[j].w * w.w; }
            p[e] = s; asm volatile("" ::: "memory"); }
#pragma unroll
        for (int e = 0; e < 32; ++e) p[e] += __shfl_xor(p[e], 32);
#pragma unroll
        for (int i = 0; i < 16; ++i) { const bool up = (lane & 16) != 0; const float send = up ? p[i] : p[i + 16], keep = up ? p[i + 16] : p[i]; p[i] = keep + __shfl_xor(send, 16); }
#pragma unroll
        for (int i = 0; i < 8; ++i) { const bool up = (lane & 8) != 0; const float send = up ? p[i] : p[i + 8], keep = up ? p[i + 8] : p[i]; p[i] = keep + __shfl_xor(send, 8); }
#pragma unroll
        for (int i = 0; i < 4; ++i) { const bool up = (lane & 4) != 0; const float send = up ? p[i] : p[i + 4], keep = up ? p[i + 4] : p[i]; p[i] = keep + __shfl_xor(send, 4); }
#pragma unroll
        for (int i = 0; i < 2; ++i) { const bool up = (lane & 2) != 0; const float send = up ? p[i] : p[i + 2], keep = up ? p[i + 2] : p[i]; p[i] = keep + __shfl_xor(send, 2); }
        { const bool up = (lane & 1) != 0; const float send = up ? p[0] : p[1], keep = up ? p[1] : p[0]; p[0] = keep + __shfl_xor(send, 1); }
        const int myidx = lane & 31;
        float cur = p[0] + rb[myidx];
        float tv[4]; int ti[4];
#pragma unroll
        for (int k = 0; k < 4; ++k) { float bv = cur; int bi = myidx;
#pragma unroll
            for (int off = 16; off >= 1; off >>= 1) { const float ov = __shfl_xor(bv, off); const int oi = __shfl_xor(bi, off);
                const bool take = (ov > bv) || (ov == bv && oi < bi); bv = take ? ov : bv; bi = take ? oi : bi; }
            tv[k] = bv; ti[k] = bi; if (myidx == bi) cur = -INFINITY; }
        const float e1 = expf(tv[1] - tv[0]), e2 = expf(tv[2] - tv[0]), e3 = expf(tv[3] - tv[0]);
        const float inv = 1.f / (1.f + e1 + e2 + e3);
        if (lane < 4) { const int e = lane == 0 ? ti[0] : lane == 1 ? ti[1] : lane == 2 ? ti[2] : ti[3];
            const float pr = (lane == 0 ? 1.f : lane == 1 ? e1 : lane == 2 ? e2 : e3) * inv;
            const unsigned pos = __hip_atomic_fetch_add(cnt + e, 1u, __ATOMIC_RELAXED, __HIP_MEMORY_SCOPE_AGENT);
            LIST[(size_t)e * NTOK + pos] = t; TOKE[(size_t)t * 4 + lane] = ((unsigned)e << 16) | pos; TOKP[(size_t)t * 4 + lane] = pr; }
    }
    __syncthreads();
}

__device__ __forceinline__ void build_moe_tab(const Args& a, int l, volatile LAS int* tab) {
    const unsigned* cnt = (const unsigned*)(a.ws + WS_CTL) + CW_CNT + l * 32;
    const int tid = otid();
    __syncthreads();
    if (tid < 32) tab[64 + tid] = (int)__hip_atomic_load(cnt + tid, __ATOMIC_RELAXED, __HIP_MEMORY_SCOPE_AGENT);
    __syncthreads();
    if (tid == 0) { int s = 0; for (int e = 0; e < 32; ++e) { tab[e] = s; s += (tab[64 + e] + 255) >> 8; } tab[32] = s; }
    __syncthreads();
}

__device__ __forceinline__ void phase_combine(const Args& a, int l, const LAS int* tab) {
    const int tid = otid(), lane = tid & 63, wave = tid >> 6;
    unsigned char* ws = a.ws;
    float* X = (float*)(ws + WS_X);
    const bf16_t* YM = (const bf16_t*)(ws + WS_YMOE);
    const unsigned* TOKE = (const unsigned*)(ws + WS_TOKE); const float* TOKP = (const float*)(ws + WS_TOKP);
    const float* modl = (const float*)(ws + WS_MISC + MISC_MOD) + (size_t)l * 8 * 6144;
    for (int t = blockIdx.x * 8 + wave; t < NTOK; t += gridDim.x * 8) {
        f32x4 v[4], acc[4];
#pragma unroll
        for (int j = 0; j < 4; ++j) { v[j] = *(const f32x4*)(X + (size_t)t * DM + 4 * lane + 256 * j); acc[j] = (f32x4){0.f, 0.f, 0.f, 0.f}; }
#pragma unroll
        for (int k = 0; k < 4; ++k) { const unsigned ep = TOKE[(size_t)t * 4 + k]; const float pr = TOKP[(size_t)t * 4 + k];
            const int e = ep >> 16, pos = ep & 0xffff; const size_t srow = (size_t)tab[e] * 256 + pos;
#pragma unroll
            for (int j = 0; j < 4; ++j) { const u32x2 y = *(const u32x2*)(YM + srow * DM + 4 * lane + 256 * j);
                acc[j].x += pr * bflo(y.x); acc[j].y += pr * bfhi(y.x); acc[j].z += pr * bflo(y.y); acc[j].w += pr * bfhi(y.y); } }
        const float* mb = modl + (size_t)(t >> 11) * 6144;
#pragma unroll
        for (int j = 0; j < 4; ++j) { const f32x4 gt = *(const f32x4*)(mb + 5120 + 4 * lane + 256 * j); v[j] = v[j] + gt * acc[j]; }
        const float rstd = row_rstd(v, 1e-6f);
        if (l + 1 < DEPTH) {
#pragma unroll
            for (int j = 0; j < 4; ++j) *(f32x4*)(X + (size_t)t * DM + 4 * lane + 256 * j) = v[j];
            const float* mn = modl + (size_t)8 * 6144 + (size_t)(t >> 11) * 6144;
            norm_mod_store(v, rstd, a.in[I_N1G] + (size_t)(l + 1) * DM, mn + 1024, mn, (bf16_t*)(ws + WS_H) + (size_t)t * DM, lane);
        } else {
#pragma unroll
            for (int j = 0; j < 4; ++j) { const int c = 4 * lane + 256 * j; const f32x4 g = *(const f32x4*)(a.in[I_FNG] + c);
                *(f32x4*)(a.out + (size_t)t * DM + c) = v[j] * rstd * g; }
        }
    }
}

constexpr int N_PHASES = 2 + 10 * DEPTH;
__global__ void __launch_bounds__(512, 2) fwd(Args a) {
    extern __shared__ __attribute__((aligned(16))) unsigned char smem[];
    LAS unsigned char* lds = (LAS unsigned char*)smem;
    const int tid = threadIdx.x;
    unsigned* ctl = (unsigned*)(a.ws + WS_CTL);
    volatile LAS unsigned* xbw = (volatile LAS unsigned*)(lds + LDS_CTL_OFF);
    volatile LAS int* tab = (volatile LAS int*)(lds + LDS_CTL_OFF + 256);
    volatile LAS int* qw = (volatile LAS int*)(lds + LDS_CTL_OFF + 1024);
    if (tid < 4) xbw[tid] = 0u;
    __syncthreads();
    const int lo = a.ph_lo, hi = a.ph_hi;
    XcdBarrier bar; bar.bar = ctl + CW_BAR; bar.x = 0; bar.st = xbw;
    if (hi - lo > 1) bar = xcd_barrier_post(ctl + CW_BAR, xbw);
#ifndef BRMASK
#define BRMASK 7
#endif
#ifndef PHMASK
#define PHMASK 0xFFF
#endif
#define PHSEL(k) ((k) < 2 ? (k) : 2 + ((k) - 2) % 10)
#define IN(k) (((PHMASK >> PHSEL(k)) & 1) && lo <= (k) && (k) < hi)
#define SEAM(k) do { if (IN(k) && IN((k) + 1)) xcd_barrier(bar); } while (0)
    unsigned char* ws = a.ws;
    if (IN(0)) { phase_p0(a, lds); SEAM(0); }
    if (IN(1)) { phase_norm1(a, 0); SEAM(1); }
    for (int l = 0; l < DEPTH; ++l) {
        const int pb = 2 + 10 * l;
        if (IN(pb + 0)) {
            pg8::StaticOrder S; S.init(NTOK, PLD, gridDim.x, blockIdx.x);
            pg8::EpiProj E{(bf16_t*)(ws + WS_PROJ)};
            pg8::gemm_phase<pg8::EpiProj, pg8::StaticOrder>(lds, (const bf16_t*)(ws + WS_H), (const bf16_t*)(ws + WS_WIN) + (size_t)l * PLD * DM, DM, 0, S, E);
            SEAM(pb + 0);
        }
        if (IN(pb + 1)) { phase_rwkv_pre(a, l, lds); phase_swa(a, lds); SEAM(pb + 1); }
        if (IN(pb + 2)) {
            for (int u = blockIdx.x; u < 192; u += gridDim.x) rwkv_scan_unit(a, u, lds);
            for (;;) {
                if (tid == 0) *qw = (int)__hip_atomic_fetch_add(ctl + CW_QH + 64 * l, 1u, __ATOMIC_RELAXED, __HIP_MEMORY_SCOPE_AGENT);
                __syncthreads();
                const int item = *qw;
                __syncthreads();
                if (item >= 768) break;
                diffattn_unit(a, l, item, lds);
            }
            SEAM(pb + 2);
        }
        if (IN(pb + 3)) { phase_post(a, l); SEAM(pb + 3); }
        if (IN(pb + 4)) {
            pg8::StaticOrder S; S.init(NTOK, DM, gridDim.x, blockIdx.x);
            const bf16_t* P = (const bf16_t*)(ws + WS_PROJ); float* MF = (float*)(ws + WS_MF); bf16_t* MG = (bf16_t*)(ws + WS_MERGED);
            if (BRMASK & 1) { pg8::EpiBranch<0> E{P, MF, MG}; pg8::gemm_phase<pg8::EpiBranch<0>, pg8::StaticOrder>(lds, (const bf16_t*)(ws + WS_OA), (const bf16_t*)(ws + WS_WA) + (size_t)l * DM * 256, 256, 0, S, E); }
            if (BRMASK & 2) { pg8::EpiBranch<1> E{P, MF, MG}; pg8::gemm_phase<pg8::EpiBranch<1>, pg8::StaticOrder>(lds, (const bf16_t*)(ws + WS_OB), (const bf16_t*)(ws + WS_WB) + (size_t)l * DM * 768, 768, 0, S, E); }
            if (BRMASK & 4) { pg8::EpiBranch<2> E{P, MF, MG}; pg8::gemm_phase<pg8::EpiBranch<2>, pg8::StaticOrder>(lds, (const bf16_t*)(ws + WS_OC), (const bf16_t*)(ws + WS_WC) + (size_t)l * DM * 768, 768, 0, S, E); }
            SEAM(pb + 4);
        }
        if (IN(pb + 5)) {
            pg8::StaticOrder S; S.init(NTOK, DM, gridDim.x, blockIdx.x);
            pg8::EpiOut E{l == 0 ? a.in[I_X] : (const float*)(ws + WS_X), (float*)(ws + WS_X), (const float*)(ws + WS_MISC + MISC_MOD) + (size_t)l * 8 * 6144 + 2048};
            pg8::gemm_phase<pg8::EpiOut, pg8::StaticOrder>(lds, (const bf16_t*)(ws + WS_MERGED), (const bf16_t*)(ws + WS_WO) + (size_t)l * DM * DM, DM, 0, S, E);
            SEAM(pb + 5);
        }
        if (IN(pb + 6)) { phase_route(a, l, lds); SEAM(pb + 6); }
        if (IN(pb + 7)) {
            build_moe_tab(a, l, tab);
            pg8::MoeOrder<true> S{(const LAS int*)tab, (const int*)(ws + WS_LIST), 8, (int)gridDim.x, (int)blockIdx.x};
            pg8::EpiMoe1 E{(bf16_t*)(ws + WS_ACT), a.in[I_B1] + (size_t)l * NE * 2 * FF};
            pg8::gemm_phase<pg8::EpiMoe1, pg8::MoeOrder<true>>(lds, (const bf16_t*)(ws + WS_H), (const bf16_t*)(ws + WS_W1) + (size_t)l * NE * 2 * FF * DM, DM, (size_t)2 * FF * DM * 2, S, E);
            SEAM(pb + 7);
        }
        if (IN(pb + 8)) {
            build_moe_tab(a, l, tab);
            pg8::MoeOrder<false> S{(const LAS int*)tab, nullptr, 4, (int)gridDim.x, (int)blockIdx.x};
            pg8::EpiMoe2 E{(bf16_t*)(ws + WS_YMOE), a.in[I_B2] + (size_t)l * NE * DM};
            pg8::gemm_phase<pg8::EpiMoe2, pg8::MoeOrder<false>>(lds, (const bf16_t*)(ws + WS_ACT), (const bf16_t*)(ws + WS_W2) + (size_t)l * NE * DM * FF, FF, (size_t)DM * FF * 2, S, E);
            SEAM(pb + 8);
        }
        if (IN(pb + 9)) { build_moe_tab(a, l, tab); phase_combine(a, l, (const LAS int*)tab); SEAM(pb + 9); }
    }
#undef IN
#undef SEAM
}

#ifndef MK_ONE_LAUNCH
#define MK_ONE_LAUNCH 0
#endif
extern "C" void kernel_launch(void* const* d_in, const int* in_sizes, int n_in, void* d_out, int out_size, void* d_ws, size_t ws_size, hipStream_t stream) {
    static int grid = 0;
    if (grid == 0) {
        if (n_in != 32 || ws_size < WS_END) { fprintf(stderr, "kernel_launch: unexpected n_in %d or ws %zu < %zu\n", n_in, ws_size, (size_t)WS_END); grid = -1; return; }
        int dev = 0, cus = 0;
        if (hipGetDevice(&dev) != hipSuccess || hipDeviceGetAttribute(&cus, hipDeviceAttributeMultiprocessorCount, dev) != hipSuccess) { grid = -1; return; }
        if (hipFuncSetAttribute((const void*)fwd, hipFuncAttributeMaxDynamicSharedMemorySize, LDS_BYTES) != hipSuccess) { fprintf(stderr, "kernel_launch: hipFuncSetAttribute failed\n"); grid = -1; return; }
        int per_cu = 0;
        if (hipOccupancyMaxActiveBlocksPerMultiprocessor(&per_cu, (const void*)fwd, 512, LDS_BYTES) != hipSuccess || per_cu < 1) fprintf(stderr, "kernel_launch: occupancy query says %d\n", per_cu);
        (void)hipGetLastError();
        grid = cus;
    }
    if (grid < 0) return;
    (void)hipMemsetAsync((char*)d_ws + WS_CTL, 0, CTL_BYTES, stream);
    Args a{};
    for (int i = 0; i < 32; ++i) a.in[i] = (const float*)d_in[i];
    a.out = (float*)d_out; a.ws = (unsigned char*)d_ws;
#if MK_ONE_LAUNCH
    a.ph_lo = 0; a.ph_hi = N_PHASES;
    hipLaunchKernelGGL(fwd, dim3(grid), dim3(512), LDS_BYTES, stream, a);
#else
    for (int p = 0; p < N_PHASES; ++p) { a.ph_lo = p; a.ph_hi = p + 1; hipLaunchKernelGGL(fwd, dim3(grid), dim3(512), LDS_BYTES, stream, a); }
#endif
}
```

```cpp
#include <hip/hip_runtime.h>
#include <stdint.h>
#include <stdio.h>

#define LAS __attribute__((address_space(3)))
typedef unsigned short bf16_t;
typedef short bf16x8 __attribute__((ext_vector_type(8)));
typedef short s16x4 __attribute__((ext_vector_type(4)));
typedef float f32x2 __attribute__((ext_vector_type(2)));
typedef float f32x4 __attribute__((ext_vector_type(4)));
typedef float f32x16 __attribute__((ext_vector_type(16)));
typedef unsigned u32x2 __attribute__((ext_vector_type(2)));
typedef unsigned u32x4 __attribute__((ext_vector_type(4)));
typedef __bf16 bf16x2_t __attribute__((ext_vector_type(2)));
typedef short v4i16_t __attribute__((ext_vector_type(4)));

constexpr int NB = 8, NT = 2048, DM = 1024, NTOK = NB * NT, DEPTH = 2;
constexpr int IN_COLS = 10368, PLD = 10496;
constexpr int C_AQ = 0, C_AK = 768, C_AV = 1536, C_BS = 2304, C_CQ = 5120, C_CK = 5888, C_CV = 6656, C_G = 7424;
constexpr int RSTR = 2688, RW = 768, NE = 32, FF = 1024;
constexpr float LOG2E = 1.4426950408889634f;

constexpr size_t al256(size_t x) { return (x + 255) & ~(size_t)255; }
constexpr size_t WS_CTL = 0;
constexpr size_t CTL_BYTES = 65536;
constexpr size_t WS_MISC = WS_CTL + CTL_BYTES;
constexpr size_t MISC_MOD = 0, MISC_LAM = 393216, MISC_BIASA = 393472, MISC_BIASC = 399872, MISC_BYTES = 1 << 20;
constexpr size_t WS_WIN = WS_MISC + MISC_BYTES;
constexpr size_t WS_WA = WS_WIN + (size_t)DEPTH * PLD * DM * 2;
constexpr size_t WS_WB = WS_WA + (size_t)DEPTH * DM * 256 * 2;
constexpr size_t WS_WC = WS_WB + (size_t)DEPTH * DM * 768 * 2;
constexpr size_t WS_WO = WS_WC + (size_t)DEPTH * DM * 768 * 2;
constexpr size_t WS_W1 = WS_WO + (size_t)DEPTH * DM * DM * 2;
constexpr size_t WS_W2 = WS_W1 + (size_t)DEPTH * NE * 2 * FF * DM * 2;
constexpr size_t WS_H = WS_W2 + (size_t)DEPTH * NE * DM * FF * 2;
constexpr size_t WS_X = WS_H + (size_t)NTOK * DM * 2;
constexpr size_t WS_OA = WS_X + (size_t)NTOK * DM * 4;
constexpr size_t WS_OB = WS_OA + (size_t)NTOK * 256 * 2;
constexpr size_t WS_OC = WS_OB + (size_t)NTOK * 768 * 2;
constexpr size_t WS_MERGED = WS_OC + (size_t)NTOK * 768 * 2;
constexpr size_t WS_LIST = WS_MERGED + (size_t)NTOK * DM * 2;
constexpr size_t WS_TOKE = WS_LIST + (size_t)NE * NTOK * 4;
constexpr size_t WS_TOKP = WS_TOKE + (size_t)NTOK * 4 * 4;
constexpr size_t WS_U = WS_TOKP + (size_t)NTOK * 4 * 4;
constexpr size_t WS_PROJ = WS_U;
constexpr size_t WS_RR = WS_PROJ + (size_t)NTOK * PLD * 2;
constexpr size_t WS_RV = WS_RR + (size_t)NTOK * RW * 4;
constexpr size_t WS_RWD = WS_RV + (size_t)NTOK * RW * 4;
constexpr size_t WS_RKK = WS_RWD + (size_t)2 * NTOK * RW * 4;
constexpr size_t WS_RKKA = WS_RKK + (size_t)2 * NTOK * RW * 4;
constexpr size_t WS_RKD = WS_RKKA + (size_t)2 * NTOK * RW * 4;
constexpr size_t WS_GS = WS_RKD + (size_t)2 * NTOK * RW * 4;
constexpr size_t WS_Y = WS_GS + (size_t)NTOK * 128 * 4;
constexpr size_t WS_OAG = WS_Y + (size_t)2 * NTOK * RW * 4;
constexpr size_t WS_LSE = WS_OAG + (size_t)3 * NTOK * 256 * 4;
constexpr size_t WS_MF = WS_LSE + (size_t)3 * NTOK * 4 * 4;
constexpr size_t WS_END1 = WS_MF + (size_t)NTOK * DM * 4;
constexpr int SLOT_ROWS = 4 * NTOK + NE * 256;
constexpr size_t WS_ACT = WS_U;
constexpr size_t WS_YMOE = WS_ACT + (size_t)SLOT_ROWS * FF * 2;
constexpr size_t WS_END2 = WS_YMOE + (size_t)SLOT_ROWS * DM * 2;
constexpr size_t WS_END = WS_END1 > WS_END2 ? WS_END1 : WS_END2;

constexpr int CW_BAR = 0;
constexpr int CW_CNT = 4096;
constexpr int CW_QH = 4224;

constexpr int LDS_STAGE = 131072;
constexpr int LDS_CTL_OFF = LDS_STAGE;
constexpr int LDS_BYTES = LDS_STAGE + 16384;

__device__ __forceinline__ int otid() { int t = threadIdx.x; asm volatile("" : "+v"(t)); return t; }
__device__ __forceinline__ int obid() { int t = blockIdx.x; asm volatile("" : "+s"(t)); return t; }
__device__ __forceinline__ unsigned pk2(float lo, float hi) { f32x2 v = {lo, hi}; bf16x2_t b = __builtin_convertvector(v, bf16x2_t); return __builtin_bit_cast(unsigned, b); }
__device__ __forceinline__ float bflo(unsigned u) { return __builtin_bit_cast(float, u << 16); }
__device__ __forceinline__ float bfhi(unsigned u) { return __builtin_bit_cast(float, u & 0xffff0000u); }
__device__ __forceinline__ float bf2f(bf16_t h) { return __builtin_bit_cast(float, (unsigned)h << 16); }
__device__ __forceinline__ float wave_sum(float v) {
#pragma unroll
    for (int o = 1; o < 64; o <<= 1) v += __shfl_xor(v, o);
    return v;
}
__device__ __forceinline__ float sigmoidf_(float x) { return 1.f / (1.f + __expf(-x)); }
__device__ __forceinline__ int crow(int r, int hi) { return (r & 3) + 8 * (r >> 2) + 4 * hi; }
__device__ __forceinline__ s16x4 vtr(const LAS unsigned char* p) { return __builtin_bit_cast(s16x4, __builtin_amdgcn_ds_read_tr16_b64_v4i16((LAS v4i16_t*)p)); }
__device__ __forceinline__ float dpp_sum8(float x) {
    int v = __builtin_bit_cast(int, x);
    x += __builtin_bit_cast(float, __builtin_amdgcn_update_dpp(0, v, 0xB1, 0xF, 0xF, true));
    v = __builtin_bit_cast(int, x);
    x += __builtin_bit_cast(float, __builtin_amdgcn_update_dpp(0, v, 0x4E, 0xF, 0xF, true));
    v = __builtin_bit_cast(int, x);
    x += __builtin_bit_cast(float, __builtin_amdgcn_update_dpp(0, v, 0x141, 0xF, 0xF, true));
    return x;
}

#define XB_TMO      128
#define XB_XCNT(j)  (256  + 64 * (j))
#define XB_XSUB(j)  (1280 + 64 * (j))
#define XB_XGEN(j)  (2304 + 64 * (j))
#define XB_TOP      3328
#define XB_TOPGEN   3392
#define XCD_BAR_WORDS 3456
#define XB_SPIN_CAP (1u << 18)
__device__ __forceinline__ unsigned xb_ld(unsigned* p)              { return __hip_atomic_load(p, __ATOMIC_RELAXED, __HIP_MEMORY_SCOPE_AGENT); }
__device__ __forceinline__ unsigned xb_add(unsigned* p, unsigned v) { return __hip_atomic_fetch_add(p, v, __ATOMIC_RELAXED, __HIP_MEMORY_SCOPE_AGENT); }
__device__ __forceinline__ unsigned xb_xcc_id() { return (unsigned)__builtin_amdgcn_s_getreg((3 << 11) | 20) & 0xFu; }
#define XB_SPIN(cond, bar) do { unsigned _sp = 0; while (cond) { __builtin_amdgcn_s_sleep(1); \
    if ((++_sp & 255u) == 0u) { if (xb_ld(&(bar)[XB_TMO])) break; if (_sp > XB_SPIN_CAP) { atomicAdd(&(bar)[XB_TMO], 1u); break; } } } } while (0)
struct XcdBarrier { unsigned* bar; unsigned x; volatile LAS unsigned* st; };
__device__ __forceinline__ XcdBarrier xcd_barrier_post(unsigned* bar, volatile LAS unsigned* st) {
    XcdBarrier b; b.bar = bar; b.x = xb_xcc_id(); b.st = st;
    if (threadIdx.x == 0) (void)xb_add(&bar[XB_XCNT(b.x)], 1u);
    return b;
}
__device__ __forceinline__ void xcd_barrier_complete(unsigned* bar, unsigned x, unsigned& nloc, unsigned& nx) {
    const unsigned G = gridDim.x * gridDim.y * gridDim.z;
    unsigned sum, cnt, mine, sp = 0u;
    for (;;) {
        sum = 0u; cnt = 0u; mine = 0u;
#pragma unroll
        for (unsigned j = 0; j < 16; ++j) { const unsigned c = xb_ld(&bar[XB_XCNT(j)]); sum += c; cnt += (c > 0u) ? 1u : 0u; mine = (j == x) ? c : mine; }
        if (sum == G) break;
        __builtin_amdgcn_s_sleep(1);
        if ((++sp & 255u) == 0u) { if (xb_ld(&bar[XB_TMO])) break; if (sp > XB_SPIN_CAP) { atomicAdd(&bar[XB_TMO], 1u); break; } }
    }
    nloc = mine > 0u ? mine : 1u; nx = cnt > 0u ? cnt : 1u;
}
__device__ __forceinline__ void xcd_barrier(const XcdBarrier& b) {
    asm volatile("s_waitcnt vmcnt(0)" ::: "memory");
    __syncthreads();
    if (threadIdx.x == 0) {
        unsigned* bar = b.bar;
        __builtin_amdgcn_s_waitcnt(0);
        unsigned nloc = b.st[0], nx = b.st[1];
        if (nloc == 0u) { xcd_barrier_complete(bar, b.x, nloc, nx); b.st[0] = nloc; b.st[1] = nx; }
        const unsigned old = xb_add(&bar[XB_XSUB(b.x)], 1u);
        const unsigned gen = old / nloc;
        if (old + 1u == (gen + 1u) * nloc) {
            __builtin_amdgcn_fence(__ATOMIC_RELEASE, "agent");
            asm volatile("s_waitcnt vmcnt(0)" ::: "memory");
            const unsigned og = xb_add(&bar[XB_TOP], 1u);
            const unsigned tg = og / nx;
            if (og + 1u == (tg + 1u) * nx) xb_add(&bar[XB_TOPGEN], 1u);
            else XB_SPIN(xb_ld(&bar[XB_TOPGEN]) == tg, bar);
            __builtin_amdgcn_fence(__ATOMIC_ACQUIRE, "agent");
            xb_add(&bar[XB_XGEN(b.x)], 1u);
            asm volatile("s_waitcnt vmcnt(0)" ::: "memory");
        } else {
            XB_SPIN(xb_ld(&bar[XB_XGEN(b.x)]) == gen, bar);
            __builtin_amdgcn_fence(__ATOMIC_ACQUIRE, "agent");
            asm volatile("s_waitcnt vmcnt(0)" ::: "memory");
        }
    }
    __syncthreads();
}

namespace pg8 {
constexpr int BM = 256, BK = 64, HALF = 128, HTB = HALF * BK * 2, STAGE_BYTES = 8 * HTB, NXCD = 8, WGM = 8;
__device__ __forceinline__ int lds_byte(int r, int c) { const int st = (r >> 4) * 2 + (c >> 5), rr = r & 15, cc = c & 31, ob = rr * 64 + cc * 2; return st * 1024 + (ob ^ (((ob >> 9) & 1) << 5)); }
__device__ __forceinline__ void stage_rc(int b, int& R, int& C) { const int st = b / 1024, sb = b % 1024, swz = sb ^ (((sb >> 9) & 1) << 5); R = (st >> 1) * 16 + swz / 64; C = (st & 1) * 32 + (swz % 64) / 2; }
__device__ __forceinline__ int perm32(int rho) { const int n = rho >> 4, i = rho & 15; return 8 * (i >> 2) + 4 * n + (i & 3); }

struct Unit { int pm, pn, e, lt; };

struct StaticOrder {
    static constexpr bool GATHER = false;
    int nM, nN, nwg, G, c;
    __device__ void init(int M, int N, int G_, int c_) { nM = M / BM; nN = N / BM; nwg = nM * nN; G = G_; c = c_; }
    __device__ __forceinline__ bool next(int i, Unit& u) const {
        const long L = (long)i * G + c; if (L >= nwg) return false;
        int wgid = (int)L; { const int q = nwg / NXCD, r = nwg % NXCD, xcd = wgid % NXCD, off = wgid / NXCD; wgid = (xcd < r ? xcd * (q + 1) : r * (q + 1) + (xcd - r) * q) + off; }
        const int nig = WGM * nN, gid = wgid / nig, fm = gid * WGM, gsz = (nM - fm) < WGM ? (nM - fm) : WGM;
        u.pm = fm + ((wgid % nig) % gsz); u.pn = (wgid % nig) / gsz; u.e = 0; u.lt = 0; return true;
    }
    __device__ __forceinline__ int arow(const Unit& u, int r) const { return u.pm * BM + r; }
};
template <bool GATHER_> struct MoeOrder {
    static constexpr bool GATHER = GATHER_;
    const LAS int* tab;
    const int* list;
    int ncol, G, c;
    __device__ __forceinline__ bool next(int i, Unit& u) const {
        const int L = i * G + c; const int total = tab[32] * ncol; if (L >= total) return false;
        const int rt = L / ncol; u.pn = L - rt * ncol; u.pm = rt;
        int e = 0;
#pragma unroll 1
        for (int j = 1; j < 32; ++j) e = (tab[j] <= rt) ? j : e;
        u.e = e; u.lt = rt - tab[e]; return true;
    }
    __device__ __forceinline__ int arow(const Unit& u, int r) const {
        if (!GATHER_) return u.pm * BM + r;
        const int pos = u.lt * BM + r; const int cnt = tab[64 + u.e];
        return pos < cnt ? list[(size_t)u.e * NTOK + pos] : 0;
    }
};

template <class Epi, class Sched>
__device__ __forceinline__ void gemm_phase(LAS unsigned char* lds, const bf16_t* A, const bf16_t* Bt, const int K, const size_t b_estride_bytes, const Sched& S, const Epi& E) {
    constexpr bool GATHER = Sched::GATHER;
    const int tid = otid(), wid = __builtin_amdgcn_readfirstlane(tid >> 6), lane = tid & 63, wr = wid >> 2, wc = wid & 3, fr = lane & 15, fq = lane >> 4;
    const int nt = K / BK;
    int Rr[2], Cc[2]; unsigned voffA[2], voffB[2];
#pragma unroll
    for (int i = 0; i < 2; ++i) { int R, C; stage_rc(tid * 16 + i * 8192, R, C); const int Rb = Epi::PERM ? ((R & ~31) + perm32(R & 31)) : R;
        Rr[i] = R; Cc[i] = C; voffA[i] = (unsigned)(R * K + C) * 2u; voffB[i] = (unsigned)(Rb * K + C) * 2u; }
    const size_t kstep = (size_t)(BK * 2);
    const size_t hstep = (size_t)HALF * K * 2;
    const size_t tstep = 2 * hstep;
    const unsigned ldsw = (unsigned)wid * 1024u;
    const int aoff = lds_byte(wr * 64 + fr, fq * 8), boff = lds_byte(wc * 32 + fr, fq * 8);
#define PG8_SA(b, h) (((b) * 2 + (h)) * HTB)
#define PG8_SB(b, h) ((4 + (b) * 2 + (h)) * HTB)
#define PG8_STAGE(bufoff, gbase, voff) do { _Pragma("unroll") for (int _i = 0; _i < 2; ++_i) \
        __builtin_amdgcn_global_load_lds((const unsigned*)((const char*)(gbase) + (voff)[_i]), (LAS unsigned*)(lds + (bufoff) + ldsw + _i * 8192), 16, 0, 0); } while (0)
#define PG8_STAGEA(bufoff, uptr, offs, h, kb) do { _Pragma("unroll") for (int _i = 0; _i < 2; ++_i) { const char* _src; \
        if constexpr (GATHER) _src = (const char*)A + (size_t)(offs)[h][_i] + (size_t)(kb); else _src = (uptr) + (size_t)(h) * hstep + (size_t)(kb) + voffA[_i]; \
        __builtin_amdgcn_global_load_lds((const unsigned*)_src, (LAS unsigned*)(lds + (bufoff) + ldsw + _i * 8192), 16, 0, 0); } } while (0)
#define PG8_LDA(dst, b, h) do { _Pragma("unroll") for (int m = 0; m < 4; ++m) _Pragma("unroll") for (int k = 0; k < 2; ++k) dst[m][k] = *(const LAS bf16x8*)(lds + PG8_SA(b, h) + aoff + m * 2048 + k * 1024); } while (0)
#define PG8_LDB(dst, b, h) do { _Pragma("unroll") for (int n = 0; n < 2; ++n) _Pragma("unroll") for (int k = 0; k < 2; ++k) dst[n][k] = *(const LAS bf16x8*)(lds + PG8_SB(b, h) + boff + n * 2048 + k * 1024); } while (0)
#define PG8_MMA(ai, bj, At, Bt_) do { __builtin_amdgcn_s_setprio(1); _Pragma("unroll") for (int m = 0; m < 4; ++m) _Pragma("unroll") for (int n = 0; n < 2; ++n) _Pragma("unroll") for (int k = 0; k < 2; ++k) \
        acc[ai][bj][m][n] = __builtin_amdgcn_mfma_f32_16x16x32_bf16(Bt_[n][k], At[m][k], acc[ai][bj][m][n], 0, 0, 0); __builtin_amdgcn_s_setprio(0); } while (0)
#define PG8_WAIT_V(n) asm volatile("s_waitcnt vmcnt(" #n ")" ::: "memory")
#define PG8_WAIT_L(n) asm volatile("s_waitcnt lgkmcnt(" #n ")" ::: "memory")
#define PG8_BAR __builtin_amdgcn_s_barrier()
#define PG8_SCHED __builtin_amdgcn_sched_barrier(0)
#define PG8_AOFFS(dst, u) do { if constexpr (GATHER) { _Pragma("unroll") for (int _h = 0; _h < 2; ++_h) _Pragma("unroll") for (int _i = 0; _i < 2; ++_i) \
        dst[_h][_i] = ((unsigned)S.arow(u, _h * HALF + Rr[_i]) * (unsigned)K + (unsigned)Cc[_i]) * 2u; } } while (0)
    Unit cur, nxt; int ui = 0;
    if (!S.next(0, cur)) return;
    f32x4 acc[2][2][4][2];
#pragma unroll
    for (int a = 0; a < 2; ++a)
#pragma unroll
        for (int b = 0; b < 2; ++b)
#pragma unroll
            for (int m = 0; m < 4; ++m)
#pragma unroll
                for (int n = 0; n < 2; ++n) acc[a][b][m][n] = (f32x4){0.f, 0.f, 0.f, 0.f};
    bf16x8 At[4][2], B0[2][2], B1[2][2];
    unsigned aoc[2][2] = {{0u, 0u}, {0u, 0u}}, aon[2][2] = {{0u, 0u}, {0u, 0u}};
    PG8_AOFFS(aoc, cur);
    const char* cA = (const char*)A + (size_t)cur.pm * tstep;
    const char* cB = (const char*)Bt + (size_t)cur.e * b_estride_bytes + (size_t)cur.pn * tstep;
    PG8_STAGE(PG8_SB(0, 0), cB, voffB); PG8_STAGEA(PG8_SA(0, 0), cA, aoc, 0, 0); PG8_STAGE(PG8_SB(0, 1), cB + hstep, voffB); PG8_STAGEA(PG8_SA(0, 1), cA, aoc, 1, 0);
    if (wr == 1) PG8_BAR;
    PG8_WAIT_V(4); PG8_BAR;
    PG8_STAGE(PG8_SB(1, 0), cB + kstep, voffB); PG8_STAGEA(PG8_SA(1, 0), cA, aoc, 0, kstep); PG8_STAGE(PG8_SB(1, 1), cB + hstep + kstep, voffB);
    PG8_WAIT_V(6); PG8_BAR;
    for (;;) {
        const bool has_next = S.next(ui + 1, nxt);
        const char* nA = has_next ? (const char*)A + (size_t)nxt.pm * tstep : cA;
        const char* nB = has_next ? (const char*)Bt + (size_t)nxt.e * b_estride_bytes + (size_t)nxt.pn * tstep : cB;
        if constexpr (GATHER) {
            if (has_next) { PG8_AOFFS(aon, nxt); } else {
#pragma unroll
                for (int h = 0; h < 2; ++h)
#pragma unroll
                    for (int i = 0; i < 2; ++i) aon[h][i] = aoc[h][i]; } }
#pragma unroll 1
        for (int t = 0; t < nt; t += 2) {
            const bool last = (t == nt - 2);
            const size_t k1 = (size_t)(t + 1) * kstep;
            const size_t k2 = last ? (size_t)0 : (size_t)(t + 2) * kstep;
            const size_t k3 = k2 + kstep;
            const char* a2p = last ? nA : cA;
            unsigned a2o[2][2];
#pragma unroll
            for (int h = 0; h < 2; ++h)
#pragma unroll
                for (int i = 0; i < 2; ++i) a2o[h][i] = last ? aon[h][i] : aoc[h][i];
            const char* b2 = last ? nB : cB + (size_t)(t + 2) * kstep; const char* b3 = b2 + kstep;
            PG8_LDB(B0, 0, 0); PG8_SCHED; PG8_LDA(At, 0, 0); PG8_STAGEA(PG8_SA(1, 1), cA, aoc, 1, k1);
            PG8_WAIT_L(8); PG8_BAR; PG8_WAIT_L(0); PG8_MMA(0, 0, At, B0); PG8_BAR; PG8_SCHED;
            PG8_LDB(B1, 0, 1); PG8_STAGE(PG8_SB(0, 0), b2, voffB);
            PG8_BAR; PG8_WAIT_L(0); PG8_MMA(0, 1, At, B1); PG8_BAR;
            PG8_LDA(At, 0, 1); PG8_STAGEA(PG8_SA(0, 0), a2p, a2o, 0, k2);
            PG8_BAR; PG8_WAIT_L(0); PG8_MMA(1, 0, At, B0); PG8_BAR; PG8_SCHED;
            PG8_STAGE(PG8_SB(0, 1), b2 + hstep, voffB);
            PG8_WAIT_V(6); PG8_BAR; PG8_MMA(1, 1, At, B1); PG8_BAR;
            PG8_LDB(B0, 1, 0); PG8_SCHED; PG8_LDA(At, 1, 0); PG8_STAGEA(PG8_SA(0, 1), a2p, a2o, 1, k2);
            PG8_WAIT_L(8); PG8_BAR; PG8_WAIT_L(0); PG8_MMA(0, 0, At, B0); PG8_BAR; PG8_SCHED;
            PG8_LDB(B1, 1, 1); PG8_STAGE(PG8_SB(1, 0), b3, voffB);
            PG8_BAR; PG8_WAIT_L(0); PG8_MMA(0, 1, At, B1); PG8_BAR;
            PG8_LDA(At, 1, 1); PG8_STAGEA(PG8_SA(1, 0), a2p, a2o, 0, k3);
            PG8_BAR; PG8_WAIT_L(0); PG8_MMA(1, 0, At, B0); PG8_BAR; PG8_SCHED;
            PG8_STAGE(PG8_SB(1, 1), b3 + hstep, voffB);
            PG8_WAIT_V(6); PG8_BAR; PG8_MMA(1, 1, At, B1); PG8_BAR;
        }
        E(acc, cur, wr, wc, fr, fq);
        if (!has_next) break;
#pragma unroll
        for (int a = 0; a < 2; ++a)
#pragma unroll
            for (int b = 0; b < 2; ++b)
#pragma unroll
                for (int m = 0; m < 4; ++m)
#pragma unroll
                    for (int n = 0; n < 2; ++n) acc[a][b][m][n] = (f32x4){0.f, 0.f, 0.f, 0.f};
        cur = nxt; cA = nA; cB = nB; ++ui;
#pragma unroll
        for (int h = 0; h < 2; ++h)
#pragma unroll
            for (int i = 0; i < 2; ++i) aoc[h][i] = aon[h][i];
    }
    PG8_WAIT_V(0);
    if (wr == 0) PG8_BAR;
    PG8_BAR;
#undef PG8_SA
#undef PG8_SB
#undef PG8_STAGE
#undef PG8_STAGEA
#undef PG8_LDA
#undef PG8_LDB
#undef PG8_MMA
#undef PG8_WAIT_V
#undef PG8_WAIT_L
#undef PG8_BAR
#undef PG8_SCHED
#undef PG8_AOFFS
}

typedef f32x4 Acc[2][2][4][2];

struct EpiProj {
    static constexpr bool PERM = true;
    bf16_t* O;
    __device__ __forceinline__ void operator()(const Acc& acc, const Unit& u, int wr, int wc, int fr, int fq) const {
        const int row0 = u.pm * BM + wr * 64 + fr, col0 = u.pn * BM + wc * 32 + 8 * fq; const bool sg = u.pn >= 29;
#pragma unroll
        for (int ai = 0; ai < 2; ++ai)
#pragma unroll
            for (int m = 0; m < 4; ++m) { bf16_t* rowp = O + (size_t)(row0 + ai * HALF + m * 16) * PLD + col0;
#pragma unroll
                for (int bj = 0; bj < 2; ++bj) { f32x4 v0 = acc[ai][bj][m][0], v1 = acc[ai][bj][m][1];
                    if (sg) {
#pragma unroll
                        for (int j = 0; j < 4; ++j) { v0[j] = sigmoidf_(v0[j]); v1[j] = sigmoidf_(v1[j]); } }
                    u32x4 w; w.x = pk2(v0[0], v0[1]); w.y = pk2(v0[2], v0[3]); w.z = pk2(v1[0], v1[1]); w.w = pk2(v1[2], v1[3]);
                    *(u32x4*)(rowp + bj * HALF) = w; } }
    }
};
template <int SEG> struct EpiBranch {
    static constexpr bool PERM = true;
    const bf16_t* P; float* MF; bf16_t* MG;
    __device__ __forceinline__ void operator()(const Acc& acc, const Unit& u, int wr, int wc, int fr, int fq) const {
        const int row0 = u.pm * BM + wr * 64 + fr, col0 = u.pn * BM + wc * 32 + 8 * fq;
#pragma unroll
        for (int ai = 0; ai < 2; ++ai)
#pragma unroll
            for (int m = 0; m < 4; ++m) { const size_t r = (size_t)(row0 + ai * HALF + m * 16);
                asm volatile("" ::: "memory");
#pragma unroll
                for (int bj = 0; bj < 2; ++bj) { const int c = col0 + bj * HALF;
                    const u32x4 g = *(const u32x4*)(P + r * PLD + C_G + SEG * 1024 + c);
                    f32x4 v0 = acc[ai][bj][m][0], v1 = acc[ai][bj][m][1];
                    v0[0] *= bflo(g.x); v0[1] *= bfhi(g.x); v0[2] *= bflo(g.y); v0[3] *= bfhi(g.y);
                    v1[0] *= bflo(g.z); v1[1] *= bfhi(g.z); v1[2] *= bflo(g.w); v1[3] *= bfhi(g.w);
                    float* mp = MF + r * DM + c;
                    if (SEG > 0) { v0 += *(const f32x4*)mp; v1 += *(const f32x4*)(mp + 4); }
                    if (SEG < 2) { *(f32x4*)mp = v0; *(f32x4*)(mp + 4) = v1; }
                    else { u32x4 w; w.x = pk2(v0[0], v0[1]); w.y = pk2(v0[2], v0[3]); w.z = pk2(v1[0], v1[1]); w.w = pk2(v1[2], v1[3]); *(u32x4*)(MG + r * DM + c) = w; } } }
    }
};
struct EpiOut {
    static constexpr bool PERM = false;
    const float* xsrc; float* X; const float* gt;
    __device__ __forceinline__ void operator()(const Acc& acc, const Unit& u, int wr, int wc, int fr, int fq) const {
        const int row0 = u.pm * BM + wr * 64 + fr, col0 = u.pn * BM + wc * 32 + 4 * fq;
        const float* gp = gt + (size_t)((u.pm * BM) >> 11) * 6144 + col0;
        f32x4 gv[2][2];
#pragma unroll
        for (int bj = 0; bj < 2; ++bj)
#pragma unroll
            for (int n = 0; n < 2; ++n) gv[bj][n] = *(const f32x4*)(gp + bj * HALF + n * 16);
#pragma unroll
        for (int ai = 0; ai < 2; ++ai)
#pragma unroll
            for (int m = 0; m < 4; ++m) { const size_t o = (size_t)(row0 + ai * HALF + m * 16) * DM + col0;
#pragma unroll
                for (int bj = 0; bj < 2; ++bj)
#pragma unroll
                    for (int n = 0; n < 2; ++n) { const f32x4 xv = *(const f32x4*)(xsrc + o + bj * HALF + n * 16);
                        *(f32x4*)(X + o + bj * HALF + n * 16) = xv + gv[bj][n] * acc[ai][bj][m][n]; } }
    }
};
struct EpiMoe1 {
    static constexpr bool PERM = true;
    bf16_t* ACT; const float* b1;
    __device__ __forceinline__ void operator()(const Acc& acc, const Unit& u, int wr, int wc, int fr, int fq) const {
        const int row0 = u.pm * BM + wr * 64 + fr, col0 = u.pn * BM + wc * 32 + 8 * fq;
        const float* bp = b1 + (size_t)u.e * (2 * FF) + col0;
        f32x4 bv[2][2];
#pragma unroll
        for (int bj = 0; bj < 2; ++bj)
#pragma unroll
            for (int n = 0; n < 2; ++n) bv[bj][n] = *(const f32x4*)(bp + bj * HALF + 4 * n);
#pragma unroll
        for (int ai = 0; ai < 2; ++ai)
#pragma unroll
            for (int m = 0; m < 4; ++m) { bf16_t* rowp = ACT + (size_t)(row0 + ai * HALF + m * 16) * FF + (col0 >> 1);
#pragma unroll
                for (int bj = 0; bj < 2; ++bj) { const f32x4 v0 = acc[ai][bj][m][0] + bv[bj][0], v1 = acc[ai][bj][m][1] + bv[bj][1];
                    float a[4];
#pragma unroll
                    for (int q = 0; q < 4; ++q) { const float gl = (q < 2) ? v0[2 * q] : v1[2 * q - 4], ln = (q < 2) ? v0[2 * q + 1] : v1[2 * q - 3];
                        const float xg = fminf(gl, 7.0f), xl = fminf(fmaxf(ln, -7.0f), 7.0f);
                        a[q] = xg * sigmoidf_(1.702f * xg) * (xl + 1.0f); }
                    u32x2 w; w.x = pk2(a[0], a[1]); w.y = pk2(a[2], a[3]);
                    *(u32x2*)(rowp + bj * (HALF / 2)) = w; } }
    }
};
struct EpiMoe2 {
    static constexpr bool PERM = true;
    bf16_t* Y; const float* b2;
    __device__ __forceinline__ void operator()(const Acc& acc, const Unit& u, int wr, int wc, int fr, int fq) const {
        const int row0 = u.pm * BM + wr * 64 + fr, col0 = u.pn * BM + wc * 32 + 8 * fq;
        const float* bp = b2 + (size_t)u.e * DM + col0;
        f32x4 bv[2][2];
#pragma unroll
        for (int bj = 0; bj < 2; ++bj)
#pragma unroll
            for (int n = 0; n < 2; ++n) bv[bj][n] = *(const f32x4*)(bp + bj * HALF + 4 * n);
#pragma unroll
        for (int ai = 0; ai < 2; ++ai)
#pragma unroll
            for (int m = 0; m < 4; ++m) { bf16_t* rowp = Y + (size_t)(row0 + ai * HALF + m * 16) * DM + col0;
#pragma unroll
                for (int bj = 0; bj < 2; ++bj) { const f32x4 v0 = acc[ai][bj][m][0] + bv[bj][0], v1 = acc[ai][bj][m][1] + bv[bj][1];
                    u32x4 w; w.x = pk2(v0[0], v0[1]); w.y = pk2(v0[2], v0[3]); w.z = pk2(v1[0], v1[1]); w.w = pk2(v1[2], v1[3]);
                    *(u32x4*)(rowp + bj * HALF) = w; } }
    }
};
}

struct Args { const float* in[32]; float* out; unsigned char* ws; int ph_lo, ph_hi; };
enum { I_X = 0, I_C, I_WMOD, I_BMOD, I_N1G, I_N2G, I_WIN, I_MU, I_W0, I_WUP, I_A0, I_AUP, I_GUP, I_KK, I_KA, I_RK, I_LNG, I_LNB, I_DLAM, I_SUBG, I_RELB, I_WBA, I_WBB, I_WBC, I_WOUT, I_RW, I_RB, I_W1, I_B1, I_W2, I_B2, I_FNG };

__device__ __forceinline__ void lds_fence() { asm volatile("s_waitcnt lgkmcnt(0)" ::: "memory"); }

__device__ __forceinline__ void tr_item(const float* W, int ldw, int ncols, bf16_t* WT, int K, LAS float* scr, int item, int lane) {
    const int nblk = ncols >> 5, kb = item / nblk, nb = item - kb * nblk, k0 = 64 * kb, n0 = 32 * nb;
#pragma unroll 8
    for (int i = 0; i < 32; ++i) { const int kk = 2 * i + (lane >> 5); scr[kk * 33 + (lane & 31)] = W[(size_t)(k0 + kk) * ldw + n0 + (lane & 31)]; }
    lds_fence();
    const int c = lane & 7;
#pragma unroll
    for (int j = 0; j < 4; ++j) { const int n = (lane >> 3) + 8 * j; const LAS float* s = scr + (8 * c) * 33 + n;
        u32x4 o; o.x = pk2(s[0 * 33], s[1 * 33]); o.y = pk2(s[2 * 33], s[3 * 33]); o.z = pk2(s[4 * 33], s[5 * 33]); o.w = pk2(s[6 * 33], s[7 * 33]);
        *(u32x4*)(WT + (size_t)(n0 + n) * K + k0 + 8 * c) = o; }
    lds_fence();
}
__device__ __forceinline__ int t5_bucket(int rel) {
    const int ret = rel > 0 ? 16 : 0; const int n = rel < 0 ? -rel : rel;
    int v;
    if (n < 8) v = n; else if (n < 12) v = 8; else if (n < 16) v = 9; else if (n < 23) v = 10; else if (n < 32) v = 11;
    else if (n < 46) v = 12; else if (n < 64) v = 13; else if (n < 91) v = 14; else v = 15;
    return ret + v;
}
__device__ __forceinline__ void phase_p0(const Args& a, LAS unsigned char* lds) {
    const int tid = otid(), lane = tid & 63, wave = tid >> 6, G = gridDim.x;
    unsigned char* ws = a.ws;
    {
        LAS float* scr = (LAS float*)(lds + wave * 8448);
        const int gw = blockIdx.x * 8 + wave, NGW = G * 8;
        constexpr int NITEMS = 65536 + 32768 + 2 * 6592;
        for (int it = gw; it < NITEMS; it += NGW) {
            int r = it;
            if (r < 65536) { const int mat = r >> 10; tr_item(a.in[I_W1] + (size_t)mat * DM * 2 * FF, 2 * FF, 2 * FF, (bf16_t*)(ws + WS_W1) + (size_t)mat * 2 * FF * DM, DM, scr, r & 1023, lane); continue; }
            r -= 65536;
            if (r < 32768) { const int mat = r >> 9; tr_item(a.in[I_W2] + (size_t)mat * FF * DM, DM, DM, (bf16_t*)(ws + WS_W2) + (size_t)mat * DM * FF, FF, scr, r & 511, lane); continue; }
            r -= 32768;
            const int l = r / 6592; r -= l * 6592;
            if (r < 2496) { tr_item(a.in[I_WIN] + (size_t)l * DM * IN_COLS, IN_COLS, 4992, (bf16_t*)(ws + WS_WIN) + (size_t)l * PLD * DM, DM, scr, r, lane); continue; }
            r -= 2496;
            if (r < 2688) { tr_item(a.in[I_WIN] + (size_t)l * DM * IN_COLS + 4992, IN_COLS, 5376, (bf16_t*)(ws + WS_WIN) + (size_t)l * PLD * DM + (size_t)5120 * DM, DM, scr, r, lane); continue; }
            r -= 2688;
            if (r < 128) { tr_item(a.in[I_WBA] + (size_t)l * 256 * DM, DM, DM, (bf16_t*)(ws + WS_WA) + (size_t)l * DM * 256, 256, scr, r, lane); continue; }
            r -= 128;
            if (r < 384) { tr_item(a.in[I_WBB] + (size_t)l * 768 * DM, DM, DM, (bf16_t*)(ws + WS_WB) + (size_t)l * DM * 768, 768, scr, r, lane); continue; }
            r -= 384;
            if (r < 384) { tr_item(a.in[I_WBC] + (size_t)l * 768 * DM, DM, DM, (bf16_t*)(ws + WS_WC) + (size_t)l * DM * 768, 768, scr, r, lane); continue; }
            r -= 384;
            tr_item(a.in[I_WOUT] + (size_t)l * DM * DM, DM, DM, (bf16_t*)(ws + WS_WO) + (size_t)l * DM * DM, DM, scr, r, lane);
        }
        for (int i = blockIdx.x * 512 + tid; i < 2 * 128 * DM / 8; i += G * 512) {
            const int l = i / (128 * DM / 8), o = i - l * (128 * DM / 8);
            *(u32x4*)((bf16_t*)(ws + WS_WIN) + (size_t)l * PLD * DM + (size_t)4992 * DM + (size_t)o * 8) = (u32x4){0u, 0u, 0u, 0u};
        }
    }
    __syncthreads();
    if ((int)blockIdx.x < 192) {
        LAS float* sc = (LAS float*)(lds + 69632);
        LAS float* red = (LAS float*)(lds + 102400);
        for (int i = tid; i < NB * DM; i += 512) { const float v = a.in[I_C][i]; sc[i] = v / (1.f + expf(-v)); }
        __syncthreads();
        float* mod = (float*)(ws + WS_MISC + MISC_MOD);
        for (int j = blockIdx.x; j < 192; j += G) {
            const int l = j / 96, n0 = (j - l * 96) * 64, jj = tid & 63, ks = tid >> 6;
            float acc[8];
#pragma unroll
            for (int b = 0; b < 8; ++b) acc[b] = 0.f;
            const float* wp = a.in[I_WMOD] + ((size_t)l * DM + ks * 128) * 6144 + n0 + jj;
            for (int k = 0; k < 128; ++k) { const float w = wp[(size_t)k * 6144];
#pragma unroll
                for (int b = 0; b < 8; ++b) acc[b] += sc[b * DM + ks * 128 + k] * w; }
#pragma unroll
            for (int b = 0; b < 8; ++b) red[(ks * 8 + b) * 64 + jj] = acc[b];
            __syncthreads();
            { const int b = tid >> 6; float s = 0.f;
#pragma unroll
              for (int k2 = 0; k2 < 8; ++k2) s += red[(k2 * 8 + b) * 64 + jj];
              mod[((size_t)l * 8 + b) * 6144 + n0 + jj] = s + a.in[I_BMOD][(size_t)l * 6144 + n0 + jj]; }
            __syncthreads();
        }
    }
    if ((int)blockIdx.x == G - 1) {
        float* lam = (float*)(ws + WS_MISC + MISC_LAM);
        if (tid < 2) { const int l = tid; const float* dl = a.in[I_DLAM] + (size_t)l * 256; float s01 = 0.f, s23 = 0.f;
            for (int d = 0; d < 64; ++d) { s01 += dl[d] * dl[64 + d]; s23 += dl[128 + d] * dl[192 + d]; }
            const float li = 0.8f - 0.6f * expf(-0.3f * (float)l);
            lam[l] = expf(s01) - expf(s23) + li; lam[2 + l] = li; }
        float* bA = (float*)(ws + WS_MISC + MISC_BIASA);
        for (int i = tid; i < 12 * 129; i += 512) { const int head = i / 129, jj = i - head * 129, g = head >> 2; const int dil = (g == 0) ? 1 : (g == 1) ? 4 : 16;
            bA[i] = a.in[I_RELB][t5_bucket((jj - 64) * dil) * 18 + head] * LOG2E; }
        float* bC = (float*)(ws + WS_MISC + MISC_BIASC);
        for (int i = tid; i < 6 * 257; i += 512) { const int h = i / 257, rel = i - h * 257 - 128;
            bC[i] = a.in[I_RELB][t5_bucket(rel) * 18 + 12 + h] * LOG2E; }
    }
}

__device__ __forceinline__ float row_rstd(const f32x4 (&v)[4], float eps) {
    float s = 0.f;
#pragma unroll
    for (int j = 0; j < 4; ++j) s += (v[j].x * v[j].x + v[j].y * v[j].y) + (v[j].z * v[j].z + v[j].w * v[j].w);
    return rsqrtf(wave_sum(s) * (1.f / DM) + eps);
}
__device__ __forceinline__ void norm_mod_store(const f32x4 (&v)[4], float rstd, const float* g, const float* sc, const float* sh, bf16_t* orow, int lane) {
#pragma unroll
    for (int j = 0; j < 4; ++j) { const int c = 4 * lane + 256 * j;
        const f32x4 gv = *(const f32x4*)(g + c), scv = *(const f32x4*)(sc + c), shv = *(const f32x4*)(sh + c);
        const f32x4 y = v[j] * rstd * gv * (scv + 1.0f) + shv;
        u32x2 w; w.x = pk2(y.x, y.y); w.y = pk2(y.z, y.w);
        *(u32x2*)(orow + c) = w; }
}
__device__ __forceinline__ void phase_norm1(const Args& a, int l) {
    const int tid = otid(), lane = tid & 63, wave = tid >> 6;
    const float* mod = (const float*)(a.ws + WS_MISC + MISC_MOD) + (size_t)l * 8 * 6144;
    bf16_t* H = (bf16_t*)(a.ws + WS_H);
    for (int t = blockIdx.x * 8 + wave; t < NTOK; t += gridDim.x * 8) {
        const float* xr = a.in[I_X] + (size_t)t * DM; f32x4 v[4];
#pragma unroll
        for (int j = 0; j < 4; ++j) v[j] = *(const f32x4*)(xr + 4 * lane + 256 * j);
        const float rstd = row_rstd(v, 1e-6f);
        const float* mb = mod + (size_t)(t >> 11) * 6144;
        norm_mod_store(v, rstd, a.in[I_N1G] + (size_t)l * DM, mb + 1024, mb, H + (size_t)t * DM, lane);
    }
}

__device__ __forceinline__ float shiftv(const bf16_t* P, int t, int col, const float* mu) {
    const int ts = t & (NT - 1); const bf16_t* p0 = P + (size_t)t * PLD + C_BS + col;
    const float p = bf2f(p0[0]);
    const float pm = ts > 0 ? bf2f(p0[-PLD]) : 0.f;
    const float pn = ts < NT - 1 ? bf2f(p0[PLD]) : 0.f;
    return p + mu[col] * (pm - p) + mu[RSTR + col] * (pn - p);
}
__device__ __forceinline__ void phase_rwkv_pre(const Args& a, int l, LAS unsigned char* lds) {
    const int tid = otid(), lane = tid & 63, wave = tid >> 6;
    unsigned char* ws = a.ws;
    const bf16_t* P = (const bf16_t*)(ws + WS_PROJ);
    const float* mu = a.in[I_MU] + (size_t)l * 2 * RSTR;
    LAS float* LW = (LAS float*)lds;
    float* GS = (float*)(ws + WS_GS);
    float* RR = (float*)(ws + WS_RR); float* RV = (float*)(ws + WS_RV);
    float* RWD = (float*)(ws + WS_RWD); float* RKK = (float*)(ws + WS_RKK); float* RKKA = (float*)(ws + WS_RKKA); float* RKD = (float*)(ws + WS_RKD);
    const float* w0 = a.in[I_W0] + (size_t)l * 2 * RW; const float* a0 = a.in[I_A0] + (size_t)l * 2 * RW;
    const float* wup = a.in[I_WUP] + (size_t)l * 2 * 64 * RW; const float* aup = a.in[I_AUP] + (size_t)l * 2 * 64 * RW;
    const float* kkp = a.in[I_KK] + (size_t)l * 2 * RW; const float* kap = a.in[I_KA] + (size_t)l * 2 * RW;
    for (int tile = blockIdx.x; tile < NTOK / 32; tile += gridDim.x) {
        const int t0 = tile * 32;
        for (int idx = tid; idx < 32 * 384; idx += 512) {
            const int i = idx / 384, cc = idx - i * 384;
            const float val = shiftv(P, t0 + i, 2304 + cc, mu);
            if (cc < 128) { const int di = cc >> 6, j = cc & 63; LW[(j * 32 + i) * 4 + di] = tanhf(val); }
            else if (cc < 256) { const int c2 = cc - 128, di = c2 >> 6, j = c2 & 63; LW[(j * 32 + i) * 4 + 2 + di] = val; }
            else GS[(size_t)(t0 + i) * 128 + cc - 256] = sigmoidf_(val);
        }
        __syncthreads();
        for (int q = wave; q < 48; q += 8) {
            const int hd = q % 12, tg = q / 12, c = hd * 64 + lane, tb = t0 + tg * 8;
            float kv[8];
#pragma unroll
            for (int tk = 0; tk < 8; ++tk) { const int t = tb + tk;
                kv[tk] = shiftv(P, t, 768 + c, mu);
                RR[(size_t)t * RW + c] = shiftv(P, t, c, mu);
                RV[(size_t)t * RW + c] = shiftv(P, t, 1536 + c, mu); }
            float aw0[8], aw1[8], aa0[8], aa1[8];
#pragma unroll
            for (int tk = 0; tk < 8; ++tk) { aw0[tk] = 0.f; aw1[tk] = 0.f; aa0[tk] = 0.f; aa1[tk] = 0.f; }
            for (int j = 0; j < 64; ++j) {
                const float wu0 = wup[(size_t)j * RW + c], wu1 = wup[(size_t)(64 + j) * RW + c], au0 = aup[(size_t)j * RW + c], au1 = aup[(size_t)(64 + j) * RW + c];
#pragma unroll
                for (int tk = 0; tk < 8; ++tk) { const f32x4 q4 = *(const LAS f32x4*)(LW + (j * 32 + tg * 8 + tk) * 4);
                    aw0[tk] += q4.x * wu0; aw1[tk] += q4.y * wu1; aa0[tk] += q4.z * au0; aa1[tk] += q4.w * au1; }
            }
#pragma unroll
            for (int di = 0; di < 2; ++di) {
                const float w0c = w0[di * RW + c], a0c = a0[di * RW + c], kkc = kkp[di * RW + c], kac = kap[di * RW + c];
#pragma unroll
                for (int tk = 0; tk < 8; ++tk) { const int t = tb + tk;
                    const float z = w0c + (di ? aw1[tk] : aw0[tk]);
                    const float u = -z; const float sp = fmaxf(u, 0.f) + log1pf(expf(-fabsf(u)));
                    const float wlog = -sp - 0.5f;
                    const float decay = expf(-expf(wlog));
                    const float av = sigmoidf_(a0c + (di ? aa1[tk] : aa0[tk]));
                    const float kr = kv[tk] * kkc;
                    const float nrm = wave_sum(kr * kr);
                    const float kk = kr * rsqrtf(fmaxf(nrm, 1e-24f));
                    const float kd = kv[tk] * (1.f + (av - 1.f) * kac);
                    const size_t o = ((size_t)di * NTOK + t) * RW + c;
                    RWD[o] = decay; RKK[o] = kk; RKKA[o] = kk * av; RKD[o] = kd; }
            }
        }
        __syncthreads();
    }
}

__device__ __forceinline__ void swa_wave_unit(const bf16_t* P, float* OAG, float* LSE, const LAS float* biasA, LAS unsigned char* vbuf, int u, int lane) {
    const int b = u / 768; const int rem = u - b * 768; const int head = rem >> 6, s = rem & 63;
    const int g = head >> 2, hh = head & 3;
    const int dsh = (g == 0) ? 0 : (g == 1) ? 2 : 4;
    const int L = NT >> dsh, nmbsh = 6 - dsh;
    const int r = s >> nmbsh, mb = s & ((1 << nmbsh) - 1);
    const int r32 = lane & 31, hi = lane >> 5;
    const size_t tq = (size_t)b * NT + ((mb * 32 + r32) << dsh) + r;
    bf16x8 qf[4];
    { const bf16_t* qp = P + tq * PLD + C_AQ + head * 64 + 8 * hi;
#pragma unroll
      for (int s4 = 0; s4 < 4; ++s4) qf[s4] = *(const bf16x8*)(qp + 16 * s4); }
    f32x16 o[2]; o[0] = (f32x16){}; o[1] = (f32x16){};
    float m = -1e30f, lsum = 0.f;
    const float SC = 0.125f * LOG2E;
    const LAS float* bh = biasA + head * 129 + 64;
    const int trbase = (4 * hi + ((lane & 15) >> 2)) * 144 + (16 * ((lane >> 4) & 1) + 4 * (lane & 3)) * 2;
    for (int kt = -2; kt <= 2; ++kt) {
        const int m0 = mb * 32 + kt * 32;
        if (m0 + 31 < 0 || m0 >= L) continue;
        bf16x8 kf[4];
        { int km = m0 + r32; km = km < 0 ? 0 : (km > L - 1 ? L - 1 : km);
          const bf16_t* kp = P + ((size_t)b * NT + (km << dsh) + r) * PLD + C_AK + head * 64 + 8 * hi;
#pragma unroll
          for (int s4 = 0; s4 < 4; ++s4) kf[s4] = *(const bf16x8*)(kp + 16 * s4); }
        asm volatile("" ::: "memory");
#pragma unroll
        for (int c4 = 0; c4 < 4; ++c4) { const int id = lane + 64 * c4, row = id >> 3, ch = id & 7;
            int vm = m0 + row; vm = vm < 0 ? 0 : (vm > L - 1 ? L - 1 : vm);
            const u32x4 val = *(const u32x4*)(P + ((size_t)b * NT + (vm << dsh) + r) * PLD + C_AV + head * 64 + ch * 8);
            *(LAS u32x4*)(vbuf + row * 144 + ch * 16) = val; }
        f32x16 sacc = (f32x16){};
#pragma unroll
        for (int s4 = 0; s4 < 4; ++s4) sacc = __builtin_amdgcn_mfma_f32_32x32x16_bf16(kf[s4], qf[s4], sacc, 0, 0, 0);
        float x[16]; float mx = -1e30f;
#pragma unroll
        for (int rg = 0; rg < 16; ++rg) { const int kvl = crow(rg, hi), km = m0 + kvl, j = kt * 32 + kvl - r32;
            const bool valid = (km >= 0) && (km < L) && (j >= -64) && (j <= 64);
            const int jc = j < -64 ? -64 : (j > 64 ? 64 : j);
            const float xv = sacc[rg] * SC + bh[jc];
            x[rg] = valid ? xv : -1e30f; mx = fmaxf(mx, x[rg]); }
        mx = fmaxf(mx, __shfl_xor(mx, 32));
        const float mn = fmaxf(m, mx), alpha = __builtin_amdgcn_exp2f(m - mn); m = mn;
        float ps = 0.f;
#pragma unroll
        for (int rg = 0; rg < 16; ++rg) { x[rg] = __builtin_amdgcn_exp2f(x[rg] - mn); ps += x[rg]; }
        lsum = lsum * alpha + ps;
#pragma unroll
        for (int rg = 0; rg < 16; ++rg) { o[0][rg] *= alpha; o[1][rg] *= alpha; }
        u32x4 pw[2];
#pragma unroll
        for (int s2 = 0; s2 < 2; ++s2) { pw[s2].x = pk2(x[8 * s2 + 0], x[8 * s2 + 1]); pw[s2].y = pk2(x[8 * s2 + 2], x[8 * s2 + 3]); pw[s2].z = pk2(x[8 * s2 + 4], x[8 * s2 + 5]); pw[s2].w = pk2(x[8 * s2 + 6], x[8 * s2 + 7]); }
        lds_fence();
#pragma unroll
        for (int db = 0; db < 2; ++db)
#pragma unroll
            for (int s2 = 0; s2 < 2; ++s2) {
                const s16x4 lo = vtr(vbuf + trbase + (16 * s2) * 144 + db * 64);
                const s16x4 hi4 = vtr(vbuf + trbase + (16 * s2 + 8) * 144 + db * 64);
                const bf16x8 af = (bf16x8){lo[0], lo[1], lo[2], lo[3], hi4[0], hi4[1], hi4[2], hi4[3]};
                o[db] = __builtin_amdgcn_mfma_f32_32x32x16_bf16(af, __builtin_bit_cast(bf16x8, pw[s2]), o[db], 0, 0, 0);
            }
        asm volatile("" ::: "memory");
    }
    const float lt = lsum + __shfl_xor(lsum, 32);
    const float inv = 1.f / lt;
    float* op = OAG + ((size_t)g * NTOK + tq) * 256 + hh * 64;
#pragma unroll
    for (int db = 0; db < 2; ++db)
#pragma unroll
        for (int i = 0; i < 4; ++i) { f32x4 v = (f32x4){o[db][4 * i], o[db][4 * i + 1], o[db][4 * i + 2], o[db][4 * i + 3]} * inv;
            *(f32x4*)(op + db * 32 + 8 * i + 4 * hi) = v; }
    if (hi == 0) LSE[((size_t)g * NTOK + tq) * 4 + hh] = m + __log2f(lt);
}
__device__ __forceinline__ void phase_swa(const Args& a, LAS unsigned char* lds) {
    const int tid = otid(), lane = tid & 63, wave = tid >> 6;
    LAS float* bA = (LAS float*)(lds + 40960);
    const float* bAg = (const float*)(a.ws + WS_MISC + MISC_BIASA);
    for (int i = tid; i < 12 * 129; i += 512) bA[i] = bAg[i];
    __syncthreads();
    for (int item = blockIdx.x; item < 768; item += gridDim.x)
        swa_wave_unit((const bf16_t*)(a.ws + WS_PROJ), (float*)(a.ws + WS_OAG), (float*)(a.ws + WS_LSE), bA, lds + wave * 4608, item * 8 + wave, lane);
    __syncthreads();
}

__device__ __forceinline__ void rwkv_scan_unit(const Args& a, int unit, LAS unsigned char* lds) {
    const int dir = unit & 1, bh = unit >> 1, h = bh % 12, b = bh / 12;
    const int tid = otid(), row = tid >> 3, kp = tid & 7;
    unsigned char* ws = a.ws;
    const size_t base_d = ((size_t)dir * NTOK + (size_t)b * NT) * RW + h * 64;
    const size_t base_s = ((size_t)b * NT) * RW + h * 64;
    const float* src[6] = { (const float*)(ws + WS_RWD) + base_d, (const float*)(ws + WS_RKK) + base_d, (const float*)(ws + WS_RKKA) + base_d, (const float*)(ws + WS_RKD) + base_d,
                            (const float*)(ws + WS_RR) + base_s, (const float*)(ws + WS_RV) + base_s };
    float* Y = (float*)(ws + WS_Y) + base_d;
    LAS float* ybuf = (LAS float*)(lds + 98304);
    const int li = tid >> 4, lc4 = tid & 15;
    float S[8];
#pragma unroll
    for (int i = 0; i < 8; ++i) S[i] = 0.f;
    f32x4 regs[6];
    { const int ts = dir ? NT - 32 : 0;
#pragma unroll
      for (int q = 0; q < 6; ++q) regs[q] = *(const f32x4*)(src[q] + (size_t)(ts + li) * RW + lc4 * 4);
#pragma unroll
      for (int q = 0; q < 6; ++q) *(LAS f32x4*)(lds + ((q * 32 + li) * 64 + lc4 * 4) * 4) = regs[q]; }
    __syncthreads();
    for (int c = 0; c < 64; ++c) {
        const int ts = dir ? NT - 32 * (c + 1) : 32 * c;
        if (c + 1 < 64) { const int tn = dir ? NT - 32 * (c + 2) : 32 * (c + 1);
#pragma unroll
            for (int q = 0; q < 6; ++q) regs[q] = *(const f32x4*)(src[q] + (size_t)(tn + li) * RW + lc4 * 4); }
        const LAS unsigned char* buf = lds + (c & 1) * 49152;
#pragma unroll 4
        for (int ii = 0; ii < 32; ++ii) {
            const int i = dir ? 31 - ii : ii;
            const LAS float* pw = (const LAS float*)(buf + ((0 * 32 + i) * 64 + 8 * kp) * 4);
            const f32x4 w0 = *(const LAS f32x4*)pw, w1 = *(const LAS f32x4*)(pw + 4);
            const f32x4 k0 = *(const LAS f32x4*)(pw + 2048), k1 = *(const LAS f32x4*)(pw + 2048 + 4);
            const f32x4 a0 = *(const LAS f32x4*)(pw + 4096), a1 = *(const LAS f32x4*)(pw + 4096 + 4);
            const f32x4 d0 = *(const LAS f32x4*)(pw + 6144), d1 = *(const LAS f32x4*)(pw + 6144 + 4);
            const f32x4 r0 = *(const LAS f32x4*)(pw + 8192), r1 = *(const LAS f32x4*)(pw + 8192 + 4);
            const float vv = *(const LAS float*)(buf + ((5 * 32 + i) * 64 + row) * 4);
            float sa = S[0] * k0.x + S[1] * k0.y + S[2] * k0.z + S[3] * k0.w + S[4] * k1.x + S[5] * k1.y + S[6] * k1.z + S[7] * k1.w;
            sa = -dpp_sum8(sa);
            S[0] = S[0] * w0.x + sa * a0.x + vv * d0.x; S[1] = S[1] * w0.y + sa * a0.y + vv * d0.y; S[2] = S[2] * w0.z + sa * a0.z + vv * d0.z; S[3] = S[3] * w0.w + sa * a0.w + vv * d0.w;
            S[4] = S[4] * w1.x + sa * a1.x + vv * d1.x; S[5] = S[5] * w1.y + sa * a1.y + vv * d1.y; S[6] = S[6] * w1.z + sa * a1.z + vv * d1.z; S[7] = S[7] * w1.w + sa * a1.w + vv * d1.w;
            float y = S[0] * r0.x + S[1] * r0.y + S[2] * r0.z + S[3] * r0.w + S[4] * r1.x + S[5] * r1.y + S[6] * r1.z + S[7] * r1.w;
            y = dpp_sum8(y);
            if (kp == 0) ybuf[i * 64 + row] = y;
        }
        __syncthreads();
        *(f32x4*)(Y + (size_t)(ts + li) * RW + lc4 * 4) = *(const LAS f32x4*)(ybuf + li * 64 + lc4 * 4);
        if (c + 1 < 64) { LAS unsigned char* nb = lds + ((c + 1) & 1) * 49152;
#pragma unroll
            for (int q = 0; q < 6; ++q) *(LAS f32x4*)(nb + ((q * 32 + li) * 64 + lc4 * 4) * 4) = regs[q]; }
        __syncthreads();
    }
}

__device__ __forceinline__ void diffattn_unit(const Args& a, int l, int unit, LAS unsigned char* lds) {
    constexpr int RS = 272;
    const int b = unit / 96; const int rem = unit - b * 96; const int h = rem >> 4, qb = rem & 15;
    const int tid = otid(), lane = tid & 63, wave = __builtin_amdgcn_readfirstlane(tid >> 6), r32 = lane & 31, hi = lane >> 5;
    const int c = wave & 1, qblk = wave >> 1;
    const int q0 = qb * 128 + qblk * 32;
    const bf16_t* P = (const bf16_t*)(a.ws + WS_PROJ);
    const size_t rowb = (size_t)b * NT;
    bf16x8 qf[4];
    { const bf16_t* qp = P + (rowb + q0 + r32) * PLD + C_CQ + h * 128 + c * 64 + 8 * hi;
#pragma unroll
      for (int s4 = 0; s4 < 4; ++s4) qf[s4] = *(const bf16x8*)(qp + 16 * s4); }
    LAS float* biasL = (LAS float*)(lds + 69632);
    { const float* bC = (const float*)(a.ws + WS_MISC + MISC_BIASC) + h * 257;
      for (int i = tid; i < 257; i += 512) biasL[i] = bC[i]; }
    const int srow0 = tid >> 4, sch = tid & 15;
    const bf16_t* kg = P + (rowb + srow0) * PLD + C_CK + h * 128 + sch * 8;
    const bf16_t* vg = P + (rowb + srow0) * PLD + C_CV + h * 128 + sch * 8;
    u32x4 kr[2], vr[2];
#pragma unroll
    for (int i = 0; i < 2; ++i) { kr[i] = *(const u32x4*)(kg + (size_t)(32 * i) * PLD); vr[i] = *(const u32x4*)(vg + (size_t)(32 * i) * PLD); }
#pragma unroll
    for (int i = 0; i < 2; ++i) { *(LAS u32x4*)(lds + (srow0 + 32 * i) * RS + sch * 16) = kr[i]; *(LAS u32x4*)(lds + 34816 + (srow0 + 32 * i) * RS + sch * 16) = vr[i]; }
    __syncthreads();
    f32x16 o[4];
#pragma unroll
    for (int db = 0; db < 4; ++db) o[db] = (f32x16){};
    float m = -1e30f, lsum = 0.f;
    const float SC = 0.125f * LOG2E;
    const int trb = (4 * hi + ((lane & 15) >> 2)) * RS + (16 * ((lane >> 4) & 1) + 4 * (lane & 3)) * 2;
    const int qabs = q0 + r32;
    for (int t = 0; t < 32; ++t) {
        if (t + 1 < 32) {
#pragma unroll
            for (int i = 0; i < 2; ++i) { kr[i] = *(const u32x4*)(kg + (size_t)(64 * (t + 1) + 32 * i) * PLD); vr[i] = *(const u32x4*)(vg + (size_t)(64 * (t + 1) + 32 * i) * PLD); } }
        const LAS unsigned char* Kb = lds + (t & 1) * 17408;
        const LAS unsigned char* Vb = lds + 34816 + (t & 1) * 17408;
        f32x16 sa0 = (f32x16){}, sa1 = (f32x16){};
#pragma unroll
        for (int s4 = 0; s4 < 4; ++s4) {
            const bf16x8 kf0 = *(const LAS bf16x8*)(Kb + r32 * RS + c * 128 + 32 * s4 + 16 * hi);
            const bf16x8 kf1 = *(const LAS bf16x8*)(Kb + (32 + r32) * RS + c * 128 + 32 * s4 + 16 * hi);
            sa0 = __builtin_amdgcn_mfma_f32_32x32x16_bf16(kf0, qf[s4], sa0, 0, 0, 0);
            sa1 = __builtin_amdgcn_mfma_f32_32x32x16_bf16(kf1, qf[s4], sa1, 0, 0, 0);
        }
        float x0[16], x1[16];
        const int kv0 = 64 * t;
        const bool farp = (kv0 >= q0 + 31 + 128), farn = (kv0 + 63 + 128 <= q0);
        if (farp || farn) { const float cb = farp ? biasL[256] : biasL[0];
#pragma unroll
            for (int rg = 0; rg < 16; ++rg) { x0[rg] = sa0[rg] * SC + cb; x1[rg] = sa1[rg] * SC + cb; }
        } else {
#pragma unroll
            for (int rg = 0; rg < 16; ++rg) { int rel = kv0 + crow(rg, hi) - qabs; int rc = rel < -128 ? -128 : (rel > 128 ? 128 : rel);
                x0[rg] = sa0[rg] * SC + biasL[rc + 128];
                rel += 32; rc = rel < -128 ? -128 : (rel > 128 ? 128 : rel);
                x1[rg] = sa1[rg] * SC + biasL[rc + 128]; }
        }
        float mx = fmaxf(x0[0], x1[0]);
#pragma unroll
        for (int rg = 1; rg < 16; ++rg) mx = fmaxf(mx, fmaxf(x0[rg], x1[rg]));
        mx = fmaxf(mx, __shfl_xor(mx, 32));
        const float mn = fmaxf(m, mx), alpha = __builtin_amdgcn_exp2f(m - mn); m = mn;
        float ps = 0.f;
#pragma unroll
        for (int rg = 0; rg < 16; ++rg) { x0[rg] = __builtin_amdgcn_exp2f(x0[rg] - mn); x1[rg] = __builtin_amdgcn_exp2f(x1[rg] - mn); ps += x0[rg] + x1[rg]; }
        lsum = lsum * alpha + ps;
#pragma unroll
        for (int db = 0; db < 4; ++db)
#pragma unroll
            for (int rg = 0; rg < 16; ++rg) o[db][rg] *= alpha;
        u32x4 pw[4];
#pragma unroll
        for (int s2 = 0; s2 < 2; ++s2) {
            pw[s2].x = pk2(x0[8 * s2 + 0], x0[8 * s2 + 1]); pw[s2].y = pk2(x0[8 * s2 + 2], x0[8 * s2 + 3]); pw[s2].z = pk2(x0[8 * s2 + 4], x0[8 * s2 + 5]); pw[s2].w = pk2(x0[8 * s2 + 6], x0[8 * s2 + 7]);
            pw[2 + s2].x = pk2(x1[8 * s2 + 0], x1[8 * s2 + 1]); pw[2 + s2].y = pk2(x1[8 * s2 + 2], x1[8 * s2 + 3]); pw[2 + s2].z = pk2(x1[8 * s2 + 4], x1[8 * s2 + 5]); pw[2 + s2].w = pk2(x1[8 * s2 + 6], x1[8 * s2 + 7]); }
#pragma unroll
        for (int db = 0; db < 4; ++db)
#pragma unroll
            for (int s = 0; s < 4; ++s) {
                const s16x4 lo = vtr(Vb + trb + (16 * s) * RS + db * 64);
                const s16x4 hi4 = vtr(Vb + trb + (16 * s + 8) * RS + db * 64);
                const bf16x8 af = (bf16x8){lo[0], lo[1], lo[2], lo[3], hi4[0], hi4[1], hi4[2], hi4[3]};
                o[db] = __builtin_amdgcn_mfma_f32_32x32x16_bf16(af, __builtin_bit_cast(bf16x8, pw[s]), o[db], 0, 0, 0);
            }
        if (t + 1 < 32) { LAS unsigned char* Kn = lds + ((t + 1) & 1) * 17408; LAS unsigned char* Vn = lds + 34816 + ((t + 1) & 1) * 17408;
#pragma unroll
            for (int i = 0; i < 2; ++i) { *(LAS u32x4*)(Kn + (srow0 + 32 * i) * RS + sch * 16) = kr[i]; *(LAS u32x4*)(Vn + (srow0 + 32 * i) * RS + sch * 16) = vr[i]; } }
        __syncthreads();
    }
    const float lt = lsum + __shfl_xor(lsum, 32);
    const float inv = 1.f / lt;
    const float* lamp = (const float*)(a.ws + WS_MISC + MISC_LAM);
    const float lam = lamp[l], linit = lamp[2 + l];
    LAS float* XO = (LAS float*)lds;
    if (c == 1) {
        const float f = inv * lam;
#pragma unroll
        for (int db = 0; db < 4; ++db)
#pragma unroll
            for (int rg = 0; rg < 16; ++rg) XO[(qblk * 64 + db * 16 + rg) * 64 + lane] = o[db][rg] * f;
    }
    __syncthreads();
    if (c == 0) {
        float ss = 0.f;
#pragma unroll
        for (int db = 0; db < 4; ++db)
#pragma unroll
            for (int rg = 0; rg < 16; ++rg) { const float v = o[db][rg] * inv - XO[(qblk * 64 + db * 16 + rg) * 64 + lane]; o[db][rg] = v; ss += v * v; }
        ss += __shfl_xor(ss, 32);
        const float sc = rsqrtf(ss * (1.f / 128.f) + 1e-5f) * (1.f - linit);
        const float* sg = a.in[I_SUBG] + (size_t)l * 128;
        bf16_t* op = (bf16_t*)(a.ws + WS_OC) + (rowb + q0 + r32) * 768 + h * 128;
#pragma unroll
        for (int db = 0; db < 4; ++db)
#pragma unroll
            for (int i = 0; i < 4; ++i) { const int d = db * 32 + 8 * i + 4 * hi; const f32x4 g4 = *(const f32x4*)(sg + d);
                u32x2 w; w.x = pk2(o[db][4 * i] * sc * g4.x, o[db][4 * i + 1] * sc * g4.y); w.y = pk2(o[db][4 * i + 2] * sc * g4.z, o[db][4 * i + 3] * sc * g4.w);
                *(u32x2*)(op + d) = w; }
    }
    __syncthreads();
}

__device__ __forceinline__ void phase_post(const Args& a, int l) {
    const int tid = otid(), lane = tid & 63, wave = tid >> 6;
    unsigned char* ws = a.ws;
    const float* OAG = (const float*)(ws + WS_OAG); const float* LSE = (const float*)(ws + WS_LSE);
    bf16_t* OA = (bf16_t*)(ws + WS_OA); bf16_t* OB = (bf16_t*)(ws + WS_OB);
    const float* GS = (const float*)(ws + WS_GS); const float* Y = (const float*)(ws + WS_Y);
    const float* RR = (const float*)(ws + WS_RR); const float* RV = (const float*)(ws + WS_RV); const float* RKD = (const float*)(ws + WS_RKD);
    const float* gup = a.in[I_GUP] + (size_t)l * 128 * RW;
    const float* rk = a.in[I_RK] + (size_t)l * RW; const float* lng = a.in[I_LNG] + (size_t)l * RW; const float* lnb = a.in[I_LNB] + (size_t)l * RW;
    for (int task = blockIdx.x * 8 + wave; task < NTOK / 4; task += gridDim.x * 8) {
        const int t0 = task * 4;
#pragma unroll
        for (int tk = 0; tk < 4; ++tk) { const size_t t = t0 + tk; const int hh = lane >> 4;
            const float l0 = LSE[((size_t)0 * NTOK + t) * 4 + hh], l1 = LSE[((size_t)1 * NTOK + t) * 4 + hh], l2 = LSE[((size_t)2 * NTOK + t) * 4 + hh];
            const float mx = fmaxf(l0, fmaxf(l1, l2));
            const float w0 = __builtin_amdgcn_exp2f(l0 - mx), w1 = __builtin_amdgcn_exp2f(l1 - mx), w2 = __builtin_amdgcn_exp2f(l2 - mx);
            const float inv = 1.f / (w0 + w1 + w2);
            const f32x4 o0 = *(const f32x4*)(OAG + ((size_t)0 * NTOK + t) * 256 + lane * 4), o1 = *(const f32x4*)(OAG + ((size_t)1 * NTOK + t) * 256 + lane * 4), o2 = *(const f32x4*)(OAG + ((size_t)2 * NTOK + t) * 256 + lane * 4);
            const f32x4 r = (o0 * w0 + o1 * w1 + o2 * w2) * inv;
            u32x2 w; w.x = pk2(r.x, r.y); w.y = pk2(r.z, r.w);
            *(u32x2*)(OA + t * 256 + lane * 4) = w; }
        float gsr[4][2];
#pragma unroll
        for (int tk = 0; tk < 4; ++tk) { gsr[tk][0] = GS[(size_t)(t0 + tk) * 128 + lane]; gsr[tk][1] = GS[(size_t)(t0 + tk) * 128 + 64 + lane]; }
        float gacc[12][4];
#pragma unroll
        for (int i = 0; i < 12; ++i)
#pragma unroll
            for (int tk = 0; tk < 4; ++tk) gacc[i][tk] = 0.f;
#pragma unroll
        for (int jh = 0; jh < 2; ++jh)
            for (int j = 0; j < 64; ++j) {
                float gv[4];
#pragma unroll
                for (int tk = 0; tk < 4; ++tk) gv[tk] = __builtin_bit_cast(float, __builtin_amdgcn_readlane(__builtin_bit_cast(int, gsr[tk][jh]), j));
                const float* gp = gup + (size_t)(jh * 64 + j) * RW + lane;
#pragma unroll
                for (int i = 0; i < 12; ++i) { const float gu = gp[i * 64];
#pragma unroll
                    for (int tk = 0; tk < 4; ++tk) gacc[i][tk] += gv[tk] * gu; }
            }
#pragma unroll
        for (int tk = 0; tk < 4; ++tk) { const size_t t = t0 + tk;
#pragma unroll
            for (int i = 0; i < 12; ++i) { const int c = i * 64 + lane;
                const float y = Y[t * RW + c] + Y[((size_t)NTOK + t) * RW + c];
                const float mean = wave_sum(y) * (1.f / 64.f);
                const float dv = y - mean;
                const float var = wave_sum(dv * dv) * (1.f / 64.f);
                const float yn = dv * rsqrtf(var + 64e-5f) * lng[c] + lnb[c];
                const float r = RR[t * RW + c], v = RV[t * RW + c], rkc = rk[c];
                const float s0 = wave_sum(r * RKD[t * RW + c] * rkc), s1 = wave_sum(r * RKD[((size_t)NTOK + t) * RW + c] * rkc);
                const float outv = (yn + (s0 + s1) * v) * gacc[i][tk];
                OB[t * RW + c] = (bf16_t)(pk2(outv, 0.f) & 0xffffu); } }
    }
}

__device__ __forceinline__ void phase_route(const Args& a, int l, LAS unsigned char* lds) {
    const int tid = otid(), lane = tid & 63, wave = tid >> 6;
    unsigned char* ws = a.ws;
    LAS float* rwT = (LAS float*)lds;
    { const float* rw = a.in[I_RW] + (size_t)l * DM * NE;
      for (int idx = tid; idx < NE * DM; idx += 512) { const int e = idx >> 10, k = idx & 1023; rwT[idx] = rw[k * NE + e]; } }
    __syncthreads();
    const float* X = (const float*)(ws + WS_X);
    const float* mod = (const float*)(ws + WS_MISC + MISC_MOD) + (size_t)l * 8 * 6144;
    bf16_t* H = (bf16_t*)(ws + WS_H);
    unsigned* cnt = (unsigned*)(ws + WS_CTL) + CW_CNT + l * 32;
    int* LIST = (int*)(ws + WS_LIST); unsigned* TOKE = (unsigned*)(ws + WS_TOKE); float* TOKP = (float*)(ws + WS_TOKP);
    const float* g2 = a.in[I_N2G] + (size_t)l * DM; const float* rb = a.in[I_RB] + (size_t)l * NE;
    for (int t = blockIdx.x * 8 + wave; t < NTOK; t += gridDim.x * 8) {
        f32x4 v[4];
#pragma unroll
        for (int j = 0; j < 4; ++j) v[j] = *(const f32x4*)(X + (size_t)t * DM + 4 * lane + 256 * j);
        const float rstd = row_rstd(v, 1e-6f);
        const float* mb = mod + (size_t)(t >> 11) * 6144;
        f32x4 hv[4];
#pragma unroll
        for (int j = 0; j < 4; ++j) { const int c = 4 * lane + 256 * j;
            const f32x4 gv = *(const f32x4*)(g2 + c), scv = *(const f32x4*)(mb + 4096 + c), shv = *(const f32x4*)(mb + 3072 + c);
            hv[j] = v[j] * rstd * gv * (scv + 1.0f) + shv;
            u32x2 w; w.x = pk2(hv[j].x, hv[j].y); w.y = pk2(hv[j].z, hv[j].w);
            *(u32x2*)(H + (size_t)t * DM + c) = w; }
        float p[32];
#pragma unroll
        for (int e = 0; e < 32; ++e) { float s = 0.f;
#pragma unroll
            for (int j = 0; j < 4; ++j) { const f32x4 w = *(const LAS f32x4*)(rwT + e * 1024 + 4 * lane + 256 * j);
                s += hv[j].x * w.x + hv[j].y * w.y + hv[j].z * w.z + hv[j].w * w.w; }
            p[e] = s; asm volatile("" ::: "memory"); }
#pragma unroll
        for (int e = 0; e < 32; ++e) p[e] += __shfl_xor(p[e], 32);
#pragma unroll
        for (int i = 0; i < 16; ++i) { const bool up = (lane & 16) != 0; const float send = up ? p[i] : p[i + 16], keep = up ? p[i + 16] : p[i]; p[i] = keep + __shfl_xor(send, 16); }
#pragma unroll
        for (int i = 0; i < 8; ++i) { const bool up = (lane & 8) != 0; const float send = up ? p[i] : p[i + 8], keep = up ? p[i + 8] : p[i]; p[i] = keep + __shfl_xor(send, 8); }
#pragma unroll
        for (int i = 0; i < 4; ++i) { const bool up = (lane & 4) != 0; const float send = up ? p[i] : p[i + 4], keep = up ? p[i + 4] : p[i]; p[i] = keep + __shfl_xor(send, 4); }
#pragma unroll
        for (int i = 0; i < 2; ++i) { const bool up = (lane & 2) != 0; const float send = up ? p[i] : p[i + 2], keep = up ? p[i + 2] : p[i]; p[i] = keep + __shfl_xor(send, 2); }
        { const bool up = (lane & 1) != 0; const float send = up ? p[0] : p[1], keep = up ? p[1] : p[0]; p[0] = keep + __shfl_xor(send, 1); }
        const int myidx = lane & 31;
        float cur = p[0] + rb[myidx];
        float tv[4]; int ti[4];
#pragma unroll
        for (int k = 0; k < 4; ++k) { float bv = cur; int bi = myidx;
#pragma unroll
            for (int off = 16; off >= 1; off >>= 1) { const float ov = __shfl_xor(bv, off); const int oi = __shfl_xor(bi, off);
                const bool take = (ov > bv) || (ov == bv && oi < bi); bv = take ? ov : bv; bi = take ? oi : bi; }
            tv[k] = bv; ti[k] = bi; if (myidx == bi) cur = -INFINITY; }
        const float e1 = expf(tv[1] - tv[0]), e2 = expf(tv[2] - tv[0]), e3 = expf(tv[3] - tv[0]);
        const float inv = 1.f / (1.f + e1 + e2 + e3);
        if (lane < 4) { const int e = lane == 0 ? ti[0] : lane == 1 ? ti[1] : lane == 2 ? ti[2] : ti[3];
            const float pr = (lane == 0 ? 1.f : lane == 1 ? e1 : lane == 2 ? e2 : e3) * inv;
            const unsigned pos = __hip_atomic_fetch_add(cnt + e, 1u, __ATOMIC_RELAXED, __HIP_MEMORY_SCOPE_AGENT);
            LIST[(size_t)e * NTOK + pos] = t; TOKE[(size_t)t * 4 + lane] = ((unsigned)e << 16) | pos; TOKP[(size_t)t * 4 + lane] = pr; }
    }
    __syncthreads();
}

__device__ __forceinline__ void build_moe_tab(const Args& a, int l, volatile LAS int* tab) {
    const unsigned* cnt = (const unsigned*)(a.ws + WS_CTL) + CW_CNT + l * 32;
    const int tid = otid();
    __syncthreads();
    if (tid < 32) tab[64 + tid] = (int)__hip_atomic_load(cnt + tid, __ATOMIC_RELAXED, __HIP_MEMORY_SCOPE_AGENT);
    __syncthreads();
    if (tid == 0) { int s = 0; for (int e = 0; e < 32; ++e) { tab[e] = s; s += (tab[64 + e] + 255) >> 8; } tab[32] = s; }
    __syncthreads();
}

__device__ __forceinline__ void phase_combine(const Args& a, int l, const LAS int* tab) {
    const int tid = otid(), lane = tid & 63, wave = tid >> 6;
    unsigned char* ws = a.ws;
    float* X = (float*)(ws + WS_X);
    const bf16_t* YM = (const bf16_t*)(ws + WS_YMOE);
    const unsigned* TOKE = (const unsigned*)(ws + WS_TOKE); const float* TOKP = (const float*)(ws + WS_TOKP);
    const float* modl = (const float*)(ws + WS_MISC + MISC_MOD) + (size_t)l * 8 * 6144;
    for (int t = blockIdx.x * 8 + wave; t < NTOK; t += gridDim.x * 8) {
        f32x4 v[4], acc[4];
#pragma unroll
        for (int j = 0; j < 4; ++j) { v[j] = *(const f32x4*)(X + (size_t)t * DM + 4 * lane + 256 * j); acc[j] = (f32x4){0.f, 0.f, 0.f, 0.f}; }
#pragma unroll
        for (int k = 0; k < 4; ++k) { const unsigned ep = TOKE[(size_t)t * 4 + k]; const float pr = TOKP[(size_t)t * 4 + k];
            const int e = ep >> 16, pos = ep & 0xffff; const size_t srow = (size_t)tab[e] * 256 + pos;
#pragma unroll
            for (int j = 0; j < 4; ++j) { const u32x2 y = *(const u32x2*)(YM + srow * DM + 4 * lane + 256 * j);
                acc[j].x += pr * bflo(y.x); acc[j].y += pr * bfhi(y.x); acc[j].z += pr * bflo(y.y); acc[j].w += pr * bfhi(y.y); } }
        const float* mb = modl + (size_t)(t >> 11) * 6144;
#pragma unroll
        for (int j = 0; j < 4; ++j) { const f32x4 gt = *(const f32x4*)(mb + 5120 + 4 * lane + 256 * j); v[j] = v[j] + gt * acc[j]; }
        const float rstd = row_rstd(v, 1e-6f);
        if (l + 1 < DEPTH) {
#pragma unroll
            for (int j = 0; j < 4; ++j) *(f32x4*)(X + (size_t)t * DM + 4 * lane + 256 * j) = v[j];
            const float* mn = modl + (size_t)8 * 6144 + (size_t)(t >> 11) * 6144;
            norm_mod_store(v, rstd, a.in[I_N1G] + (size_t)(l + 1) * DM, mn + 1024, mn, (bf16_t*)(ws + WS_H) + (size_t)t * DM, lane);
        } else {
#pragma unroll
            for (int j = 0; j < 4; ++j) { const int c = 4 * lane + 256 * j; const f32x4 g = *(const f32x4*)(a.in[I_FNG] + c);
                *(f32x4*)(a.out + (size_t)t * DM + c) = v[j] * rstd * g; }
        }
    }
}

constexpr int N_PHASES = 2 + 10 * DEPTH;
__global__ void __launch_bounds__(512, 2) fwd(Args a) {
    extern __shared__ __attribute__((aligned(16))) unsigned char smem[];
    LAS unsigned char* lds = (LAS unsigned char*)smem;
    const int tid = threadIdx.x;
    unsigned* ctl = (unsigned*)(a.ws + WS_CTL);
    volatile LAS unsigned* xbw = (volatile LAS unsigned*)(lds + LDS_CTL_OFF);
    volatile LAS int* tab = (volatile LAS int*)(lds + LDS_CTL_OFF + 256);
    volatile LAS int* qw = (volatile LAS int*)(lds + LDS_CTL_OFF + 1024);
    if (tid < 4) xbw[tid] = 0u;
    __syncthreads();
    const int lo = a.ph_lo, hi = a.ph_hi;
    XcdBarrier bar; bar.bar = ctl + CW_BAR; bar.x = 0; bar.st = xbw;
    if (hi - lo > 1) bar = xcd_barrier_post(ctl + CW_BAR, xbw);
#ifndef BRMASK
#define BRMASK 7
#endif
#ifndef PHMASK
#define PHMASK 0xFFF
#endif
#define PHSEL(k) ((k) < 2 ? (k) : 2 + ((k) - 2) % 10)
#define IN(k) (((PHMASK >> PHSEL(k)) & 1) && lo <= (k) && (k) < hi)
#define SEAM(k) do { if (IN(k) && IN((k) + 1)) { xcd_barrier(bar); } } while (0)
    unsigned char* ws = a.ws;
    if (IN(0)) { phase_p0(a, lds); SEAM(0); }
    if (IN(1)) { phase_norm1(a, 0); SEAM(1); }
    for (int l = 0; l < DEPTH; ++l) {
        const int pb = 2 + 10 * l;
        if (IN(pb + 0)) {
            pg8::StaticOrder S; S.init(NTOK, PLD, gridDim.x, blockIdx.x);
            pg8::EpiProj E{(bf16_t*)(ws + WS_PROJ)};
            pg8::gemm_phase<pg8::EpiProj, pg8::StaticOrder>(lds, (const bf16_t*)(ws + WS_H), (const bf16_t*)(ws + WS_WIN) + (size_t)l * PLD * DM, DM, 0, S, E);
            SEAM(pb + 0);
        }
        if (IN(pb + 1)) { phase_rwkv_pre(a, l, lds); phase_swa(a, lds); SEAM(pb + 1); }
        if (IN(pb + 2)) {
            for (int u = blockIdx.x; u < 192; u += gridDim.x) rwkv_scan_unit(a, u, lds);
            for (;;) {
                if (tid == 0) *qw = (int)__hip_atomic_fetch_add(ctl + CW_QH + 64 * l, 1u, __ATOMIC_RELAXED, __HIP_MEMORY_SCOPE_AGENT);
                __syncthreads();
                const int item = *qw;
                __syncthreads();
                if (item >= 768) break;
                diffattn_unit(a, l, item, lds);
            }
            SEAM(pb + 2);
        }
        if (IN(pb + 3)) { phase_post(a, l); SEAM(pb + 3); }
        if (IN(pb + 4)) {
            pg8::StaticOrder S; S.init(NTOK, DM, gridDim.x, blockIdx.x);
            const bf16_t* P = (const bf16_t*)(ws + WS_PROJ); float* MF = (float*)(ws + WS_MF); bf16_t* MG = (bf16_t*)(ws + WS_MERGED);
            if (BRMASK & 1) { pg8::EpiBranch<0> E{P, MF, MG}; pg8::gemm_phase<pg8::EpiBranch<0>, pg8::StaticOrder>(lds, (const bf16_t*)(ws + WS_OA), (const bf16_t*)(ws + WS_WA) + (size_t)l * DM * 256, 256, 0, S, E); }
            if (BRMASK & 2) { pg8::EpiBranch<1> E{P, MF, MG}; pg8::gemm_phase<pg8::EpiBranch<1>, pg8::StaticOrder>(lds, (const bf16_t*)(ws + WS_OB), (const bf16_t*)(ws + WS_WB) + (size_t)l * DM * 768, 768, 0, S, E); }
            if (BRMASK & 4) { pg8::EpiBranch<2> E{P, MF, MG}; pg8::gemm_phase<pg8::EpiBranch<2>, pg8::StaticOrder>(lds, (const bf16_t*)(ws + WS_OC), (const bf16_t*)(ws + WS_WC) + (size_t)l * DM * 768, 768, 0, S, E); }
            SEAM(pb + 4);
        }
        if (IN(pb + 5)) {
            pg8::StaticOrder S; S.init(NTOK, DM, gridDim.x, blockIdx.x);
            pg8::EpiOut E{l == 0 ? a.in[I_X] : (const float*)(ws + WS_X), (float*)(ws + WS_X), (const float*)(ws + WS_MISC + MISC_MOD) + (size_t)l * 8 * 6144 + 2048};
            pg8::gemm_phase<pg8::EpiOut, pg8::StaticOrder>(lds, (const bf16_t*)(ws + WS_MERGED), (const bf16_t*)(ws + WS_WO) + (size_t)l * DM * DM, DM, 0, S, E);
            SEAM(pb + 5);
        }
        if (IN(pb + 6)) { phase_route(a, l, lds); SEAM(pb + 6); }
        if (IN(pb + 7)) {
            build_moe_tab(a, l, tab);
            pg8::MoeOrder<true> S{(const LAS int*)tab, (const int*)(ws + WS_LIST), 8, (int)gridDim.x, (int)blockIdx.x};
            pg8::EpiMoe1 E{(bf16_t*)(ws + WS_ACT), a.in[I_B1] + (size_t)l * NE * 2 * FF};
            pg8::gemm_phase<pg8::EpiMoe1, pg8::MoeOrder<true>>(lds, (const bf16_t*)(ws + WS_H), (const bf16_t*)(ws + WS_W1) + (size_t)l * NE * 2 * FF * DM, DM, (size_t)2 * FF * DM * 2, S, E);
            SEAM(pb + 7);
        }
        if (IN(pb + 8)) {
            build_moe_tab(a, l, tab);
            pg8::MoeOrder<false> S{(const LAS int*)tab, nullptr, 4, (int)gridDim.x, (int)blockIdx.x};
            pg8::EpiMoe2 E{(bf16_t*)(ws + WS_YMOE), a.in[I_B2] + (size_t)l * NE * DM};
            pg8::gemm_phase<pg8::EpiMoe2, pg8::MoeOrder<false>>(lds, (const bf16_t*)(ws + WS_ACT), (const bf16_t*)(ws + WS_W2) + (size_t)l * NE * DM * FF, FF, (size_t)DM * FF * 2, S, E);
            SEAM(pb + 8);
        }
        if (IN(pb + 9)) { build_moe_tab(a, l, tab); phase_combine(a, l, (const LAS int*)tab); SEAM(pb + 9); }
    }
#undef IN
#undef SEAM
}

#ifndef MK_ONE_LAUNCH
#define MK_ONE_LAUNCH 1
#endif
extern "C" void kernel_launch(void* const* d_in, const int* in_sizes, int n_in, void* d_out, int out_size, void* d_ws, size_t ws_size, hipStream_t stream) {
    static int grid = 0;
    if (grid == 0) {
        if (n_in != 32 || ws_size < WS_END) { fprintf(stderr, "kernel_launch: unexpected n_in %d or ws %zu < %zu\n", n_in, ws_size, (size_t)WS_END); grid = -1; return; }
        int dev = 0, cus = 0;
        if (hipGetDevice(&dev) != hipSuccess || hipDeviceGetAttribute(&cus, hipDeviceAttributeMultiprocessorCount, dev) != hipSuccess) { grid = -1; return; }
        if (hipFuncSetAttribute((const void*)fwd, hipFuncAttributeMaxDynamicSharedMemorySize, LDS_BYTES) != hipSuccess) { fprintf(stderr, "kernel_launch: hipFuncSetAttribute failed\n"); grid = -1; return; }
        int per_cu = 0;
        if (hipOccupancyMaxActiveBlocksPerMultiprocessor(&per_cu, (const void*)fwd, 512, LDS_BYTES) != hipSuccess || per_cu < 1) fprintf(stderr, "kernel_launch: occupancy query says %d\n", per_cu);
        (void)hipGetLastError();
        grid = cus;
    }
    if (grid < 0) return;
    (void)hipMemsetAsync((char*)d_ws + WS_CTL, 0, CTL_BYTES, stream);
    Args a{};
    for (int i = 0; i < 32; ++i) a.in[i] = (const float*)d_in[i];
    a.out = (float*)d_out; a.ws = (unsigned char*)d_ws;
#if MK_ONE_LAUNCH
    a.ph_lo = 0; a.ph_hi = N_PHASES;
    hipLaunchKernelGGL(fwd, dim3(grid), dim3(512), LDS_BYTES, stream, a);
#else
    for (int p = 0; p < N_PHASES; ++p) { a.ph_lo = p; a.ph_hi = p + 1; hipLaunchKernelGGL(fwd, dim3(grid), dim3(512), LDS_BYTES, stream, a); }
#endif
}
```

```cpp
#include <hip/hip_runtime.h>
#include <stdint.h>
#include <stdio.h>

#define LAS __attribute__((address_space(3)))
typedef unsigned short bf16_t;
typedef short bf16x8 __attribute__((ext_vector_type(8)));
typedef short s16x4 __attribute__((ext_vector_type(4)));
typedef float f32x2 __attribute__((ext_vector_type(2)));
typedef float f32x4 __attribute__((ext_vector_type(4)));
typedef float f32x16 __attribute__((ext_vector_type(16)));
typedef unsigned u32x2 __attribute__((ext_vector_type(2)));
typedef unsigned u32x4 __attribute__((ext_vector_type(4)));
typedef __bf16 bf16x2_t __attribute__((ext_vector_type(2)));
typedef short v4i16_t __attribute__((ext_vector_type(4)));

constexpr int NB = 8, NT = 2048, DM = 1024, NTOK = NB * NT, DEPTH = 2;
constexpr int IN_COLS = 10368, PLD = 10496;
constexpr int C_AQ = 0, C_AK = 768, C_AV = 1536, C_BS = 2304, C_CQ = 5120, C_CK = 5888, C_CV = 6656, C_G = 7424;
constexpr int RSTR = 2688, RW = 768, NE = 32, FF = 1024;
constexpr float LOG2E = 1.4426950408889634f;

constexpr size_t al256(size_t x) { return (x + 255) & ~(size_t)255; }
constexpr size_t WS_CTL = 0;
constexpr size_t CTL_BYTES = 65536;
constexpr size_t WS_MISC = WS_CTL + CTL_BYTES;
constexpr size_t MISC_MOD = 0, MISC_LAM = 393216, MISC_BIASA = 393472, MISC_BIASC = 399872, MISC_WUPT = 409600, MISC_AUPT = 409600 + 393216, MISC_BYTES = 2 << 20;
constexpr size_t WS_WIN = WS_MISC + MISC_BYTES;
constexpr size_t WS_WA = WS_WIN + (size_t)DEPTH * PLD * DM * 2;
constexpr size_t WS_WB = WS_WA + (size_t)DEPTH * DM * 256 * 2;
constexpr size_t WS_WC = WS_WB + (size_t)DEPTH * DM * 768 * 2;
constexpr size_t WS_WO = WS_WC + (size_t)DEPTH * DM * 768 * 2;
constexpr size_t WS_W1 = WS_WO + (size_t)DEPTH * DM * DM * 2;
constexpr size_t WS_W2 = WS_W1 + (size_t)DEPTH * NE * 2 * FF * DM * 2;
constexpr size_t WS_H = WS_W2 + (size_t)DEPTH * NE * DM * FF * 2;
constexpr size_t WS_X = WS_H + (size_t)NTOK * DM * 2;
constexpr size_t WS_OA = WS_X + (size_t)NTOK * DM * 4;
constexpr size_t WS_OB = WS_OA + (size_t)NTOK * 256 * 2;
constexpr size_t WS_OC = WS_OB + (size_t)NTOK * 768 * 2;
constexpr size_t WS_MERGED = WS_OC + (size_t)NTOK * 768 * 2;
constexpr size_t WS_LIST = WS_MERGED + (size_t)NTOK * DM * 2;
constexpr size_t WS_TOKE = WS_LIST + (size_t)NE * NTOK * 4;
constexpr size_t WS_TOKP = WS_TOKE + (size_t)NTOK * 4 * 4;
constexpr size_t WS_U = WS_TOKP + (size_t)NTOK * 4 * 4;
constexpr size_t WS_PROJ = WS_U;
constexpr size_t WS_RR = WS_PROJ + (size_t)NTOK * PLD * 2;
constexpr size_t WS_RV = WS_RR + (size_t)NTOK * RW * 4;
constexpr size_t WS_RWD = WS_RV + (size_t)NTOK * RW * 4;
constexpr size_t WS_RKK = WS_RWD + (size_t)2 * NTOK * RW * 4;
constexpr size_t WS_RKKA = WS_RKK + (size_t)2 * NTOK * RW * 4;
constexpr size_t WS_RKD = WS_RKKA + (size_t)2 * NTOK * RW * 4;
constexpr size_t WS_GS = WS_RKD + (size_t)2 * NTOK * RW * 4;
constexpr size_t WS_Y = WS_GS + (size_t)NTOK * 128 * 4;
constexpr size_t WS_OAG = WS_Y + (size_t)2 * NTOK * RW * 4;
constexpr size_t WS_LSE = WS_OAG + (size_t)3 * NTOK * 256 * 4;
constexpr size_t WS_MF = WS_LSE + (size_t)3 * NTOK * 4 * 4;
constexpr size_t WS_QA = WS_MF + (size_t)NTOK * DM * 4;
constexpr size_t WS_SS = WS_QA + (size_t)6144 * 4096 * 2;
constexpr size_t WS_END1 = WS_SS + (size_t)6144 * 4096 * 2;
constexpr size_t WS_MP = WS_RWD, WS_NP = WS_RKK, WS_Y0 = WS_RKKA;
constexpr int SLOT_ROWS = 4 * NTOK + NE * 256;
constexpr size_t WS_ACT = WS_U;
constexpr size_t WS_YMOE = WS_ACT + (size_t)SLOT_ROWS * FF * 2;
constexpr size_t WS_END2 = WS_YMOE + (size_t)SLOT_ROWS * DM * 2;
constexpr size_t WS_END = WS_END1 > WS_END2 ? WS_END1 : WS_END2;

constexpr int CW_BAR = 0;
constexpr int CW_CNT = 4096;
constexpr int CW_QH = 4224;

constexpr int LDS_STAGE = 147456;
constexpr int LDS_CTL_OFF = LDS_STAGE;
constexpr int LDS_BYTES = LDS_STAGE + 4096;

__device__ __forceinline__ int otid() { int t = threadIdx.x; asm volatile("" : "+v"(t)); return t; }
__device__ __forceinline__ int obid() { int t = blockIdx.x; asm volatile("" : "+s"(t)); return t; }
__device__ __forceinline__ unsigned pk2(float lo, float hi) { f32x2 v = {lo, hi}; bf16x2_t b = __builtin_convertvector(v, bf16x2_t); return __builtin_bit_cast(unsigned, b); }
__device__ __forceinline__ float bflo(unsigned u) { return __builtin_bit_cast(float, u << 16); }
__device__ __forceinline__ float bfhi(unsigned u) { return __builtin_bit_cast(float, u & 0xffff0000u); }
__device__ __forceinline__ float bf2f(bf16_t h) { return __builtin_bit_cast(float, (unsigned)h << 16); }
__device__ __forceinline__ float wave_sum(float v) {
#pragma unroll
    for (int o = 1; o < 64; o <<= 1) v += __shfl_xor(v, o);
    return v;
}
__device__ __forceinline__ float sigmoidf_(float x) { return 1.f / (1.f + __expf(-x)); }
__device__ __forceinline__ int crow(int r, int hi) { return (r & 3) + 8 * (r >> 2) + 4 * hi; }
__device__ __forceinline__ s16x4 vtr(const LAS unsigned char* p) { return __builtin_bit_cast(s16x4, __builtin_amdgcn_ds_read_tr16_b64_v4i16((LAS v4i16_t*)p)); }
__device__ __forceinline__ float dpp_sum8(float x) {
    int v = __builtin_bit_cast(int, x);
    x += __builtin_bit_cast(float, __builtin_amdgcn_update_dpp(0, v, 0xB1, 0xF, 0xF, true));
    v = __builtin_bit_cast(int, x);
    x += __builtin_bit_cast(float, __builtin_amdgcn_update_dpp(0, v, 0x4E, 0xF, 0xF, true));
    v = __builtin_bit_cast(int, x);
    x += __builtin_bit_cast(float, __builtin_amdgcn_update_dpp(0, v, 0x141, 0xF, 0xF, true));
    return x;
}

#define XB_TMO      128
#define XB_XCNT(j)  (256  + 64 * (j))
#define XB_XSUB(j)  (1280 + 64 * (j))
#define XB_XGEN(j)  (2304 + 64 * (j))
#define XB_TOP      3328
#define XB_TOPGEN   3392
#define XCD_BAR_WORDS 3456
#define XB_SPIN_CAP (1u << 18)
__device__ __forceinline__ unsigned xb_ld(unsigned* p)              { return __hip_atomic_load(p, __ATOMIC_RELAXED, __HIP_MEMORY_SCOPE_AGENT); }
__device__ __forceinline__ unsigned xb_add(unsigned* p, unsigned v) { return __hip_atomic_fetch_add(p, v, __ATOMIC_RELAXED, __HIP_MEMORY_SCOPE_AGENT); }
__device__ __forceinline__ unsigned xb_xcc_id() { return (unsigned)__builtin_amdgcn_s_getreg((3 << 11) | 20) & 0xFu; }
#define XB_SPIN(cond, bar) do { unsigned _sp = 0; while (cond) { __builtin_amdgcn_s_sleep(1); \
    if ((++_sp & 255u) == 0u) { if (xb_ld(&(bar)[XB_TMO])) break; if (_sp > XB_SPIN_CAP) { atomicAdd(&(bar)[XB_TMO], 1u); break; } } } } while (0)
struct XcdBarrier { unsigned* bar; unsigned x; volatile LAS unsigned* st; };
__device__ __forceinline__ XcdBarrier xcd_barrier_post(unsigned* bar, volatile LAS unsigned* st) {
    XcdBarrier b; b.bar = bar; b.x = xb_xcc_id(); b.st = st;
    if (threadIdx.x == 0) (void)xb_add(&bar[XB_XCNT(b.x)], 1u);
    return b;
}
__device__ __forceinline__ void xcd_barrier_complete(unsigned* bar, unsigned x, unsigned& nloc, unsigned& nx) {
    const unsigned G = gridDim.x * gridDim.y * gridDim.z;
    unsigned sum, cnt, mine, sp = 0u;
    for (;;) {
        sum = 0u; cnt = 0u; mine = 0u;
#pragma unroll
        for (unsigned j = 0; j < 16; ++j) { const unsigned c = xb_ld(&bar[XB_XCNT(j)]); sum += c; cnt += (c > 0u) ? 1u : 0u; mine = (j == x) ? c : mine; }
        if (sum == G) break;
        __builtin_amdgcn_s_sleep(1);
        if ((++sp & 255u) == 0u) { if (xb_ld(&bar[XB_TMO])) break; if (sp > XB_SPIN_CAP) { atomicAdd(&bar[XB_TMO], 1u); break; } }
    }
    nloc = mine > 0u ? mine : 1u; nx = cnt > 0u ? cnt : 1u;
}
__device__ __forceinline__ void xcd_barrier(const XcdBarrier& b) {
    asm volatile("s_waitcnt vmcnt(0)" ::: "memory");
    __syncthreads();
    if (threadIdx.x == 0) {
        unsigned* bar = b.bar;
        __builtin_amdgcn_s_waitcnt(0);
        unsigned nloc = b.st[0], nx = b.st[1];
        if (nloc == 0u) { xcd_barrier_complete(bar, b.x, nloc, nx); b.st[0] = nloc; b.st[1] = nx; }
        const unsigned old = xb_add(&bar[XB_XSUB(b.x)], 1u);
        const unsigned gen = old / nloc;
        if (old + 1u == (gen + 1u) * nloc) {
            __builtin_amdgcn_fence(__ATOMIC_RELEASE, "agent");
            asm volatile("s_waitcnt vmcnt(0)" ::: "memory");
            const unsigned og = xb_add(&bar[XB_TOP], 1u);
            const unsigned tg = og / nx;
            if (og + 1u == (tg + 1u) * nx) xb_add(&bar[XB_TOPGEN], 1u);
            else XB_SPIN(xb_ld(&bar[XB_TOPGEN]) == tg, bar);
            __builtin_amdgcn_fence(__ATOMIC_ACQUIRE, "agent");
            xb_add(&bar[XB_XGEN(b.x)], 1u);
            asm volatile("s_waitcnt vmcnt(0)" ::: "memory");
        } else {
            XB_SPIN(xb_ld(&bar[XB_XGEN(b.x)]) == gen, bar);
            __builtin_amdgcn_fence(__ATOMIC_ACQUIRE, "agent");
            asm volatile("s_waitcnt vmcnt(0)" ::: "memory");
        }
    }
    __syncthreads();
}

namespace pg8 {
constexpr int BM = 256, BK = 64, HALF = 128, HTB = HALF * BK * 2, STAGE_BYTES = 8 * HTB, NXCD = 8, WGM = 8;
__device__ __forceinline__ int lds_byte(int r, int c) { const int st = (r >> 4) * 2 + (c >> 5), rr = r & 15, cc = c & 31, ob = rr * 64 + cc * 2; return st * 1024 + (ob ^ (((ob >> 9) & 1) << 5)); }
__device__ __forceinline__ void stage_rc(int b, int& R, int& C) { const int st = b / 1024, sb = b % 1024, swz = sb ^ (((sb >> 9) & 1) << 5); R = (st >> 1) * 16 + swz / 64; C = (st & 1) * 32 + (swz % 64) / 2; }
__device__ __forceinline__ int perm32(int rho) { const int n = rho >> 4, i = rho & 15; return 8 * (i >> 2) + 4 * n + (i & 3); }

struct Unit { int pm, pn, e, lt; };

struct StaticOrder {
    static constexpr bool GATHER = false;
    int nM, nN, nwg, G, c;
    __device__ void init(int M, int N, int G_, int c_) { nM = M / BM; nN = N / BM; nwg = nM * nN; G = G_; c = c_; }
    __device__ __forceinline__ bool next(int i, Unit& u) const {
        const long L = (long)i * G + c; if (L >= nwg) return false;
        int wgid = (int)L; { const int q = nwg / NXCD, r = nwg % NXCD, xcd = wgid % NXCD, off = wgid / NXCD; wgid = (xcd < r ? xcd * (q + 1) : r * (q + 1) + (xcd - r) * q) + off; }
        const int nig = WGM * nN, gid = wgid / nig, fm = gid * WGM, gsz = (nM - fm) < WGM ? (nM - fm) : WGM;
        u.pm = fm + ((wgid % nig) % gsz); u.pn = (wgid % nig) / gsz; u.e = 0; u.lt = 0; return true;
    }
    __device__ __forceinline__ int arow(const Unit& u, int r) const { return u.pm * BM + r; }
};
template <bool GATHER_> struct MoeOrder {
    static constexpr bool GATHER = GATHER_;
    const LAS int* tab;
    const int* list;
    int ncol, G, c;
    __device__ __forceinline__ bool next(int i, Unit& u) const {
        const int L = i * G + c; const int total = tab[32] * ncol; if (L >= total) return false;
        const int rt = L / ncol; u.pn = L - rt * ncol; u.pm = rt;
        int e = 0;
#pragma unroll 1
        for (int j = 1; j < 32; ++j) e = (tab[j] <= rt) ? j : e;
        u.e = e; u.lt = rt - tab[e]; return true;
    }
    __device__ __forceinline__ int arow(const Unit& u, int r) const {
        if (!GATHER_) return u.pm * BM + r;
        const int pos = u.lt * BM + r; const int cnt = tab[64 + u.e];
        return pos < cnt ? list[(size_t)u.e * NTOK + pos] : 0;
    }
};

template <class Epi, class Sched>
__device__ __forceinline__ void gemm_phase(LAS unsigned char* lds, const bf16_t* A, const bf16_t* Bt, const int K, const size_t b_estride_bytes, const Sched& S, const Epi& E) {
    constexpr bool GATHER = Sched::GATHER;
    const int tid = otid(), wid = __builtin_amdgcn_readfirstlane(tid >> 6), lane = tid & 63, wr = wid >> 2, wc = wid & 3, fr = lane & 15, fq = lane >> 4;
    const int nt = K / BK;
    int Rr[2], Cc[2]; unsigned voffA[2], voffB[2];
#pragma unroll
    for (int i = 0; i < 2; ++i) { int R, C; stage_rc(tid * 16 + i * 8192, R, C); const int Rb = Epi::PERM ? ((R & ~31) + perm32(R & 31)) : R;
        Rr[i] = R; Cc[i] = C; voffA[i] = (unsigned)(R * K + C) * 2u; voffB[i] = (unsigned)(Rb * K + C) * 2u; }
    const size_t kstep = (size_t)(BK * 2);
    const size_t hstep = (size_t)HALF * K * 2;
    const size_t tstep = 2 * hstep;
    const unsigned ldsw = (unsigned)wid * 1024u;
    const int aoff = lds_byte(wr * 64 + fr, fq * 8), boff = lds_byte(wc * 32 + fr, fq * 8);
#define PG8_SA(b, h) (((b) * 2 + (h)) * HTB)
#define PG8_SB(b, h) ((4 + (b) * 2 + (h)) * HTB)
#define PG8_STAGE(bufoff, gbase, voff) do { _Pragma("unroll") for (int _i = 0; _i < 2; ++_i) \
        __builtin_amdgcn_global_load_lds((const unsigned*)((const char*)(gbase) + (voff)[_i]), (LAS unsigned*)(lds + (bufoff) + ldsw + _i * 8192), 16, 0, 0); } while (0)
#define PG8_STAGEA(bufoff, uptr, offs, h, kb) do { _Pragma("unroll") for (int _i = 0; _i < 2; ++_i) { const char* _src; \
        if constexpr (GATHER) _src = (const char*)A + (size_t)(offs)[h][_i] + (size_t)(kb); else _src = (uptr) + (size_t)(h) * hstep + (size_t)(kb) + voffA[_i]; \
        __builtin_amdgcn_global_load_lds((const unsigned*)_src, (LAS unsigned*)(lds + (bufoff) + ldsw + _i * 8192), 16, 0, 0); } } while (0)
#define PG8_LDA(dst, b, h) do { _Pragma("unroll") for (int m = 0; m < 4; ++m) _Pragma("unroll") for (int k = 0; k < 2; ++k) dst[m][k] = *(const LAS bf16x8*)(lds + PG8_SA(b, h) + aoff + m * 2048 + k * 1024); } while (0)
#define PG8_LDB(dst, b, h) do { _Pragma("unroll") for (int n = 0; n < 2; ++n) _Pragma("unroll") for (int k = 0; k < 2; ++k) dst[n][k] = *(const LAS bf16x8*)(lds + PG8_SB(b, h) + boff + n * 2048 + k * 1024); } while (0)
#define PG8_MMA(ai, bj, At, Bt_) do { __builtin_amdgcn_s_setprio(1); _Pragma("unroll") for (int m = 0; m < 4; ++m) _Pragma("unroll") for (int n = 0; n < 2; ++n) _Pragma("unroll") for (int k = 0; k < 2; ++k) \
        acc[ai][bj][m][n] = __builtin_amdgcn_mfma_f32_16x16x32_bf16(Bt_[n][k], At[m][k], acc[ai][bj][m][n], 0, 0, 0); __builtin_amdgcn_s_setprio(0); } while (0)
#define PG8_WAIT_V(n) asm volatile("s_waitcnt vmcnt(" #n ")" ::: "memory")
#define PG8_WAIT_L(n) asm volatile("s_waitcnt lgkmcnt(" #n ")" ::: "memory")
#define PG8_BAR __builtin_amdgcn_s_barrier()
#define PG8_SCHED __builtin_amdgcn_sched_barrier(0)
#define PG8_AOFFS(dst, u) do { if constexpr (GATHER) { _Pragma("unroll") for (int _h = 0; _h < 2; ++_h) _Pragma("unroll") for (int _i = 0; _i < 2; ++_i) \
        dst[_h][_i] = ((unsigned)S.arow(u, _h * HALF + Rr[_i]) * (unsigned)K + (unsigned)Cc[_i]) * 2u; } } while (0)
    Unit cur, nxt; int ui = 0;
    if (!S.next(0, cur)) return;
    f32x4 acc[2][2][4][2];
#pragma unroll
    for (int a = 0; a < 2; ++a)
#pragma unroll
        for (int b = 0; b < 2; ++b)
#pragma unroll
            for (int m = 0; m < 4; ++m)
#pragma unroll
                for (int n = 0; n < 2; ++n) acc[a][b][m][n] = (f32x4){0.f, 0.f, 0.f, 0.f};
    bf16x8 At[4][2], B0[2][2], B1[2][2];
    unsigned aoc[2][2] = {{0u, 0u}, {0u, 0u}}, aon[2][2] = {{0u, 0u}, {0u, 0u}};
    PG8_AOFFS(aoc, cur);
    const char* cA = (const char*)A + (size_t)cur.pm * tstep;
    const char* cB = (const char*)Bt + (size_t)cur.e * b_estride_bytes + (size_t)cur.pn * tstep;
    PG8_STAGE(PG8_SB(0, 0), cB, voffB); PG8_STAGEA(PG8_SA(0, 0), cA, aoc, 0, 0); PG8_STAGE(PG8_SB(0, 1), cB + hstep, voffB); PG8_STAGEA(PG8_SA(0, 1), cA, aoc, 1, 0);
    if (wr == 1) PG8_BAR;
    PG8_WAIT_V(4); PG8_BAR;
    PG8_STAGE(PG8_SB(1, 0), cB + kstep, voffB); PG8_STAGEA(PG8_SA(1, 0), cA, aoc, 0, kstep); PG8_STAGE(PG8_SB(1, 1), cB + hstep + kstep, voffB);
    PG8_WAIT_V(6); PG8_BAR;
    for (;;) {
        const bool has_next = S.next(ui + 1, nxt);
        const char* nA = has_next ? (const char*)A + (size_t)nxt.pm * tstep : cA;
        const char* nB = has_next ? (const char*)Bt + (size_t)nxt.e * b_estride_bytes + (size_t)nxt.pn * tstep : cB;
        if constexpr (GATHER) {
            if (has_next) { PG8_AOFFS(aon, nxt); } else {
#pragma unroll
                for (int h = 0; h < 2; ++h)
#pragma unroll
                    for (int i = 0; i < 2; ++i) aon[h][i] = aoc[h][i]; } }
#pragma unroll 1
        for (int t = 0; t < nt; t += 2) {
            const bool last = (t == nt - 2);
            const size_t k1 = (size_t)(t + 1) * kstep;
            const size_t k2 = last ? (size_t)0 : (size_t)(t + 2) * kstep;
            const size_t k3 = k2 + kstep;
            const char* a2p = last ? nA : cA;
            unsigned a2o[2][2];
#pragma unroll
            for (int h = 0; h < 2; ++h)
#pragma unroll
                for (int i = 0; i < 2; ++i) a2o[h][i] = last ? aon[h][i] : aoc[h][i];
            const char* b2 = last ? nB : cB + (size_t)(t + 2) * kstep; const char* b3 = b2 + kstep;
            PG8_LDB(B0, 0, 0); PG8_SCHED; PG8_LDA(At, 0, 0); PG8_STAGEA(PG8_SA(1, 1), cA, aoc, 1, k1);
            PG8_WAIT_L(8); PG8_BAR; PG8_WAIT_L(0); PG8_MMA(0, 0, At, B0); PG8_BAR; PG8_SCHED;
            PG8_LDB(B1, 0, 1); PG8_STAGE(PG8_SB(0, 0), b2, voffB);
            PG8_BAR; PG8_WAIT_L(0); PG8_MMA(0, 1, At, B1); PG8_BAR;
            PG8_LDA(At, 0, 1); PG8_STAGEA(PG8_SA(0, 0), a2p, a2o, 0, k2);
            PG8_BAR; PG8_WAIT_L(0); PG8_MMA(1, 0, At, B0); PG8_BAR; PG8_SCHED;
            PG8_STAGE(PG8_SB(0, 1), b2 + hstep, voffB);
            PG8_WAIT_V(6); PG8_BAR; PG8_MMA(1, 1, At, B1); PG8_BAR;
            PG8_LDB(B0, 1, 0); PG8_SCHED; PG8_LDA(At, 1, 0); PG8_STAGEA(PG8_SA(0, 1), a2p, a2o, 1, k2);
            PG8_WAIT_L(8); PG8_BAR; PG8_WAIT_L(0); PG8_MMA(0, 0, At, B0); PG8_BAR; PG8_SCHED;
            PG8_LDB(B1, 1, 1); PG8_STAGE(PG8_SB(1, 0), b3, voffB);
            PG8_BAR; PG8_WAIT_L(0); PG8_MMA(0, 1, At, B1); PG8_BAR;
            PG8_LDA(At, 1, 1); PG8_STAGEA(PG8_SA(1, 0), a2p, a2o, 0, k3);
            PG8_BAR; PG8_WAIT_L(0); PG8_MMA(1, 0, At, B0); PG8_BAR; PG8_SCHED;
            PG8_STAGE(PG8_SB(1, 1), b3 + hstep, voffB);
            PG8_WAIT_V(6); PG8_BAR; PG8_MMA(1, 1, At, B1); PG8_BAR;
        }
        E(acc, cur, wr, wc, fr, fq);
        if (!has_next) break;
#pragma unroll
        for (int a = 0; a < 2; ++a)
#pragma unroll
            for (int b = 0; b < 2; ++b)
#pragma unroll
                for (int m = 0; m < 4; ++m)
#pragma unroll
                    for (int n = 0; n < 2; ++n) acc[a][b][m][n] = (f32x4){0.f, 0.f, 0.f, 0.f};
        cur = nxt; cA = nA; cB = nB; ++ui;
#pragma unroll
        for (int h = 0; h < 2; ++h)
#pragma unroll
            for (int i = 0; i < 2; ++i) aoc[h][i] = aon[h][i];
    }
    PG8_WAIT_V(0);
    if (wr == 0) PG8_BAR;
    PG8_BAR;
#undef PG8_SA
#undef PG8_SB
#undef PG8_STAGE
#undef PG8_STAGEA
#undef PG8_LDA
#undef PG8_LDB
#undef PG8_MMA
#undef PG8_WAIT_V
#undef PG8_WAIT_L
#undef PG8_BAR
#undef PG8_SCHED
#undef PG8_AOFFS
}

typedef f32x4 Acc[2][2][4][2];

struct EpiProj {
    static constexpr bool PERM = true;
    bf16_t* O;
    __device__ __forceinline__ void operator()(const Acc& acc, const Unit& u, int wr, int wc, int fr, int fq) const {
        const int row0 = u.pm * BM + wr * 64 + fr, col0 = u.pn * BM + wc * 32 + 8 * fq; const bool sg = u.pn >= 29;
#pragma unroll
        for (int ai = 0; ai < 2; ++ai)
#pragma unroll
            for (int m = 0; m < 4; ++m) { bf16_t* rowp = O + (size_t)(row0 + ai * HALF + m * 16) * PLD + col0;
#pragma unroll
                for (int bj = 0; bj < 2; ++bj) { f32x4 v0 = acc[ai][bj][m][0], v1 = acc[ai][bj][m][1];
                    if (sg) {
#pragma unroll
                        for (int j = 0; j < 4; ++j) { v0[j] = sigmoidf_(v0[j]); v1[j] = sigmoidf_(v1[j]); } }
                    u32x4 w; w.x = pk2(v0[0], v0[1]); w.y = pk2(v0[2], v0[3]); w.z = pk2(v1[0], v1[1]); w.w = pk2(v1[2], v1[3]);
                    *(u32x4*)(rowp + bj * HALF) = w; } }
    }
};
template <int SEG> struct EpiBranch {
    static constexpr bool PERM = true;
    const bf16_t* P; float* MF; bf16_t* MG;
    __device__ __forceinline__ void operator()(const Acc& acc, const Unit& u, int wr, int wc, int fr, int fq) const {
        const int row0 = u.pm * BM + wr * 64 + fr, col0 = u.pn * BM + wc * 32 + 8 * fq;
#pragma unroll
        for (int ai = 0; ai < 2; ++ai)
#pragma unroll
            for (int m = 0; m < 4; ++m) { const size_t r = (size_t)(row0 + ai * HALF + m * 16);
                asm volatile("" ::: "memory");
#pragma unroll
                for (int bj = 0; bj < 2; ++bj) { const int c = col0 + bj * HALF;
                    const u32x4 g = *(const u32x4*)(P + r * PLD + C_G + SEG * 1024 + c);
                    f32x4 v0 = acc[ai][bj][m][0], v1 = acc[ai][bj][m][1];
                    v0[0] *= bflo(g.x); v0[1] *= bfhi(g.x); v0[2] *= bflo(g.y); v0[3] *= bfhi(g.y);
                    v1[0] *= bflo(g.z); v1[1] *= bfhi(g.z); v1[2] *= bflo(g.w); v1[3] *= bfhi(g.w);
                    float* mp = MF + r * DM + c;
                    if (SEG > 0) { v0 += *(const f32x4*)mp; v1 += *(const f32x4*)(mp + 4); }
                    if (SEG < 2) { *(f32x4*)mp = v0; *(f32x4*)(mp + 4) = v1; }
                    else { u32x4 w; w.x = pk2(v0[0], v0[1]); w.y = pk2(v0[2], v0[3]); w.z = pk2(v1[0], v1[1]); w.w = pk2(v1[2], v1[3]); *(u32x4*)(MG + r * DM + c) = w; } } }
    }
};
struct EpiOut {
    static constexpr bool PERM = false;
    const float* xsrc; float* X; const float* gt;
    __device__ __forceinline__ void operator()(const Acc& acc, const Unit& u, int wr, int wc, int fr, int fq) const {
        const int row0 = u.pm * BM + wr * 64 + fr, col0 = u.pn * BM + wc * 32 + 4 * fq;
        const float* gp = gt + (size_t)((u.pm * BM) >> 11) * 6144 + col0;
        f32x4 gv[2][2];
#pragma unroll
        for (int bj = 0; bj < 2; ++bj)
#pragma unroll
            for (int n = 0; n < 2; ++n) gv[bj][n] = *(const f32x4*)(gp + bj * HALF + n * 16);
#pragma unroll
        for (int ai = 0; ai < 2; ++ai)
#pragma unroll
            for (int m = 0; m < 4; ++m) { const size_t o = (size_t)(row0 + ai * HALF + m * 16) * DM + col0;
#pragma unroll
                for (int bj = 0; bj < 2; ++bj)
#pragma unroll
                    for (int n = 0; n < 2; ++n) { const f32x4 xv = *(const f32x4*)(xsrc + o + bj * HALF + n * 16);
                        *(f32x4*)(X + o + bj * HALF + n * 16) = xv + gv[bj][n] * acc[ai][bj][m][n]; } }
    }
};
struct EpiMoe1 {
    static constexpr bool PERM = true;
    bf16_t* ACT; const float* b1;
    __device__ __forceinline__ void operator()(const Acc& acc, const Unit& u, int wr, int wc, int fr, int fq) const {
        const int row0 = u.pm * BM + wr * 64 + fr, col0 = u.pn * BM + wc * 32 + 8 * fq;
        const float* bp = b1 + (size_t)u.e * (2 * FF) + col0;
        f32x4 bv[2][2];
#pragma unroll
        for (int bj = 0; bj < 2; ++bj)
#pragma unroll
            for (int n = 0; n < 2; ++n) bv[bj][n] = *(const f32x4*)(bp + bj * HALF + 4 * n);
#pragma unroll
        for (int ai = 0; ai < 2; ++ai)
#pragma unroll
            for (int m = 0; m < 4; ++m) { bf16_t* rowp = ACT + (size_t)(row0 + ai * HALF + m * 16) * FF + (col0 >> 1);
#pragma unroll
                for (int bj = 0; bj < 2; ++bj) { const f32x4 v0 = acc[ai][bj][m][0] + bv[bj][0], v1 = acc[ai][bj][m][1] + bv[bj][1];
                    float a[4];
#pragma unroll
                    for (int q = 0; q < 4; ++q) { const float gl = (q < 2) ? v0[2 * q] : v1[2 * q - 4], ln = (q < 2) ? v0[2 * q + 1] : v1[2 * q - 3];
                        const float xg = fminf(gl, 7.0f), xl = fminf(fmaxf(ln, -7.0f), 7.0f);
                        a[q] = xg * sigmoidf_(1.702f * xg) * (xl + 1.0f); }
                    u32x2 w; w.x = pk2(a[0], a[1]); w.y = pk2(a[2], a[3]);
                    *(u32x2*)(rowp + bj * (HALF / 2)) = w; } }
    }
};
struct EpiMoe2 {
    static constexpr bool PERM = true;
    bf16_t* Y; const float* b2;
    __device__ __forceinline__ void operator()(const Acc& acc, const Unit& u, int wr, int wc, int fr, int fq) const {
        const int row0 = u.pm * BM + wr * 64 + fr, col0 = u.pn * BM + wc * 32 + 8 * fq;
        const float* bp = b2 + (size_t)u.e * DM + col0;
        f32x4 bv[2][2];
#pragma unroll
        for (int bj = 0; bj < 2; ++bj)
#pragma unroll
            for (int n = 0; n < 2; ++n) bv[bj][n] = *(const f32x4*)(bp + bj * HALF + 4 * n);
#pragma unroll
        for (int ai = 0; ai < 2; ++ai)
#pragma unroll
            for (int m = 0; m < 4; ++m) { bf16_t* rowp = Y + (size_t)(row0 + ai * HALF + m * 16) * DM + col0;
#pragma unroll
                for (int bj = 0; bj < 2; ++bj) { const f32x4 v0 = acc[ai][bj][m][0] + bv[bj][0], v1 = acc[ai][bj][m][1] + bv[bj][1];
                    u32x4 w; w.x = pk2(v0[0], v0[1]); w.y = pk2(v0[2], v0[3]); w.z = pk2(v1[0], v1[1]); w.w = pk2(v1[2], v1[3]);
                    *(u32x4*)(rowp + bj * HALF) = w; } }
    }
};
}

struct Args { const float* in[32]; float* out; unsigned char* ws; int ph_lo, ph_hi; };
enum { I_X = 0, I_C, I_WMOD, I_BMOD, I_N1G, I_N2G, I_WIN, I_MU, I_W0, I_WUP, I_A0, I_AUP, I_GUP, I_KK, I_KA, I_RK, I_LNG, I_LNB, I_DLAM, I_SUBG, I_RELB, I_WBA, I_WBB, I_WBC, I_WOUT, I_RW, I_RB, I_W1, I_B1, I_W2, I_B2, I_FNG };

__device__ __forceinline__ void lds_fence() { asm volatile("s_waitcnt lgkmcnt(0)" ::: "memory"); }

__device__ __forceinline__ void tr_item(const float* W, int ldw, int ncols, bf16_t* WT, int K, LAS float* scr, int item, int lane) {
    const int nblk = ncols >> 5, kb = item / nblk, nb = item - kb * nblk, k0 = 64 * kb, n0 = 32 * nb;
#pragma unroll 8
    for (int i = 0; i < 32; ++i) { const int kk = 2 * i + (lane >> 5); scr[kk * 33 + (lane & 31)] = W[(size_t)(k0 + kk) * ldw + n0 + (lane & 31)]; }
    lds_fence();
    const int c = lane & 7;
#pragma unroll
    for (int j = 0; j < 4; ++j) { const int n = (lane >> 3) + 8 * j; const LAS float* s = scr + (8 * c) * 33 + n;
        u32x4 o; o.x = pk2(s[0 * 33], s[1 * 33]); o.y = pk2(s[2 * 33], s[3 * 33]); o.z = pk2(s[4 * 33], s[5 * 33]); o.w = pk2(s[6 * 33], s[7 * 33]);
        *(u32x4*)(WT + (size_t)(n0 + n) * K + k0 + 8 * c) = o; }
    lds_fence();
}
__device__ __forceinline__ int t5_bucket(int rel) {
    const int ret = rel > 0 ? 16 : 0; const int n = rel < 0 ? -rel : rel;
    int v;
    if (n < 8) v = n; else if (n < 12) v = 8; else if (n < 16) v = 9; else if (n < 23) v = 10; else if (n < 32) v = 11;
    else if (n < 46) v = 12; else if (n < 64) v = 13; else if (n < 91) v = 14; else v = 15;
    return ret + v;
}
__device__ __forceinline__ void phase_p0(const Args& a, LAS unsigned char* lds) {
    const int tid = otid(), lane = tid & 63, wave = tid >> 6, G = gridDim.x;
    unsigned char* ws = a.ws;
    {
        LAS float* scr = (LAS float*)(lds + wave * 8448);
        const int gw = blockIdx.x * 8 + wave, NGW = G * 8;
        constexpr int NITEMS = 65536 + 32768 + 2 * 6592;
        for (int it = gw; it < NITEMS; it += NGW) {
            int r = it;
            if (r < 65536) { const int mat = r >> 10; tr_item(a.in[I_W1] + (size_t)mat * DM * 2 * FF, 2 * FF, 2 * FF, (bf16_t*)(ws + WS_W1) + (size_t)mat * 2 * FF * DM, DM, scr, r & 1023, lane); continue; }
            r -= 65536;
            if (r < 32768) { const int mat = r >> 9; tr_item(a.in[I_W2] + (size_t)mat * FF * DM, DM, DM, (bf16_t*)(ws + WS_W2) + (size_t)mat * DM * FF, FF, scr, r & 511, lane); continue; }
            r -= 32768;
            const int l = r / 6592; r -= l * 6592;
            if (r < 2496) { tr_item(a.in[I_WIN] + (size_t)l * DM * IN_COLS, IN_COLS, 4992, (bf16_t*)(ws + WS_WIN) + (size_t)l * PLD * DM, DM, scr, r, lane); continue; }
            r -= 2496;
            if (r < 2688) { tr_item(a.in[I_WIN] + (size_t)l * DM * IN_COLS + 4992, IN_COLS, 5376, (bf16_t*)(ws + WS_WIN) + (size_t)l * PLD * DM + (size_t)5120 * DM, DM, scr, r, lane); continue; }
            r -= 2688;
            if (r < 128) { tr_item(a.in[I_WBA] + (size_t)l * 256 * DM, DM, DM, (bf16_t*)(ws + WS_WA) + (size_t)l * DM * 256, 256, scr, r, lane); continue; }
            r -= 128;
            if (r < 384) { tr_item(a.in[I_WBB] + (size_t)l * 768 * DM, DM, DM, (bf16_t*)(ws + WS_WB) + (size_t)l * DM * 768, 768, scr, r, lane); continue; }
            r -= 384;
            if (r < 384) { tr_item(a.in[I_WBC] + (size_t)l * 768 * DM, DM, DM, (bf16_t*)(ws + WS_WC) + (size_t)l * DM * 768, 768, scr, r, lane); continue; }
            r -= 384;
            tr_item(a.in[I_WOUT] + (size_t)l * DM * DM, DM, DM, (bf16_t*)(ws + WS_WO) + (size_t)l * DM * DM, DM, scr, r, lane);
        }
        for (int i = blockIdx.x * 512 + tid; i < 2 * 128 * DM / 8; i += G * 512) {
            const int l = i / (128 * DM / 8), o = i - l * (128 * DM / 8);
            *(u32x4*)((bf16_t*)(ws + WS_WIN) + (size_t)l * PLD * DM + (size_t)4992 * DM + (size_t)o * 8) = (u32x4){0u, 0u, 0u, 0u};
        }
    }
    {
        bf16_t* WT = (bf16_t*)(ws + WS_MISC + MISC_WUPT); bf16_t* AT = (bf16_t*)(ws + WS_MISC + MISC_AUPT);
        for (int i = blockIdx.x * 512 + tid; i < 2 * 2 * 12 * 4096; i += G * 512) {
            const int j = i & 63, k = (i >> 6) & 63, hd = (i >> 12) % 12, ld = i / (12 * 4096);
            const size_t src = ((size_t)ld * 64 + j) * RW + hd * 64 + k;
            WT[i] = (bf16_t)(pk2(a.in[I_WUP][src], 0.f) & 0xffffu); AT[i] = (bf16_t)(pk2(a.in[I_AUP][src], 0.f) & 0xffffu);
        }
    }
    __syncthreads();
    if ((int)blockIdx.x < 192) {
        LAS float* sc = (LAS float*)(lds + 69632);
        LAS float* red = (LAS float*)(lds + 102400);
        for (int i = tid; i < NB * DM; i += 512) { const float v = a.in[I_C][i]; sc[i] = v / (1.f + expf(-v)); }
        __syncthreads();
        float* mod = (float*)(ws + WS_MISC + MISC_MOD);
        for (int j = blockIdx.x; j < 192; j += G) {
            const int l = j / 96, n0 = (j - l * 96) * 64, jj = tid & 63, ks = tid >> 6;
            float acc[8];
#pragma unroll
            for (int b = 0; b < 8; ++b) acc[b] = 0.f;
            const float* wp = a.in[I_WMOD] + ((size_t)l * DM + ks * 128) * 6144 + n0 + jj;
            for (int k = 0; k < 128; ++k) { const float w = wp[(size_t)k * 6144];
#pragma unroll
                for (int b = 0; b < 8; ++b) acc[b] += sc[b * DM + ks * 128 + k] * w; }
#pragma unroll
            for (int b = 0; b < 8; ++b) red[(ks * 8 + b) * 64 + jj] = acc[b];
            __syncthreads();
            { const int b = tid >> 6; float s = 0.f;
#pragma unroll
              for (int k2 = 0; k2 < 8; ++k2) s += red[(k2 * 8 + b) * 64 + jj];
              mod[((size_t)l * 8 + b) * 6144 + n0 + jj] = s + a.in[I_BMOD][(size_t)l * 6144 + n0 + jj]; }
            __syncthreads();
        }
    }
    if ((int)blockIdx.x == G - 1) {
        float* lam = (float*)(ws + WS_MISC + MISC_LAM);
        if (tid < 2) { const int l = tid; const float* dl = a.in[I_DLAM] + (size_t)l * 256; float s01 = 0.f, s23 = 0.f;
            for (int d = 0; d < 64; ++d) { s01 += dl[d] * dl[64 + d]; s23 += dl[128 + d] * dl[192 + d]; }
            const float li = 0.8f - 0.6f * expf(-0.3f * (float)l);
            lam[l] = expf(s01) - expf(s23) + li; lam[2 + l] = li; }
        float* bA = (float*)(ws + WS_MISC + MISC_BIASA);
        for (int i = tid; i < 12 * 129; i += 512) { const int head = i / 129, jj = i - head * 129, g = head >> 2; const int dil = (g == 0) ? 1 : (g == 1) ? 4 : 16;
            bA[i] = a.in[I_RELB][t5_bucket((jj - 64) * dil) * 18 + head] * LOG2E; }
        float* bC = (float*)(ws + WS_MISC + MISC_BIASC);
        for (int i = tid; i < 6 * 257; i += 512) { const int h = i / 257, rel = i - h * 257 - 128;
            bC[i] = a.in[I_RELB][t5_bucket(rel) * 18 + 12 + h] * LOG2E; }
    }
}

__device__ __forceinline__ float row_rstd(const f32x4 (&v)[4], float eps) {
    float s = 0.f;
#pragma unroll
    for (int j = 0; j < 4; ++j) s += (v[j].x * v[j].x + v[j].y * v[j].y) + (v[j].z * v[j].z + v[j].w * v[j].w);
    return rsqrtf(wave_sum(s) * (1.f / DM) + eps);
}
__device__ __forceinline__ void norm_mod_store(const f32x4 (&v)[4], float rstd, const float* g, const float* sc, const float* sh, bf16_t* orow, int lane) {
#pragma unroll
    for (int j = 0; j < 4; ++j) { const int c = 4 * lane + 256 * j;
        const f32x4 gv = *(const f32x4*)(g + c), scv = *(const f32x4*)(sc + c), shv = *(const f32x4*)(sh + c);
        const f32x4 y = v[j] * rstd * gv * (scv + 1.0f) + shv;
        u32x2 w; w.x = pk2(y.x, y.y); w.y = pk2(y.z, y.w);
        *(u32x2*)(orow + c) = w; }
}
__device__ __forceinline__ void phase_norm1(const Args& a, int l) {
    const int tid = otid(), lane = tid & 63, wave = tid >> 6;
    const float* mod = (const float*)(a.ws + WS_MISC + MISC_MOD) + (size_t)l * 8 * 6144;
    bf16_t* H = (bf16_t*)(a.ws + WS_H);
    for (int t = blockIdx.x * 8 + wave; t < NTOK; t += gridDim.x * 8) {
        const float* xr = a.in[I_X] + (size_t)t * DM; f32x4 v[4];
#pragma unroll
        for (int j = 0; j < 4; ++j) v[j] = *(const f32x4*)(xr + 4 * lane + 256 * j);
        const float rstd = row_rstd(v, 1e-6f);
        const float* mb = mod + (size_t)(t >> 11) * 6144;
        norm_mod_store(v, rstd, a.in[I_N1G] + (size_t)l * DM, mb + 1024, mb, H + (size_t)t * DM, lane);
    }
}

__device__ __forceinline__ float shiftv(const bf16_t* P, int t, int col, const float* mu) {
    const int ts = t & (NT - 1); const bf16_t* p0 = P + (size_t)t * PLD + C_BS + col;
    const float p = bf2f(p0[0]);
    const float pm = ts > 0 ? bf2f(p0[-PLD]) : 0.f;
    const float pn = ts < NT - 1 ? bf2f(p0[PLD]) : 0.f;
    return p + mu[col] * (pm - p) + mu[RSTR + col] * (pn - p);
}
__device__ __forceinline__ void phase_rwkv_pre(const Args& a, int l, LAS unsigned char* lds) {
    const int tid = otid(), lane = tid & 63, wave = tid >> 6;
    unsigned char* ws = a.ws;
    const bf16_t* P = (const bf16_t*)(ws + WS_PROJ);
    const float* mu = a.in[I_MU] + (size_t)l * 2 * RSTR;
    LAS float* LW = (LAS float*)lds;
    float* GS = (float*)(ws + WS_GS);
    float* RR = (float*)(ws + WS_RR); float* RV = (float*)(ws + WS_RV);
    float* RWD = (float*)(ws + WS_RWD); float* RKK = (float*)(ws + WS_RKK); float* RKKA = (float*)(ws + WS_RKKA); float* RKD = (float*)(ws + WS_RKD);
    const float* w0 = a.in[I_W0] + (size_t)l * 2 * RW; const float* a0 = a.in[I_A0] + (size_t)l * 2 * RW;
    const float* wup = a.in[I_WUP] + (size_t)l * 2 * 64 * RW; const float* aup = a.in[I_AUP] + (size_t)l * 2 * 64 * RW;
    const float* kkp = a.in[I_KK] + (size_t)l * 2 * RW; const float* kap = a.in[I_KA] + (size_t)l * 2 * RW;
    for (int tile = blockIdx.x; tile < NTOK / 32; tile += gridDim.x) {
        const int t0 = tile * 32;
        for (int idx = tid; idx < 32 * 384; idx += 512) {
            const int i = idx / 384, cc = idx - i * 384;
            const float val = shiftv(P, t0 + i, 2304 + cc, mu);
            if (cc < 128) { const int di = cc >> 6, j = cc & 63; LW[(j * 32 + i) * 4 + di] = tanhf(val); }
            else if (cc < 256) { const int c2 = cc - 128, di = c2 >> 6, j = c2 & 63; LW[(j * 32 + i) * 4 + 2 + di] = val; }
            else GS[(size_t)(t0 + i) * 128 + cc - 256] = sigmoidf_(val);
        }
        __syncthreads();
        for (int q = wave; q < 48; q += 8) {
            const int hd = q % 12, tg = q / 12, c = hd * 64 + lane, tb = t0 + tg * 8;
            float kv[8];
#pragma unroll
            for (int tk = 0; tk < 8; ++tk) { const int t = tb + tk;
                kv[tk] = shiftv(P, t, 768 + c, mu);
                RR[(size_t)t * RW + c] = shiftv(P, t, c, mu);
                RV[(size_t)t * RW + c] = shiftv(P, t, 1536 + c, mu); }
            float aw0[8], aw1[8], aa0[8], aa1[8];
#pragma unroll
            for (int tk = 0; tk < 8; ++tk) { aw0[tk] = 0.f; aw1[tk] = 0.f; aa0[tk] = 0.f; aa1[tk] = 0.f; }
            for (int j = 0; j < 64; ++j) {
                const float wu0 = wup[(size_t)j * RW + c], wu1 = wup[(size_t)(64 + j) * RW + c], au0 = aup[(size_t)j * RW + c], au1 = aup[(size_t)(64 + j) * RW + c];
#pragma unroll
                for (int tk = 0; tk < 8; ++tk) { const f32x4 q4 = *(const LAS f32x4*)(LW + (j * 32 + tg * 8 + tk) * 4);
                    aw0[tk] += q4.x * wu0; aw1[tk] += q4.y * wu1; aa0[tk] += q4.z * au0; aa1[tk] += q4.w * au1; }
            }
#pragma unroll
            for (int di = 0; di < 2; ++di) {
                const float w0c = w0[di * RW + c], a0c = a0[di * RW + c], kkc = kkp[di * RW + c], kac = kap[di * RW + c];
#pragma unroll
                for (int tk = 0; tk < 8; ++tk) { const int t = tb + tk;
                    const float z = w0c + (di ? aw1[tk] : aw0[tk]);
                    const float u = -z; const float sp = fmaxf(u, 0.f) + log1pf(expf(-fabsf(u)));
                    const float wlog = -sp - 0.5f;
                    const float decay = expf(-expf(wlog));
                    const float av = sigmoidf_(a0c + (di ? aa1[tk] : aa0[tk]));
                    const float kr = kv[tk] * kkc;
                    const float nrm = wave_sum(kr * kr);
                    const float kk = kr * rsqrtf(fmaxf(nrm, 1e-24f));
                    const float kd = kv[tk] * (1.f + (av - 1.f) * kac);
                    const size_t o = ((size_t)di * NTOK + t) * RW + c;
                    RWD[o] = decay; RKK[o] = kk; RKKA[o] = kk * av; RKD[o] = kd; }
            }
        }
        __syncthreads();
    }
}

__device__ __forceinline__ void swa_wave_unit(const bf16_t* P, float* OAG, float* LSE, const LAS float* biasA, LAS unsigned char* vbuf, int u, int lane) {
    const int b = u / 768; const int rem = u - b * 768; const int head = rem >> 6, s = rem & 63;
    const int g = head >> 2, hh = head & 3;
    const int dsh = (g == 0) ? 0 : (g == 1) ? 2 : 4;
    const int L = NT >> dsh, nmbsh = 6 - dsh;
    const int r = s >> nmbsh, mb = s & ((1 << nmbsh) - 1);
    const int r32 = lane & 31, hi = lane >> 5;
    const size_t tq = (size_t)b * NT + ((mb * 32 + r32) << dsh) + r;
    bf16x8 qf[4];
    { const bf16_t* qp = P + tq * PLD + C_AQ + head * 64 + 8 * hi;
#pragma unroll
      for (int s4 = 0; s4 < 4; ++s4) qf[s4] = *(const bf16x8*)(qp + 16 * s4); }
    f32x16 o[2]; o[0] = (f32x16){}; o[1] = (f32x16){};
    float m = -1e30f, lsum = 0.f;
    const float SC = 0.125f * LOG2E;
    const LAS float* bh = biasA + head * 129 + 64;
    const int trbase = (4 * hi + ((lane & 15) >> 2)) * 144 + (16 * ((lane >> 4) & 1) + 4 * (lane & 3)) * 2;
    for (int kt = -2; kt <= 2; ++kt) {
        const int m0 = mb * 32 + kt * 32;
        if (m0 + 31 < 0 || m0 >= L) continue;
        bf16x8 kf[4];
        { int km = m0 + r32; km = km < 0 ? 0 : (km > L - 1 ? L - 1 : km);
          const bf16_t* kp = P + ((size_t)b * NT + (km << dsh) + r) * PLD + C_AK + head * 64 + 8 * hi;
#pragma unroll
          for (int s4 = 0; s4 < 4; ++s4) kf[s4] = *(const bf16x8*)(kp + 16 * s4); }
        asm volatile("" ::: "memory");
#pragma unroll
        for (int c4 = 0; c4 < 4; ++c4) { const int id = lane + 64 * c4, row = id >> 3, ch = id & 7;
            int vm = m0 + row; vm = vm < 0 ? 0 : (vm > L - 1 ? L - 1 : vm);
            const u32x4 val = *(const u32x4*)(P + ((size_t)b * NT + (vm << dsh) + r) * PLD + C_AV + head * 64 + ch * 8);
            *(LAS u32x4*)(vbuf + row * 144 + ch * 16) = val; }
        f32x16 sacc = (f32x16){};
#pragma unroll
        for (int s4 = 0; s4 < 4; ++s4) sacc = __builtin_amdgcn_mfma_f32_32x32x16_bf16(kf[s4], qf[s4], sacc, 0, 0, 0);
        float x[16]; float mx = -1e30f;
#pragma unroll
        for (int rg = 0; rg < 16; ++rg) { const int kvl = crow(rg, hi), km = m0 + kvl, j = kt * 32 + kvl - r32;
            const bool valid = (km >= 0) && (km < L) && (j >= -64) && (j <= 64);
            const int jc = j < -64 ? -64 : (j > 64 ? 64 : j);
            const float xv = sacc[rg] * SC + bh[jc];
            x[rg] = valid ? xv : -1e30f; mx = fmaxf(mx, x[rg]); }
        mx = fmaxf(mx, __shfl_xor(mx, 32));
        const float mn = fmaxf(m, mx), alpha = __builtin_amdgcn_exp2f(m - mn); m = mn;
        float ps = 0.f;
#pragma unroll
        for (int rg = 0; rg < 16; ++rg) { x[rg] = __builtin_amdgcn_exp2f(x[rg] - mn); ps += x[rg]; }
        lsum = lsum * alpha + ps;
#pragma unroll
        for (int rg = 0; rg < 16; ++rg) { o[0][rg] *= alpha; o[1][rg] *= alpha; }
        u32x4 pw[2];
#pragma unroll
        for (int s2 = 0; s2 < 2; ++s2) { pw[s2].x = pk2(x[8 * s2 + 0], x[8 * s2 + 1]); pw[s2].y = pk2(x[8 * s2 + 2], x[8 * s2 + 3]); pw[s2].z = pk2(x[8 * s2 + 4], x[8 * s2 + 5]); pw[s2].w = pk2(x[8 * s2 + 6], x[8 * s2 + 7]); }
        lds_fence();
#pragma unroll
        for (int db = 0; db < 2; ++db)
#pragma unroll
            for (int s2 = 0; s2 < 2; ++s2) {
                const s16x4 lo = vtr(vbuf + trbase + (16 * s2) * 144 + db * 64);
                const s16x4 hi4 = vtr(vbuf + trbase + (16 * s2 + 8) * 144 + db * 64);
                const bf16x8 af = (bf16x8){lo[0], lo[1], lo[2], lo[3], hi4[0], hi4[1], hi4[2], hi4[3]};
                o[db] = __builtin_amdgcn_mfma_f32_32x32x16_bf16(af, __builtin_bit_cast(bf16x8, pw[s2]), o[db], 0, 0, 0);
            }
        asm volatile("" ::: "memory");
    }
    const float lt = lsum + __shfl_xor(lsum, 32);
    const float inv = 1.f / lt;
    float* op = OAG + ((size_t)g * NTOK + tq) * 256 + hh * 64;
#pragma unroll
    for (int db = 0; db < 2; ++db)
#pragma unroll
        for (int i = 0; i < 4; ++i) { f32x4 v = (f32x4){o[db][4 * i], o[db][4 * i + 1], o[db][4 * i + 2], o[db][4 * i + 3]} * inv;
            *(f32x4*)(op + db * 32 + 8 * i + 4 * hi) = v; }
    if (hi == 0) LSE[((size_t)g * NTOK + tq) * 4 + hh] = m + __log2f(lt);
}
__device__ __forceinline__ void phase_swa(const Args& a, LAS unsigned char* lds) {
    const int tid = otid(), lane = tid & 63, wave = tid >> 6;
    LAS float* bA = (LAS float*)(lds + 40960);
    const float* bAg = (const float*)(a.ws + WS_MISC + MISC_BIASA);
    for (int i = tid; i < 12 * 129; i += 512) bA[i] = bAg[i];
    __syncthreads();
    for (int item = blockIdx.x; item < 768; item += gridDim.x)
        swa_wave_unit((const bf16_t*)(a.ws + WS_PROJ), (float*)(a.ws + WS_OAG), (float*)(a.ws + WS_LSE), bA, lds + wave * 4608, item * 8 + wave, lane);
    __syncthreads();
}

__device__ __forceinline__ void rwkv_scan_unit(const Args& a, int unit, LAS unsigned char* lds) {
    const int dir = unit & 1, bh = unit >> 1, h = bh % 12, b = bh / 12;
    const int tid = otid(), row = tid >> 3, kp = tid & 7;
    unsigned char* ws = a.ws;
    const size_t base_d = ((size_t)dir * NTOK + (size_t)b * NT) * RW + h * 64;
    const size_t base_s = ((size_t)b * NT) * RW + h * 64;
    const float* src[6] = { (const float*)(ws + WS_RWD) + base_d, (const float*)(ws + WS_RKK) + base_d, (const float*)(ws + WS_RKKA) + base_d, (const float*)(ws + WS_RKD) + base_d,
                            (const float*)(ws + WS_RR) + base_s, (const float*)(ws + WS_RV) + base_s };
    float* Y = (float*)(ws + WS_Y) + base_d;
    LAS float* ybuf = (LAS float*)(lds + 98304);
    const int li = tid >> 4, lc4 = tid & 15;
    float S[8];
#pragma unroll
    for (int i = 0; i < 8; ++i) S[i] = 0.f;
    f32x4 regs[6];
    { const int ts = dir ? NT - 32 : 0;
#pragma unroll
      for (int q = 0; q < 6; ++q) regs[q] = *(const f32x4*)(src[q] + (size_t)(ts + li) * RW + lc4 * 4);
#pragma unroll
      for (int q = 0; q < 6; ++q) *(LAS f32x4*)(lds + ((q * 32 + li) * 64 + lc4 * 4) * 4) = regs[q]; }
    __syncthreads();
    for (int c = 0; c < 64; ++c) {
        const int ts = dir ? NT - 32 * (c + 1) : 32 * c;
        if (c + 1 < 64) { const int tn = dir ? NT - 32 * (c + 2) : 32 * (c + 1);
#pragma unroll
            for (int q = 0; q < 6; ++q) regs[q] = *(const f32x4*)(src[q] + (size_t)(tn + li) * RW + lc4 * 4); }
        const LAS unsigned char* buf = lds + (c & 1) * 49152;
#pragma unroll 4
        for (int ii = 0; ii < 32; ++ii) {
            const int i = dir ? 31 - ii : ii;
            const LAS float* pw = (const LAS float*)(buf + ((0 * 32 + i) * 64 + 8 * kp) * 4);
            const f32x4 w0 = *(const LAS f32x4*)pw, w1 = *(const LAS f32x4*)(pw + 4);
            const f32x4 k0 = *(const LAS f32x4*)(pw + 2048), k1 = *(const LAS f32x4*)(pw + 2048 + 4);
            const f32x4 a0 = *(const LAS f32x4*)(pw + 4096), a1 = *(const LAS f32x4*)(pw + 4096 + 4);
            const f32x4 d0 = *(const LAS f32x4*)(pw + 6144), d1 = *(const LAS f32x4*)(pw + 6144 + 4);
            const f32x4 r0 = *(const LAS f32x4*)(pw + 8192), r1 = *(const LAS f32x4*)(pw + 8192 + 4);
            const float vv = *(const LAS float*)(buf + ((5 * 32 + i) * 64 + row) * 4);
            float sa = S[0] * k0.x + S[1] * k0.y + S[2] * k0.z + S[3] * k0.w + S[4] * k1.x + S[5] * k1.y + S[6] * k1.z + S[7] * k1.w;
            sa = -dpp_sum8(sa);
            S[0] = S[0] * w0.x + sa * a0.x + vv * d0.x; S[1] = S[1] * w0.y + sa * a0.y + vv * d0.y; S[2] = S[2] * w0.z + sa * a0.z + vv * d0.z; S[3] = S[3] * w0.w + sa * a0.w + vv * d0.w;
            S[4] = S[4] * w1.x + sa * a1.x + vv * d1.x; S[5] = S[5] * w1.y + sa * a1.y + vv * d1.y; S[6] = S[6] * w1.z + sa * a1.z + vv * d1.z; S[7] = S[7] * w1.w + sa * a1.w + vv * d1.w;
            float y = S[0] * r0.x + S[1] * r0.y + S[2] * r0.z + S[3] * r0.w + S[4] * r1.x + S[5] * r1.y + S[6] * r1.z + S[7] * r1.w;
            y = dpp_sum8(y);
            if (kp == 0) ybuf[i * 64 + row] = y;
        }
        __syncthreads();
        *(f32x4*)(Y + (size_t)(ts + li) * RW + lc4 * 4) = *(const LAS f32x4*)(ybuf + li * 64 + lc4 * 4);
        if (c + 1 < 64) { LAS unsigned char* nb = lds + ((c + 1) & 1) * 49152;
#pragma unroll
            for (int q = 0; q < 6; ++q) *(LAS f32x4*)(nb + ((q * 32 + li) * 64 + lc4 * 4) * 4) = regs[q]; }
        __syncthreads();
    }
}

constexpr int RLD = 144, RMAT = 64 * RLD;
constexpr int R_P = 0, R_Q = 4 * RMAT, R_M = R_Q + 2 * 17408;
constexpr int R_WD = R_P, R_AD = R_P + RMAT, R_WUP = R_P + 2 * RMAT, R_AUP = R_P + 3 * RMAT;
constexpr int R_LK = R_P, R_RK = R_P + RMAT, R_RB = R_P + 2 * RMAT, R_TT = R_P + 3 * RMAT;
constexpr int R_ZW = R_Q, R_ZA = R_Q + 17408, R_LBF = R_Q, R_SEG = R_ZA, R_GC = R_ZA + 2048, R_W1T = R_ZA + 4096;
constexpr int R_A = R_M, R_AT = R_M + RMAT, R_B = R_M + 2 * RMAT, R_BPT = R_M + 3 * RMAT, R_K = R_M + 4 * RMAT, R_KPT = R_M + 5 * RMAT, R_RHO = R_M + 6 * RMAT, R_VT = R_M + 7 * RMAT;
constexpr int R_UT = R_B, R_TAT = R_K;
static_assert(R_M + 8 * RMAT <= LDS_STAGE, "R1 LDS");

__device__ __forceinline__ f32x16 tile64(const LAS unsigned char* X, const LAS unsigned char* Yt, int r32, int hi, f32x16 acc) {
#pragma unroll
    for (int s4 = 0; s4 < 4; ++s4) {
        const bf16x8 xa = *(const LAS bf16x8*)(X + r32 * RLD + 32 * s4 + 16 * hi);
        const bf16x8 yb = *(const LAS bf16x8*)(Yt + r32 * RLD + 32 * s4 + 16 * hi);
        acc = __builtin_amdgcn_mfma_f32_32x32x16_bf16(xa, yb, acc, 0, 0, 0);
    }
    return acc;
}
__device__ __forceinline__ void shift8(const bf16_t* p0, bool hm, bool hn, const float* mu, int col, float (&o)[8]) {
    const u32x4 c = *(const u32x4*)(p0 + col); u32x4 m = (u32x4){0u, 0u, 0u, 0u}, n = (u32x4){0u, 0u, 0u, 0u};
    if (hm) m = *(const u32x4*)(p0 + col - PLD);
    if (hn) n = *(const u32x4*)(p0 + col + PLD);
    const f32x4 a0 = *(const f32x4*)(mu + col), a1 = *(const f32x4*)(mu + col + 4), b0 = *(const f32x4*)(mu + RSTR + col), b1 = *(const f32x4*)(mu + RSTR + col + 4);
#pragma unroll
    for (int q = 0; q < 4; ++q) {
        const float pl = bflo(c[q]), ph = bfhi(c[q]);
        const float m0 = (q < 2) ? a0[2 * q] : a1[2 * q - 4], m1 = (q < 2) ? a0[2 * q + 1] : a1[2 * q - 3];
        const float n0 = (q < 2) ? b0[2 * q] : b1[2 * q - 4], n1 = (q < 2) ? b0[2 * q + 1] : b1[2 * q - 3];
        o[2 * q] = pl + m0 * (bflo(m[q]) - pl) + n0 * (bflo(n[q]) - pl);
        o[2 * q + 1] = ph + m1 * (bfhi(m[q]) - ph) + n1 * (bfhi(n[q]) - ph);
    }
}
__device__ __forceinline__ u32x4 pack8(const float (&x)[8]) { u32x4 w; w.x = pk2(x[0], x[1]); w.y = pk2(x[2], x[3]); w.z = pk2(x[4], x[5]); w.w = pk2(x[6], x[7]); return w; }
__device__ __forceinline__ bf16_t f2bf(float x) { return (bf16_t)(pk2(x, 0.f) & 0xffffu); }

__device__ __forceinline__ void rwkv_r1_task(const Args& a, int l, int ct, LAS unsigned char* lds) {
    const int tid = otid(), lane = tid & 63, wave = __builtin_amdgcn_readfirstlane(tid >> 6), r32 = lane & 31, hi = lane >> 5;
    const int c = ct & 31, dir = (ct >> 5) & 1, bh = ct >> 6, h = bh % 12, b = bh / 12;
    unsigned char* ws = a.ws;
    const bf16_t* P = (const bf16_t*)(ws + WS_PROJ);
    const float* mu = a.in[I_MU] + (size_t)l * 2 * RSTR;
    const int ti = tid >> 3, seg = tid & 7;
    const int tseq = dir ? (NT - 1 - 64 * c - ti) : (64 * c + ti);
    const size_t trow = (size_t)b * NT + tseq;
    float r8[8], k8[8], v8[8];
    {
        const bf16_t* p0 = P + trow * PLD + C_BS; const bool hm = tseq > 0, hn = tseq < NT - 1;
        shift8(p0, hm, hn, mu, h * 64 + 8 * seg, r8);
        shift8(p0, hm, hn, mu, 768 + h * 64 + 8 * seg, k8);
        shift8(p0, hm, hn, mu, 1536 + h * 64 + 8 * seg, v8);
        float t8[8];
        shift8(p0, hm, hn, mu, 2304 + dir * 64 + 8 * seg, t8);
#pragma unroll
        for (int q = 0; q < 8; ++q) t8[q] = tanhf(t8[q]);
        *(LAS u32x4*)(lds + R_WD + ti * RLD + 16 * seg) = pack8(t8);
        shift8(p0, hm, hn, mu, 2432 + dir * 64 + 8 * seg, t8);
        *(LAS u32x4*)(lds + R_AD + ti * RLD + 16 * seg) = pack8(t8);
        if (h == 0 && dir == 0) {
            float* GS = (float*)(ws + WS_GS) + trow * 128;
#pragma unroll
            for (int hf = 0; hf < 2; ++hf) { shift8(p0, hm, hn, mu, 2560 + 64 * hf + 8 * seg, t8);
                *(f32x4*)(GS + 64 * hf + 8 * seg) = (f32x4){sigmoidf_(t8[0]), sigmoidf_(t8[1]), sigmoidf_(t8[2]), sigmoidf_(t8[3])};
                *(f32x4*)(GS + 64 * hf + 8 * seg + 4) = (f32x4){sigmoidf_(t8[4]), sigmoidf_(t8[5]), sigmoidf_(t8[6]), sigmoidf_(t8[7])}; }
        }
        const size_t wofs = ((size_t)(l * 2 + dir) * 12 + h) * 4096 + (size_t)ti * 64 + 8 * seg;
        *(LAS u32x4*)(lds + R_WUP + ti * RLD + 16 * seg) = *(const u32x4*)((const bf16_t*)(ws + WS_MISC + MISC_WUPT) + wofs);
        *(LAS u32x4*)(lds + R_AUP + ti * RLD + 16 * seg) = *(const u32x4*)((const bf16_t*)(ws + WS_MISC + MISC_AUPT) + wofs);
        if (dir == 0) {
            float* RR = (float*)(ws + WS_RR) + trow * RW + h * 64 + 8 * seg; float* RV = (float*)(ws + WS_RV) + trow * RW + h * 64 + 8 * seg;
            *(f32x4*)RR = (f32x4){r8[0], r8[1], r8[2], r8[3]}; *(f32x4*)(RR + 4) = (f32x4){r8[4], r8[5], r8[6], r8[7]};
            *(f32x4*)RV = (f32x4){v8[0], v8[1], v8[2], v8[3]}; *(f32x4*)(RV + 4) = (f32x4){v8[4], v8[5], v8[6], v8[7]};
        }
    }
    __syncthreads();
    {
        const int p = wave >> 2, tt = wave & 3, tm = tt >> 1, tn = tt & 1;
        f32x16 acc = (f32x16){};
        acc = tile64(lds + (p ? R_AUP : R_WUP) + 32 * tm * RLD, lds + (p ? R_AD : R_WD) + 32 * tn * RLD, r32, hi, acc);
        LAS float* Z = (LAS float*)(lds + (p ? R_ZA : R_ZW));
#pragma unroll
        for (int q = 0; q < 4; ++q) *(LAS f32x4*)(Z + (32 * tn + r32) * 68 + 32 * tm + 8 * q + 4 * hi) = (f32x4){acc[4 * q], acc[4 * q + 1], acc[4 * q + 2], acc[4 * q + 3]};
    }
    __syncthreads();
    float kka8[8], kk8[8], kd8[8];
    {
        const int cb = dir * RW + h * 64 + 8 * seg;
        const float* w0 = a.in[I_W0] + (size_t)l * 2 * RW + cb; const float* a0 = a.in[I_A0] + (size_t)l * 2 * RW + cb;
        const float* kkp = a.in[I_KK] + (size_t)l * 2 * RW + cb; const float* kap = a.in[I_KA] + (size_t)l * 2 * RW + cb;
        LAS float* Zw = (LAS float*)(lds + R_ZW) + ti * 68 + 8 * seg; const LAS float* Za = (const LAS float*)(lds + R_ZA) + ti * 68 + 8 * seg;
        float nrm = 0.f, av[8], e8[8];
#pragma unroll
        for (int q = 0; q < 8; ++q) {
            const float z = w0[q] + Zw[q];
            const float u = -z; const float sp = fmaxf(u, 0.f) + log1pf(expf(-fabsf(u)));
            e8[q] = expf(-sp - 0.5f);
            av[q] = sigmoidf_(a0[q] + Za[q]);
            const float kr = k8[q] * kkp[q]; kk8[q] = kr; nrm += kr * kr;
            kd8[q] = k8[q] * (1.f + (av[q] - 1.f) * kap[q]);
        }
        nrm = dpp_sum8(nrm);
        const float rn = rsqrtf(fmaxf(nrm, 1e-24f));
#pragma unroll
        for (int q = 0; q < 8; ++q) { kk8[q] *= rn; kka8[q] = kk8[q] * av[q]; Zw[q] = e8[q]; }
        float* RKD = (float*)(ws + WS_RKD) + ((size_t)dir * NTOK + trow) * RW + h * 64 + 8 * seg;
        *(f32x4*)RKD = (f32x4){kd8[0], kd8[1], kd8[2], kd8[3]}; *(f32x4*)(RKD + 4) = (f32x4){kd8[4], kd8[5], kd8[6], kd8[7]};
    }
    __syncthreads();
    {
        const int kc = tid & 63, sg = tid >> 6;
        LAS float* Zw = (LAS float*)(lds + R_ZW); LAS float* SEG = (LAS float*)(lds + R_SEG);
        float run = 0.f;
#pragma unroll
        for (int q = 0; q < 8; ++q) { run += Zw[(8 * sg + q) * 68 + kc]; Zw[(8 * sg + q) * 68 + kc] = run; }
        SEG[sg * 64 + kc] = run;
        __syncthreads();
        float off = 0.f;
        for (int s2 = 0; s2 < sg; ++s2) off += SEG[s2 * 64 + kc];
#pragma unroll
        for (int q = 0; q < 8; ++q) Zw[(8 * sg + q) * 68 + kc] += off;
    }
    __syncthreads();
    {
        const LAS float* G = (const LAS float*)(lds + R_ZW);
        float al[8], be[8], bp[8], ka[8], kp[8], rh[8];
#pragma unroll
        for (int q = 0; q < 8; ++q) {
            const float gi = G[ti * 68 + 8 * seg + q], gm = ti > 0 ? G[(ti - 1) * 68 + 8 * seg + q] : 0.f, g63 = G[63 * 68 + 8 * seg + q];
            const float ig = expf(gi), tl = expf(gi - g63);
            al[q] = expf(-gm) * kk8[q]; be[q] = kka8[q] * ig; bp[q] = kka8[q] * tl; ka[q] = kd8[q] * ig; kp[q] = kd8[q] * tl; rh[q] = r8[q] * expf(-gi);
            if (ti == 63) ((LAS float*)(lds + R_GC))[8 * seg + q] = expf(-g63);
        }
        *(LAS u32x4*)(lds + R_A + ti * RLD + 16 * seg) = pack8(al);
        *(LAS u32x4*)(lds + R_B + ti * RLD + 16 * seg) = pack8(be);
        *(LAS u32x4*)(lds + R_K + ti * RLD + 16 * seg) = pack8(ka);
        *(LAS u32x4*)(lds + R_RHO + ti * RLD + 16 * seg) = pack8(rh);
#pragma unroll
        for (int q = 0; q < 8; ++q) { const int ro = (8 * seg + q) * RLD + 2 * ti;
            *(LAS bf16_t*)(lds + R_AT + ro) = f2bf(al[q]); *(LAS bf16_t*)(lds + R_BPT + ro) = f2bf(bp[q]);
            *(LAS bf16_t*)(lds + R_KPT + ro) = f2bf(kp[q]); *(LAS bf16_t*)(lds + R_VT + ro) = f2bf(v8[q]); }
    }
    __syncthreads();
    {
        const int tt = wave & 3, tm = tt >> 1, tn = tt & 1;
        const int jb = 32 * tm, ib = 32 * tn, i = ib + r32;
        f32x16 acc0 = (f32x16){}, acc1 = (f32x16){};
        if (tm <= tn) {
            const LAS unsigned char* Yt = lds + (wave < 4 ? R_A : R_RHO) + ib * RLD;
            acc0 = tile64(lds + (wave < 4 ? R_B : R_K) + jb * RLD, Yt, r32, hi, acc0);
            acc1 = tile64(lds + (wave < 4 ? R_K : R_B) + jb * RLD, Yt, r32, hi, acc1);
        }
#pragma unroll
        for (int rg = 0; rg < 16; ++rg) { const int j = jb + crow(rg, hi); const bool keep = (wave < 4) ? (j < i) : (j <= i);
            acc0[rg] = keep ? acc0[rg] : 0.f; acc1[rg] = keep ? acc1[rg] : 0.f; }
#pragma unroll
        for (int q = 0; q < 4; ++q) { const int jo = jb + 8 * q + 4 * hi;
            u32x2 w1; w1.x = pk2(acc1[4 * q], acc1[4 * q + 1]); w1.y = pk2(acc1[4 * q + 2], acc1[4 * q + 3]);
            if (wave < 4) {
                *(LAS f32x4*)((LAS float*)(lds + R_LBF) + i * 68 + jo) = (f32x4){acc0[4 * q], acc0[4 * q + 1], acc0[4 * q + 2], acc0[4 * q + 3]};
                *(LAS u32x2*)(lds + R_LK + i * RLD + 2 * jo) = w1;
            } else {
                u32x2 w0; w0.x = pk2(acc0[4 * q], acc0[4 * q + 1]); w0.y = pk2(acc0[4 * q + 2], acc0[4 * q + 3]);
                *(LAS u32x2*)(lds + R_RK + i * RLD + 2 * jo) = w0;
                *(LAS u32x2*)(lds + R_RB + i * RLD + 2 * jo) = w1;
            } }
    }
    __syncthreads();
    if (wave == 0) {
        const LAS float* Lf = (const LAS float*)(lds + R_LBF);
        float Tm[64];
#pragma unroll
        for (int i = 0; i < 64; ++i) {
            float acc = (lane == i) ? 1.f : 0.f;
#pragma unroll
            for (int m4 = 0; m4 < (i + 3) / 4; ++m4) { const f32x4 l4 = *(const LAS f32x4*)(Lf + i * 68 + 4 * m4);
#pragma unroll
                for (int e = 0; e < 4; ++e) if (4 * m4 + e < i) acc -= l4[e] * Tm[4 * m4 + e]; }
            Tm[i] = acc;
            *(LAS bf16_t*)(lds + R_TT + i * RLD + 2 * lane) = f2bf(acc);
        }
    } else if (wave >= 4) {
        const int tt = wave & 3, tm = tt >> 1, tn = tt & 1;
        f32x16 acc = (f32x16){};
        acc = tile64(lds + R_LK + 32 * tm * RLD, lds + R_VT + 32 * tn * RLD, r32, hi, acc);
#pragma unroll
        for (int q = 0; q < 4; ++q) { u32x2 w; w.x = pk2(acc[4 * q], acc[4 * q + 1]); w.y = pk2(acc[4 * q + 2], acc[4 * q + 3]);
            *(LAS u32x2*)(lds + R_W1T + (32 * tn + r32) * RLD + 2 * (32 * tm + 8 * q + 4 * hi)) = w; }
    }
    __syncthreads();
    {
        const int tt = wave & 3, tm = tt >> 1, tn = tt & 1;
        f32x16 acc = (f32x16){};
        acc = tile64(lds + R_TT + 32 * tm * RLD, lds + (wave < 4 ? R_W1T : R_AT) + 32 * tn * RLD, r32, hi, acc);
        LAS unsigned char* dst = lds + (wave < 4 ? R_UT : R_TAT);
#pragma unroll
        for (int q = 0; q < 4; ++q) { u32x2 w; w.x = pk2(acc[4 * q], acc[4 * q + 1]); w.y = pk2(acc[4 * q + 2], acc[4 * q + 3]);
            *(LAS u32x2*)(dst + (32 * tn + r32) * RLD + 2 * (32 * tm + 8 * q + 4 * hi)) = w; }
    }
    __syncthreads();
    {
        const int tt = wave & 3, tm = tt >> 1, tn = tt & 1;
        const size_t cto = (size_t)ct * 4096;
        if (wave < 4) {
            f32x16 acc = (f32x16){};
            acc = tile64(lds + R_TAT + 32 * tm * RLD, lds + R_RB + 32 * tn * RLD, r32, hi, acc);
            bf16_t* QA = (bf16_t*)(ws + WS_QA) + cto;
#pragma unroll
            for (int q = 0; q < 4; ++q) { const int i = 32 * tn + r32, k = 32 * tm + 8 * q + 4 * hi;
                const u32x2 rv = *(const LAS u32x2*)(lds + R_RHO + i * RLD + 2 * k);
                u32x2 w; w.x = pk2(bflo(rv.x) - acc[4 * q], bfhi(rv.x) - acc[4 * q + 1]); w.y = pk2(bflo(rv.y) - acc[4 * q + 2], bfhi(rv.y) - acc[4 * q + 3]);
                *(u32x2*)(QA + i * 64 + k) = w; }
            f32x16 am = (f32x16){};
            am = tile64(lds + R_BPT + 32 * tm * RLD, lds + R_TAT + 32 * tn * RLD, r32, hi, am);
            float* MP = (float*)(ws + WS_MP) + cto; const LAS float* GC = (const LAS float*)(lds + R_GC);
#pragma unroll
            for (int q = 0; q < 4; ++q) { const int k = 32 * tn + r32, kp0 = 32 * tm + 8 * q + 4 * hi; f32x4 o4;
#pragma unroll
                for (int e = 0; e < 4; ++e) o4[e] = ((kp0 + e == k) ? GC[kp0 + e] : 0.f) - am[4 * q + e];
                *(f32x4*)(MP + k * 64 + kp0) = o4; }
        } else {
            f32x16 a1 = (f32x16){}, a2 = (f32x16){};
            a1 = tile64(lds + R_VT + 32 * tm * RLD, lds + R_RK + 32 * tn * RLD, r32, hi, a1);
            a2 = tile64(lds + R_UT + 32 * tm * RLD, lds + R_RB + 32 * tn * RLD, r32, hi, a2);
            float* Y0 = (float*)(ws + WS_Y0) + cto;
#pragma unroll
            for (int q = 0; q < 4; ++q) *(f32x4*)(Y0 + (32 * tn + r32) * 64 + 32 * tm + 8 * q + 4 * hi) = (f32x4){a1[4 * q] - a2[4 * q], a1[4 * q + 1] - a2[4 * q + 1], a1[4 * q + 2] - a2[4 * q + 2], a1[4 * q + 3] - a2[4 * q + 3]};
            f32x16 n1 = (f32x16){}, n2 = (f32x16){};
            n1 = tile64(lds + R_KPT + 32 * tm * RLD, lds + R_VT + 32 * tn * RLD, r32, hi, n1);
            n2 = tile64(lds + R_BPT + 32 * tm * RLD, lds + R_UT + 32 * tn * RLD, r32, hi, n2);
            float* NP = (float*)(ws + WS_NP) + cto;
#pragma unroll
            for (int q = 0; q < 4; ++q) *(f32x4*)(NP + (32 * tn + r32) * 64 + 32 * tm + 8 * q + 4 * hi) = (f32x4){n1[4 * q] - n2[4 * q], n1[4 * q + 1] - n2[4 * q + 1], n1[4 * q + 2] - n2[4 * q + 2], n1[4 * q + 3] - n2[4 * q + 3]};
        }
    }
    __syncthreads();
}

__device__ __forceinline__ void rwkv_r2_unit(const Args& a, int unit, LAS unsigned char* lds) {
    const int tid = otid(), lane = tid & 63, wave = __builtin_amdgcn_readfirstlane(tid >> 6);
    unsigned char* ws = a.ws;
    LAS float* S = (LAS float*)lds;
    const int vb = wave >> 1, kb0 = 2 * (wave & 1), l15 = lane & 15, lq = lane >> 4;
    for (int i = tid; i < 64 * 68; i += 512) S[i] = 0.f;
    const float* MPb = (const float*)(ws + WS_MP) + (size_t)unit * 32 * 4096; const float* NPb = (const float*)(ws + WS_NP) + (size_t)unit * 32 * 4096;
    bf16_t* SSb = (bf16_t*)(ws + WS_SS) + (size_t)unit * 32 * 4096;
    float Bm[2][16]; f32x4 acc[2];
#pragma unroll
    for (int t2 = 0; t2 < 2; ++t2) {
#pragma unroll
        for (int ks = 0; ks < 16; ++ks) Bm[t2][ks] = MPb[(4 * ks + lq) * 64 + 16 * (kb0 + t2) + l15];
#pragma unroll
        for (int rg = 0; rg < 4; ++rg) acc[t2][rg] = NPb[(16 * vb + 4 * lq + rg) * 64 + 16 * (kb0 + t2) + l15]; }
    __syncthreads();
    for (int c = 0; c < 32; ++c) {
        { const int v = tid >> 3, sg = tid & 7; const LAS float* sp = S + v * 68 + 8 * sg; float x[8];
#pragma unroll
          for (int q = 0; q < 8; ++q) x[q] = sp[q];
          *(u32x4*)(SSb + (size_t)c * 4096 + v * 64 + 8 * sg) = pack8(x); }
#pragma unroll
        for (int ks = 0; ks < 16; ++ks) { const float av = S[(16 * vb + l15) * 68 + 4 * ks + lq];
            acc[0] = __builtin_amdgcn_mfma_f32_16x16x4f32(av, Bm[0][ks], acc[0], 0, 0, 0);
            acc[1] = __builtin_amdgcn_mfma_f32_16x16x4f32(av, Bm[1][ks], acc[1], 0, 0, 0); }
        __syncthreads();
#pragma unroll
        for (int t2 = 0; t2 < 2; ++t2)
#pragma unroll
            for (int rg = 0; rg < 4; ++rg) S[(16 * vb + 4 * lq + rg) * 68 + 16 * (kb0 + t2) + l15] = acc[t2][rg];
        if (c + 1 < 32) { const float* MPc = MPb + (size_t)(c + 1) * 4096; const float* NPc = NPb + (size_t)(c + 1) * 4096;
#pragma unroll
            for (int t2 = 0; t2 < 2; ++t2) {
#pragma unroll
                for (int ks = 0; ks < 16; ++ks) Bm[t2][ks] = MPc[(4 * ks + lq) * 64 + 16 * (kb0 + t2) + l15];
#pragma unroll
                for (int rg = 0; rg < 4; ++rg) acc[t2][rg] = NPc[(16 * vb + 4 * lq + rg) * 64 + 16 * (kb0 + t2) + l15]; } }
        __syncthreads();
    }
}

__device__ __forceinline__ void phase_rwkv_r3(const Args& a) {
    const int tid = otid(), lane = tid & 63, wave = tid >> 6, r32 = lane & 31, hi = lane >> 5;
    unsigned char* ws = a.ws;
    for (int wt = blockIdx.x * 8 + wave; wt < 6144 * 4; wt += gridDim.x * 8) {
        const int ct = wt >> 2, tt = wt & 3, tm = tt >> 1, tn = tt & 1;
        const int c = ct & 31, dir = (ct >> 5) & 1, bh = ct >> 6, h = bh % 12, b = bh / 12;
        const bf16_t* SS = (const bf16_t*)(ws + WS_SS) + (size_t)ct * 4096; const bf16_t* QA = (const bf16_t*)(ws + WS_QA) + (size_t)ct * 4096;
        const float* Y0 = (const float*)(ws + WS_Y0) + (size_t)ct * 4096;
        const int i = 32 * tn + r32;
        f32x16 acc;
#pragma unroll
        for (int q = 0; q < 4; ++q) { const f32x4 y = *(const f32x4*)(Y0 + i * 64 + 32 * tm + 8 * q + 4 * hi); acc[4 * q] = y.x; acc[4 * q + 1] = y.y; acc[4 * q + 2] = y.z; acc[4 * q + 3] = y.w; }
#pragma unroll
        for (int s4 = 0; s4 < 4; ++s4) {
            const bf16x8 xa = *(const bf16x8*)(SS + (32 * tm + r32) * 64 + 16 * s4 + 8 * hi);
            const bf16x8 yb = *(const bf16x8*)(QA + i * 64 + 16 * s4 + 8 * hi);
            acc = __builtin_amdgcn_mfma_f32_32x32x16_bf16(xa, yb, acc, 0, 0, 0);
        }
        const int tseq = dir ? (NT - 1 - 64 * c - i) : (64 * c + i);
        float* Y = (float*)(ws + WS_Y) + ((size_t)dir * NTOK + (size_t)b * NT + tseq) * RW + h * 64 + 32 * tm;
#pragma unroll
        for (int q = 0; q < 4; ++q) *(f32x4*)(Y + 8 * q + 4 * hi) = (f32x4){acc[4 * q], acc[4 * q + 1], acc[4 * q + 2], acc[4 * q + 3]};
    }
}

__device__ __forceinline__ void diffattn_unit(const Args& a, int l, int unit, LAS unsigned char* lds) {
    constexpr int RS = 272;
    const int b = unit / 96; const int rem = unit - b * 96; const int h = rem >> 4, qb = rem & 15;
    const int tid = otid(), lane = tid & 63, wave = __builtin_amdgcn_readfirstlane(tid >> 6), r32 = lane & 31, hi = lane >> 5;
    const int c = wave & 1, qblk = wave >> 1;
    const int q0 = qb * 128 + qblk * 32;
    const bf16_t* P = (const bf16_t*)(a.ws + WS_PROJ);
    const size_t rowb = (size_t)b * NT;
    bf16x8 qf[4];
    { const bf16_t* qp = P + (rowb + q0 + r32) * PLD + C_CQ + h * 128 + c * 64 + 8 * hi;
#pragma unroll
      for (int s4 = 0; s4 < 4; ++s4) qf[s4] = *(const bf16x8*)(qp + 16 * s4); }
    LAS float* biasL = (LAS float*)(lds + 69632);
    { const float* bC = (const float*)(a.ws + WS_MISC + MISC_BIASC) + h * 257;
      for (int i = tid; i < 257; i += 512) biasL[i] = bC[i]; }
    const int srow0 = tid >> 4, sch = tid & 15;
    const bf16_t* kg = P + (rowb + srow0) * PLD + C_CK + h * 128 + sch * 8;
    const bf16_t* vg = P + (rowb + srow0) * PLD + C_CV + h * 128 + sch * 8;
    u32x4 kr[2], vr[2];
#pragma unroll
    for (int i = 0; i < 2; ++i) { kr[i] = *(const u32x4*)(kg + (size_t)(32 * i) * PLD); vr[i] = *(const u32x4*)(vg + (size_t)(32 * i) * PLD); }
#pragma unroll
    for (int i = 0; i < 2; ++i) { *(LAS u32x4*)(lds + (srow0 + 32 * i) * RS + sch * 16) = kr[i]; *(LAS u32x4*)(lds + 34816 + (srow0 + 32 * i) * RS + sch * 16) = vr[i]; }
    __syncthreads();
    f32x16 o[4];
#pragma unroll
    for (int db = 0; db < 4; ++db) o[db] = (f32x16){};
    float m = -1e30f, lsum = 0.f;
    const float SC = 0.125f * LOG2E;
    const int trb = (4 * hi + ((lane & 15) >> 2)) * RS + (16 * ((lane >> 4) & 1) + 4 * (lane & 3)) * 2;
    const int qabs = q0 + r32;
    for (int t = 0; t < 32; ++t) {
        if (t + 1 < 32) {
#pragma unroll
            for (int i = 0; i < 2; ++i) { kr[i] = *(const u32x4*)(kg + (size_t)(64 * (t + 1) + 32 * i) * PLD); vr[i] = *(const u32x4*)(vg + (size_t)(64 * (t + 1) + 32 * i) * PLD); } }
        const LAS unsigned char* Kb = lds + (t & 1) * 17408;
        const LAS unsigned char* Vb = lds + 34816 + (t & 1) * 17408;
        f32x16 sa0 = (f32x16){}, sa1 = (f32x16){};
#pragma unroll
        for (int s4 = 0; s4 < 4; ++s4) {
            const bf16x8 kf0 = *(const LAS bf16x8*)(Kb + r32 * RS + c * 128 + 32 * s4 + 16 * hi);
            const bf16x8 kf1 = *(const LAS bf16x8*)(Kb + (32 + r32) * RS + c * 128 + 32 * s4 + 16 * hi);
            sa0 = __builtin_amdgcn_mfma_f32_32x32x16_bf16(kf0, qf[s4], sa0, 0, 0, 0);
            sa1 = __builtin_amdgcn_mfma_f32_32x32x16_bf16(kf1, qf[s4], sa1, 0, 0, 0);
        }
        float x0[16], x1[16];
        const int kv0 = 64 * t;
        const bool farp = (kv0 >= q0 + 31 + 128), farn = (kv0 + 63 + 128 <= q0);
        if (farp || farn) { const float cb = farp ? biasL[256] : biasL[0];
#pragma unroll
            for (int rg = 0; rg < 16; ++rg) { x0[rg] = sa0[rg] * SC + cb; x1[rg] = sa1[rg] * SC + cb; }
        } else {
#pragma unroll
            for (int rg = 0; rg < 16; ++rg) { int rel = kv0 + crow(rg, hi) - qabs; int rc = rel < -128 ? -128 : (rel > 128 ? 128 : rel);
                x0[rg] = sa0[rg] * SC + biasL[rc + 128];
                rel += 32; rc = rel < -128 ? -128 : (rel > 128 ? 128 : rel);
                x1[rg] = sa1[rg] * SC + biasL[rc + 128]; }
        }
        float mx = fmaxf(x0[0], x1[0]);
#pragma unroll
        for (int rg = 1; rg < 16; ++rg) mx = fmaxf(mx, fmaxf(x0[rg], x1[rg]));
        mx = fmaxf(mx, __shfl_xor(mx, 32));
        const float mn = fmaxf(m, mx), alpha = __builtin_amdgcn_exp2f(m - mn); m = mn;
        float ps = 0.f;
#pragma unroll
        for (int rg = 0; rg < 16; ++rg) { x0[rg] = __builtin_amdgcn_exp2f(x0[rg] - mn); x1[rg] = __builtin_amdgcn_exp2f(x1[rg] - mn); ps += x0[rg] + x1[rg]; }
        lsum = lsum * alpha + ps;
#pragma unroll
        for (int db = 0; db < 4; ++db)
#pragma unroll
            for (int rg = 0; rg < 16; ++rg) o[db][rg] *= alpha;
        u32x4 pw[4];
#pragma unroll
        for (int s2 = 0; s2 < 2; ++s2) {
            pw[s2].x = pk2(x0[8 * s2 + 0], x0[8 * s2 + 1]); pw[s2].y = pk2(x0[8 * s2 + 2], x0[8 * s2 + 3]); pw[s2].z = pk2(x0[8 * s2 + 4], x0[8 * s2 + 5]); pw[s2].w = pk2(x0[8 * s2 + 6], x0[8 * s2 + 7]);
            pw[2 + s2].x = pk2(x1[8 * s2 + 0], x1[8 * s2 + 1]); pw[2 + s2].y = pk2(x1[8 * s2 + 2], x1[8 * s2 + 3]); pw[2 + s2].z = pk2(x1[8 * s2 + 4], x1[8 * s2 + 5]); pw[2 + s2].w = pk2(x1[8 * s2 + 6], x1[8 * s2 + 7]); }
#pragma unroll
        for (int db = 0; db < 4; ++db)
#pragma unroll
            for (int s = 0; s < 4; ++s) {
                const s16x4 lo = vtr(Vb + trb + (16 * s) * RS + db * 64);
                const s16x4 hi4 = vtr(Vb + trb + (16 * s + 8) * RS + db * 64);
                const bf16x8 af = (bf16x8){lo[0], lo[1], lo[2], lo[3], hi4[0], hi4[1], hi4[2], hi4[3]};
                o[db] = __builtin_amdgcn_mfma_f32_32x32x16_bf16(af, __builtin_bit_cast(bf16x8, pw[s]), o[db], 0, 0, 0);
            }
        if (t + 1 < 32) { LAS unsigned char* Kn = lds + ((t + 1) & 1) * 17408; LAS unsigned char* Vn = lds + 34816 + ((t + 1) & 1) * 17408;
#pragma unroll
            for (int i = 0; i < 2; ++i) { *(LAS u32x4*)(Kn + (srow0 + 32 * i) * RS + sch * 16) = kr[i]; *(LAS u32x4*)(Vn + (srow0 + 32 * i) * RS + sch * 16) = vr[i]; } }
        __syncthreads();
    }
    const float lt = lsum + __shfl_xor(lsum, 32);
    const float inv = 1.f / lt;
    const float* lamp = (const float*)(a.ws + WS_MISC + MISC_LAM);
    const float lam = lamp[l], linit = lamp[2 + l];
    LAS float* XO = (LAS float*)lds;
    if (c == 1) {
        const float f = inv * lam;
#pragma unroll
        for (int db = 0; db < 4; ++db)
#pragma unroll
            for (int rg = 0; rg < 16; ++rg) XO[(qblk * 64 + db * 16 + rg) * 64 + lane] = o[db][rg] * f;
    }
    __syncthreads();
    if (c == 0) {
        float ss = 0.f;
#pragma unroll
        for (int db = 0; db < 4; ++db)
#pragma unroll
            for (int rg = 0; rg < 16; ++rg) { const float v = o[db][rg] * inv - XO[(qblk * 64 + db * 16 + rg) * 64 + lane]; o[db][rg] = v; ss += v * v; }
        ss += __shfl_xor(ss, 32);
        const float sc = rsqrtf(ss * (1.f / 128.f) + 1e-5f) * (1.f - linit);
        const float* sg = a.in[I_SUBG] + (size_t)l * 128;
        bf16_t* op = (bf16_t*)(a.ws + WS_OC) + (rowb + q0 + r32) * 768 + h * 128;
#pragma unroll
        for (int db = 0; db < 4; ++db)
#pragma unroll
            for (int i = 0; i < 4; ++i) { const int d = db * 32 + 8 * i + 4 * hi; const f32x4 g4 = *(const f32x4*)(sg + d);
                u32x2 w; w.x = pk2(o[db][4 * i] * sc * g4.x, o[db][4 * i + 1] * sc * g4.y); w.y = pk2(o[db][4 * i + 2] * sc * g4.z, o[db][4 * i + 3] * sc * g4.w);
                *(u32x2*)(op + d) = w; }
    }
    __syncthreads();
}

__device__ __forceinline__ void phase_post(const Args& a, int l) {
    const int tid = otid(), lane = tid & 63, wave = tid >> 6;
    unsigned char* ws = a.ws;
    const float* OAG = (const float*)(ws + WS_OAG); const float* LSE = (const float*)(ws + WS_LSE);
    bf16_t* OA = (bf16_t*)(ws + WS_OA); bf16_t* OB = (bf16_t*)(ws + WS_OB);
    const float* GS = (const float*)(ws + WS_GS); const float* Y = (const float*)(ws + WS_Y);
    const float* RR = (const float*)(ws + WS_RR); const float* RV = (const float*)(ws + WS_RV); const float* RKD = (const float*)(ws + WS_RKD);
    const float* gup = a.in[I_GUP] + (size_t)l * 128 * RW;
    const float* rk = a.in[I_RK] + (size_t)l * RW; const float* lng = a.in[I_LNG] + (size_t)l * RW; const float* lnb = a.in[I_LNB] + (size_t)l * RW;
    for (int task = blockIdx.x * 8 + wave; task < NTOK / 4; task += gridDim.x * 8) {
        const int t0 = task * 4;
#pragma unroll
        for (int tk = 0; tk < 4; ++tk) { const size_t t = t0 + tk; const int hh = lane >> 4;
            const float l0 = LSE[((size_t)0 * NTOK + t) * 4 + hh], l1 = LSE[((size_t)1 * NTOK + t) * 4 + hh], l2 = LSE[((size_t)2 * NTOK + t) * 4 + hh];
            const float mx = fmaxf(l0, fmaxf(l1, l2));
            const float w0 = __builtin_amdgcn_exp2f(l0 - mx), w1 = __builtin_amdgcn_exp2f(l1 - mx), w2 = __builtin_amdgcn_exp2f(l2 - mx);
            const float inv = 1.f / (w0 + w1 + w2);
            const f32x4 o0 = *(const f32x4*)(OAG + ((size_t)0 * NTOK + t) * 256 + lane * 4), o1 = *(const f32x4*)(OAG + ((size_t)1 * NTOK + t) * 256 + lane * 4), o2 = *(const f32x4*)(OAG + ((size_t)2 * NTOK + t) * 256 + lane * 4);
            const f32x4 r = (o0 * w0 + o1 * w1 + o2 * w2) * inv;
            u32x2 w; w.x = pk2(r.x, r.y); w.y = pk2(r.z, r.w);
            *(u32x2*)(OA + t * 256 + lane * 4) = w; }
        float gsr[4][2];
#pragma unroll
        for (int tk = 0; tk < 4; ++tk) { gsr[tk][0] = GS[(size_t)(t0 + tk) * 128 + lane]; gsr[tk][1] = GS[(size_t)(t0 + tk) * 128 + 64 + lane]; }
        float gacc[12][4];
#pragma unroll
        for (int i = 0; i < 12; ++i)
#pragma unroll
            for (int tk = 0; tk < 4; ++tk) gacc[i][tk] = 0.f;
#pragma unroll
        for (int jh = 0; jh < 2; ++jh)
            for (int j = 0; j < 64; ++j) {
                float gv[4];
#pragma unroll
                for (int tk = 0; tk < 4; ++tk) gv[tk] = __builtin_bit_cast(float, __builtin_amdgcn_readlane(__builtin_bit_cast(int, gsr[tk][jh]), j));
                const float* gp = gup + (size_t)(jh * 64 + j) * RW + lane;
#pragma unroll
                for (int i = 0; i < 12; ++i) { const float gu = gp[i * 64];
#pragma unroll
                    for (int tk = 0; tk < 4; ++tk) gacc[i][tk] += gv[tk] * gu; }
            }
#pragma unroll
        for (int tk = 0; tk < 4; ++tk) { const size_t t = t0 + tk;
#pragma unroll
            for (int i = 0; i < 12; ++i) { const int c = i * 64 + lane;
                const float y = Y[t * RW + c] + Y[((size_t)NTOK + t) * RW + c];
                const float mean = wave_sum(y) * (1.f / 64.f);
                const float dv = y - mean;
                const float var = wave_sum(dv * dv) * (1.f / 64.f);
                const float yn = dv * rsqrtf(var + 64e-5f) * lng[c] + lnb[c];
                const float r = RR[t * RW + c], v = RV[t * RW + c], rkc = rk[c];
                const float s0 = wave_sum(r * RKD[t * RW + c] * rkc), s1 = wave_sum(r * RKD[((size_t)NTOK + t) * RW + c] * rkc);
                const float outv = (yn + (s0 + s1) * v) * gacc[i][tk];
                OB[t * RW + c] = (bf16_t)(pk2(outv, 0.f) & 0xffffu); } }
    }
}

__device__ __forceinline__ void phase_route(const Args& a, int l, LAS unsigned char* lds) {
    const int tid = otid(), lane = tid & 63, wave = tid >> 6;
    unsigned char* ws = a.ws;
    LAS float* rwT = (LAS float*)lds;
    { const float* rw = a.in[I_RW] + (size_t)l * DM * NE;
      for (int idx = tid; idx < NE * DM; idx += 512) { const int e = idx >> 10, k = idx & 1023; rwT[idx] = rw[k * NE + e]; } }
    __syncthreads();
    const float* X = (const float*)(ws + WS_X);
    const float* mod = (const float*)(ws + WS_MISC + MISC_MOD) + (size_t)l * 8 * 6144;
    bf16_t* H = (bf16_t*)(ws + WS_H);
    unsigned* cnt = (unsigned*)(ws + WS_CTL) + CW_CNT + l * 32;
    int* LIST = (int*)(ws + WS_LIST); unsigned* TOKE = (unsigned*)(ws + WS_TOKE); float* TOKP = (float*)(ws + WS_TOKP);
    const float* g2 = a.in[I_N2G] + (size_t)l * DM; const float* rb = a.in[I_RB] + (size_t)l * NE;
    for (int t = blockIdx.x * 8 + wave; t < NTOK; t += gridDim.x * 8) {
        f32x4 v[4];
#pragma unroll
        for (int j = 0; j < 4; ++j) v[j] = *(const f32x4*)(X + (size_t)t * DM + 4 * lane + 256 * j);
        const float rstd = row_rstd(v, 1e-6f);
        const float* mb = mod + (size_t)(t >> 11) * 6144;
        f32x4 hv[4];
#pragma unroll
        for (int j = 0; j < 4; ++j) { const int c = 4 * lane + 256 * j;
            const f32x4 gv = *(const f32x4*)(g2 + c), scv = *(const f32x4*)(mb + 4096 + c), shv = *(const f32x4*)(mb + 3072 + c);
            hv[j] = v[j] * rstd * gv * (scv + 1.0f) + shv;
            u32x2 w; w.x = pk2(hv[j].x, hv[j].y); w.y = pk2(hv[j].z, hv[j].w);
            *(u32x2*)(H + (size_t)t * DM + c) = w; }
        float p[32];
#pragma unroll
        for (int e = 0; e < 32; ++e) { float s = 0.f;
#pragma unroll
            for (int j = 0; j < 4; ++j) { const f32x4 w = *(const LAS f32x4*)(rwT + e * 1024 + 4 * lane + 256 * j);
                s += hv[j].x * w.x + hv[j].y * w.y + hv[j].z * w.z + hv[j].w * w.w; }
            p[e] = s; asm volatile("" ::: "memory"); }
#pragma unroll
        for (int e = 0; e < 32; ++e) p[e] += __shfl_xor(p[e], 32);
#pragma unroll
        for (int i = 0; i < 16; ++i) { const bool up = (lane & 16) != 0; const float send = up ? p[i] : p[i + 16], keep = up ? p[i + 16] : p[i]; p[i] = keep + __shfl_xor(send, 16); }
#pragma unroll
        for (int i = 0; i < 8; ++i) { const bool up = (lane & 8) != 0; const float send = up ? p[i] : p[i + 8], keep = up ? p[i + 8] : p[i]; p[i] = keep + __shfl_xor(send, 8); }
#pragma unroll
        for (int i = 0; i < 4; ++i) { const bool up = (lane & 4) != 0; const float send = up ? p[i] : p[i + 4], keep = up ? p[i + 4] : p[i]; p[i] = keep + __shfl_xor(send, 4); }
#pragma unroll
        for (int i = 0; i < 2; ++i) { const bool up = (lane & 2) != 0; const float send = up ? p[i] : p[i + 2], keep = up ? p[i + 2] : p[i]; p[i] = keep + __shfl_xor(send, 2); }
        { const bool up = (lane & 1) != 0; const float send = up ? p[0] : p[1], keep = up ? p[1] : p[0]; p[0] = keep + __shfl_xor(send, 1); }
        const int myidx = lane & 31;
        float cur = p[0] + rb[myidx];
        float tv[4]; int ti[4];
#pragma unroll
        for (int k = 0; k < 4; ++k) { float bv = cur; int bi = myidx;
#pragma unroll
            for (int off = 16; off >= 1; off >>= 1) { const float ov = __shfl_xor(bv, off); const int oi = __shfl_xor(bi, off);
                const bool take = (ov > bv) || (ov == bv && oi < bi); bv = take ? ov : bv; bi = take ? oi : bi; }
            tv[k] = bv; ti[k] = bi; if (myidx == bi) cur = -INFINITY; }
        const float e1 = expf(tv[1] - tv[0]), e2 = expf(tv[2] - tv[0]), e3 = expf(tv[3] - tv[0]);
        const float inv = 1.f / (1.f + e1 + e2 + e3);
        if (lane < 4) { const int e = lane == 0 ? ti[0] : lane == 1 ? ti[1] : lane == 2 ? ti[2] : ti[3];
            const float pr = (lane == 0 ? 1.f : lane == 1 ? e1 : lane == 2 ? e2 : e3) * inv;
            const unsigned pos = __hip_atomic_fetch_add(cnt + e, 1u, __ATOMIC_RELAXED, __HIP_MEMORY_SCOPE_AGENT);
            LIST[(size_t)e * NTOK + pos] = t; TOKE[(size_t)t * 4 + lane] = ((unsigned)e << 16) | pos; TOKP[(size_t)t * 4 + lane] = pr; }
    }
    __syncthreads();
}

__device__ __forceinline__ void build_moe_tab(const Args& a, int l, volatile LAS int* tab) {
    const unsigned* cnt = (const unsigned*)(a.ws + WS_CTL) + CW_CNT + l * 32;
    const int tid = otid();
    __syncthreads();
    if (tid < 32) tab[64 + tid] = (int)__hip_atomic_load(cnt + tid, __ATOMIC_RELAXED, __HIP_MEMORY_SCOPE_AGENT);
    __syncthreads();
    if (tid == 0) { int s = 0; for (int e = 0; e < 32; ++e) { tab[e] = s; s += (tab[64 + e] + 255) >> 8; } tab[32] = s; }
    __syncthreads();
}

__device__ __forceinline__ void phase_combine(const Args& a, int l, const LAS int* tab) {
    const int tid = otid(), lane = tid & 63, wave = tid >> 6;
    unsigned char* ws = a.ws;
    float* X = (float*)(ws + WS_X);
    const bf16_t* YM = (const bf16_t*)(ws + WS_YMOE);
    const unsigned* TOKE = (const unsigned*)(ws + WS_TOKE); const float* TOKP = (const float*)(ws + WS_TOKP);
    const float* modl = (const float*)(ws + WS_MISC + MISC_MOD) + (size_t)l * 8 * 6144;
    for (int t = blockIdx.x * 8 + wave; t < NTOK; t += gridDim.x * 8) {
        f32x4 v[4], acc[4];
#pragma unroll
        for (int j = 0; j < 4; ++j) { v[j] = *(const f32x4*)(X + (size_t)t * DM + 4 * lane + 256 * j); acc[j] = (f32x4){0.f, 0.f, 0.f, 0.f}; }
#pragma unroll
        for (int k = 0; k < 4; ++k) { const unsigned ep = TOKE[(size_t)t * 4 + k]; const float pr = TOKP[(size_t)t * 4 + k];
            const int e = ep >> 16, pos = ep & 0xffff; const size_t srow = (size_t)tab[e] * 256 + pos;
#pragma unroll
            for (int j = 0; j < 4; ++j) { const u32x2 y = *(const u32x2*)(YM + srow * DM + 4 * lane + 256 * j);
                acc[j].x += pr * bflo(y.x); acc[j].y += pr * bfhi(y.x); acc[j].z += pr * bflo(y.y); acc[j].w += pr * bfhi(y.y); } }
        const float* mb = modl + (size_t)(t >> 11) * 6144;
#pragma unroll
        for (int j = 0; j < 4; ++j) { const f32x4 gt = *(const f32x4*)(mb + 5120 + 4 * lane + 256 * j); v[j] = v[j] + gt * acc[j]; }
        const float rstd = row_rstd(v, 1e-6f);
        if (l + 1 < DEPTH) {
#pragma unroll
            for (int j = 0; j < 4; ++j) *(f32x4*)(X + (size_t)t * DM + 4 * lane + 256 * j) = v[j];
            const float* mn = modl + (size_t)8 * 6144 + (size_t)(t >> 11) * 6144;
            norm_mod_store(v, rstd, a.in[I_N1G] + (size_t)(l + 1) * DM, mn + 1024, mn, (bf16_t*)(ws + WS_H) + (size_t)t * DM, lane);
        } else {
#pragma unroll
            for (int j = 0; j < 4; ++j) { const int c = 4 * lane + 256 * j; const f32x4 g = *(const f32x4*)(a.in[I_FNG] + c);
                *(f32x4*)(a.out + (size_t)t * DM + c) = v[j] * rstd * g; }
        }
    }
}

constexpr int NPL = 11;
constexpr int N_PHASES = 2 + NPL * DEPTH;
__global__ void __launch_bounds__(512, 2) fwd(Args a) {
    extern __shared__ __attribute__((aligned(16))) unsigned char smem[];
    LAS unsigned char* lds = (LAS unsigned char*)smem;
    const int tid = threadIdx.x;
    unsigned* ctl = (unsigned*)(a.ws + WS_CTL);
    volatile LAS unsigned* xbw = (volatile LAS unsigned*)(lds + LDS_CTL_OFF);
    volatile LAS int* tab = (volatile LAS int*)(lds + LDS_CTL_OFF + 256);
    volatile LAS int* qw = (volatile LAS int*)(lds + LDS_CTL_OFF + 1024);
    if (tid < 4) xbw[tid] = 0u;
    __syncthreads();
    const int lo = a.ph_lo, hi = a.ph_hi;
    XcdBarrier bar; bar.bar = ctl + CW_BAR; bar.x = 0; bar.st = xbw;
    if (hi - lo > 1) bar = xcd_barrier_post(ctl + CW_BAR, xbw);
#ifndef DUPMASK
#define DUPMASK 0
#endif
#define NREP(k) (((DUPMASK >> PHSEL(k)) & 1) ? 2 : 1)
#ifndef BRMASK
#define BRMASK 7
#endif
#ifndef PHMASK
#define PHMASK 0xFFFFF
#endif
#define PHSEL(k) ((k) < 2 ? (k) : 2 + ((k) - 2) % NPL)
#define IN(k) (((PHMASK >> PHSEL(k)) & 1) && lo <= (k) && (k) < hi)
#define SEAM(k) do { if (IN(k) && IN((k) + 1)) { xcd_barrier(bar); } } while (0)
    unsigned char* ws = a.ws;
    if (IN(0)) { for (int rep = 0; rep < NREP(0); ++rep) { phase_p0(a, lds); __syncthreads(); } SEAM(0); }
    if (IN(1)) { phase_norm1(a, 0); SEAM(1); }
    for (int l = 0; l < DEPTH; ++l) {
        const int pb = 2 + NPL * l;
        if (IN(pb + 0)) {
          for (int rep = 0; rep < NREP(pb + 0); ++rep) {
            pg8::StaticOrder S; S.init(NTOK, PLD, gridDim.x, blockIdx.x);
            pg8::EpiProj E{(bf16_t*)(ws + WS_PROJ)};
            pg8::gemm_phase<pg8::EpiProj, pg8::StaticOrder>(lds, (const bf16_t*)(ws + WS_H), (const bf16_t*)(ws + WS_WIN) + (size_t)l * PLD * DM, DM, 0, S, E);
          }
            SEAM(pb + 0);
        }
        if (IN(pb + 1)) { for (int rep = 0; rep < NREP(pb + 1); ++rep) { for (int ct = blockIdx.x; ct < 6144; ct += gridDim.x) rwkv_r1_task(a, l, ct, lds); phase_swa(a, lds); } SEAM(pb + 1); }
        if (IN(pb + 2)) {
          for (int rep = 0; rep < NREP(pb + 2); ++rep) {
            for (int u = blockIdx.x; u < 192; u += gridDim.x) rwkv_r2_unit(a, u, lds);
            for (;;) {
                if (tid == 0) *qw = (int)__hip_atomic_fetch_add(ctl + CW_QH + 64 * (2 * l + rep), 1u, __ATOMIC_RELAXED, __HIP_MEMORY_SCOPE_AGENT);
                __syncthreads();
                const int item = *qw;
                __syncthreads();
                if (item >= 768) break;
                diffattn_unit(a, l, item, lds);
            }
          }
            SEAM(pb + 2);
        }
        if (IN(pb + 3)) { for (int rep = 0; rep < NREP(pb + 3); ++rep) phase_rwkv_r3(a); SEAM(pb + 3); }
        if (IN(pb + 4)) { for (int rep = 0; rep < NREP(pb + 4); ++rep) phase_post(a, l); SEAM(pb + 4); }
        if (IN(pb + 5)) {
          for (int rep = 0; rep < NREP(pb + 5); ++rep) {
            pg8::StaticOrder S; S.init(NTOK, DM, gridDim.x, blockIdx.x);
            const bf16_t* P = (const bf16_t*)(ws + WS_PROJ); float* MF = (float*)(ws + WS_MF); bf16_t* MG = (bf16_t*)(ws + WS_MERGED);
            if (BRMASK & 1) { pg8::EpiBranch<0> E{P, MF, MG}; pg8::gemm_phase<pg8::EpiBranch<0>, pg8::StaticOrder>(lds, (const bf16_t*)(ws + WS_OA), (const bf16_t*)(ws + WS_WA) + (size_t)l * DM * 256, 256, 0, S, E); }
            if (BRMASK & 2) { pg8::EpiBranch<1> E{P, MF, MG}; pg8::gemm_phase<pg8::EpiBranch<1>, pg8::StaticOrder>(lds, (const bf16_t*)(ws + WS_OB), (const bf16_t*)(ws + WS_WB) + (size_t)l * DM * 768, 768, 0, S, E); }
            if (BRMASK & 4) { pg8::EpiBranch<2> E{P, MF, MG}; pg8::gemm_phase<pg8::EpiBranch<2>, pg8::StaticOrder>(lds, (const bf16_t*)(ws + WS_OC), (const bf16_t*)(ws + WS_WC) + (size_t)l * DM * 768, 768, 0, S, E); }
          }
            SEAM(pb + 5);
        }
        if (IN(pb + 6)) {
            pg8::StaticOrder S; S.init(NTOK, DM, gridDim.x, blockIdx.x);
            pg8::EpiOut E{l == 0 ? a.in[I_X] : (const float*)(ws + WS_X), (float*)(ws + WS_X), (const float*)(ws + WS_MISC + MISC_MOD) + (size_t)l * 8 * 6144 + 2048};
            pg8::gemm_phase<pg8::EpiOut, pg8::StaticOrder>(lds, (const bf16_t*)(ws + WS_MERGED), (const bf16_t*)(ws + WS_WO) + (size_t)l * DM * DM, DM, 0, S, E);
            SEAM(pb + 6);
        }
        if (IN(pb + 7)) { phase_route(a, l, lds); SEAM(pb + 7); }
        if (IN(pb + 8)) {
          for (int rep = 0; rep < NREP(pb + 8); ++rep) {
            build_moe_tab(a, l, tab);
            pg8::MoeOrder<true> S{(const LAS int*)tab, (const int*)(ws + WS_LIST), 8, (int)gridDim.x, (int)blockIdx.x};
            pg8::EpiMoe1 E{(bf16_t*)(ws + WS_ACT), a.in[I_B1] + (size_t)l * NE * 2 * FF};
            pg8::gemm_phase<pg8::EpiMoe1, pg8::MoeOrder<true>>(lds, (const bf16_t*)(ws + WS_H), (const bf16_t*)(ws + WS_W1) + (size_t)l * NE * 2 * FF * DM, DM, (size_t)2 * FF * DM * 2, S, E);
          }
            SEAM(pb + 8);
        }
        if (IN(pb + 9)) {
          for (int rep = 0; rep < NREP(pb + 9); ++rep) {
            build_moe_tab(a, l, tab);
            pg8::MoeOrder<false> S{(const LAS int*)tab, nullptr, 4, (int)gridDim.x, (int)blockIdx.x};
            pg8::EpiMoe2 E{(bf16_t*)(ws + WS_YMOE), a.in[I_B2] + (size_t)l * NE * DM};
            pg8::gemm_phase<pg8::EpiMoe2, pg8::MoeOrder<false>>(lds, (const bf16_t*)(ws + WS_ACT), (const bf16_t*)(ws + WS_W2) + (size_t)l * NE * DM * FF, FF, (size_t)DM * FF * 2, S, E);
          }
            SEAM(pb + 9);
        }
        if (IN(pb + 10)) { build_moe_tab(a, l, tab); phase_combine(a, l, (const LAS int*)tab); SEAM(pb + 10); }
    }
#undef IN
#undef SEAM
}

#ifndef MK_ONE_LAUNCH
#define MK_ONE_LAUNCH 1
#endif
extern "C" void kernel_launch(void* const* d_in, const int* in_sizes, int n_in, void* d_out, int out_size, void* d_ws, size_t ws_size, hipStream_t stream) {
    static int grid = 0;
    if (grid == 0) {
        if (n_in != 32 || ws_size < WS_END) { fprintf(stderr, "kernel_launch: unexpected n_in %d or ws %zu < %zu\n", n_in, ws_size, (size_t)WS_END); grid = -1; return; }
        int dev = 0, cus = 0;
        if (hipGetDevice(&dev) != hipSuccess || hipDeviceGetAttribute(&cus, hipDeviceAttributeMultiprocessorCount, dev) != hipSuccess) { grid = -1; return; }
        if (hipFuncSetAttribute((const void*)fwd, hipFuncAttributeMaxDynamicSharedMemorySize, LDS_BYTES) != hipSuccess) { fprintf(stderr, "kernel_launch: hipFuncSetAttribute failed\n"); grid = -1; return; }
        int per_cu = 0;
        if (hipOccupancyMaxActiveBlocksPerMultiprocessor(&per_cu, (const void*)fwd, 512, LDS_BYTES) != hipSuccess || per_cu < 1) fprintf(stderr, "kernel_launch: occupancy query says %d\n", per_cu);
        (void)hipGetLastError();
        grid = cus;
    }
    if (grid < 0) return;
    (void)hipMemsetAsync((char*)d_ws + WS_CTL, 0, CTL_BYTES, stream);
    Args a{};
    for (int i = 0; i < 32; ++i) a.in[i] = (const float*)d_in[i];
    a.out = (float*)d_out; a.ws = (unsigned char*)d_ws;
#if MK_ONE_LAUNCH
    a.ph_lo = 0; a.ph_hi = N_PHASES;
    hipLaunchKernelGGL(fwd, dim3(grid), dim3(512), LDS_BYTES, stream, a);
#else
    for (int p = 0; p < N_PHASES; ++p) { a.ph_lo = p; a.ph_hi = p + 1; hipLaunchKernelGGL(fwd, dim3(grid), dim3(512), LDS_BYTES, stream, a); }
#endif
}
```

```cpp
#include <hip/hip_runtime.h>
#include <stdint.h>
#include <stdio.h>

#define LAS __attribute__((address_space(3)))
typedef unsigned short bf16_t;
typedef short bf16x8 __attribute__((ext_vector_type(8)));
typedef short s16x4 __attribute__((ext_vector_type(4)));
typedef float f32x2 __attribute__((ext_vector_type(2)));
typedef float f32x4 __attribute__((ext_vector_type(4)));
typedef float f32x16 __attribute__((ext_vector_type(16)));
typedef unsigned u32x2 __attribute__((ext_vector_type(2)));
typedef unsigned u32x4 __attribute__((ext_vector_type(4)));
typedef __bf16 bf16x2_t __attribute__((ext_vector_type(2)));
typedef short v4i16_t __attribute__((ext_vector_type(4)));

constexpr int NB = 8, NT = 2048, DM = 1024, NTOK = NB * NT, DEPTH = 2;
constexpr int IN_COLS = 10368, PLD = 10496;
constexpr int C_AQ = 0, C_AK = 768, C_AV = 1536, C_BS = 2304, C_CQ = 5120, C_CK = 5888, C_CV = 6656, C_G = 7424;
constexpr int RSTR = 2688, RW = 768, NE = 32, FF = 1024;
constexpr float LOG2E = 1.4426950408889634f;

constexpr size_t al256(size_t x) { return (x + 255) & ~(size_t)255; }
constexpr size_t WS_CTL = 0;
constexpr size_t CTL_BYTES = 65536;
constexpr size_t WS_MISC = WS_CTL + CTL_BYTES;
constexpr size_t MISC_MOD = 0, MISC_LAM = 393216, MISC_BIASA = 393472, MISC_BIASC = 399872, MISC_WUPT = 409600, MISC_AUPT = 409600 + 393216, MISC_GUPT = 409600 + 2 * 393216, MISC_BYTES = 2 << 20;
constexpr size_t WS_WIN = WS_MISC + MISC_BYTES;
constexpr size_t WS_WA = WS_WIN + (size_t)DEPTH * PLD * DM * 2;
constexpr size_t WS_WB = WS_WA + (size_t)DEPTH * DM * 256 * 2;
constexpr size_t WS_WC = WS_WB + (size_t)DEPTH * DM * 768 * 2;
constexpr size_t WS_WO = WS_WC + (size_t)DEPTH * DM * 768 * 2;
constexpr size_t WS_W1 = WS_WO + (size_t)DEPTH * DM * DM * 2;
constexpr size_t WS_W2 = WS_W1 + (size_t)DEPTH * NE * 2 * FF * DM * 2;
constexpr size_t WS_H = WS_W2 + (size_t)DEPTH * NE * DM * FF * 2;
constexpr size_t WS_X = WS_H + (size_t)NTOK * DM * 2;
constexpr size_t WS_OA = WS_X + (size_t)NTOK * DM * 4;
constexpr size_t WS_OB = WS_OA + (size_t)NTOK * 256 * 2;
constexpr size_t WS_OC = WS_OB + (size_t)NTOK * 768 * 2;
constexpr size_t WS_MERGED = WS_OC + (size_t)NTOK * 768 * 2;
constexpr size_t WS_LIST = WS_MERGED + (size_t)NTOK * DM * 2;
constexpr size_t WS_TOKE = WS_LIST + (size_t)NE * NTOK * 4;
constexpr size_t WS_TOKP = WS_TOKE + (size_t)NTOK * 4 * 4;
constexpr size_t WS_U = WS_TOKP + (size_t)NTOK * 4 * 4;
constexpr size_t WS_PROJ = WS_U;
constexpr size_t WS_RR = WS_PROJ + (size_t)NTOK * PLD * 2;
constexpr size_t WS_RV = WS_RR + (size_t)NTOK * RW * 4;
constexpr size_t WS_RWD = WS_RV + (size_t)NTOK * RW * 4;
constexpr size_t WS_RKK = WS_RWD + (size_t)2 * NTOK * RW * 4;
constexpr size_t WS_RKKA = WS_RKK + (size_t)2 * NTOK * RW * 4;
constexpr size_t WS_RKD = WS_RKKA + (size_t)2 * NTOK * RW * 4;
constexpr size_t WS_GS = WS_RKD + (size_t)2 * NTOK * RW * 4;
constexpr size_t WS_Y = WS_GS + (size_t)NTOK * 128 * 4;
constexpr size_t WS_OAG = WS_Y + (size_t)2 * NTOK * RW * 4;
constexpr size_t WS_LSE = WS_OAG + (size_t)3 * NTOK * 256 * 4;
constexpr size_t WS_MF = WS_LSE + (size_t)3 * NTOK * 4 * 4;
constexpr size_t WS_QA = WS_MF + (size_t)NTOK * DM * 4;
constexpr size_t WS_SS = WS_QA + (size_t)6144 * 4096 * 2;
constexpr size_t WS_END1 = WS_SS + (size_t)6144 * 4096 * 2;
constexpr size_t WS_GG = WS_Y;
constexpr size_t WS_MP = WS_RWD, WS_NP = WS_RKK, WS_Y0 = WS_RKKA;
constexpr int SLOT_ROWS = 4 * NTOK + NE * 256;
constexpr size_t WS_ACT = WS_U;
constexpr size_t WS_YMOE = WS_ACT + (size_t)SLOT_ROWS * FF * 2;
constexpr size_t WS_END2 = WS_YMOE + (size_t)SLOT_ROWS * DM * 2;
constexpr size_t WS_END = WS_END1 > WS_END2 ? WS_END1 : WS_END2;

constexpr int CW_BAR = 0;
constexpr int CW_CNT = 4096;
constexpr int CW_QH = 4224;

constexpr int LDS_STAGE = 147456;
constexpr int LDS_CTL_OFF = LDS_STAGE;
constexpr int LDS_BYTES = LDS_STAGE + 4096;

__device__ __forceinline__ int otid() { int t = threadIdx.x; asm volatile("" : "+v"(t)); return t; }
__device__ __forceinline__ int obid() { int t = blockIdx.x; asm volatile("" : "+s"(t)); return t; }
__device__ __forceinline__ unsigned pk2(float lo, float hi) { f32x2 v = {lo, hi}; bf16x2_t b = __builtin_convertvector(v, bf16x2_t); return __builtin_bit_cast(unsigned, b); }
__device__ __forceinline__ u32x4 pack8(const float (&x)[8]) { u32x4 w; w.x = pk2(x[0], x[1]); w.y = pk2(x[2], x[3]); w.z = pk2(x[4], x[5]); w.w = pk2(x[6], x[7]); return w; }
__device__ __forceinline__ bf16_t f2bf(float x) { return (bf16_t)(pk2(x, 0.f) & 0xffffu); }
__device__ __forceinline__ float bflo(unsigned u) { return __builtin_bit_cast(float, u << 16); }
__device__ __forceinline__ float bfhi(unsigned u) { return __builtin_bit_cast(float, u & 0xffff0000u); }
__device__ __forceinline__ float bf2f(bf16_t h) { return __builtin_bit_cast(float, (unsigned)h << 16); }
__device__ __forceinline__ float wave_sum(float v) {
#pragma unroll
    for (int o = 1; o < 64; o <<= 1) v += __shfl_xor(v, o);
    return v;
}
__device__ __forceinline__ float sigmoidf_(float x) { return 1.f / (1.f + __expf(-x)); }
__device__ __forceinline__ int crow(int r, int hi) { return (r & 3) + 8 * (r >> 2) + 4 * hi; }
__device__ __forceinline__ s16x4 vtr(const LAS unsigned char* p) { return __builtin_bit_cast(s16x4, __builtin_amdgcn_ds_read_tr16_b64_v4i16((LAS v4i16_t*)p)); }
__device__ __forceinline__ float dpp_sum8(float x) {
    int v = __builtin_bit_cast(int, x);
    x += __builtin_bit_cast(float, __builtin_amdgcn_update_dpp(0, v, 0xB1, 0xF, 0xF, true));
    v = __builtin_bit_cast(int, x);
    x += __builtin_bit_cast(float, __builtin_amdgcn_update_dpp(0, v, 0x4E, 0xF, 0xF, true));
    v = __builtin_bit_cast(int, x);
    x += __builtin_bit_cast(float, __builtin_amdgcn_update_dpp(0, v, 0x141, 0xF, 0xF, true));
    return x;
}

#define XB_TMO      128
#define XB_XCNT(j)  (256  + 64 * (j))
#define XB_XSUB(j)  (1280 + 64 * (j))
#define XB_XGEN(j)  (2304 + 64 * (j))
#define XB_TOP      3328
#define XB_TOPGEN   3392
#define XCD_BAR_WORDS 3456
#define XB_SPIN_CAP (1u << 18)
__device__ __forceinline__ unsigned xb_ld(unsigned* p)              { return __hip_atomic_load(p, __ATOMIC_RELAXED, __HIP_MEMORY_SCOPE_AGENT); }
__device__ __forceinline__ unsigned xb_add(unsigned* p, unsigned v) { return __hip_atomic_fetch_add(p, v, __ATOMIC_RELAXED, __HIP_MEMORY_SCOPE_AGENT); }
__device__ __forceinline__ unsigned xb_xcc_id() { return (unsigned)__builtin_amdgcn_s_getreg((3 << 11) | 20) & 0xFu; }
#define XB_SPIN(cond, bar) do { unsigned _sp = 0; while (cond) { __builtin_amdgcn_s_sleep(1); \
    if ((++_sp & 255u) == 0u) { if (xb_ld(&(bar)[XB_TMO])) break; if (_sp > XB_SPIN_CAP) { atomicAdd(&(bar)[XB_TMO], 1u); break; } } } } while (0)
struct XcdBarrier { unsigned* bar; unsigned x; volatile LAS unsigned* st; };
__device__ __forceinline__ XcdBarrier xcd_barrier_post(unsigned* bar, volatile LAS unsigned* st) {
    XcdBarrier b; b.bar = bar; b.x = xb_xcc_id(); b.st = st;
    if (threadIdx.x == 0) (void)xb_add(&bar[XB_XCNT(b.x)], 1u);
    return b;
}
__device__ __forceinline__ void xcd_barrier_complete(unsigned* bar, unsigned x, unsigned& nloc, unsigned& nx) {
    const unsigned G = gridDim.x * gridDim.y * gridDim.z;
    unsigned sum, cnt, mine, sp = 0u;
    for (;;) {
        sum = 0u; cnt = 0u; mine = 0u;
#pragma unroll
        for (unsigned j = 0; j < 16; ++j) { const unsigned c = xb_ld(&bar[XB_XCNT(j)]); sum += c; cnt += (c > 0u) ? 1u : 0u; mine = (j == x) ? c : mine; }
        if (sum == G) break;
        __builtin_amdgcn_s_sleep(1);
        if ((++sp & 255u) == 0u) { if (xb_ld(&bar[XB_TMO])) break; if (sp > XB_SPIN_CAP) { atomicAdd(&bar[XB_TMO], 1u); break; } }
    }
    nloc = mine > 0u ? mine : 1u; nx = cnt > 0u ? cnt : 1u;
}
__device__ __forceinline__ void xcd_barrier(const XcdBarrier& b) {
    asm volatile("s_waitcnt vmcnt(0)" ::: "memory");
    __syncthreads();
    if (threadIdx.x == 0) {
        unsigned* bar = b.bar;
        __builtin_amdgcn_s_waitcnt(0);
        unsigned nloc = b.st[0], nx = b.st[1];
        if (nloc == 0u) { xcd_barrier_complete(bar, b.x, nloc, nx); b.st[0] = nloc; b.st[1] = nx; }
        const unsigned old = xb_add(&bar[XB_XSUB(b.x)], 1u);
        const unsigned gen = old / nloc;
        if (old + 1u == (gen + 1u) * nloc) {
            __builtin_amdgcn_fence(__ATOMIC_RELEASE, "agent");
            asm volatile("s_waitcnt vmcnt(0)" ::: "memory");
            const unsigned og = xb_add(&bar[XB_TOP], 1u);
            const unsigned tg = og / nx;
            if (og + 1u == (tg + 1u) * nx) xb_add(&bar[XB_TOPGEN], 1u);
            else XB_SPIN(xb_ld(&bar[XB_TOPGEN]) == tg, bar);
            __builtin_amdgcn_fence(__ATOMIC_ACQUIRE, "agent");
            xb_add(&bar[XB_XGEN(b.x)], 1u);
            asm volatile("s_waitcnt vmcnt(0)" ::: "memory");
        } else {
            XB_SPIN(xb_ld(&bar[XB_XGEN(b.x)]) == gen, bar);
            __builtin_amdgcn_fence(__ATOMIC_ACQUIRE, "agent");
            asm volatile("s_waitcnt vmcnt(0)" ::: "memory");
        }
    }
    __syncthreads();
}

namespace pg8 {
constexpr int BM = 256, BK = 64, HALF = 128, HTB = HALF * BK * 2, STAGE_BYTES = 8 * HTB, NXCD = 8, WGM = 8;
__device__ __forceinline__ int lds_byte(int r, int c) { const int st = (r >> 4) * 2 + (c >> 5), rr = r & 15, cc = c & 31, ob = rr * 64 + cc * 2; return st * 1024 + (ob ^ (((ob >> 9) & 1) << 5)); }
__device__ __forceinline__ void stage_rc(int b, int& R, int& C) { const int st = b / 1024, sb = b % 1024, swz = sb ^ (((sb >> 9) & 1) << 5); R = (st >> 1) * 16 + swz / 64; C = (st & 1) * 32 + (swz % 64) / 2; }
__device__ __forceinline__ int perm32(int rho) { const int n = rho >> 4, i = rho & 15; return 8 * (i >> 2) + 4 * n + (i & 3); }

struct Unit { int pm, pn, e, lt; };

struct StaticOrder {
    static constexpr bool GATHER = false;
    int nM, nN, nwg, G, c;
    __device__ void init(int M, int N, int G_, int c_) { nM = M / BM; nN = N / BM; nwg = nM * nN; G = G_; c = c_; }
    __device__ __forceinline__ bool next(int i, Unit& u) const {
        const long L = (long)i * G + c; if (L >= nwg) return false;
        int wgid = (int)L; { const int q = nwg / NXCD, r = nwg % NXCD, xcd = wgid % NXCD, off = wgid / NXCD; wgid = (xcd < r ? xcd * (q + 1) : r * (q + 1) + (xcd - r) * q) + off; }
        const int nig = WGM * nN, gid = wgid / nig, fm = gid * WGM, gsz = (nM - fm) < WGM ? (nM - fm) : WGM;
        u.pm = fm + ((wgid % nig) % gsz); u.pn = (wgid % nig) / gsz; u.e = 0; u.lt = 0; return true;
    }
    __device__ __forceinline__ int arow(const Unit& u, int r) const { return u.pm * BM + r; }
};
template <bool GATHER_> struct MoeOrder {
    static constexpr bool GATHER = GATHER_;
    const LAS int* tab;
    const int* list;
    int ncol, G, c;
    __device__ __forceinline__ bool next(int i, Unit& u) const {
        const int L = i * G + c; const int total = tab[32] * ncol; if (L >= total) return false;
        const int rt = L / ncol; u.pn = L - rt * ncol; u.pm = rt;
        int e = 0;
#pragma unroll 1
        for (int j = 1; j < 32; ++j) e = (tab[j] <= rt) ? j : e;
        u.e = e; u.lt = rt - tab[e]; return true;
    }
    __device__ __forceinline__ int arow(const Unit& u, int r) const {
        if (!GATHER_) return u.pm * BM + r;
        const int pos = u.lt * BM + r; const int cnt = tab[64 + u.e];
        return pos < cnt ? list[(size_t)u.e * NTOK + pos] : 0;
    }
};

template <class Epi, class Sched>
__device__ __forceinline__ void gemm_phase(LAS unsigned char* lds, const bf16_t* A, const bf16_t* Bt, const int K, const size_t b_estride_bytes, const Sched& S, const Epi& E) {
    constexpr bool GATHER = Sched::GATHER;
    const int tid = otid(), wid = __builtin_amdgcn_readfirstlane(tid >> 6), lane = tid & 63, wr = wid >> 2, wc = wid & 3, fr = lane & 15, fq = lane >> 4;
    const int nt = K / BK;
    int Rr[2], Cc[2]; unsigned voffA[2], voffB[2];
#pragma unroll
    for (int i = 0; i < 2; ++i) { int R, C; stage_rc(tid * 16 + i * 8192, R, C); const int Rb = Epi::PERM ? ((R & ~31) + perm32(R & 31)) : R;
        Rr[i] = R; Cc[i] = C; voffA[i] = (unsigned)(R * K + C) * 2u; voffB[i] = (unsigned)(Rb * K + C) * 2u; }
    const size_t kstep = (size_t)(BK * 2);
    const size_t hstep = (size_t)HALF * K * 2;
    const size_t tstep = 2 * hstep;
    const unsigned ldsw = (unsigned)wid * 1024u;
    const int aoff = lds_byte(wr * 64 + fr, fq * 8), boff = lds_byte(wc * 32 + fr, fq * 8);
#define PG8_SA(b, h) (((b) * 2 + (h)) * HTB)
#define PG8_SB(b, h) ((4 + (b) * 2 + (h)) * HTB)
#define PG8_STAGE(bufoff, gbase, voff) do { _Pragma("unroll") for (int _i = 0; _i < 2; ++_i) \
        __builtin_amdgcn_global_load_lds((const unsigned*)((const char*)(gbase) + (voff)[_i]), (LAS unsigned*)(lds + (bufoff) + ldsw + _i * 8192), 16, 0, 0); } while (0)
#define PG8_STAGEA(bufoff, uptr, offs, h, kb) do { _Pragma("unroll") for (int _i = 0; _i < 2; ++_i) { const char* _src; \
        if constexpr (GATHER) _src = (const char*)A + (size_t)(offs)[h][_i] + (size_t)(kb); else _src = (uptr) + (size_t)(h) * hstep + (size_t)(kb) + voffA[_i]; \
        __builtin_amdgcn_global_load_lds((const unsigned*)_src, (LAS unsigned*)(lds + (bufoff) + ldsw + _i * 8192), 16, 0, 0); } } while (0)
#define PG8_LDA(dst, b, h) do { _Pragma("unroll") for (int m = 0; m < 4; ++m) _Pragma("unroll") for (int k = 0; k < 2; ++k) dst[m][k] = *(const LAS bf16x8*)(lds + PG8_SA(b, h) + aoff + m * 2048 + k * 1024); } while (0)
#define PG8_LDB(dst, b, h) do { _Pragma("unroll") for (int n = 0; n < 2; ++n) _Pragma("unroll") for (int k = 0; k < 2; ++k) dst[n][k] = *(const LAS bf16x8*)(lds + PG8_SB(b, h) + boff + n * 2048 + k * 1024); } while (0)
#define PG8_MMA(ai, bj, At, Bt_) do { __builtin_amdgcn_s_setprio(1); _Pragma("unroll") for (int m = 0; m < 4; ++m) _Pragma("unroll") for (int n = 0; n < 2; ++n) _Pragma("unroll") for (int k = 0; k < 2; ++k) \
        acc[ai][bj][m][n] = __builtin_amdgcn_mfma_f32_16x16x32_bf16(Bt_[n][k], At[m][k], acc[ai][bj][m][n], 0, 0, 0); __builtin_amdgcn_s_setprio(0); } while (0)
#define PG8_WAIT_V(n) asm volatile("s_waitcnt vmcnt(" #n ")" ::: "memory")
#define PG8_WAIT_L(n) asm volatile("s_waitcnt lgkmcnt(" #n ")" ::: "memory")
#define PG8_BAR __builtin_amdgcn_s_barrier()
#define PG8_SCHED __builtin_amdgcn_sched_barrier(0)
#define PG8_AOFFS(dst, u) do { if constexpr (GATHER) { _Pragma("unroll") for (int _h = 0; _h < 2; ++_h) _Pragma("unroll") for (int _i = 0; _i < 2; ++_i) \
        dst[_h][_i] = ((unsigned)S.arow(u, _h * HALF + Rr[_i]) * (unsigned)K + (unsigned)Cc[_i]) * 2u; } } while (0)
    Unit cur, nxt; int ui = 0;
    if (!S.next(0, cur)) return;
    f32x4 acc[2][2][4][2];
#pragma unroll
    for (int a = 0; a < 2; ++a)
#pragma unroll
        for (int b = 0; b < 2; ++b)
#pragma unroll
            for (int m = 0; m < 4; ++m)
#pragma unroll
                for (int n = 0; n < 2; ++n) acc[a][b][m][n] = (f32x4){0.f, 0.f, 0.f, 0.f};
    bf16x8 At[4][2], B0[2][2], B1[2][2];
    unsigned aoc[2][2] = {{0u, 0u}, {0u, 0u}}, aon[2][2] = {{0u, 0u}, {0u, 0u}};
    PG8_AOFFS(aoc, cur);
    const char* cA = (const char*)A + (size_t)cur.pm * tstep;
    const char* cB = (const char*)Bt + (size_t)cur.e * b_estride_bytes + (size_t)cur.pn * tstep;
    PG8_STAGE(PG8_SB(0, 0), cB, voffB); PG8_STAGEA(PG8_SA(0, 0), cA, aoc, 0, 0); PG8_STAGE(PG8_SB(0, 1), cB + hstep, voffB); PG8_STAGEA(PG8_SA(0, 1), cA, aoc, 1, 0);
    if (wr == 1) PG8_BAR;
    PG8_WAIT_V(4); PG8_BAR;
    PG8_STAGE(PG8_SB(1, 0), cB + kstep, voffB); PG8_STAGEA(PG8_SA(1, 0), cA, aoc, 0, kstep); PG8_STAGE(PG8_SB(1, 1), cB + hstep + kstep, voffB);
    PG8_WAIT_V(6); PG8_BAR;
    for (;;) {
        const bool has_next = S.next(ui + 1, nxt);
        const char* nA = has_next ? (const char*)A + (size_t)nxt.pm * tstep : cA;
        const char* nB = has_next ? (const char*)Bt + (size_t)nxt.e * b_estride_bytes + (size_t)nxt.pn * tstep : cB;
        if constexpr (GATHER) {
            if (has_next) { PG8_AOFFS(aon, nxt); } else {
#pragma unroll
                for (int h = 0; h < 2; ++h)
#pragma unroll
                    for (int i = 0; i < 2; ++i) aon[h][i] = aoc[h][i]; } }
#pragma unroll 1
        for (int t = 0; t < nt; t += 2) {
            const bool last = (t == nt - 2);
            const size_t k1 = (size_t)(t + 1) * kstep;
            const size_t k2 = last ? (size_t)0 : (size_t)(t + 2) * kstep;
            const size_t k3 = k2 + kstep;
            const char* a2p = last ? nA : cA;
            unsigned a2o[2][2];
#pragma unroll
            for (int h = 0; h < 2; ++h)
#pragma unroll
                for (int i = 0; i < 2; ++i) a2o[h][i] = last ? aon[h][i] : aoc[h][i];
            const char* b2 = last ? nB : cB + (size_t)(t + 2) * kstep; const char* b3 = b2 + kstep;
            PG8_LDB(B0, 0, 0); PG8_SCHED; PG8_LDA(At, 0, 0); PG8_STAGEA(PG8_SA(1, 1), cA, aoc, 1, k1);
            PG8_WAIT_L(8); PG8_BAR; PG8_WAIT_L(0); PG8_MMA(0, 0, At, B0); PG8_BAR; PG8_SCHED;
            PG8_LDB(B1, 0, 1); PG8_STAGE(PG8_SB(0, 0), b2, voffB);
            PG8_BAR; PG8_WAIT_L(0); PG8_MMA(0, 1, At, B1); PG8_BAR;
            PG8_LDA(At, 0, 1); PG8_STAGEA(PG8_SA(0, 0), a2p, a2o, 0, k2);
            PG8_BAR; PG8_WAIT_L(0); PG8_MMA(1, 0, At, B0); PG8_BAR; PG8_SCHED;
            PG8_STAGE(PG8_SB(0, 1), b2 + hstep, voffB);
            PG8_WAIT_V(6); PG8_BAR; PG8_MMA(1, 1, At, B1); PG8_BAR;
            PG8_LDB(B0, 1, 0); PG8_SCHED; PG8_LDA(At, 1, 0); PG8_STAGEA(PG8_SA(0, 1), a2p, a2o, 1, k2);
            PG8_WAIT_L(8); PG8_BAR; PG8_WAIT_L(0); PG8_MMA(0, 0, At, B0); PG8_BAR; PG8_SCHED;
            PG8_LDB(B1, 1, 1); PG8_STAGE(PG8_SB(1, 0), b3, voffB);
            PG8_BAR; PG8_WAIT_L(0); PG8_MMA(0, 1, At, B1); PG8_BAR;
            PG8_LDA(At, 1, 1); PG8_STAGEA(PG8_SA(1, 0), a2p, a2o, 0, k3);
            PG8_BAR; PG8_WAIT_L(0); PG8_MMA(1, 0, At, B0); PG8_BAR; PG8_SCHED;
            PG8_STAGE(PG8_SB(1, 1), b3 + hstep, voffB);
            PG8_WAIT_V(6); PG8_BAR; PG8_MMA(1, 1, At, B1); PG8_BAR;
        }
        E(acc, cur, wr, wc, fr, fq);
        if (!has_next) break;
#pragma unroll
        for (int a = 0; a < 2; ++a)
#pragma unroll
            for (int b = 0; b < 2; ++b)
#pragma unroll
                for (int m = 0; m < 4; ++m)
#pragma unroll
                    for (int n = 0; n < 2; ++n) acc[a][b][m][n] = (f32x4){0.f, 0.f, 0.f, 0.f};
        cur = nxt; cA = nA; cB = nB; ++ui;
#pragma unroll
        for (int h = 0; h < 2; ++h)
#pragma unroll
            for (int i = 0; i < 2; ++i) aoc[h][i] = aon[h][i];
    }
    PG8_WAIT_V(0);
    if (wr == 0) PG8_BAR;
    PG8_BAR;
#undef PG8_SA
#undef PG8_SB
#undef PG8_STAGE
#undef PG8_STAGEA
#undef PG8_LDA
#undef PG8_LDB
#undef PG8_MMA
#undef PG8_WAIT_V
#undef PG8_WAIT_L
#undef PG8_BAR
#undef PG8_SCHED
#undef PG8_AOFFS
}

typedef f32x4 Acc[2][2][4][2];

struct EpiProj {
    static constexpr bool PERM = true;
    bf16_t* O; int ld; int sg_from;
    __device__ __forceinline__ void operator()(const Acc& acc, const Unit& u, int wr, int wc, int fr, int fq) const {
        const int row0 = u.pm * BM + wr * 64 + fr, col0 = u.pn * BM + wc * 32 + 8 * fq; const bool sg = u.pn >= sg_from;
#pragma unroll
        for (int ai = 0; ai < 2; ++ai)
#pragma unroll
            for (int m = 0; m < 4; ++m) { bf16_t* rowp = O + (size_t)(row0 + ai * HALF + m * 16) * ld + col0;
#pragma unroll
                for (int bj = 0; bj < 2; ++bj) { f32x4 v0 = acc[ai][bj][m][0], v1 = acc[ai][bj][m][1];
                    if (sg) {
#pragma unroll
                        for (int j = 0; j < 4; ++j) { v0[j] = sigmoidf_(v0[j]); v1[j] = sigmoidf_(v1[j]); } }
                    u32x4 w; w.x = pk2(v0[0], v0[1]); w.y = pk2(v0[2], v0[3]); w.z = pk2(v1[0], v1[1]); w.w = pk2(v1[2], v1[3]);
                    *(u32x4*)(rowp + bj * HALF) = w; } }
    }
};
template <int SEG> struct EpiBranch {
    static constexpr bool PERM = true;
    const bf16_t* P; float* MF; bf16_t* MG;
    __device__ __forceinline__ void operator()(const Acc& acc, const Unit& u, int wr, int wc, int fr, int fq) const {
        const int row0 = u.pm * BM + wr * 64 + fr, col0 = u.pn * BM + wc * 32 + 8 * fq;
#pragma unroll
        for (int ai = 0; ai < 2; ++ai)
#pragma unroll
            for (int m = 0; m < 4; ++m) { const size_t r = (size_t)(row0 + ai * HALF + m * 16);
                asm volatile("" ::: "memory");
#pragma unroll
                for (int bj = 0; bj < 2; ++bj) { const int c = col0 + bj * HALF;
                    const u32x4 g = *(const u32x4*)(P + r * PLD + C_G + SEG * 1024 + c);
                    f32x4 v0 = acc[ai][bj][m][0], v1 = acc[ai][bj][m][1];
                    v0[0] *= bflo(g.x); v0[1] *= bfhi(g.x); v0[2] *= bflo(g.y); v0[3] *= bfhi(g.y);
                    v1[0] *= bflo(g.z); v1[1] *= bfhi(g.z); v1[2] *= bflo(g.w); v1[3] *= bfhi(g.w);
                    float* mp = MF + r * DM + c;
                    if (SEG > 0) { v0 += *(const f32x4*)mp; v1 += *(const f32x4*)(mp + 4); }
                    if (SEG < 2) { *(f32x4*)mp = v0; *(f32x4*)(mp + 4) = v1; }
                    else { u32x4 w; w.x = pk2(v0[0], v0[1]); w.y = pk2(v0[2], v0[3]); w.z = pk2(v1[0], v1[1]); w.w = pk2(v1[2], v1[3]); *(u32x4*)(MG + r * DM + c) = w; } } }
    }
};
struct EpiOut {
    static constexpr bool PERM = false;
    const float* xsrc; float* X; const float* gt;
    __device__ __forceinline__ void operator()(const Acc& acc, const Unit& u, int wr, int wc, int fr, int fq) const {
        const int row0 = u.pm * BM + wr * 64 + fr, col0 = u.pn * BM + wc * 32 + 4 * fq;
        const float* gp = gt + (size_t)((u.pm * BM) >> 11) * 6144 + col0;
        f32x4 gv[2][2];
#pragma unroll
        for (int bj = 0; bj < 2; ++bj)
#pragma unroll
            for (int n = 0; n < 2; ++n) gv[bj][n] = *(const f32x4*)(gp + bj * HALF + n * 16);
#pragma unroll
        for (int ai = 0; ai < 2; ++ai)
#pragma unroll
            for (int m = 0; m < 4; ++m) { const size_t o = (size_t)(row0 + ai * HALF + m * 16) * DM + col0;
#pragma unroll
                for (int bj = 0; bj < 2; ++bj)
#pragma unroll
                    for (int n = 0; n < 2; ++n) { const f32x4 xv = *(const f32x4*)(xsrc + o + bj * HALF + n * 16);
                        *(f32x4*)(X + o + bj * HALF + n * 16) = xv + gv[bj][n] * acc[ai][bj][m][n]; } }
    }
};
struct EpiMoe1 {
    static constexpr bool PERM = true;
    bf16_t* ACT; const float* b1;
    __device__ __forceinline__ void operator()(const Acc& acc, const Unit& u, int wr, int wc, int fr, int fq) const {
        const int row0 = u.pm * BM + wr * 64 + fr, col0 = u.pn * BM + wc * 32 + 8 * fq;
        const float* bp = b1 + (size_t)u.e * (2 * FF) + col0;
        f32x4 bv[2][2];
#pragma unroll
        for (int bj = 0; bj < 2; ++bj)
#pragma unroll
            for (int n = 0; n < 2; ++n) bv[bj][n] = *(const f32x4*)(bp + bj * HALF + 4 * n);
#pragma unroll
        for (int ai = 0; ai < 2; ++ai)
#pragma unroll
            for (int m = 0; m < 4; ++m) { bf16_t* rowp = ACT + (size_t)(row0 + ai * HALF + m * 16) * FF + (col0 >> 1);
#pragma unroll
                for (int bj = 0; bj < 2; ++bj) { const f32x4 v0 = acc[ai][bj][m][0] + bv[bj][0], v1 = acc[ai][bj][m][1] + bv[bj][1];
                    float a[4];
#pragma unroll
                    for (int q = 0; q < 4; ++q) { const float gl = (q < 2) ? v0[2 * q] : v1[2 * q - 4], ln = (q < 2) ? v0[2 * q + 1] : v1[2 * q - 3];
                        const float xg = fminf(gl, 7.0f), xl = fminf(fmaxf(ln, -7.0f), 7.0f);
                        a[q] = xg * sigmoidf_(1.702f * xg) * (xl + 1.0f); }
                    u32x2 w; w.x = pk2(a[0], a[1]); w.y = pk2(a[2], a[3]);
                    *(u32x2*)(rowp + bj * (HALF / 2)) = w; } }
    }
};
struct EpiMoe2 {
    static constexpr bool PERM = true;
    bf16_t* Y; const float* b2;
    __device__ __forceinline__ void operator()(const Acc& acc, const Unit& u, int wr, int wc, int fr, int fq) const {
        const int row0 = u.pm * BM + wr * 64 + fr, col0 = u.pn * BM + wc * 32 + 8 * fq;
        const float* bp = b2 + (size_t)u.e * DM + col0;
        f32x4 bv[2][2];
#pragma unroll
        for (int bj = 0; bj < 2; ++bj)
#pragma unroll
            for (int n = 0; n < 2; ++n) bv[bj][n] = *(const f32x4*)(bp + bj * HALF + 4 * n);
#pragma unroll
        for (int ai = 0; ai < 2; ++ai)
#pragma unroll
            for (int m = 0; m < 4; ++m) { bf16_t* rowp = Y + (size_t)(row0 + ai * HALF + m * 16) * DM + col0;
#pragma unroll
                for (int bj = 0; bj < 2; ++bj) { const f32x4 v0 = acc[ai][bj][m][0] + bv[bj][0], v1 = acc[ai][bj][m][1] + bv[bj][1];
                    u32x4 w; w.x = pk2(v0[0], v0[1]); w.y = pk2(v0[2], v0[3]); w.z = pk2(v1[0], v1[1]); w.w = pk2(v1[2], v1[3]);
                    *(u32x4*)(rowp + bj * HALF) = w; } }
    }
};
}

struct Args { const float* in[32]; float* out; unsigned char* ws; int ph_lo, ph_hi; };
enum { I_X = 0, I_C, I_WMOD, I_BMOD, I_N1G, I_N2G, I_WIN, I_MU, I_W0, I_WUP, I_A0, I_AUP, I_GUP, I_KK, I_KA, I_RK, I_LNG, I_LNB, I_DLAM, I_SUBG, I_RELB, I_WBA, I_WBB, I_WBC, I_WOUT, I_RW, I_RB, I_W1, I_B1, I_W2, I_B2, I_FNG };

__device__ __forceinline__ void lds_fence() { asm volatile("s_waitcnt lgkmcnt(0)" ::: "memory"); }

__device__ __forceinline__ void tr_item(const float* W, int ldw, int ncols, bf16_t* WT, int K, LAS float* scr, int item, int lane) {
    const int nblk = ncols >> 5, kb = item / nblk, nb = item - kb * nblk, k0 = 64 * kb, n0 = 32 * nb;
#pragma unroll 8
    for (int i = 0; i < 32; ++i) { const int kk = 2 * i + (lane >> 5); scr[kk * 33 + (lane & 31)] = W[(size_t)(k0 + kk) * ldw + n0 + (lane & 31)]; }
    lds_fence();
    const int c = lane & 7;
#pragma unroll
    for (int j = 0; j < 4; ++j) { const int n = (lane >> 3) + 8 * j; const LAS float* s = scr + (8 * c) * 33 + n;
        u32x4 o; o.x = pk2(s[0 * 33], s[1 * 33]); o.y = pk2(s[2 * 33], s[3 * 33]); o.z = pk2(s[4 * 33], s[5 * 33]); o.w = pk2(s[6 * 33], s[7 * 33]);
        *(u32x4*)(WT + (size_t)(n0 + n) * K + k0 + 8 * c) = o; }
    lds_fence();
}
__device__ __forceinline__ int t5_bucket(int rel) {
    const int ret = rel > 0 ? 16 : 0; const int n = rel < 0 ? -rel : rel;
    int v;
    if (n < 8) v = n; else if (n < 12) v = 8; else if (n < 16) v = 9; else if (n < 23) v = 10; else if (n < 32) v = 11;
    else if (n < 46) v = 12; else if (n < 64) v = 13; else if (n < 91) v = 14; else v = 15;
    return ret + v;
}
__device__ __forceinline__ void phase_p0(const Args& a, LAS unsigned char* lds) {
    const int tid = otid(), lane = tid & 63, wave = tid >> 6, G = gridDim.x;
    unsigned char* ws = a.ws;
    {
        LAS float* scr = (LAS float*)(lds + wave * 8448);
        const int gw = blockIdx.x * 8 + wave, NGW = G * 8;
        constexpr int NITEMS = 65536 + 32768 + 2 * 6592;
        for (int it = gw; it < NITEMS; it += NGW) {
            int r = it;
            if (r < 65536) { const int mat = r >> 10; tr_item(a.in[I_W1] + (size_t)mat * DM * 2 * FF, 2 * FF, 2 * FF, (bf16_t*)(ws + WS_W1) + (size_t)mat * 2 * FF * DM, DM, scr, r & 1023, lane); continue; }
            r -= 65536;
            if (r < 32768) { const int mat = r >> 9; tr_item(a.in[I_W2] + (size_t)mat * FF * DM, DM, DM, (bf16_t*)(ws + WS_W2) + (size_t)mat * DM * FF, FF, scr, r & 511, lane); continue; }
            r -= 32768;
            const int l = r / 6592; r -= l * 6592;
            if (r < 2496) { tr_item(a.in[I_WIN] + (size_t)l * DM * IN_COLS, IN_COLS, 4992, (bf16_t*)(ws + WS_WIN) + (size_t)l * PLD * DM, DM, scr, r, lane); continue; }
            r -= 2496;
            if (r < 2688) { tr_item(a.in[I_WIN] + (size_t)l * DM * IN_COLS + 4992, IN_COLS, 5376, (bf16_t*)(ws + WS_WIN) + (size_t)l * PLD * DM + (size_t)5120 * DM, DM, scr, r, lane); continue; }
            r -= 2688;
            if (r < 128) { tr_item(a.in[I_WBA] + (size_t)l * 256 * DM, DM, DM, (bf16_t*)(ws + WS_WA) + (size_t)l * DM * 256, 256, scr, r, lane); continue; }
            r -= 128;
            if (r < 384) { tr_item(a.in[I_WBB] + (size_t)l * 768 * DM, DM, DM, (bf16_t*)(ws + WS_WB) + (size_t)l * DM * 768, 768, scr, r, lane); continue; }
            r -= 384;
            if (r < 384) { tr_item(a.in[I_WBC] + (size_t)l * 768 * DM, DM, DM, (bf16_t*)(ws + WS_WC) + (size_t)l * DM * 768, 768, scr, r, lane); continue; }
            r -= 384;
            tr_item(a.in[I_WOUT] + (size_t)l * DM * DM, DM, DM, (bf16_t*)(ws + WS_WO) + (size_t)l * DM * DM, DM, scr, r, lane);
        }
        for (int i = blockIdx.x * 512 + tid; i < 2 * 128 * DM / 8; i += G * 512) {
            const int l = i / (128 * DM / 8), o = i - l * (128 * DM / 8);
            *(u32x4*)((bf16_t*)(ws + WS_WIN) + (size_t)l * PLD * DM + (size_t)4992 * DM + (size_t)o * 8) = (u32x4){0u, 0u, 0u, 0u};
        }
    }
    {
        bf16_t* WT = (bf16_t*)(ws + WS_MISC + MISC_WUPT); bf16_t* AT = (bf16_t*)(ws + WS_MISC + MISC_AUPT);
        for (int i = blockIdx.x * 512 + tid; i < 2 * 2 * 12 * 4096; i += G * 512) {
            const int j = i & 63, k = (i >> 6) & 63, hd = (i >> 12) % 12, ld = i / (12 * 4096);
            const size_t src = ((size_t)ld * 64 + j) * RW + hd * 64 + k;
            WT[i] = (bf16_t)(pk2(a.in[I_WUP][src], 0.f) & 0xffffu); AT[i] = (bf16_t)(pk2(a.in[I_AUP][src], 0.f) & 0xffffu);
        }
    }
    {
        bf16_t* GT = (bf16_t*)(ws + WS_MISC + MISC_GUPT);
        for (int i = blockIdx.x * 512 + tid; i < 2 * 768 * 256; i += G * 512) {
            const int k = i & 255, n = (i >> 8) % 768, l2 = i / (768 * 256);
            GT[i] = k < 128 ? f2bf(a.in[I_GUP][((size_t)l2 * 128 + k) * RW + n]) : (bf16_t)0;
        }
    }
    __syncthreads();
    if ((int)blockIdx.x < 192) {
        LAS float* sc = (LAS float*)(lds + 69632);
        LAS float* red = (LAS float*)(lds + 102400);
        for (int i = tid; i < NB * DM; i += 512) { const float v = a.in[I_C][i]; sc[i] = v / (1.f + expf(-v)); }
        __syncthreads();
        float* mod = (float*)(ws + WS_MISC + MISC_MOD);
        for (int j = blockIdx.x; j < 192; j += G) {
            const int l = j / 96, n0 = (j - l * 96) * 64, jj = tid & 63, ks = tid >> 6;
            float acc[8];
#pragma unroll
            for (int b = 0; b < 8; ++b) acc[b] = 0.f;
            const float* wp = a.in[I_WMOD] + ((size_t)l * DM + ks * 128) * 6144 + n0 + jj;
            for (int k = 0; k < 128; ++k) { const float w = wp[(size_t)k * 6144];
#pragma unroll
                for (int b = 0; b < 8; ++b) acc[b] += sc[b * DM + ks * 128 + k] * w; }
#pragma unroll
            for (int b = 0; b < 8; ++b) red[(ks * 8 + b) * 64 + jj] = acc[b];
            __syncthreads();
            { const int b = tid >> 6; float s = 0.f;
#pragma unroll
              for (int k2 = 0; k2 < 8; ++k2) s += red[(k2 * 8 + b) * 64 + jj];
              mod[((size_t)l * 8 + b) * 6144 + n0 + jj] = s + a.in[I_BMOD][(size_t)l * 6144 + n0 + jj]; }
            __syncthreads();
        }
    }
    if ((int)blockIdx.x == G - 1) {
        float* lam = (float*)(ws + WS_MISC + MISC_LAM);
        if (tid < 2) { const int l = tid; const float* dl = a.in[I_DLAM] + (size_t)l * 256; float s01 = 0.f, s23 = 0.f;
            for (int d = 0; d < 64; ++d) { s01 += dl[d] * dl[64 + d]; s23 += dl[128 + d] * dl[192 + d]; }
            const float li = 0.8f - 0.6f * expf(-0.3f * (float)l);
            lam[l] = expf(s01) - expf(s23) + li; lam[2 + l] = li; }
        float* bA = (float*)(ws + WS_MISC + MISC_BIASA);
        for (int i = tid; i < 12 * 129; i += 512) { const int head = i / 129, jj = i - head * 129, g = head >> 2; const int dil = (g == 0) ? 1 : (g == 1) ? 4 : 16;
            bA[i] = a.in[I_RELB][t5_bucket((jj - 64) * dil) * 18 + head] * LOG2E; }
        float* bC = (float*)(ws + WS_MISC + MISC_BIASC);
        for (int i = tid; i < 6 * 257; i += 512) { const int h = i / 257, rel = i - h * 257 - 128;
            bC[i] = a.in[I_RELB][t5_bucket(rel) * 18 + 12 + h] * LOG2E; }
    }
}

__device__ __forceinline__ float row_rstd(const f32x4 (&v)[4], float eps) {
    float s = 0.f;
#pragma unroll
    for (int j = 0; j < 4; ++j) s += (v[j].x * v[j].x + v[j].y * v[j].y) + (v[j].z * v[j].z + v[j].w * v[j].w);
    return rsqrtf(wave_sum(s) * (1.f / DM) + eps);
}
__device__ __forceinline__ void norm_mod_store(const f32x4 (&v)[4], float rstd, const float* g, const float* sc, const float* sh, bf16_t* orow, int lane) {
#pragma unroll
    for (int j = 0; j < 4; ++j) { const int c = 4 * lane + 256 * j;
        const f32x4 gv = *(const f32x4*)(g + c), scv = *(const f32x4*)(sc + c), shv = *(const f32x4*)(sh + c);
        const f32x4 y = v[j] * rstd * gv * (scv + 1.0f) + shv;
        u32x2 w; w.x = pk2(y.x, y.y); w.y = pk2(y.z, y.w);
        *(u32x2*)(orow + c) = w; }
}
__device__ __forceinline__ void phase_norm1(const Args& a, int l) {
    const int tid = otid(), lane = tid & 63, wave = tid >> 6;
    const float* mod = (const float*)(a.ws + WS_MISC + MISC_MOD) + (size_t)l * 8 * 6144;
    bf16_t* H = (bf16_t*)(a.ws + WS_H);
    for (int t = blockIdx.x * 8 + wave; t < NTOK; t += gridDim.x * 8) {
        const float* xr = a.in[I_X] + (size_t)t * DM; f32x4 v[4];
#pragma unroll
        for (int j = 0; j < 4; ++j) v[j] = *(const f32x4*)(xr + 4 * lane + 256 * j);
        const float rstd = row_rstd(v, 1e-6f);
        const float* mb = mod + (size_t)(t >> 11) * 6144;
        norm_mod_store(v, rstd, a.in[I_N1G] + (size_t)l * DM, mb + 1024, mb, H + (size_t)t * DM, lane);
    }
}

__device__ __forceinline__ float shiftv(const bf16_t* P, int t, int col, const float* mu) {
    const int ts = t & (NT - 1); const bf16_t* p0 = P + (size_t)t * PLD + C_BS + col;
    const float p = bf2f(p0[0]);
    const float pm = ts > 0 ? bf2f(p0[-PLD]) : 0.f;
    const float pn = ts < NT - 1 ? bf2f(p0[PLD]) : 0.f;
    return p + mu[col] * (pm - p) + mu[RSTR + col] * (pn - p);
}
__device__ __forceinline__ void phase_rwkv_pre(const Args& a, int l, LAS unsigned char* lds) {
    const int tid = otid(), lane = tid & 63, wave = tid >> 6;
    unsigned char* ws = a.ws;
    const bf16_t* P = (const bf16_t*)(ws + WS_PROJ);
    const float* mu = a.in[I_MU] + (size_t)l * 2 * RSTR;
    LAS float* LW = (LAS float*)lds;
    float* GS = (float*)(ws + WS_GS);
    float* RR = (float*)(ws + WS_RR); float* RV = (float*)(ws + WS_RV);
    float* RWD = (float*)(ws + WS_RWD); float* RKK = (float*)(ws + WS_RKK); float* RKKA = (float*)(ws + WS_RKKA); float* RKD = (float*)(ws + WS_RKD);
    const float* w0 = a.in[I_W0] + (size_t)l * 2 * RW; const float* a0 = a.in[I_A0] + (size_t)l * 2 * RW;
    const float* wup = a.in[I_WUP] + (size_t)l * 2 * 64 * RW; const float* aup = a.in[I_AUP] + (size_t)l * 2 * 64 * RW;
    const float* kkp = a.in[I_KK] + (size_t)l * 2 * RW; const float* kap = a.in[I_KA] + (size_t)l * 2 * RW;
    for (int tile = blockIdx.x; tile < NTOK / 32; tile += gridDim.x) {
        const int t0 = tile * 32;
        for (int idx = tid; idx < 32 * 384; idx += 512) {
            const int i = idx / 384, cc = idx - i * 384;
            const float val = shiftv(P, t0 + i, 2304 + cc, mu);
            if (cc < 128) { const int di = cc >> 6, j = cc & 63; LW[(j * 32 + i) * 4 + di] = tanhf(val); }
            else if (cc < 256) { const int c2 = cc - 128, di = c2 >> 6, j = c2 & 63; LW[(j * 32 + i) * 4 + 2 + di] = val; }
            else GS[(size_t)(t0 + i) * 128 + cc - 256] = sigmoidf_(val);
        }
        __syncthreads();
        for (int q = wave; q < 48; q += 8) {
            const int hd = q % 12, tg = q / 12, c = hd * 64 + lane, tb = t0 + tg * 8;
            float kv[8];
#pragma unroll
            for (int tk = 0; tk < 8; ++tk) { const int t = tb + tk;
                kv[tk] = shiftv(P, t, 768 + c, mu);
                RR[(size_t)t * RW + c] = shiftv(P, t, c, mu);
                RV[(size_t)t * RW + c] = shiftv(P, t, 1536 + c, mu); }
            float aw0[8], aw1[8], aa0[8], aa1[8];
#pragma unroll
            for (int tk = 0; tk < 8; ++tk) { aw0[tk] = 0.f; aw1[tk] = 0.f; aa0[tk] = 0.f; aa1[tk] = 0.f; }
            for (int j = 0; j < 64; ++j) {
                const float wu0 = wup[(size_t)j * RW + c], wu1 = wup[(size_t)(64 + j) * RW + c], au0 = aup[(size_t)j * RW + c], au1 = aup[(size_t)(64 + j) * RW + c];
#pragma unroll
                for (int tk = 0; tk < 8; ++tk) { const f32x4 q4 = *(const LAS f32x4*)(LW + (j * 32 + tg * 8 + tk) * 4);
                    aw0[tk] += q4.x * wu0; aw1[tk] += q4.y * wu1; aa0[tk] += q4.z * au0; aa1[tk] += q4.w * au1; }
            }
#pragma unroll
            for (int di = 0; di < 2; ++di) {
                const float w0c = w0[di * RW + c], a0c = a0[di * RW + c], kkc = kkp[di * RW + c], kac = kap[di * RW + c];
#pragma unroll
                for (int tk = 0; tk < 8; ++tk) { const int t = tb + tk;
                    const float z = w0c + (di ? aw1[tk] : aw0[tk]);
                    const float u = -z; const float sp = fmaxf(u, 0.f) + log1pf(expf(-fabsf(u)));
                    const float wlog = -sp - 0.5f;
                    const float decay = expf(-expf(wlog));
                    const float av = sigmoidf_(a0c + (di ? aa1[tk] : aa0[tk]));
                    const float kr = kv[tk] * kkc;
                    const float nrm = wave_sum(kr * kr);
                    const float kk = kr * rsqrtf(fmaxf(nrm, 1e-24f));
                    const float kd = kv[tk] * (1.f + (av - 1.f) * kac);
                    const size_t o = ((size_t)di * NTOK + t) * RW + c;
                    RWD[o] = decay; RKK[o] = kk; RKKA[o] = kk * av; RKD[o] = kd; }
            }
        }
        __syncthreads();
    }
}

__device__ __forceinline__ void swa_wave_unit(const bf16_t* P, float* OAG, float* LSE, const LAS float* biasA, LAS unsigned char* vbuf, int u, int lane) {
    const int b = u / 768; const int rem = u - b * 768; const int head = rem >> 6, s = rem & 63;
    const int g = head >> 2, hh = head & 3;
    const int dsh = (g == 0) ? 0 : (g == 1) ? 2 : 4;
    const int L = NT >> dsh, nmbsh = 6 - dsh;
    const int r = s >> nmbsh, mb = s & ((1 << nmbsh) - 1);
    const int r32 = lane & 31, hi = lane >> 5;
    const size_t tq = (size_t)b * NT + ((mb * 32 + r32) << dsh) + r;
    bf16x8 qf[4];
    { const bf16_t* qp = P + tq * PLD + C_AQ + head * 64 + 8 * hi;
#pragma unroll
      for (int s4 = 0; s4 < 4; ++s4) qf[s4] = *(const bf16x8*)(qp + 16 * s4); }
    f32x16 o[2]; o[0] = (f32x16){}; o[1] = (f32x16){};
    float m = -1e30f, lsum = 0.f;
    const float SC = 0.125f * LOG2E;
    const LAS float* bh = biasA + head * 129 + 64;
    const int trbase = (4 * hi + ((lane & 15) >> 2)) * 144 + (16 * ((lane >> 4) & 1) + 4 * (lane & 3)) * 2;
    for (int kt = -2; kt <= 2; ++kt) {
        const int m0 = mb * 32 + kt * 32;
        if (m0 + 31 < 0 || m0 >= L) continue;
        bf16x8 kf[4];
        { int km = m0 + r32; km = km < 0 ? 0 : (km > L - 1 ? L - 1 : km);
          const bf16_t* kp = P + ((size_t)b * NT + (km << dsh) + r) * PLD + C_AK + head * 64 + 8 * hi;
#pragma unroll
          for (int s4 = 0; s4 < 4; ++s4) kf[s4] = *(const bf16x8*)(kp + 16 * s4); }
        asm volatile("" ::: "memory");
#pragma unroll
        for (int c4 = 0; c4 < 4; ++c4) { const int id = lane + 64 * c4, row = id >> 3, ch = id & 7;
            int vm = m0 + row; vm = vm < 0 ? 0 : (vm > L - 1 ? L - 1 : vm);
            const u32x4 val = *(const u32x4*)(P + ((size_t)b * NT + (vm << dsh) + r) * PLD + C_AV + head * 64 + ch * 8);
            *(LAS u32x4*)(vbuf + row * 144 + ch * 16) = val; }
        f32x16 sacc = (f32x16){};
#pragma unroll
        for (int s4 = 0; s4 < 4; ++s4) sacc = __builtin_amdgcn_mfma_f32_32x32x16_bf16(kf[s4], qf[s4], sacc, 0, 0, 0);
        float x[16]; float mx = -1e30f;
#pragma unroll
        for (int rg = 0; rg < 16; ++rg) { const int kvl = crow(rg, hi), km = m0 + kvl, j = kt * 32 + kvl - r32;
            const bool valid = (km >= 0) && (km < L) && (j >= -64) && (j <= 64);
            const int jc = j < -64 ? -64 : (j > 64 ? 64 : j);
            const float xv = sacc[rg] * SC + bh[jc];
            x[rg] = valid ? xv : -1e30f; mx = fmaxf(mx, x[rg]); }
        mx = fmaxf(mx, __shfl_xor(mx, 32));
        const float mn = fmaxf(m, mx), alpha = __builtin_amdgcn_exp2f(m - mn); m = mn;
        float ps = 0.f;
#pragma unroll
        for (int rg = 0; rg < 16; ++rg) { x[rg] = __builtin_amdgcn_exp2f(x[rg] - mn); ps += x[rg]; }
        lsum = lsum * alpha + ps;
#pragma unroll
        for (int rg = 0; rg < 16; ++rg) { o[0][rg] *= alpha; o[1][rg] *= alpha; }
        u32x4 pw[2];
#pragma unroll
        for (int s2 = 0; s2 < 2; ++s2) { pw[s2].x = pk2(x[8 * s2 + 0], x[8 * s2 + 1]); pw[s2].y = pk2(x[8 * s2 + 2], x[8 * s2 + 3]); pw[s2].z = pk2(x[8 * s2 + 4], x[8 * s2 + 5]); pw[s2].w = pk2(x[8 * s2 + 6], x[8 * s2 + 7]); }
        lds_fence();
#pragma unroll
        for (int db = 0; db < 2; ++db)
#pragma unroll
            for (int s2 = 0; s2 < 2; ++s2) {
                const s16x4 lo = vtr(vbuf + trbase + (16 * s2) * 144 + db * 64);
                const s16x4 hi4 = vtr(vbuf + trbase + (16 * s2 + 8) * 144 + db * 64);
                const bf16x8 af = (bf16x8){lo[0], lo[1], lo[2], lo[3], hi4[0], hi4[1], hi4[2], hi4[3]};
                o[db] = __builtin_amdgcn_mfma_f32_32x32x16_bf16(af, __builtin_bit_cast(bf16x8, pw[s2]), o[db], 0, 0, 0);
            }
        asm volatile("" ::: "memory");
    }
    const float lt = lsum + __shfl_xor(lsum, 32);
    const float inv = 1.f / lt;
    float* op = OAG + ((size_t)g * NTOK + tq) * 256 + hh * 64;
#pragma unroll
    for (int db = 0; db < 2; ++db)
#pragma unroll
        for (int i = 0; i < 4; ++i) { f32x4 v = (f32x4){o[db][4 * i], o[db][4 * i + 1], o[db][4 * i + 2], o[db][4 * i + 3]} * inv;
            *(f32x4*)(op + db * 32 + 8 * i + 4 * hi) = v; }
    if (hi == 0) LSE[((size_t)g * NTOK + tq) * 4 + hh] = m + __log2f(lt);
}
__device__ __forceinline__ void phase_swa(const Args& a, LAS unsigned char* lds) {
    const int tid = otid(), lane = tid & 63, wave = tid >> 6;
    LAS float* bA = (LAS float*)(lds + 40960);
    const float* bAg = (const float*)(a.ws + WS_MISC + MISC_BIASA);
    for (int i = tid; i < 12 * 129; i += 512) bA[i] = bAg[i];
    __syncthreads();
    for (int item = blockIdx.x; item < 768; item += gridDim.x)
        swa_wave_unit((const bf16_t*)(a.ws + WS_PROJ), (float*)(a.ws + WS_OAG), (float*)(a.ws + WS_LSE), bA, lds + wave * 4608, item * 8 + wave, lane);
    __syncthreads();
}

__device__ __forceinline__ void rwkv_scan_unit(const Args& a, int unit, LAS unsigned char* lds) {
    const int dir = unit & 1, bh = unit >> 1, h = bh % 12, b = bh / 12;
    const int tid = otid(), row = tid >> 3, kp = tid & 7;
    unsigned char* ws = a.ws;
    const size_t base_d = ((size_t)dir * NTOK + (size_t)b * NT) * RW + h * 64;
    const size_t base_s = ((size_t)b * NT) * RW + h * 64;
    const float* src[6] = { (const float*)(ws + WS_RWD) + base_d, (const float*)(ws + WS_RKK) + base_d, (const float*)(ws + WS_RKKA) + base_d, (const float*)(ws + WS_RKD) + base_d,
                            (const float*)(ws + WS_RR) + base_s, (const float*)(ws + WS_RV) + base_s };
    float* Y = (float*)(ws + WS_Y) + base_d;
    LAS float* ybuf = (LAS float*)(lds + 98304);
    const int li = tid >> 4, lc4 = tid & 15;
    float S[8];
#pragma unroll
    for (int i = 0; i < 8; ++i) S[i] = 0.f;
    f32x4 regs[6];
    { const int ts = dir ? NT - 32 : 0;
#pragma unroll
      for (int q = 0; q < 6; ++q) regs[q] = *(const f32x4*)(src[q] + (size_t)(ts + li) * RW + lc4 * 4);
#pragma unroll
      for (int q = 0; q < 6; ++q) *(LAS f32x4*)(lds + ((q * 32 + li) * 64 + lc4 * 4) * 4) = regs[q]; }
    __syncthreads();
    for (int c = 0; c < 64; ++c) {
        const int ts = dir ? NT - 32 * (c + 1) : 32 * c;
        if (c + 1 < 64) { const int tn = dir ? NT - 32 * (c + 2) : 32 * (c + 1);
#pragma unroll
            for (int q = 0; q < 6; ++q) regs[q] = *(const f32x4*)(src[q] + (size_t)(tn + li) * RW + lc4 * 4); }
        const LAS unsigned char* buf = lds + (c & 1) * 49152;
#pragma unroll 4
        for (int ii = 0; ii < 32; ++ii) {
            const int i = dir ? 31 - ii : ii;
            const LAS float* pw = (const LAS float*)(buf + ((0 * 32 + i) * 64 + 8 * kp) * 4);
            const f32x4 w0 = *(const LAS f32x4*)pw, w1 = *(const LAS f32x4*)(pw + 4);
            const f32x4 k0 = *(const LAS f32x4*)(pw + 2048), k1 = *(const LAS f32x4*)(pw + 2048 + 4);
            const f32x4 a0 = *(const LAS f32x4*)(pw + 4096), a1 = *(const LAS f32x4*)(pw + 4096 + 4);
            const f32x4 d0 = *(const LAS f32x4*)(pw + 6144), d1 = *(const LAS f32x4*)(pw + 6144 + 4);
            const f32x4 r0 = *(const LAS f32x4*)(pw + 8192), r1 = *(const LAS f32x4*)(pw + 8192 + 4);
            const float vv = *(const LAS float*)(buf + ((5 * 32 + i) * 64 + row) * 4);
            float sa = S[0] * k0.x + S[1] * k0.y + S[2] * k0.z + S[3] * k0.w + S[4] * k1.x + S[5] * k1.y + S[6] * k1.z + S[7] * k1.w;
            sa = -dpp_sum8(sa);
            S[0] = S[0] * w0.x + sa * a0.x + vv * d0.x; S[1] = S[1] * w0.y + sa * a0.y + vv * d0.y; S[2] = S[2] * w0.z + sa * a0.z + vv * d0.z; S[3] = S[3] * w0.w + sa * a0.w + vv * d0.w;
            S[4] = S[4] * w1.x + sa * a1.x + vv * d1.x; S[5] = S[5] * w1.y + sa * a1.y + vv * d1.y; S[6] = S[6] * w1.z + sa * a1.z + vv * d1.z; S[7] = S[7] * w1.w + sa * a1.w + vv * d1.w;
            float y = S[0] * r0.x + S[1] * r0.y + S[2] * r0.z + S[3] * r0.w + S[4] * r1.x + S[5] * r1.y + S[6] * r1.z + S[7] * r1.w;
            y = dpp_sum8(y);
            if (kp == 0) ybuf[i * 64 + row] = y;
        }
        __syncthreads();
        *(f32x4*)(Y + (size_t)(ts + li) * RW + lc4 * 4) = *(const LAS f32x4*)(ybuf + li * 64 + lc4 * 4);
        if (c + 1 < 64) { LAS unsigned char* nb = lds + ((c + 1) & 1) * 49152;
#pragma unroll
            for (int q = 0; q < 6; ++q) *(LAS f32x4*)(nb + ((q * 32 + li) * 64 + lc4 * 4) * 4) = regs[q]; }
        __syncthreads();
    }
}

constexpr int RLD = 144, RMAT = 64 * RLD;
constexpr int R_P = 0, R_Q = 4 * RMAT, R_M = R_Q + 2 * 17408;
constexpr int R_WD = R_P, R_AD = R_P + RMAT, R_WUP = R_P + 2 * RMAT, R_AUP = R_P + 3 * RMAT;
constexpr int R_LK = R_P, R_RK = R_P + RMAT, R_RB = R_P + 2 * RMAT, R_TT = R_P + 3 * RMAT;
constexpr int R_ZW = R_Q, R_ZA = R_Q + 17408, R_LBF = R_Q, R_SEG = R_ZA, R_GC = R_ZA + 2048, R_W1T = R_ZA + 4096;
constexpr int R_A = R_M, R_B = R_M + 2 * RMAT, R_BP = R_M + 3 * RMAT, R_K = R_M + 4 * RMAT, R_KP = R_M + 5 * RMAT, R_RHO = R_M + 6 * RMAT, R_V = R_M + 7 * RMAT;
constexpr int R_UT = R_B, R_TAT = R_K;
constexpr int R_TMP0 = R_SEG, R_TMP1 = R_ZA + 13312, R_TMP2 = R_ZA + 13312 + 2048;
static_assert(R_M + 8 * RMAT <= LDS_STAGE, "R1 LDS");

template <bool XT, bool YT>
__device__ __forceinline__ f32x16 tile64x(const LAS unsigned char* XM, int x0, const LAS unsigned char* YM, int y0, int lane, f32x16 acc) {
    const int r32 = lane & 31, hi = lane >> 5;
    const int trofs = ((lane & 15) >> 2) * RLD + (16 * ((lane >> 4) & 1) + 4 * (lane & 3)) * 2;
#pragma unroll
    for (int s4 = 0; s4 < 4; ++s4) {
        bf16x8 xa, yb;
        if (!XT) xa = *(const LAS bf16x8*)(XM + (x0 + r32) * RLD + 32 * s4 + 16 * hi);
        else { const s16x4 lo = vtr(XM + (16 * s4 + 8 * hi) * RLD + trofs + 2 * x0), h4 = vtr(XM + (16 * s4 + 8 * hi + 4) * RLD + trofs + 2 * x0);
               xa = (bf16x8){lo[0], lo[1], lo[2], lo[3], h4[0], h4[1], h4[2], h4[3]}; }
        if (!YT) yb = *(const LAS bf16x8*)(YM + (y0 + r32) * RLD + 32 * s4 + 16 * hi);
        else { const s16x4 lo = vtr(YM + (16 * s4 + 8 * hi) * RLD + trofs + 2 * y0), h4 = vtr(YM + (16 * s4 + 8 * hi + 4) * RLD + trofs + 2 * y0);
               yb = (bf16x8){lo[0], lo[1], lo[2], lo[3], h4[0], h4[1], h4[2], h4[3]}; }
        acc = __builtin_amdgcn_mfma_f32_32x32x16_bf16(xa, yb, acc, 0, 0, 0);
    }
    return acc;
}
__device__ __forceinline__ void shift8r(const u32x4 c, u32x4 m, u32x4 n, bool hm, bool hn, const float* mu, int col, float (&o)[8]) {
    const unsigned mm = hm ? 0xffffffffu : 0u, nm = hn ? 0xffffffffu : 0u;
    m = m & mm; n = n & nm;
    const f32x4 a0 = *(const f32x4*)(mu + col), a1 = *(const f32x4*)(mu + col + 4), b0 = *(const f32x4*)(mu + RSTR + col), b1 = *(const f32x4*)(mu + RSTR + col + 4);
#pragma unroll
    for (int q = 0; q < 4; ++q) {
        const float pl = bflo(c[q]), ph = bfhi(c[q]);
        const float m0 = (q < 2) ? a0[2 * q] : a1[2 * q - 4], m1 = (q < 2) ? a0[2 * q + 1] : a1[2 * q - 3];
        const float n0 = (q < 2) ? b0[2 * q] : b1[2 * q - 4], n1 = (q < 2) ? b0[2 * q + 1] : b1[2 * q - 3];
        o[2 * q] = pl + m0 * (bflo(m[q]) - pl) + n0 * (bflo(n[q]) - pl);
        o[2 * q + 1] = ph + m1 * (bfhi(m[q]) - ph) + n1 * (bfhi(n[q]) - ph);
    }
}
__device__ __forceinline__ int r1_col(int g, int h, int dir, int seg) { return (g < 3 ? g * 768 + h * 64 : (g == 3 ? 2304 : 2432) + dir * 64) + 8 * seg; }
__device__ __forceinline__ void r1_issue(const bf16_t* P, int ct, int tid, u32x4 (&raw)[15]) {
    const int c = ct & 31, dir = (ct >> 5) & 1, bh = ct >> 6, h = bh % 12, b = bh / 12, ti = tid >> 3, seg = tid & 7;
    const int tseq = dir ? (NT - 1 - 64 * c - ti) : (64 * c + ti);
    const bf16_t* p0 = P + ((size_t)b * NT + tseq) * PLD + C_BS;
    const int dm = tseq > 0 ? PLD : 0, dn = tseq < NT - 1 ? PLD : 0;
#pragma unroll
    for (int g = 0; g < 5; ++g) { const int col = r1_col(g, h, dir, seg);
        raw[3 * g] = *(const u32x4*)(p0 + col); raw[3 * g + 1] = *(const u32x4*)(p0 + col - dm); raw[3 * g + 2] = *(const u32x4*)(p0 + col + dn); }
}

__device__ __forceinline__ void phase_rwkv_r1(const Args& a, int l, LAS unsigned char* lds) {
    const int tid0 = otid();
    unsigned char* ws = a.ws;
    const bf16_t* P = (const bf16_t*)(ws + WS_PROJ);
    const float* mu = a.in[I_MU] + (size_t)l * 2 * RSTR;
    const int G = gridDim.x;
    u32x4 raw[15];
    if ((int)blockIdx.x < 6144) r1_issue(P, blockIdx.x, tid0, raw);
  for (int ct = blockIdx.x; ct < 6144; ct += G) {
    int tid = tid0; asm volatile("" : "+v"(tid));
    const int lane = tid & 63, wave = __builtin_amdgcn_readfirstlane(tid >> 6), r32 = lane & 31, hi = lane >> 5;
    const int ti = tid >> 3, seg = tid & 7;
    const int c = ct & 31, dir = (ct >> 5) & 1, bh = ct >> 6, h = bh % 12, b = bh / 12;
    const int tseq = dir ? (NT - 1 - 64 * c - ti) : (64 * c + ti);
    const size_t trow = (size_t)b * NT + tseq;
    const bool hm = tseq > 0, hn = tseq < NT - 1;
    float r8[8], k8[8], v8[8];
    {
        shift8r(raw[0], raw[1], raw[2], hm, hn, mu, r1_col(0, h, dir, seg), r8);
        shift8r(raw[3], raw[4], raw[5], hm, hn, mu, r1_col(1, h, dir, seg), k8);
        shift8r(raw[6], raw[7], raw[8], hm, hn, mu, r1_col(2, h, dir, seg), v8);
        float t8[8];
        shift8r(raw[9], raw[10], raw[11], hm, hn, mu, r1_col(3, h, dir, seg), t8);
#pragma unroll
        for (int q = 0; q < 8; ++q) { const float e2 = __expf(2.f * t8[q]); t8[q] = 1.f - 2.f / (e2 + 1.f); }
        *(LAS u32x4*)(lds + R_WD + ti * RLD + 16 * seg) = pack8(t8);
        shift8r(raw[12], raw[13], raw[14], hm, hn, mu, r1_col(4, h, dir, seg), t8);
        *(LAS u32x4*)(lds + R_AD + ti * RLD + 16 * seg) = pack8(t8);
        if (h == 0 && dir == 0) {
            const bf16_t* p0 = P + trow * PLD + C_BS;
            bf16_t* GS = (bf16_t*)(ws + WS_GS) + trow * 256;
#pragma unroll
            for (int hf = 0; hf < 2; ++hf) { const int col = 2560 + 64 * hf + 8 * seg;
                shift8r(*(const u32x4*)(p0 + col), *(const u32x4*)(p0 + col - (hm ? PLD : 0)), *(const u32x4*)(p0 + col + (hn ? PLD : 0)), hm, hn, mu, col, t8);
#pragma unroll
                for (int q = 0; q < 8; ++q) t8[q] = sigmoidf_(t8[q]);
                *(u32x4*)(GS + 64 * hf + 8 * seg) = pack8(t8);
                *(u32x4*)(GS + 128 + 64 * hf + 8 * seg) = (u32x4){0u, 0u, 0u, 0u}; }
        }
        const size_t wofs = ((size_t)(l * 2 + dir) * 12 + h) * 4096 + (size_t)ti * 64 + 8 * seg;
        *(LAS u32x4*)(lds + R_WUP + ti * RLD + 16 * seg) = *(const u32x4*)((const bf16_t*)(ws + WS_MISC + MISC_WUPT) + wofs);
        *(LAS u32x4*)(lds + R_AUP + ti * RLD + 16 * seg) = *(const u32x4*)((const bf16_t*)(ws + WS_MISC + MISC_AUPT) + wofs);
        if (dir == 0) {
            float* RR = (float*)(ws + WS_RR) + trow * RW + h * 64 + 8 * seg; float* RV = (float*)(ws + WS_RV) + trow * RW + h * 64 + 8 * seg;
            *(f32x4*)RR = (f32x4){r8[0], r8[1], r8[2], r8[3]}; *(f32x4*)(RR + 4) = (f32x4){r8[4], r8[5], r8[6], r8[7]};
            *(f32x4*)RV = (f32x4){v8[0], v8[1], v8[2], v8[3]}; *(f32x4*)(RV + 4) = (f32x4){v8[4], v8[5], v8[6], v8[7]};
        }
    }
    if (ct + G < 6144) r1_issue(P, ct + G, tid, raw);
    __syncthreads();
    {
        const int p = wave >> 2, tt = wave & 3, tm = tt >> 1, tn = tt & 1;
        f32x16 acc = (f32x16){};
        acc = tile64x<false, false>(lds + (p ? R_AUP : R_WUP), 32 * tm, lds + (p ? R_AD : R_WD), 32 * tn, lane, acc);
        LAS float* Z = (LAS float*)(lds + (p ? R_ZA : R_ZW));
#pragma unroll
        for (int q = 0; q < 4; ++q) *(LAS f32x4*)(Z + (32 * tn + r32) * 68 + 32 * tm + 8 * q + 4 * hi) = (f32x4){acc[4 * q], acc[4 * q + 1], acc[4 * q + 2], acc[4 * q + 3]};
    }
    __syncthreads();
    float kka8[8], kk8[8], kd8[8];
    {
        const int cb = dir * RW + h * 64 + 8 * seg;
        const float* w0 = a.in[I_W0] + (size_t)l * 2 * RW + cb; const float* a0 = a.in[I_A0] + (size_t)l * 2 * RW + cb;
        const float* kkp = a.in[I_KK] + (size_t)l * 2 * RW + cb; const float* kap = a.in[I_KA] + (size_t)l * 2 * RW + cb;
        LAS float* Zw = (LAS float*)(lds + R_ZW) + ti * 68 + 8 * seg; const LAS float* Za = (const LAS float*)(lds + R_ZA) + ti * 68 + 8 * seg;
        float nrm = 0.f, av[8], e8[8];
#pragma unroll
        for (int q = 0; q < 8; ++q) {
            const float z = w0[q] + Zw[q];
            const float u = -z; const float sp = fmaxf(u, 0.f) + __logf(1.f + __expf(-fabsf(u)));
            e8[q] = __expf(-sp - 0.5f);
            av[q] = sigmoidf_(a0[q] + Za[q]);
            const float kr = k8[q] * kkp[q]; kk8[q] = kr; nrm += kr * kr;
            kd8[q] = k8[q] * (1.f + (av[q] - 1.f) * kap[q]);
        }
        nrm = dpp_sum8(nrm);
        const float rn = rsqrtf(fmaxf(nrm, 1e-24f));
#pragma unroll
        for (int q = 0; q < 8; ++q) { kk8[q] *= rn; kka8[q] = kk8[q] * av[q]; Zw[q] = e8[q]; }
        float* RKD = (float*)(ws + WS_RKD) + ((size_t)dir * NTOK + trow) * RW + h * 64 + 8 * seg;
        *(f32x4*)RKD = (f32x4){kd8[0], kd8[1], kd8[2], kd8[3]}; *(f32x4*)(RKD + 4) = (f32x4){kd8[4], kd8[5], kd8[6], kd8[7]};
    }
    __syncthreads();
    {
        const int kc = tid & 63, sg = tid >> 6;
        LAS float* Zw = (LAS float*)(lds + R_ZW); LAS float* SEG = (LAS float*)(lds + R_SEG);
        float run = 0.f;
#pragma unroll
        for (int q = 0; q < 8; ++q) { run += Zw[(8 * sg + q) * 68 + kc]; Zw[(8 * sg + q) * 68 + kc] = run; }
        SEG[sg * 64 + kc] = run;
        __syncthreads();
        float off = 0.f;
        for (int s2 = 0; s2 < sg; ++s2) off += SEG[s2 * 64 + kc];
#pragma unroll
        for (int q = 0; q < 8; ++q) Zw[(8 * sg + q) * 68 + kc] += off;
    }
    __syncthreads();
    {
        const LAS float* Gp = (const LAS float*)(lds + R_ZW);
        float al[8], be[8], bp[8], ka[8], kp[8], rh[8];
#pragma unroll
        for (int q = 0; q < 8; ++q) {
            const float gi = Gp[ti * 68 + 8 * seg + q], gm = ti > 0 ? Gp[(ti - 1) * 68 + 8 * seg + q] : 0.f, g63 = Gp[63 * 68 + 8 * seg + q];
            const float ig = __expf(gi), tl = __expf(gi - g63);
            al[q] = __expf(-gm) * kk8[q]; be[q] = kka8[q] * ig; bp[q] = kka8[q] * tl; ka[q] = kd8[q] * ig; kp[q] = kd8[q] * tl; rh[q] = r8[q] * __expf(-gi);
            if (ti == 63) ((LAS float*)(lds + R_GC))[8 * seg + q] = __expf(-g63);
        }
        const int o = ti * RLD + 16 * seg;
        *(LAS u32x4*)(lds + R_A + o) = pack8(al); *(LAS u32x4*)(lds + R_B + o) = pack8(be); *(LAS u32x4*)(lds + R_K + o) = pack8(ka); *(LAS u32x4*)(lds + R_RHO + o) = pack8(rh);
        *(LAS u32x4*)(lds + R_BP + o) = pack8(bp); *(LAS u32x4*)(lds + R_KP + o) = pack8(kp); *(LAS u32x4*)(lds + R_V + o) = pack8(v8);
    }
    __syncthreads();
    {
        const int tt = wave & 3, tm = tt >> 1, tn = tt & 1;
        const int jb = 32 * tm, ib = 32 * tn, i = ib + r32;
        f32x16 acc0 = (f32x16){}, acc1 = (f32x16){};
        if (tm <= tn) {
            acc0 = tile64x<false, false>(lds + (wave < 4 ? R_B : R_K), jb, lds + (wave < 4 ? R_A : R_RHO), ib, lane, acc0);
            acc1 = tile64x<false, false>(lds + (wave < 4 ? R_K : R_B), jb, lds + (wave < 4 ? R_A : R_RHO), ib, lane, acc1);
        }
#pragma unroll
        for (int rg = 0; rg < 16; ++rg) { const int j = jb + crow(rg, hi); const bool keep = (wave < 4) ? (j < i) : (j <= i);
            acc0[rg] = keep ? acc0[rg] : 0.f; acc1[rg] = keep ? acc1[rg] : 0.f; }
#pragma unroll
        for (int q = 0; q < 4; ++q) { const int jo = jb + 8 * q + 4 * hi;
            u32x2 w1; w1.x = pk2(acc1[4 * q], acc1[4 * q + 1]); w1.y = pk2(acc1[4 * q + 2], acc1[4 * q + 3]);
            if (wave < 4) {
                *(LAS f32x4*)((LAS float*)(lds + R_LBF) + i * 68 + jo) = (f32x4){acc0[4 * q], acc0[4 * q + 1], acc0[4 * q + 2], acc0[4 * q + 3]};
                *(LAS u32x2*)(lds + R_LK + i * RLD + 2 * jo) = w1;
                if (wave == 1) { u32x2 wl; wl.x = pk2(acc0[4 * q], acc0[4 * q + 1]); wl.y = pk2(acc0[4 * q + 2], acc0[4 * q + 3]);
                    *(LAS u32x2*)(lds + R_TMP0 + r32 * 64 + 2 * (8 * q + 4 * hi)) = wl; }
            } else {
                u32x2 w0; w0.x = pk2(acc0[4 * q], acc0[4 * q + 1]); w0.y = pk2(acc0[4 * q + 2], acc0[4 * q + 3]);
                *(LAS u32x2*)(lds + R_RK + i * RLD + 2 * jo) = w0;
                *(LAS u32x2*)(lds + R_RB + i * RLD + 2 * jo) = w1;
            } }
    }
    __syncthreads();
    if (wave < 2) {
        const int blk = wave, col = r32;
        const LAS float* Lf = (const LAS float*)(lds + R_LBF) + (32 * blk) * 68 + 32 * blk;
        float Tm[32];
        f32x4 cur[8], nxt[8];
#pragma unroll
        for (int m4 = 0; m4 < 8; ++m4) { cur[m4] = (f32x4){0.f, 0.f, 0.f, 0.f}; nxt[m4] = (f32x4){0.f, 0.f, 0.f, 0.f}; }
        cur[0] = *(const LAS f32x4*)(Lf + 68);
        Tm[0] = (col == 0) ? 1.f : 0.f;
#pragma unroll
        for (int i = 1; i < 32; ++i) {
            if (i + 1 < 32) {
#pragma unroll
                for (int m4 = 0; m4 < (i + 4) / 4; ++m4) nxt[m4] = *(const LAS f32x4*)(Lf + (i + 1) * 68 + 4 * m4);
            }
            float c0 = (col == i) ? 1.f : 0.f, c1 = 0.f, c2 = 0.f, c3 = 0.f;
#pragma unroll
            for (int m4 = 0; m4 < (i + 3) / 4; ++m4) {
                if (4 * m4 + 0 < i) c0 -= cur[m4][0] * Tm[4 * m4 + 0];
                if (4 * m4 + 1 < i) c1 -= cur[m4][1] * Tm[4 * m4 + 1];
                if (4 * m4 + 2 < i) c2 -= cur[m4][2] * Tm[4 * m4 + 2];
                if (4 * m4 + 3 < i) c3 -= cur[m4][3] * Tm[4 * m4 + 3]; }
            Tm[i] = (c0 + c1) + (c2 + c3);
#pragma unroll
            for (int m4 = 0; m4 < 8; ++m4) cur[m4] = nxt[m4];
            asm volatile("" : "+v"(Tm[i]) :: "memory");
        }
        if (hi == 0) {
#pragma unroll
            for (int i = 0; i < 32; ++i) {
                *(LAS bf16_t*)(lds + R_TT + (32 * blk + i) * RLD + 2 * (32 * blk + col)) = f2bf(Tm[i]);
                if (blk == 0) *(LAS bf16_t*)(lds + R_TT + i * RLD + 2 * (32 + col)) = (bf16_t)0;
            }
            if (blk == 0) {
#pragma unroll
                for (int q = 0; q < 4; ++q) { float x8[8];
#pragma unroll
                    for (int e = 0; e < 8; ++e) x8[e] = Tm[8 * q + e];
                    *(LAS u32x4*)(lds + R_TMP1 + col * 64 + 16 * q) = pack8(x8); } }
        }
    } else if (wave >= 4) {
        const int tt = wave & 3, tm = tt >> 1, tn = tt & 1;
        f32x16 acc = (f32x16){};
        acc = tile64x<false, true>(lds + R_LK, 32 * tm, lds + R_V, 32 * tn, lane, acc);
#pragma unroll
        for (int q = 0; q < 4; ++q) { u32x2 w; w.x = pk2(acc[4 * q], acc[4 * q + 1]); w.y = pk2(acc[4 * q + 2], acc[4 * q + 3]);
            *(LAS u32x2*)(lds + R_W1T + (32 * tn + r32) * RLD + 2 * (32 * tm + 8 * q + 4 * hi)) = w; }
    }
    __syncthreads();
    if (wave == 0) {
        f32x16 x1 = (f32x16){};
#pragma unroll
        for (int s2 = 0; s2 < 2; ++s2) x1 = __builtin_amdgcn_mfma_f32_32x32x16_bf16(*(const LAS bf16x8*)(lds + R_TMP0 + r32 * 64 + 32 * s2 + 16 * hi), *(const LAS bf16x8*)(lds + R_TMP1 + r32 * 64 + 32 * s2 + 16 * hi), x1, 0, 0, 0);
#pragma unroll
        for (int q = 0; q < 4; ++q) { u32x2 w; w.x = pk2(x1[4 * q], x1[4 * q + 1]); w.y = pk2(x1[4 * q + 2], x1[4 * q + 3]);
            *(LAS u32x2*)(lds + R_TMP2 + r32 * 64 + 2 * (8 * q + 4 * hi)) = w; }
        lds_fence();
        f32x16 t21 = (f32x16){};
#pragma unroll
        for (int s2 = 0; s2 < 2; ++s2) t21 = __builtin_amdgcn_mfma_f32_32x32x16_bf16(*(const LAS bf16x8*)(lds + R_TT + (32 + r32) * RLD + 64 + 32 * s2 + 16 * hi), *(const LAS bf16x8*)(lds + R_TMP2 + r32 * 64 + 32 * s2 + 16 * hi), t21, 0, 0, 0);
#pragma unroll
        for (int rg = 0; rg < 16; ++rg) *(LAS bf16_t*)(lds + R_TT + (32 + crow(rg, hi)) * RLD + 2 * r32) = f2bf(-t21[rg]);
    }
    __syncthreads();
    {
        const int tt = wave & 3, tm = tt >> 1, tn = tt & 1;
        f32x16 acc = (f32x16){};
        if (wave < 4) acc = tile64x<false, false>(lds + R_TT, 32 * tm, lds + R_W1T, 32 * tn, lane, acc);
        else          acc = tile64x<false, true>(lds + R_TT, 32 * tm, lds + R_A, 32 * tn, lane, acc);
        LAS unsigned char* dst = lds + (wave < 4 ? R_UT : R_TAT);
#pragma unroll
        for (int q = 0; q < 4; ++q) { u32x2 w; w.x = pk2(acc[4 * q], acc[4 * q + 1]); w.y = pk2(acc[4 * q + 2], acc[4 * q + 3]);
            *(LAS u32x2*)(dst + (32 * tn + r32) * RLD + 2 * (32 * tm + 8 * q + 4 * hi)) = w; }
    }
    __syncthreads();
    {
        const int tt = wave & 3, tm = tt >> 1, tn = tt & 1;
        const size_t cto = (size_t)ct * 4096;
        if (wave < 4) {
            f32x16 acc = (f32x16){};
            acc = tile64x<false, false>(lds + R_TAT, 32 * tm, lds + R_RB, 32 * tn, lane, acc);
            bf16_t* QA = (bf16_t*)(ws + WS_QA) + cto;
#pragma unroll
            for (int q = 0; q < 4; ++q) { const int i = 32 * tn + r32, k = 32 * tm + 8 * q + 4 * hi;
                const u32x2 rv = *(const LAS u32x2*)(lds + R_RHO + i * RLD + 2 * k);
                u32x2 w; w.x = pk2(bflo(rv.x) - acc[4 * q], bfhi(rv.x) - acc[4 * q + 1]); w.y = pk2(bflo(rv.y) - acc[4 * q + 2], bfhi(rv.y) - acc[4 * q + 3]);
                *(u32x2*)(QA + ((tn * 4 + 2 * tm + (q >> 1)) * 64 + (q & 1) * 32 + r32) * 8 + 4 * hi) = w; }
            f32x16 am = (f32x16){};
            am = tile64x<true, false>(lds + R_BP, 32 * tm, lds + R_TAT, 32 * tn, lane, am);
            float* MP = (float*)(ws + WS_MP) + cto; const LAS float* GC = (const LAS float*)(lds + R_GC);
#pragma unroll
            for (int q = 0; q < 4; ++q) { const int k = 32 * tn + r32, kp0 = 32 * tm + 8 * q + 4 * hi; f32x4 o4;
#pragma unroll
                for (int e = 0; e < 4; ++e) o4[e] = ((kp0 + e == k) ? GC[kp0 + e] : 0.f) - am[4 * q + e];
                *(f32x4*)(MP + k * 64 + kp0) = o4; }
        } else {
            f32x16 a1 = (f32x16){}, a2 = (f32x16){};
            a1 = tile64x<true, false>(lds + R_V, 32 * tm, lds + R_RK, 32 * tn, lane, a1);
            a2 = tile64x<false, false>(lds + R_UT, 32 * tm, lds + R_RB, 32 * tn, lane, a2);
            float* Y0 = (float*)(ws + WS_Y0) + cto + tt * 1024 + lane;
#pragma unroll
            for (int rg = 0; rg < 16; ++rg) Y0[rg * 64] = a1[rg] - a2[rg];
            f32x16 n1 = (f32x16){}, n2 = (f32x16){};
            n1 = tile64x<true, true>(lds + R_KP, 32 * tm, lds + R_V, 32 * tn, lane, n1);
            n2 = tile64x<true, false>(lds + R_BP, 32 * tm, lds + R_UT, 32 * tn, lane, n2);
            float* NP = (float*)(ws + WS_NP) + cto;
#pragma unroll
            for (int q = 0; q < 4; ++q) *(f32x4*)(NP + (32 * tn + r32) * 64 + 32 * tm + 8 * q + 4 * hi) = (f32x4){n1[4 * q] - n2[4 * q], n1[4 * q + 1] - n2[4 * q + 1], n1[4 * q + 2] - n2[4 * q + 2], n1[4 * q + 3] - n2[4 * q + 3]};
        }
    }
    __syncthreads();
  }
}

__device__ __forceinline__ void rwkv_r2_unit(const Args& a, int unit, LAS unsigned char* lds) {
    const int tid = otid(), lane = tid & 63, wave = __builtin_amdgcn_readfirstlane(tid >> 6);
    unsigned char* ws = a.ws;
    LAS float* S = (LAS float*)lds;
    const int vb = wave >> 1, kb0 = 2 * (wave & 1), l15 = lane & 15, lq = lane >> 4;
    for (int i = tid; i < 64 * 68; i += 512) S[i] = 0.f;
    const float* MPb = (const float*)(ws + WS_MP) + (size_t)unit * 32 * 4096; const float* NPb = (const float*)(ws + WS_NP) + (size_t)unit * 32 * 4096;
    bf16_t* SSb = (bf16_t*)(ws + WS_SS) + (size_t)unit * 32 * 4096;
    float Bm[2][16]; f32x4 acc[2];
#pragma unroll
    for (int t2 = 0; t2 < 2; ++t2) {
#pragma unroll
        for (int ks = 0; ks < 16; ++ks) Bm[t2][ks] = MPb[(4 * ks + lq) * 64 + 16 * (kb0 + t2) + l15];
#pragma unroll
        for (int rg = 0; rg < 4; ++rg) acc[t2][rg] = NPb[(16 * vb + 4 * lq + rg) * 64 + 16 * (kb0 + t2) + l15]; }
    __syncthreads();
    for (int c = 0; c < 32; ++c) {
        { const int v = tid >> 3, sg = tid & 7; const LAS float* sp = S + v * 68 + 8 * sg; float x[8];
#pragma unroll
          for (int q = 0; q < 8; ++q) x[q] = sp[q];
          *(u32x4*)(SSb + (size_t)c * 4096 + v * 64 + 8 * sg) = pack8(x); }
#pragma unroll
        for (int ks = 0; ks < 16; ++ks) { const float av = S[(16 * vb + l15) * 68 + 4 * ks + lq];
            acc[0] = __builtin_amdgcn_mfma_f32_16x16x4f32(av, Bm[0][ks], acc[0], 0, 0, 0);
            acc[1] = __builtin_amdgcn_mfma_f32_16x16x4f32(av, Bm[1][ks], acc[1], 0, 0, 0); }
        __syncthreads();
#pragma unroll
        for (int t2 = 0; t2 < 2; ++t2)
#pragma unroll
            for (int rg = 0; rg < 4; ++rg) S[(16 * vb + 4 * lq + rg) * 68 + 16 * (kb0 + t2) + l15] = acc[t2][rg];
        if (c + 1 < 32) { const float* MPc = MPb + (size_t)(c + 1) * 4096; const float* NPc = NPb + (size_t)(c + 1) * 4096;
#pragma unroll
            for (int t2 = 0; t2 < 2; ++t2) {
#pragma unroll
                for (int ks = 0; ks < 16; ++ks) Bm[t2][ks] = MPc[(4 * ks + lq) * 64 + 16 * (kb0 + t2) + l15];
#pragma unroll
                for (int rg = 0; rg < 4; ++rg) acc[t2][rg] = NPc[(16 * vb + 4 * lq + rg) * 64 + 16 * (kb0 + t2) + l15]; } }
        __syncthreads();
    }
}

__device__ __forceinline__ void phase_rwkv_out(const Args& a, int l) {
    const int tid = otid(), lane = tid & 63, wave = tid >> 6, r32 = lane & 31, hi = lane >> 5;
    unsigned char* ws = a.ws;
    const bf16_t* SSg = (const bf16_t*)(ws + WS_SS); const bf16_t* QAg = (const bf16_t*)(ws + WS_QA); const float* Y0g = (const float*)(ws + WS_Y0);
    const float* RR = (const float*)(ws + WS_RR); const float* RV = (const float*)(ws + WS_RV); const float* RKD = (const float*)(ws + WS_RKD);
    const bf16_t* GG = (const bf16_t*)(ws + WS_GG); bf16_t* OB = (bf16_t*)(ws + WS_OB);
    const float* rk = a.in[I_RK] + (size_t)l * RW; const float* lng = a.in[I_LNG] + (size_t)l * RW; const float* lnb = a.in[I_LNB] + (size_t)l * RW;
    for (int wt = blockIdx.x * 8 + wave; wt < 6144; wt += gridDim.x * 8) {
        const int tq = wt & 63, bh = wt >> 6, h = bh % 12, b = bh / 12, c = tq >> 1, tn = tq & 1, tnb = 1 - tn;
        const size_t ctf = ((size_t)bh * 2 + 0) * 32 + c, ctb = ((size_t)bh * 2 + 1) * 32 + (31 - c);
        const size_t t = (size_t)b * NT + 64 * c + 32 * tn + r32;
        const int srcl = (lane & 32) + 31 - r32;
        float y[2][16];
#pragma unroll
        for (int tm = 0; tm < 2; ++tm) {
            f32x16 af, ab;
            const float* y0f = Y0g + ctf * 4096 + (tm * 2 + tn) * 1024 + lane; const float* y0b = Y0g + ctb * 4096 + (tm * 2 + tnb) * 1024 + lane;
#pragma unroll
            for (int rg = 0; rg < 16; ++rg) { af[rg] = y0f[rg * 64]; ab[rg] = y0b[rg * 64]; }
#pragma unroll
            for (int s4 = 0; s4 < 4; ++s4) {
                const bf16x8 xf = *(const bf16x8*)(SSg + ctf * 4096 + (32 * tm + r32) * 64 + 16 * s4 + 8 * hi);
                const bf16x8 yf = *(const bf16x8*)(QAg + ctf * 4096 + ((tn * 4 + s4) * 64 + lane) * 8);
                af = __builtin_amdgcn_mfma_f32_32x32x16_bf16(xf, yf, af, 0, 0, 0);
                const bf16x8 xb = *(const bf16x8*)(SSg + ctb * 4096 + (32 * tm + r32) * 64 + 16 * s4 + 8 * hi);
                const bf16x8 yb = *(const bf16x8*)(QAg + ctb * 4096 + ((tnb * 4 + s4) * 64 + lane) * 8);
                ab = __builtin_amdgcn_mfma_f32_32x32x16_bf16(xb, yb, ab, 0, 0, 0);
            }
#pragma unroll
            for (int rg = 0; rg < 16; ++rg) y[tm][rg] = af[rg] + __shfl(ab[rg], srcl);
        }
        float sm = 0.f;
#pragma unroll
        for (int tm = 0; tm < 2; ++tm)
#pragma unroll
            for (int rg = 0; rg < 16; ++rg) sm += y[tm][rg];
        sm += __shfl_xor(sm, 32);
        const float mean = sm * (1.f / 64.f);
        float sv = 0.f;
#pragma unroll
        for (int tm = 0; tm < 2; ++tm)
#pragma unroll
            for (int rg = 0; rg < 16; ++rg) { const float d = y[tm][rg] - mean; y[tm][rg] = d; sv += d * d; }
        sv += __shfl_xor(sv, 32);
        const float rstd = rsqrtf(sv * (1.f / 64.f) + 64e-5f);
        float s0 = 0.f, s1 = 0.f;
        { const size_t o = t * RW + h * 64 + 32 * hi;
#pragma unroll
          for (int q = 0; q < 8; ++q) { const f32x4 r4 = *(const f32x4*)(RR + o + 4 * q), k0 = *(const f32x4*)(RKD + o + 4 * q), k1 = *(const f32x4*)(RKD + (size_t)NTOK * RW + o + 4 * q), w4 = *(const f32x4*)(rk + h * 64 + 32 * hi + 4 * q);
              const f32x4 rw = r4 * w4;
              s0 += rw.x * k0.x + rw.y * k0.y + rw.z * k0.z + rw.w * k0.w; s1 += rw.x * k1.x + rw.y * k1.y + rw.z * k1.z + rw.w * k1.w; } }
        s0 += s1; s0 += __shfl_xor(s0, 32);
#pragma unroll
        for (int tm = 0; tm < 2; ++tm)
#pragma unroll
            for (int q = 0; q < 4; ++q) { const int cc = h * 64 + 32 * tm + 8 * q + 4 * hi;
                const f32x4 g4 = *(const f32x4*)(lng + cc), b4 = *(const f32x4*)(lnb + cc), v4 = *(const f32x4*)(RV + t * RW + cc);
                const u32x2 gg = *(const u32x2*)(GG + t * RW + cc);
                const float o0 = (y[tm][4 * q] * rstd * g4.x + b4.x + s0 * v4.x) * bflo(gg.x), o1 = (y[tm][4 * q + 1] * rstd * g4.y + b4.y + s0 * v4.y) * bfhi(gg.x);
                const float o2 = (y[tm][4 * q + 2] * rstd * g4.z + b4.z + s0 * v4.z) * bflo(gg.y), o3 = (y[tm][4 * q + 3] * rstd * g4.w + b4.w + s0 * v4.w) * bfhi(gg.y);
                u32x2 w; w.x = pk2(o0, o1); w.y = pk2(o2, o3);
                *(u32x2*)(OB + t * RW + cc) = w; }
    }
    const float* OAG = (const float*)(ws + WS_OAG); const float* LSE = (const float*)(ws + WS_LSE); bf16_t* OA = (bf16_t*)(ws + WS_OA);
    for (int task = blockIdx.x * 8 + wave; task < NTOK / 4; task += gridDim.x * 8) {
#pragma unroll
        for (int tk = 0; tk < 4; ++tk) { const size_t t = (size_t)task * 4 + tk; const int hh = lane >> 4;
            const float l0 = LSE[((size_t)0 * NTOK + t) * 4 + hh], l1 = LSE[((size_t)1 * NTOK + t) * 4 + hh], l2 = LSE[((size_t)2 * NTOK + t) * 4 + hh];
            const float mx = fmaxf(l0, fmaxf(l1, l2));
            const float w0 = __builtin_amdgcn_exp2f(l0 - mx), w1 = __builtin_amdgcn_exp2f(l1 - mx), w2 = __builtin_amdgcn_exp2f(l2 - mx);
            const float inv = 1.f / (w0 + w1 + w2);
            const f32x4 o0 = *(const f32x4*)(OAG + ((size_t)0 * NTOK + t) * 256 + lane * 4), o1 = *(const f32x4*)(OAG + ((size_t)1 * NTOK + t) * 256 + lane * 4), o2 = *(const f32x4*)(OAG + ((size_t)2 * NTOK + t) * 256 + lane * 4);
            const f32x4 r = (o0 * w0 + o1 * w1 + o2 * w2) * inv;
            u32x2 w; w.x = pk2(r.x, r.y); w.y = pk2(r.z, r.w);
            *(u32x2*)(OA + t * 256 + lane * 4) = w; }
    }
}

__device__ __forceinline__ void diffattn_unit(const Args& a, int l, int unit, LAS unsigned char* lds) {
    constexpr int RS = 272;
    const int b = unit / 96; const int rem = unit - b * 96; const int h = rem >> 4, qb = rem & 15;
    const int tid = otid(), lane = tid & 63, wave = __builtin_amdgcn_readfirstlane(tid >> 6), r32 = lane & 31, hi = lane >> 5;
    const int c = wave & 1, qblk = wave >> 1;
    const int q0 = qb * 128 + qblk * 32;
    const bf16_t* P = (const bf16_t*)(a.ws + WS_PROJ);
    const size_t rowb = (size_t)b * NT;
    bf16x8 qf[4];
    { const bf16_t* qp = P + (rowb + q0 + r32) * PLD + C_CQ + h * 128 + c * 64 + 8 * hi;
#pragma unroll
      for (int s4 = 0; s4 < 4; ++s4) qf[s4] = *(const bf16x8*)(qp + 16 * s4); }
    LAS float* biasL = (LAS float*)(lds + 69632);
    { const float* bC = (const float*)(a.ws + WS_MISC + MISC_BIASC) + h * 257;
      for (int i = tid; i < 257; i += 512) biasL[i] = bC[i]; }
    const int srow0 = tid >> 4, sch = tid & 15;
    const bf16_t* kg = P + (rowb + srow0) * PLD + C_CK + h * 128 + sch * 8;
    const bf16_t* vg = P + (rowb + srow0) * PLD + C_CV + h * 128 + sch * 8;
    u32x4 kr[2], vr[2];
#pragma unroll
    for (int i = 0; i < 2; ++i) { kr[i] = *(const u32x4*)(kg + (size_t)(32 * i) * PLD); vr[i] = *(const u32x4*)(vg + (size_t)(32 * i) * PLD); }
#pragma unroll
    for (int i = 0; i < 2; ++i) { *(LAS u32x4*)(lds + (srow0 + 32 * i) * RS + sch * 16) = kr[i]; *(LAS u32x4*)(lds + 34816 + (srow0 + 32 * i) * RS + sch * 16) = vr[i]; }
    __syncthreads();
    f32x16 o[4];
#pragma unroll
    for (int db = 0; db < 4; ++db) o[db] = (f32x16){};
    float m = -1e30f, lsum = 0.f;
    const float SC = 0.125f * LOG2E;
    const int trb = (4 * hi + ((lane & 15) >> 2)) * RS + (16 * ((lane >> 4) & 1) + 4 * (lane & 3)) * 2;
    const int qabs = q0 + r32;
    for (int t = 0; t < 32; ++t) {
        if (t + 1 < 32) {
#pragma unroll
            for (int i = 0; i < 2; ++i) { kr[i] = *(const u32x4*)(kg + (size_t)(64 * (t + 1) + 32 * i) * PLD); vr[i] = *(const u32x4*)(vg + (size_t)(64 * (t + 1) + 32 * i) * PLD); } }
        const LAS unsigned char* Kb = lds + (t & 1) * 17408;
        const LAS unsigned char* Vb = lds + 34816 + (t & 1) * 17408;
        f32x16 sa0 = (f32x16){}, sa1 = (f32x16){};
#pragma unroll
        for (int s4 = 0; s4 < 4; ++s4) {
            const bf16x8 kf0 = *(const LAS bf16x8*)(Kb + r32 * RS + c * 128 + 32 * s4 + 16 * hi);
            const bf16x8 kf1 = *(const LAS bf16x8*)(Kb + (32 + r32) * RS + c * 128 + 32 * s4 + 16 * hi);
            sa0 = __builtin_amdgcn_mfma_f32_32x32x16_bf16(kf0, qf[s4], sa0, 0, 0, 0);
            sa1 = __builtin_amdgcn_mfma_f32_32x32x16_bf16(kf1, qf[s4], sa1, 0, 0, 0);
        }
        float x0[16], x1[16];
        const int kv0 = 64 * t;
        const bool farp = (kv0 >= q0 + 31 + 128), farn = (kv0 + 63 + 128 <= q0);
        if (farp || farn) { const float cb = farp ? biasL[256] : biasL[0];
#pragma unroll
            for (int rg = 0; rg < 16; ++rg) { x0[rg] = sa0[rg] * SC + cb; x1[rg] = sa1[rg] * SC + cb; }
        } else {
#pragma unroll
            for (int rg = 0; rg < 16; ++rg) { int rel = kv0 + crow(rg, hi) - qabs; int rc = rel < -128 ? -128 : (rel > 128 ? 128 : rel);
                x0[rg] = sa0[rg] * SC + biasL[rc + 128];
                rel += 32; rc = rel < -128 ? -128 : (rel > 128 ? 128 : rel);
                x1[rg] = sa1[rg] * SC + biasL[rc + 128]; }
        }
        float mx = fmaxf(x0[0], x1[0]);
#pragma unroll
        for (int rg = 1; rg < 16; ++rg) mx = fmaxf(mx, fmaxf(x0[rg], x1[rg]));
        mx = fmaxf(mx, __shfl_xor(mx, 32));
        const float mn = fmaxf(m, mx), alpha = __builtin_amdgcn_exp2f(m - mn); m = mn;
        float ps = 0.f;
#pragma unroll
        for (int rg = 0; rg < 16; ++rg) { x0[rg] = __builtin_amdgcn_exp2f(x0[rg] - mn); x1[rg] = __builtin_amdgcn_exp2f(x1[rg] - mn); ps += x0[rg] + x1[rg]; }
        lsum = lsum * alpha + ps;
#pragma unroll
        for (int db = 0; db < 4; ++db)
#pragma unroll
            for (int rg = 0; rg < 16; ++rg) o[db][rg] *= alpha;
        u32x4 pw[4];
#pragma unroll
        for (int s2 = 0; s2 < 2; ++s2) {
            pw[s2].x = pk2(x0[8 * s2 + 0], x0[8 * s2 + 1]); pw[s2].y = pk2(x0[8 * s2 + 2], x0[8 * s2 + 3]); pw[s2].z = pk2(x0[8 * s2 + 4], x0[8 * s2 + 5]); pw[s2].w = pk2(x0[8 * s2 + 6], x0[8 * s2 + 7]);
            pw[2 + s2].x = pk2(x1[8 * s2 + 0], x1[8 * s2 + 1]); pw[2 + s2].y = pk2(x1[8 * s2 + 2], x1[8 * s2 + 3]); pw[2 + s2].z = pk2(x1[8 * s2 + 4], x1[8 * s2 + 5]); pw[2 + s2].w = pk2(x1[8 * s2 + 6], x1[8 * s2 + 7]); }
#pragma unroll
        for (int db = 0; db < 4; ++db)
#pragma unroll
            for (int s = 0; s < 4; ++s) {
                const s16x4 lo = vtr(Vb + trb + (16 * s) * RS + db * 64);
                const s16x4 hi4 = vtr(Vb + trb + (16 * s + 8) * RS + db * 64);
                const bf16x8 af = (bf16x8){lo[0], lo[1], lo[2], lo[3], hi4[0], hi4[1], hi4[2], hi4[3]};
                o[db] = __builtin_amdgcn_mfma_f32_32x32x16_bf16(af, __builtin_bit_cast(bf16x8, pw[s]), o[db], 0, 0, 0);
            }
        if (t + 1 < 32) { LAS unsigned char* Kn = lds + ((t + 1) & 1) * 17408; LAS unsigned char* Vn = lds + 34816 + ((t + 1) & 1) * 17408;
#pragma unroll
            for (int i = 0; i < 2; ++i) { *(LAS u32x4*)(Kn + (srow0 + 32 * i) * RS + sch * 16) = kr[i]; *(LAS u32x4*)(Vn + (srow0 + 32 * i) * RS + sch * 16) = vr[i]; } }
        __syncthreads();
    }
    const float lt = lsum + __shfl_xor(lsum, 32);
    const float inv = 1.f / lt;
    const float* lamp = (const float*)(a.ws + WS_MISC + MISC_LAM);
    const float lam = lamp[l], linit = lamp[2 + l];
    LAS float* XO = (LAS float*)lds;
    if (c == 1) {
        const float f = inv * lam;
#pragma unroll
        for (int db = 0; db < 4; ++db)
#pragma unroll
            for (int rg = 0; rg < 16; ++rg) XO[(qblk * 64 + db * 16 + rg) * 64 + lane] = o[db][rg] * f;
    }
    __syncthreads();
    if (c == 0) {
        float ss = 0.f;
#pragma unroll
        for (int db = 0; db < 4; ++db)
#pragma unroll
            for (int rg = 0; rg < 16; ++rg) { const float v = o[db][rg] * inv - XO[(qblk * 64 + db * 16 + rg) * 64 + lane]; o[db][rg] = v; ss += v * v; }
        ss += __shfl_xor(ss, 32);
        const float sc = rsqrtf(ss * (1.f / 128.f) + 1e-5f) * (1.f - linit);
        const float* sg = a.in[I_SUBG] + (size_t)l * 128;
        bf16_t* op = (bf16_t*)(a.ws + WS_OC) + (rowb + q0 + r32) * 768 + h * 128;
#pragma unroll
        for (int db = 0; db < 4; ++db)
#pragma unroll
            for (int i = 0; i < 4; ++i) { const int d = db * 32 + 8 * i + 4 * hi; const f32x4 g4 = *(const f32x4*)(sg + d);
                u32x2 w; w.x = pk2(o[db][4 * i] * sc * g4.x, o[db][4 * i + 1] * sc * g4.y); w.y = pk2(o[db][4 * i + 2] * sc * g4.z, o[db][4 * i + 3] * sc * g4.w);
                *(u32x2*)(op + d) = w; }
    }
    __syncthreads();
}

__device__ __forceinline__ void phase_post(const Args& a, int l) {
    const int tid = otid(), lane = tid & 63, wave = tid >> 6;
    unsigned char* ws = a.ws;
    const float* OAG = (const float*)(ws + WS_OAG); const float* LSE = (const float*)(ws + WS_LSE);
    bf16_t* OA = (bf16_t*)(ws + WS_OA); bf16_t* OB = (bf16_t*)(ws + WS_OB);
    const float* GS = (const float*)(ws + WS_GS); const float* Y = (const float*)(ws + WS_Y);
    const float* RR = (const float*)(ws + WS_RR); const float* RV = (const float*)(ws + WS_RV); const float* RKD = (const float*)(ws + WS_RKD);
    const float* gup = a.in[I_GUP] + (size_t)l * 128 * RW;
    const float* rk = a.in[I_RK] + (size_t)l * RW; const float* lng = a.in[I_LNG] + (size_t)l * RW; const float* lnb = a.in[I_LNB] + (size_t)l * RW;
    for (int task = blockIdx.x * 8 + wave; task < NTOK / 4; task += gridDim.x * 8) {
        const int t0 = task * 4;
#pragma unroll
        for (int tk = 0; tk < 4; ++tk) { const size_t t = t0 + tk; const int hh = lane >> 4;
            const float l0 = LSE[((size_t)0 * NTOK + t) * 4 + hh], l1 = LSE[((size_t)1 * NTOK + t) * 4 + hh], l2 = LSE[((size_t)2 * NTOK + t) * 4 + hh];
            const float mx = fmaxf(l0, fmaxf(l1, l2));
            const float w0 = __builtin_amdgcn_exp2f(l0 - mx), w1 = __builtin_amdgcn_exp2f(l1 - mx), w2 = __builtin_amdgcn_exp2f(l2 - mx);
            const float inv = 1.f / (w0 + w1 + w2);
            const f32x4 o0 = *(const f32x4*)(OAG + ((size_t)0 * NTOK + t) * 256 + lane * 4), o1 = *(const f32x4*)(OAG + ((size_t)1 * NTOK + t) * 256 + lane * 4), o2 = *(const f32x4*)(OAG + ((size_t)2 * NTOK + t) * 256 + lane * 4);
            const f32x4 r = (o0 * w0 + o1 * w1 + o2 * w2) * inv;
            u32x2 w; w.x = pk2(r.x, r.y); w.y = pk2(r.z, r.w);
            *(u32x2*)(OA + t * 256 + lane * 4) = w; }
        float gsr[4][2];
#pragma unroll
        for (int tk = 0; tk < 4; ++tk) { gsr[tk][0] = GS[(size_t)(t0 + tk) * 128 + lane]; gsr[tk][1] = GS[(size_t)(t0 + tk) * 128 + 64 + lane]; }
        float gacc[12][4];
#pragma unroll
        for (int i = 0; i < 12; ++i)
#pragma unroll
            for (int tk = 0; tk < 4; ++tk) gacc[i][tk] = 0.f;
#pragma unroll
        for (int jh = 0; jh < 2; ++jh)
            for (int j = 0; j < 64; ++j) {
                float gv[4];
#pragma unroll
                for (int tk = 0; tk < 4; ++tk) gv[tk] = __builtin_bit_cast(float, __builtin_amdgcn_readlane(__builtin_bit_cast(int, gsr[tk][jh]), j));
                const float* gp = gup + (size_t)(jh * 64 + j) * RW + lane;
#pragma unroll
                for (int i = 0; i < 12; ++i) { const float gu = gp[i * 64];
#pragma unroll
                    for (int tk = 0; tk < 4; ++tk) gacc[i][tk] += gv[tk] * gu; }
            }
#pragma unroll
        for (int tk = 0; tk < 4; ++tk) { const size_t t = t0 + tk;
#pragma unroll
            for (int i = 0; i < 12; ++i) { const int c = i * 64 + lane;
                const float y = Y[t * RW + c] + Y[((size_t)NTOK + t) * RW + c];
                const float mean = wave_sum(y) * (1.f / 64.f);
                const float dv = y - mean;
                const float var = wave_sum(dv * dv) * (1.f / 64.f);
                const float yn = dv * rsqrtf(var + 64e-5f) * lng[c] + lnb[c];
                const float r = RR[t * RW + c], v = RV[t * RW + c], rkc = rk[c];
                const float s0 = wave_sum(r * RKD[t * RW + c] * rkc), s1 = wave_sum(r * RKD[((size_t)NTOK + t) * RW + c] * rkc);
                const float outv = (yn + (s0 + s1) * v) * gacc[i][tk];
                OB[t * RW + c] = (bf16_t)(pk2(outv, 0.f) & 0xffffu); } }
    }
}

__device__ __forceinline__ void phase_route(const Args& a, int l, LAS unsigned char* lds) {
    const int tid = otid(), lane = tid & 63, wave = tid >> 6;
    unsigned char* ws = a.ws;
    LAS float* rwT = (LAS float*)lds;
    { const float* rw = a.in[I_RW] + (size_t)l * DM * NE;
      for (int idx = tid; idx < NE * DM; idx += 512) { const int e = idx >> 10, k = idx & 1023; rwT[idx] = rw[k * NE + e]; } }
    __syncthreads();
    const float* X = (const float*)(ws + WS_X);
    const float* mod = (const float*)(ws + WS_MISC + MISC_MOD) + (size_t)l * 8 * 6144;
    bf16_t* H = (bf16_t*)(ws + WS_H);
    unsigned* cnt = (unsigned*)(ws + WS_CTL) + CW_CNT + l * 32;
    int* LIST = (int*)(ws + WS_LIST); unsigned* TOKE = (unsigned*)(ws + WS_TOKE); float* TOKP = (float*)(ws + WS_TOKP);
    const float* g2 = a.in[I_N2G] + (size_t)l * DM; const float* rb = a.in[I_RB] + (size_t)l * NE;
    for (int t = blockIdx.x * 8 + wave; t < NTOK; t += gridDim.x * 8) {
        f32x4 v[4];
#pragma unroll
        for (int j = 0; j < 4; ++j) v[j] = *(const f32x4*)(X + (size_t)t * DM + 4 * lane + 256 * j);
        const float rstd = row_rstd(v, 1e-6f);
        const float* mb = mod + (size_t)(t >> 11) * 6144;
        f32x4 hv[4];
#pragma unroll
        for (int j = 0; j < 4; ++j) { const int c = 4 * lane + 256 * j;
            const f32x4 gv = *(const f32x4*)(g2 + c), scv = *(const f32x4*)(mb + 4096 + c), shv = *(const f32x4*)(mb + 3072 + c);
            hv[j] = v[j] * rstd * gv * (scv + 1.0f) + shv;
            u32x2 w; w.x = pk2(hv[j].x, hv[j].y); w.y = pk2(hv[j].z, hv[j].w);
            *(u32x2*)(H + (size_t)t * DM + c) = w; }
        float p[32];
#pragma unroll
        for (int e = 0; e < 32; ++e) { float s = 0.f;
#pragma unroll
            for (int j = 0; j < 4; ++j) { const f32x4 w = *(const LAS f32x4*)(rwT + e * 1024 + 4 * lane + 256 * j);
                s += hv[j].x * w.x + hv[j].y * w.y + hv[j].z * w.z + hv[j].w * w.w; }
            p[e] = s; asm volatile("" ::: "memory"); }
#pragma unroll
        for (int e = 0; e < 32; ++e) p[e] += __shfl_xor(p[e], 32);
#pragma unroll
        for (int i = 0; i < 16; ++i) { const bool up = (lane & 16) != 0; const float send = up ? p[i] : p[i + 16], keep = up ? p[i + 16] : p[i]; p[i] = keep + __shfl_xor(send, 16); }
#pragma unroll
        for (int i = 0; i < 8; ++i) { const bool up = (lane & 8) != 0; const float send = up ? p[i] : p[i + 8], keep = up ? p[i + 8] : p[i]; p[i] = keep + __shfl_xor(send, 8); }
#pragma unroll
        for (int i = 0; i < 4; ++i) { const bool up = (lane & 4) != 0; const float send = up ? p[i] : p[i + 4], keep = up ? p[i + 4] : p[i]; p[i] = keep + __shfl_xor(send, 4); }
#pragma unroll
        for (int i = 0; i < 2; ++i) { const bool up = (lane & 2) != 0; const float send = up ? p[i] : p[i + 2], keep = up ? p[i + 2] : p[i]; p[i] = keep + __shfl_xor(send, 2); }
        { const bool up = (lane & 1) != 0; const float send = up ? p[0] : p[1], keep = up ? p[1] : p[0]; p[0] = keep + __shfl_xor(send, 1); }
        const int myidx = lane & 31;
        float cur = p[0] + rb[myidx];
        float tv[4]; int ti[4];
#pragma unroll
        for (int k = 0; k < 4; ++k) { float bv = cur; int bi = myidx;
#pragma unroll
            for (int off = 16; off >= 1; off >>= 1) { const float ov = __shfl_xor(bv, off); const int oi = __shfl_xor(bi, off);
                const bool take = (ov > bv) || (ov == bv && oi < bi); bv = take ? ov : bv; bi = take ? oi : bi; }
            tv[k] = bv; ti[k] = bi; if (myidx == bi) cur = -INFINITY; }
        const float e1 = expf(tv[1] - tv[0]), e2 = expf(tv[2] - tv[0]), e3 = expf(tv[3] - tv[0]);
        const float inv = 1.f / (1.f + e1 + e2 + e3);
        if (lane < 4) { const int e = lane == 0 ? ti[0] : lane == 1 ? ti[1] : lane == 2 ? ti[2] : ti[3];
            const float pr = (lane == 0 ? 1.f : lane == 1 ? e1 : lane == 2 ? e2 : e3) * inv;
            const unsigned pos = __hip_atomic_fetch_add(cnt + e, 1u, __ATOMIC_RELAXED, __HIP_MEMORY_SCOPE_AGENT);
            LIST[(size_t)e * NTOK + pos] = t; TOKE[(size_t)t * 4 + lane] = ((unsigned)e << 16) | pos; TOKP[(size_t)t * 4 + lane] = pr; }
    }
    __syncthreads();
}

__device__ __forceinline__ void build_moe_tab(const Args& a, int l, volatile LAS int* tab) {
    const unsigned* cnt = (const unsigned*)(a.ws + WS_CTL) + CW_CNT + l * 32;
    const int tid = otid();
    __syncthreads();
    if (tid < 32) tab[64 + tid] = (int)__hip_atomic_load(cnt + tid, __ATOMIC_RELAXED, __HIP_MEMORY_SCOPE_AGENT);
    __syncthreads();
    if (tid == 0) { int s = 0; for (int e = 0; e < 32; ++e) { tab[e] = s; s += (tab[64 + e] + 255) >> 8; } tab[32] = s; }
    __syncthreads();
}

__device__ __forceinline__ void phase_combine(const Args& a, int l, const LAS int* tab) {
    const int tid = otid(), lane = tid & 63, wave = tid >> 6;
    unsigned char* ws = a.ws;
    float* X = (float*)(ws + WS_X);
    const bf16_t* YM = (const bf16_t*)(ws + WS_YMOE);
    const unsigned* TOKE = (const unsigned*)(ws + WS_TOKE); const float* TOKP = (const float*)(ws + WS_TOKP);
    const float* modl = (const float*)(ws + WS_MISC + MISC_MOD) + (size_t)l * 8 * 6144;
    for (int t = blockIdx.x * 8 + wave; t < NTOK; t += gridDim.x * 8) {
        f32x4 v[4], acc[4];
#pragma unroll
        for (int j = 0; j < 4; ++j) { v[j] = *(const f32x4*)(X + (size_t)t * DM + 4 * lane + 256 * j); acc[j] = (f32x4){0.f, 0.f, 0.f, 0.f}; }
#pragma unroll
        for (int k = 0; k < 4; ++k) { const unsigned ep = TOKE[(size_t)t * 4 + k]; const float pr = TOKP[(size_t)t * 4 + k];
            const int e = ep >> 16, pos = ep & 0xffff; const size_t srow = (size_t)tab[e] * 256 + pos;
#pragma unroll
            for (int j = 0; j < 4; ++j) { const u32x2 y = *(const u32x2*)(YM + srow * DM + 4 * lane + 256 * j);
                acc[j].x += pr * bflo(y.x); acc[j].y += pr * bfhi(y.x); acc[j].z += pr * bflo(y.y); acc[j].w += pr * bfhi(y.y); } }
        const float* mb = modl + (size_t)(t >> 11) * 6144;
#pragma unroll
        for (int j = 0; j < 4; ++j) { const f32x4 gt = *(const f32x4*)(mb + 5120 + 4 * lane + 256 * j); v[j] = v[j] + gt * acc[j]; }
        const float rstd = row_rstd(v, 1e-6f);
        if (l + 1 < DEPTH) {
#pragma unroll
            for (int j = 0; j < 4; ++j) *(f32x4*)(X + (size_t)t * DM + 4 * lane + 256 * j) = v[j];
            const float* mn = modl + (size_t)8 * 6144 + (size_t)(t >> 11) * 6144;
            norm_mod_store(v, rstd, a.in[I_N1G] + (size_t)(l + 1) * DM, mn + 1024, mn, (bf16_t*)(ws + WS_H) + (size_t)t * DM, lane);
        } else {
#pragma unroll
            for (int j = 0; j < 4; ++j) { const int c = 4 * lane + 256 * j; const f32x4 g = *(const f32x4*)(a.in[I_FNG] + c);
                *(f32x4*)(a.out + (size_t)t * DM + c) = v[j] * rstd * g; }
        }
    }
}

constexpr int NPL = 10;
constexpr int N_PHASES = 2 + NPL * DEPTH;
__global__ void __launch_bounds__(512, 2) fwd(Args a) {
    extern __shared__ __attribute__((aligned(16))) unsigned char smem[];
    LAS unsigned char* lds = (LAS unsigned char*)smem;
    const int tid = threadIdx.x;
    unsigned* ctl = (unsigned*)(a.ws + WS_CTL);
    volatile LAS unsigned* xbw = (volatile LAS unsigned*)(lds + LDS_CTL_OFF);
    volatile LAS int* tab = (volatile LAS int*)(lds + LDS_CTL_OFF + 256);
    volatile LAS int* qw = (volatile LAS int*)(lds + LDS_CTL_OFF + 1024);
    if (tid < 4) xbw[tid] = 0u;
    __syncthreads();
    const int lo = a.ph_lo, hi = a.ph_hi;
    XcdBarrier bar; bar.bar = ctl + CW_BAR; bar.x = 0; bar.st = xbw;
    if (hi - lo > 1) bar = xcd_barrier_post(ctl + CW_BAR, xbw);
#ifndef DUPMASK
#define DUPMASK 0
#endif
#define NREP(k) (((DUPMASK >> PHSEL(k)) & 1) ? 2 : 1)
#ifndef BRMASK
#define BRMASK 7
#endif
#ifndef PHMASK
#define PHMASK 0xFFFFF
#endif
#define PHSEL(k) ((k) < 2 ? (k) : 2 + ((k) - 2) % NPL)
#define IN(k) (((PHMASK >> PHSEL(k)) & 1) && lo <= (k) && (k) < hi)
#define SEAM(k) do { if (IN(k) && IN((k) + 1)) { xcd_barrier(bar); } } while (0)
    unsigned char* ws = a.ws;
    if (IN(0)) { for (int rep = 0; rep < NREP(0); ++rep) { phase_p0(a, lds); __syncthreads(); } SEAM(0); }
    if (IN(1)) { phase_norm1(a, 0); SEAM(1); }
    for (int l = 0; l < DEPTH; ++l) {
        const int pb = 2 + NPL * l;
        if (IN(pb + 0)) {
          for (int rep = 0; rep < NREP(pb + 0); ++rep) {
            pg8::StaticOrder S; S.init(NTOK, PLD, gridDim.x, blockIdx.x);
            pg8::EpiProj E{(bf16_t*)(ws + WS_PROJ), PLD, 29};
            pg8::gemm_phase<pg8::EpiProj, pg8::StaticOrder>(lds, (const bf16_t*)(ws + WS_H), (const bf16_t*)(ws + WS_WIN) + (size_t)l * PLD * DM, DM, 0, S, E);
          }
            SEAM(pb + 0);
        }
        if (IN(pb + 1)) { for (int rep = 0; rep < NREP(pb + 1) + ((DUPMASK >> 17) & 1); ++rep) { phase_rwkv_r1(a, l, lds); } for (int rep = 0; rep < NREP(pb + 1) + ((DUPMASK >> 16) & 1); ++rep) phase_swa(a, lds); SEAM(pb + 1); }
        if (IN(pb + 2)) {
          for (int rep = 0; rep < NREP(pb + 2); ++rep) {
            {
                pg8::StaticOrder S; S.init(NTOK, RW, gridDim.x, blockIdx.x);
                pg8::EpiProj E{(bf16_t*)(ws + WS_GG), RW, 1 << 30};
                pg8::gemm_phase<pg8::EpiProj, pg8::StaticOrder>(lds, (const bf16_t*)(ws + WS_GS), (const bf16_t*)(ws + WS_MISC + MISC_GUPT) + (size_t)l * RW * 256, 256, 0, S, E);
            }
            for (int u = blockIdx.x; u < 192; u += gridDim.x) rwkv_r2_unit(a, u, lds);
            for (;;) {
                if (tid == 0) *qw = (int)__hip_atomic_fetch_add(ctl + CW_QH + 64 * (2 * l + rep), 1u, __ATOMIC_RELAXED, __HIP_MEMORY_SCOPE_AGENT);
                __syncthreads();
                const int item = *qw;
                __syncthreads();
                if (item >= 768) break;
                diffattn_unit(a, l, item, lds);
            }
          }
            SEAM(pb + 2);
        }
        if (IN(pb + 3)) { for (int rep = 0; rep < NREP(pb + 3); ++rep) phase_rwkv_out(a, l); SEAM(pb + 3); }
        if (IN(pb + 4)) {
          for (int rep = 0; rep < NREP(pb + 4); ++rep) {
            pg8::StaticOrder S; S.init(NTOK, DM, gridDim.x, blockIdx.x);
            const bf16_t* P = (const bf16_t*)(ws + WS_PROJ); float* MF = (float*)(ws + WS_MF); bf16_t* MG = (bf16_t*)(ws + WS_MERGED);
            if (BRMASK & 1) { pg8::EpiBranch<0> E{P, MF, MG}; pg8::gemm_phase<pg8::EpiBranch<0>, pg8::StaticOrder>(lds, (const bf16_t*)(ws + WS_OA), (const bf16_t*)(ws + WS_WA) + (size_t)l * DM * 256, 256, 0, S, E); }
            if (BRMASK & 2) { pg8::EpiBranch<1> E{P, MF, MG}; pg8::gemm_phase<pg8::EpiBranch<1>, pg8::StaticOrder>(lds, (const bf16_t*)(ws + WS_OB), (const bf16_t*)(ws + WS_WB) + (size_t)l * DM * 768, 768, 0, S, E); }
            if (BRMASK & 4) { pg8::EpiBranch<2> E{P, MF, MG}; pg8::gemm_phase<pg8::EpiBranch<2>, pg8::StaticOrder>(lds, (const bf16_t*)(ws + WS_OC), (const bf16_t*)(ws + WS_WC) + (size_t)l * DM * 768, 768, 0, S, E); }
          }
            SEAM(pb + 4);
        }
        if (IN(pb + 5)) {
            pg8::StaticOrder S; S.init(NTOK, DM, gridDim.x, blockIdx.x);
            pg8::EpiOut E{l == 0 ? a.in[I_X] : (const float*)(ws + WS_X), (float*)(ws + WS_X), (const float*)(ws + WS_MISC + MISC_MOD) + (size_t)l * 8 * 6144 + 2048};
            pg8::gemm_phase<pg8::EpiOut, pg8::StaticOrder>(lds, (const bf16_t*)(ws + WS_MERGED), (const bf16_t*)(ws + WS_WO) + (size_t)l * DM * DM, DM, 0, S, E);
            SEAM(pb + 5);
        }
        if (IN(pb + 6)) { phase_route(a, l, lds); SEAM(pb + 6); }
        if (IN(pb + 7)) {
          for (int rep = 0; rep < NREP(pb + 7); ++rep) {
            build_moe_tab(a, l, tab);
            pg8::MoeOrder<true> S{(const LAS int*)tab, (const int*)(ws + WS_LIST), 8, (int)gridDim.x, (int)blockIdx.x};
            pg8::EpiMoe1 E{(bf16_t*)(ws + WS_ACT), a.in[I_B1] + (size_t)l * NE * 2 * FF};
            pg8::gemm_phase<pg8::EpiMoe1, pg8::MoeOrder<true>>(lds, (const bf16_t*)(ws + WS_H), (const bf16_t*)(ws + WS_W1) + (size_t)l * NE * 2 * FF * DM, DM, (size_t)2 * FF * DM * 2, S, E);
          }
            SEAM(pb + 7);
        }
        if (IN(pb + 8)) {
          for (int rep = 0; rep < NREP(pb + 8); ++rep) {
            build_moe_tab(a, l, tab);
            pg8::MoeOrder<false> S{(const LAS int*)tab, nullptr, 4, (int)gridDim.x, (int)blockIdx.x};
            pg8::EpiMoe2 E{(bf16_t*)(ws + WS_YMOE), a.in[I_B2] + (size_t)l * NE * DM};
            pg8::gemm_phase<pg8::EpiMoe2, pg8::MoeOrder<false>>(lds, (const bf16_t*)(ws + WS_ACT), (const bf16_t*)(ws + WS_W2) + (size_t)l * NE * DM * FF, FF, (size_t)DM * FF * 2, S, E);
          }
            SEAM(pb + 8);
        }
        if (IN(pb + 9)) { build_moe_tab(a, l, tab); phase_combine(a, l, (const LAS int*)tab); SEAM(pb + 9); }
    }
#undef IN
#undef SEAM
}

#ifndef MK_ONE_LAUNCH
#define MK_ONE_LAUNCH 1
#endif
extern "C" void kernel_launch(void* const* d_in, const int* in_sizes, int n_in, void* d_out, int out_size, void* d_ws, size_t ws_size, hipStream_t stream) {
    static int grid = 0;
    if (grid == 0) {
        if (n_in != 32 || ws_size < WS_END) { fprintf(stderr, "kernel_launch: unexpected n_in %d or ws %zu < %zu\n", n_in, ws_size, (size_t)WS_END); grid = -1; return; }
        int dev = 0, cus = 0;
        if (hipGetDevice(&dev) != hipSuccess || hipDeviceGetAttribute(&cus, hipDeviceAttributeMultiprocessorCount, dev) != hipSuccess) { grid = -1; return; }
        if (hipFuncSetAttribute((const void*)fwd, hipFuncAttributeMaxDynamicSharedMemorySize, LDS_BYTES) != hipSuccess) { fprintf(stderr, "kernel_launch: hipFuncSetAttribute failed\n"); grid = -1; return; }
        int per_cu = 0;
        if (hipOccupancyMaxActiveBlocksPerMultiprocessor(&per_cu, (const void*)fwd, 512, LDS_BYTES) != hipSuccess || per_cu < 1) fprintf(stderr, "kernel_launch: occupancy query says %d\n", per_cu);
        (void)hipGetLastError();
        grid = cus;
    }
    if (grid < 0) return;
    (void)hipMemsetAsync((char*)d_ws + WS_CTL, 0, CTL_BYTES, stream);
    Args a{};
    for (int i = 0; i < 32; ++i) a.in[i] = (const float*)d_in[i];
    a.out = (float*)d_out; a.ws = (unsigned char*)d_ws;
#if MK_ONE_LAUNCH
    a.ph_lo = 0; a.ph_hi = N_PHASES;
    hipLaunchKernelGGL(fwd, dim3(grid), dim3(512), LDS_BYTES, stream, a);
#else
    for (int p = 0; p < N_PHASES; ++p) { a.ph_lo = p; a.ph_hi = p + 1; hipLaunchKernelGGL(fwd, dim3(grid), dim3(512), LDS_BYTES, stream, a); }
#endif
}
```

```cpp
#include <hip/hip_runtime.h>
#include <stdint.h>
#include <stdio.h>

#define LAS __attribute__((address_space(3)))
typedef unsigned short bf16_t;
typedef short bf16x8 __attribute__((ext_vector_type(8)));
typedef short s16x4 __attribute__((ext_vector_type(4)));
typedef float f32x2 __attribute__((ext_vector_type(2)));
typedef float f32x4 __attribute__((ext_vector_type(4)));
typedef float f32x16 __attribute__((ext_vector_type(16)));
typedef unsigned u32x2 __attribute__((ext_vector_type(2)));
typedef unsigned u32x4 __attribute__((ext_vector_type(4)));
typedef __bf16 bf16x2_t __attribute__((ext_vector_type(2)));
typedef short v4i16_t __attribute__((ext_vector_type(4)));

constexpr int NB = 8, NT = 2048, DM = 1024, NTOK = NB * NT, DEPTH = 2;
constexpr int IN_COLS = 10368, PLD = 10496;
constexpr int C_AQ = 0, C_AK = 768, C_AV = 1536, C_BS = 2304, C_CQ = 5120, C_CK = 5888, C_CV = 6656, C_G = 7424;
constexpr int RSTR = 2688, RW = 768, NE = 32, FF = 1024;
constexpr float LOG2E = 1.4426950408889634f;

constexpr size_t al256(size_t x) { return (x + 255) & ~(size_t)255; }
constexpr size_t WS_CTL = 0;
constexpr size_t CTL_BYTES = 65536;
constexpr size_t WS_MISC = WS_CTL + CTL_BYTES;
constexpr size_t MISC_MOD = 0, MISC_LAM = 393216, MISC_BIASA = 393472, MISC_BIASC = 399872, MISC_WUPT = 409600, MISC_AUPT = 409600 + 393216, MISC_GUPT = 409600 + 2 * 393216, MISC_BYTES = 2 << 20;
constexpr size_t WS_WIN = WS_MISC + MISC_BYTES;
constexpr size_t WS_WA = WS_WIN + (size_t)DEPTH * PLD * DM * 2;
constexpr size_t WS_WB = WS_WA + (size_t)DEPTH * DM * 256 * 2;
constexpr size_t WS_WC = WS_WB + (size_t)DEPTH * DM * 768 * 2;
constexpr size_t WS_WO = WS_WC + (size_t)DEPTH * DM * 768 * 2;
constexpr size_t WS_W1 = WS_WO + (size_t)DEPTH * DM * DM * 2;
constexpr size_t WS_W2 = WS_W1 + (size_t)DEPTH * NE * 2 * FF * DM * 2;
constexpr size_t WS_H = WS_W2 + (size_t)DEPTH * NE * DM * FF * 2;
constexpr size_t WS_X = WS_H + (size_t)NTOK * DM * 2;
constexpr size_t WS_OA = WS_X + (size_t)NTOK * DM * 4;
constexpr size_t WS_OB = WS_OA + (size_t)NTOK * 256 * 2;
constexpr size_t WS_OC = WS_OB + (size_t)NTOK * 768 * 2;
constexpr size_t WS_MERGED = WS_OC + (size_t)NTOK * 768 * 2;
constexpr size_t WS_LIST = WS_MERGED + (size_t)NTOK * DM * 2;
constexpr size_t WS_TOKE = WS_LIST + (size_t)NE * NTOK * 4;
constexpr size_t WS_TOKP = WS_TOKE + (size_t)NTOK * 4 * 4;
constexpr size_t WS_U = WS_TOKP + (size_t)NTOK * 4 * 4;
constexpr size_t WS_PROJ = WS_U;
constexpr size_t WS_RR = WS_PROJ + (size_t)NTOK * PLD * 2;
constexpr size_t WS_RV = WS_RR + (size_t)NTOK * RW * 4;
constexpr size_t WS_RWD = WS_RV + (size_t)NTOK * RW * 4;
constexpr size_t WS_RKK = WS_RWD + (size_t)2 * NTOK * RW * 4;
constexpr size_t WS_RKKA = WS_RKK + (size_t)2 * NTOK * RW * 4;
constexpr size_t WS_RKD = WS_RKKA + (size_t)2 * NTOK * RW * 4;
constexpr size_t WS_GS = WS_RKD + (size_t)2 * NTOK * RW * 4;
constexpr size_t WS_Y = WS_GS + (size_t)NTOK * 128 * 4;
constexpr size_t WS_OAG = WS_Y + (size_t)2 * NTOK * RW * 4;
constexpr size_t WS_LSE = WS_OAG + (size_t)3 * NTOK * 256 * 4;
constexpr size_t WS_MF = WS_LSE + (size_t)3 * NTOK * 4 * 4;
constexpr size_t WS_QA = WS_MF + (size_t)NTOK * DM * 4;
constexpr size_t WS_SS = WS_QA + (size_t)6144 * 4096 * 2;
constexpr size_t WS_END1 = WS_SS + (size_t)6144 * 4096 * 2;
constexpr size_t WS_GG = WS_Y;
constexpr size_t WS_MP = WS_RWD, WS_NP = WS_RKK, WS_Y0 = WS_RKKA;
constexpr int SLOT_ROWS = 4 * NTOK + NE * 256;
constexpr size_t WS_ACT = WS_U;
constexpr size_t WS_YMOE = WS_ACT + (size_t)SLOT_ROWS * FF * 2;
constexpr size_t WS_END2 = WS_YMOE + (size_t)SLOT_ROWS * DM * 2;
constexpr size_t WS_END = WS_END1 > WS_END2 ? WS_END1 : WS_END2;

constexpr int CW_BAR = 0;
constexpr int CW_CNT = 4096;
constexpr int CW_QH = 4224;
constexpr int CW_RT = 5120;

constexpr int LDS_STAGE = 147456;
constexpr int LDS_CTL_OFF = LDS_STAGE;
constexpr int LDS_BYTES = LDS_STAGE + 4096;

__device__ __forceinline__ int otid() { int t = threadIdx.x; asm volatile("" : "+v"(t)); return t; }
__device__ __forceinline__ int obid() { int t = blockIdx.x; asm volatile("" : "+s"(t)); return t; }
__device__ __forceinline__ unsigned pk2(float lo, float hi) { f32x2 v = {lo, hi}; bf16x2_t b = __builtin_convertvector(v, bf16x2_t); return __builtin_bit_cast(unsigned, b); }
__device__ __forceinline__ u32x4 pack8(const float (&x)[8]) { u32x4 w; w.x = pk2(x[0], x[1]); w.y = pk2(x[2], x[3]); w.z = pk2(x[4], x[5]); w.w = pk2(x[6], x[7]); return w; }
__device__ __forceinline__ bf16_t f2bf(float x) { return (bf16_t)(pk2(x, 0.f) & 0xffffu); }
__device__ __forceinline__ float bflo(unsigned u) { return __builtin_bit_cast(float, u << 16); }
__device__ __forceinline__ float bfhi(unsigned u) { return __builtin_bit_cast(float, u & 0xffff0000u); }
__device__ __forceinline__ float bf2f(bf16_t h) { return __builtin_bit_cast(float, (unsigned)h << 16); }
__device__ __forceinline__ float wave_sum(float v) {
#pragma unroll
    for (int o = 1; o < 64; o <<= 1) v += __shfl_xor(v, o);
    return v;
}
__device__ __forceinline__ float sigmoidf_(float x) { return 1.f / (1.f + __expf(-x)); }
__device__ __forceinline__ int crow(int r, int hi) { return (r & 3) + 8 * (r >> 2) + 4 * hi; }
__device__ __forceinline__ s16x4 vtr(const LAS unsigned char* p) { return __builtin_bit_cast(s16x4, __builtin_amdgcn_ds_read_tr16_b64_v4i16((LAS v4i16_t*)p)); }
__device__ __forceinline__ float dpp_sum8(float x) {
    int v = __builtin_bit_cast(int, x);
    x += __builtin_bit_cast(float, __builtin_amdgcn_update_dpp(0, v, 0xB1, 0xF, 0xF, true));
    v = __builtin_bit_cast(int, x);
    x += __builtin_bit_cast(float, __builtin_amdgcn_update_dpp(0, v, 0x4E, 0xF, 0xF, true));
    v = __builtin_bit_cast(int, x);
    x += __builtin_bit_cast(float, __builtin_amdgcn_update_dpp(0, v, 0x141, 0xF, 0xF, true));
    return x;
}

#define XB_TMO      128
#define XB_XCNT(j)  (256  + 64 * (j))
#define XB_XSUB(j)  (1280 + 64 * (j))
#define XB_XGEN(j)  (2304 + 64 * (j))
#define XB_TOP      3328
#define XB_TOPGEN   3392
#define XCD_BAR_WORDS 3456
#define XB_SPIN_CAP (1u << 18)
__device__ __forceinline__ unsigned xb_ld(unsigned* p)              { return __hip_atomic_load(p, __ATOMIC_RELAXED, __HIP_MEMORY_SCOPE_AGENT); }
__device__ __forceinline__ unsigned xb_add(unsigned* p, unsigned v) { return __hip_atomic_fetch_add(p, v, __ATOMIC_RELAXED, __HIP_MEMORY_SCOPE_AGENT); }
__device__ __forceinline__ unsigned xb_xcc_id() { return (unsigned)__builtin_amdgcn_s_getreg((3 << 11) | 20) & 0xFu; }
#define XB_SPIN(cond, bar) do { unsigned _sp = 0; while (cond) { __builtin_amdgcn_s_sleep(1); \
    if ((++_sp & 255u) == 0u) { if (xb_ld(&(bar)[XB_TMO])) break; if (_sp > XB_SPIN_CAP) { atomicAdd(&(bar)[XB_TMO], 1u); break; } } } } while (0)
struct XcdBarrier { unsigned* bar; unsigned x; volatile LAS unsigned* st; };
__device__ __forceinline__ XcdBarrier xcd_barrier_post(unsigned* bar, volatile LAS unsigned* st) {
    XcdBarrier b; b.bar = bar; b.x = xb_xcc_id(); b.st = st;
    if (threadIdx.x == 0) (void)xb_add(&bar[XB_XCNT(b.x)], 1u);
    return b;
}
__device__ __forceinline__ void xcd_barrier_complete(unsigned* bar, unsigned x, unsigned& nloc, unsigned& nx) {
    const unsigned G = gridDim.x * gridDim.y * gridDim.z;
    unsigned sum, cnt, mine, sp = 0u;
    for (;;) {
        sum = 0u; cnt = 0u; mine = 0u;
#pragma unroll
        for (unsigned j = 0; j < 16; ++j) { const unsigned c = xb_ld(&bar[XB_XCNT(j)]); sum += c; cnt += (c > 0u) ? 1u : 0u; mine = (j == x) ? c : mine; }
        if (sum == G) break;
        __builtin_amdgcn_s_sleep(1);
        if ((++sp & 255u) == 0u) { if (xb_ld(&bar[XB_TMO])) break; if (sp > XB_SPIN_CAP) { atomicAdd(&bar[XB_TMO], 1u); break; } }
    }
    nloc = mine > 0u ? mine : 1u; nx = cnt > 0u ? cnt : 1u;
}
__device__ __forceinline__ void xcd_barrier(const XcdBarrier& b) {
    asm volatile("s_waitcnt vmcnt(0)" ::: "memory");
    __syncthreads();
    if (threadIdx.x == 0) {
        unsigned* bar = b.bar;
        __builtin_amdgcn_s_waitcnt(0);
        unsigned nloc = b.st[0], nx = b.st[1];
        if (nloc == 0u) { xcd_barrier_complete(bar, b.x, nloc, nx); b.st[0] = nloc; b.st[1] = nx; }
        const unsigned old = xb_add(&bar[XB_XSUB(b.x)], 1u);
        const unsigned gen = old / nloc;
        if (old + 1u == (gen + 1u) * nloc) {
            __builtin_amdgcn_fence(__ATOMIC_RELEASE, "agent");
            asm volatile("s_waitcnt vmcnt(0)" ::: "memory");
            const unsigned og = xb_add(&bar[XB_TOP], 1u);
            const unsigned tg = og / nx;
            if (og + 1u == (tg + 1u) * nx) xb_add(&bar[XB_TOPGEN], 1u);
            else XB_SPIN(xb_ld(&bar[XB_TOPGEN]) == tg, bar);
            __builtin_amdgcn_fence(__ATOMIC_ACQUIRE, "agent");
            xb_add(&bar[XB_XGEN(b.x)], 1u);
            asm volatile("s_waitcnt vmcnt(0)" ::: "memory");
        } else {
            XB_SPIN(xb_ld(&bar[XB_XGEN(b.x)]) == gen, bar);
            __builtin_amdgcn_fence(__ATOMIC_ACQUIRE, "agent");
            asm volatile("s_waitcnt vmcnt(0)" ::: "memory");
        }
    }
    __syncthreads();
}

namespace pg8 {
constexpr int BM = 256, BK = 64, HALF = 128, HTB = HALF * BK * 2, STAGE_BYTES = 8 * HTB, NXCD = 8, WGM = 8;
__device__ __forceinline__ int lds_byte(int r, int c) { const int st = (r >> 4) * 2 + (c >> 5), rr = r & 15, cc = c & 31, ob = rr * 64 + cc * 2; return st * 1024 + (ob ^ (((ob >> 9) & 1) << 5)); }
__device__ __forceinline__ void stage_rc(int b, int& R, int& C) { const int st = b / 1024, sb = b % 1024, swz = sb ^ (((sb >> 9) & 1) << 5); R = (st >> 1) * 16 + swz / 64; C = (st & 1) * 32 + (swz % 64) / 2; }
__device__ __forceinline__ int perm32(int rho) { const int n = rho >> 4, i = rho & 15; return 8 * (i >> 2) + 4 * n + (i & 3); }

struct Unit { int pm, pn, e, lt; };

struct StaticOrder {
    static constexpr bool GATHER = false;
    int nM, nN, nwg, G, c;
    __device__ void init(int M, int N, int G_, int c_) { nM = M / BM; nN = N / BM; nwg = nM * nN; G = G_; c = c_; }
    __device__ __forceinline__ bool next(int i, Unit& u) const {
        const long L = (long)i * G + c; if (L >= nwg) return false;
        int wgid = (int)L; { const int q = nwg / NXCD, r = nwg % NXCD, xcd = wgid % NXCD, off = wgid / NXCD; wgid = (xcd < r ? xcd * (q + 1) : r * (q + 1) + (xcd - r) * q) + off; }
        const int nig = WGM * nN, gid = wgid / nig, fm = gid * WGM, gsz = (nM - fm) < WGM ? (nM - fm) : WGM;
        u.pm = fm + ((wgid % nig) % gsz); u.pn = (wgid % nig) / gsz; u.e = 0; u.lt = 0; return true;
    }
    __device__ __forceinline__ int arow(const Unit& u, int r) const { return u.pm * BM + r; }
    __device__ __forceinline__ void a_ready(const Unit&) const {}
    __device__ __forceinline__ void done(const Unit&) const {}
};
template <bool GATHER_> struct MoeOrder {
    static constexpr bool GATHER = GATHER_;
    const LAS int* tab;
    const int* list;
    int ncol, G, c;
    __device__ __forceinline__ bool next(int i, Unit& u) const {
        if (true) {
            const int L = i * G + c; const int total = tab[32] * ncol; if (L >= total) return false;
            const int rt = L / ncol; u.pn = L - rt * ncol; u.pm = rt;
            int e = 0;
#pragma unroll 1
            for (int j = 1; j < 32; ++j) e = (tab[j] <= rt) ? j : e;
            u.e = e; u.lt = rt - tab[e]; return true;
        }
        const int x = c & 7, W = G >> 3; int q = i * W + (c >> 3);
#pragma unroll 1
        for (int k = 0; k < 4; ++k) { const int e = x + 8 * k; const int nt_e = tab[e + 1] - tab[e], sz = nt_e * ncol;
            if (q < sz) { const int lt = q / ncol; u.pn = q - lt * ncol; u.lt = lt; u.e = e; u.pm = tab[e] + lt; return true; }
            q -= sz; }
        return false;
    }
    __device__ __forceinline__ int arow(const Unit& u, int r) const {
        if (!GATHER_) return u.pm * BM + r;
        const int pos = u.lt * BM + r; const int cnt = tab[64 + u.e];
        return pos < cnt ? list[(size_t)u.e * NTOK + pos] : 0;
    }
    unsigned* rtc;
    __device__ __forceinline__ void done(const Unit& u) const {
        if (GATHER_) { asm volatile("s_waitcnt vmcnt(0)" ::: "memory");
            if ((threadIdx.x & 63) == 0) __hip_atomic_fetch_add(rtc + 16 * u.pm, 1u, __ATOMIC_RELAXED, __HIP_MEMORY_SCOPE_AGENT); }
    }
    __device__ __forceinline__ void a_ready(const Unit& u) const {
        if (!GATHER_) {
            if (threadIdx.x < 64) {
                unsigned sp = 0;
                while ((unsigned)__builtin_amdgcn_readfirstlane(__hip_atomic_load(rtc + 16 * u.pm, __ATOMIC_RELAXED, __HIP_MEMORY_SCOPE_AGENT)) < 64u) {
                    __builtin_amdgcn_s_sleep(2); if (++sp > (1u << 22)) break; }
                __builtin_amdgcn_fence(__ATOMIC_ACQUIRE, "agent");
                asm volatile("s_waitcnt vmcnt(0)" ::: "memory");
            }
            asm volatile("" ::: "memory"); __builtin_amdgcn_s_barrier(); asm volatile("" ::: "memory");
        }
    }
};

template <class Epi, class Sched>
__device__ __forceinline__ void gemm_phase(LAS unsigned char* lds, const bf16_t* A, const bf16_t* Bt, const int K, const size_t b_estride_bytes, const Sched& S, const Epi& E) {
    constexpr bool GATHER = Sched::GATHER;
    const int tid = otid(), wid = __builtin_amdgcn_readfirstlane(tid >> 6), lane = tid & 63, wr = wid >> 2, wc = wid & 3, fr = lane & 15, fq = lane >> 4;
    const int nt = K / BK;
    int Rr[2], Cc[2]; unsigned voffA[2], voffB[2];
#pragma unroll
    for (int i = 0; i < 2; ++i) { int R, C; stage_rc(tid * 16 + i * 8192, R, C); const int Rb = Epi::PERM ? ((R & ~31) + perm32(R & 31)) : R;
        Rr[i] = R; Cc[i] = C; voffA[i] = (unsigned)(R * K + C) * 2u; voffB[i] = (unsigned)(Rb * K + C) * 2u; }
    const size_t kstep = (size_t)(BK * 2);
    const size_t hstep = (size_t)HALF * K * 2;
    const size_t tstep = 2 * hstep;
    const unsigned ldsw = (unsigned)wid * 1024u;
    const int aoff = lds_byte(wr * 64 + fr, fq * 8), boff = lds_byte(wc * 32 + fr, fq * 8);
#define PG8_SA(b, h) (((b) * 2 + (h)) * HTB)
#define PG8_SB(b, h) ((4 + (b) * 2 + (h)) * HTB)
#define PG8_STAGE(bufoff, gbase, voff) do { _Pragma("unroll") for (int _i = 0; _i < 2; ++_i) \
        __builtin_amdgcn_global_load_lds((const unsigned*)((const char*)(gbase) + (voff)[_i]), (LAS unsigned*)(lds + (bufoff) + ldsw + _i * 8192), 16, 0, 0); } while (0)
#define PG8_STAGEA(bufoff, uptr, offs, h, kb) do { _Pragma("unroll") for (int _i = 0; _i < 2; ++_i) { const char* _src; \
        if constexpr (GATHER) _src = (const char*)A + (size_t)(offs)[h][_i] + (size_t)(kb); else _src = (uptr) + (size_t)(h) * hstep + (size_t)(kb) + voffA[_i]; \
        __builtin_amdgcn_global_load_lds((const unsigned*)_src, (LAS unsigned*)(lds + (bufoff) + ldsw + _i * 8192), 16, 0, 0); } } while (0)
#define PG8_LDA(dst, b, h) do { _Pragma("unroll") for (int m = 0; m < 4; ++m) _Pragma("unroll") for (int k = 0; k < 2; ++k) dst[m][k] = *(const LAS bf16x8*)(lds + PG8_SA(b, h) + aoff + m * 2048 + k * 1024); } while (0)
#define PG8_LDB(dst, b, h) do { _Pragma("unroll") for (int n = 0; n < 2; ++n) _Pragma("unroll") for (int k = 0; k < 2; ++k) dst[n][k] = *(const LAS bf16x8*)(lds + PG8_SB(b, h) + boff + n * 2048 + k * 1024); } while (0)
#define PG8_MMA(ai, bj, At, Bt_) do { __builtin_amdgcn_s_setprio(1); _Pragma("unroll") for (int m = 0; m < 4; ++m) _Pragma("unroll") for (int n = 0; n < 2; ++n) _Pragma("unroll") for (int k = 0; k < 2; ++k) \
        acc[ai][bj][m][n] = __builtin_amdgcn_mfma_f32_16x16x32_bf16(Bt_[n][k], At[m][k], acc[ai][bj][m][n], 0, 0, 0); __builtin_amdgcn_s_setprio(0); } while (0)
#define PG8_WAIT_V(n) asm volatile("s_waitcnt vmcnt(" #n ")" ::: "memory")
#define PG8_WAIT_L(n) asm volatile("s_waitcnt lgkmcnt(" #n ")" ::: "memory")
#define PG8_BAR __builtin_amdgcn_s_barrier()
#define PG8_SCHED __builtin_amdgcn_sched_barrier(0)
#define PG8_AOFFS(dst, u) do { if constexpr (GATHER) { _Pragma("unroll") for (int _h = 0; _h < 2; ++_h) _Pragma("unroll") for (int _i = 0; _i < 2; ++_i) \
        dst[_h][_i] = ((unsigned)S.arow(u, _h * HALF + Rr[_i]) * (unsigned)K + (unsigned)Cc[_i]) * 2u; } } while (0)
    Unit cur, nxt; int ui = 0;
    if (!S.next(0, cur)) return;
    f32x4 acc[2][2][4][2];
#pragma unroll
    for (int a = 0; a < 2; ++a)
#pragma unroll
        for (int b = 0; b < 2; ++b)
#pragma unroll
            for (int m = 0; m < 4; ++m)
#pragma unroll
                for (int n = 0; n < 2; ++n) acc[a][b][m][n] = (f32x4){0.f, 0.f, 0.f, 0.f};
    bf16x8 At[4][2], B0[2][2], B1[2][2];
    unsigned aoc[2][2] = {{0u, 0u}, {0u, 0u}}, aon[2][2] = {{0u, 0u}, {0u, 0u}};
    PG8_AOFFS(aoc, cur);
    const char* cA = (const char*)A + (size_t)cur.pm * tstep;
    const char* cB = (const char*)Bt + (size_t)cur.e * b_estride_bytes + (size_t)cur.pn * tstep;
    S.a_ready(cur);
    PG8_STAGE(PG8_SB(0, 0), cB, voffB); PG8_STAGEA(PG8_SA(0, 0), cA, aoc, 0, 0); PG8_STAGE(PG8_SB(0, 1), cB + hstep, voffB); PG8_STAGEA(PG8_SA(0, 1), cA, aoc, 1, 0);
    if (wr == 1) PG8_BAR;
    PG8_WAIT_V(4); PG8_BAR;
    PG8_STAGE(PG8_SB(1, 0), cB + kstep, voffB); PG8_STAGEA(PG8_SA(1, 0), cA, aoc, 0, kstep); PG8_STAGE(PG8_SB(1, 1), cB + hstep + kstep, voffB);
    PG8_WAIT_V(6); PG8_BAR;
    for (;;) {
        const bool has_next = S.next(ui + 1, nxt);
        const char* nA = has_next ? (const char*)A + (size_t)nxt.pm * tstep : cA;
        const char* nB = has_next ? (const char*)Bt + (size_t)nxt.e * b_estride_bytes + (size_t)nxt.pn * tstep : cB;
        if constexpr (GATHER) {
            if (has_next) { PG8_AOFFS(aon, nxt); } else {
#pragma unroll
                for (int h = 0; h < 2; ++h)
#pragma unroll
                    for (int i = 0; i < 2; ++i) aon[h][i] = aoc[h][i]; } }
#pragma unroll 1
        for (int t = 0; t < nt; t += 2) {
            const bool last = (t == nt - 2);
            const size_t k1 = (size_t)(t + 1) * kstep;
            const size_t k2 = last ? (size_t)0 : (size_t)(t + 2) * kstep;
            const size_t k3 = k2 + kstep;
            const char* a2p = last ? nA : cA;
            unsigned a2o[2][2];
#pragma unroll
            for (int h = 0; h < 2; ++h)
#pragma unroll
                for (int i = 0; i < 2; ++i) a2o[h][i] = last ? aon[h][i] : aoc[h][i];
            const char* b2 = last ? nB : cB + (size_t)(t + 2) * kstep; const char* b3 = b2 + kstep;
            if (last && has_next) S.a_ready(nxt);
            PG8_LDB(B0, 0, 0); PG8_SCHED; PG8_LDA(At, 0, 0); PG8_STAGEA(PG8_SA(1, 1), cA, aoc, 1, k1);
            PG8_WAIT_L(8); PG8_BAR; PG8_WAIT_L(0); PG8_MMA(0, 0, At, B0); PG8_BAR; PG8_SCHED;
            PG8_LDB(B1, 0, 1); PG8_STAGE(PG8_SB(0, 0), b2, voffB);
            PG8_BAR; PG8_WAIT_L(0); PG8_MMA(0, 1, At, B1); PG8_BAR;
            PG8_LDA(At, 0, 1); PG8_STAGEA(PG8_SA(0, 0), a2p, a2o, 0, k2);
            PG8_BAR; PG8_WAIT_L(0); PG8_MMA(1, 0, At, B0); PG8_BAR; PG8_SCHED;
            PG8_STAGE(PG8_SB(0, 1), b2 + hstep, voffB);
            PG8_WAIT_V(6); PG8_BAR; PG8_MMA(1, 1, At, B1); PG8_BAR;
            PG8_LDB(B0, 1, 0); PG8_SCHED; PG8_LDA(At, 1, 0); PG8_STAGEA(PG8_SA(0, 1), a2p, a2o, 1, k2);
            PG8_WAIT_L(8); PG8_BAR; PG8_WAIT_L(0); PG8_MMA(0, 0, At, B0); PG8_BAR; PG8_SCHED;
            PG8_LDB(B1, 1, 1); PG8_STAGE(PG8_SB(1, 0), b3, voffB);
            PG8_BAR; PG8_WAIT_L(0); PG8_MMA(0, 1, At, B1); PG8_BAR;
            PG8_LDA(At, 1, 1); PG8_STAGEA(PG8_SA(1, 0), a2p, a2o, 0, k3);
            PG8_BAR; PG8_WAIT_L(0); PG8_MMA(1, 0, At, B0); PG8_BAR; PG8_SCHED;
            PG8_STAGE(PG8_SB(1, 1), b3 + hstep, voffB);
            PG8_WAIT_V(6); PG8_BAR; PG8_MMA(1, 1, At, B1); PG8_BAR;
        }
        E(acc, cur, wr, wc, fr, fq); S.done(cur);
        if (!has_next) break;
#pragma unroll
        for (int a = 0; a < 2; ++a)
#pragma unroll
            for (int b = 0; b < 2; ++b)
#pragma unroll
                for (int m = 0; m < 4; ++m)
#pragma unroll
                    for (int n = 0; n < 2; ++n) acc[a][b][m][n] = (f32x4){0.f, 0.f, 0.f, 0.f};
        cur = nxt; cA = nA; cB = nB; ++ui;
#pragma unroll
        for (int h = 0; h < 2; ++h)
#pragma unroll
            for (int i = 0; i < 2; ++i) aoc[h][i] = aon[h][i];
    }
    PG8_WAIT_V(0);
    if (wr == 0) PG8_BAR;
    PG8_BAR;
#undef PG8_SA
#undef PG8_SB
#undef PG8_STAGE
#undef PG8_STAGEA
#undef PG8_LDA
#undef PG8_LDB
#undef PG8_MMA
#undef PG8_WAIT_V
#undef PG8_WAIT_L
#undef PG8_BAR
#undef PG8_SCHED
#undef PG8_AOFFS
}

typedef f32x4 Acc[2][2][4][2];

struct EpiProj {
    static constexpr bool PERM = true;
    bf16_t* O; int ld; int sg_from;
    __device__ __forceinline__ void operator()(const Acc& acc, const Unit& u, int wr, int wc, int fr, int fq) const {
        const int row0 = u.pm * BM + wr * 64 + fr, col0 = u.pn * BM + wc * 32 + 8 * fq; const bool sg = u.pn >= sg_from;
#pragma unroll
        for (int ai = 0; ai < 2; ++ai)
#pragma unroll
            for (int m = 0; m < 4; ++m) { bf16_t* rowp = O + (size_t)(row0 + ai * HALF + m * 16) * ld + col0;
#pragma unroll
                for (int bj = 0; bj < 2; ++bj) { f32x4 v0 = acc[ai][bj][m][0], v1 = acc[ai][bj][m][1];
                    if (sg) {
#pragma unroll
                        for (int j = 0; j < 4; ++j) { v0[j] = sigmoidf_(v0[j]); v1[j] = sigmoidf_(v1[j]); } }
                    u32x4 w; w.x = pk2(v0[0], v0[1]); w.y = pk2(v0[2], v0[3]); w.z = pk2(v1[0], v1[1]); w.w = pk2(v1[2], v1[3]);
                    *(u32x4*)(rowp + bj * HALF) = w; } }
    }
};
template <int SEG> struct EpiBranch {
    static constexpr bool PERM = true;
    const bf16_t* P; float* MF; bf16_t* MG;
    __device__ __forceinline__ void operator()(const Acc& acc, const Unit& u, int wr, int wc, int fr, int fq) const {
        const int row0 = u.pm * BM + wr * 64 + fr, col0 = u.pn * BM + wc * 32 + 8 * fq;
#pragma unroll
        for (int ai = 0; ai < 2; ++ai)
#pragma unroll
            for (int m = 0; m < 4; ++m) { const size_t r = (size_t)(row0 + ai * HALF + m * 16);
                asm volatile("" ::: "memory");
#pragma unroll
                for (int bj = 0; bj < 2; ++bj) { const int c = col0 + bj * HALF;
                    const u32x4 g = *(const u32x4*)(P + r * PLD + C_G + SEG * 1024 + c);
                    f32x4 v0 = acc[ai][bj][m][0], v1 = acc[ai][bj][m][1];
                    v0[0] *= bflo(g.x); v0[1] *= bfhi(g.x); v0[2] *= bflo(g.y); v0[3] *= bfhi(g.y);
                    v1[0] *= bflo(g.z); v1[1] *= bfhi(g.z); v1[2] *= bflo(g.w); v1[3] *= bfhi(g.w);
                    float* mp = MF + r * DM + c;
                    if (SEG > 0) { v0 += *(const f32x4*)mp; v1 += *(const f32x4*)(mp + 4); }
                    if (SEG < 2) { *(f32x4*)mp = v0; *(f32x4*)(mp + 4) = v1; }
                    else { u32x4 w; w.x = pk2(v0[0], v0[1]); w.y = pk2(v0[2], v0[3]); w.z = pk2(v1[0], v1[1]); w.w = pk2(v1[2], v1[3]); *(u32x4*)(MG + r * DM + c) = w; } } }
    }
};
struct EpiOut {
    static constexpr bool PERM = false;
    const float* xsrc; float* X; const float* gt;
    __device__ __forceinline__ void operator()(const Acc& acc, const Unit& u, int wr, int wc, int fr, int fq) const {
        const int row0 = u.pm * BM + wr * 64 + fr, col0 = u.pn * BM + wc * 32 + 4 * fq;
        const float* gp = gt + (size_t)((u.pm * BM) >> 11) * 6144 + col0;
        f32x4 gv[2][2];
#pragma unroll
        for (int bj = 0; bj < 2; ++bj)
#pragma unroll
            for (int n = 0; n < 2; ++n) gv[bj][n] = *(const f32x4*)(gp + bj * HALF + n * 16);
#pragma unroll
        for (int ai = 0; ai < 2; ++ai)
#pragma unroll
            for (int m = 0; m < 4; ++m) { const size_t o = (size_t)(row0 + ai * HALF + m * 16) * DM + col0;
#pragma unroll
                for (int bj = 0; bj < 2; ++bj)
#pragma unroll
                    for (int n = 0; n < 2; ++n) { const f32x4 xv = *(const f32x4*)(xsrc + o + bj * HALF + n * 16);
                        *(f32x4*)(X + o + bj * HALF + n * 16) = xv + gv[bj][n] * acc[ai][bj][m][n]; } }
    }
};
struct EpiMoe1 {
    static constexpr bool PERM = true;
    bf16_t* ACT; const float* b1;
    __device__ __forceinline__ void operator()(const Acc& acc, const Unit& u, int wr, int wc, int fr, int fq) const {
        const int row0 = u.pm * BM + wr * 64 + fr, col0 = u.pn * BM + wc * 32 + 8 * fq;
        const float* bp = b1 + (size_t)u.e * (2 * FF) + col0;
        f32x4 bv[2][2];
#pragma unroll
        for (int bj = 0; bj < 2; ++bj)
#pragma unroll
            for (int n = 0; n < 2; ++n) bv[bj][n] = *(const f32x4*)(bp + bj * HALF + 4 * n);
#pragma unroll
        for (int ai = 0; ai < 2; ++ai)
#pragma unroll
            for (int m = 0; m < 4; ++m) { bf16_t* rowp = ACT + (size_t)(row0 + ai * HALF + m * 16) * FF + (col0 >> 1);
#pragma unroll
                for (int bj = 0; bj < 2; ++bj) { const f32x4 v0 = acc[ai][bj][m][0] + bv[bj][0], v1 = acc[ai][bj][m][1] + bv[bj][1];
                    float a[4];
#pragma unroll
                    for (int q = 0; q < 4; ++q) { const float gl = (q < 2) ? v0[2 * q] : v1[2 * q - 4], ln = (q < 2) ? v0[2 * q + 1] : v1[2 * q - 3];
                        const float xg = fminf(gl, 7.0f), xl = fminf(fmaxf(ln, -7.0f), 7.0f);
                        a[q] = xg * sigmoidf_(1.702f * xg) * (xl + 1.0f); }
                    const unsigned long long w = (unsigned long long)pk2(a[0], a[1]) | ((unsigned long long)pk2(a[2], a[3]) << 32);
                    __hip_atomic_store((unsigned long long*)(rowp + bj * (HALF / 2)), w, __ATOMIC_RELAXED, __HIP_MEMORY_SCOPE_AGENT); } }
    }
};
struct EpiMoe2 {
    static constexpr bool PERM = true;
    bf16_t* Y; const float* b2;
    __device__ __forceinline__ void operator()(const Acc& acc, const Unit& u, int wr, int wc, int fr, int fq) const {
        const int row0 = u.pm * BM + wr * 64 + fr, col0 = u.pn * BM + wc * 32 + 8 * fq;
        const float* bp = b2 + (size_t)u.e * DM + col0;
        f32x4 bv[2][2];
#pragma unroll
        for (int bj = 0; bj < 2; ++bj)
#pragma unroll
            for (int n = 0; n < 2; ++n) bv[bj][n] = *(const f32x4*)(bp + bj * HALF + 4 * n);
#pragma unroll
        for (int ai = 0; ai < 2; ++ai)
#pragma unroll
            for (int m = 0; m < 4; ++m) { bf16_t* rowp = Y + (size_t)(row0 + ai * HALF + m * 16) * DM + col0;
#pragma unroll
                for (int bj = 0; bj < 2; ++bj) { const f32x4 v0 = acc[ai][bj][m][0] + bv[bj][0], v1 = acc[ai][bj][m][1] + bv[bj][1];
                    u32x4 w; w.x = pk2(v0[0], v0[1]); w.y = pk2(v0[2], v0[3]); w.z = pk2(v1[0], v1[1]); w.w = pk2(v1[2], v1[3]);
                    *(u32x4*)(rowp + bj * HALF) = w; } }
    }
};
}

struct Args { const float* in[32]; float* out; unsigned char* ws; int ph_lo, ph_hi; };
enum { I_X = 0, I_C, I_WMOD, I_BMOD, I_N1G, I_N2G, I_WIN, I_MU, I_W0, I_WUP, I_A0, I_AUP, I_GUP, I_KK, I_KA, I_RK, I_LNG, I_LNB, I_DLAM, I_SUBG, I_RELB, I_WBA, I_WBB, I_WBC, I_WOUT, I_RW, I_RB, I_W1, I_B1, I_W2, I_B2, I_FNG };

__device__ __forceinline__ void lds_fence() { asm volatile("s_waitcnt lgkmcnt(0)" ::: "memory"); }

__device__ __forceinline__ void tr_item(const float* W, int ldw, int ncols, bf16_t* WT, int K, LAS float* scr, int item, int lane) {
    const int nblk = ncols >> 5, kb = item / nblk, nb = item - kb * nblk, k0 = 64 * kb, n0 = 32 * nb;
#pragma unroll 8
    for (int i = 0; i < 32; ++i) { const int kk = 2 * i + (lane >> 5); scr[kk * 33 + (lane & 31)] = W[(size_t)(k0 + kk) * ldw + n0 + (lane & 31)]; }
    lds_fence();
    const int c = lane & 7;
#pragma unroll
    for (int j = 0; j < 4; ++j) { const int n = (lane >> 3) + 8 * j; const LAS float* s = scr + (8 * c) * 33 + n;
        u32x4 o; o.x = pk2(s[0 * 33], s[1 * 33]); o.y = pk2(s[2 * 33], s[3 * 33]); o.z = pk2(s[4 * 33], s[5 * 33]); o.w = pk2(s[6 * 33], s[7 * 33]);
        *(u32x4*)(WT + (size_t)(n0 + n) * K + k0 + 8 * c) = o; }
    lds_fence();
}
__device__ __forceinline__ int t5_bucket(int rel) {
    const int ret = rel > 0 ? 16 : 0; const int n = rel < 0 ? -rel : rel;
    int v;
    if (n < 8) v = n; else if (n < 12) v = 8; else if (n < 16) v = 9; else if (n < 23) v = 10; else if (n < 32) v = 11;
    else if (n < 46) v = 12; else if (n < 64) v = 13; else if (n < 91) v = 14; else v = 15;
    return ret + v;
}
__device__ __forceinline__ void phase_p0(const Args& a, LAS unsigned char* lds) {
    const int tid = otid(), lane = tid & 63, wave = tid >> 6, G = gridDim.x;
    unsigned char* ws = a.ws;
    {
        LAS float* scr = (LAS float*)(lds + wave * 8448);
        const int gw = blockIdx.x * 8 + wave, NGW = G * 8;
        constexpr int NITEMS = 65536 + 32768 + 2 * 6592;
        for (int it = gw; it < NITEMS; it += NGW) {
            int r = it;
            if (r < 65536) { const int mat = r >> 10; tr_item(a.in[I_W1] + (size_t)mat * DM * 2 * FF, 2 * FF, 2 * FF, (bf16_t*)(ws + WS_W1) + (size_t)mat * 2 * FF * DM, DM, scr, r & 1023, lane); continue; }
            r -= 65536;
            if (r < 32768) { const int mat = r >> 9; tr_item(a.in[I_W2] + (size_t)mat * FF * DM, DM, DM, (bf16_t*)(ws + WS_W2) + (size_t)mat * DM * FF, FF, scr, r & 511, lane); continue; }
            r -= 32768;
            const int l = r / 6592; r -= l * 6592;
            if (r < 2496) { tr_item(a.in[I_WIN] + (size_t)l * DM * IN_COLS, IN_COLS, 4992, (bf16_t*)(ws + WS_WIN) + (size_t)l * PLD * DM, DM, scr, r, lane); continue; }
            r -= 2496;
            if (r < 2688) { tr_item(a.in[I_WIN] + (size_t)l * DM * IN_COLS + 4992, IN_COLS, 5376, (bf16_t*)(ws + WS_WIN) + (size_t)l * PLD * DM + (size_t)5120 * DM, DM, scr, r, lane); continue; }
            r -= 2688;
            if (r < 128) { tr_item(a.in[I_WBA] + (size_t)l * 256 * DM, DM, DM, (bf16_t*)(ws + WS_WA) + (size_t)l * DM * 256, 256, scr, r, lane); continue; }
            r -= 128;
            if (r < 384) { tr_item(a.in[I_WBB] + (size_t)l * 768 * DM, DM, DM, (bf16_t*)(ws + WS_WB) + (size_t)l * DM * 768, 768, scr, r, lane); continue; }
            r -= 384;
            if (r < 384) { tr_item(a.in[I_WBC] + (size_t)l * 768 * DM, DM, DM, (bf16_t*)(ws + WS_WC) + (size_t)l * DM * 768, 768, scr, r, lane); continue; }
            r -= 384;
            tr_item(a.in[I_WOUT] + (size_t)l * DM * DM, DM, DM, (bf16_t*)(ws + WS_WO) + (size_t)l * DM * DM, DM, scr, r, lane);
        }
        for (int i = blockIdx.x * 512 + tid; i < 2 * 128 * DM / 8; i += G * 512) {
            const int l = i / (128 * DM / 8), o = i - l * (128 * DM / 8);
            *(u32x4*)((bf16_t*)(ws + WS_WIN) + (size_t)l * PLD * DM + (size_t)4992 * DM + (size_t)o * 8) = (u32x4){0u, 0u, 0u, 0u};
        }
    }
    {
        bf16_t* WT = (bf16_t*)(ws + WS_MISC + MISC_WUPT); bf16_t* AT = (bf16_t*)(ws + WS_MISC + MISC_AUPT);
        for (int i = blockIdx.x * 512 + tid; i < 2 * 2 * 12 * 4096; i += G * 512) {
            const int j = i & 63, k = (i >> 6) & 63, hd = (i >> 12) % 12, ld = i / (12 * 4096);
            const size_t src = ((size_t)ld * 64 + j) * RW + hd * 64 + k;
            WT[i] = (bf16_t)(pk2(a.in[I_WUP][src], 0.f) & 0xffffu); AT[i] = (bf16_t)(pk2(a.in[I_AUP][src], 0.f) & 0xffffu);
        }
    }
    {
        bf16_t* GT = (bf16_t*)(ws + WS_MISC + MISC_GUPT);
        for (int i = blockIdx.x * 512 + tid; i < 2 * 768 * 256; i += G * 512) {
            const int k = i & 255, n = (i >> 8) % 768, l2 = i / (768 * 256);
            GT[i] = k < 128 ? f2bf(a.in[I_GUP][((size_t)l2 * 128 + k) * RW + n]) : (bf16_t)0;
        }
    }
    __syncthreads();
    if ((int)blockIdx.x < 192) {
        LAS float* sc = (LAS float*)(lds + 69632);
        LAS float* red = (LAS float*)(lds + 102400);
        for (int i = tid; i < NB * DM; i += 512) { const float v = a.in[I_C][i]; sc[i] = v / (1.f + expf(-v)); }
        __syncthreads();
        float* mod = (float*)(ws + WS_MISC + MISC_MOD);
        for (int j = blockIdx.x; j < 192; j += G) {
            const int l = j / 96, n0 = (j - l * 96) * 64, jj = tid & 63, ks = tid >> 6;
            float acc[8];
#pragma unroll
            for (int b = 0; b < 8; ++b) acc[b] = 0.f;
            const float* wp = a.in[I_WMOD] + ((size_t)l * DM + ks * 128) * 6144 + n0 + jj;
            for (int k = 0; k < 128; ++k) { const float w = wp[(size_t)k * 6144];
#pragma unroll
                for (int b = 0; b < 8; ++b) acc[b] += sc[b * DM + ks * 128 + k] * w; }
#pragma unroll
            for (int b = 0; b < 8; ++b) red[(ks * 8 + b) * 64 + jj] = acc[b];
            __syncthreads();
            { const int b = tid >> 6; float s = 0.f;
#pragma unroll
              for (int k2 = 0; k2 < 8; ++k2) s += red[(k2 * 8 + b) * 64 + jj];
              mod[((size_t)l * 8 + b) * 6144 + n0 + jj] = s + a.in[I_BMOD][(size_t)l * 6144 + n0 + jj]; }
            __syncthreads();
        }
    }
    if ((int)blockIdx.x == G - 1) {
        float* lam = (float*)(ws + WS_MISC + MISC_LAM);
        if (tid < 2) { const int l = tid; const float* dl = a.in[I_DLAM] + (size_t)l * 256; float s01 = 0.f, s23 = 0.f;
            for (int d = 0; d < 64; ++d) { s01 += dl[d] * dl[64 + d]; s23 += dl[128 + d] * dl[192 + d]; }
            const float li = 0.8f - 0.6f * expf(-0.3f * (float)l);
            lam[l] = expf(s01) - expf(s23) + li; lam[2 + l] = li; }
        float* bA = (float*)(ws + WS_MISC + MISC_BIASA);
        for (int i = tid; i < 12 * 129; i += 512) { const int head = i / 129, jj = i - head * 129, g = head >> 2; const int dil = (g == 0) ? 1 : (g == 1) ? 4 : 16;
            bA[i] = a.in[I_RELB][t5_bucket((jj - 64) * dil) * 18 + head] * LOG2E; }
        float* bC = (float*)(ws + WS_MISC + MISC_BIASC);
        for (int i = tid; i < 6 * 257; i += 512) { const int h = i / 257, rel = i - h * 257 - 128;
            bC[i] = a.in[I_RELB][t5_bucket(rel) * 18 + 12 + h] * LOG2E; }
    }
}

__device__ __forceinline__ float row_rstd(const f32x4 (&v)[4], float eps) {
    float s = 0.f;
#pragma unroll
    for (int j = 0; j < 4; ++j) s += (v[j].x * v[j].x + v[j].y * v[j].y) + (v[j].z * v[j].z + v[j].w * v[j].w);
    return rsqrtf(wave_sum(s) * (1.f / DM) + eps);
}
__device__ __forceinline__ void norm_mod_store(const f32x4 (&v)[4], float rstd, const float* g, const float* sc, const float* sh, bf16_t* orow, int lane) {
#pragma unroll
    for (int j = 0; j < 4; ++j) { const int c = 4 * lane + 256 * j;
        const f32x4 gv = *(const f32x4*)(g + c), scv = *(const f32x4*)(sc + c), shv = *(const f32x4*)(sh + c);
        const f32x4 y = v[j] * rstd * gv * (scv + 1.0f) + shv;
        u32x2 w; w.x = pk2(y.x, y.y); w.y = pk2(y.z, y.w);
        *(u32x2*)(orow + c) = w; }
}
__device__ __forceinline__ void phase_norm1(const Args& a, int l) {
    const int tid = otid(), lane = tid & 63, wave = tid >> 6;
    const float* mod = (const float*)(a.ws + WS_MISC + MISC_MOD) + (size_t)l * 8 * 6144;
    bf16_t* H = (bf16_t*)(a.ws + WS_H);
    for (int t = blockIdx.x * 8 + wave; t < NTOK; t += gridDim.x * 8) {
        const float* xr = a.in[I_X] + (size_t)t * DM; f32x4 v[4];
#pragma unroll
        for (int j = 0; j < 4; ++j) v[j] = *(const f32x4*)(xr + 4 * lane + 256 * j);
        const float rstd = row_rstd(v, 1e-6f);
        const float* mb = mod + (size_t)(t >> 11) * 6144;
        norm_mod_store(v, rstd, a.in[I_N1G] + (size_t)l * DM, mb + 1024, mb, H + (size_t)t * DM, lane);
    }
}

__device__ __forceinline__ float shiftv(const bf16_t* P, int t, int col, const float* mu) {
    const int ts = t & (NT - 1); const bf16_t* p0 = P + (size_t)t * PLD + C_BS + col;
    const float p = bf2f(p0[0]);
    const float pm = ts > 0 ? bf2f(p0[-PLD]) : 0.f;
    const float pn = ts < NT - 1 ? bf2f(p0[PLD]) : 0.f;
    return p + mu[col] * (pm - p) + mu[RSTR + col] * (pn - p);
}
__device__ __forceinline__ void phase_rwkv_pre(const Args& a, int l, LAS unsigned char* lds) {
    const int tid = otid(), lane = tid & 63, wave = tid >> 6;
    unsigned char* ws = a.ws;
    const bf16_t* P = (const bf16_t*)(ws + WS_PROJ);
    const float* mu = a.in[I_MU] + (size_t)l * 2 * RSTR;
    LAS float* LW = (LAS float*)lds;
    float* GS = (float*)(ws + WS_GS);
    float* RR = (float*)(ws + WS_RR); float* RV = (float*)(ws + WS_RV);
    float* RWD = (float*)(ws + WS_RWD); float* RKK = (float*)(ws + WS_RKK); float* RKKA = (float*)(ws + WS_RKKA); float* RKD = (float*)(ws + WS_RKD);
    const float* w0 = a.in[I_W0] + (size_t)l * 2 * RW; const float* a0 = a.in[I_A0] + (size_t)l * 2 * RW;
    const float* wup = a.in[I_WUP] + (size_t)l * 2 * 64 * RW; const float* aup = a.in[I_AUP] + (size_t)l * 2 * 64 * RW;
    const float* kkp = a.in[I_KK] + (size_t)l * 2 * RW; const float* kap = a.in[I_KA] + (size_t)l * 2 * RW;
    for (int tile = blockIdx.x; tile < NTOK / 32; tile += gridDim.x) {
        const int t0 = tile * 32;
        for (int idx = tid; idx < 32 * 384; idx += 512) {
            const int i = idx / 384, cc = idx - i * 384;
            const float val = shiftv(P, t0 + i, 2304 + cc, mu);
            if (cc < 128) { const int di = cc >> 6, j = cc & 63; LW[(j * 32 + i) * 4 + di] = tanhf(val); }
            else if (cc < 256) { const int c2 = cc - 128, di = c2 >> 6, j = c2 & 63; LW[(j * 32 + i) * 4 + 2 + di] = val; }
            else GS[(size_t)(t0 + i) * 128 + cc - 256] = sigmoidf_(val);
        }
        __syncthreads();
        for (int q = wave; q < 48; q += 8) {
            const int hd = q % 12, tg = q / 12, c = hd * 64 + lane, tb = t0 + tg * 8;
            float kv[8];
#pragma unroll
            for (int tk = 0; tk < 8; ++tk) { const int t = tb + tk;
                kv[tk] = shiftv(P, t, 768 + c, mu);
                RR[(size_t)t * RW + c] = shiftv(P, t, c, mu);
                RV[(size_t)t * RW + c] = shiftv(P, t, 1536 + c, mu); }
            float aw0[8], aw1[8], aa0[8], aa1[8];
#pragma unroll
            for (int tk = 0; tk < 8; ++tk) { aw0[tk] = 0.f; aw1[tk] = 0.f; aa0[tk] = 0.f; aa1[tk] = 0.f; }
            for (int j = 0; j < 64; ++j) {
                const float wu0 = wup[(size_t)j * RW + c], wu1 = wup[(size_t)(64 + j) * RW + c], au0 = aup[(size_t)j * RW + c], au1 = aup[(size_t)(64 + j) * RW + c];
#pragma unroll
                for (int tk = 0; tk < 8; ++tk) { const f32x4 q4 = *(const LAS f32x4*)(LW + (j * 32 + tg * 8 + tk) * 4);
                    aw0[tk] += q4.x * wu0; aw1[tk] += q4.y * wu1; aa0[tk] += q4.z * au0; aa1[tk] += q4.w * au1; }
            }
#pragma unroll
            for (int di = 0; di < 2; ++di) {
                const float w0c = w0[di * RW + c], a0c = a0[di * RW + c], kkc = kkp[di * RW + c], kac = kap[di * RW + c];
#pragma unroll
                for (int tk = 0; tk < 8; ++tk) { const int t = tb + tk;
                    const float z = w0c + (di ? aw1[tk] : aw0[tk]);
                    const float u = -z; const float sp = fmaxf(u, 0.f) + log1pf(expf(-fabsf(u)));
                    const float wlog = -sp - 0.5f;
                    const float decay = expf(-expf(wlog));
                    const float av = sigmoidf_(a0c + (di ? aa1[tk] : aa0[tk]));
                    const float kr = kv[tk] * kkc;
                    const float nrm = wave_sum(kr * kr);
                    const float kk = kr * rsqrtf(fmaxf(nrm, 1e-24f));
                    const float kd = kv[tk] * (1.f + (av - 1.f) * kac);
                    const size_t o = ((size_t)di * NTOK + t) * RW + c;
                    RWD[o] = decay; RKK[o] = kk; RKKA[o] = kk * av; RKD[o] = kd; }
            }
        }
        __syncthreads();
    }
}

__device__ __forceinline__ void swa_wave_unit(const bf16_t* P, float* OAG, float* LSE, const LAS float* biasA, LAS unsigned char* vbuf, int u, int lane) {
    const int b = u / 768; const int rem = u - b * 768; const int head = rem >> 6, s = rem & 63;
    const int g = head >> 2, hh = head & 3;
    const int dsh = (g == 0) ? 0 : (g == 1) ? 2 : 4;
    const int L = NT >> dsh, nmbsh = 6 - dsh;
    const int r = s >> nmbsh, mb = s & ((1 << nmbsh) - 1);
    const int r32 = lane & 31, hi = lane >> 5;
    const size_t tq = (size_t)b * NT + ((mb * 32 + r32) << dsh) + r;
    bf16x8 qf[4];
    { const bf16_t* qp = P + tq * PLD + C_AQ + head * 64 + 8 * hi;
#pragma unroll
      for (int s4 = 0; s4 < 4; ++s4) qf[s4] = *(const bf16x8*)(qp + 16 * s4); }
    f32x16 o[2]; o[0] = (f32x16){}; o[1] = (f32x16){};
    float m = -1e30f, lsum = 0.f;
    const float SC = 0.125f * LOG2E;
    const LAS float* bh = biasA + head * 129 + 64;
    const int trbase = (4 * hi + ((lane & 15) >> 2)) * 144 + (16 * ((lane >> 4) & 1) + 4 * (lane & 3)) * 2;
    for (int kt = -2; kt <= 2; ++kt) {
        const int m0 = mb * 32 + kt * 32;
        if (m0 + 31 < 0 || m0 >= L) continue;
        bf16x8 kf[4];
        { int km = m0 + r32; km = km < 0 ? 0 : (km > L - 1 ? L - 1 : km);
          const bf16_t* kp = P + ((size_t)b * NT + (km << dsh) + r) * PLD + C_AK + head * 64 + 8 * hi;
#pragma unroll
          for (int s4 = 0; s4 < 4; ++s4) kf[s4] = *(const bf16x8*)(kp + 16 * s4); }
        asm volatile("" ::: "memory");
#pragma unroll
        for (int c4 = 0; c4 < 4; ++c4) { const int id = lane + 64 * c4, row = id >> 3, ch = id & 7;
            int vm = m0 + row; vm = vm < 0 ? 0 : (vm > L - 1 ? L - 1 : vm);
            const u32x4 val = *(const u32x4*)(P + ((size_t)b * NT + (vm << dsh) + r) * PLD + C_AV + head * 64 + ch * 8);
            *(LAS u32x4*)(vbuf + row * 144 + ch * 16) = val; }
        f32x16 sacc = (f32x16){};
#pragma unroll
        for (int s4 = 0; s4 < 4; ++s4) sacc = __builtin_amdgcn_mfma_f32_32x32x16_bf16(kf[s4], qf[s4], sacc, 0, 0, 0);
        float x[16]; float mx = -1e30f;
#pragma unroll
        for (int rg = 0; rg < 16; ++rg) { const int kvl = crow(rg, hi), km = m0 + kvl, j = kt * 32 + kvl - r32;
            const bool valid = (km >= 0) && (km < L) && (j >= -64) && (j <= 64);
            const int jc = j < -64 ? -64 : (j > 64 ? 64 : j);
            const float xv = sacc[rg] * SC + bh[jc];
            x[rg] = valid ? xv : -1e30f; mx = fmaxf(mx, x[rg]); }
        mx = fmaxf(mx, __shfl_xor(mx, 32));
        const float mn = fmaxf(m, mx), alpha = __builtin_amdgcn_exp2f(m - mn); m = mn;
        float ps = 0.f;
#pragma unroll
        for (int rg = 0; rg < 16; ++rg) { x[rg] = __builtin_amdgcn_exp2f(x[rg] - mn); ps += x[rg]; }
        lsum = lsum * alpha + ps;
#pragma unroll
        for (int rg = 0; rg < 16; ++rg) { o[0][rg] *= alpha; o[1][rg] *= alpha; }
        u32x4 pw[2];
#pragma unroll
        for (int s2 = 0; s2 < 2; ++s2) { pw[s2].x = pk2(x[8 * s2 + 0], x[8 * s2 + 1]); pw[s2].y = pk2(x[8 * s2 + 2], x[8 * s2 + 3]); pw[s2].z = pk2(x[8 * s2 + 4], x[8 * s2 + 5]); pw[s2].w = pk2(x[8 * s2 + 6], x[8 * s2 + 7]); }
        lds_fence();
#pragma unroll
        for (int db = 0; db < 2; ++db)
#pragma unroll
            for (int s2 = 0; s2 < 2; ++s2) {
                const s16x4 lo = vtr(vbuf + trbase + (16 * s2) * 144 + db * 64);
                const s16x4 hi4 = vtr(vbuf + trbase + (16 * s2 + 8) * 144 + db * 64);
                const bf16x8 af = (bf16x8){lo[0], lo[1], lo[2], lo[3], hi4[0], hi4[1], hi4[2], hi4[3]};
                o[db] = __builtin_amdgcn_mfma_f32_32x32x16_bf16(af, __builtin_bit_cast(bf16x8, pw[s2]), o[db], 0, 0, 0);
            }
        asm volatile("" ::: "memory");
    }
    const float lt = lsum + __shfl_xor(lsum, 32);
    const float inv = 1.f / lt;
    float* op = OAG + ((size_t)g * NTOK + tq) * 256 + hh * 64;
#pragma unroll
    for (int db = 0; db < 2; ++db)
#pragma unroll
        for (int i = 0; i < 4; ++i) { f32x4 v = (f32x4){o[db][4 * i], o[db][4 * i + 1], o[db][4 * i + 2], o[db][4 * i + 3]} * inv;
            *(f32x4*)(op + db * 32 + 8 * i + 4 * hi) = v; }
    if (hi == 0) LSE[((size_t)g * NTOK + tq) * 4 + hh] = m + __log2f(lt);
}
__device__ __forceinline__ void phase_swa(const Args& a, LAS unsigned char* lds) {
    const int tid = otid(), lane = tid & 63, wave = tid >> 6;
    LAS float* bA = (LAS float*)(lds + 40960);
    const float* bAg = (const float*)(a.ws + WS_MISC + MISC_BIASA);
    for (int i = tid; i < 12 * 129; i += 512) bA[i] = bAg[i];
    __syncthreads();
    for (int item = blockIdx.x; item < 768; item += gridDim.x)
        swa_wave_unit((const bf16_t*)(a.ws + WS_PROJ), (float*)(a.ws + WS_OAG), (float*)(a.ws + WS_LSE), bA, lds + wave * 4608, item * 8 + wave, lane);
    __syncthreads();
}

__device__ __forceinline__ void rwkv_scan_unit(const Args& a, int unit, LAS unsigned char* lds) {
    const int dir = unit & 1, bh = unit >> 1, h = bh % 12, b = bh / 12;
    const int tid = otid(), row = tid >> 3, kp = tid & 7;
    unsigned char* ws = a.ws;
    const size_t base_d = ((size_t)dir * NTOK + (size_t)b * NT) * RW + h * 64;
    const size_t base_s = ((size_t)b * NT) * RW + h * 64;
    const float* src[6] = { (const float*)(ws + WS_RWD) + base_d, (const float*)(ws + WS_RKK) + base_d, (const float*)(ws + WS_RKKA) + base_d, (const float*)(ws + WS_RKD) + base_d,
                            (const float*)(ws + WS_RR) + base_s, (const float*)(ws + WS_RV) + base_s };
    float* Y = (float*)(ws + WS_Y) + base_d;
    LAS float* ybuf = (LAS float*)(lds + 98304);
    const int li = tid >> 4, lc4 = tid & 15;
    float S[8];
#pragma unroll
    for (int i = 0; i < 8; ++i) S[i] = 0.f;
    f32x4 regs[6];
    { const int ts = dir ? NT - 32 : 0;
#pragma unroll
      for (int q = 0; q < 6; ++q) regs[q] = *(const f32x4*)(src[q] + (size_t)(ts + li) * RW + lc4 * 4);
#pragma unroll
      for (int q = 0; q < 6; ++q) *(LAS f32x4*)(lds + ((q * 32 + li) * 64 + lc4 * 4) * 4) = regs[q]; }
    __syncthreads();
    for (int c = 0; c < 64; ++c) {
        const int ts = dir ? NT - 32 * (c + 1) : 32 * c;
        if (c + 1 < 64) { const int tn = dir ? NT - 32 * (c + 2) : 32 * (c + 1);
#pragma unroll
            for (int q = 0; q < 6; ++q) regs[q] = *(const f32x4*)(src[q] + (size_t)(tn + li) * RW + lc4 * 4); }
        const LAS unsigned char* buf = lds + (c & 1) * 49152;
#pragma unroll 4
        for (int ii = 0; ii < 32; ++ii) {
            const int i = dir ? 31 - ii : ii;
            const LAS float* pw = (const LAS float*)(buf + ((0 * 32 + i) * 64 + 8 * kp) * 4);
            const f32x4 w0 = *(const LAS f32x4*)pw, w1 = *(const LAS f32x4*)(pw + 4);
            const f32x4 k0 = *(const LAS f32x4*)(pw + 2048), k1 = *(const LAS f32x4*)(pw + 2048 + 4);
            const f32x4 a0 = *(const LAS f32x4*)(pw + 4096), a1 = *(const LAS f32x4*)(pw + 4096 + 4);
            const f32x4 d0 = *(const LAS f32x4*)(pw + 6144), d1 = *(const LAS f32x4*)(pw + 6144 + 4);
            const f32x4 r0 = *(const LAS f32x4*)(pw + 8192), r1 = *(const LAS f32x4*)(pw + 8192 + 4);
            const float vv = *(const LAS float*)(buf + ((5 * 32 + i) * 64 + row) * 4);
            float sa = S[0] * k0.x + S[1] * k0.y + S[2] * k0.z + S[3] * k0.w + S[4] * k1.x + S[5] * k1.y + S[6] * k1.z + S[7] * k1.w;
            sa = -dpp_sum8(sa);
            S[0] = S[0] * w0.x + sa * a0.x + vv * d0.x; S[1] = S[1] * w0.y + sa * a0.y + vv * d0.y; S[2] = S[2] * w0.z + sa * a0.z + vv * d0.z; S[3] = S[3] * w0.w + sa * a0.w + vv * d0.w;
            S[4] = S[4] * w1.x + sa * a1.x + vv * d1.x; S[5] = S[5] * w1.y + sa * a1.y + vv * d1.y; S[6] = S[6] * w1.z + sa * a1.z + vv * d1.z; S[7] = S[7] * w1.w + sa * a1.w + vv * d1.w;
            float y = S[0] * r0.x + S[1] * r0.y + S[2] * r0.z + S[3] * r0.w + S[4] * r1.x + S[5] * r1.y + S[6] * r1.z + S[7] * r1.w;
            y = dpp_sum8(y);
            if (kp == 0) ybuf[i * 64 + row] = y;
        }
        __syncthreads();
        *(f32x4*)(Y + (size_t)(ts + li) * RW + lc4 * 4) = *(const LAS f32x4*)(ybuf + li * 64 + lc4 * 4);
        if (c + 1 < 64) { LAS unsigned char* nb = lds + ((c + 1) & 1) * 49152;
#pragma unroll
            for (int q = 0; q < 6; ++q) *(LAS f32x4*)(nb + ((q * 32 + li) * 64 + lc4 * 4) * 4) = regs[q]; }
        __syncthreads();
    }
}

constexpr int RLD = 144, RMAT = 64 * RLD;
constexpr int R_P = 0, R_Q = 4 * RMAT, R_M = R_Q + 2 * 17408;
constexpr int R_WD = R_P, R_AD = R_P + RMAT, R_WUP = R_P + 2 * RMAT, R_AUP = R_P + 3 * RMAT;
constexpr int R_LK = R_P, R_RK = R_P + RMAT, R_RB = R_P + 2 * RMAT, R_TT = R_P + 3 * RMAT;
constexpr int R_ZW = R_Q, R_ZA = R_Q + 17408, R_LBF = R_Q, R_SEG = R_ZA, R_GC = R_ZA + 2048, R_W1T = R_ZA + 4096;
constexpr int R_A = R_M, R_B = R_M + 2 * RMAT, R_BP = R_M + 3 * RMAT, R_K = R_M + 4 * RMAT, R_KP = R_M + 5 * RMAT, R_RHO = R_M + 6 * RMAT, R_V = R_M + 7 * RMAT;
constexpr int R_UT = R_B, R_TAT = R_K;
constexpr int R_TMP0 = R_SEG, R_TMP1 = R_ZA + 13312, R_TMP2 = R_ZA + 13312 + 2048;
static_assert(R_M + 8 * RMAT <= LDS_STAGE, "R1 LDS");

template <bool XT, bool YT>
__device__ __forceinline__ f32x16 tile64x(const LAS unsigned char* XM, int x0, const LAS unsigned char* YM, int y0, int lane, f32x16 acc) {
    const int r32 = lane & 31, hi = lane >> 5;
    const int trofs = ((lane & 15) >> 2) * RLD + (16 * ((lane >> 4) & 1) + 4 * (lane & 3)) * 2;
#pragma unroll
    for (int s4 = 0; s4 < 4; ++s4) {
        bf16x8 xa, yb;
        if (!XT) xa = *(const LAS bf16x8*)(XM + (x0 + r32) * RLD + 32 * s4 + 16 * hi);
        else { const s16x4 lo = vtr(XM + (16 * s4 + 8 * hi) * RLD + trofs + 2 * x0), h4 = vtr(XM + (16 * s4 + 8 * hi + 4) * RLD + trofs + 2 * x0);
               xa = (bf16x8){lo[0], lo[1], lo[2], lo[3], h4[0], h4[1], h4[2], h4[3]}; }
        if (!YT) yb = *(const LAS bf16x8*)(YM + (y0 + r32) * RLD + 32 * s4 + 16 * hi);
        else { const s16x4 lo = vtr(YM + (16 * s4 + 8 * hi) * RLD + trofs + 2 * y0), h4 = vtr(YM + (16 * s4 + 8 * hi + 4) * RLD + trofs + 2 * y0);
               yb = (bf16x8){lo[0], lo[1], lo[2], lo[3], h4[0], h4[1], h4[2], h4[3]}; }
        acc = __builtin_amdgcn_mfma_f32_32x32x16_bf16(xa, yb, acc, 0, 0, 0);
    }
    return acc;
}
__device__ __forceinline__ void shift8r(const u32x4 c, u32x4 m, u32x4 n, bool hm, bool hn, const float* mu, int col, float (&o)[8]) {
    const unsigned mm = hm ? 0xffffffffu : 0u, nm = hn ? 0xffffffffu : 0u;
    m = m & mm; n = n & nm;
    const f32x4 a0 = *(const f32x4*)(mu + col), a1 = *(const f32x4*)(mu + col + 4), b0 = *(const f32x4*)(mu + RSTR + col), b1 = *(const f32x4*)(mu + RSTR + col + 4);
#pragma unroll
    for (int q = 0; q < 4; ++q) {
        const float pl = bflo(c[q]), ph = bfhi(c[q]);
        const float m0 = (q < 2) ? a0[2 * q] : a1[2 * q - 4], m1 = (q < 2) ? a0[2 * q + 1] : a1[2 * q - 3];
        const float n0 = (q < 2) ? b0[2 * q] : b1[2 * q - 4], n1 = (q < 2) ? b0[2 * q + 1] : b1[2 * q - 3];
        o[2 * q] = pl + m0 * (bflo(m[q]) - pl) + n0 * (bflo(n[q]) - pl);
        o[2 * q + 1] = ph + m1 * (bfhi(m[q]) - ph) + n1 * (bfhi(n[q]) - ph);
    }
}
__device__ __forceinline__ int r1_col(int g, int h, int dir, int seg) { return (g < 3 ? g * 768 + h * 64 : (g == 3 ? 2304 : 2432) + dir * 64) + 8 * seg; }
__device__ __forceinline__ void r1_issue(const bf16_t* P, int ct, int tid, u32x4 (&raw)[15]) {
    const int c = ct & 31, dir = (ct >> 5) & 1, bh = ct >> 6, h = bh % 12, b = bh / 12, ti = tid >> 3, seg = tid & 7;
    const int tseq = dir ? (NT - 1 - 64 * c - ti) : (64 * c + ti);
    const bf16_t* p0 = P + ((size_t)b * NT + tseq) * PLD + C_BS;
    const int dm = tseq > 0 ? PLD : 0, dn = tseq < NT - 1 ? PLD : 0;
#pragma unroll
    for (int g = 0; g < 5; ++g) { const int col = r1_col(g, h, dir, seg);
        raw[3 * g] = *(const u32x4*)(p0 + col); raw[3 * g + 1] = *(const u32x4*)(p0 + col - dm); raw[3 * g + 2] = *(const u32x4*)(p0 + col + dn); }
}

__device__ __forceinline__ void phase_rwkv_r1(const Args& a, int l, LAS unsigned char* lds) {
    const int tid0 = otid();
    unsigned char* ws = a.ws;
    const bf16_t* P = (const bf16_t*)(ws + WS_PROJ);
    const float* mu = a.in[I_MU] + (size_t)l * 2 * RSTR;
    const int G = gridDim.x;
    u32x4 raw[15];
    if ((int)blockIdx.x < 6144) r1_issue(P, blockIdx.x, tid0, raw);
  for (int ct = blockIdx.x; ct < 6144; ct += G) {
    int tid = tid0; asm volatile("" : "+v"(tid));
    const int lane = tid & 63, wave = __builtin_amdgcn_readfirstlane(tid >> 6), r32 = lane & 31, hi = lane >> 5;
    const int ti = tid >> 3, seg = tid & 7;
    const int c = ct & 31, dir = (ct >> 5) & 1, bh = ct >> 6, h = bh % 12, b = bh / 12;
    const int tseq = dir ? (NT - 1 - 64 * c - ti) : (64 * c + ti);
    const size_t trow = (size_t)b * NT + tseq;
    const bool hm = tseq > 0, hn = tseq < NT - 1;
    float r8[8], k8[8], v8[8];
    {
        shift8r(raw[0], raw[1], raw[2], hm, hn, mu, r1_col(0, h, dir, seg), r8);
        shift8r(raw[3], raw[4], raw[5], hm, hn, mu, r1_col(1, h, dir, seg), k8);
        shift8r(raw[6], raw[7], raw[8], hm, hn, mu, r1_col(2, h, dir, seg), v8);
        float t8[8];
        shift8r(raw[9], raw[10], raw[11], hm, hn, mu, r1_col(3, h, dir, seg), t8);
#pragma unroll
        for (int q = 0; q < 8; ++q) { const float e2 = __expf(2.f * t8[q]); t8[q] = 1.f - 2.f / (e2 + 1.f); }
        *(LAS u32x4*)(lds + R_WD + ti * RLD + 16 * seg) = pack8(t8);
        shift8r(raw[12], raw[13], raw[14], hm, hn, mu, r1_col(4, h, dir, seg), t8);
        *(LAS u32x4*)(lds + R_AD + ti * RLD + 16 * seg) = pack8(t8);
        if (h == 0 && dir == 0) {
            const bf16_t* p0 = P + trow * PLD + C_BS;
            bf16_t* GS = (bf16_t*)(ws + WS_GS) + trow * 256;
#pragma unroll
            for (int hf = 0; hf < 2; ++hf) { const int col = 2560 + 64 * hf + 8 * seg;
                shift8r(*(const u32x4*)(p0 + col), *(const u32x4*)(p0 + col - (hm ? PLD : 0)), *(const u32x4*)(p0 + col + (hn ? PLD : 0)), hm, hn, mu, col, t8);
#pragma unroll
                for (int q = 0; q < 8; ++q) t8[q] = sigmoidf_(t8[q]);
                *(u32x4*)(GS + 64 * hf + 8 * seg) = pack8(t8);
                *(u32x4*)(GS + 128 + 64 * hf + 8 * seg) = (u32x4){0u, 0u, 0u, 0u}; }
        }
        const size_t wofs = ((size_t)(l * 2 + dir) * 12 + h) * 4096 + (size_t)ti * 64 + 8 * seg;
        *(LAS u32x4*)(lds + R_WUP + ti * RLD + 16 * seg) = *(const u32x4*)((const bf16_t*)(ws + WS_MISC + MISC_WUPT) + wofs);
        *(LAS u32x4*)(lds + R_AUP + ti * RLD + 16 * seg) = *(const u32x4*)((const bf16_t*)(ws + WS_MISC + MISC_AUPT) + wofs);
        if (dir == 0) {
            float* RR = (float*)(ws + WS_RR) + trow * RW + h * 64 + 8 * seg; float* RV = (float*)(ws + WS_RV) + trow * RW + h * 64 + 8 * seg;
            *(f32x4*)RR = (f32x4){r8[0], r8[1], r8[2], r8[3]}; *(f32x4*)(RR + 4) = (f32x4){r8[4], r8[5], r8[6], r8[7]};
            *(f32x4*)RV = (f32x4){v8[0], v8[1], v8[2], v8[3]}; *(f32x4*)(RV + 4) = (f32x4){v8[4], v8[5], v8[6], v8[7]};
        }
    }
    if (ct + G < 6144) r1_issue(P, ct + G, tid, raw);
    __syncthreads();
    {
        const int p = wave >> 2, tt = wave & 3, tm = tt >> 1, tn = tt & 1;
        f32x16 acc = (f32x16){};
        acc = tile64x<false, false>(lds + (p ? R_AUP : R_WUP), 32 * tm, lds + (p ? R_AD : R_WD), 32 * tn, lane, acc);
        LAS float* Z = (LAS float*)(lds + (p ? R_ZA : R_ZW));
#pragma unroll
        for (int q = 0; q < 4; ++q) *(LAS f32x4*)(Z + (32 * tn + r32) * 68 + 32 * tm + 8 * q + 4 * hi) = (f32x4){acc[4 * q], acc[4 * q + 1], acc[4 * q + 2], acc[4 * q + 3]};
    }
    __syncthreads();
    float kka8[8], kk8[8], kd8[8];
    {
        const int cb = dir * RW + h * 64 + 8 * seg;
        const float* w0 = a.in[I_W0] + (size_t)l * 2 * RW + cb; const float* a0 = a.in[I_A0] + (size_t)l * 2 * RW + cb;
        const float* kkp = a.in[I_KK] + (size_t)l * 2 * RW + cb; const float* kap = a.in[I_KA] + (size_t)l * 2 * RW + cb;
        LAS float* Zw = (LAS float*)(lds + R_ZW) + ti * 68 + 8 * seg; const LAS float* Za = (const LAS float*)(lds + R_ZA) + ti * 68 + 8 * seg;
        float nrm = 0.f, av[8], e8[8];
#pragma unroll
        for (int q = 0; q < 8; ++q) {
            const float z = w0[q] + Zw[q];
            const float u = -z; const float sp = fmaxf(u, 0.f) + __logf(1.f + __expf(-fabsf(u)));
            e8[q] = __expf(-sp - 0.5f);
            av[q] = sigmoidf_(a0[q] + Za[q]);
            const float kr = k8[q] * kkp[q]; kk8[q] = kr; nrm += kr * kr;
            kd8[q] = k8[q] * (1.f + (av[q] - 1.f) * kap[q]);
        }
        nrm = dpp_sum8(nrm);
        const float rn = rsqrtf(fmaxf(nrm, 1e-24f));
#pragma unroll
        for (int q = 0; q < 8; ++q) { kk8[q] *= rn; kka8[q] = kk8[q] * av[q]; Zw[q] = e8[q]; }
        float* RKD = (float*)(ws + WS_RKD) + ((size_t)dir * NTOK + trow) * RW + h * 64 + 8 * seg;
        *(f32x4*)RKD = (f32x4){kd8[0], kd8[1], kd8[2], kd8[3]}; *(f32x4*)(RKD + 4) = (f32x4){kd8[4], kd8[5], kd8[6], kd8[7]};
    }
    __syncthreads();
    {
        const int kc = tid & 63, sg = tid >> 6;
        LAS float* Zw = (LAS float*)(lds + R_ZW); LAS float* SEG = (LAS float*)(lds + R_SEG);
        float run = 0.f;
#pragma unroll
        for (int q = 0; q < 8; ++q) { run += Zw[(8 * sg + q) * 68 + kc]; Zw[(8 * sg + q) * 68 + kc] = run; }
        SEG[sg * 64 + kc] = run;
        __syncthreads();
        float off = 0.f;
        for (int s2 = 0; s2 < sg; ++s2) off += SEG[s2 * 64 + kc];
#pragma unroll
        for (int q = 0; q < 8; ++q) Zw[(8 * sg + q) * 68 + kc] += off;
    }
    __syncthreads();
    {
        const LAS float* Gp = (const LAS float*)(lds + R_ZW);
        float al[8], be[8], bp[8], ka[8], kp[8], rh[8];
#pragma unroll
        for (int q = 0; q < 8; ++q) {
            const float gi = Gp[ti * 68 + 8 * seg + q], gm = ti > 0 ? Gp[(ti - 1) * 68 + 8 * seg + q] : 0.f, g63 = Gp[63 * 68 + 8 * seg + q];
            const float ig = __expf(gi), tl = __expf(gi - g63);
            al[q] = __expf(-gm) * kk8[q]; be[q] = kka8[q] * ig; bp[q] = kka8[q] * tl; ka[q] = kd8[q] * ig; kp[q] = kd8[q] * tl; rh[q] = r8[q] * __expf(-gi);
            if (ti == 63) ((LAS float*)(lds + R_GC))[8 * seg + q] = __expf(-g63);
        }
        const int o = ti * RLD + 16 * seg;
        *(LAS u32x4*)(lds + R_A + o) = pack8(al); *(LAS u32x4*)(lds + R_B + o) = pack8(be); *(LAS u32x4*)(lds + R_K + o) = pack8(ka); *(LAS u32x4*)(lds + R_RHO + o) = pack8(rh);
        *(LAS u32x4*)(lds + R_BP + o) = pack8(bp); *(LAS u32x4*)(lds + R_KP + o) = pack8(kp); *(LAS u32x4*)(lds + R_V + o) = pack8(v8);
    }
    __syncthreads();
    {
        const int tt = wave & 3, tm = tt >> 1, tn = tt & 1;
        const int jb = 32 * tm, ib = 32 * tn, i = ib + r32;
        f32x16 acc0 = (f32x16){}, acc1 = (f32x16){};
        if (tm <= tn) {
            acc0 = tile64x<false, false>(lds + (wave < 4 ? R_B : R_K), jb, lds + (wave < 4 ? R_A : R_RHO), ib, lane, acc0);
            acc1 = tile64x<false, false>(lds + (wave < 4 ? R_K : R_B), jb, lds + (wave < 4 ? R_A : R_RHO), ib, lane, acc1);
        }
#pragma unroll
        for (int rg = 0; rg < 16; ++rg) { const int j = jb + crow(rg, hi); const bool keep = (wave < 4) ? (j < i) : (j <= i);
            acc0[rg] = keep ? acc0[rg] : 0.f; acc1[rg] = keep ? acc1[rg] : 0.f; }
#pragma unroll
        for (int q = 0; q < 4; ++q) { const int jo = jb + 8 * q + 4 * hi;
            u32x2 w1; w1.x = pk2(acc1[4 * q], acc1[4 * q + 1]); w1.y = pk2(acc1[4 * q + 2], acc1[4 * q + 3]);
            if (wave < 4) {
                *(LAS f32x4*)((LAS float*)(lds + R_LBF) + i * 68 + jo) = (f32x4){acc0[4 * q], acc0[4 * q + 1], acc0[4 * q + 2], acc0[4 * q + 3]};
                *(LAS u32x2*)(lds + R_LK + i * RLD + 2 * jo) = w1;
                if (wave == 1) { u32x2 wl; wl.x = pk2(acc0[4 * q], acc0[4 * q + 1]); wl.y = pk2(acc0[4 * q + 2], acc0[4 * q + 3]);
                    *(LAS u32x2*)(lds + R_TMP0 + r32 * 64 + 2 * (8 * q + 4 * hi)) = wl; }
            } else {
                u32x2 w0; w0.x = pk2(acc0[4 * q], acc0[4 * q + 1]); w0.y = pk2(acc0[4 * q + 2], acc0[4 * q + 3]);
                *(LAS u32x2*)(lds + R_RK + i * RLD + 2 * jo) = w0;
                *(LAS u32x2*)(lds + R_RB + i * RLD + 2 * jo) = w1;
            } }
    }
    __syncthreads();
    if (wave < 2) {
        const int blk = wave, col = r32;
        const LAS float* Lf = (const LAS float*)(lds + R_LBF) + (32 * blk) * 68 + 32 * blk;
        float Tm[32];
        f32x4 cur[8], nxt[8];
#pragma unroll
        for (int m4 = 0; m4 < 8; ++m4) { cur[m4] = (f32x4){0.f, 0.f, 0.f, 0.f}; nxt[m4] = (f32x4){0.f, 0.f, 0.f, 0.f}; }
        cur[0] = *(const LAS f32x4*)(Lf + 68);
        Tm[0] = (col == 0) ? 1.f : 0.f;
#pragma unroll
        for (int i = 1; i < 32; ++i) {
            if (i + 1 < 32) {
#pragma unroll
                for (int m4 = 0; m4 < (i + 4) / 4; ++m4) nxt[m4] = *(const LAS f32x4*)(Lf + (i + 1) * 68 + 4 * m4);
            }
            float c0 = (col == i) ? 1.f : 0.f, c1 = 0.f, c2 = 0.f, c3 = 0.f;
#pragma unroll
            for (int m4 = 0; m4 < (i + 3) / 4; ++m4) {
                if (4 * m4 + 0 < i) c0 -= cur[m4][0] * Tm[4 * m4 + 0];
                if (4 * m4 + 1 < i) c1 -= cur[m4][1] * Tm[4 * m4 + 1];
                if (4 * m4 + 2 < i) c2 -= cur[m4][2] * Tm[4 * m4 + 2];
                if (4 * m4 + 3 < i) c3 -= cur[m4][3] * Tm[4 * m4 + 3]; }
            Tm[i] = (c0 + c1) + (c2 + c3);
#pragma unroll
            for (int m4 = 0; m4 < 8; ++m4) cur[m4] = nxt[m4];
            asm volatile("" : "+v"(Tm[i]) :: "memory");
        }
        if (hi == 0) {
#pragma unroll
            for (int i = 0; i < 32; ++i) {
                *(LAS bf16_t*)(lds + R_TT + (32 * blk + i) * RLD + 2 * (32 * blk + col)) = f2bf(Tm[i]);
                if (blk == 0) *(LAS bf16_t*)(lds + R_TT + i * RLD + 2 * (32 + col)) = (bf16_t)0;
            }
            if (blk == 0) {
#pragma unroll
                for (int q = 0; q < 4; ++q) { float x8[8];
#pragma unroll
                    for (int e = 0; e < 8; ++e) x8[e] = Tm[8 * q + e];
                    *(LAS u32x4*)(lds + R_TMP1 + col * 64 + 16 * q) = pack8(x8); } }
        }
    } else if (wave >= 4) {
        const int tt = wave & 3, tm = tt >> 1, tn = tt & 1;
        f32x16 acc = (f32x16){};
        acc = tile64x<false, true>(lds + R_LK, 32 * tm, lds + R_V, 32 * tn, lane, acc);
#pragma unroll
        for (int q = 0; q < 4; ++q) { u32x2 w; w.x = pk2(acc[4 * q], acc[4 * q + 1]); w.y = pk2(acc[4 * q + 2], acc[4 * q + 3]);
            *(LAS u32x2*)(lds + R_W1T + (32 * tn + r32) * RLD + 2 * (32 * tm + 8 * q + 4 * hi)) = w; }
    }
    __syncthreads();
    if (wave == 0) {
        f32x16 x1 = (f32x16){};
#pragma unroll
        for (int s2 = 0; s2 < 2; ++s2) x1 = __builtin_amdgcn_mfma_f32_32x32x16_bf16(*(const LAS bf16x8*)(lds + R_TMP0 + r32 * 64 + 32 * s2 + 16 * hi), *(const LAS bf16x8*)(lds + R_TMP1 + r32 * 64 + 32 * s2 + 16 * hi), x1, 0, 0, 0);
#pragma unroll
        for (int q = 0; q < 4; ++q) { u32x2 w; w.x = pk2(x1[4 * q], x1[4 * q + 1]); w.y = pk2(x1[4 * q + 2], x1[4 * q + 3]);
            *(LAS u32x2*)(lds + R_TMP2 + r32 * 64 + 2 * (8 * q + 4 * hi)) = w; }
        lds_fence();
        f32x16 t21 = (f32x16){};
#pragma unroll
        for (int s2 = 0; s2 < 2; ++s2) t21 = __builtin_amdgcn_mfma_f32_32x32x16_bf16(*(const LAS bf16x8*)(lds + R_TT + (32 + r32) * RLD + 64 + 32 * s2 + 16 * hi), *(const LAS bf16x8*)(lds + R_TMP2 + r32 * 64 + 32 * s2 + 16 * hi), t21, 0, 0, 0);
#pragma unroll
        for (int rg = 0; rg < 16; ++rg) *(LAS bf16_t*)(lds + R_TT + (32 + crow(rg, hi)) * RLD + 2 * r32) = f2bf(-t21[rg]);
    }
    __syncthreads();
    {
        const int tt = wave & 3, tm = tt >> 1, tn = tt & 1;
        f32x16 acc = (f32x16){};
        if (wave < 4) acc = tile64x<false, false>(lds + R_TT, 32 * tm, lds + R_W1T, 32 * tn, lane, acc);
        else          acc = tile64x<false, true>(lds + R_TT, 32 * tm, lds + R_A, 32 * tn, lane, acc);
        LAS unsigned char* dst = lds + (wave < 4 ? R_UT : R_TAT);
#pragma unroll
        for (int q = 0; q < 4; ++q) { u32x2 w; w.x = pk2(acc[4 * q], acc[4 * q + 1]); w.y = pk2(acc[4 * q + 2], acc[4 * q + 3]);
            *(LAS u32x2*)(dst + (32 * tn + r32) * RLD + 2 * (32 * tm + 8 * q + 4 * hi)) = w; }
    }
    __syncthreads();
    {
        const int tt = wave & 3, tm = tt >> 1, tn = tt & 1;
        const size_t cto = (size_t)ct * 4096;
        if (wave < 4) {
            f32x16 acc = (f32x16){};
            acc = tile64x<false, false>(lds + R_TAT, 32 * tm, lds + R_RB, 32 * tn, lane, acc);
            bf16_t* QA = (bf16_t*)(ws + WS_QA) + cto;
#pragma unroll
            for (int q = 0; q < 4; ++q) { const int i = 32 * tn + r32, k = 32 * tm + 8 * q + 4 * hi;
                const u32x2 rv = *(const LAS u32x2*)(lds + R_RHO + i * RLD + 2 * k);
                u32x2 w; w.x = pk2(bflo(rv.x) - acc[4 * q], bfhi(rv.x) - acc[4 * q + 1]); w.y = pk2(bflo(rv.y) - acc[4 * q + 2], bfhi(rv.y) - acc[4 * q + 3]);
                *(u32x2*)(QA + ((tn * 4 + 2 * tm + (q >> 1)) * 64 + (q & 1) * 32 + r32) * 8 + 4 * hi) = w; }
            f32x16 am = (f32x16){};
            am = tile64x<true, false>(lds + R_BP, 32 * tm, lds + R_TAT, 32 * tn, lane, am);
            float* MP = (float*)(ws + WS_MP) + cto; const LAS float* GC = (const LAS float*)(lds + R_GC);
#pragma unroll
            for (int q = 0; q < 4; ++q) { const int k = 32 * tn + r32, kp0 = 32 * tm + 8 * q + 4 * hi; f32x4 o4;
#pragma unroll
                for (int e = 0; e < 4; ++e) o4[e] = ((kp0 + e == k) ? GC[kp0 + e] : 0.f) - am[4 * q + e];
                *(f32x4*)(MP + k * 64 + kp0) = o4; }
        } else {
            f32x16 a1 = (f32x16){}, a2 = (f32x16){};
            a1 = tile64x<true, false>(lds + R_V, 32 * tm, lds + R_RK, 32 * tn, lane, a1);
            a2 = tile64x<false, false>(lds + R_UT, 32 * tm, lds + R_RB, 32 * tn, lane, a2);
            float* Y0 = (float*)(ws + WS_Y0) + cto + tt * 1024 + lane;
#pragma unroll
            for (int rg = 0; rg < 16; ++rg) Y0[rg * 64] = a1[rg] - a2[rg];
            f32x16 n1 = (f32x16){}, n2 = (f32x16){};
            n1 = tile64x<true, true>(lds + R_KP, 32 * tm, lds + R_V, 32 * tn, lane, n1);
            n2 = tile64x<true, false>(lds + R_BP, 32 * tm, lds + R_UT, 32 * tn, lane, n2);
            float* NP = (float*)(ws + WS_NP) + cto;
#pragma unroll
            for (int q = 0; q < 4; ++q) *(f32x4*)(NP + (32 * tn + r32) * 64 + 32 * tm + 8 * q + 4 * hi) = (f32x4){n1[4 * q] - n2[4 * q], n1[4 * q + 1] - n2[4 * q + 1], n1[4 * q + 2] - n2[4 * q + 2], n1[4 * q + 3] - n2[4 * q + 3]};
        }
    }
    __syncthreads();
  }
}

__device__ __forceinline__ void rwkv_r2_unit(const Args& a, int unit, LAS unsigned char* lds) {
    const int tid = otid(), lane = tid & 63, wave = __builtin_amdgcn_readfirstlane(tid >> 6);
    unsigned char* ws = a.ws;
    LAS float* S = (LAS float*)lds;
    const int vb = wave >> 1, kb0 = 2 * (wave & 1), l15 = lane & 15, lq = lane >> 4;
    for (int i = tid; i < 64 * 68; i += 512) S[i] = 0.f;
    const float* MPb = (const float*)(ws + WS_MP) + (size_t)unit * 32 * 4096; const float* NPb = (const float*)(ws + WS_NP) + (size_t)unit * 32 * 4096;
    bf16_t* SSb = (bf16_t*)(ws + WS_SS) + (size_t)unit * 32 * 4096;
    float Bm[2][16]; f32x4 acc[2];
#pragma unroll
    for (int t2 = 0; t2 < 2; ++t2) {
#pragma unroll
        for (int ks = 0; ks < 16; ++ks) Bm[t2][ks] = MPb[(4 * ks + lq) * 64 + 16 * (kb0 + t2) + l15];
#pragma unroll
        for (int rg = 0; rg < 4; ++rg) acc[t2][rg] = NPb[(16 * vb + 4 * lq + rg) * 64 + 16 * (kb0 + t2) + l15]; }
    __syncthreads();
    for (int c = 0; c < 32; ++c) {
        { const int v = tid >> 3, sg = tid & 7; const LAS float* sp = S + v * 68 + 8 * sg; float x[8];
#pragma unroll
          for (int q = 0; q < 8; ++q) x[q] = sp[q];
          *(u32x4*)(SSb + (size_t)c * 4096 + v * 64 + 8 * sg) = pack8(x); }
#pragma unroll
        for (int ks = 0; ks < 16; ++ks) { const float av = S[(16 * vb + l15) * 68 + 4 * ks + lq];
            acc[0] = __builtin_amdgcn_mfma_f32_16x16x4f32(av, Bm[0][ks], acc[0], 0, 0, 0);
            acc[1] = __builtin_amdgcn_mfma_f32_16x16x4f32(av, Bm[1][ks], acc[1], 0, 0, 0); }
        __syncthreads();
#pragma unroll
        for (int t2 = 0; t2 < 2; ++t2)
#pragma unroll
            for (int rg = 0; rg < 4; ++rg) S[(16 * vb + 4 * lq + rg) * 68 + 16 * (kb0 + t2) + l15] = acc[t2][rg];
        if (c + 1 < 32) { const float* MPc = MPb + (size_t)(c + 1) * 4096; const float* NPc = NPb + (size_t)(c + 1) * 4096;
#pragma unroll
            for (int t2 = 0; t2 < 2; ++t2) {
#pragma unroll
                for (int ks = 0; ks < 16; ++ks) Bm[t2][ks] = MPc[(4 * ks + lq) * 64 + 16 * (kb0 + t2) + l15];
#pragma unroll
                for (int rg = 0; rg < 4; ++rg) acc[t2][rg] = NPc[(16 * vb + 4 * lq + rg) * 64 + 16 * (kb0 + t2) + l15]; } }
        __syncthreads();
    }
}

__device__ __forceinline__ void phase_rwkv_out(const Args& a, int l) {
    const int tid = otid(), lane = tid & 63, wave = tid >> 6, r32 = lane & 31, hi = lane >> 5;
    unsigned char* ws = a.ws;
    const bf16_t* SSg = (const bf16_t*)(ws + WS_SS); const bf16_t* QAg = (const bf16_t*)(ws + WS_QA); const float* Y0g = (const float*)(ws + WS_Y0);
    const float* RR = (const float*)(ws + WS_RR); const float* RV = (const float*)(ws + WS_RV); const float* RKD = (const float*)(ws + WS_RKD);
    const bf16_t* GG = (const bf16_t*)(ws + WS_GG); bf16_t* OB = (bf16_t*)(ws + WS_OB);
    const float* rk = a.in[I_RK] + (size_t)l * RW; const float* lng = a.in[I_LNG] + (size_t)l * RW; const float* lnb = a.in[I_LNB] + (size_t)l * RW;
    for (int wt = blockIdx.x * 8 + wave; wt < 6144; wt += gridDim.x * 8) {
        const int tq = wt & 63, bh = wt >> 6, h = bh % 12, b = bh / 12, c = tq >> 1, tn = tq & 1, tnb = 1 - tn;
        const size_t ctf = ((size_t)bh * 2 + 0) * 32 + c, ctb = ((size_t)bh * 2 + 1) * 32 + (31 - c);
        const size_t t = (size_t)b * NT + 64 * c + 32 * tn + r32;
        const int srcl = (lane & 32) + 31 - r32;
        float y[2][16];
#pragma unroll
        for (int tm = 0; tm < 2; ++tm) {
            f32x16 af, ab;
            const float* y0f = Y0g + ctf * 4096 + (tm * 2 + tn) * 1024 + lane; const float* y0b = Y0g + ctb * 4096 + (tm * 2 + tnb) * 1024 + lane;
#pragma unroll
            for (int rg = 0; rg < 16; ++rg) { af[rg] = y0f[rg * 64]; ab[rg] = y0b[rg * 64]; }
#pragma unroll
            for (int s4 = 0; s4 < 4; ++s4) {
                const bf16x8 xf = *(const bf16x8*)(SSg + ctf * 4096 + (32 * tm + r32) * 64 + 16 * s4 + 8 * hi);
                const bf16x8 yf = *(const bf16x8*)(QAg + ctf * 4096 + ((tn * 4 + s4) * 64 + lane) * 8);
                af = __builtin_amdgcn_mfma_f32_32x32x16_bf16(xf, yf, af, 0, 0, 0);
                const bf16x8 xb = *(const bf16x8*)(SSg + ctb * 4096 + (32 * tm + r32) * 64 + 16 * s4 + 8 * hi);
                const bf16x8 yb = *(const bf16x8*)(QAg + ctb * 4096 + ((tnb * 4 + s4) * 64 + lane) * 8);
                ab = __builtin_amdgcn_mfma_f32_32x32x16_bf16(xb, yb, ab, 0, 0, 0);
            }
#pragma unroll
            for (int rg = 0; rg < 16; ++rg) y[tm][rg] = af[rg] + __shfl(ab[rg], srcl);
        }
        float sm = 0.f;
#pragma unroll
        for (int tm = 0; tm < 2; ++tm)
#pragma unroll
            for (int rg = 0; rg < 16; ++rg) sm += y[tm][rg];
        sm += __shfl_xor(sm, 32);
        const float mean = sm * (1.f / 64.f);
        float sv = 0.f;
#pragma unroll
        for (int tm = 0; tm < 2; ++tm)
#pragma unroll
            for (int rg = 0; rg < 16; ++rg) { const float d = y[tm][rg] - mean; y[tm][rg] = d; sv += d * d; }
        sv += __shfl_xor(sv, 32);
        const float rstd = rsqrtf(sv * (1.f / 64.f) + 64e-5f);
        float s0 = 0.f, s1 = 0.f;
        { const size_t o = t * RW + h * 64 + 32 * hi;
#pragma unroll
          for (int q = 0; q < 8; ++q) { const f32x4 r4 = *(const f32x4*)(RR + o + 4 * q), k0 = *(const f32x4*)(RKD + o + 4 * q), k1 = *(const f32x4*)(RKD + (size_t)NTOK * RW + o + 4 * q), w4 = *(const f32x4*)(rk + h * 64 + 32 * hi + 4 * q);
              const f32x4 rw = r4 * w4;
              s0 += rw.x * k0.x + rw.y * k0.y + rw.z * k0.z + rw.w * k0.w; s1 += rw.x * k1.x + rw.y * k1.y + rw.z * k1.z + rw.w * k1.w; } }
        s0 += s1; s0 += __shfl_xor(s0, 32);
#pragma unroll
        for (int tm = 0; tm < 2; ++tm)
#pragma unroll
            for (int q = 0; q < 4; ++q) { const int cc = h * 64 + 32 * tm + 8 * q + 4 * hi;
                const f32x4 g4 = *(const f32x4*)(lng + cc), b4 = *(const f32x4*)(lnb + cc), v4 = *(const f32x4*)(RV + t * RW + cc);
                const u32x2 gg = *(const u32x2*)(GG + t * RW + cc);
                const float o0 = (y[tm][4 * q] * rstd * g4.x + b4.x + s0 * v4.x) * bflo(gg.x), o1 = (y[tm][4 * q + 1] * rstd * g4.y + b4.y + s0 * v4.y) * bfhi(gg.x);
                const float o2 = (y[tm][4 * q + 2] * rstd * g4.z + b4.z + s0 * v4.z) * bflo(gg.y), o3 = (y[tm][4 * q + 3] * rstd * g4.w + b4.w + s0 * v4.w) * bfhi(gg.y);
                u32x2 w; w.x = pk2(o0, o1); w.y = pk2(o2, o3);
                *(u32x2*)(OB + t * RW + cc) = w; }
    }
    const float* OAG = (const float*)(ws + WS_OAG); const float* LSE = (const float*)(ws + WS_LSE); bf16_t* OA = (bf16_t*)(ws + WS_OA);
    for (int task = blockIdx.x * 8 + wave; task < NTOK / 4; task += gridDim.x * 8) {
#pragma unroll
        for (int tk = 0; tk < 4; ++tk) { const size_t t = (size_t)task * 4 + tk; const int hh = lane >> 4;
            const float l0 = LSE[((size_t)0 * NTOK + t) * 4 + hh], l1 = LSE[((size_t)1 * NTOK + t) * 4 + hh], l2 = LSE[((size_t)2 * NTOK + t) * 4 + hh];
            const float mx = fmaxf(l0, fmaxf(l1, l2));
            const float w0 = __builtin_amdgcn_exp2f(l0 - mx), w1 = __builtin_amdgcn_exp2f(l1 - mx), w2 = __builtin_amdgcn_exp2f(l2 - mx);
            const float inv = 1.f / (w0 + w1 + w2);
            const f32x4 o0 = *(const f32x4*)(OAG + ((size_t)0 * NTOK + t) * 256 + lane * 4), o1 = *(const f32x4*)(OAG + ((size_t)1 * NTOK + t) * 256 + lane * 4), o2 = *(const f32x4*)(OAG + ((size_t)2 * NTOK + t) * 256 + lane * 4);
            const f32x4 r = (o0 * w0 + o1 * w1 + o2 * w2) * inv;
            u32x2 w; w.x = pk2(r.x, r.y); w.y = pk2(r.z, r.w);
            *(u32x2*)(OA + t * 256 + lane * 4) = w; }
    }
}

__device__ __forceinline__ void diffattn_unit(const Args& a, int l, int unit, LAS unsigned char* lds) {
    constexpr int RS = 272;
    const int b = unit / 96; const int rem = unit - b * 96; const int h = rem >> 4, qb = rem & 15;
    const int tid = otid(), lane = tid & 63, wave = __builtin_amdgcn_readfirstlane(tid >> 6), r32 = lane & 31, hi = lane >> 5;
    const int c = wave & 1, qblk = wave >> 1;
    const int q0 = qb * 128 + qblk * 32;
    const bf16_t* P = (const bf16_t*)(a.ws + WS_PROJ);
    const size_t rowb = (size_t)b * NT;
    bf16x8 qf[4];
    { const bf16_t* qp = P + (rowb + q0 + r32) * PLD + C_CQ + h * 128 + c * 64 + 8 * hi;
#pragma unroll
      for (int s4 = 0; s4 < 4; ++s4) qf[s4] = *(const bf16x8*)(qp + 16 * s4); }
    LAS float* biasL = (LAS float*)(lds + 69632);
    { const float* bC = (const float*)(a.ws + WS_MISC + MISC_BIASC) + h * 257;
      for (int i = tid; i < 257; i += 512) biasL[i] = bC[i]; }
    const int srow0 = tid >> 4, sch = tid & 15;
    const bf16_t* kg = P + (rowb + srow0) * PLD + C_CK + h * 128 + sch * 8;
    const bf16_t* vg = P + (rowb + srow0) * PLD + C_CV + h * 128 + sch * 8;
    u32x4 kr[2], vr[2];
#pragma unroll
    for (int i = 0; i < 2; ++i) { kr[i] = *(const u32x4*)(kg + (size_t)(32 * i) * PLD); vr[i] = *(const u32x4*)(vg + (size_t)(32 * i) * PLD); }
#pragma unroll
    for (int i = 0; i < 2; ++i) { *(LAS u32x4*)(lds + (srow0 + 32 * i) * RS + sch * 16) = kr[i]; *(LAS u32x4*)(lds + 34816 + (srow0 + 32 * i) * RS + sch * 16) = vr[i]; }
    __syncthreads();
    f32x16 o[4];
#pragma unroll
    for (int db = 0; db < 4; ++db) o[db] = (f32x16){};
    float m = -1e30f, lsum = 0.f;
    const float SC = 0.125f * LOG2E;
    const int trb = (4 * hi + ((lane & 15) >> 2)) * RS + (16 * ((lane >> 4) & 1) + 4 * (lane & 3)) * 2;
    const int qabs = q0 + r32;
    for (int t = 0; t < 32; ++t) {
        if (t + 1 < 32) {
#pragma unroll
            for (int i = 0; i < 2; ++i) { kr[i] = *(const u32x4*)(kg + (size_t)(64 * (t + 1) + 32 * i) * PLD); vr[i] = *(const u32x4*)(vg + (size_t)(64 * (t + 1) + 32 * i) * PLD); } }
        const LAS unsigned char* Kb = lds + (t & 1) * 17408;
        const LAS unsigned char* Vb = lds + 34816 + (t & 1) * 17408;
        f32x16 sa0 = (f32x16){}, sa1 = (f32x16){};
#pragma unroll
        for (int s4 = 0; s4 < 4; ++s4) {
            const bf16x8 kf0 = *(const LAS bf16x8*)(Kb + r32 * RS + c * 128 + 32 * s4 + 16 * hi);
            const bf16x8 kf1 = *(const LAS bf16x8*)(Kb + (32 + r32) * RS + c * 128 + 32 * s4 + 16 * hi);
            sa0 = __builtin_amdgcn_mfma_f32_32x32x16_bf16(kf0, qf[s4], sa0, 0, 0, 0);
            sa1 = __builtin_amdgcn_mfma_f32_32x32x16_bf16(kf1, qf[s4], sa1, 0, 0, 0);
        }
        float x0[16], x1[16];
        const int kv0 = 64 * t;
        const bool farp = (kv0 >= q0 + 31 + 128), farn = (kv0 + 63 + 128 <= q0);
        if (farp || farn) { const float cb = farp ? biasL[256] : biasL[0];
#pragma unroll
            for (int rg = 0; rg < 16; ++rg) { x0[rg] = sa0[rg] * SC + cb; x1[rg] = sa1[rg] * SC + cb; }
        } else {
#pragma unroll
            for (int rg = 0; rg < 16; ++rg) { int rel = kv0 + crow(rg, hi) - qabs; int rc = rel < -128 ? -128 : (rel > 128 ? 128 : rel);
                x0[rg] = sa0[rg] * SC + biasL[rc + 128];
                rel += 32; rc = rel < -128 ? -128 : (rel > 128 ? 128 : rel);
                x1[rg] = sa1[rg] * SC + biasL[rc + 128]; }
        }
        float mx = fmaxf(x0[0], x1[0]);
#pragma unroll
        for (int rg = 1; rg < 16; ++rg) mx = fmaxf(mx, fmaxf(x0[rg], x1[rg]));
        mx = fmaxf(mx, __shfl_xor(mx, 32));
        const float mn = fmaxf(m, mx), alpha = __builtin_amdgcn_exp2f(m - mn); m = mn;
        float ps = 0.f;
#pragma unroll
        for (int rg = 0; rg < 16; ++rg) { x0[rg] = __builtin_amdgcn_exp2f(x0[rg] - mn); x1[rg] = __builtin_amdgcn_exp2f(x1[rg] - mn); ps += x0[rg] + x1[rg]; }
        lsum = lsum * alpha + ps;
#pragma unroll
        for (int db = 0; db < 4; ++db)
#pragma unroll
            for (int rg = 0; rg < 16; ++rg) o[db][rg] *= alpha;
        u32x4 pw[4];
#pragma unroll
        for (int s2 = 0; s2 < 2; ++s2) {
            pw[s2].x = pk2(x0[8 * s2 + 0], x0[8 * s2 + 1]); pw[s2].y = pk2(x0[8 * s2 + 2], x0[8 * s2 + 3]); pw[s2].z = pk2(x0[8 * s2 + 4], x0[8 * s2 + 5]); pw[s2].w = pk2(x0[8 * s2 + 6], x0[8 * s2 + 7]);
            pw[2 + s2].x = pk2(x1[8 * s2 + 0], x1[8 * s2 + 1]); pw[2 + s2].y = pk2(x1[8 * s2 + 2], x1[8 * s2 + 3]); pw[2 + s2].z = pk2(x1[8 * s2 + 4], x1[8 * s2 + 5]); pw[2 + s2].w = pk2(x1[8 * s2 + 6], x1[8 * s2 + 7]); }
#pragma unroll
        for (int db = 0; db < 4; ++db)
#pragma unroll
            for (int s = 0; s < 4; ++s) {
                const s16x4 lo = vtr(Vb + trb + (16 * s) * RS + db * 64);
                const s16x4 hi4 = vtr(Vb + trb + (16 * s + 8) * RS + db * 64);
                const bf16x8 af = (bf16x8){lo[0], lo[1], lo[2], lo[3], hi4[0], hi4[1], hi4[2], hi4[3]};
                o[db] = __builtin_amdgcn_mfma_f32_32x32x16_bf16(af, __builtin_bit_cast(bf16x8, pw[s]), o[db], 0, 0, 0);
            }
        if (t + 1 < 32) { LAS unsigned char* Kn = lds + ((t + 1) & 1) * 17408; LAS unsigned char* Vn = lds + 34816 + ((t + 1) & 1) * 17408;
#pragma unroll
            for (int i = 0; i < 2; ++i) { *(LAS u32x4*)(Kn + (srow0 + 32 * i) * RS + sch * 16) = kr[i]; *(LAS u32x4*)(Vn + (srow0 + 32 * i) * RS + sch * 16) = vr[i]; } }
        __syncthreads();
    }
    const float lt = lsum + __shfl_xor(lsum, 32);
    const float inv = 1.f / lt;
    const float* lamp = (const float*)(a.ws + WS_MISC + MISC_LAM);
    const float lam = lamp[l], linit = lamp[2 + l];
    LAS float* XO = (LAS float*)lds;
    if (c == 1) {
        const float f = inv * lam;
#pragma unroll
        for (int db = 0; db < 4; ++db)
#pragma unroll
            for (int rg = 0; rg < 16; ++rg) XO[(qblk * 64 + db * 16 + rg) * 64 + lane] = o[db][rg] * f;
    }
    __syncthreads();
    if (c == 0) {
        float ss = 0.f;
#pragma unroll
        for (int db = 0; db < 4; ++db)
#pragma unroll
            for (int rg = 0; rg < 16; ++rg) { const float v = o[db][rg] * inv - XO[(qblk * 64 + db * 16 + rg) * 64 + lane]; o[db][rg] = v; ss += v * v; }
        ss += __shfl_xor(ss, 32);
        const float sc = rsqrtf(ss * (1.f / 128.f) + 1e-5f) * (1.f - linit);
        const float* sg = a.in[I_SUBG] + (size_t)l * 128;
        bf16_t* op = (bf16_t*)(a.ws + WS_OC) + (rowb + q0 + r32) * 768 + h * 128;
#pragma unroll
        for (int db = 0; db < 4; ++db)
#pragma unroll
            for (int i = 0; i < 4; ++i) { const int d = db * 32 + 8 * i + 4 * hi; const f32x4 g4 = *(const f32x4*)(sg + d);
                u32x2 w; w.x = pk2(o[db][4 * i] * sc * g4.x, o[db][4 * i + 1] * sc * g4.y); w.y = pk2(o[db][4 * i + 2] * sc * g4.z, o[db][4 * i + 3] * sc * g4.w);
                *(u32x2*)(op + d) = w; }
    }
    __syncthreads();
}

__device__ __forceinline__ void phase_post(const Args& a, int l) {
    const int tid = otid(), lane = tid & 63, wave = tid >> 6;
    unsigned char* ws = a.ws;
    const float* OAG = (const float*)(ws + WS_OAG); const float* LSE = (const float*)(ws + WS_LSE);
    bf16_t* OA = (bf16_t*)(ws + WS_OA); bf16_t* OB = (bf16_t*)(ws + WS_OB);
    const float* GS = (const float*)(ws + WS_GS); const float* Y = (const float*)(ws + WS_Y);
    const float* RR = (const float*)(ws + WS_RR); const float* RV = (const float*)(ws + WS_RV); const float* RKD = (const float*)(ws + WS_RKD);
    const float* gup = a.in[I_GUP] + (size_t)l * 128 * RW;
    const float* rk = a.in[I_RK] + (size_t)l * RW; const float* lng = a.in[I_LNG] + (size_t)l * RW; const float* lnb = a.in[I_LNB] + (size_t)l * RW;
    for (int task = blockIdx.x * 8 + wave; task < NTOK / 4; task += gridDim.x * 8) {
        const int t0 = task * 4;
#pragma unroll
        for (int tk = 0; tk < 4; ++tk) { const size_t t = t0 + tk; const int hh = lane >> 4;
            const float l0 = LSE[((size_t)0 * NTOK + t) * 4 + hh], l1 = LSE[((size_t)1 * NTOK + t) * 4 + hh], l2 = LSE[((size_t)2 * NTOK + t) * 4 + hh];
            const float mx = fmaxf(l0, fmaxf(l1, l2));
            const float w0 = __builtin_amdgcn_exp2f(l0 - mx), w1 = __builtin_amdgcn_exp2f(l1 - mx), w2 = __builtin_amdgcn_exp2f(l2 - mx);
            const float inv = 1.f / (w0 + w1 + w2);
            const f32x4 o0 = *(const f32x4*)(OAG + ((size_t)0 * NTOK + t) * 256 + lane * 4), o1 = *(const f32x4*)(OAG + ((size_t)1 * NTOK + t) * 256 + lane * 4), o2 = *(const f32x4*)(OAG + ((size_t)2 * NTOK + t) * 256 + lane * 4);
            const f32x4 r = (o0 * w0 + o1 * w1 + o2 * w2) * inv;
            u32x2 w; w.x = pk2(r.x, r.y); w.y = pk2(r.z, r.w);
            *(u32x2*)(OA + t * 256 + lane * 4) = w; }
        float gsr[4][2];
#pragma unroll
        for (int tk = 0; tk < 4; ++tk) { gsr[tk][0] = GS[(size_t)(t0 + tk) * 128 + lane]; gsr[tk][1] = GS[(size_t)(t0 + tk) * 128 + 64 + lane]; }
        float gacc[12][4];
#pragma unroll
        for (int i = 0; i < 12; ++i)
#pragma unroll
            for (int tk = 0; tk < 4; ++tk) gacc[i][tk] = 0.f;
#pragma unroll
        for (int jh = 0; jh < 2; ++jh)
            for (int j = 0; j < 64; ++j) {
                float gv[4];
#pragma unroll
                for (int tk = 0; tk < 4; ++tk) gv[tk] = __builtin_bit_cast(float, __builtin_amdgcn_readlane(__builtin_bit_cast(int, gsr[tk][jh]), j));
                const float* gp = gup + (size_t)(jh * 64 + j) * RW + lane;
#pragma unroll
                for (int i = 0; i < 12; ++i) { const float gu = gp[i * 64];
#pragma unroll
                    for (int tk = 0; tk < 4; ++tk) gacc[i][tk] += gv[tk] * gu; }
            }
#pragma unroll
        for (int tk = 0; tk < 4; ++tk) { const size_t t = t0 + tk;
#pragma unroll
            for (int i = 0; i < 12; ++i) { const int c = i * 64 + lane;
                const float y = Y[t * RW + c] + Y[((size_t)NTOK + t) * RW + c];
                const float mean = wave_sum(y) * (1.f / 64.f);
                const float dv = y - mean;
                const float var = wave_sum(dv * dv) * (1.f / 64.f);
                const float yn = dv * rsqrtf(var + 64e-5f) * lng[c] + lnb[c];
                const float r = RR[t * RW + c], v = RV[t * RW + c], rkc = rk[c];
                const float s0 = wave_sum(r * RKD[t * RW + c] * rkc), s1 = wave_sum(r * RKD[((size_t)NTOK + t) * RW + c] * rkc);
                const float outv = (yn + (s0 + s1) * v) * gacc[i][tk];
                OB[t * RW + c] = (bf16_t)(pk2(outv, 0.f) & 0xffffu); } }
    }
}

__device__ __forceinline__ void phase_route(const Args& a, int l, LAS unsigned char* lds, bool commit = true) {
    const int tid = otid(), lane = tid & 63, wave = __builtin_amdgcn_readfirstlane(tid >> 6), r32 = lane & 31, hi = lane >> 5;
    unsigned char* ws = a.ws;
    LAS float* hb = (LAS float*)lds;
    LAS float* lg = (LAS float*)(lds + 131200);
    const float* X = (const float*)(ws + WS_X);
    const float* mod = (const float*)(ws + WS_MISC + MISC_MOD) + (size_t)l * 8 * 6144;
    bf16_t* H = (bf16_t*)(ws + WS_H);
    unsigned* cnt = (unsigned*)(ws + WS_CTL) + CW_CNT + l * 32;
    int* LIST = (int*)(ws + WS_LIST); unsigned* TOKE = (unsigned*)(ws + WS_TOKE); float* TOKP = (float*)(ws + WS_TOKP);
    const float* g2 = a.in[I_N2G] + (size_t)l * DM; const float* rb = a.in[I_RB] + (size_t)l * NE;
    float Bw[64];
    { const float* rw = a.in[I_RW] + (size_t)l * DM * NE + (size_t)(128 * wave + hi) * NE + r32;
#pragma unroll
      for (int s2 = 0; s2 < 64; ++s2) Bw[s2] = rw[(size_t)(2 * s2) * NE]; }
    for (int tb = blockIdx.x; tb < NTOK / 64; tb += gridDim.x) {
        for (int rnd = 0; rnd < 2; ++rnd) {
            const int tbase = tb * 64 + rnd * 32;
            const float* mb = mod + (size_t)(tbase >> 11) * 6144;
#pragma unroll 1
            for (int q = 0; q < 4; ++q) {
                const int tl = 4 * wave + q; const size_t t = (size_t)tbase + tl;
                f32x4 v[4];
#pragma unroll
                for (int j = 0; j < 4; ++j) v[j] = *(const f32x4*)(X + t * DM + 4 * lane + 256 * j);
                const float rstd = row_rstd(v, 1e-6f);
#pragma unroll
                for (int j = 0; j < 4; ++j) { const int c = 4 * lane + 256 * j;
                    const f32x4 gv = *(const f32x4*)(g2 + c), scv = *(const f32x4*)(mb + 4096 + c), shv = *(const f32x4*)(mb + 3072 + c);
                    const f32x4 hv = v[j] * rstd * gv * (scv + 1.0f) + shv;
                    u32x2 w; w.x = pk2(hv.x, hv.y); w.y = pk2(hv.z, hv.w);
                    *(u32x2*)(H + t * DM + c) = w;
                    LAS float* hp = hb + tl * 1025 + c; hp[0] = hv.x; hp[1] = hv.y; hp[2] = hv.z; hp[3] = hv.w; }
            }
            __syncthreads();
            f32x16 d = (f32x16){};
            { const LAS float* ap = hb + r32 * 1025 + 128 * wave + hi;
#pragma unroll
              for (int s2 = 0; s2 < 64; ++s2) d = __builtin_amdgcn_mfma_f32_32x32x2f32(ap[2 * s2], Bw[s2], d, 0, 0, 0); }
            __syncthreads();
#pragma unroll
            for (int rg = 0; rg < 16; ++rg) hb[(wave * 16 + rg) * 64 + lane] = d[rg];
            __syncthreads();
#pragma unroll
            for (int j = 0; j < 2; ++j) { const int idx = tid + 512 * j, rg = idx >> 6, ln = idx & 63; float sm = 0.f;
#pragma unroll
                for (int w8 = 0; w8 < 8; ++w8) sm += hb[(w8 * 16 + rg) * 64 + ln];
                lg[crow(rg, ln >> 5) * 33 + (ln & 31)] = sm + rb[ln & 31]; }
            __syncthreads();
#pragma unroll 1
            for (int q = 0; q < 4; ++q) {
                const int tl = 4 * wave + q; const int t = tbase + tl;
                const int myidx = lane & 31;
                float cur = lg[tl * 33 + myidx];
                float tv[4]; int ti4[4];
#pragma unroll
                for (int k = 0; k < 4; ++k) { float bv = cur; int bi = myidx;
#pragma unroll
                    for (int off = 16; off >= 1; off >>= 1) { const float ov = __shfl_xor(bv, off); const int oi = __shfl_xor(bi, off);
                        const bool take = (ov > bv) || (ov == bv && oi < bi); bv = take ? ov : bv; bi = take ? oi : bi; }
                    tv[k] = bv; ti4[k] = bi; if (myidx == bi) cur = -INFINITY; }
                const float e1 = expf(tv[1] - tv[0]), e2 = expf(tv[2] - tv[0]), e3 = expf(tv[3] - tv[0]);
                const float inv = 1.f / (1.f + e1 + e2 + e3);
                if (lane < 4) { const int e = lane == 0 ? ti4[0] : lane == 1 ? ti4[1] : lane == 2 ? ti4[2] : ti4[3];
                    const float pr = (lane == 0 ? 1.f : lane == 1 ? e1 : lane == 2 ? e2 : e3) * inv;
                    const unsigned pos = commit ? __hip_atomic_fetch_add(cnt + e, 1u, __ATOMIC_RELAXED, __HIP_MEMORY_SCOPE_AGENT) : (unsigned)(t & 0xffff);
                    if (commit) LIST[(size_t)e * NTOK + pos] = t;
                    TOKE[(size_t)t * 4 + lane] = ((unsigned)e << 16) | pos; TOKP[(size_t)t * 4 + lane] = pr; }
            }
            __syncthreads();
        }
    }
}

__device__ __forceinline__ void build_moe_tab(const Args& a, int l, volatile LAS int* tab) {
    const unsigned* cnt = (const unsigned*)(a.ws + WS_CTL) + CW_CNT + l * 32;
    const int tid = otid();
    __syncthreads();
    if (tid < 32) tab[64 + tid] = (int)__hip_atomic_load(cnt + tid, __ATOMIC_RELAXED, __HIP_MEMORY_SCOPE_AGENT);
    __syncthreads();
    if (tid == 0) { int s = 0; for (int e = 0; e < 32; ++e) { tab[e] = s; s += (tab[64 + e] + 255) >> 8; } tab[32] = s; }
    __syncthreads();
}

__device__ __forceinline__ void phase_combine(const Args& a, int l, const LAS int* tab, bool dry = false) {
    const int tid = otid(), lane = tid & 63, wave = tid >> 6;
    unsigned char* ws = a.ws;
    float* X = (float*)(ws + WS_X);
    const bf16_t* YM = (const bf16_t*)(ws + WS_YMOE);
    const unsigned* TOKE = (const unsigned*)(ws + WS_TOKE); const float* TOKP = (const float*)(ws + WS_TOKP);
    const float* modl = (const float*)(ws + WS_MISC + MISC_MOD) + (size_t)l * 8 * 6144;
    for (int t = blockIdx.x * 8 + wave; t < NTOK; t += gridDim.x * 8) {
        f32x4 v[4], acc[4];
#pragma unroll
        for (int j = 0; j < 4; ++j) { v[j] = *(const f32x4*)(X + (size_t)t * DM + 4 * lane + 256 * j); acc[j] = (f32x4){0.f, 0.f, 0.f, 0.f}; }
#pragma unroll
        for (int k = 0; k < 4; ++k) { const unsigned ep = TOKE[(size_t)t * 4 + k]; const float pr = TOKP[(size_t)t * 4 + k];
            const int e = ep >> 16, pos = ep & 0xffff; const size_t srow = (size_t)tab[e] * 256 + pos;
#pragma unroll
            for (int j = 0; j < 4; ++j) { const u32x2 y = *(const u32x2*)(YM + srow * DM + 4 * lane + 256 * j);
                acc[j].x += pr * bflo(y.x); acc[j].y += pr * bfhi(y.x); acc[j].z += pr * bflo(y.y); acc[j].w += pr * bfhi(y.y); } }
        const float* mb = modl + (size_t)(t >> 11) * 6144;
#pragma unroll
        for (int j = 0; j < 4; ++j) { const f32x4 gt = *(const f32x4*)(mb + 5120 + 4 * lane + 256 * j); v[j] = v[j] + gt * acc[j]; }
        const float rstd = row_rstd(v, 1e-6f);
        float* Xo = dry ? (float*)(ws + WS_QA) : X; bf16_t* Ho = dry ? (bf16_t*)(ws + WS_QA + (size_t)NTOK * DM * 4) : (bf16_t*)(ws + WS_H); float* Oo = dry ? (float*)(ws + WS_QA) : a.out;
        if (l + 1 < DEPTH) {
#pragma unroll
            for (int j = 0; j < 4; ++j) *(f32x4*)(Xo + (size_t)t * DM + 4 * lane + 256 * j) = v[j];
            const float* mn = modl + (size_t)8 * 6144 + (size_t)(t >> 11) * 6144;
            norm_mod_store(v, rstd, a.in[I_N1G] + (size_t)(l + 1) * DM, mn + 1024, mn, Ho + (size_t)t * DM, lane);
        } else {
#pragma unroll
            for (int j = 0; j < 4; ++j) { const int c = 4 * lane + 256 * j; const f32x4 g = *(const f32x4*)(a.in[I_FNG] + c);
                *(f32x4*)(Oo + (size_t)t * DM + c) = v[j] * rstd * g; }
        }
    }
}

constexpr int NPL = 9;
constexpr int N_PHASES = 2 + NPL * DEPTH;
__global__ void __launch_bounds__(512, 2) fwd(Args a) {
    extern __shared__ __attribute__((aligned(16))) unsigned char smem[];
    LAS unsigned char* lds = (LAS unsigned char*)smem;
    const int tid = threadIdx.x;
    unsigned* ctl = (unsigned*)(a.ws + WS_CTL);
    volatile LAS unsigned* xbw = (volatile LAS unsigned*)(lds + LDS_CTL_OFF);
    volatile LAS int* tab = (volatile LAS int*)(lds + LDS_CTL_OFF + 256);
    volatile LAS int* qw = (volatile LAS int*)(lds + LDS_CTL_OFF + 1024);
    if (tid < 4) xbw[tid] = 0u;
    __syncthreads();
    const int lo = a.ph_lo, hi = a.ph_hi;
    XcdBarrier bar; bar.bar = ctl + CW_BAR; bar.x = 0; bar.st = xbw;
    if (hi - lo > 1) bar = xcd_barrier_post(ctl + CW_BAR, xbw);
#ifndef DUPMASK
#define DUPMASK 0
#endif
#define NREP(k) (((DUPMASK >> PHSEL(k)) & 1) ? 2 : 1)
#ifndef BRMASK
#define BRMASK 7
#endif
#ifndef PHMASK
#define PHMASK 0xFFFFF
#endif
#define PHSEL(k) ((k) < 2 ? (k) : 2 + ((k) - 2) % NPL)
#define IN(k) (((PHMASK >> PHSEL(k)) & 1) && lo <= (k) && (k) < hi)
#define SEAM(k) do { if (IN(k) && IN((k) + 1)) { xcd_barrier(bar); } } while (0)
    unsigned char* ws = a.ws;
    if (IN(0)) { for (int rep = 0; rep < NREP(0); ++rep) { phase_p0(a, lds); __syncthreads(); } SEAM(0); }
    if (IN(1)) { phase_norm1(a, 0); SEAM(1); }
    for (int l = 0; l < DEPTH; ++l) {
        const int pb = 2 + NPL * l;
        if (IN(pb + 0)) {
          for (int rep = 0; rep < NREP(pb + 0); ++rep) {
            pg8::StaticOrder S; S.init(NTOK, PLD, gridDim.x, blockIdx.x);
            pg8::EpiProj E{(bf16_t*)(ws + WS_PROJ), PLD, 29};
            pg8::gemm_phase<pg8::EpiProj, pg8::StaticOrder>(lds, (const bf16_t*)(ws + WS_H), (const bf16_t*)(ws + WS_WIN) + (size_t)l * PLD * DM, DM, 0, S, E);
          }
            SEAM(pb + 0);
        }
        if (IN(pb + 1)) { for (int rep = 0; rep < NREP(pb + 1) + ((DUPMASK >> 17) & 1); ++rep) { phase_rwkv_r1(a, l, lds); } for (int rep = 0; rep < NREP(pb + 1) + ((DUPMASK >> 16) & 1); ++rep) phase_swa(a, lds); SEAM(pb + 1); }
        if (IN(pb + 2)) {
          for (int rep = 0; rep < NREP(pb + 2); ++rep) {
            {
                pg8::StaticOrder S; S.init(NTOK, RW, gridDim.x, blockIdx.x);
                pg8::EpiProj E{(bf16_t*)(ws + WS_GG), RW, 1 << 30};
                pg8::gemm_phase<pg8::EpiProj, pg8::StaticOrder>(lds, (const bf16_t*)(ws + WS_GS), (const bf16_t*)(ws + WS_MISC + MISC_GUPT) + (size_t)l * RW * 256, 256, 0, S, E);
            }
            for (int u = blockIdx.x; u < 192; u += gridDim.x) rwkv_r2_unit(a, u, lds);
            for (;;) {
                if (tid == 0) *qw = (int)__hip_atomic_fetch_add(ctl + CW_QH + 64 * (2 * l + rep), 1u, __ATOMIC_RELAXED, __HIP_MEMORY_SCOPE_AGENT);
                __syncthreads();
                const int item = *qw;
                __syncthreads();
                if (item >= 768) break;
                diffattn_unit(a, l, item, lds);
            }
          }
            SEAM(pb + 2);
        }
        if (IN(pb + 3)) { for (int rep = 0; rep < NREP(pb + 3); ++rep) phase_rwkv_out(a, l); SEAM(pb + 3); }
        if (IN(pb + 4)) {
          for (int rep = 0; rep < NREP(pb + 4); ++rep) {
            pg8::StaticOrder S; S.init(NTOK, DM, gridDim.x, blockIdx.x);
            const bf16_t* P = (const bf16_t*)(ws + WS_PROJ); float* MF = (float*)(ws + WS_MF); bf16_t* MG = (bf16_t*)(ws + WS_MERGED);
            if (BRMASK & 1) { pg8::EpiBranch<0> E{P, MF, MG}; pg8::gemm_phase<pg8::EpiBranch<0>, pg8::StaticOrder>(lds, (const bf16_t*)(ws + WS_OA), (const bf16_t*)(ws + WS_WA) + (size_t)l * DM * 256, 256, 0, S, E); }
            if (BRMASK & 2) { pg8::EpiBranch<1> E{P, MF, MG}; pg8::gemm_phase<pg8::EpiBranch<1>, pg8::StaticOrder>(lds, (const bf16_t*)(ws + WS_OB), (const bf16_t*)(ws + WS_WB) + (size_t)l * DM * 768, 768, 0, S, E); }
            if (BRMASK & 4) { pg8::EpiBranch<2> E{P, MF, MG}; pg8::gemm_phase<pg8::EpiBranch<2>, pg8::StaticOrder>(lds, (const bf16_t*)(ws + WS_OC), (const bf16_t*)(ws + WS_WC) + (size_t)l * DM * 768, 768, 0, S, E); }
          }
            SEAM(pb + 4);
        }
        if (IN(pb + 5)) {
            pg8::StaticOrder S; S.init(NTOK, DM, gridDim.x, blockIdx.x);
            pg8::EpiOut E{l == 0 ? a.in[I_X] : (const float*)(ws + WS_X), (float*)(ws + WS_X), (const float*)(ws + WS_MISC + MISC_MOD) + (size_t)l * 8 * 6144 + 2048};
            pg8::gemm_phase<pg8::EpiOut, pg8::StaticOrder>(lds, (const bf16_t*)(ws + WS_MERGED), (const bf16_t*)(ws + WS_WO) + (size_t)l * DM * DM, DM, 0, S, E);
            SEAM(pb + 5);
        }
        if (IN(pb + 6)) { for (int rep = 0; rep < NREP(pb + 6); ++rep) phase_route(a, l, lds, rep == NREP(pb + 6) - 1); SEAM(pb + 6); }
        if (IN(pb + 7)) {
          for (int rep = 0; rep < NREP(pb + 7); ++rep) {
            build_moe_tab(a, l, tab);
            unsigned* rtc = ctl + CW_RT + (l * 2 + rep) * 2048;
            {
                pg8::MoeOrder<true> S{(const LAS int*)tab, (const int*)(ws + WS_LIST), 8, (int)gridDim.x, (int)blockIdx.x, rtc};
                pg8::EpiMoe1 E{(bf16_t*)(ws + WS_ACT), a.in[I_B1] + (size_t)l * NE * 2 * FF};
                pg8::gemm_phase<pg8::EpiMoe1, pg8::MoeOrder<true>>(lds, (const bf16_t*)(ws + WS_H), (const bf16_t*)(ws + WS_W1) + (size_t)l * NE * 2 * FF * DM, DM, (size_t)2 * FF * DM * 2, S, E);
            }
            {
                pg8::MoeOrder<false> S{(const LAS int*)tab, nullptr, 4, (int)gridDim.x, (int)(gridDim.x - 1 - blockIdx.x), rtc};
                pg8::EpiMoe2 E{(bf16_t*)(ws + WS_YMOE), a.in[I_B2] + (size_t)l * NE * DM};
                pg8::gemm_phase<pg8::EpiMoe2, pg8::MoeOrder<false>>(lds, (const bf16_t*)(ws + WS_ACT), (const bf16_t*)(ws + WS_W2) + (size_t)l * NE * DM * FF, FF, (size_t)DM * FF * 2, S, E);
            }
          }
            SEAM(pb + 7);
        }
        if (IN(pb + 8)) { build_moe_tab(a, l, tab); for (int rep = 0; rep < NREP(pb + 8); ++rep) phase_combine(a, l, (const LAS int*)tab, rep != NREP(pb + 8) - 1); SEAM(pb + 8); }
    }
#undef IN
#undef SEAM
}

#ifndef MK_ONE_LAUNCH
#define MK_ONE_LAUNCH 1
#endif
extern "C" void kernel_launch(void* const* d_in, const int* in_sizes, int n_in, void* d_out, int out_size, void* d_ws, size_t ws_size, hipStream_t stream) {
    static int grid = 0;
    if (grid == 0) {
        if (n_in != 32 || ws_size < WS_END) { fprintf(stderr, "kernel_launch: unexpected n_in %d or ws %zu < %zu\n", n_in, ws_size, (size_t)WS_END); grid = -1; return; }
        int dev = 0, cus = 0;
        if (hipGetDevice(&dev) != hipSuccess || hipDeviceGetAttribute(&cus, hipDeviceAttributeMultiprocessorCount, dev) != hipSuccess) { grid = -1; return; }
        if (hipFuncSetAttribute((const void*)fwd, hipFuncAttributeMaxDynamicSharedMemorySize, LDS_BYTES) != hipSuccess) { fprintf(stderr, "kernel_launch: hipFuncSetAttribute failed\n"); grid = -1; return; }
        int per_cu = 0;
        if (hipOccupancyMaxActiveBlocksPerMultiprocessor(&per_cu, (const void*)fwd, 512, LDS_BYTES) != hipSuccess || per_cu < 1) fprintf(stderr, "kernel_launch: occupancy query says %d\n", per_cu);
        (void)hipGetLastError();
        grid = cus;
    }
    if (grid < 0) return;
    (void)hipMemsetAsync((char*)d_ws + WS_CTL, 0, CTL_BYTES, stream);
    Args a{};
    for (int i = 0; i < 32; ++i) a.in[i] = (const float*)d_in[i];
    a.out = (float*)d_out; a.ws = (unsigned char*)d_ws;
#if MK_ONE_LAUNCH
    a.ph_lo = 0; a.ph_hi = N_PHASES;
    hipLaunchKernelGGL(fwd, dim3(grid), dim3(512), LDS_BYTES, stream, a);
#else
    for (int p = 0; p < N_PHASES; ++p) { a.ph_lo = p; a.ph_hi = p + 1; hipLaunchKernelGGL(fwd, dim3(grid), dim3(512), LDS_BYTES, stream, a); }
#endif
}
```

```cpp
#include <hip/hip_runtime.h>
#include <stdint.h>
#include <stdio.h>

#define LAS __attribute__((address_space(3)))
typedef unsigned short bf16_t;
typedef short bf16x8 __attribute__((ext_vector_type(8)));
typedef short s16x4 __attribute__((ext_vector_type(4)));
typedef float f32x2 __attribute__((ext_vector_type(2)));
typedef float f32x4 __attribute__((ext_vector_type(4)));
typedef float f32x16 __attribute__((ext_vector_type(16)));
typedef unsigned u32x2 __attribute__((ext_vector_type(2)));
typedef unsigned u32x4 __attribute__((ext_vector_type(4)));
typedef __bf16 bf16x2_t __attribute__((ext_vector_type(2)));
typedef short v4i16_t __attribute__((ext_vector_type(4)));

constexpr int NB = 8, NT = 2048, DM = 1024, NTOK = NB * NT, DEPTH = 2;
constexpr int IN_COLS = 10368, PLD = 10496;
constexpr int C_AQ = 0, C_AK = 768, C_AV = 1536, C_BS = 2304, C_CQ = 5120, C_CK = 5888, C_CV = 6656, C_G = 7424;
constexpr int RSTR = 2688, RW = 768, NE = 32, FF = 1024;
constexpr float LOG2E = 1.4426950408889634f;

constexpr size_t al256(size_t x) { return (x + 255) & ~(size_t)255; }
constexpr size_t WS_CTL = 0;
constexpr size_t CTL_BYTES = 65536;
constexpr size_t WS_MISC = WS_CTL + CTL_BYTES;
constexpr size_t MISC_MOD = 0, MISC_LAM = 393216, MISC_BIASA = 393472, MISC_BIASC = 399872, MISC_WUPT = 409600, MISC_AUPT = 409600 + 393216, MISC_GUPT = 409600 + 2 * 393216, MISC_BYTES = 2 << 20;
constexpr size_t WS_WIN = WS_MISC + MISC_BYTES;
constexpr size_t WS_WA = WS_WIN + (size_t)DEPTH * PLD * DM * 2;
constexpr size_t WS_WB = WS_WA + (size_t)DEPTH * DM * 256 * 2;
constexpr size_t WS_WC = WS_WB + (size_t)DEPTH * DM * 768 * 2;
constexpr size_t WS_WO = WS_WC + (size_t)DEPTH * DM * 768 * 2;
constexpr size_t WS_W1 = WS_WO + (size_t)DEPTH * DM * DM * 2;
constexpr size_t WS_W2 = WS_W1 + (size_t)DEPTH * NE * 2 * FF * DM * 2;
constexpr size_t WS_H = WS_W2 + (size_t)DEPTH * NE * DM * FF * 2;
constexpr size_t WS_X = WS_H + (size_t)NTOK * DM * 2;
constexpr size_t WS_OA = WS_X + (size_t)NTOK * DM * 4;
constexpr size_t WS_OB = WS_OA + (size_t)NTOK * 256 * 2;
constexpr size_t WS_OC = WS_OB + (size_t)NTOK * 768 * 2;
constexpr size_t WS_MERGED = WS_OC + (size_t)NTOK * 768 * 2;
constexpr size_t WS_LIST = WS_MERGED + (size_t)NTOK * DM * 2;
constexpr size_t WS_TOKE = WS_LIST + (size_t)NE * NTOK * 4;
constexpr size_t WS_TOKP = WS_TOKE + (size_t)NTOK * 4 * 4;
constexpr size_t WS_U = WS_TOKP + (size_t)NTOK * 4 * 4;
constexpr size_t WS_PROJ = WS_U;
constexpr size_t WS_RR = WS_PROJ + (size_t)NTOK * PLD * 2;
constexpr size_t WS_RV = WS_RR + (size_t)NTOK * RW * 4;
constexpr size_t WS_RWD = WS_RV + (size_t)NTOK * RW * 4;
constexpr size_t WS_RKK = WS_RWD + (size_t)2 * NTOK * RW * 4;
constexpr size_t WS_RKKA = WS_RKK + (size_t)2 * NTOK * RW * 4;
constexpr size_t WS_RKD = WS_RKKA + (size_t)2 * NTOK * RW * 4;
constexpr size_t WS_GS = WS_RKD + (size_t)2 * NTOK * RW * 4;
constexpr size_t WS_Y = WS_GS + (size_t)NTOK * 128 * 4;
constexpr size_t WS_OAG = WS_Y + (size_t)2 * NTOK * RW * 4;
constexpr size_t WS_LSE = WS_OAG + (size_t)3 * NTOK * 256 * 4;
constexpr size_t WS_MF = WS_LSE + (size_t)3 * NTOK * 4 * 4;
constexpr size_t WS_QA = WS_MF + (size_t)NTOK * DM * 4;
constexpr size_t WS_SS = WS_QA + (size_t)6144 * 4096 * 2;
constexpr size_t WS_END1 = WS_SS + (size_t)6144 * 4096 * 2;
constexpr size_t WS_GG = WS_Y;
constexpr size_t WS_MP = WS_RWD, WS_NP = WS_RKK, WS_Y0 = WS_RKKA;
constexpr int SLOT_ROWS = 4 * NTOK + NE * 256;
constexpr size_t WS_ACT = WS_U;
constexpr size_t WS_YMOE = WS_ACT + (size_t)SLOT_ROWS * FF * 2;
constexpr size_t WS_END2 = WS_YMOE + (size_t)SLOT_ROWS * DM * 2;
constexpr size_t WS_END = WS_END1 > WS_END2 ? WS_END1 : WS_END2;

constexpr int CW_BAR = 0;
constexpr int CW_CNT = 13312;
constexpr int CW_QH = 4224;
constexpr int CW_RT = 5120;

constexpr int LDS_STAGE = 155648;
constexpr int LDS_CTL_OFF = LDS_STAGE;
constexpr int LDS_BYTES = LDS_STAGE + 4096;

__device__ __forceinline__ int otid() { int t = threadIdx.x; asm volatile("" : "+v"(t)); return t; }
__device__ __forceinline__ int obid() { int t = blockIdx.x; asm volatile("" : "+s"(t)); return t; }
__device__ __forceinline__ unsigned pk2(float lo, float hi) { f32x2 v = {lo, hi}; bf16x2_t b = __builtin_convertvector(v, bf16x2_t); return __builtin_bit_cast(unsigned, b); }
__device__ __forceinline__ u32x4 pack8(const float (&x)[8]) { u32x4 w; w.x = pk2(x[0], x[1]); w.y = pk2(x[2], x[3]); w.z = pk2(x[4], x[5]); w.w = pk2(x[6], x[7]); return w; }
__device__ __forceinline__ bf16_t f2bf(float x) { return (bf16_t)(pk2(x, 0.f) & 0xffffu); }
__device__ __forceinline__ float bflo(unsigned u) { return __builtin_bit_cast(float, u << 16); }
__device__ __forceinline__ float bfhi(unsigned u) { return __builtin_bit_cast(float, u & 0xffff0000u); }
__device__ __forceinline__ float bf2f(bf16_t h) { return __builtin_bit_cast(float, (unsigned)h << 16); }
__device__ __forceinline__ float wave_sum(float v) {
#pragma unroll
    for (int o = 1; o < 64; o <<= 1) v += __shfl_xor(v, o);
    return v;
}
__device__ __forceinline__ float sigmoidf_(float x) { return 1.f / (1.f + __expf(-x)); }
__device__ __forceinline__ int crow(int r, int hi) { return (r & 3) + 8 * (r >> 2) + 4 * hi; }
__device__ __forceinline__ s16x4 vtr(const LAS unsigned char* p) { return __builtin_bit_cast(s16x4, __builtin_amdgcn_ds_read_tr16_b64_v4i16((LAS v4i16_t*)p)); }
__device__ __forceinline__ float dpp_sum8(float x) {
    int v = __builtin_bit_cast(int, x);
    x += __builtin_bit_cast(float, __builtin_amdgcn_update_dpp(0, v, 0xB1, 0xF, 0xF, true));
    v = __builtin_bit_cast(int, x);
    x += __builtin_bit_cast(float, __builtin_amdgcn_update_dpp(0, v, 0x4E, 0xF, 0xF, true));
    v = __builtin_bit_cast(int, x);
    x += __builtin_bit_cast(float, __builtin_amdgcn_update_dpp(0, v, 0x141, 0xF, 0xF, true));
    return x;
}

#define XB_TMO      128
#define XB_XCNT(j)  (256  + 64 * (j))
#define XB_XSUB(j)  (1280 + 64 * (j))
#define XB_XGEN(j)  (2304 + 64 * (j))
#define XB_TOP      3328
#define XB_TOPGEN   3392
#define XCD_BAR_WORDS 3456
#define XB_SPIN_CAP (1u << 18)
__device__ __forceinline__ unsigned xb_ld(unsigned* p)              { return __hip_atomic_load(p, __ATOMIC_RELAXED, __HIP_MEMORY_SCOPE_AGENT); }
__device__ __forceinline__ unsigned xb_add(unsigned* p, unsigned v) { return __hip_atomic_fetch_add(p, v, __ATOMIC_RELAXED, __HIP_MEMORY_SCOPE_AGENT); }
__device__ __forceinline__ unsigned xb_xcc_id() { return (unsigned)__builtin_amdgcn_s_getreg((3 << 11) | 20) & 0xFu; }
#define XB_SPIN(cond, bar) do { unsigned _sp = 0; while (cond) { __builtin_amdgcn_s_sleep(1); \
    if ((++_sp & 255u) == 0u) { if (xb_ld(&(bar)[XB_TMO])) break; if (_sp > XB_SPIN_CAP) { atomicAdd(&(bar)[XB_TMO], 1u); break; } } } } while (0)
struct XcdBarrier { unsigned* bar; unsigned x; volatile LAS unsigned* st; };
__device__ __forceinline__ XcdBarrier xcd_barrier_post(unsigned* bar, volatile LAS unsigned* st) {
    XcdBarrier b; b.bar = bar; b.x = xb_xcc_id(); b.st = st;
    if (threadIdx.x == 0) (void)xb_add(&bar[XB_XCNT(b.x)], 1u);
    return b;
}
__device__ __forceinline__ void xcd_barrier_complete(unsigned* bar, unsigned x, unsigned& nloc, unsigned& nx) {
    const unsigned G = gridDim.x * gridDim.y * gridDim.z;
    unsigned sum, cnt, mine, sp = 0u;
    for (;;) {
        sum = 0u; cnt = 0u; mine = 0u;
#pragma unroll
        for (unsigned j = 0; j < 16; ++j) { const unsigned c = xb_ld(&bar[XB_XCNT(j)]); sum += c; cnt += (c > 0u) ? 1u : 0u; mine = (j == x) ? c : mine; }
        if (sum == G) break;
        __builtin_amdgcn_s_sleep(1);
        if ((++sp & 255u) == 0u) { if (xb_ld(&bar[XB_TMO])) break; if (sp > XB_SPIN_CAP) { atomicAdd(&bar[XB_TMO], 1u); break; } }
    }
    nloc = mine > 0u ? mine : 1u; nx = cnt > 0u ? cnt : 1u;
}
__device__ __forceinline__ void xcd_barrier(const XcdBarrier& b) {
    asm volatile("s_waitcnt vmcnt(0)" ::: "memory");
    __syncthreads();
    if (threadIdx.x == 0) {
        unsigned* bar = b.bar;
        __builtin_amdgcn_s_waitcnt(0);
        unsigned nloc = b.st[0], nx = b.st[1];
        if (nloc == 0u) { xcd_barrier_complete(bar, b.x, nloc, nx); b.st[0] = nloc; b.st[1] = nx; }
        const unsigned old = xb_add(&bar[XB_XSUB(b.x)], 1u);
        const unsigned gen = old / nloc;
        if (old + 1u == (gen + 1u) * nloc) {
            __builtin_amdgcn_fence(__ATOMIC_RELEASE, "agent");
            asm volatile("s_waitcnt vmcnt(0)" ::: "memory");
            const unsigned og = xb_add(&bar[XB_TOP], 1u);
            const unsigned tg = og / nx;
            if (og + 1u == (tg + 1u) * nx) xb_add(&bar[XB_TOPGEN], 1u);
            else XB_SPIN(xb_ld(&bar[XB_TOPGEN]) == tg, bar);
            __builtin_amdgcn_fence(__ATOMIC_ACQUIRE, "agent");
            xb_add(&bar[XB_XGEN(b.x)], 1u);
            asm volatile("s_waitcnt vmcnt(0)" ::: "memory");
        } else {
            XB_SPIN(xb_ld(&bar[XB_XGEN(b.x)]) == gen, bar);
            __builtin_amdgcn_fence(__ATOMIC_ACQUIRE, "agent");
            asm volatile("s_waitcnt vmcnt(0)" ::: "memory");
        }
    }
    __syncthreads();
}

namespace pg8 {
constexpr int BM = 256, BK = 64, HALF = 128, HTB = HALF * BK * 2, STAGE_BYTES = 8 * HTB, NXCD = 8, WGM = 8;
__device__ __forceinline__ int lds_byte(int r, int c) { const int st = (r >> 4) * 2 + (c >> 5), rr = r & 15, cc = c & 31, ob = rr * 64 + cc * 2; return st * 1024 + (ob ^ (((ob >> 9) & 1) << 5)); }
__device__ __forceinline__ void stage_rc(int b, int& R, int& C) { const int st = b / 1024, sb = b % 1024, swz = sb ^ (((sb >> 9) & 1) << 5); R = (st >> 1) * 16 + swz / 64; C = (st & 1) * 32 + (swz % 64) / 2; }
__device__ __forceinline__ int perm32(int rho) { const int n = rho >> 4, i = rho & 15; return 8 * (i >> 2) + 4 * n + (i & 3); }

struct Unit { int pm, pn, e, lt; };

struct StaticOrder {
    static constexpr bool GATHER = false;
    int nM, nN, nwg, G, c;
    __device__ void init(int M, int N, int G_, int c_) { nM = M / BM; nN = N / BM; nwg = nM * nN; G = G_; c = c_; }
    __device__ __forceinline__ bool next(int i, Unit& u) const {
        const long L = (long)i * G + c; if (L >= nwg) return false;
        int wgid = (int)L; { const int q = nwg / NXCD, r = nwg % NXCD, xcd = wgid % NXCD, off = wgid / NXCD; wgid = (xcd < r ? xcd * (q + 1) : r * (q + 1) + (xcd - r) * q) + off; }
        const int nig = WGM * nN, gid = wgid / nig, fm = gid * WGM, gsz = (nM - fm) < WGM ? (nM - fm) : WGM;
        u.pm = fm + ((wgid % nig) % gsz); u.pn = (wgid % nig) / gsz; u.e = 0; u.lt = 0; return true;
    }
    __device__ __forceinline__ int arow(const Unit& u, int r) const { return u.pm * BM + r; }
    __device__ __forceinline__ void a_ready(const Unit&) const {}
    __device__ __forceinline__ void done(const Unit&) const {}
};
template <bool GATHER_> struct MoeOrder {
    static constexpr bool GATHER = GATHER_;
    const LAS int* tab;
    const int* list;
    int ncol, G, c;
    __device__ __forceinline__ bool next(int i, Unit& u) const {
        if (true) {
            const int L = i * G + c; const int total = tab[32] * ncol; if (L >= total) return false;
            const int rt = L / ncol; u.pn = L - rt * ncol; u.pm = rt;
            int e = 0;
#pragma unroll 1
            for (int j = 1; j < 32; ++j) e = (tab[j] <= rt) ? j : e;
            u.e = e; u.lt = rt - tab[e]; return true;
        }
        const int x = c & 7, W = G >> 3; int q = i * W + (c >> 3);
#pragma unroll 1
        for (int k = 0; k < 4; ++k) { const int e = x + 8 * k; const int nt_e = tab[e + 1] - tab[e], sz = nt_e * ncol;
            if (q < sz) { const int lt = q / ncol; u.pn = q - lt * ncol; u.lt = lt; u.e = e; u.pm = tab[e] + lt; return true; }
            q -= sz; }
        return false;
    }
    __device__ __forceinline__ int arow(const Unit& u, int r) const {
        if (!GATHER_) return u.pm * BM + r;
        const int pos = u.lt * BM + r; const int cnt = tab[64 + u.e];
        return pos < cnt ? list[(size_t)u.e * NTOK + pos] : 0;
    }
    unsigned* rtc;
    __device__ __forceinline__ void done(const Unit& u) const {
        if (GATHER_) { asm volatile("s_waitcnt vmcnt(0)" ::: "memory");
            if ((threadIdx.x & 63) == 0) __hip_atomic_fetch_add(rtc + 16 * u.pm, 1u, __ATOMIC_RELAXED, __HIP_MEMORY_SCOPE_AGENT); }
    }
    __device__ __forceinline__ void a_ready(const Unit& u) const {
        if (!GATHER_) {
            if (threadIdx.x < 64) {
                unsigned sp = 0;
                while ((unsigned)__builtin_amdgcn_readfirstlane(__hip_atomic_load(rtc + 16 * u.pm, __ATOMIC_RELAXED, __HIP_MEMORY_SCOPE_AGENT)) < 64u) {
                    __builtin_amdgcn_s_sleep(2); if (++sp > (1u << 22)) break; }
                __builtin_amdgcn_fence(__ATOMIC_ACQUIRE, "agent");
                asm volatile("s_waitcnt vmcnt(0)" ::: "memory");
            }
            asm volatile("" ::: "memory"); __builtin_amdgcn_s_barrier(); asm volatile("" ::: "memory");
        }
    }
};

template <class Epi, class Sched>
__device__ __forceinline__ void gemm_phase(LAS unsigned char* lds, const bf16_t* A, const bf16_t* Bt, const int K, const size_t b_estride_bytes, const Sched& S, const Epi& E) {
    constexpr bool GATHER = Sched::GATHER;
    const int tid = otid(), wid = __builtin_amdgcn_readfirstlane(tid >> 6), lane = tid & 63, wr = wid >> 2, wc = wid & 3, fr = lane & 15, fq = lane >> 4;
    const int nt = K / BK;
    int Rr[2], Cc[2]; unsigned voffA[2], voffB[2];
#pragma unroll
    for (int i = 0; i < 2; ++i) { int R, C; stage_rc(tid * 16 + i * 8192, R, C); const int Rb = Epi::PERM ? ((R & ~31) + perm32(R & 31)) : R;
        Rr[i] = R; Cc[i] = C; voffA[i] = (unsigned)(R * K + C) * 2u; voffB[i] = (unsigned)(Rb * K + C) * 2u; }
    const size_t kstep = (size_t)(BK * 2);
    const size_t hstep = (size_t)HALF * K * 2;
    const size_t tstep = 2 * hstep;
    const unsigned ldsw = (unsigned)wid * 1024u;
    const int aoff = lds_byte(wr * 64 + fr, fq * 8), boff = lds_byte(wc * 32 + fr, fq * 8);
#define PG8_SA(b, h) (((b) * 2 + (h)) * HTB)
#define PG8_SB(b, h) ((4 + (b) * 2 + (h)) * HTB)
#define PG8_STAGE(bufoff, gbase, voff) do { _Pragma("unroll") for (int _i = 0; _i < 2; ++_i) \
        __builtin_amdgcn_global_load_lds((const unsigned*)((const char*)(gbase) + (voff)[_i]), (LAS unsigned*)(lds + (bufoff) + ldsw + _i * 8192), 16, 0, 0); } while (0)
#define PG8_STAGEA(bufoff, uptr, offs, h, kb) do { _Pragma("unroll") for (int _i = 0; _i < 2; ++_i) { const char* _src; \
        if constexpr (GATHER) _src = (const char*)A + (size_t)(offs)[h][_i] + (size_t)(kb); else _src = (uptr) + (size_t)(h) * hstep + (size_t)(kb) + voffA[_i]; \
        __builtin_amdgcn_global_load_lds((const unsigned*)_src, (LAS unsigned*)(lds + (bufoff) + ldsw + _i * 8192), 16, 0, 0); } } while (0)
#define PG8_LDA(dst, b, h) do { _Pragma("unroll") for (int m = 0; m < 4; ++m) _Pragma("unroll") for (int k = 0; k < 2; ++k) dst[m][k] = *(const LAS bf16x8*)(lds + PG8_SA(b, h) + aoff + m * 2048 + k * 1024); } while (0)
#define PG8_LDB(dst, b, h) do { _Pragma("unroll") for (int n = 0; n < 2; ++n) _Pragma("unroll") for (int k = 0; k < 2; ++k) dst[n][k] = *(const LAS bf16x8*)(lds + PG8_SB(b, h) + boff + n * 2048 + k * 1024); } while (0)
#define PG8_MMA(ai, bj, At, Bt_) do { __builtin_amdgcn_s_setprio(1); _Pragma("unroll") for (int m = 0; m < 4; ++m) _Pragma("unroll") for (int n = 0; n < 2; ++n) _Pragma("unroll") for (int k = 0; k < 2; ++k) \
        acc[ai][bj][m][n] = __builtin_amdgcn_mfma_f32_16x16x32_bf16(Bt_[n][k], At[m][k], acc[ai][bj][m][n], 0, 0, 0); __builtin_amdgcn_s_setprio(0); } while (0)
#define PG8_WAIT_V(n) asm volatile("s_waitcnt vmcnt(" #n ")" ::: "memory")
#define PG8_WAIT_L(n) asm volatile("s_waitcnt lgkmcnt(" #n ")" ::: "memory")
#define PG8_BAR __builtin_amdgcn_s_barrier()
#define PG8_SCHED __builtin_amdgcn_sched_barrier(0)
#define PG8_AOFFS(dst, u) do { if constexpr (GATHER) { _Pragma("unroll") for (int _h = 0; _h < 2; ++_h) _Pragma("unroll") for (int _i = 0; _i < 2; ++_i) \
        dst[_h][_i] = ((unsigned)S.arow(u, _h * HALF + Rr[_i]) * (unsigned)K + (unsigned)Cc[_i]) * 2u; } } while (0)
    Unit cur, nxt; int ui = 0;
    if (!S.next(0, cur)) return;
    f32x4 acc[2][2][4][2];
#pragma unroll
    for (int a = 0; a < 2; ++a)
#pragma unroll
        for (int b = 0; b < 2; ++b)
#pragma unroll
            for (int m = 0; m < 4; ++m)
#pragma unroll
                for (int n = 0; n < 2; ++n) acc[a][b][m][n] = (f32x4){0.f, 0.f, 0.f, 0.f};
    bf16x8 At[4][2], B0[2][2], B1[2][2];
    unsigned aoc[2][2] = {{0u, 0u}, {0u, 0u}}, aon[2][2] = {{0u, 0u}, {0u, 0u}};
    PG8_AOFFS(aoc, cur);
    const char* cA = (const char*)A + (size_t)cur.pm * tstep;
    const char* cB = (const char*)Bt + (size_t)cur.e * b_estride_bytes + (size_t)cur.pn * tstep;
    S.a_ready(cur);
    PG8_STAGE(PG8_SB(0, 0), cB, voffB); PG8_STAGEA(PG8_SA(0, 0), cA, aoc, 0, 0); PG8_STAGE(PG8_SB(0, 1), cB + hstep, voffB); PG8_STAGEA(PG8_SA(0, 1), cA, aoc, 1, 0);
    if (wr == 1) PG8_BAR;
    PG8_WAIT_V(4); PG8_BAR;
    PG8_STAGE(PG8_SB(1, 0), cB + kstep, voffB); PG8_STAGEA(PG8_SA(1, 0), cA, aoc, 0, kstep); PG8_STAGE(PG8_SB(1, 1), cB + hstep + kstep, voffB);
    PG8_WAIT_V(6); PG8_BAR;
    for (;;) {
        const bool has_next = S.next(ui + 1, nxt);
        const char* nA = has_next ? (const char*)A + (size_t)nxt.pm * tstep : cA;
        const char* nB = has_next ? (const char*)Bt + (size_t)nxt.e * b_estride_bytes + (size_t)nxt.pn * tstep : cB;
        if constexpr (GATHER) {
            if (has_next) { PG8_AOFFS(aon, nxt); } else {
#pragma unroll
                for (int h = 0; h < 2; ++h)
#pragma unroll
                    for (int i = 0; i < 2; ++i) aon[h][i] = aoc[h][i]; } }
#pragma unroll 1
        for (int t = 0; t < nt; t += 2) {
            const bool last = (t == nt - 2);
            const size_t k1 = (size_t)(t + 1) * kstep;
            const size_t k2 = last ? (size_t)0 : (size_t)(t + 2) * kstep;
            const size_t k3 = k2 + kstep;
            const char* a2p = last ? nA : cA;
            unsigned a2o[2][2];
#pragma unroll
            for (int h = 0; h < 2; ++h)
#pragma unroll
                for (int i = 0; i < 2; ++i) a2o[h][i] = last ? aon[h][i] : aoc[h][i];
            const char* b2 = last ? nB : cB + (size_t)(t + 2) * kstep; const char* b3 = b2 + kstep;
            if (last && has_next) S.a_ready(nxt);
            PG8_LDB(B0, 0, 0); PG8_SCHED; PG8_LDA(At, 0, 0); PG8_STAGEA(PG8_SA(1, 1), cA, aoc, 1, k1);
            PG8_WAIT_L(8); PG8_BAR; PG8_WAIT_L(0); PG8_MMA(0, 0, At, B0); PG8_BAR; PG8_SCHED;
            PG8_LDB(B1, 0, 1); PG8_STAGE(PG8_SB(0, 0), b2, voffB);
            PG8_BAR; PG8_WAIT_L(0); PG8_MMA(0, 1, At, B1); PG8_BAR;
            PG8_LDA(At, 0, 1); PG8_STAGEA(PG8_SA(0, 0), a2p, a2o, 0, k2);
            PG8_BAR; PG8_WAIT_L(0); PG8_MMA(1, 0, At, B0); PG8_BAR; PG8_SCHED;
            PG8_STAGE(PG8_SB(0, 1), b2 + hstep, voffB);
            PG8_WAIT_V(6); PG8_BAR; PG8_MMA(1, 1, At, B1); PG8_BAR;
            PG8_LDB(B0, 1, 0); PG8_SCHED; PG8_LDA(At, 1, 0); PG8_STAGEA(PG8_SA(0, 1), a2p, a2o, 1, k2);
            PG8_WAIT_L(8); PG8_BAR; PG8_WAIT_L(0); PG8_MMA(0, 0, At, B0); PG8_BAR; PG8_SCHED;
            PG8_LDB(B1, 1, 1); PG8_STAGE(PG8_SB(1, 0), b3, voffB);
            PG8_BAR; PG8_WAIT_L(0); PG8_MMA(0, 1, At, B1); PG8_BAR;
            PG8_LDA(At, 1, 1); PG8_STAGEA(PG8_SA(1, 0), a2p, a2o, 0, k3);
            PG8_BAR; PG8_WAIT_L(0); PG8_MMA(1, 0, At, B0); PG8_BAR; PG8_SCHED;
            PG8_STAGE(PG8_SB(1, 1), b3 + hstep, voffB);
            PG8_WAIT_V(6); PG8_BAR; PG8_MMA(1, 1, At, B1); PG8_BAR;
        }
        E(acc, cur, wr, wc, fr, fq); S.done(cur);
        if (!has_next) break;
#pragma unroll
        for (int a = 0; a < 2; ++a)
#pragma unroll
            for (int b = 0; b < 2; ++b)
#pragma unroll
                for (int m = 0; m < 4; ++m)
#pragma unroll
                    for (int n = 0; n < 2; ++n) acc[a][b][m][n] = (f32x4){0.f, 0.f, 0.f, 0.f};
        cur = nxt; cA = nA; cB = nB; ++ui;
#pragma unroll
        for (int h = 0; h < 2; ++h)
#pragma unroll
            for (int i = 0; i < 2; ++i) aoc[h][i] = aon[h][i];
    }
    PG8_WAIT_V(0);
    if (wr == 0) PG8_BAR;
    PG8_BAR;
#undef PG8_SA
#undef PG8_SB
#undef PG8_STAGE
#undef PG8_STAGEA
#undef PG8_LDA
#undef PG8_LDB
#undef PG8_MMA
#undef PG8_WAIT_V
#undef PG8_WAIT_L
#undef PG8_BAR
#undef PG8_SCHED
#undef PG8_AOFFS
}

typedef f32x4 Acc[2][2][4][2];

struct EpiProj {
    static constexpr bool PERM = true;
    bf16_t* O; int ld; int sg_from;
    __device__ __forceinline__ void operator()(const Acc& acc, const Unit& u, int wr, int wc, int fr, int fq) const {
        const int row0 = u.pm * BM + wr * 64 + fr, col0 = u.pn * BM + wc * 32 + 8 * fq; const bool sg = u.pn >= sg_from;
#pragma unroll
        for (int ai = 0; ai < 2; ++ai)
#pragma unroll
            for (int m = 0; m < 4; ++m) { bf16_t* rowp = O + (size_t)(row0 + ai * HALF + m * 16) * ld + col0;
#pragma unroll
                for (int bj = 0; bj < 2; ++bj) { f32x4 v0 = acc[ai][bj][m][0], v1 = acc[ai][bj][m][1];
                    if (sg) {
#pragma unroll
                        for (int j = 0; j < 4; ++j) { v0[j] = sigmoidf_(v0[j]); v1[j] = sigmoidf_(v1[j]); } }
                    u32x4 w; w.x = pk2(v0[0], v0[1]); w.y = pk2(v0[2], v0[3]); w.z = pk2(v1[0], v1[1]); w.w = pk2(v1[2], v1[3]);
                    *(u32x4*)(rowp + bj * HALF) = w; } }
    }
};
template <int SEG> struct EpiBranch {
    static constexpr bool PERM = true;
    const bf16_t* P; float* MF; bf16_t* MG;
    __device__ __forceinline__ void operator()(const Acc& acc, const Unit& u, int wr, int wc, int fr, int fq) const {
        const int row0 = u.pm * BM + wr * 64 + fr, col0 = u.pn * BM + wc * 32 + 8 * fq;
#pragma unroll
        for (int ai = 0; ai < 2; ++ai)
#pragma unroll
            for (int m = 0; m < 4; ++m) { const size_t r = (size_t)(row0 + ai * HALF + m * 16);
                asm volatile("" ::: "memory");
#pragma unroll
                for (int bj = 0; bj < 2; ++bj) { const int c = col0 + bj * HALF;
                    const u32x4 g = *(const u32x4*)(P + r * PLD + C_G + SEG * 1024 + c);
                    f32x4 v0 = acc[ai][bj][m][0], v1 = acc[ai][bj][m][1];
                    v0[0] *= bflo(g.x); v0[1] *= bfhi(g.x); v0[2] *= bflo(g.y); v0[3] *= bfhi(g.y);
                    v1[0] *= bflo(g.z); v1[1] *= bfhi(g.z); v1[2] *= bflo(g.w); v1[3] *= bfhi(g.w);
                    float* mp = MF + r * DM + c;
                    if (SEG > 0) { v0 += *(const f32x4*)mp; v1 += *(const f32x4*)(mp + 4); }
                    if (SEG < 2) { *(f32x4*)mp = v0; *(f32x4*)(mp + 4) = v1; }
                    else { u32x4 w; w.x = pk2(v0[0], v0[1]); w.y = pk2(v0[2], v0[3]); w.z = pk2(v1[0], v1[1]); w.w = pk2(v1[2], v1[3]); *(u32x4*)(MG + r * DM + c) = w; } } }
    }
};
struct EpiOut {
    static constexpr bool PERM = false;
    const float* xsrc; float* X; const float* gt;
    __device__ __forceinline__ void operator()(const Acc& acc, const Unit& u, int wr, int wc, int fr, int fq) const {
        const int row0 = u.pm * BM + wr * 64 + fr, col0 = u.pn * BM + wc * 32 + 4 * fq;
        const float* gp = gt + (size_t)((u.pm * BM) >> 11) * 6144 + col0;
        f32x4 gv[2][2];
#pragma unroll
        for (int bj = 0; bj < 2; ++bj)
#pragma unroll
            for (int n = 0; n < 2; ++n) gv[bj][n] = *(const f32x4*)(gp + bj * HALF + n * 16);
#pragma unroll
        for (int ai = 0; ai < 2; ++ai)
#pragma unroll
            for (int m = 0; m < 4; ++m) { const size_t o = (size_t)(row0 + ai * HALF + m * 16) * DM + col0;
#pragma unroll
                for (int bj = 0; bj < 2; ++bj)
#pragma unroll
                    for (int n = 0; n < 2; ++n) { const f32x4 xv = *(const f32x4*)(xsrc + o + bj * HALF + n * 16);
                        *(f32x4*)(X + o + bj * HALF + n * 16) = xv + gv[bj][n] * acc[ai][bj][m][n]; } }
    }
};
struct EpiMoe1 {
    static constexpr bool PERM = true;
    bf16_t* ACT; const float* b1;
    __device__ __forceinline__ void operator()(const Acc& acc, const Unit& u, int wr, int wc, int fr, int fq) const {
        const int row0 = u.pm * BM + wr * 64 + fr, col0 = u.pn * BM + wc * 32 + 8 * fq;
        const float* bp = b1 + (size_t)u.e * (2 * FF) + col0;
        f32x4 bv[2][2];
#pragma unroll
        for (int bj = 0; bj < 2; ++bj)
#pragma unroll
            for (int n = 0; n < 2; ++n) bv[bj][n] = *(const f32x4*)(bp + bj * HALF + 4 * n);
#pragma unroll
        for (int ai = 0; ai < 2; ++ai)
#pragma unroll
            for (int m = 0; m < 4; ++m) { bf16_t* rowp = ACT + (size_t)(row0 + ai * HALF + m * 16) * FF + (col0 >> 1);
#pragma unroll
                for (int bj = 0; bj < 2; ++bj) { const f32x4 v0 = acc[ai][bj][m][0] + bv[bj][0], v1 = acc[ai][bj][m][1] + bv[bj][1];
                    float a[4];
#pragma unroll
                    for (int q = 0; q < 4; ++q) { const float gl = (q < 2) ? v0[2 * q] : v1[2 * q - 4], ln = (q < 2) ? v0[2 * q + 1] : v1[2 * q - 3];
                        const float xg = fminf(gl, 7.0f), xl = fminf(fmaxf(ln, -7.0f), 7.0f);
                        a[q] = xg * sigmoidf_(1.702f * xg) * (xl + 1.0f); }
                    const unsigned long long w = (unsigned long long)pk2(a[0], a[1]) | ((unsigned long long)pk2(a[2], a[3]) << 32);
                    __hip_atomic_store((unsigned long long*)(rowp + bj * (HALF / 2)), w, __ATOMIC_RELAXED, __HIP_MEMORY_SCOPE_AGENT); } }
    }
};
struct EpiMoe2 {
    static constexpr bool PERM = true;
    bf16_t* Y; const float* b2;
    __device__ __forceinline__ void operator()(const Acc& acc, const Unit& u, int wr, int wc, int fr, int fq) const {
        const int row0 = u.pm * BM + wr * 64 + fr, col0 = u.pn * BM + wc * 32 + 8 * fq;
        const float* bp = b2 + (size_t)u.e * DM + col0;
        f32x4 bv[2][2];
#pragma unroll
        for (int bj = 0; bj < 2; ++bj)
#pragma unroll
            for (int n = 0; n < 2; ++n) bv[bj][n] = *(const f32x4*)(bp + bj * HALF + 4 * n);
#pragma unroll
        for (int ai = 0; ai < 2; ++ai)
#pragma unroll
            for (int m = 0; m < 4; ++m) { bf16_t* rowp = Y + (size_t)(row0 + ai * HALF + m * 16) * DM + col0;
#pragma unroll
                for (int bj = 0; bj < 2; ++bj) { const f32x4 v0 = acc[ai][bj][m][0] + bv[bj][0], v1 = acc[ai][bj][m][1] + bv[bj][1];
                    u32x4 w; w.x = pk2(v0[0], v0[1]); w.y = pk2(v0[2], v0[3]); w.z = pk2(v1[0], v1[1]); w.w = pk2(v1[2], v1[3]);
                    *(u32x4*)(rowp + bj * HALF) = w; } }
    }
};
}

struct Args { const float* in[32]; float* out; unsigned char* ws; int ph_lo, ph_hi; };
enum { I_X = 0, I_C, I_WMOD, I_BMOD, I_N1G, I_N2G, I_WIN, I_MU, I_W0, I_WUP, I_A0, I_AUP, I_GUP, I_KK, I_KA, I_RK, I_LNG, I_LNB, I_DLAM, I_SUBG, I_RELB, I_WBA, I_WBB, I_WBC, I_WOUT, I_RW, I_RB, I_W1, I_B1, I_W2, I_B2, I_FNG };

__device__ __forceinline__ void lds_fence() { asm volatile("s_waitcnt lgkmcnt(0)" ::: "memory"); }

__device__ __forceinline__ void tr_item(const float* W, int ldw, int ncols, bf16_t* WT, int K, LAS float* scr, int item, int lane) {
    const int nblk = ncols >> 5, kb = item / nblk, nb = item - kb * nblk, k0 = 64 * kb, n0 = 32 * nb;
#pragma unroll 8
    for (int i = 0; i < 32; ++i) { const int kk = 2 * i + (lane >> 5); scr[kk * 33 + (lane & 31)] = W[(size_t)(k0 + kk) * ldw + n0 + (lane & 31)]; }
    lds_fence();
    const int c = lane & 7;
#pragma unroll
    for (int j = 0; j < 4; ++j) { const int n = (lane >> 3) + 8 * j; const LAS float* s = scr + (8 * c) * 33 + n;
        u32x4 o; o.x = pk2(s[0 * 33], s[1 * 33]); o.y = pk2(s[2 * 33], s[3 * 33]); o.z = pk2(s[4 * 33], s[5 * 33]); o.w = pk2(s[6 * 33], s[7 * 33]);
        *(u32x4*)(WT + (size_t)(n0 + n) * K + k0 + 8 * c) = o; }
    lds_fence();
}
__device__ __forceinline__ int t5_bucket(int rel) {
    const int ret = rel > 0 ? 16 : 0; const int n = rel < 0 ? -rel : rel;
    int v;
    if (n < 8) v = n; else if (n < 12) v = 8; else if (n < 16) v = 9; else if (n < 23) v = 10; else if (n < 32) v = 11;
    else if (n < 46) v = 12; else if (n < 64) v = 13; else if (n < 91) v = 14; else v = 15;
    return ret + v;
}
__device__ __forceinline__ void phase_p0(const Args& a, LAS unsigned char* lds) {
    const int tid = otid(), lane = tid & 63, wave = tid >> 6, G = gridDim.x;
    unsigned char* ws = a.ws;
    {
        LAS float* scr = (LAS float*)(lds + wave * 8448);
        const int gw = blockIdx.x * 8 + wave, NGW = G * 8;
        constexpr int NITEMS = 65536 + 32768 + 2 * 6592;
        for (int it = gw; it < NITEMS; it += NGW) {
            int r = it;
            if (r < 65536) { const int mat = r >> 10; tr_item(a.in[I_W1] + (size_t)mat * DM * 2 * FF, 2 * FF, 2 * FF, (bf16_t*)(ws + WS_W1) + (size_t)mat * 2 * FF * DM, DM, scr, r & 1023, lane); continue; }
            r -= 65536;
            if (r < 32768) { const int mat = r >> 9; tr_item(a.in[I_W2] + (size_t)mat * FF * DM, DM, DM, (bf16_t*)(ws + WS_W2) + (size_t)mat * DM * FF, FF, scr, r & 511, lane); continue; }
            r -= 32768;
            const int l = r / 6592; r -= l * 6592;
            if (r < 2496) { tr_item(a.in[I_WIN] + (size_t)l * DM * IN_COLS, IN_COLS, 4992, (bf16_t*)(ws + WS_WIN) + (size_t)l * PLD * DM, DM, scr, r, lane); continue; }
            r -= 2496;
            if (r < 2688) { tr_item(a.in[I_WIN] + (size_t)l * DM * IN_COLS + 4992, IN_COLS, 5376, (bf16_t*)(ws + WS_WIN) + (size_t)l * PLD * DM + (size_t)5120 * DM, DM, scr, r, lane); continue; }
            r -= 2688;
            if (r < 128) { tr_item(a.in[I_WBA] + (size_t)l * 256 * DM, DM, DM, (bf16_t*)(ws + WS_WA) + (size_t)l * DM * 256, 256, scr, r, lane); continue; }
            r -= 128;
            if (r < 384) { tr_item(a.in[I_WBB] + (size_t)l * 768 * DM, DM, DM, (bf16_t*)(ws + WS_WB) + (size_t)l * DM * 768, 768, scr, r, lane); continue; }
            r -= 384;
            if (r < 384) { tr_item(a.in[I_WBC] + (size_t)l * 768 * DM, DM, DM, (bf16_t*)(ws + WS_WC) + (size_t)l * DM * 768, 768, scr, r, lane); continue; }
            r -= 384;
            tr_item(a.in[I_WOUT] + (size_t)l * DM * DM, DM, DM, (bf16_t*)(ws + WS_WO) + (size_t)l * DM * DM, DM, scr, r, lane);
        }
        for (int i = blockIdx.x * 512 + tid; i < 2 * 128 * DM / 8; i += G * 512) {
            const int l = i / (128 * DM / 8), o = i - l * (128 * DM / 8);
            *(u32x4*)((bf16_t*)(ws + WS_WIN) + (size_t)l * PLD * DM + (size_t)4992 * DM + (size_t)o * 8) = (u32x4){0u, 0u, 0u, 0u};
        }
    }
    {
        bf16_t* WT = (bf16_t*)(ws + WS_MISC + MISC_WUPT); bf16_t* AT = (bf16_t*)(ws + WS_MISC + MISC_AUPT);
        for (int i = blockIdx.x * 512 + tid; i < 2 * 2 * 12 * 4096; i += G * 512) {
            const int j = i & 63, k = (i >> 6) & 63, hd = (i >> 12) % 12, ld = i / (12 * 4096);
            const size_t src = ((size_t)ld * 64 + j) * RW + hd * 64 + k;
            WT[i] = (bf16_t)(pk2(a.in[I_WUP][src], 0.f) & 0xffffu); AT[i] = (bf16_t)(pk2(a.in[I_AUP][src], 0.f) & 0xffffu);
        }
    }
    {
        bf16_t* GT = (bf16_t*)(ws + WS_MISC + MISC_GUPT);
        for (int i = blockIdx.x * 512 + tid; i < 2 * 768 * 256; i += G * 512) {
            const int k = i & 255, n = (i >> 8) % 768, l2 = i / (768 * 256);
            GT[i] = k < 128 ? f2bf(a.in[I_GUP][((size_t)l2 * 128 + k) * RW + n]) : (bf16_t)0;
        }
    }
    __syncthreads();
    if ((int)blockIdx.x < 192) {
        LAS float* sc = (LAS float*)(lds + 69632);
        LAS float* red = (LAS float*)(lds + 102400);
        for (int i = tid; i < NB * DM; i += 512) { const float v = a.in[I_C][i]; sc[i] = v / (1.f + expf(-v)); }
        __syncthreads();
        float* mod = (float*)(ws + WS_MISC + MISC_MOD);
        for (int j = blockIdx.x; j < 192; j += G) {
            const int l = j / 96, n0 = (j - l * 96) * 64, jj = tid & 63, ks = tid >> 6;
            float acc[8];
#pragma unroll
            for (int b = 0; b < 8; ++b) acc[b] = 0.f;
            const float* wp = a.in[I_WMOD] + ((size_t)l * DM + ks * 128) * 6144 + n0 + jj;
            for (int k = 0; k < 128; ++k) { const float w = wp[(size_t)k * 6144];
#pragma unroll
                for (int b = 0; b < 8; ++b) acc[b] += sc[b * DM + ks * 128 + k] * w; }
#pragma unroll
            for (int b = 0; b < 8; ++b) red[(ks * 8 + b) * 64 + jj] = acc[b];
            __syncthreads();
            { const int b = tid >> 6; float s = 0.f;
#pragma unroll
              for (int k2 = 0; k2 < 8; ++k2) s += red[(k2 * 8 + b) * 64 + jj];
              mod[((size_t)l * 8 + b) * 6144 + n0 + jj] = s + a.in[I_BMOD][(size_t)l * 6144 + n0 + jj]; }
            __syncthreads();
        }
    }
    if ((int)blockIdx.x == G - 1) {
        float* lam = (float*)(ws + WS_MISC + MISC_LAM);
        if (tid < 2) { const int l = tid; const float* dl = a.in[I_DLAM] + (size_t)l * 256; float s01 = 0.f, s23 = 0.f;
            for (int d = 0; d < 64; ++d) { s01 += dl[d] * dl[64 + d]; s23 += dl[128 + d] * dl[192 + d]; }
            const float li = 0.8f - 0.6f * expf(-0.3f * (float)l);
            lam[l] = expf(s01) - expf(s23) + li; lam[2 + l] = li; }
        float* bA = (float*)(ws + WS_MISC + MISC_BIASA);
        for (int i = tid; i < 12 * 129; i += 512) { const int head = i / 129, jj = i - head * 129, g = head >> 2; const int dil = (g == 0) ? 1 : (g == 1) ? 4 : 16;
            bA[i] = a.in[I_RELB][t5_bucket((jj - 64) * dil) * 18 + head] * LOG2E; }
        float* bC = (float*)(ws + WS_MISC + MISC_BIASC);
        for (int i = tid; i < 6 * 257; i += 512) { const int h = i / 257, rel = i - h * 257 - 128;
            bC[i] = a.in[I_RELB][t5_bucket(rel) * 18 + 12 + h] * LOG2E; }
    }
}

__device__ __forceinline__ float row_rstd(const f32x4 (&v)[4], float eps) {
    float s = 0.f;
#pragma unroll
    for (int j = 0; j < 4; ++j) s += (v[j].x * v[j].x + v[j].y * v[j].y) + (v[j].z * v[j].z + v[j].w * v[j].w);
    return rsqrtf(wave_sum(s) * (1.f / DM) + eps);
}
__device__ __forceinline__ void norm_mod_store(const f32x4 (&v)[4], float rstd, const float* g, const float* sc, const float* sh, bf16_t* orow, int lane) {
#pragma unroll
    for (int j = 0; j < 4; ++j) { const int c = 4 * lane + 256 * j;
        const f32x4 gv = *(const f32x4*)(g + c), scv = *(const f32x4*)(sc + c), shv = *(const f32x4*)(sh + c);
        const f32x4 y = v[j] * rstd * gv * (scv + 1.0f) + shv;
        u32x2 w; w.x = pk2(y.x, y.y); w.y = pk2(y.z, y.w);
        *(u32x2*)(orow + c) = w; }
}
__device__ __forceinline__ void phase_norm1(const Args& a, int l) {
    const int tid = otid(), lane = tid & 63, wave = tid >> 6;
    const float* mod = (const float*)(a.ws + WS_MISC + MISC_MOD) + (size_t)l * 8 * 6144;
    bf16_t* H = (bf16_t*)(a.ws + WS_H);
    for (int t = blockIdx.x * 8 + wave; t < NTOK; t += gridDim.x * 8) {
        const float* xr = a.in[I_X] + (size_t)t * DM; f32x4 v[4];
#pragma unroll
        for (int j = 0; j < 4; ++j) v[j] = *(const f32x4*)(xr + 4 * lane + 256 * j);
        const float rstd = row_rstd(v, 1e-6f);
        const float* mb = mod + (size_t)(t >> 11) * 6144;
        norm_mod_store(v, rstd, a.in[I_N1G] + (size_t)l * DM, mb + 1024, mb, H + (size_t)t * DM, lane);
    }
}

__device__ __forceinline__ void swa_wave_unit(const bf16_t* P, float* OAG, float* LSE, const LAS float* biasA, LAS unsigned char* vbuf, int u, int lane) {
    const int b = u / 768; const int rem = u - b * 768; const int head = rem >> 6, s = rem & 63;
    const int g = head >> 2, hh = head & 3;
    const int dsh = (g == 0) ? 0 : (g == 1) ? 2 : 4;
    const int L = NT >> dsh, nmbsh = 6 - dsh;
    const int r = s >> nmbsh, mb = s & ((1 << nmbsh) - 1);
    const int r32 = lane & 31, hi = lane >> 5;
    const size_t tq = (size_t)b * NT + ((mb * 32 + r32) << dsh) + r;
    bf16x8 qf[4];
    { const bf16_t* qp = P + tq * PLD + C_AQ + head * 64 + 8 * hi;
#pragma unroll
      for (int s4 = 0; s4 < 4; ++s4) qf[s4] = *(const bf16x8*)(qp + 16 * s4); }
    f32x16 o[2]; o[0] = (f32x16){}; o[1] = (f32x16){};
    float m = -1e30f, lsum = 0.f;
    const float SC = 0.125f * LOG2E;
    const LAS float* bh = biasA + head * 129 + 64;
    const int trbase = (4 * hi + ((lane & 15) >> 2)) * 144 + (16 * ((lane >> 4) & 1) + 4 * (lane & 3)) * 2;
    for (int kt = -2; kt <= 2; ++kt) {
        const int m0 = mb * 32 + kt * 32;
        if (m0 + 31 < 0 || m0 >= L) continue;
        bf16x8 kf[4];
        { int km = m0 + r32; km = km < 0 ? 0 : (km > L - 1 ? L - 1 : km);
          const bf16_t* kp = P + ((size_t)b * NT + (km << dsh) + r) * PLD + C_AK + head * 64 + 8 * hi;
#pragma unroll
          for (int s4 = 0; s4 < 4; ++s4) kf[s4] = *(const bf16x8*)(kp + 16 * s4); }
        asm volatile("" ::: "memory");
#pragma unroll
        for (int c4 = 0; c4 < 4; ++c4) { const int id = lane + 64 * c4, row = id >> 3, ch = id & 7;
            int vm = m0 + row; vm = vm < 0 ? 0 : (vm > L - 1 ? L - 1 : vm);
            const u32x4 val = *(const u32x4*)(P + ((size_t)b * NT + (vm << dsh) + r) * PLD + C_AV + head * 64 + ch * 8);
            *(LAS u32x4*)(vbuf + row * 144 + ch * 16) = val; }
        f32x16 sacc = (f32x16){};
#pragma unroll
        for (int s4 = 0; s4 < 4; ++s4) sacc = __builtin_amdgcn_mfma_f32_32x32x16_bf16(kf[s4], qf[s4], sacc, 0, 0, 0);
        float x[16]; float mx = -1e30f;
#pragma unroll
        for (int rg = 0; rg < 16; ++rg) { const int kvl = crow(rg, hi), km = m0 + kvl, j = kt * 32 + kvl - r32;
            const bool valid = (km >= 0) && (km < L) && (j >= -64) && (j <= 64);
            const int jc = j < -64 ? -64 : (j > 64 ? 64 : j);
            const float xv = sacc[rg] * SC + bh[jc];
            x[rg] = valid ? xv : -1e30f; mx = fmaxf(mx, x[rg]); }
        mx = fmaxf(mx, __shfl_xor(mx, 32));
        const float mn = fmaxf(m, mx), alpha = __builtin_amdgcn_exp2f(m - mn); m = mn;
        float ps = 0.f;
#pragma unroll
        for (int rg = 0; rg < 16; ++rg) { x[rg] = __builtin_amdgcn_exp2f(x[rg] - mn); ps += x[rg]; }
        lsum = lsum * alpha + ps;
#pragma unroll
        for (int rg = 0; rg < 16; ++rg) { o[0][rg] *= alpha; o[1][rg] *= alpha; }
        u32x4 pw[2];
#pragma unroll
        for (int s2 = 0; s2 < 2; ++s2) { pw[s2].x = pk2(x[8 * s2 + 0], x[8 * s2 + 1]); pw[s2].y = pk2(x[8 * s2 + 2], x[8 * s2 + 3]); pw[s2].z = pk2(x[8 * s2 + 4], x[8 * s2 + 5]); pw[s2].w = pk2(x[8 * s2 + 6], x[8 * s2 + 7]); }
        lds_fence();
#pragma unroll
        for (int db = 0; db < 2; ++db)
#pragma unroll
            for (int s2 = 0; s2 < 2; ++s2) {
                const s16x4 lo = vtr(vbuf + trbase + (16 * s2) * 144 + db * 64);
                const s16x4 hi4 = vtr(vbuf + trbase + (16 * s2 + 8) * 144 + db * 64);
                const bf16x8 af = (bf16x8){lo[0], lo[1], lo[2], lo[3], hi4[0], hi4[1], hi4[2], hi4[3]};
                o[db] = __builtin_amdgcn_mfma_f32_32x32x16_bf16(af, __builtin_bit_cast(bf16x8, pw[s2]), o[db], 0, 0, 0);
            }
        asm volatile("" ::: "memory");
    }
    const float lt = lsum + __shfl_xor(lsum, 32);
    const float inv = 1.f / lt;
    float* op = OAG + ((size_t)g * NTOK + tq) * 256 + hh * 64;
#pragma unroll
    for (int db = 0; db < 2; ++db)
#pragma unroll
        for (int i = 0; i < 4; ++i) { f32x4 v = (f32x4){o[db][4 * i], o[db][4 * i + 1], o[db][4 * i + 2], o[db][4 * i + 3]} * inv;
            *(f32x4*)(op + db * 32 + 8 * i + 4 * hi) = v; }
    if (hi == 0) LSE[((size_t)g * NTOK + tq) * 4 + hh] = m + __log2f(lt);
}
__device__ __forceinline__ void phase_swa(const Args& a, LAS unsigned char* lds) {
    const int tid = otid(), lane = tid & 63, wave = tid >> 6;
    LAS float* bA = (LAS float*)(lds + 40960);
    const float* bAg = (const float*)(a.ws + WS_MISC + MISC_BIASA);
    for (int i = tid; i < 12 * 129; i += 512) bA[i] = bAg[i];
    __syncthreads();
    for (int item = blockIdx.x; item < 768; item += gridDim.x)
        swa_wave_unit((const bf16_t*)(a.ws + WS_PROJ), (float*)(a.ws + WS_OAG), (float*)(a.ws + WS_LSE), bA, lds + wave * 4608, item * 8 + wave, lane);
    __syncthreads();
}

constexpr int RLD = 144, RMAT = 64 * RLD;
constexpr int R_P = 0, R_Q = 4 * RMAT, R_M = R_Q + 2 * 17408;
constexpr int R_WD = R_P, R_AD = R_P + RMAT, R_WUP = R_P + 2 * RMAT, R_AUP = R_P + 3 * RMAT;
constexpr int R_LK = R_P, R_RK = R_P + RMAT, R_RB = R_P + 2 * RMAT, R_TT = R_P + 3 * RMAT;
constexpr int R_ZW = R_Q, R_ZA = R_Q + 17408, R_LBF = R_Q, R_SEG = R_ZA, R_GC = R_ZA + 2048, R_W1T = R_ZA + 4096;
constexpr int R_A = R_M, R_B = R_M + 2 * RMAT, R_BP = R_M + 3 * RMAT, R_K = R_M + 4 * RMAT, R_KP = R_M + 5 * RMAT, R_RHO = R_M + 6 * RMAT, R_V = R_M + 7 * RMAT;
constexpr int R_UT = R_B, R_TAT = R_K;
constexpr int R_TMP0 = R_SEG, R_TMP1 = R_ZA + 13312, R_TMP2 = R_ZA + 13312 + 2048;
constexpr int R_PAR = R_M + 8 * RMAT, NPAR = 960;
static_assert(R_PAR + 2 * NPAR * 4 <= LDS_STAGE, "R1 LDS");

template <bool XT, bool YT>
__device__ __forceinline__ f32x16 tile64x(const LAS unsigned char* XM, int x0, const LAS unsigned char* YM, int y0, int lane, f32x16 acc) {
    const int r32 = lane & 31, hi = lane >> 5;
    const int trofs = ((lane & 15) >> 2) * RLD + (16 * ((lane >> 4) & 1) + 4 * (lane & 3)) * 2;
#pragma unroll
    for (int s4 = 0; s4 < 4; ++s4) {
        bf16x8 xa, yb;
        if (!XT) xa = *(const LAS bf16x8*)(XM + (x0 + r32) * RLD + 32 * s4 + 16 * hi);
        else { const s16x4 lo = vtr(XM + (16 * s4 + 8 * hi) * RLD + trofs + 2 * x0), h4 = vtr(XM + (16 * s4 + 8 * hi + 4) * RLD + trofs + 2 * x0);
               xa = (bf16x8){lo[0], lo[1], lo[2], lo[3], h4[0], h4[1], h4[2], h4[3]}; }
        if (!YT) yb = *(const LAS bf16x8*)(YM + (y0 + r32) * RLD + 32 * s4 + 16 * hi);
        else { const s16x4 lo = vtr(YM + (16 * s4 + 8 * hi) * RLD + trofs + 2 * y0), h4 = vtr(YM + (16 * s4 + 8 * hi + 4) * RLD + trofs + 2 * y0);
               yb = (bf16x8){lo[0], lo[1], lo[2], lo[3], h4[0], h4[1], h4[2], h4[3]}; }
        acc = __builtin_amdgcn_mfma_f32_32x32x16_bf16(xa, yb, acc, 0, 0, 0);
    }
    return acc;
}
template <class MP>
__device__ __forceinline__ void shift8r(const u32x4 c, u32x4 m, u32x4 n, bool hm, bool hn, MP mu0, MP mu1, float (&o)[8]) {
    const unsigned mm = hm ? 0xffffffffu : 0u, nm = hn ? 0xffffffffu : 0u;
    m = m & mm; n = n & nm;
#pragma unroll
    for (int q = 0; q < 4; ++q) {
        const float pl = bflo(c[q]), ph = bfhi(c[q]);
        o[2 * q] = pl + mu0[2 * q] * (bflo(m[q]) - pl) + mu1[2 * q] * (bflo(n[q]) - pl);
        o[2 * q + 1] = ph + mu0[2 * q + 1] * (bfhi(m[q]) - ph) + mu1[2 * q + 1] * (bfhi(n[q]) - ph);
    }
}
__device__ __forceinline__ float r1_param(const Args& a, int l, int h, int dir, int idx) {
    const int j = idx & 63, row = idx >> 6;
    if (row < 10) { const int g = row >> 1, which = row & 1; const int col = (g < 3 ? g * 768 + h * 64 : (g == 3 ? 2304 : 2432) + dir * 64) + j;
        return a.in[I_MU][(size_t)l * 2 * RSTR + (size_t)which * RSTR + col]; }
    const int cb = (l * 2 + dir) * RW + h * 64 + j;
    if (row == 10) return a.in[I_W0][cb];
    if (row == 11) return a.in[I_A0][cb];
    if (row == 12) return a.in[I_KK][cb];
    if (row == 13) return a.in[I_KA][cb];
    return a.in[I_RK][(size_t)l * RW + h * 64 + j];
}
__device__ __forceinline__ int r1_col(int g, int h, int dir, int seg) { return (g < 3 ? g * 768 + h * 64 : (g == 3 ? 2304 : 2432) + dir * 64) + 8 * seg; }
__device__ __forceinline__ void r1_issue(const bf16_t* P, int ct, int tid, u32x4 (&raw)[15]) {
    const int c = ct & 31, dir = (ct >> 5) & 1, bh = ct >> 6, h = bh % 12, b = bh / 12, ti = tid >> 3, seg = tid & 7;
    const int tseq = dir ? (NT - 1 - 64 * c - ti) : (64 * c + ti);
    const bf16_t* p0 = P + ((size_t)b * NT + tseq) * PLD + C_BS;
    const int dm = tseq > 0 ? PLD : 0, dn = tseq < NT - 1 ? PLD : 0;
#pragma unroll
    for (int g = 0; g < 5; ++g) { const int col = r1_col(g, h, dir, seg);
        raw[3 * g] = *(const u32x4*)(p0 + col); raw[3 * g + 1] = *(const u32x4*)(p0 + col - dm); raw[3 * g + 2] = *(const u32x4*)(p0 + col + dn); }
}

__device__ __forceinline__ void phase_rwkv_r1(const Args& a, int l, LAS unsigned char* lds) {
    const int tid0 = otid();
    unsigned char* ws = a.ws;
    const bf16_t* P = (const bf16_t*)(ws + WS_PROJ);
    const float* mu = a.in[I_MU] + (size_t)l * 2 * RSTR;
    const int G = gridDim.x;
    u32x4 raw[15], wup4, aup4;
    if ((int)blockIdx.x < 6144) { r1_issue(P, blockIdx.x, tid0, raw);
        { const int c0 = blockIdx.x; const size_t wofs = ((size_t)(l * 2 + ((c0 >> 5) & 1)) * 12 + ((c0 >> 6) % 12)) * 4096 + (size_t)(tid0 >> 3) * 64 + 8 * (tid0 & 7);
          wup4 = *(const u32x4*)((const bf16_t*)(ws + WS_MISC + MISC_WUPT) + wofs); aup4 = *(const u32x4*)((const bf16_t*)(ws + WS_MISC + MISC_AUPT) + wofs); }
        const int ct0 = blockIdx.x, bh0 = ct0 >> 6;
        LAS float* pt = (LAS float*)(lds + R_PAR);
        pt[tid0] = r1_param(a, l, bh0 % 12, (ct0 >> 5) & 1, tid0); if (tid0 + 512 < NPAR) pt[tid0 + 512] = r1_param(a, l, bh0 % 12, (ct0 >> 5) & 1, tid0 + 512); }
    __syncthreads();
    int itn = 0;
    f32x16 po0 = (f32x16){}, po1 = (f32x16){}; int ctp = -1;
#define R1_FLUSH(ctq, LANE, WAVE) do { const int _r32 = (LANE) & 31, _hi = (LANE) >> 5, _tt = (WAVE) & 3, _tm = _tt >> 1, _tn = _tt & 1; const size_t _cto = (size_t)(ctq) * 4096; \
        if ((WAVE) < 4) { bf16_t* QA = (bf16_t*)(ws + WS_QA) + _cto; float* MP = (float*)(ws + WS_MP) + _cto; \
            _Pragma("unroll") for (int q = 0; q < 4; ++q) { u32x2 w; w.x = pk2(po0[4 * q], po0[4 * q + 1]); w.y = pk2(po0[4 * q + 2], po0[4 * q + 3]); \
                *(u32x2*)(QA + ((_tn * 4 + 2 * _tm + (q >> 1)) * 64 + (q & 1) * 32 + _r32) * 8 + 4 * _hi) = w; \
                *(f32x4*)(MP + (32 * _tn + _r32) * 64 + 32 * _tm + 8 * q + 4 * _hi) = (f32x4){po1[4 * q], po1[4 * q + 1], po1[4 * q + 2], po1[4 * q + 3]}; } \
        } else { float* Y0 = (float*)(ws + WS_Y0) + _cto + _tt * 1024 + (LANE); float* NP = (float*)(ws + WS_NP) + _cto; \
            _Pragma("unroll") for (int rg = 0; rg < 16; ++rg) Y0[rg * 64] = po0[rg]; \
            _Pragma("unroll") for (int q = 0; q < 4; ++q) *(f32x4*)(NP + (32 * _tn + _r32) * 64 + 32 * _tm + 8 * q + 4 * _hi) = (f32x4){po1[4 * q], po1[4 * q + 1], po1[4 * q + 2], po1[4 * q + 3]}; } } while (0)
  for (int ct = blockIdx.x; ct < 6144; ct += G, ++itn) {
    int tid = tid0; asm volatile("" : "+v"(tid));
    const int lane = tid & 63, wave = __builtin_amdgcn_readfirstlane(tid >> 6), r32 = lane & 31, hi = lane >> 5;
    const int ti = tid >> 3, seg = tid & 7;
    const int c = ct & 31, dir = (ct >> 5) & 1, bh = ct >> 6, h = bh % 12, b = bh / 12;
    const int tseq = dir ? (NT - 1 - 64 * c - ti) : (64 * c + ti);
    const size_t trow = (size_t)b * NT + tseq;
    const bool hm = tseq > 0, hn = tseq < NT - 1;
    const LAS float* PT = (const LAS float*)(lds + R_PAR) + (itn & 1) * NPAR;
    float pnx0 = 0.f, pnx1 = 0.f;
    float r8[8], k8[8], v8[8];
    {
        shift8r(raw[0], raw[1], raw[2], hm, hn, PT + 0 * 64 + 8 * seg, PT + 1 * 64 + 8 * seg, r8);
        shift8r(raw[3], raw[4], raw[5], hm, hn, PT + 2 * 64 + 8 * seg, PT + 3 * 64 + 8 * seg, k8);
        shift8r(raw[6], raw[7], raw[8], hm, hn, PT + 4 * 64 + 8 * seg, PT + 5 * 64 + 8 * seg, v8);
        float t8[8];
        shift8r(raw[9], raw[10], raw[11], hm, hn, PT + 6 * 64 + 8 * seg, PT + 7 * 64 + 8 * seg, t8);
#pragma unroll
        for (int q = 0; q < 8; ++q) { const float e2 = __expf(2.f * t8[q]); t8[q] = 1.f - 2.f / (e2 + 1.f); }
        *(LAS u32x4*)(lds + R_WD + ti * RLD + 16 * seg) = pack8(t8);
        shift8r(raw[12], raw[13], raw[14], hm, hn, PT + 8 * 64 + 8 * seg, PT + 9 * 64 + 8 * seg, t8);
        *(LAS u32x4*)(lds + R_AD + ti * RLD + 16 * seg) = pack8(t8);
        if (h == 0 && dir == 0) {
            const bf16_t* p0 = P + trow * PLD + C_BS;
            bf16_t* GS = (bf16_t*)(ws + WS_GS) + trow * 256;
#pragma unroll
            for (int hf = 0; hf < 2; ++hf) { const int col = 2560 + 64 * hf + 8 * seg;
                shift8r(*(const u32x4*)(p0 + col), *(const u32x4*)(p0 + col - (hm ? PLD : 0)), *(const u32x4*)(p0 + col + (hn ? PLD : 0)), hm, hn, mu + col, mu + RSTR + col, t8);
#pragma unroll
                for (int q = 0; q < 8; ++q) t8[q] = sigmoidf_(t8[q]);
                *(u32x4*)(GS + 64 * hf + 8 * seg) = pack8(t8);
                *(u32x4*)(GS + 128 + 64 * hf + 8 * seg) = (u32x4){0u, 0u, 0u, 0u}; }
        }
        *(LAS u32x4*)(lds + R_WUP + ti * RLD + 16 * seg) = wup4;
        *(LAS u32x4*)(lds + R_AUP + ti * RLD + 16 * seg) = aup4;
        if (dir == 0) *(u32x4*)((bf16_t*)(ws + WS_RV) + trow * RW + h * 64 + 8 * seg) = pack8(v8);
    }
    if (ctp >= 0) R1_FLUSH(ctp, lane, wave);
    if (ct + G < 6144) { r1_issue(P, ct + G, tid, raw);
        const int ctn = ct + G, bhn = ctn >> 6;
        { const size_t wofs = ((size_t)(l * 2 + ((ctn >> 5) & 1)) * 12 + (bhn % 12)) * 4096 + (size_t)ti * 64 + 8 * seg;
          wup4 = *(const u32x4*)((const bf16_t*)(ws + WS_MISC + MISC_WUPT) + wofs); aup4 = *(const u32x4*)((const bf16_t*)(ws + WS_MISC + MISC_AUPT) + wofs); }
        pnx0 = r1_param(a, l, bhn % 12, (ctn >> 5) & 1, tid); if (tid + 512 < NPAR) pnx1 = r1_param(a, l, bhn % 12, (ctn >> 5) & 1, tid + 512); }
    __syncthreads();
    {
        const int p = wave >> 2, tt = wave & 3, tm = tt >> 1, tn = tt & 1;
        f32x16 acc = (f32x16){};
        acc = tile64x<false, false>(lds + (p ? R_AUP : R_WUP), 32 * tm, lds + (p ? R_AD : R_WD), 32 * tn, lane, acc);
        LAS float* Z = (LAS float*)(lds + (p ? R_ZA : R_ZW));
#pragma unroll
        for (int q = 0; q < 4; ++q) *(LAS f32x4*)(Z + (32 * tn + r32) * 68 + 32 * tm + 8 * q + 4 * hi) = (f32x4){acc[4 * q], acc[4 * q + 1], acc[4 * q + 2], acc[4 * q + 3]};
    }
    __syncthreads();
    float kka8[8], kk8[8], kd8[8];
    {
        const LAS float* w0 = PT + 10 * 64 + 8 * seg; const LAS float* a0 = PT + 11 * 64 + 8 * seg;
        const LAS float* kkp = PT + 12 * 64 + 8 * seg; const LAS float* kap = PT + 13 * 64 + 8 * seg;
        LAS float* Zw = (LAS float*)(lds + R_ZW) + ti * 68 + 8 * seg; const LAS float* Za = (const LAS float*)(lds + R_ZA) + ti * 68 + 8 * seg;
        float nrm = 0.f, av[8], e8[8];
#pragma unroll
        for (int q = 0; q < 8; ++q) {
            const float z = w0[q] + Zw[q];
            const float u = -z; const float sp = fmaxf(u, 0.f) + __logf(1.f + __expf(-fabsf(u)));
            e8[q] = __expf(-sp - 0.5f);
            av[q] = sigmoidf_(a0[q] + Za[q]);
            const float kr = k8[q] * kkp[q]; kk8[q] = kr; nrm += kr * kr;
            kd8[q] = k8[q] * (1.f + (av[q] - 1.f) * kap[q]);
        }
        nrm = dpp_sum8(nrm);
        const float rn = rsqrtf(fmaxf(nrm, 1e-24f));
#pragma unroll
        for (int q = 0; q < 8; ++q) { kk8[q] *= rn; kka8[q] = kk8[q] * av[q]; Zw[q] = e8[q]; }
        { const LAS float* rkp = PT + 14 * 64 + 8 * seg; float bs = 0.f;
#pragma unroll
          for (int q = 0; q < 8; ++q) bs += r8[q] * kd8[q] * rkp[q];
          bs = dpp_sum8(bs);
          if (seg == 0) ((float*)(ws + WS_RR))[((size_t)dir * NTOK + trow) * 12 + h] = bs; }
    }
    __syncthreads();
    {
        const int kc = tid & 63, sg = tid >> 6;
        LAS float* Zw = (LAS float*)(lds + R_ZW); LAS float* SEG = (LAS float*)(lds + R_SEG);
        float run = 0.f;
#pragma unroll
        for (int q = 0; q < 8; ++q) { run += Zw[(8 * sg + q) * 68 + kc]; Zw[(8 * sg + q) * 68 + kc] = run; }
        SEG[sg * 64 + kc] = run;
        __syncthreads();
        float off = 0.f;
        for (int s2 = 0; s2 < sg; ++s2) off += SEG[s2 * 64 + kc];
#pragma unroll
        for (int q = 0; q < 8; ++q) Zw[(8 * sg + q) * 68 + kc] += off;
    }
    __syncthreads();
    {
        const LAS float* Gp = (const LAS float*)(lds + R_ZW);
        float al[8], be[8], bp[8], ka[8], kp[8], rh[8];
#pragma unroll
        for (int q = 0; q < 8; ++q) {
            const float gi = Gp[ti * 68 + 8 * seg + q], gm = ti > 0 ? Gp[(ti - 1) * 68 + 8 * seg + q] : 0.f, g63 = Gp[63 * 68 + 8 * seg + q];
            const float ig = __expf(gi), tl = __expf(gi - g63);
            al[q] = __expf(-gm) * kk8[q]; be[q] = kka8[q] * ig; bp[q] = kka8[q] * tl; ka[q] = kd8[q] * ig; kp[q] = kd8[q] * tl; rh[q] = r8[q] * __expf(-gi);
            if (ti == 63) ((LAS float*)(lds + R_GC))[8 * seg + q] = __expf(-g63);
        }
        const int o = ti * RLD + 16 * seg;
        *(LAS u32x4*)(lds + R_A + o) = pack8(al); *(LAS u32x4*)(lds + R_B + o) = pack8(be); *(LAS u32x4*)(lds + R_K + o) = pack8(ka); *(LAS u32x4*)(lds + R_RHO + o) = pack8(rh);
        *(LAS u32x4*)(lds + R_BP + o) = pack8(bp); *(LAS u32x4*)(lds + R_KP + o) = pack8(kp); *(LAS u32x4*)(lds + R_V + o) = pack8(v8);
    }
    __syncthreads();
    {
        const int tt = wave & 3, tm = tt >> 1, tn = tt & 1;
        const int jb = 32 * tm, ib = 32 * tn, i = ib + r32;
        f32x16 acc0 = (f32x16){}, acc1 = (f32x16){};
        if (tm <= tn) {
            acc0 = tile64x<false, false>(lds + (wave < 4 ? R_B : R_K), jb, lds + (wave < 4 ? R_A : R_RHO), ib, lane, acc0);
            acc1 = tile64x<false, false>(lds + (wave < 4 ? R_K : R_B), jb, lds + (wave < 4 ? R_A : R_RHO), ib, lane, acc1);
        }
#pragma unroll
        for (int rg = 0; rg < 16; ++rg) { const int j = jb + crow(rg, hi); const bool keep = (wave < 4) ? (j < i) : (j <= i);
            acc0[rg] = keep ? acc0[rg] : 0.f; acc1[rg] = keep ? acc1[rg] : 0.f; }
#pragma unroll
        for (int q = 0; q < 4; ++q) { const int jo = jb + 8 * q + 4 * hi;
            u32x2 w1; w1.x = pk2(acc1[4 * q], acc1[4 * q + 1]); w1.y = pk2(acc1[4 * q + 2], acc1[4 * q + 3]);
            if (wave < 4) {
                *(LAS f32x4*)((LAS float*)(lds + R_LBF) + i * 68 + jo) = (f32x4){acc0[4 * q], acc0[4 * q + 1], acc0[4 * q + 2], acc0[4 * q + 3]};
                *(LAS u32x2*)(lds + R_LK + i * RLD + 2 * jo) = w1;
                if (wave == 1) { u32x2 wl; wl.x = pk2(acc0[4 * q], acc0[4 * q + 1]); wl.y = pk2(acc0[4 * q + 2], acc0[4 * q + 3]);
                    *(LAS u32x2*)(lds + R_TMP0 + r32 * 64 + 2 * (8 * q + 4 * hi)) = wl; }
            } else {
                u32x2 w0; w0.x = pk2(acc0[4 * q], acc0[4 * q + 1]); w0.y = pk2(acc0[4 * q + 2], acc0[4 * q + 3]);
                *(LAS u32x2*)(lds + R_RK + i * RLD + 2 * jo) = w0;
                *(LAS u32x2*)(lds + R_RB + i * RLD + 2 * jo) = w1;
            } }
    }
    __syncthreads();
    if (wave < 2) {
        const int blk = wave, col = r32;
        const LAS float* Lf = (const LAS float*)(lds + R_LBF) + (32 * blk) * 68 + 32 * blk;
        float Tm[32];
        f32x4 cur[8], nxt[8];
#pragma unroll
        for (int m4 = 0; m4 < 8; ++m4) { cur[m4] = (f32x4){0.f, 0.f, 0.f, 0.f}; nxt[m4] = (f32x4){0.f, 0.f, 0.f, 0.f}; }
        cur[0] = *(const LAS f32x4*)(Lf + 68);
        Tm[0] = (col == 0) ? 1.f : 0.f;
#pragma unroll
        for (int i = 1; i < 32; ++i) {
            if (i + 1 < 32) {
#pragma unroll
                for (int m4 = 0; m4 < (i + 4) / 4; ++m4) nxt[m4] = *(const LAS f32x4*)(Lf + (i + 1) * 68 + 4 * m4);
            }
            float c0 = (col == i) ? 1.f : 0.f, c1 = 0.f, c2 = 0.f, c3 = 0.f;
#pragma unroll
            for (int m4 = 0; m4 < (i + 3) / 4; ++m4) {
                if (4 * m4 + 0 < i) c0 -= cur[m4][0] * Tm[4 * m4 + 0];
                if (4 * m4 + 1 < i) c1 -= cur[m4][1] * Tm[4 * m4 + 1];
                if (4 * m4 + 2 < i) c2 -= cur[m4][2] * Tm[4 * m4 + 2];
                if (4 * m4 + 3 < i) c3 -= cur[m4][3] * Tm[4 * m4 + 3]; }
            Tm[i] = (c0 + c1) + (c2 + c3);
#pragma unroll
            for (int m4 = 0; m4 < 8; ++m4) cur[m4] = nxt[m4];
            asm volatile("" : "+v"(Tm[i]) :: "memory");
        }
        if (hi == 0) {
#pragma unroll
            for (int i = 0; i < 32; ++i) {
                *(LAS bf16_t*)(lds + R_TT + (32 * blk + i) * RLD + 2 * (32 * blk + col)) = f2bf(Tm[i]);
                if (blk == 0) *(LAS bf16_t*)(lds + R_TT + i * RLD + 2 * (32 + col)) = (bf16_t)0;
            }
            if (blk == 0) {
#pragma unroll
                for (int q = 0; q < 4; ++q) { float x8[8];
#pragma unroll
                    for (int e = 0; e < 8; ++e) x8[e] = Tm[8 * q + e];
                    *(LAS u32x4*)(lds + R_TMP1 + col * 64 + 16 * q) = pack8(x8); } }
        }
    } else if (wave >= 4) {
        const int tt = wave & 3, tm = tt >> 1, tn = tt & 1;
        f32x16 acc = (f32x16){};
        acc = tile64x<false, true>(lds + R_LK, 32 * tm, lds + R_V, 32 * tn, lane, acc);
#pragma unroll
        for (int q = 0; q < 4; ++q) { u32x2 w; w.x = pk2(acc[4 * q], acc[4 * q + 1]); w.y = pk2(acc[4 * q + 2], acc[4 * q + 3]);
            *(LAS u32x2*)(lds + R_W1T + (32 * tn + r32) * RLD + 2 * (32 * tm + 8 * q + 4 * hi)) = w; }
    }
    __syncthreads();
    if (wave == 0) {
        f32x16 x1 = (f32x16){};
#pragma unroll
        for (int s2 = 0; s2 < 2; ++s2) x1 = __builtin_amdgcn_mfma_f32_32x32x16_bf16(*(const LAS bf16x8*)(lds + R_TMP0 + r32 * 64 + 32 * s2 + 16 * hi), *(const LAS bf16x8*)(lds + R_TMP1 + r32 * 64 + 32 * s2 + 16 * hi), x1, 0, 0, 0);
#pragma unroll
        for (int q = 0; q < 4; ++q) { u32x2 w; w.x = pk2(x1[4 * q], x1[4 * q + 1]); w.y = pk2(x1[4 * q + 2], x1[4 * q + 3]);
            *(LAS u32x2*)(lds + R_TMP2 + r32 * 64 + 2 * (8 * q + 4 * hi)) = w; }
        lds_fence();
        f32x16 t21 = (f32x16){};
#pragma unroll
        for (int s2 = 0; s2 < 2; ++s2) t21 = __builtin_amdgcn_mfma_f32_32x32x16_bf16(*(const LAS bf16x8*)(lds + R_TT + (32 + r32) * RLD + 64 + 32 * s2 + 16 * hi), *(const LAS bf16x8*)(lds + R_TMP2 + r32 * 64 + 32 * s2 + 16 * hi), t21, 0, 0, 0);
#pragma unroll
        for (int rg = 0; rg < 16; ++rg) *(LAS bf16_t*)(lds + R_TT + (32 + crow(rg, hi)) * RLD + 2 * r32) = f2bf(-t21[rg]);
    }
    __syncthreads();
    {
        const int tt = wave & 3, tm = tt >> 1, tn = tt & 1;
        f32x16 acc = (f32x16){};
        if (wave < 4) acc = tile64x<false, false>(lds + R_TT, 32 * tm, lds + R_W1T, 32 * tn, lane, acc);
        else          acc = tile64x<false, true>(lds + R_TT, 32 * tm, lds + R_A, 32 * tn, lane, acc);
        LAS unsigned char* dst = lds + (wave < 4 ? R_UT : R_TAT);
#pragma unroll
        for (int q = 0; q < 4; ++q) { u32x2 w; w.x = pk2(acc[4 * q], acc[4 * q + 1]); w.y = pk2(acc[4 * q + 2], acc[4 * q + 3]);
            *(LAS u32x2*)(dst + (32 * tn + r32) * RLD + 2 * (32 * tm + 8 * q + 4 * hi)) = w; }
    }
    __syncthreads();
    {
        const int tt = wave & 3, tm = tt >> 1, tn = tt & 1;
        if (wave < 4) {
            f32x16 acc = (f32x16){};
            acc = tile64x<false, false>(lds + R_TAT, 32 * tm, lds + R_RB, 32 * tn, lane, acc);
#pragma unroll
            for (int q = 0; q < 4; ++q) { const int i = 32 * tn + r32, k = 32 * tm + 8 * q + 4 * hi;
                const u32x2 rv = *(const LAS u32x2*)(lds + R_RHO + i * RLD + 2 * k);
                po0[4 * q] = bflo(rv.x) - acc[4 * q]; po0[4 * q + 1] = bfhi(rv.x) - acc[4 * q + 1]; po0[4 * q + 2] = bflo(rv.y) - acc[4 * q + 2]; po0[4 * q + 3] = bfhi(rv.y) - acc[4 * q + 3]; }
            f32x16 am = (f32x16){};
            am = tile64x<true, false>(lds + R_BP, 32 * tm, lds + R_TAT, 32 * tn, lane, am);
            const LAS float* GC = (const LAS float*)(lds + R_GC);
#pragma unroll
            for (int q = 0; q < 4; ++q) { const int k = 32 * tn + r32, kp0 = 32 * tm + 8 * q + 4 * hi;
#pragma unroll
                for (int e = 0; e < 4; ++e) po1[4 * q + e] = ((kp0 + e == k) ? GC[kp0 + e] : 0.f) - am[4 * q + e]; }
        } else {
            f32x16 a1 = (f32x16){}, a2 = (f32x16){};
            a1 = tile64x<true, false>(lds + R_V, 32 * tm, lds + R_RK, 32 * tn, lane, a1);
            a2 = tile64x<false, false>(lds + R_UT, 32 * tm, lds + R_RB, 32 * tn, lane, a2);
            po0 = a1 - a2;
            f32x16 n1 = (f32x16){}, n2 = (f32x16){};
            n1 = tile64x<true, true>(lds + R_KP, 32 * tm, lds + R_V, 32 * tn, lane, n1);
            n2 = tile64x<true, false>(lds + R_BP, 32 * tm, lds + R_UT, 32 * tn, lane, n2);
            po1 = n1 - n2;
        }
        ctp = ct;
    }
    if (ct + G < 6144) { LAS float* pn = (LAS float*)(lds + R_PAR) + ((itn + 1) & 1) * NPAR; pn[tid] = pnx0; if (tid + 512 < NPAR) pn[tid + 512] = pnx1; }
    __syncthreads();
  }
    if (ctp >= 0) { const int lane = tid0 & 63, wave = __builtin_amdgcn_readfirstlane(tid0 >> 6); R1_FLUSH(ctp, lane, wave); }
#undef R1_FLUSH
}

__device__ __forceinline__ void rwkv_r2_unit(const Args& a, int unit, LAS unsigned char* lds) {
    const int tid = otid(), lane = tid & 63, wave = __builtin_amdgcn_readfirstlane(tid >> 6);
    unsigned char* ws = a.ws;
    LAS float* S = (LAS float*)lds;
    const int vb = wave >> 1, kb0 = 2 * (wave & 1), l15 = lane & 15, lq = lane >> 4;
    for (int i = tid; i < 64 * 68; i += 512) S[i] = 0.f;
    const float* MPb = (const float*)(ws + WS_MP) + (size_t)unit * 32 * 4096; const float* NPb = (const float*)(ws + WS_NP) + (size_t)unit * 32 * 4096;
    bf16_t* SSb = (bf16_t*)(ws + WS_SS) + (size_t)unit * 32 * 4096;
    float Bm[2][16]; f32x4 acc[2];
#pragma unroll
    for (int t2 = 0; t2 < 2; ++t2) {
#pragma unroll
        for (int ks = 0; ks < 16; ++ks) Bm[t2][ks] = MPb[(4 * ks + lq) * 64 + 16 * (kb0 + t2) + l15];
#pragma unroll
        for (int rg = 0; rg < 4; ++rg) acc[t2][rg] = NPb[(16 * vb + 4 * lq + rg) * 64 + 16 * (kb0 + t2) + l15]; }
    __syncthreads();
    for (int c = 0; c < 32; ++c) {
        { const int v = tid >> 3, sg = tid & 7; const LAS float* sp = S + v * 68 + 8 * sg; float x[8];
#pragma unroll
          for (int q = 0; q < 8; ++q) x[q] = sp[q];
          *(u32x4*)(SSb + (size_t)c * 4096 + v * 64 + 8 * sg) = pack8(x); }
#pragma unroll
        for (int ks = 0; ks < 16; ++ks) { const float av = S[(16 * vb + l15) * 68 + 4 * ks + lq];
            acc[0] = __builtin_amdgcn_mfma_f32_16x16x4f32(av, Bm[0][ks], acc[0], 0, 0, 0);
            acc[1] = __builtin_amdgcn_mfma_f32_16x16x4f32(av, Bm[1][ks], acc[1], 0, 0, 0); }
        __syncthreads();
#pragma unroll
        for (int t2 = 0; t2 < 2; ++t2)
#pragma unroll
            for (int rg = 0; rg < 4; ++rg) S[(16 * vb + 4 * lq + rg) * 68 + 16 * (kb0 + t2) + l15] = acc[t2][rg];
        if (c + 1 < 32) { const float* MPc = MPb + (size_t)(c + 1) * 4096; const float* NPc = NPb + (size_t)(c + 1) * 4096;
#pragma unroll
            for (int t2 = 0; t2 < 2; ++t2) {
#pragma unroll
                for (int ks = 0; ks < 16; ++ks) Bm[t2][ks] = MPc[(4 * ks + lq) * 64 + 16 * (kb0 + t2) + l15];
#pragma unroll
                for (int rg = 0; rg < 4; ++rg) acc[t2][rg] = NPc[(16 * vb + 4 * lq + rg) * 64 + 16 * (kb0 + t2) + l15]; } }
        __syncthreads();
    }
}

__device__ __forceinline__ void phase_rwkv_out(const Args& a, int l) {
    const int tid = otid(), lane = tid & 63, wave = tid >> 6, r32 = lane & 31, hi = lane >> 5;
    unsigned char* ws = a.ws;
    const bf16_t* SSg = (const bf16_t*)(ws + WS_SS); const bf16_t* QAg = (const bf16_t*)(ws + WS_QA); const float* Y0g = (const float*)(ws + WS_Y0);
    const bf16_t* RV = (const bf16_t*)(ws + WS_RV);
    const bf16_t* GG = (const bf16_t*)(ws + WS_GG); bf16_t* OB = (bf16_t*)(ws + WS_OB);
    const float* lng = a.in[I_LNG] + (size_t)l * RW; const float* lnb = a.in[I_LNB] + (size_t)l * RW;
    for (int wt = blockIdx.x * 8 + wave; wt < 6144; wt += gridDim.x * 8) {
        const int tq = wt & 63, bh = wt >> 6, h = bh % 12, b = bh / 12, c = tq >> 1, tn = tq & 1, tnb = 1 - tn;
        const size_t ctf = ((size_t)bh * 2 + 0) * 32 + c, ctb = ((size_t)bh * 2 + 1) * 32 + (31 - c);
        const size_t t = (size_t)b * NT + 64 * c + 32 * tn + r32;
        const int srcl = (lane & 32) + 31 - r32;
        float y[2][16];
#pragma unroll
        for (int tm = 0; tm < 2; ++tm) {
            f32x16 af, ab;
            const float* y0f = Y0g + ctf * 4096 + (tm * 2 + tn) * 1024 + lane; const float* y0b = Y0g + ctb * 4096 + (tm * 2 + tnb) * 1024 + lane;
#pragma unroll
            for (int rg = 0; rg < 16; ++rg) { af[rg] = y0f[rg * 64]; ab[rg] = y0b[rg * 64]; }
#pragma unroll
            for (int s4 = 0; s4 < 4; ++s4) {
                const bf16x8 xf = *(const bf16x8*)(SSg + ctf * 4096 + (32 * tm + r32) * 64 + 16 * s4 + 8 * hi);
                const bf16x8 yf = *(const bf16x8*)(QAg + ctf * 4096 + ((tn * 4 + s4) * 64 + lane) * 8);
                af = __builtin_amdgcn_mfma_f32_32x32x16_bf16(xf, yf, af, 0, 0, 0);
                const bf16x8 xb = *(const bf16x8*)(SSg + ctb * 4096 + (32 * tm + r32) * 64 + 16 * s4 + 8 * hi);
                const bf16x8 yb = *(const bf16x8*)(QAg + ctb * 4096 + ((tnb * 4 + s4) * 64 + lane) * 8);
                ab = __builtin_amdgcn_mfma_f32_32x32x16_bf16(xb, yb, ab, 0, 0, 0);
            }
#pragma unroll
            for (int rg = 0; rg < 16; ++rg) y[tm][rg] = af[rg] + __shfl(ab[rg], srcl);
        }
        float sm = 0.f;
#pragma unroll
        for (int tm = 0; tm < 2; ++tm)
#pragma unroll
            for (int rg = 0; rg < 16; ++rg) sm += y[tm][rg];
        sm += __shfl_xor(sm, 32);
        const float mean = sm * (1.f / 64.f);
        float sv = 0.f;
#pragma unroll
        for (int tm = 0; tm < 2; ++tm)
#pragma unroll
            for (int rg = 0; rg < 16; ++rg) { const float d = y[tm][rg] - mean; y[tm][rg] = d; sv += d * d; }
        sv += __shfl_xor(sv, 32);
        const float rstd = rsqrtf(sv * (1.f / 64.f) + 64e-5f);
        const float* BS = (const float*)(ws + WS_RR);
        const float s0 = BS[t * 12 + h] + BS[((size_t)NTOK + t) * 12 + h];
#pragma unroll
        for (int tm = 0; tm < 2; ++tm)
#pragma unroll
            for (int q = 0; q < 4; ++q) { const int cc = h * 64 + 32 * tm + 8 * q + 4 * hi;
                const f32x4 g4 = *(const f32x4*)(lng + cc), b4 = *(const f32x4*)(lnb + cc); const u32x2 vv = *(const u32x2*)(RV + t * RW + cc);
                const f32x4 v4 = (f32x4){bflo(vv.x), bfhi(vv.x), bflo(vv.y), bfhi(vv.y)};
                const u32x2 gg = *(const u32x2*)(GG + t * RW + cc);
                const float o0 = (y[tm][4 * q] * rstd * g4.x + b4.x + s0 * v4.x) * bflo(gg.x), o1 = (y[tm][4 * q + 1] * rstd * g4.y + b4.y + s0 * v4.y) * bfhi(gg.x);
                const float o2 = (y[tm][4 * q + 2] * rstd * g4.z + b4.z + s0 * v4.z) * bflo(gg.y), o3 = (y[tm][4 * q + 3] * rstd * g4.w + b4.w + s0 * v4.w) * bfhi(gg.y);
                u32x2 w; w.x = pk2(o0, o1); w.y = pk2(o2, o3);
                *(u32x2*)(OB + t * RW + cc) = w; }
    }
    const float* OAG = (const float*)(ws + WS_OAG); const float* LSE = (const float*)(ws + WS_LSE); bf16_t* OA = (bf16_t*)(ws + WS_OA);
    for (int task = blockIdx.x * 8 + wave; task < NTOK / 4; task += gridDim.x * 8) {
#pragma unroll
        for (int tk = 0; tk < 4; ++tk) { const size_t t = (size_t)task * 4 + tk; const int hh = lane >> 4;
            const float l0 = LSE[((size_t)0 * NTOK + t) * 4 + hh], l1 = LSE[((size_t)1 * NTOK + t) * 4 + hh], l2 = LSE[((size_t)2 * NTOK + t) * 4 + hh];
            const float mx = fmaxf(l0, fmaxf(l1, l2));
            const float w0 = __builtin_amdgcn_exp2f(l0 - mx), w1 = __builtin_amdgcn_exp2f(l1 - mx), w2 = __builtin_amdgcn_exp2f(l2 - mx);
            const float inv = 1.f / (w0 + w1 + w2);
            const f32x4 o0 = *(const f32x4*)(OAG + ((size_t)0 * NTOK + t) * 256 + lane * 4), o1 = *(const f32x4*)(OAG + ((size_t)1 * NTOK + t) * 256 + lane * 4), o2 = *(const f32x4*)(OAG + ((size_t)2 * NTOK + t) * 256 + lane * 4);
            const f32x4 r = (o0 * w0 + o1 * w1 + o2 * w2) * inv;
            u32x2 w; w.x = pk2(r.x, r.y); w.y = pk2(r.z, r.w);
            *(u32x2*)(OA + t * 256 + lane * 4) = w; }
    }
}

__device__ __forceinline__ void diffattn_unit(const Args& a, int l, int unit, LAS unsigned char* lds) {
    constexpr int RS = 272;
    const int b = unit / 96; const int rem = unit - b * 96; const int h = rem >> 4, qb = rem & 15;
    const int tid = otid(), lane = tid & 63, wave = __builtin_amdgcn_readfirstlane(tid >> 6), r32 = lane & 31, hi = lane >> 5;
    const int c = wave & 1, qblk = wave >> 1;
    const int q0 = qb * 128 + qblk * 32;
    const bf16_t* P = (const bf16_t*)(a.ws + WS_PROJ);
    const size_t rowb = (size_t)b * NT;
    bf16x8 qf[4];
    { const bf16_t* qp = P + (rowb + q0 + r32) * PLD + C_CQ + h * 128 + c * 64 + 8 * hi;
#pragma unroll
      for (int s4 = 0; s4 < 4; ++s4) qf[s4] = *(const bf16x8*)(qp + 16 * s4); }
    LAS float* biasL = (LAS float*)(lds + 69632);
    { const float* bC = (const float*)(a.ws + WS_MISC + MISC_BIASC) + h * 257;
      for (int i = tid; i < 257; i += 512) biasL[i] = bC[i]; }
    const int srow0 = tid >> 4, sch = tid & 15;
    const bf16_t* kg = P + (rowb + srow0) * PLD + C_CK + h * 128 + sch * 8;
    const bf16_t* vg = P + (rowb + srow0) * PLD + C_CV + h * 128 + sch * 8;
    u32x4 kr[2], vr[2];
#pragma unroll
    for (int i = 0; i < 2; ++i) { kr[i] = *(const u32x4*)(kg + (size_t)(32 * i) * PLD); vr[i] = *(const u32x4*)(vg + (size_t)(32 * i) * PLD); }
#pragma unroll
    for (int i = 0; i < 2; ++i) { *(LAS u32x4*)(lds + (srow0 + 32 * i) * RS + sch * 16) = kr[i]; *(LAS u32x4*)(lds + 34816 + (srow0 + 32 * i) * RS + sch * 16) = vr[i]; }
    __syncthreads();
    f32x16 o[4];
#pragma unroll
    for (int db = 0; db < 4; ++db) o[db] = (f32x16){};
    float m = -1e30f, lsum = 0.f;
    const float SC = 0.125f * LOG2E;
    const int trb = (4 * hi + ((lane & 15) >> 2)) * RS + (16 * ((lane >> 4) & 1) + 4 * (lane & 3)) * 2;
    const int qabs = q0 + r32;
    for (int t = 0; t < 32; ++t) {
        if (t + 1 < 32) {
#pragma unroll
            for (int i = 0; i < 2; ++i) { kr[i] = *(const u32x4*)(kg + (size_t)(64 * (t + 1) + 32 * i) * PLD); vr[i] = *(const u32x4*)(vg + (size_t)(64 * (t + 1) + 32 * i) * PLD); } }
        const LAS unsigned char* Kb = lds + (t & 1) * 17408;
        const LAS unsigned char* Vb = lds + 34816 + (t & 1) * 17408;
        f32x16 sa0 = (f32x16){}, sa1 = (f32x16){};
#pragma unroll
        for (int s4 = 0; s4 < 4; ++s4) {
            const bf16x8 kf0 = *(const LAS bf16x8*)(Kb + r32 * RS + c * 128 + 32 * s4 + 16 * hi);
            const bf16x8 kf1 = *(const LAS bf16x8*)(Kb + (32 + r32) * RS + c * 128 + 32 * s4 + 16 * hi);
            sa0 = __builtin_amdgcn_mfma_f32_32x32x16_bf16(kf0, qf[s4], sa0, 0, 0, 0);
            sa1 = __builtin_amdgcn_mfma_f32_32x32x16_bf16(kf1, qf[s4], sa1, 0, 0, 0);
        }
        float x0[16], x1[16];
        const int kv0 = 64 * t;
        const bool farp = (kv0 >= q0 + 31 + 128), farn = (kv0 + 63 + 128 <= q0);
        if (farp || farn) { const float cb = farp ? biasL[256] : biasL[0];
#pragma unroll
            for (int rg = 0; rg < 16; ++rg) { x0[rg] = sa0[rg] * SC + cb; x1[rg] = sa1[rg] * SC + cb; }
        } else {
#pragma unroll
            for (int rg = 0; rg < 16; ++rg) { int rel = kv0 + crow(rg, hi) - qabs; int rc = rel < -128 ? -128 : (rel > 128 ? 128 : rel);
                x0[rg] = sa0[rg] * SC + biasL[rc + 128];
                rel += 32; rc = rel < -128 ? -128 : (rel > 128 ? 128 : rel);
                x1[rg] = sa1[rg] * SC + biasL[rc + 128]; }
        }
        float mx = fmaxf(x0[0], x1[0]);
#pragma unroll
        for (int rg = 1; rg < 16; ++rg) mx = fmaxf(mx, fmaxf(x0[rg], x1[rg]));
        mx = fmaxf(mx, __shfl_xor(mx, 32));
        const float mn = fmaxf(m, mx), alpha = __builtin_amdgcn_exp2f(m - mn); m = mn;
        float ps = 0.f;
#pragma unroll
        for (int rg = 0; rg < 16; ++rg) { x0[rg] = __builtin_amdgcn_exp2f(x0[rg] - mn); x1[rg] = __builtin_amdgcn_exp2f(x1[rg] - mn); ps += x0[rg] + x1[rg]; }
        lsum = lsum * alpha + ps;
#pragma unroll
        for (int db = 0; db < 4; ++db)
#pragma unroll
            for (int rg = 0; rg < 16; ++rg) o[db][rg] *= alpha;
        u32x4 pw[4];
#pragma unroll
        for (int s2 = 0; s2 < 2; ++s2) {
            pw[s2].x = pk2(x0[8 * s2 + 0], x0[8 * s2 + 1]); pw[s2].y = pk2(x0[8 * s2 + 2], x0[8 * s2 + 3]); pw[s2].z = pk2(x0[8 * s2 + 4], x0[8 * s2 + 5]); pw[s2].w = pk2(x0[8 * s2 + 6], x0[8 * s2 + 7]);
            pw[2 + s2].x = pk2(x1[8 * s2 + 0], x1[8 * s2 + 1]); pw[2 + s2].y = pk2(x1[8 * s2 + 2], x1[8 * s2 + 3]); pw[2 + s2].z = pk2(x1[8 * s2 + 4], x1[8 * s2 + 5]); pw[2 + s2].w = pk2(x1[8 * s2 + 6], x1[8 * s2 + 7]); }
#pragma unroll
        for (int db = 0; db < 4; ++db)
#pragma unroll
            for (int s = 0; s < 4; ++s) {
                const s16x4 lo = vtr(Vb + trb + (16 * s) * RS + db * 64);
                const s16x4 hi4 = vtr(Vb + trb + (16 * s + 8) * RS + db * 64);
                const bf16x8 af = (bf16x8){lo[0], lo[1], lo[2], lo[3], hi4[0], hi4[1], hi4[2], hi4[3]};
                o[db] = __builtin_amdgcn_mfma_f32_32x32x16_bf16(af, __builtin_bit_cast(bf16x8, pw[s]), o[db], 0, 0, 0);
            }
        if (t + 1 < 32) { LAS unsigned char* Kn = lds + ((t + 1) & 1) * 17408; LAS unsigned char* Vn = lds + 34816 + ((t + 1) & 1) * 17408;
#pragma unroll
            for (int i = 0; i < 2; ++i) { *(LAS u32x4*)(Kn + (srow0 + 32 * i) * RS + sch * 16) = kr[i]; *(LAS u32x4*)(Vn + (srow0 + 32 * i) * RS + sch * 16) = vr[i]; } }
        __syncthreads();
    }
    const float lt = lsum + __shfl_xor(lsum, 32);
    const float inv = 1.f / lt;
    const float* lamp = (const float*)(a.ws + WS_MISC + MISC_LAM);
    const float lam = lamp[l], linit = lamp[2 + l];
    LAS float* XO = (LAS float*)lds;
    if (c == 1) {
        const float f = inv * lam;
#pragma unroll
        for (int db = 0; db < 4; ++db)
#pragma unroll
            for (int rg = 0; rg < 16; ++rg) XO[(qblk * 64 + db * 16 + rg) * 64 + lane] = o[db][rg] * f;
    }
    __syncthreads();
    if (c == 0) {
        float ss = 0.f;
#pragma unroll
        for (int db = 0; db < 4; ++db)
#pragma unroll
            for (int rg = 0; rg < 16; ++rg) { const float v = o[db][rg] * inv - XO[(qblk * 64 + db * 16 + rg) * 64 + lane]; o[db][rg] = v; ss += v * v; }
        ss += __shfl_xor(ss, 32);
        const float sc = rsqrtf(ss * (1.f / 128.f) + 1e-5f) * (1.f - linit);
        const float* sg = a.in[I_SUBG] + (size_t)l * 128;
        bf16_t* op = (bf16_t*)(a.ws + WS_OC) + (rowb + q0 + r32) * 768 + h * 128;
#pragma unroll
        for (int db = 0; db < 4; ++db)
#pragma unroll
            for (int i = 0; i < 4; ++i) { const int d = db * 32 + 8 * i + 4 * hi; const f32x4 g4 = *(const f32x4*)(sg + d);
                u32x2 w; w.x = pk2(o[db][4 * i] * sc * g4.x, o[db][4 * i + 1] * sc * g4.y); w.y = pk2(o[db][4 * i + 2] * sc * g4.z, o[db][4 * i + 3] * sc * g4.w);
                *(u32x2*)(op + d) = w; }
    }
    __syncthreads();
}

__device__ __forceinline__ void phase_route(const Args& a, int l, LAS unsigned char* lds, bool commit = true) {
    const int tid = otid(), lane = tid & 63, wave = __builtin_amdgcn_readfirstlane(tid >> 6), r32 = lane & 31, hi = lane >> 5;
    unsigned char* ws = a.ws;
    LAS float* hb = (LAS float*)lds;
    LAS float* lg = (LAS float*)(lds + 131200);
    volatile LAS int* sel = (volatile LAS int*)(lds + 131200 + 4224);
    const float* X = (const float*)(ws + WS_X);
    const float* mod = (const float*)(ws + WS_MISC + MISC_MOD) + (size_t)l * 8 * 6144;
    bf16_t* H = (bf16_t*)(ws + WS_H);
    unsigned* cnt = (unsigned*)(ws + WS_CTL) + CW_CNT + l * 512;
    int* LIST = (int*)(ws + WS_LIST); unsigned* TOKE = (unsigned*)(ws + WS_TOKE); float* TOKP = (float*)(ws + WS_TOKP);
    const float* g2 = a.in[I_N2G] + (size_t)l * DM; const float* rb = a.in[I_RB] + (size_t)l * NE;
    float Bw[64];
    { const float* rw = a.in[I_RW] + (size_t)l * DM * NE + (size_t)(128 * wave + hi) * NE + r32;
#pragma unroll
      for (int s2 = 0; s2 < 64; ++s2) Bw[s2] = rw[(size_t)(2 * s2) * NE]; }
    for (int tb = blockIdx.x; tb < NTOK / 64; tb += gridDim.x) {
        for (int rnd = 0; rnd < 2; ++rnd) {
            const int tbase = tb * 64 + rnd * 32;
            const float* mb = mod + (size_t)(tbase >> 11) * 6144;
#pragma unroll 1
            for (int q = 0; q < 4; ++q) {
                const int tl = 4 * wave + q; const size_t t = (size_t)tbase + tl;
                f32x4 v[4];
#pragma unroll
                for (int j = 0; j < 4; ++j) v[j] = *(const f32x4*)(X + t * DM + 4 * lane + 256 * j);
                const float rstd = row_rstd(v, 1e-6f);
#pragma unroll
                for (int j = 0; j < 4; ++j) { const int c = 4 * lane + 256 * j;
                    const f32x4 gv = *(const f32x4*)(g2 + c), scv = *(const f32x4*)(mb + 4096 + c), shv = *(const f32x4*)(mb + 3072 + c);
                    const f32x4 hv = v[j] * rstd * gv * (scv + 1.0f) + shv;
                    u32x2 w; w.x = pk2(hv.x, hv.y); w.y = pk2(hv.z, hv.w);
                    *(u32x2*)(H + t * DM + c) = w;
                    LAS float* hp = hb + tl * 1025 + c; hp[0] = hv.x; hp[1] = hv.y; hp[2] = hv.z; hp[3] = hv.w; }
            }
            __syncthreads();
            f32x16 d = (f32x16){};
            { const LAS float* ap = hb + r32 * 1025 + 128 * wave + hi;
#pragma unroll
              for (int s2 = 0; s2 < 64; ++s2) d = __builtin_amdgcn_mfma_f32_32x32x2f32(ap[2 * s2], Bw[s2], d, 0, 0, 0); }
            __syncthreads();
#pragma unroll
            for (int rg = 0; rg < 16; ++rg) hb[(wave * 16 + rg) * 64 + lane] = d[rg];
            __syncthreads();
#pragma unroll
            for (int j = 0; j < 2; ++j) { const int idx = tid + 512 * j, rg = idx >> 6, ln = idx & 63; float sm = 0.f;
#pragma unroll
                for (int w8 = 0; w8 < 8; ++w8) sm += hb[(w8 * 16 + rg) * 64 + ln];
                lg[crow(rg, ln >> 5) * 33 + (ln & 31)] = sm + rb[ln & 31]; }
            __syncthreads();
#pragma unroll 1
            for (int q = 0; q < 4; ++q) {
                const int tl = 4 * wave + q; const int t = tbase + tl;
                const int myidx = lane & 31;
                float cur = lg[tl * 33 + myidx];
                float tv[4]; int ti4[4];
#pragma unroll
                for (int k = 0; k < 4; ++k) { float bv = cur; int bi = myidx;
#pragma unroll
                    for (int off = 16; off >= 1; off >>= 1) { const float ov = __shfl_xor(bv, off); const int oi = __shfl_xor(bi, off);
                        const bool take = (ov > bv) || (ov == bv && oi < bi); bv = take ? ov : bv; bi = take ? oi : bi; }
                    tv[k] = bv; ti4[k] = bi; if (myidx == bi) cur = -INFINITY; }
                const float e1 = expf(tv[1] - tv[0]), e2 = expf(tv[2] - tv[0]), e3 = expf(tv[3] - tv[0]);
                const float inv = 1.f / (1.f + e1 + e2 + e3);
                if (lane < 4) { const int e = lane == 0 ? ti4[0] : lane == 1 ? ti4[1] : lane == 2 ? ti4[2] : ti4[3];
                    const float pr = (lane == 0 ? 1.f : lane == 1 ? e1 : lane == 2 ? e2 : e3) * inv;
                    sel[(rnd * 32 + tl) * 4 + lane] = e; TOKP[(size_t)t * 4 + lane] = pr; }
            }
            __syncthreads();
        }
        if (tid < 32) { const int e = tid; int n = 0;
            for (int i = 0; i < 256; ++i) n += (sel[i] == e) ? 1 : 0;
            unsigned run = (commit && n > 0) ? __hip_atomic_fetch_add(cnt + 16 * e, (unsigned)n, __ATOMIC_RELAXED, __HIP_MEMORY_SCOPE_AGENT) : 0u;
            for (int i = 0; i < 256; ++i) if (sel[i] == e) { const int t = tb * 64 + (i >> 2);
                if (commit) LIST[(size_t)e * NTOK + run] = t;
                TOKE[(size_t)t * 4 + (i & 3)] = ((unsigned)e << 16) | (run & 0xffffu); ++run; } }
        __syncthreads();
    }
}

__device__ __forceinline__ void build_moe_tab(const Args& a, int l, volatile LAS int* tab) {
    const unsigned* cnt = (const unsigned*)(a.ws + WS_CTL) + CW_CNT + l * 512;
    const int tid = otid();
    __syncthreads();
    if (tid < 32) tab[64 + tid] = (int)__hip_atomic_load(cnt + 16 * tid, __ATOMIC_RELAXED, __HIP_MEMORY_SCOPE_AGENT);
    __syncthreads();
    if (tid == 0) { int s = 0; for (int e = 0; e < 32; ++e) { tab[e] = s; s += (tab[64 + e] + 255) >> 8; } tab[32] = s; }
    __syncthreads();
}

__device__ __forceinline__ void phase_combine(const Args& a, int l, const LAS int* tab, bool dry = false) {
    const int tid = otid(), lane = tid & 63, wave = tid >> 6;
    unsigned char* ws = a.ws;
    float* X = (float*)(ws + WS_X);
    const bf16_t* YM = (const bf16_t*)(ws + WS_YMOE);
    const unsigned* TOKE = (const unsigned*)(ws + WS_TOKE); const float* TOKP = (const float*)(ws + WS_TOKP);
    const float* modl = (const float*)(ws + WS_MISC + MISC_MOD) + (size_t)l * 8 * 6144;
    for (int t = blockIdx.x * 8 + wave; t < NTOK; t += gridDim.x * 8) {
        f32x4 v[4], acc[4];
#pragma unroll
        for (int j = 0; j < 4; ++j) { v[j] = *(const f32x4*)(X + (size_t)t * DM + 4 * lane + 256 * j); acc[j] = (f32x4){0.f, 0.f, 0.f, 0.f}; }
#pragma unroll
        for (int k = 0; k < 4; ++k) { const unsigned ep = TOKE[(size_t)t * 4 + k]; const float pr = TOKP[(size_t)t * 4 + k];
            const int e = ep >> 16, pos = ep & 0xffff; const size_t srow = (size_t)tab[e] * 256 + pos;
#pragma unroll
            for (int j = 0; j < 4; ++j) { const u32x2 y = *(const u32x2*)(YM + srow * DM + 4 * lane + 256 * j);
                acc[j].x += pr * bflo(y.x); acc[j].y += pr * bfhi(y.x); acc[j].z += pr * bflo(y.y); acc[j].w += pr * bfhi(y.y); } }
        const float* mb = modl + (size_t)(t >> 11) * 6144;
#pragma unroll
        for (int j = 0; j < 4; ++j) { const f32x4 gt = *(const f32x4*)(mb + 5120 + 4 * lane + 256 * j); v[j] = v[j] + gt * acc[j]; }
        const float rstd = row_rstd(v, 1e-6f);
        float* Xo = dry ? (float*)(ws + WS_QA) : X; bf16_t* Ho = dry ? (bf16_t*)(ws + WS_QA + (size_t)NTOK * DM * 4) : (bf16_t*)(ws + WS_H); float* Oo = dry ? (float*)(ws + WS_QA) : a.out;
        if (l + 1 < DEPTH) {
#pragma unroll
            for (int j = 0; j < 4; ++j) *(f32x4*)(Xo + (size_t)t * DM + 4 * lane + 256 * j) = v[j];
            const float* mn = modl + (size_t)8 * 6144 + (size_t)(t >> 11) * 6144;
            norm_mod_store(v, rstd, a.in[I_N1G] + (size_t)(l + 1) * DM, mn + 1024, mn, Ho + (size_t)t * DM, lane);
        } else {
#pragma unroll
            for (int j = 0; j < 4; ++j) { const int c = 4 * lane + 256 * j; const f32x4 g = *(const f32x4*)(a.in[I_FNG] + c);
                *(f32x4*)(Oo + (size_t)t * DM + c) = v[j] * rstd * g; }
        }
    }
}

constexpr int NPL = 9;
constexpr int N_PHASES = 2 + NPL * DEPTH;
__global__ void __launch_bounds__(512, 2) fwd(Args a) {
    extern __shared__ __attribute__((aligned(16))) unsigned char smem[];
    LAS unsigned char* lds = (LAS unsigned char*)smem;
    const int tid = threadIdx.x;
    unsigned* ctl = (unsigned*)(a.ws + WS_CTL);
    volatile LAS unsigned* xbw = (volatile LAS unsigned*)(lds + LDS_CTL_OFF);
    volatile LAS int* tab = (volatile LAS int*)(lds + LDS_CTL_OFF + 256);
    volatile LAS int* qw = (volatile LAS int*)(lds + LDS_CTL_OFF + 1024);
    if (tid < 4) xbw[tid] = 0u;
    __syncthreads();
    const int lo = a.ph_lo, hi = a.ph_hi;
    XcdBarrier bar; bar.bar = ctl + CW_BAR; bar.x = 0; bar.st = xbw;
    if (hi - lo > 1) bar = xcd_barrier_post(ctl + CW_BAR, xbw);
#ifndef DUPMASK
#define DUPMASK 0
#endif
#define NREP(k) (((DUPMASK >> PHSEL(k)) & 1) ? 2 : 1)
#ifndef BRMASK
#define BRMASK 7
#endif
#ifndef PHMASK
#define PHMASK 0xFFFFF
#endif
#define PHSEL(k) ((k) < 2 ? (k) : 2 + ((k) - 2) % NPL)
#define IN(k) (((PHMASK >> PHSEL(k)) & 1) && lo <= (k) && (k) < hi)
#define SEAM(k) do { if (IN(k) && IN((k) + 1)) { xcd_barrier(bar); } } while (0)
    unsigned char* ws = a.ws;
    if (IN(0)) { for (int rep = 0; rep < NREP(0); ++rep) { phase_p0(a, lds); __syncthreads(); } SEAM(0); }
    if (IN(1)) { phase_norm1(a, 0); SEAM(1); }
    for (int l = 0; l < DEPTH; ++l) {
        const int pb = 2 + NPL * l;
        if (IN(pb + 0)) {
          for (int rep = 0; rep < NREP(pb + 0); ++rep) {
            pg8::StaticOrder S; S.init(NTOK, PLD, gridDim.x, blockIdx.x);
            pg8::EpiProj E{(bf16_t*)(ws + WS_PROJ), PLD, 29};
            pg8::gemm_phase<pg8::EpiProj, pg8::StaticOrder>(lds, (const bf16_t*)(ws + WS_H), (const bf16_t*)(ws + WS_WIN) + (size_t)l * PLD * DM, DM, 0, S, E);
          }
            SEAM(pb + 0);
        }
        if (IN(pb + 1)) { for (int rep = 0; rep < NREP(pb + 1) + ((DUPMASK >> 17) & 1); ++rep) { phase_rwkv_r1(a, l, lds); } for (int rep = 0; rep < NREP(pb + 1) + ((DUPMASK >> 16) & 1); ++rep) phase_swa(a, lds); SEAM(pb + 1); }
        if (IN(pb + 2)) {
          for (int rep = 0; rep < NREP(pb + 2); ++rep) {
            {
                pg8::StaticOrder S; S.init(NTOK, RW, gridDim.x, blockIdx.x);
                pg8::EpiProj E{(bf16_t*)(ws + WS_GG), RW, 1 << 30};
                pg8::gemm_phase<pg8::EpiProj, pg8::StaticOrder>(lds, (const bf16_t*)(ws + WS_GS), (const bf16_t*)(ws + WS_MISC + MISC_GUPT) + (size_t)l * RW * 256, 256, 0, S, E);
            }
            for (int u = blockIdx.x; u < 192; u += gridDim.x) rwkv_r2_unit(a, u, lds);
            for (;;) {
                if (tid == 0) *qw = (int)__hip_atomic_fetch_add(ctl + CW_QH + 64 * (2 * l + rep), 1u, __ATOMIC_RELAXED, __HIP_MEMORY_SCOPE_AGENT);
                __syncthreads();
                const int item = *qw;
                __syncthreads();
                if (item >= 768) break;
                diffattn_unit(a, l, item, lds);
            }
          }
            SEAM(pb + 2);
        }
        if (IN(pb + 3)) { for (int rep = 0; rep < NREP(pb + 3); ++rep) phase_rwkv_out(a, l); SEAM(pb + 3); }
        if (IN(pb + 4)) {
          for (int rep = 0; rep < NREP(pb + 4); ++rep) {
            pg8::StaticOrder S; S.init(NTOK, DM, gridDim.x, blockIdx.x);
            const bf16_t* P = (const bf16_t*)(ws + WS_PROJ); float* MF = (float*)(ws + WS_MF); bf16_t* MG = (bf16_t*)(ws + WS_MERGED);
            if (BRMASK & 1) { pg8::EpiBranch<0> E{P, MF, MG}; pg8::gemm_phase<pg8::EpiBranch<0>, pg8::StaticOrder>(lds, (const bf16_t*)(ws + WS_OA), (const bf16_t*)(ws + WS_WA) + (size_t)l * DM * 256, 256, 0, S, E); }
            if (BRMASK & 2) { pg8::EpiBranch<1> E{P, MF, MG}; pg8::gemm_phase<pg8::EpiBranch<1>, pg8::StaticOrder>(lds, (const bf16_t*)(ws + WS_OB), (const bf16_t*)(ws + WS_WB) + (size_t)l * DM * 768, 768, 0, S, E); }
            if (BRMASK & 4) { pg8::EpiBranch<2> E{P, MF, MG}; pg8::gemm_phase<pg8::EpiBranch<2>, pg8::StaticOrder>(lds, (const bf16_t*)(ws + WS_OC), (const bf16_t*)(ws + WS_WC) + (size_t)l * DM * 768, 768, 0, S, E); }
          }
            SEAM(pb + 4);
        }
        if (IN(pb + 5)) {
            pg8::StaticOrder S; S.init(NTOK, DM, gridDim.x, blockIdx.x);
            pg8::EpiOut E{l == 0 ? a.in[I_X] : (const float*)(ws + WS_X), (float*)(ws + WS_X), (const float*)(ws + WS_MISC + MISC_MOD) + (size_t)l * 8 * 6144 + 2048};
            pg8::gemm_phase<pg8::EpiOut, pg8::StaticOrder>(lds, (const bf16_t*)(ws + WS_MERGED), (const bf16_t*)(ws + WS_WO) + (size_t)l * DM * DM, DM, 0, S, E);
            SEAM(pb + 5);
        }
        if (IN(pb + 6)) { for (int rep = 0; rep < NREP(pb + 6); ++rep) phase_route(a, l, lds, rep == NREP(pb + 6) - 1); SEAM(pb + 6); }
        if (IN(pb + 7)) {
          for (int rep = 0; rep < NREP(pb + 7); ++rep) {
            build_moe_tab(a, l, tab);
            unsigned* rtc = ctl + CW_RT + (l * 2 + rep) * 2048;
            {
                pg8::MoeOrder<true> S{(const LAS int*)tab, (const int*)(ws + WS_LIST), 8, (int)gridDim.x, (int)blockIdx.x, rtc};
                pg8::EpiMoe1 E{(bf16_t*)(ws + WS_ACT), a.in[I_B1] + (size_t)l * NE * 2 * FF};
                pg8::gemm_phase<pg8::EpiMoe1, pg8::MoeOrder<true>>(lds, (const bf16_t*)(ws + WS_H), (const bf16_t*)(ws + WS_W1) + (size_t)l * NE * 2 * FF * DM, DM, (size_t)2 * FF * DM * 2, S, E);
            }
            {
                pg8::MoeOrder<false> S{(const LAS int*)tab, nullptr, 4, (int)gridDim.x, (int)(gridDim.x - 1 - blockIdx.x), rtc};
                pg8::EpiMoe2 E{(bf16_t*)(ws + WS_YMOE), a.in[I_B2] + (size_t)l * NE * DM};
                pg8::gemm_phase<pg8::EpiMoe2, pg8::MoeOrder<false>>(lds, (const bf16_t*)(ws + WS_ACT), (const bf16_t*)(ws + WS_W2) + (size_t)l * NE * DM * FF, FF, (size_t)DM * FF * 2, S, E);
            }
          }
            SEAM(pb + 7);
        }
        if (IN(pb + 8)) { build_moe_tab(a, l, tab); for (int rep = 0; rep < NREP(pb + 8); ++rep) phase_combine(a, l, (const LAS int*)tab, rep != NREP(pb + 8) - 1); SEAM(pb + 8); }
    }
#undef IN
#undef SEAM
}

#ifndef MK_ONE_LAUNCH
#define MK_ONE_LAUNCH 1
#endif
extern "C" void kernel_launch(void* const* d_in, const int* in_sizes, int n_in, void* d_out, int out_size, void* d_ws, size_t ws_size, hipStream_t stream) {
    static int grid = 0;
    if (grid == 0) {
        if (n_in != 32 || ws_size < WS_END) { fprintf(stderr, "kernel_launch: unexpected n_in %d or ws %zu < %zu\n", n_in, ws_size, (size_t)WS_END); grid = -1; return; }
        int dev = 0, cus = 0;
        if (hipGetDevice(&dev) != hipSuccess || hipDeviceGetAttribute(&cus, hipDeviceAttributeMultiprocessorCount, dev) != hipSuccess) { grid = -1; return; }
        if (hipFuncSetAttribute((const void*)fwd, hipFuncAttributeMaxDynamicSharedMemorySize, LDS_BYTES) != hipSuccess) { fprintf(stderr, "kernel_launch: hipFuncSetAttribute failed\n"); grid = -1; return; }
        int per_cu = 0;
        if (hipOccupancyMaxActiveBlocksPerMultiprocessor(&per_cu, (const void*)fwd, 512, LDS_BYTES) != hipSuccess || per_cu < 1) fprintf(stderr, "kernel_launch: occupancy query says %d\n", per_cu);
        (void)hipGetLastError();
        grid = cus;
    }
    if (grid < 0) return;
    (void)hipMemsetAsync((char*)d_ws + WS_CTL, 0, CTL_BYTES, stream);
    Args a{};
    for (int i = 0; i < 32; ++i) a.in[i] = (const float*)d_in[i];
    a.out = (float*)d_out; a.ws = (unsigned char*)d_ws;
#if MK_ONE_LAUNCH
    a.ph_lo = 0; a.ph_hi = N_PHASES;
    hipLaunchKernelGGL(fwd, dim3(grid), dim3(512), LDS_BYTES, stream, a);
#else
    for (int p = 0; p < N_PHASES; ++p) { a.ph_lo = p; a.ph_hi = p + 1; hipLaunchKernelGGL(fwd, dim3(grid), dim3(512), LDS_BYTES, stream, a); }
#endif
}
```

```cpp
#include <hip/hip_runtime.h>
#include <stdint.h>
#include <stdio.h>

#define LAS __attribute__((address_space(3)))
typedef unsigned short bf16_t;
typedef short bf16x8 __attribute__((ext_vector_type(8)));
typedef short s16x4 __attribute__((ext_vector_type(4)));
typedef float f32x2 __attribute__((ext_vector_type(2)));
typedef float f32x4 __attribute__((ext_vector_type(4)));
typedef float f32x16 __attribute__((ext_vector_type(16)));
typedef unsigned u32x2 __attribute__((ext_vector_type(2)));
typedef unsigned u32x4 __attribute__((ext_vector_type(4)));
typedef __bf16 bf16x2_t __attribute__((ext_vector_type(2)));
typedef short v4i16_t __attribute__((ext_vector_type(4)));

constexpr int NB = 8, NT = 2048, DM = 1024, NTOK = NB * NT, DEPTH = 2;
constexpr int IN_COLS = 10368, PLD = 10496;
constexpr int C_AQ = 0, C_AK = 768, C_AV = 1536, C_BS = 2304, C_CQ = 5120, C_CK = 5888, C_CV = 6656, C_G = 7424;
constexpr int RSTR = 2688, RW = 768, NE = 32, FF = 1024;
constexpr float LOG2E = 1.4426950408889634f;

constexpr size_t al256(size_t x) { return (x + 255) & ~(size_t)255; }
constexpr size_t WS_CTL = 0;
constexpr size_t CTL_BYTES = 65536;
constexpr size_t WS_MISC = WS_CTL + CTL_BYTES;
constexpr size_t MISC_MOD = 0, MISC_LAM = 393216, MISC_BIASA = 393472, MISC_BIASC = 399872, MISC_WUPT = 409600, MISC_AUPT = 409600 + 393216, MISC_GUPT = 409600 + 2 * 393216, MISC_BYTES = 2 << 20;
constexpr size_t WS_WIN = WS_MISC + MISC_BYTES;
constexpr size_t WS_WA = WS_WIN + (size_t)DEPTH * PLD * DM * 2;
constexpr size_t WS_WB = WS_WA + (size_t)DEPTH * DM * 256 * 2;
constexpr size_t WS_WC = WS_WB + (size_t)DEPTH * DM * 768 * 2;
constexpr size_t WS_WO = WS_WC + (size_t)DEPTH * DM * 768 * 2;
constexpr size_t WS_W1 = WS_WO + (size_t)DEPTH * DM * DM * 2;
constexpr size_t WS_W2 = WS_W1 + (size_t)DEPTH * NE * 2 * FF * DM * 2;
constexpr size_t WS_H = WS_W2 + (size_t)DEPTH * NE * DM * FF * 2;
constexpr size_t WS_X = WS_H + (size_t)NTOK * DM * 2;
constexpr size_t WS_OA = WS_X + (size_t)NTOK * DM * 4;
constexpr size_t WS_OB = WS_OA + (size_t)NTOK * 256 * 2;
constexpr size_t WS_OC = WS_OB + (size_t)NTOK * 768 * 2;
constexpr size_t WS_MERGED = WS_OC + (size_t)NTOK * 768 * 2;
constexpr size_t WS_LIST = WS_MERGED + (size_t)NTOK * DM * 2;
constexpr size_t WS_TOKE = WS_LIST + (size_t)NE * NTOK * 4;
constexpr size_t WS_TOKP = WS_TOKE + (size_t)NTOK * 4 * 4;
constexpr size_t WS_U = WS_TOKP + (size_t)NTOK * 4 * 4;
constexpr size_t WS_PROJ = WS_U;
constexpr size_t WS_RR = WS_PROJ + (size_t)NTOK * PLD * 2;
constexpr size_t WS_RV = WS_RR + (size_t)NTOK * RW * 4;
constexpr size_t WS_RWD = WS_RV + (size_t)NTOK * RW * 4;
constexpr size_t WS_RKK = WS_RWD + (size_t)2 * NTOK * RW * 4;
constexpr size_t WS_RKKA = WS_RKK + (size_t)2 * NTOK * RW * 4;
constexpr size_t WS_RKD = WS_RKKA + (size_t)2 * NTOK * RW * 4;
constexpr size_t WS_GS = WS_RKD + (size_t)2 * NTOK * RW * 4;
constexpr size_t WS_Y = WS_GS + (size_t)NTOK * 128 * 4;
constexpr size_t WS_OAG = WS_Y + (size_t)2 * NTOK * RW * 4;
constexpr size_t WS_LSE = WS_OAG + (size_t)3 * NTOK * 256 * 4;
constexpr size_t WS_MF = WS_LSE + (size_t)3 * NTOK * 4 * 4;
constexpr size_t WS_QA = WS_MF + (size_t)NTOK * DM * 4;
constexpr size_t WS_SS = WS_QA + (size_t)6144 * 4096 * 2;
constexpr size_t WS_END1 = WS_SS + (size_t)6144 * 4096 * 2;
constexpr size_t WS_GG = WS_Y;
constexpr size_t WS_MP = WS_RWD, WS_NP = WS_RKK, WS_Y0 = WS_RKKA;
constexpr int SLOT_ROWS = 4 * NTOK + NE * 256;
constexpr size_t WS_ACT = WS_U;
constexpr size_t WS_YMOE = WS_ACT + (size_t)SLOT_ROWS * FF * 2;
constexpr size_t WS_END2 = WS_YMOE + (size_t)SLOT_ROWS * DM * 2;
constexpr size_t WS_END = WS_END1 > WS_END2 ? WS_END1 : WS_END2;

constexpr int CW_BAR = 0;
constexpr int CW_CNT = 13312;
constexpr int CW_QH = 4224;
constexpr int CW_RT = 5120;

constexpr int LDS_STAGE = 155648;
constexpr int LDS_CTL_OFF = LDS_STAGE;
constexpr int LDS_BYTES = LDS_STAGE + 4096;

__device__ __forceinline__ int otid() { int t = threadIdx.x; asm volatile("" : "+v"(t)); return t; }
__device__ __forceinline__ int obid() { int t = blockIdx.x; asm volatile("" : "+s"(t)); return t; }
__device__ __forceinline__ unsigned pk2(float lo, float hi) { f32x2 v = {lo, hi}; bf16x2_t b = __builtin_convertvector(v, bf16x2_t); return __builtin_bit_cast(unsigned, b); }
__device__ __forceinline__ u32x4 pack8(const float (&x)[8]) { u32x4 w; w.x = pk2(x[0], x[1]); w.y = pk2(x[2], x[3]); w.z = pk2(x[4], x[5]); w.w = pk2(x[6], x[7]); return w; }
__device__ __forceinline__ bf16_t f2bf(float x) { return (bf16_t)(pk2(x, 0.f) & 0xffffu); }
__device__ __forceinline__ float bflo(unsigned u) { return __builtin_bit_cast(float, u << 16); }
__device__ __forceinline__ float bfhi(unsigned u) { return __builtin_bit_cast(float, u & 0xffff0000u); }
__device__ __forceinline__ float bf2f(bf16_t h) { return __builtin_bit_cast(float, (unsigned)h << 16); }
__device__ __forceinline__ float wave_sum(float v) {
#pragma unroll
    for (int o = 1; o < 64; o <<= 1) v += __shfl_xor(v, o);
    return v;
}
__device__ __forceinline__ float sigmoidf_(float x) { return 1.f / (1.f + __expf(-x)); }
__device__ __forceinline__ int crow(int r, int hi) { return (r & 3) + 8 * (r >> 2) + 4 * hi; }
__device__ __forceinline__ s16x4 vtr(const LAS unsigned char* p) { return __builtin_bit_cast(s16x4, __builtin_amdgcn_ds_read_tr16_b64_v4i16((LAS v4i16_t*)p)); }
__device__ __forceinline__ float dpp_sum8(float x) {
    int v = __builtin_bit_cast(int, x);
    x += __builtin_bit_cast(float, __builtin_amdgcn_update_dpp(0, v, 0xB1, 0xF, 0xF, true));
    v = __builtin_bit_cast(int, x);
    x += __builtin_bit_cast(float, __builtin_amdgcn_update_dpp(0, v, 0x4E, 0xF, 0xF, true));
    v = __builtin_bit_cast(int, x);
    x += __builtin_bit_cast(float, __builtin_amdgcn_update_dpp(0, v, 0x141, 0xF, 0xF, true));
    return x;
}

#define XB_TMO      128
#define XB_XCNT(j)  (256  + 64 * (j))
#define XB_XSUB(j)  (1280 + 64 * (j))
#define XB_XGEN(j)  (2304 + 64 * (j))
#define XB_TOP      3328
#define XB_TOPGEN   3392
#define XCD_BAR_WORDS 3456
#define XB_SPIN_CAP (1u << 18)
__device__ __forceinline__ unsigned xb_ld(unsigned* p)              { return __hip_atomic_load(p, __ATOMIC_RELAXED, __HIP_MEMORY_SCOPE_AGENT); }
__device__ __forceinline__ unsigned xb_add(unsigned* p, unsigned v) { return __hip_atomic_fetch_add(p, v, __ATOMIC_RELAXED, __HIP_MEMORY_SCOPE_AGENT); }
__device__ __forceinline__ unsigned xb_xcc_id() { return (unsigned)__builtin_amdgcn_s_getreg((3 << 11) | 20) & 0xFu; }
#define XB_SPIN(cond, bar) do { unsigned _sp = 0; while (cond) { __builtin_amdgcn_s_sleep(1); \
    if ((++_sp & 255u) == 0u) { if (xb_ld(&(bar)[XB_TMO])) break; if (_sp > XB_SPIN_CAP) { atomicAdd(&(bar)[XB_TMO], 1u); break; } } } } while (0)
struct XcdBarrier { unsigned* bar; unsigned x; volatile LAS unsigned* st; };
__device__ __forceinline__ XcdBarrier xcd_barrier_post(unsigned* bar, volatile LAS unsigned* st) {
    XcdBarrier b; b.bar = bar; b.x = xb_xcc_id(); b.st = st;
    if (threadIdx.x == 0) (void)xb_add(&bar[XB_XCNT(b.x)], 1u);
    return b;
}
__device__ __forceinline__ void xcd_barrier_complete(unsigned* bar, unsigned x, unsigned& nloc, unsigned& nx) {
    const unsigned G = gridDim.x * gridDim.y * gridDim.z;
    unsigned sum, cnt, mine, sp = 0u;
    for (;;) {
        sum = 0u; cnt = 0u; mine = 0u;
#pragma unroll
        for (unsigned j = 0; j < 16; ++j) { const unsigned c = xb_ld(&bar[XB_XCNT(j)]); sum += c; cnt += (c > 0u) ? 1u : 0u; mine = (j == x) ? c : mine; }
        if (sum == G) break;
        __builtin_amdgcn_s_sleep(1);
        if ((++sp & 255u) == 0u) { if (xb_ld(&bar[XB_TMO])) break; if (sp > XB_SPIN_CAP) { atomicAdd(&bar[XB_TMO], 1u); break; } }
    }
    nloc = mine > 0u ? mine : 1u; nx = cnt > 0u ? cnt : 1u;
}
__device__ __forceinline__ void xcd_barrier(const XcdBarrier& b) {
    asm volatile("s_waitcnt vmcnt(0)" ::: "memory");
    __syncthreads();
    if (threadIdx.x == 0) {
        unsigned* bar = b.bar;
        __builtin_amdgcn_s_waitcnt(0);
        unsigned nloc = b.st[0], nx = b.st[1];
        if (nloc == 0u) { xcd_barrier_complete(bar, b.x, nloc, nx); b.st[0] = nloc; b.st[1] = nx; }
        const unsigned old = xb_add(&bar[XB_XSUB(b.x)], 1u);
        const unsigned gen = old / nloc;
        if (old + 1u == (gen + 1u) * nloc) {
            __builtin_amdgcn_fence(__ATOMIC_RELEASE, "agent");
            asm volatile("s_waitcnt vmcnt(0)" ::: "memory");
            const unsigned og = xb_add(&bar[XB_TOP], 1u);
            const unsigned tg = og / nx;
            if (og + 1u == (tg + 1u) * nx) xb_add(&bar[XB_TOPGEN], 1u);
            else XB_SPIN(xb_ld(&bar[XB_TOPGEN]) == tg, bar);
            __builtin_amdgcn_fence(__ATOMIC_ACQUIRE, "agent");
            xb_add(&bar[XB_XGEN(b.x)], 1u);
            asm volatile("s_waitcnt vmcnt(0)" ::: "memory");
        } else {
            XB_SPIN(xb_ld(&bar[XB_XGEN(b.x)]) == gen, bar);
            __builtin_amdgcn_fence(__ATOMIC_ACQUIRE, "agent");
            asm volatile("s_waitcnt vmcnt(0)" ::: "memory");
        }
    }
    __syncthreads();
}

namespace pg8 {
constexpr int BM = 256, BK = 64, HALF = 128, HTB = HALF * BK * 2, STAGE_BYTES = 8 * HTB, NXCD = 8, WGM = 8;
__device__ __forceinline__ int lds_byte(int r, int c) { const int st = (r >> 4) * 2 + (c >> 5), rr = r & 15, cc = c & 31, ob = rr * 64 + cc * 2; return st * 1024 + (ob ^ (((ob >> 9) & 1) << 5)); }
__device__ __forceinline__ void stage_rc(int b, int& R, int& C) { const int st = b / 1024, sb = b % 1024, swz = sb ^ (((sb >> 9) & 1) << 5); R = (st >> 1) * 16 + swz / 64; C = (st & 1) * 32 + (swz % 64) / 2; }
__device__ __forceinline__ int perm32(int rho) { const int n = rho >> 4, i = rho & 15; return 8 * (i >> 2) + 4 * n + (i & 3); }

struct Unit { int pm, pn, e, lt; };

struct StaticOrder {
    static constexpr bool GATHER = false;
    int nM, nN, nwg, G, c;
    __device__ void init(int M, int N, int G_, int c_) { nM = M / BM; nN = N / BM; nwg = nM * nN; G = G_; c = c_; }
    __device__ __forceinline__ bool next(int i, Unit& u) const {
        const long L = (long)i * G + c; if (L >= nwg) return false;
        int wgid = (int)L; { const int q = nwg / NXCD, r = nwg % NXCD, xcd = wgid % NXCD, off = wgid / NXCD; wgid = (xcd < r ? xcd * (q + 1) : r * (q + 1) + (xcd - r) * q) + off; }
        const int nig = WGM * nN, gid = wgid / nig, fm = gid * WGM, gsz = (nM - fm) < WGM ? (nM - fm) : WGM;
        u.pm = fm + ((wgid % nig) % gsz); u.pn = (wgid % nig) / gsz; u.e = 0; u.lt = 0; return true;
    }
    __device__ __forceinline__ int arow(const Unit& u, int r) const { return u.pm * BM + r; }
    __device__ __forceinline__ void a_ready(const Unit&) const {}
    __device__ __forceinline__ void done(const Unit&) const {}
};
template <bool GATHER_> struct MoeOrder {
    static constexpr bool GATHER = GATHER_;
    const LAS int* tab;
    const int* list;
    int ncol, G, c;
    __device__ __forceinline__ bool next(int i, Unit& u) const {
        if (true) {
            const int L = i * G + c; const int total = tab[32] * ncol; if (L >= total) return false;
            const int rt = L / ncol; u.pn = L - rt * ncol; u.pm = rt;
            int e = 0;
#pragma unroll 1
            for (int j = 1; j < 32; ++j) e = (tab[j] <= rt) ? j : e;
            u.e = e; u.lt = rt - tab[e]; return true;
        }
        const int x = c & 7, W = G >> 3; int q = i * W + (c >> 3);
#pragma unroll 1
        for (int k = 0; k < 4; ++k) { const int e = x + 8 * k; const int nt_e = tab[e + 1] - tab[e], sz = nt_e * ncol;
            if (q < sz) { const int lt = q / ncol; u.pn = q - lt * ncol; u.lt = lt; u.e = e; u.pm = tab[e] + lt; return true; }
            q -= sz; }
        return false;
    }
    __device__ __forceinline__ int arow(const Unit& u, int r) const {
        if (!GATHER_) return u.pm * BM + r;
        const int pos = u.lt * BM + r; const int cnt = tab[64 + u.e];
        return pos < cnt ? list[(size_t)u.e * NTOK + pos] : 0;
    }
    unsigned* rtc;
    __device__ __forceinline__ void done(const Unit& u) const {
        if (GATHER_) { asm volatile("s_waitcnt vmcnt(0)" ::: "memory");
            if ((threadIdx.x & 63) == 0) __hip_atomic_fetch_add(rtc + 16 * u.pm, 1u, __ATOMIC_RELAXED, __HIP_MEMORY_SCOPE_AGENT); }
    }
    __device__ __forceinline__ void a_ready(const Unit& u) const {
        if (!GATHER_) {
            if (threadIdx.x < 64) {
                unsigned sp = 0;
                while ((unsigned)__builtin_amdgcn_readfirstlane(__hip_atomic_load(rtc + 16 * u.pm, __ATOMIC_RELAXED, __HIP_MEMORY_SCOPE_AGENT)) < 64u) {
                    __builtin_amdgcn_s_sleep(2); if (++sp > (1u << 22)) break; }
                __builtin_amdgcn_fence(__ATOMIC_ACQUIRE, "agent");
                asm volatile("s_waitcnt vmcnt(0)" ::: "memory");
            }
            asm volatile("" ::: "memory"); __builtin_amdgcn_s_barrier(); asm volatile("" ::: "memory");
        }
    }
};

template <class Epi, class Sched>
__device__ __forceinline__ void gemm_phase(LAS unsigned char* lds, const bf16_t* A, const bf16_t* Bt, const int K, const size_t b_estride_bytes, const Sched& S, const Epi& E) {
    constexpr bool GATHER = Sched::GATHER;
    const int tid = otid(), wid = __builtin_amdgcn_readfirstlane(tid >> 6), lane = tid & 63, wr = wid >> 2, wc = wid & 3, fr = lane & 15, fq = lane >> 4;
    const int nt = K / BK;
    int Rr[2], Cc[2]; unsigned voffA[2], voffB[2];
#pragma unroll
    for (int i = 0; i < 2; ++i) { int R, C; stage_rc(tid * 16 + i * 8192, R, C); const int Rb = Epi::PERM ? ((R & ~31) + perm32(R & 31)) : R;
        Rr[i] = R; Cc[i] = C; voffA[i] = (unsigned)(R * K + C) * 2u; voffB[i] = (unsigned)(Rb * K + C) * 2u; }
    const size_t kstep = (size_t)(BK * 2);
    const size_t hstep = (size_t)HALF * K * 2;
    const size_t tstep = 2 * hstep;
    const unsigned ldsw = (unsigned)wid * 1024u;
    const int aoff = lds_byte(wr * 64 + fr, fq * 8), boff = lds_byte(wc * 32 + fr, fq * 8);
#define PG8_SA(b, h) (((b) * 2 + (h)) * HTB)
#define PG8_SB(b, h) ((4 + (b) * 2 + (h)) * HTB)
#define PG8_STAGE(bufoff, gbase, voff) do { _Pragma("unroll") for (int _i = 0; _i < 2; ++_i) \
        __builtin_amdgcn_global_load_lds((const unsigned*)((const char*)(gbase) + (voff)[_i]), (LAS unsigned*)(lds + (bufoff) + ldsw + _i * 8192), 16, 0, 0); } while (0)
#define PG8_STAGEA(bufoff, uptr, offs, h, kb) do { _Pragma("unroll") for (int _i = 0; _i < 2; ++_i) { const char* _src; \
        if constexpr (GATHER) _src = (const char*)A + (size_t)(offs)[h][_i] + (size_t)(kb); else _src = (uptr) + (size_t)(h) * hstep + (size_t)(kb) + voffA[_i]; \
        __builtin_amdgcn_global_load_lds((const unsigned*)_src, (LAS unsigned*)(lds + (bufoff) + ldsw + _i * 8192), 16, 0, 0); } } while (0)
#define PG8_LDA(dst, b, h) do { _Pragma("unroll") for (int m = 0; m < 4; ++m) _Pragma("unroll") for (int k = 0; k < 2; ++k) dst[m][k] = *(const LAS bf16x8*)(lds + PG8_SA(b, h) + aoff + m * 2048 + k * 1024); } while (0)
#define PG8_LDB(dst, b, h) do { _Pragma("unroll") for (int n = 0; n < 2; ++n) _Pragma("unroll") for (int k = 0; k < 2; ++k) dst[n][k] = *(const LAS bf16x8*)(lds + PG8_SB(b, h) + boff + n * 2048 + k * 1024); } while (0)
#define PG8_MMA(ai, bj, At, Bt_) do { __builtin_amdgcn_s_setprio(1); _Pragma("unroll") for (int m = 0; m < 4; ++m) _Pragma("unroll") for (int n = 0; n < 2; ++n) _Pragma("unroll") for (int k = 0; k < 2; ++k) \
        acc[ai][bj][m][n] = __builtin_amdgcn_mfma_f32_16x16x32_bf16(Bt_[n][k], At[m][k], acc[ai][bj][m][n], 0, 0, 0); __builtin_amdgcn_s_setprio(0); } while (0)
#define PG8_WAIT_V(n) asm volatile("s_waitcnt vmcnt(" #n ")" ::: "memory")
#define PG8_WAIT_L(n) asm volatile("s_waitcnt lgkmcnt(" #n ")" ::: "memory")
#define PG8_BAR __builtin_amdgcn_s_barrier()
#define PG8_SCHED __builtin_amdgcn_sched_barrier(0)
#define PG8_AOFFS(dst, u) do { if constexpr (GATHER) { _Pragma("unroll") for (int _h = 0; _h < 2; ++_h) _Pragma("unroll") for (int _i = 0; _i < 2; ++_i) \
        dst[_h][_i] = ((unsigned)S.arow(u, _h * HALF + Rr[_i]) * (unsigned)K + (unsigned)Cc[_i]) * 2u; } } while (0)
    Unit cur, nxt; int ui = 0;
    if (!S.next(0, cur)) return;
    f32x4 acc[2][2][4][2];
#pragma unroll
    for (int a = 0; a < 2; ++a)
#pragma unroll
        for (int b = 0; b < 2; ++b)
#pragma unroll
            for (int m = 0; m < 4; ++m)
#pragma unroll
                for (int n = 0; n < 2; ++n) acc[a][b][m][n] = (f32x4){0.f, 0.f, 0.f, 0.f};
    bf16x8 At[4][2], B0[2][2], B1[2][2];
    unsigned aoc[2][2] = {{0u, 0u}, {0u, 0u}}, aon[2][2] = {{0u, 0u}, {0u, 0u}};
    PG8_AOFFS(aoc, cur);
    const char* cA = (const char*)A + (size_t)cur.pm * tstep;
    const char* cB = (const char*)Bt + (size_t)cur.e * b_estride_bytes + (size_t)cur.pn * tstep;
    S.a_ready(cur);
    PG8_STAGE(PG8_SB(0, 0), cB, voffB); PG8_STAGEA(PG8_SA(0, 0), cA, aoc, 0, 0); PG8_STAGE(PG8_SB(0, 1), cB + hstep, voffB); PG8_STAGEA(PG8_SA(0, 1), cA, aoc, 1, 0);
    if (wr == 1) PG8_BAR;
    PG8_WAIT_V(4); PG8_BAR;
    PG8_STAGE(PG8_SB(1, 0), cB + kstep, voffB); PG8_STAGEA(PG8_SA(1, 0), cA, aoc, 0, kstep); PG8_STAGE(PG8_SB(1, 1), cB + hstep + kstep, voffB);
    PG8_WAIT_V(6); PG8_BAR;
    for (;;) {
        const bool has_next = S.next(ui + 1, nxt);
        const char* nA = has_next ? (const char*)A + (size_t)nxt.pm * tstep : cA;
        const char* nB = has_next ? (const char*)Bt + (size_t)nxt.e * b_estride_bytes + (size_t)nxt.pn * tstep : cB;
        if constexpr (GATHER) {
            if (has_next) { PG8_AOFFS(aon, nxt); } else {
#pragma unroll
                for (int h = 0; h < 2; ++h)
#pragma unroll
                    for (int i = 0; i < 2; ++i) aon[h][i] = aoc[h][i]; } }
#define PG8_KITER(t) do { \
            const bool last = (t == nt - 2); \
            const size_t k1 = (size_t)(t + 1) * kstep; \
            const size_t k2 = last ? (size_t)0 : (size_t)(t + 2) * kstep; \
            const size_t k3 = k2 + kstep; \
            const char* a2p = last ? nA : cA; \
            unsigned a2o[2][2]; \
_Pragma("unroll") \
            for (int h = 0; h < 2; ++h) \
_Pragma("unroll") \
                for (int i = 0; i < 2; ++i) a2o[h][i] = last ? aon[h][i] : aoc[h][i]; \
            const char* b2 = last ? nB : cB + (size_t)(t + 2) * kstep; const char* b3 = b2 + kstep; \
            if (last && has_next) S.a_ready(nxt); \
            PG8_LDB(B0, 0, 0); PG8_SCHED; PG8_LDA(At, 0, 0); PG8_STAGEA(PG8_SA(1, 1), cA, aoc, 1, k1); \
            PG8_WAIT_L(8); PG8_BAR; PG8_WAIT_L(0); PG8_MMA(0, 0, At, B0); PG8_BAR; PG8_SCHED; \
            PG8_LDB(B1, 0, 1); PG8_STAGE(PG8_SB(0, 0), b2, voffB); \
            PG8_BAR; PG8_WAIT_L(0); PG8_MMA(0, 1, At, B1); PG8_BAR; \
            PG8_LDA(At, 0, 1); PG8_STAGEA(PG8_SA(0, 0), a2p, a2o, 0, k2); \
            PG8_BAR; PG8_WAIT_L(0); PG8_MMA(1, 0, At, B0); PG8_BAR; PG8_SCHED; \
            PG8_STAGE(PG8_SB(0, 1), b2 + hstep, voffB); \
            PG8_WAIT_V(6); PG8_BAR; PG8_MMA(1, 1, At, B1); PG8_BAR; \
            PG8_LDB(B0, 1, 0); PG8_SCHED; PG8_LDA(At, 1, 0); PG8_STAGEA(PG8_SA(0, 1), a2p, a2o, 1, k2); \
            PG8_WAIT_L(8); PG8_BAR; PG8_WAIT_L(0); PG8_MMA(0, 0, At, B0); PG8_BAR; PG8_SCHED; \
            PG8_LDB(B1, 1, 1); PG8_STAGE(PG8_SB(1, 0), b3, voffB); \
            PG8_BAR; PG8_WAIT_L(0); PG8_MMA(0, 1, At, B1); PG8_BAR; \
            PG8_LDA(At, 1, 1); PG8_STAGEA(PG8_SA(1, 0), a2p, a2o, 0, k3); \
            PG8_BAR; PG8_WAIT_L(0); PG8_MMA(1, 0, At, B0); PG8_BAR; PG8_SCHED; \
            PG8_STAGE(PG8_SB(1, 1), b3 + hstep, voffB); \
            PG8_WAIT_V(6); PG8_BAR; PG8_MMA(1, 1, At, B1); PG8_BAR; \
        } while (0)
        if constexpr (Epi::MIDHOOK) {
#pragma unroll 1
            for (int t = 0; t < Epi::T1; t += 2) PG8_KITER(t);
            asm volatile("" ::: "memory"); __builtin_amdgcn_sched_barrier(0); E.mid(acc, cur, 0, wr, wc, fr, fq); asm volatile("" ::: "memory"); __builtin_amdgcn_sched_barrier(0);
#pragma unroll 1
            for (int t = Epi::T1; t < Epi::T2; t += 2) PG8_KITER(t);
            asm volatile("" ::: "memory"); __builtin_amdgcn_sched_barrier(0); E.mid(acc, cur, 1, wr, wc, fr, fq); asm volatile("" ::: "memory"); __builtin_amdgcn_sched_barrier(0);
#pragma unroll 1
            for (int t = Epi::T2; t < nt; t += 2) PG8_KITER(t);
        } else {
#pragma unroll 1
            for (int t = 0; t < nt; t += 2) PG8_KITER(t);
        }
#undef PG8_KITER
        E(acc, cur, wr, wc, fr, fq); S.done(cur);
        if (!has_next) break;
#pragma unroll
        for (int a = 0; a < 2; ++a)
#pragma unroll
            for (int b = 0; b < 2; ++b)
#pragma unroll
                for (int m = 0; m < 4; ++m)
#pragma unroll
                    for (int n = 0; n < 2; ++n) acc[a][b][m][n] = (f32x4){0.f, 0.f, 0.f, 0.f};
        cur = nxt; cA = nA; cB = nB; ++ui;
#pragma unroll
        for (int h = 0; h < 2; ++h)
#pragma unroll
            for (int i = 0; i < 2; ++i) aoc[h][i] = aon[h][i];
    }
    PG8_WAIT_V(0);
    if (wr == 0) PG8_BAR;
    PG8_BAR;
#undef PG8_SA
#undef PG8_SB
#undef PG8_STAGE
#undef PG8_STAGEA
#undef PG8_LDA
#undef PG8_LDB
#undef PG8_MMA
#undef PG8_WAIT_V
#undef PG8_WAIT_L
#undef PG8_BAR
#undef PG8_SCHED
#undef PG8_AOFFS
}

typedef f32x4 Acc[2][2][4][2];

struct EpiProj {
    static constexpr bool PERM = true, MIDHOOK = false;
    bf16_t* O; int ld; int sg_from;
    __device__ __forceinline__ void operator()(const Acc& acc, const Unit& u, int wr, int wc, int fr, int fq) const {
        const int row0 = u.pm * BM + wr * 64 + fr, col0 = u.pn * BM + wc * 32 + 8 * fq; const bool sg = u.pn >= sg_from;
#pragma unroll
        for (int ai = 0; ai < 2; ++ai)
#pragma unroll
            for (int m = 0; m < 4; ++m) { bf16_t* rowp = O + (size_t)(row0 + ai * HALF + m * 16) * ld + col0;
#pragma unroll
                for (int bj = 0; bj < 2; ++bj) { f32x4 v0 = acc[ai][bj][m][0], v1 = acc[ai][bj][m][1];
                    if (sg) {
#pragma unroll
                        for (int j = 0; j < 4; ++j) { v0[j] = sigmoidf_(v0[j]); v1[j] = sigmoidf_(v1[j]); } }
                    u32x4 w; w.x = pk2(v0[0], v0[1]); w.y = pk2(v0[2], v0[3]); w.z = pk2(v1[0], v1[1]); w.w = pk2(v1[2], v1[3]);
                    *(u32x4*)(rowp + bj * HALF) = w; } }
    }
};
template <int SEG> struct EpiBranch {
    static constexpr bool PERM = true, MIDHOOK = false;
    const bf16_t* P; float* MF; bf16_t* MG;
    __device__ __forceinline__ void operator()(const Acc& acc, const Unit& u, int wr, int wc, int fr, int fq) const {
        const int row0 = u.pm * BM + wr * 64 + fr, col0 = u.pn * BM + wc * 32 + 8 * fq;
#pragma unroll
        for (int ai = 0; ai < 2; ++ai)
#pragma unroll
            for (int m = 0; m < 4; ++m) { const size_t r = (size_t)(row0 + ai * HALF + m * 16);
                asm volatile("" ::: "memory");
#pragma unroll
                for (int bj = 0; bj < 2; ++bj) { const int c = col0 + bj * HALF;
                    const u32x4 g = *(const u32x4*)(P + r * PLD + C_G + SEG * 1024 + c);
                    f32x4 v0 = acc[ai][bj][m][0], v1 = acc[ai][bj][m][1];
                    v0[0] *= bflo(g.x); v0[1] *= bfhi(g.x); v0[2] *= bflo(g.y); v0[3] *= bfhi(g.y);
                    v1[0] *= bflo(g.z); v1[1] *= bfhi(g.z); v1[2] *= bflo(g.w); v1[3] *= bfhi(g.w);
                    float* mp = MF + r * DM + c;
                    if (SEG > 0) { v0 += *(const f32x4*)mp; v1 += *(const f32x4*)(mp + 4); }
                    if (SEG < 2) { *(f32x4*)mp = v0; *(f32x4*)(mp + 4) = v1; }
                    else { u32x4 w; w.x = pk2(v0[0], v0[1]); w.y = pk2(v0[2], v0[3]); w.z = pk2(v1[0], v1[1]); w.w = pk2(v1[2], v1[3]); *(u32x4*)(MG + r * DM + c) = w; } } }
    }
};
struct EpiBranchM {
    static constexpr bool PERM = true, MIDHOOK = true;
    static constexpr int T1 = 4, T2 = 16;
    const bf16_t* P; bf16_t* MG;
    __device__ __forceinline__ void mid(Acc& acc, const Unit& u, int seg, int wr, int wc, int fr, int fq) const {
        const unsigned off0 = ((unsigned)(u.pm * BM + wr * 64 + fr) * (unsigned)PLD + (unsigned)(C_G + seg * 1024 + u.pn * BM + wc * 32 + 8 * fq)) * 2u;
        const char* Pb = (const char*)P;
#pragma unroll
        for (int ai = 0; ai < 2; ++ai)
#pragma unroll
            for (int m = 0; m < 4; ++m) {
#pragma unroll
                for (int bj = 0; bj < 2; ++bj) { const unsigned off = off0 + (unsigned)(((ai * HALF + m * 16) * PLD + bj * HALF) * 2);
                    const u32x4 gp = *(const u32x4*)(Pb + off), gn = *(const u32x4*)(Pb + off + 2048u);
#pragma unroll
                    for (int q = 0; q < 4; ++q) { const float r0 = bflo(gp[q]) * __builtin_amdgcn_rcpf(fmaxf(bflo(gn[q]), 1e-30f)), r1 = bfhi(gp[q]) * __builtin_amdgcn_rcpf(fmaxf(bfhi(gn[q]), 1e-30f));
                        acc[ai][bj][m][q >> 1][2 * (q & 1)] *= r0; acc[ai][bj][m][q >> 1][2 * (q & 1) + 1] *= r1; }
                    asm volatile("" : "+v"(acc[ai][bj][m][0]), "+v"(acc[ai][bj][m][1]) :: "memory"); } }
    }
    __device__ __forceinline__ void operator()(const Acc& acc, const Unit& u, int wr, int wc, int fr, int fq) const {
        const int row0 = u.pm * BM + wr * 64 + fr, col0 = u.pn * BM + wc * 32 + 8 * fq;
#pragma unroll
        for (int ai = 0; ai < 2; ++ai)
#pragma unroll
            for (int m = 0; m < 4; ++m) { const size_t r = (size_t)(row0 + ai * HALF + m * 16);
                asm volatile("" ::: "memory");
#pragma unroll
                for (int bj = 0; bj < 2; ++bj) { const int c = col0 + bj * HALF;
                    const u32x4 g = *(const u32x4*)(P + r * PLD + C_G + 2 * 1024 + c);
                    f32x4 v0 = acc[ai][bj][m][0], v1 = acc[ai][bj][m][1];
                    v0[0] *= bflo(g.x); v0[1] *= bfhi(g.x); v0[2] *= bflo(g.y); v0[3] *= bfhi(g.y);
                    v1[0] *= bflo(g.z); v1[1] *= bfhi(g.z); v1[2] *= bflo(g.w); v1[3] *= bfhi(g.w);
                    u32x4 w; w.x = pk2(v0[0], v0[1]); w.y = pk2(v0[2], v0[3]); w.z = pk2(v1[0], v1[1]); w.w = pk2(v1[2], v1[3]); *(u32x4*)(MG + r * DM + c) = w; } }
    }
};
struct EpiOut {
    static constexpr bool PERM = false, MIDHOOK = false;
    const float* xsrc; float* X; const float* gt;
    __device__ __forceinline__ void operator()(const Acc& acc, const Unit& u, int wr, int wc, int fr, int fq) const {
        const int row0 = u.pm * BM + wr * 64 + fr, col0 = u.pn * BM + wc * 32 + 4 * fq;
        const float* gp = gt + (size_t)((u.pm * BM) >> 11) * 6144 + col0;
        f32x4 gv[2][2];
#pragma unroll
        for (int bj = 0; bj < 2; ++bj)
#pragma unroll
            for (int n = 0; n < 2; ++n) gv[bj][n] = *(const f32x4*)(gp + bj * HALF + n * 16);
#pragma unroll
        for (int ai = 0; ai < 2; ++ai)
#pragma unroll
            for (int m = 0; m < 4; ++m) { const size_t o = (size_t)(row0 + ai * HALF + m * 16) * DM + col0;
#pragma unroll
                for (int bj = 0; bj < 2; ++bj)
#pragma unroll
                    for (int n = 0; n < 2; ++n) { const f32x4 xv = *(const f32x4*)(xsrc + o + bj * HALF + n * 16);
                        *(f32x4*)(X + o + bj * HALF + n * 16) = xv + gv[bj][n] * acc[ai][bj][m][n]; } }
    }
};
struct EpiMoe1 {
    static constexpr bool PERM = true, MIDHOOK = false;
    bf16_t* ACT; const float* b1;
    __device__ __forceinline__ void operator()(const Acc& acc, const Unit& u, int wr, int wc, int fr, int fq) const {
        const int row0 = u.pm * BM + wr * 64 + fr, col0 = u.pn * BM + wc * 32 + 8 * fq;
        const float* bp = b1 + (size_t)u.e * (2 * FF) + col0;
        f32x4 bv[2][2];
#pragma unroll
        for (int bj = 0; bj < 2; ++bj)
#pragma unroll
            for (int n = 0; n < 2; ++n) bv[bj][n] = *(const f32x4*)(bp + bj * HALF + 4 * n);
#pragma unroll
        for (int ai = 0; ai < 2; ++ai)
#pragma unroll
            for (int m = 0; m < 4; ++m) { bf16_t* rowp = ACT + (size_t)(row0 + ai * HALF + m * 16) * FF + (col0 >> 1);
#pragma unroll
                for (int bj = 0; bj < 2; ++bj) { const f32x4 v0 = acc[ai][bj][m][0] + bv[bj][0], v1 = acc[ai][bj][m][1] + bv[bj][1];
                    float a[4];
#pragma unroll
                    for (int q = 0; q < 4; ++q) { const float gl = (q < 2) ? v0[2 * q] : v1[2 * q - 4], ln = (q < 2) ? v0[2 * q + 1] : v1[2 * q - 3];
                        const float xg = fminf(gl, 7.0f), xl = fminf(fmaxf(ln, -7.0f), 7.0f);
                        a[q] = xg * sigmoidf_(1.702f * xg) * (xl + 1.0f); }
                    const unsigned long long w = (unsigned long long)pk2(a[0], a[1]) | ((unsigned long long)pk2(a[2], a[3]) << 32);
                    __hip_atomic_store((unsigned long long*)(rowp + bj * (HALF / 2)), w, __ATOMIC_RELAXED, __HIP_MEMORY_SCOPE_AGENT); } }
    }
};
struct EpiMoe2 {
    static constexpr bool PERM = true, MIDHOOK = false;
    bf16_t* Y; const float* b2;
    __device__ __forceinline__ void operator()(const Acc& acc, const Unit& u, int wr, int wc, int fr, int fq) const {
        const int row0 = u.pm * BM + wr * 64 + fr, col0 = u.pn * BM + wc * 32 + 8 * fq;
        const float* bp = b2 + (size_t)u.e * DM + col0;
        f32x4 bv[2][2];
#pragma unroll
        for (int bj = 0; bj < 2; ++bj)
#pragma unroll
            for (int n = 0; n < 2; ++n) bv[bj][n] = *(const f32x4*)(bp + bj * HALF + 4 * n);
#pragma unroll
        for (int ai = 0; ai < 2; ++ai)
#pragma unroll
            for (int m = 0; m < 4; ++m) { bf16_t* rowp = Y + (size_t)(row0 + ai * HALF + m * 16) * DM + col0;
#pragma unroll
                for (int bj = 0; bj < 2; ++bj) { const f32x4 v0 = acc[ai][bj][m][0] + bv[bj][0], v1 = acc[ai][bj][m][1] + bv[bj][1];
                    u32x4 w; w.x = pk2(v0[0], v0[1]); w.y = pk2(v0[2], v0[3]); w.z = pk2(v1[0], v1[1]); w.w = pk2(v1[2], v1[3]);
                    *(u32x4*)(rowp + bj * HALF) = w; } }
    }
};
}

struct Args { const float* in[32]; float* out; unsigned char* ws; int ph_lo, ph_hi; };
enum { I_X = 0, I_C, I_WMOD, I_BMOD, I_N1G, I_N2G, I_WIN, I_MU, I_W0, I_WUP, I_A0, I_AUP, I_GUP, I_KK, I_KA, I_RK, I_LNG, I_LNB, I_DLAM, I_SUBG, I_RELB, I_WBA, I_WBB, I_WBC, I_WOUT, I_RW, I_RB, I_W1, I_B1, I_W2, I_B2, I_FNG };

__device__ __forceinline__ void lds_fence() { asm volatile("s_waitcnt lgkmcnt(0)" ::: "memory"); }

__device__ __forceinline__ void tr_item(const float* W, int ldw, int ncols, bf16_t* WT, int K, LAS float* scr, int item, int lane) {
    const int nblk = ncols >> 5, kb = item / nblk, nb = item - kb * nblk, k0 = 64 * kb, n0 = 32 * nb;
#pragma unroll 8
    for (int i = 0; i < 32; ++i) { const int kk = 2 * i + (lane >> 5); scr[kk * 33 + (lane & 31)] = W[(size_t)(k0 + kk) * ldw + n0 + (lane & 31)]; }
    lds_fence();
    const int c = lane & 7;
#pragma unroll
    for (int j = 0; j < 4; ++j) { const int n = (lane >> 3) + 8 * j; const LAS float* s = scr + (8 * c) * 33 + n;
        u32x4 o; o.x = pk2(s[0 * 33], s[1 * 33]); o.y = pk2(s[2 * 33], s[3 * 33]); o.z = pk2(s[4 * 33], s[5 * 33]); o.w = pk2(s[6 * 33], s[7 * 33]);
        *(u32x4*)(WT + (size_t)(n0 + n) * K + k0 + 8 * c) = o; }
    lds_fence();
}
__device__ __forceinline__ int t5_bucket(int rel) {
    const int ret = rel > 0 ? 16 : 0; const int n = rel < 0 ? -rel : rel;
    int v;
    if (n < 8) v = n; else if (n < 12) v = 8; else if (n < 16) v = 9; else if (n < 23) v = 10; else if (n < 32) v = 11;
    else if (n < 46) v = 12; else if (n < 64) v = 13; else if (n < 91) v = 14; else v = 15;
    return ret + v;
}
__device__ __forceinline__ void phase_p0(const Args& a, LAS unsigned char* lds) {
    const int tid = otid(), lane = tid & 63, wave = tid >> 6, G = gridDim.x;
    unsigned char* ws = a.ws;
    {
        LAS float* scr = (LAS float*)(lds + wave * 8448);
        const int gw = blockIdx.x * 8 + wave, NGW = G * 8;
        constexpr int NITEMS = 65536 + 32768 + 2 * 6592;
        for (int it = gw; it < NITEMS; it += NGW) {
            int r = it;
            if (r < 65536) { const int mat = r >> 10; tr_item(a.in[I_W1] + (size_t)mat * DM * 2 * FF, 2 * FF, 2 * FF, (bf16_t*)(ws + WS_W1) + (size_t)mat * 2 * FF * DM, DM, scr, r & 1023, lane); continue; }
            r -= 65536;
            if (r < 32768) { const int mat = r >> 9; tr_item(a.in[I_W2] + (size_t)mat * FF * DM, DM, DM, (bf16_t*)(ws + WS_W2) + (size_t)mat * DM * FF, FF, scr, r & 511, lane); continue; }
            r -= 32768;
            const int l = r / 6592; r -= l * 6592;
            if (r < 2496) { tr_item(a.in[I_WIN] + (size_t)l * DM * IN_COLS, IN_COLS, 4992, (bf16_t*)(ws + WS_WIN) + (size_t)l * PLD * DM, DM, scr, r, lane); continue; }
            r -= 2496;
            if (r < 2688) { tr_item(a.in[I_WIN] + (size_t)l * DM * IN_COLS + 4992, IN_COLS, 5376, (bf16_t*)(ws + WS_WIN) + (size_t)l * PLD * DM + (size_t)5120 * DM, DM, scr, r, lane); continue; }
            r -= 2688;
            if (r < 128) { tr_item(a.in[I_WBA] + (size_t)l * 256 * DM, DM, DM, (bf16_t*)(ws + WS_WA) + (size_t)l * DM * 1792, 1792, scr, r, lane); continue; }
            r -= 128;
            if (r < 384) { tr_item(a.in[I_WBB] + (size_t)l * 768 * DM, DM, DM, (bf16_t*)(ws + WS_WA) + (size_t)l * DM * 1792 + 256, 1792, scr, r, lane); continue; }
            r -= 384;
            if (r < 384) { tr_item(a.in[I_WBC] + (size_t)l * 768 * DM, DM, DM, (bf16_t*)(ws + WS_WA) + (size_t)l * DM * 1792 + 1024, 1792, scr, r, lane); continue; }
            r -= 384;
            tr_item(a.in[I_WOUT] + (size_t)l * DM * DM, DM, DM, (bf16_t*)(ws + WS_WO) + (size_t)l * DM * DM, DM, scr, r, lane);
        }
        for (int i = blockIdx.x * 512 + tid; i < 2 * 128 * DM / 8; i += G * 512) {
            const int l = i / (128 * DM / 8), o = i - l * (128 * DM / 8);
            *(u32x4*)((bf16_t*)(ws + WS_WIN) + (size_t)l * PLD * DM + (size_t)4992 * DM + (size_t)o * 8) = (u32x4){0u, 0u, 0u, 0u};
        }
    }
    {
        bf16_t* WT = (bf16_t*)(ws + WS_MISC + MISC_WUPT); bf16_t* AT = (bf16_t*)(ws + WS_MISC + MISC_AUPT);
        for (int i = blockIdx.x * 512 + tid; i < 2 * 2 * 12 * 4096; i += G * 512) {
            const int j = i & 63, k = (i >> 6) & 63, hd = (i >> 12) % 12, ld = i / (12 * 4096);
            const size_t src = ((size_t)ld * 64 + j) * RW + hd * 64 + k;
            WT[i] = (bf16_t)(pk2(a.in[I_WUP][src], 0.f) & 0xffffu); AT[i] = (bf16_t)(pk2(a.in[I_AUP][src], 0.f) & 0xffffu);
        }
    }
    {
        bf16_t* GT = (bf16_t*)(ws + WS_MISC + MISC_GUPT);
        for (int i = blockIdx.x * 512 + tid; i < 2 * 768 * 256; i += G * 512) {
            const int k = i & 255, n = (i >> 8) % 768, l2 = i / (768 * 256);
            GT[i] = k < 128 ? f2bf(a.in[I_GUP][((size_t)l2 * 128 + k) * RW + n]) : (bf16_t)0;
        }
    }
    __syncthreads();
    if ((int)blockIdx.x < 192) {
        LAS float* sc = (LAS float*)(lds + 69632);
        LAS float* red = (LAS float*)(lds + 102400);
        for (int i = tid; i < NB * DM; i += 512) { const float v = a.in[I_C][i]; sc[i] = v / (1.f + expf(-v)); }
        __syncthreads();
        float* mod = (float*)(ws + WS_MISC + MISC_MOD);
        for (int j = blockIdx.x; j < 192; j += G) {
            const int l = j / 96, n0 = (j - l * 96) * 64, jj = tid & 63, ks = tid >> 6;
            float acc[8];
#pragma unroll
            for (int b = 0; b < 8; ++b) acc[b] = 0.f;
            const float* wp = a.in[I_WMOD] + ((size_t)l * DM + ks * 128) * 6144 + n0 + jj;
            for (int k = 0; k < 128; ++k) { const float w = wp[(size_t)k * 6144];
#pragma unroll
                for (int b = 0; b < 8; ++b) acc[b] += sc[b * DM + ks * 128 + k] * w; }
#pragma unroll
            for (int b = 0; b < 8; ++b) red[(ks * 8 + b) * 64 + jj] = acc[b];
            __syncthreads();
            { const int b = tid >> 6; float s = 0.f;
#pragma unroll
              for (int k2 = 0; k2 < 8; ++k2) s += red[(k2 * 8 + b) * 64 + jj];
              mod[((size_t)l * 8 + b) * 6144 + n0 + jj] = s + a.in[I_BMOD][(size_t)l * 6144 + n0 + jj]; }
            __syncthreads();
        }
    }
    if ((int)blockIdx.x == G - 1) {
        float* lam = (float*)(ws + WS_MISC + MISC_LAM);
        if (tid < 2) { const int l = tid; const float* dl = a.in[I_DLAM] + (size_t)l * 256; float s01 = 0.f, s23 = 0.f;
            for (int d = 0; d < 64; ++d) { s01 += dl[d] * dl[64 + d]; s23 += dl[128 + d] * dl[192 + d]; }
            const float li = 0.8f - 0.6f * expf(-0.3f * (float)l);
            lam[l] = expf(s01) - expf(s23) + li; lam[2 + l] = li; }
        float* bA = (float*)(ws + WS_MISC + MISC_BIASA);
        for (int i = tid; i < 12 * 129; i += 512) { const int head = i / 129, jj = i - head * 129, g = head >> 2; const int dil = (g == 0) ? 1 : (g == 1) ? 4 : 16;
            bA[i] = a.in[I_RELB][t5_bucket((jj - 64) * dil) * 18 + head] * LOG2E; }
        float* bC = (float*)(ws + WS_MISC + MISC_BIASC);
        for (int i = tid; i < 6 * 257; i += 512) { const int h = i / 257, rel = i - h * 257 - 128;
            bC[i] = a.in[I_RELB][t5_bucket(rel) * 18 + 12 + h] * LOG2E; }
    }
}

__device__ __forceinline__ float row_rstd(const f32x4 (&v)[4], float eps) {
    float s = 0.f;
#pragma unroll
    for (int j = 0; j < 4; ++j) s += (v[j].x * v[j].x + v[j].y * v[j].y) + (v[j].z * v[j].z + v[j].w * v[j].w);
    return rsqrtf(wave_sum(s) * (1.f / DM) + eps);
}
__device__ __forceinline__ void norm_mod_store(const f32x4 (&v)[4], float rstd, const float* g, const float* sc, const float* sh, bf16_t* orow, int lane) {
#pragma unroll
    for (int j = 0; j < 4; ++j) { const int c = 4 * lane + 256 * j;
        const f32x4 gv = *(const f32x4*)(g + c), scv = *(const f32x4*)(sc + c), shv = *(const f32x4*)(sh + c);
        const f32x4 y = v[j] * rstd * gv * (scv + 1.0f) + shv;
        u32x2 w; w.x = pk2(y.x, y.y); w.y = pk2(y.z, y.w);
        *(u32x2*)(orow + c) = w; }
}
__device__ __forceinline__ void phase_norm1(const Args& a, int l) {
    const int tid = otid(), lane = tid & 63, wave = tid >> 6;
    const float* mod = (const float*)(a.ws + WS_MISC + MISC_MOD) + (size_t)l * 8 * 6144;
    bf16_t* H = (bf16_t*)(a.ws + WS_H);
    for (int t = blockIdx.x * 8 + wave; t < NTOK; t += gridDim.x * 8) {
        const float* xr = a.in[I_X] + (size_t)t * DM; f32x4 v[4];
#pragma unroll
        for (int j = 0; j < 4; ++j) v[j] = *(const f32x4*)(xr + 4 * lane + 256 * j);
        const float rstd = row_rstd(v, 1e-6f);
        const float* mb = mod + (size_t)(t >> 11) * 6144;
        norm_mod_store(v, rstd, a.in[I_N1G] + (size_t)l * DM, mb + 1024, mb, H + (size_t)t * DM, lane);
    }
}

__device__ __forceinline__ void swa_wave_unit(const bf16_t* P, float* OAG, float* LSE, const LAS float* biasA, LAS unsigned char* vbuf, int u, int lane) {
    const int b = u / 768; const int rem = u - b * 768; const int head = rem >> 6, s = rem & 63;
    const int g = head >> 2, hh = head & 3;
    const int dsh = (g == 0) ? 0 : (g == 1) ? 2 : 4;
    const int L = NT >> dsh, nmbsh = 6 - dsh;
    const int r = s >> nmbsh, mb = s & ((1 << nmbsh) - 1);
    const int r32 = lane & 31, hi = lane >> 5;
    const size_t tq = (size_t)b * NT + ((mb * 32 + r32) << dsh) + r;
    bf16x8 qf[4];
    { const bf16_t* qp = P + tq * PLD + C_AQ + head * 64 + 8 * hi;
#pragma unroll
      for (int s4 = 0; s4 < 4; ++s4) qf[s4] = *(const bf16x8*)(qp + 16 * s4); }
    f32x16 o[2]; o[0] = (f32x16){}; o[1] = (f32x16){};
    float m = -1e30f, lsum = 0.f;
    const float SC = 0.125f * LOG2E;
    const LAS float* bh = biasA + head * 129 + 64;
    const int trbase = (4 * hi + ((lane & 15) >> 2)) * 144 + (16 * ((lane >> 4) & 1) + 4 * (lane & 3)) * 2;
    for (int kt = -2; kt <= 2; ++kt) {
        const int m0 = mb * 32 + kt * 32;
        if (m0 + 31 < 0 || m0 >= L) continue;
        bf16x8 kf[4];
        { int km = m0 + r32; km = km < 0 ? 0 : (km > L - 1 ? L - 1 : km);
          const bf16_t* kp = P + ((size_t)b * NT + (km << dsh) + r) * PLD + C_AK + head * 64 + 8 * hi;
#pragma unroll
          for (int s4 = 0; s4 < 4; ++s4) kf[s4] = *(const bf16x8*)(kp + 16 * s4); }
        asm volatile("" ::: "memory");
#pragma unroll
        for (int c4 = 0; c4 < 4; ++c4) { const int id = lane + 64 * c4, row = id >> 3, ch = id & 7;
            int vm = m0 + row; vm = vm < 0 ? 0 : (vm > L - 1 ? L - 1 : vm);
            const u32x4 val = *(const u32x4*)(P + ((size_t)b * NT + (vm << dsh) + r) * PLD + C_AV + head * 64 + ch * 8);
            *(LAS u32x4*)(vbuf + row * 144 + ch * 16) = val; }
        f32x16 sacc = (f32x16){};
#pragma unroll
        for (int s4 = 0; s4 < 4; ++s4) sacc = __builtin_amdgcn_mfma_f32_32x32x16_bf16(kf[s4], qf[s4], sacc, 0, 0, 0);
        float x[16]; float mx = -1e30f;
#pragma unroll
        for (int rg = 0; rg < 16; ++rg) { const int kvl = crow(rg, hi), km = m0 + kvl, j = kt * 32 + kvl - r32;
            const bool valid = (km >= 0) && (km < L) && (j >= -64) && (j <= 64);
            const int jc = j < -64 ? -64 : (j > 64 ? 64 : j);
            const float xv = sacc[rg] * SC + bh[jc];
            x[rg] = valid ? xv : -1e30f; mx = fmaxf(mx, x[rg]); }
        mx = fmaxf(mx, __shfl_xor(mx, 32));
        const float mn = fmaxf(m, mx), alpha = __builtin_amdgcn_exp2f(m - mn); m = mn;
        float ps = 0.f;
#pragma unroll
        for (int rg = 0; rg < 16; ++rg) { x[rg] = __builtin_amdgcn_exp2f(x[rg] - mn); ps += x[rg]; }
        lsum = lsum * alpha + ps;
#pragma unroll
        for (int rg = 0; rg < 16; ++rg) { o[0][rg] *= alpha; o[1][rg] *= alpha; }
        u32x4 pw[2];
#pragma unroll
        for (int s2 = 0; s2 < 2; ++s2) { pw[s2].x = pk2(x[8 * s2 + 0], x[8 * s2 + 1]); pw[s2].y = pk2(x[8 * s2 + 2], x[8 * s2 + 3]); pw[s2].z = pk2(x[8 * s2 + 4], x[8 * s2 + 5]); pw[s2].w = pk2(x[8 * s2 + 6], x[8 * s2 + 7]); }
        lds_fence();
#pragma unroll
        for (int db = 0; db < 2; ++db)
#pragma unroll
            for (int s2 = 0; s2 < 2; ++s2) {
                const s16x4 lo = vtr(vbuf + trbase + (16 * s2) * 144 + db * 64);
                const s16x4 hi4 = vtr(vbuf + trbase + (16 * s2 + 8) * 144 + db * 64);
                const bf16x8 af = (bf16x8){lo[0], lo[1], lo[2], lo[3], hi4[0], hi4[1], hi4[2], hi4[3]};
                o[db] = __builtin_amdgcn_mfma_f32_32x32x16_bf16(af, __builtin_bit_cast(bf16x8, pw[s2]), o[db], 0, 0, 0);
            }
        asm volatile("" ::: "memory");
    }
    const float lt = lsum + __shfl_xor(lsum, 32);
    const float inv = 1.f / lt;
    float* op = OAG + ((size_t)g * NTOK + tq) * 256 + hh * 64;
#pragma unroll
    for (int db = 0; db < 2; ++db)
#pragma unroll
        for (int i = 0; i < 4; ++i) { f32x4 v = (f32x4){o[db][4 * i], o[db][4 * i + 1], o[db][4 * i + 2], o[db][4 * i + 3]} * inv;
            *(f32x4*)(op + db * 32 + 8 * i + 4 * hi) = v; }
    if (hi == 0) LSE[((size_t)g * NTOK + tq) * 4 + hh] = m + __log2f(lt);
}
__device__ __forceinline__ void phase_swa(const Args& a, LAS unsigned char* lds) {
    const int tid = otid(), lane = tid & 63, wave = tid >> 6;
    LAS float* bA = (LAS float*)(lds + 40960);
    const float* bAg = (const float*)(a.ws + WS_MISC + MISC_BIASA);
    for (int i = tid; i < 12 * 129; i += 512) bA[i] = bAg[i];
    __syncthreads();
    for (int item = blockIdx.x; item < 768; item += gridDim.x)
        swa_wave_unit((const bf16_t*)(a.ws + WS_PROJ), (float*)(a.ws + WS_OAG), (float*)(a.ws + WS_LSE), bA, lds + wave * 4608, item * 8 + wave, lane);
    __syncthreads();
}

constexpr int RLD = 144, RMAT = 64 * RLD;
constexpr int R_P = 0, R_Q = 4 * RMAT, R_M = R_Q + 2 * 17408;
constexpr int R_WD = R_P, R_AD = R_P + RMAT, R_WUP = R_P + 2 * RMAT, R_AUP = R_P + 3 * RMAT;
constexpr int R_LK = R_P, R_RK = R_P + RMAT, R_RB = R_P + 2 * RMAT, R_TT = R_P + 3 * RMAT;
constexpr int R_ZW = R_Q, R_ZA = R_Q + 17408, R_LBF = R_Q, R_SEG = R_ZA, R_GC = R_ZA + 2048, R_W1T = R_ZA + 4096;
constexpr int R_A = R_M, R_B = R_M + 2 * RMAT, R_BP = R_M + 3 * RMAT, R_K = R_M + 4 * RMAT, R_KP = R_M + 5 * RMAT, R_RHO = R_M + 6 * RMAT, R_V = R_M + 7 * RMAT;
constexpr int R_UT = R_B, R_TAT = R_K;
constexpr int R_TMP0 = R_SEG, R_TMP1 = R_ZA + 13312, R_TMP2 = R_ZA + 13312 + 2048;
constexpr int R_PAR = R_M + 8 * RMAT, NPAR = 960;
static_assert(R_PAR + 2 * NPAR * 4 <= LDS_STAGE, "R1 LDS");

template <bool XT, bool YT>
__device__ __forceinline__ f32x16 tile64x(const LAS unsigned char* XM, int x0, const LAS unsigned char* YM, int y0, int lane, f32x16 acc) {
    const int r32 = lane & 31, hi = lane >> 5;
    const int trofs = ((lane & 15) >> 2) * RLD + (16 * ((lane >> 4) & 1) + 4 * (lane & 3)) * 2;
#pragma unroll
    for (int s4 = 0; s4 < 4; ++s4) {
        bf16x8 xa, yb;
        if (!XT) xa = *(const LAS bf16x8*)(XM + (x0 + r32) * RLD + 32 * s4 + 16 * hi);
        else { const s16x4 lo = vtr(XM + (16 * s4 + 8 * hi) * RLD + trofs + 2 * x0), h4 = vtr(XM + (16 * s4 + 8 * hi + 4) * RLD + trofs + 2 * x0);
               xa = (bf16x8){lo[0], lo[1], lo[2], lo[3], h4[0], h4[1], h4[2], h4[3]}; }
        if (!YT) yb = *(const LAS bf16x8*)(YM + (y0 + r32) * RLD + 32 * s4 + 16 * hi);
        else { const s16x4 lo = vtr(YM + (16 * s4 + 8 * hi) * RLD + trofs + 2 * y0), h4 = vtr(YM + (16 * s4 + 8 * hi + 4) * RLD + trofs + 2 * y0);
               yb = (bf16x8){lo[0], lo[1], lo[2], lo[3], h4[0], h4[1], h4[2], h4[3]}; }
        acc = __builtin_amdgcn_mfma_f32_32x32x16_bf16(xa, yb, acc, 0, 0, 0);
    }
    return acc;
}
template <class MP>
__device__ __forceinline__ void shift8r(const u32x4 c, u32x4 m, u32x4 n, bool hm, bool hn, MP mu0, MP mu1, float (&o)[8]) {
    const unsigned mm = hm ? 0xffffffffu : 0u, nm = hn ? 0xffffffffu : 0u;
    m = m & mm; n = n & nm;
#pragma unroll
    for (int q = 0; q < 4; ++q) {
        const float pl = bflo(c[q]), ph = bfhi(c[q]);
        o[2 * q] = pl + mu0[2 * q] * (bflo(m[q]) - pl) + mu1[2 * q] * (bflo(n[q]) - pl);
        o[2 * q + 1] = ph + mu0[2 * q + 1] * (bfhi(m[q]) - ph) + mu1[2 * q + 1] * (bfhi(n[q]) - ph);
    }
}
__device__ __forceinline__ float r1_param(const Args& a, int l, int h, int dir, int idx) {
    const int j = idx & 63, row = idx >> 6;
    if (row < 10) { const int g = row >> 1, which = row & 1; const int col = (g < 3 ? g * 768 + h * 64 : (g == 3 ? 2304 : 2432) + dir * 64) + j;
        return a.in[I_MU][(size_t)l * 2 * RSTR + (size_t)which * RSTR + col]; }
    const int cb = (l * 2 + dir) * RW + h * 64 + j;
    if (row == 10) return a.in[I_W0][cb];
    if (row == 11) return a.in[I_A0][cb];
    if (row == 12) return a.in[I_KK][cb];
    if (row == 13) return a.in[I_KA][cb];
    return a.in[I_RK][(size_t)l * RW + h * 64 + j];
}
__device__ __forceinline__ int r1_col(int g, int h, int dir, int seg) { return (g < 3 ? g * 768 + h * 64 : (g == 3 ? 2304 : 2432) + dir * 64) + 8 * seg; }
__device__ __forceinline__ void r1_issue(const bf16_t* P, int ct, int tid, u32x4 (&raw)[15]) {
    const int c = ct & 31, dir = (ct >> 5) & 1, bh = ct >> 6, h = bh % 12, b = bh / 12, ti = tid >> 3, seg = tid & 7;
    const int tseq = dir ? (NT - 1 - 64 * c - ti) : (64 * c + ti);
    const bf16_t* p0 = P + ((size_t)b * NT + tseq) * PLD + C_BS;
    const int dm = tseq > 0 ? PLD : 0, dn = tseq < NT - 1 ? PLD : 0;
#pragma unroll
    for (int g = 0; g < 5; ++g) { const int col = r1_col(g, h, dir, seg);
        raw[3 * g] = *(const u32x4*)(p0 + col); raw[3 * g + 1] = *(const u32x4*)(p0 + col - dm); raw[3 * g + 2] = *(const u32x4*)(p0 + col + dn); }
}

__device__ __forceinline__ void phase_rwkv_r1(const Args& a, int l, LAS unsigned char* lds) {
    const int tid0 = otid();
    unsigned char* ws = a.ws;
    const bf16_t* P = (const bf16_t*)(ws + WS_PROJ);
    const float* mu = a.in[I_MU] + (size_t)l * 2 * RSTR;
    const int G = gridDim.x;
    u32x4 raw[15], wup4, aup4;
    if ((int)blockIdx.x < 6144) { r1_issue(P, blockIdx.x, tid0, raw);
        { const int c0 = blockIdx.x; const size_t wofs = ((size_t)(l * 2 + ((c0 >> 5) & 1)) * 12 + ((c0 >> 6) % 12)) * 4096 + (size_t)(tid0 >> 3) * 64 + 8 * (tid0 & 7);
          wup4 = *(const u32x4*)((const bf16_t*)(ws + WS_MISC + MISC_WUPT) + wofs); aup4 = *(const u32x4*)((const bf16_t*)(ws + WS_MISC + MISC_AUPT) + wofs); }
        const int ct0 = blockIdx.x, bh0 = ct0 >> 6;
        LAS float* pt = (LAS float*)(lds + R_PAR);
        pt[tid0] = r1_param(a, l, bh0 % 12, (ct0 >> 5) & 1, tid0); if (tid0 + 512 < NPAR) pt[tid0 + 512] = r1_param(a, l, bh0 % 12, (ct0 >> 5) & 1, tid0 + 512); }
    __syncthreads();
    int itn = 0;
    f32x16 po0 = (f32x16){}, po1 = (f32x16){}; int ctp = -1;
#define R1_FLUSH(ctq, LANE, WAVE) do { const int _r32 = (LANE) & 31, _hi = (LANE) >> 5, _tt = (WAVE) & 3, _tm = _tt >> 1, _tn = _tt & 1; const size_t _cto = (size_t)(ctq) * 4096; \
        if ((WAVE) < 4) { bf16_t* QA = (bf16_t*)(ws + WS_QA) + _cto; float* MP = (float*)(ws + WS_MP) + _cto; \
            _Pragma("unroll") for (int q = 0; q < 4; ++q) { u32x2 w; w.x = pk2(po0[4 * q], po0[4 * q + 1]); w.y = pk2(po0[4 * q + 2], po0[4 * q + 3]); \
                *(u32x2*)(QA + ((_tn * 4 + 2 * _tm + (q >> 1)) * 64 + (q & 1) * 32 + _r32) * 8 + 4 * _hi) = w; \
                *(f32x4*)(MP + (32 * _tn + _r32) * 64 + 32 * _tm + 8 * q + 4 * _hi) = (f32x4){po1[4 * q], po1[4 * q + 1], po1[4 * q + 2], po1[4 * q + 3]}; } \
        } else { float* Y0 = (float*)(ws + WS_Y0) + _cto + _tt * 1024 + (LANE); float* NP = (float*)(ws + WS_NP) + _cto; \
            _Pragma("unroll") for (int rg = 0; rg < 16; ++rg) Y0[rg * 64] = po0[rg]; \
            _Pragma("unroll") for (int q = 0; q < 4; ++q) *(f32x4*)(NP + (32 * _tn + _r32) * 64 + 32 * _tm + 8 * q + 4 * _hi) = (f32x4){po1[4 * q], po1[4 * q + 1], po1[4 * q + 2], po1[4 * q + 3]}; } } while (0)
  for (int ct = blockIdx.x; ct < 6144; ct += G, ++itn) {
    int tid = tid0; asm volatile("" : "+v"(tid));
    const int lane = tid & 63, wave = __builtin_amdgcn_readfirstlane(tid >> 6), r32 = lane & 31, hi = lane >> 5;
    const int ti = tid >> 3, seg = tid & 7;
    const int c = ct & 31, dir = (ct >> 5) & 1, bh = ct >> 6, h = bh % 12, b = bh / 12;
    const int tseq = dir ? (NT - 1 - 64 * c - ti) : (64 * c + ti);
    const size_t trow = (size_t)b * NT + tseq;
    const bool hm = tseq > 0, hn = tseq < NT - 1;
    const LAS float* PT = (const LAS float*)(lds + R_PAR) + (itn & 1) * NPAR;
    float pnx0 = 0.f, pnx1 = 0.f;
    float r8[8], k8[8], v8[8];
    {
        shift8r(raw[0], raw[1], raw[2], hm, hn, PT + 0 * 64 + 8 * seg, PT + 1 * 64 + 8 * seg, r8);
        shift8r(raw[3], raw[4], raw[5], hm, hn, PT + 2 * 64 + 8 * seg, PT + 3 * 64 + 8 * seg, k8);
        shift8r(raw[6], raw[7], raw[8], hm, hn, PT + 4 * 64 + 8 * seg, PT + 5 * 64 + 8 * seg, v8);
        float t8[8];
        shift8r(raw[9], raw[10], raw[11], hm, hn, PT + 6 * 64 + 8 * seg, PT + 7 * 64 + 8 * seg, t8);
#pragma unroll
        for (int q = 0; q < 8; ++q) { const float e2 = __expf(2.f * t8[q]); t8[q] = 1.f - 2.f / (e2 + 1.f); }
        *(LAS u32x4*)(lds + R_WD + ti * RLD + 16 * seg) = pack8(t8);
        shift8r(raw[12], raw[13], raw[14], hm, hn, PT + 8 * 64 + 8 * seg, PT + 9 * 64 + 8 * seg, t8);
        *(LAS u32x4*)(lds + R_AD + ti * RLD + 16 * seg) = pack8(t8);
        if (h == 0 && dir == 0) {
            const bf16_t* p0 = P + trow * PLD + C_BS;
            bf16_t* GS = (bf16_t*)(ws + WS_GS) + trow * 256;
#pragma unroll
            for (int hf = 0; hf < 2; ++hf) { const int col = 2560 + 64 * hf + 8 * seg;
                shift8r(*(const u32x4*)(p0 + col), *(const u32x4*)(p0 + col - (hm ? PLD : 0)), *(const u32x4*)(p0 + col + (hn ? PLD : 0)), hm, hn, mu + col, mu + RSTR + col, t8);
#pragma unroll
                for (int q = 0; q < 8; ++q) t8[q] = sigmoidf_(t8[q]);
                *(u32x4*)(GS + 64 * hf + 8 * seg) = pack8(t8);
                *(u32x4*)(GS + 128 + 64 * hf + 8 * seg) = (u32x4){0u, 0u, 0u, 0u}; }
        }
        *(LAS u32x4*)(lds + R_WUP + ti * RLD + 16 * seg) = wup4;
        *(LAS u32x4*)(lds + R_AUP + ti * RLD + 16 * seg) = aup4;
        if (dir == 0) *(u32x4*)((bf16_t*)(ws + WS_RV) + trow * RW + h * 64 + 8 * seg) = pack8(v8);
    }
    if (ctp >= 0) R1_FLUSH(ctp, lane, wave);
    if (ct + G < 6144) { r1_issue(P, ct + G, tid, raw);
        const int ctn = ct + G, bhn = ctn >> 6;
        { const size_t wofs = ((size_t)(l * 2 + ((ctn >> 5) & 1)) * 12 + (bhn % 12)) * 4096 + (size_t)ti * 64 + 8 * seg;
          wup4 = *(const u32x4*)((const bf16_t*)(ws + WS_MISC + MISC_WUPT) + wofs); aup4 = *(const u32x4*)((const bf16_t*)(ws + WS_MISC + MISC_AUPT) + wofs); }
        pnx0 = r1_param(a, l, bhn % 12, (ctn >> 5) & 1, tid); if (tid + 512 < NPAR) pnx1 = r1_param(a, l, bhn % 12, (ctn >> 5) & 1, tid + 512); }
    __syncthreads();
    {
        const int p = wave >> 2, tt = wave & 3, tm = tt >> 1, tn = tt & 1;
        f32x16 acc = (f32x16){};
        acc = tile64x<false, false>(lds + (p ? R_AUP : R_WUP), 32 * tm, lds + (p ? R_AD : R_WD), 32 * tn, lane, acc);
        LAS float* Z = (LAS float*)(lds + (p ? R_ZA : R_ZW));
#pragma unroll
        for (int q = 0; q < 4; ++q) *(LAS f32x4*)(Z + (32 * tn + r32) * 68 + 32 * tm + 8 * q + 4 * hi) = (f32x4){acc[4 * q], acc[4 * q + 1], acc[4 * q + 2], acc[4 * q + 3]};
    }
    __syncthreads();
    float kka8[8], kk8[8], kd8[8];
    {
        const LAS float* w0 = PT + 10 * 64 + 8 * seg; const LAS float* a0 = PT + 11 * 64 + 8 * seg;
        const LAS float* kkp = PT + 12 * 64 + 8 * seg; const LAS float* kap = PT + 13 * 64 + 8 * seg;
        LAS float* Zw = (LAS float*)(lds + R_ZW) + ti * 68 + 8 * seg; const LAS float* Za = (const LAS float*)(lds + R_ZA) + ti * 68 + 8 * seg;
        float nrm = 0.f, av[8], e8[8];
#pragma unroll
        for (int q = 0; q < 8; ++q) {
            const float z = w0[q] + Zw[q];
            const float u = -z; const float sp = fmaxf(u, 0.f) + __logf(1.f + __expf(-fabsf(u)));
            e8[q] = __expf(-sp - 0.5f);
            av[q] = sigmoidf_(a0[q] + Za[q]);
            const float kr = k8[q] * kkp[q]; kk8[q] = kr; nrm += kr * kr;
            kd8[q] = k8[q] * (1.f + (av[q] - 1.f) * kap[q]);
        }
        nrm = dpp_sum8(nrm);
        const float rn = rsqrtf(fmaxf(nrm, 1e-24f));
#pragma unroll
        for (int q = 0; q < 8; ++q) { kk8[q] *= rn; kka8[q] = kk8[q] * av[q]; Zw[q] = e8[q]; }
        { const LAS float* rkp = PT + 14 * 64 + 8 * seg; float bs = 0.f;
#pragma unroll
          for (int q = 0; q < 8; ++q) bs += r8[q] * kd8[q] * rkp[q];
          bs = dpp_sum8(bs);
          if (seg == 0) ((float*)(ws + WS_RR))[((size_t)dir * NTOK + trow) * 12 + h] = bs; }
    }
    __syncthreads();
    {
        const int kc = tid & 63, sg = tid >> 6;
        LAS float* Zw = (LAS float*)(lds + R_ZW); LAS float* SEG = (LAS float*)(lds + R_SEG);
        float run = 0.f;
#pragma unroll
        for (int q = 0; q < 8; ++q) { run += Zw[(8 * sg + q) * 68 + kc]; Zw[(8 * sg + q) * 68 + kc] = run; }
        SEG[sg * 64 + kc] = run;
        __syncthreads();
        float off = 0.f;
        for (int s2 = 0; s2 < sg; ++s2) off += SEG[s2 * 64 + kc];
#pragma unroll
        for (int q = 0; q < 8; ++q) Zw[(8 * sg + q) * 68 + kc] += off;
    }
    __syncthreads();
    {
        const LAS float* Gp = (const LAS float*)(lds + R_ZW);
        float al[8], be[8], bp[8], ka[8], kp[8], rh[8];
#pragma unroll
        for (int q = 0; q < 8; ++q) {
            const float gi = Gp[ti * 68 + 8 * seg + q], gm = ti > 0 ? Gp[(ti - 1) * 68 + 8 * seg + q] : 0.f, g63 = Gp[63 * 68 + 8 * seg + q];
            const float ig = __expf(gi), tl = __expf(gi - g63);
            al[q] = __expf(-gm) * kk8[q]; be[q] = kka8[q] * ig; bp[q] = kka8[q] * tl; ka[q] = kd8[q] * ig; kp[q] = kd8[q] * tl; rh[q] = r8[q] * __expf(-gi);
            if (ti == 63) ((LAS float*)(lds + R_GC))[8 * seg + q] = __expf(-g63);
        }
        const int o = ti * RLD + 16 * seg;
        *(LAS u32x4*)(lds + R_A + o) = pack8(al); *(LAS u32x4*)(lds + R_B + o) = pack8(be); *(LAS u32x4*)(lds + R_K + o) = pack8(ka); *(LAS u32x4*)(lds + R_RHO + o) = pack8(rh);
        *(LAS u32x4*)(lds + R_BP + o) = pack8(bp); *(LAS u32x4*)(lds + R_KP + o) = pack8(kp); *(LAS u32x4*)(lds + R_V + o) = pack8(v8);
    }
    __syncthreads();
    {
        const int tt = wave & 3, tm = tt >> 1, tn = tt & 1;
        const int jb = 32 * tm, ib = 32 * tn, i = ib + r32;
        f32x16 acc0 = (f32x16){}, acc1 = (f32x16){};
        if (tm <= tn) {
            acc0 = tile64x<false, false>(lds + (wave < 4 ? R_B : R_K), jb, lds + (wave < 4 ? R_A : R_RHO), ib, lane, acc0);
            acc1 = tile64x<false, false>(lds + (wave < 4 ? R_K : R_B), jb, lds + (wave < 4 ? R_A : R_RHO), ib, lane, acc1);
        }
#pragma unroll
        for (int rg = 0; rg < 16; ++rg) { const int j = jb + crow(rg, hi); const bool keep = (wave < 4) ? (j < i) : (j <= i);
            acc0[rg] = keep ? acc0[rg] : 0.f; acc1[rg] = keep ? acc1[rg] : 0.f; }
#pragma unroll
        for (int q = 0; q < 4; ++q) { const int jo = jb + 8 * q + 4 * hi;
            u32x2 w1; w1.x = pk2(acc1[4 * q], acc1[4 * q + 1]); w1.y = pk2(acc1[4 * q + 2], acc1[4 * q + 3]);
            if (wave < 4) {
                *(LAS f32x4*)((LAS float*)(lds + R_LBF) + i * 68 + jo) = (f32x4){acc0[4 * q], acc0[4 * q + 1], acc0[4 * q + 2], acc0[4 * q + 3]};
                *(LAS u32x2*)(lds + R_LK + i * RLD + 2 * jo) = w1;
                if (wave == 1) { u32x2 wl; wl.x = pk2(acc0[4 * q], acc0[4 * q + 1]); wl.y = pk2(acc0[4 * q + 2], acc0[4 * q + 3]);
                    *(LAS u32x2*)(lds + R_TMP0 + r32 * 64 + 2 * (8 * q + 4 * hi)) = wl; }
            } else {
                u32x2 w0; w0.x = pk2(acc0[4 * q], acc0[4 * q + 1]); w0.y = pk2(acc0[4 * q + 2], acc0[4 * q + 3]);
                *(LAS u32x2*)(lds + R_RK + i * RLD + 2 * jo) = w0;
                *(LAS u32x2*)(lds + R_RB + i * RLD + 2 * jo) = w1;
            } }
    }
    __syncthreads();
    if (wave < 2) {
        const int blk = wave, col = r32;
        const LAS float* Lf = (const LAS float*)(lds + R_LBF) + (32 * blk) * 68 + 32 * blk;
        float Tm[32];
        f32x4 cur[8], nxt[8];
#pragma unroll
        for (int m4 = 0; m4 < 8; ++m4) { cur[m4] = (f32x4){0.f, 0.f, 0.f, 0.f}; nxt[m4] = (f32x4){0.f, 0.f, 0.f, 0.f}; }
        cur[0] = *(const LAS f32x4*)(Lf + 68);
        Tm[0] = (col == 0) ? 1.f : 0.f;
#pragma unroll
        for (int i = 1; i < 32; ++i) {
            if (i + 1 < 32) {
#pragma unroll
                for (int m4 = 0; m4 < (i + 4) / 4; ++m4) nxt[m4] = *(const LAS f32x4*)(Lf + (i + 1) * 68 + 4 * m4);
            }
            float c0 = (col == i) ? 1.f : 0.f, c1 = 0.f, c2 = 0.f, c3 = 0.f;
#pragma unroll
            for (int m4 = 0; m4 < (i + 3) / 4; ++m4) {
                if (4 * m4 + 0 < i) c0 -= cur[m4][0] * Tm[4 * m4 + 0];
                if (4 * m4 + 1 < i) c1 -= cur[m4][1] * Tm[4 * m4 + 1];
                if (4 * m4 + 2 < i) c2 -= cur[m4][2] * Tm[4 * m4 + 2];
                if (4 * m4 + 3 < i) c3 -= cur[m4][3] * Tm[4 * m4 + 3]; }
            Tm[i] = (c0 + c1) + (c2 + c3);
#pragma unroll
            for (int m4 = 0; m4 < 8; ++m4) cur[m4] = nxt[m4];
            asm volatile("" : "+v"(Tm[i]) :: "memory");
        }
        if (hi == 0) {
#pragma unroll
            for (int i = 0; i < 32; ++i) {
                *(LAS bf16_t*)(lds + R_TT + (32 * blk + i) * RLD + 2 * (32 * blk + col)) = f2bf(Tm[i]);
                if (blk == 0) *(LAS bf16_t*)(lds + R_TT + i * RLD + 2 * (32 + col)) = (bf16_t)0;
            }
            if (blk == 0) {
#pragma unroll
                for (int q = 0; q < 4; ++q) { float x8[8];
#pragma unroll
                    for (int e = 0; e < 8; ++e) x8[e] = Tm[8 * q + e];
                    *(LAS u32x4*)(lds + R_TMP1 + col * 64 + 16 * q) = pack8(x8); } }
        }
    } else if (wave >= 4) {
        const int tt = wave & 3, tm = tt >> 1, tn = tt & 1;
        f32x16 acc = (f32x16){};
        acc = tile64x<false, true>(lds + R_LK, 32 * tm, lds + R_V, 32 * tn, lane, acc);
#pragma unroll
        for (int q = 0; q < 4; ++q) { u32x2 w; w.x = pk2(acc[4 * q], acc[4 * q + 1]); w.y = pk2(acc[4 * q + 2], acc[4 * q + 3]);
            *(LAS u32x2*)(lds + R_W1T + (32 * tn + r32) * RLD + 2 * (32 * tm + 8 * q + 4 * hi)) = w; }
    }
    __syncthreads();
    if (wave == 0) {
        f32x16 x1 = (f32x16){};
#pragma unroll
        for (int s2 = 0; s2 < 2; ++s2) x1 = __builtin_amdgcn_mfma_f32_32x32x16_bf16(*(const LAS bf16x8*)(lds + R_TMP0 + r32 * 64 + 32 * s2 + 16 * hi), *(const LAS bf16x8*)(lds + R_TMP1 + r32 * 64 + 32 * s2 + 16 * hi), x1, 0, 0, 0);
#pragma unroll
        for (int q = 0; q < 4; ++q) { u32x2 w; w.x = pk2(x1[4 * q], x1[4 * q + 1]); w.y = pk2(x1[4 * q + 2], x1[4 * q + 3]);
            *(LAS u32x2*)(lds + R_TMP2 + r32 * 64 + 2 * (8 * q + 4 * hi)) = w; }
        lds_fence();
        f32x16 t21 = (f32x16){};
#pragma unroll
        for (int s2 = 0; s2 < 2; ++s2) t21 = __builtin_amdgcn_mfma_f32_32x32x16_bf16(*(const LAS bf16x8*)(lds + R_TT + (32 + r32) * RLD + 64 + 32 * s2 + 16 * hi), *(const LAS bf16x8*)(lds + R_TMP2 + r32 * 64 + 32 * s2 + 16 * hi), t21, 0, 0, 0);
#pragma unroll
        for (int rg = 0; rg < 16; ++rg) *(LAS bf16_t*)(lds + R_TT + (32 + crow(rg, hi)) * RLD + 2 * r32) = f2bf(-t21[rg]);
    }
    __syncthreads();
    {
        const int tt = wave & 3, tm = tt >> 1, tn = tt & 1;
        f32x16 acc = (f32x16){};
        if (wave < 4) acc = tile64x<false, false>(lds + R_TT, 32 * tm, lds + R_W1T, 32 * tn, lane, acc);
        else          acc = tile64x<false, true>(lds + R_TT, 32 * tm, lds + R_A, 32 * tn, lane, acc);
        LAS unsigned char* dst = lds + (wave < 4 ? R_UT : R_TAT);
#pragma unroll
        for (int q = 0; q < 4; ++q) { u32x2 w; w.x = pk2(acc[4 * q], acc[4 * q + 1]); w.y = pk2(acc[4 * q + 2], acc[4 * q + 3]);
            *(LAS u32x2*)(dst + (32 * tn + r32) * RLD + 2 * (32 * tm + 8 * q + 4 * hi)) = w; }
    }
    __syncthreads();
    {
        const int tt = wave & 3, tm = tt >> 1, tn = tt & 1;
        if (wave < 4) {
            f32x16 acc = (f32x16){};
            acc = tile64x<false, false>(lds + R_TAT, 32 * tm, lds + R_RB, 32 * tn, lane, acc);
#pragma unroll
            for (int q = 0; q < 4; ++q) { const int i = 32 * tn + r32, k = 32 * tm + 8 * q + 4 * hi;
                const u32x2 rv = *(const LAS u32x2*)(lds + R_RHO + i * RLD + 2 * k);
                po0[4 * q] = bflo(rv.x) - acc[4 * q]; po0[4 * q + 1] = bfhi(rv.x) - acc[4 * q + 1]; po0[4 * q + 2] = bflo(rv.y) - acc[4 * q + 2]; po0[4 * q + 3] = bfhi(rv.y) - acc[4 * q + 3]; }
            f32x16 am = (f32x16){};
            am = tile64x<true, false>(lds + R_BP, 32 * tm, lds + R_TAT, 32 * tn, lane, am);
            const LAS float* GC = (const LAS float*)(lds + R_GC);
#pragma unroll
            for (int q = 0; q < 4; ++q) { const int k = 32 * tn + r32, kp0 = 32 * tm + 8 * q + 4 * hi;
#pragma unroll
                for (int e = 0; e < 4; ++e) po1[4 * q + e] = ((kp0 + e == k) ? GC[kp0 + e] : 0.f) - am[4 * q + e]; }
        } else {
            f32x16 a1 = (f32x16){}, a2 = (f32x16){};
            a1 = tile64x<true, false>(lds + R_V, 32 * tm, lds + R_RK, 32 * tn, lane, a1);
            a2 = tile64x<false, false>(lds + R_UT, 32 * tm, lds + R_RB, 32 * tn, lane, a2);
            po0 = a1 - a2;
            f32x16 n1 = (f32x16){}, n2 = (f32x16){};
            n1 = tile64x<true, true>(lds + R_KP, 32 * tm, lds + R_V, 32 * tn, lane, n1);
            n2 = tile64x<true, false>(lds + R_BP, 32 * tm, lds + R_UT, 32 * tn, lane, n2);
            po1 = n1 - n2;
        }
        ctp = ct;
    }
    if (ct + G < 6144) { LAS float* pn = (LAS float*)(lds + R_PAR) + ((itn + 1) & 1) * NPAR; pn[tid] = pnx0; if (tid + 512 < NPAR) pn[tid + 512] = pnx1; }
    __syncthreads();
  }
    if (ctp >= 0) { const int lane = tid0 & 63, wave = __builtin_amdgcn_readfirstlane(tid0 >> 6); R1_FLUSH(ctp, lane, wave); }
#undef R1_FLUSH
}

__device__ __forceinline__ void rwkv_r2_unit(const Args& a, int unit, LAS unsigned char* lds) {
    const int tid = otid(), lane = tid & 63, wave = __builtin_amdgcn_readfirstlane(tid >> 6);
    unsigned char* ws = a.ws;
    LAS float* S = (LAS float*)lds;
    const int vb = wave >> 1, kb0 = 2 * (wave & 1), l15 = lane & 15, lq = lane >> 4;
    for (int i = tid; i < 64 * 68; i += 512) S[i] = 0.f;
    const float* MPb = (const float*)(ws + WS_MP) + (size_t)unit * 32 * 4096; const float* NPb = (const float*)(ws + WS_NP) + (size_t)unit * 32 * 4096;
    bf16_t* SSb = (bf16_t*)(ws + WS_SS) + (size_t)unit * 32 * 4096;
    float Bm[2][16]; f32x4 acc[2];
#pragma unroll
    for (int t2 = 0; t2 < 2; ++t2) {
#pragma unroll
        for (int ks = 0; ks < 16; ++ks) Bm[t2][ks] = MPb[(4 * ks + lq) * 64 + 16 * (kb0 + t2) + l15];
#pragma unroll
        for (int rg = 0; rg < 4; ++rg) acc[t2][rg] = NPb[(16 * vb + 4 * lq + rg) * 64 + 16 * (kb0 + t2) + l15]; }
    __syncthreads();
    for (int c = 0; c < 32; ++c) {
        { const int v = tid >> 3, sg = tid & 7; const LAS float* sp = S + v * 68 + 8 * sg; float x[8];
#pragma unroll
          for (int q = 0; q < 8; ++q) x[q] = sp[q];
          *(u32x4*)(SSb + (size_t)c * 4096 + v * 64 + 8 * sg) = pack8(x); }
#pragma unroll
        for (int ks = 0; ks < 16; ++ks) { const float av = S[(16 * vb + l15) * 68 + 4 * ks + lq];
            acc[0] = __builtin_amdgcn_mfma_f32_16x16x4f32(av, Bm[0][ks], acc[0], 0, 0, 0);
            acc[1] = __builtin_amdgcn_mfma_f32_16x16x4f32(av, Bm[1][ks], acc[1], 0, 0, 0); }
        __syncthreads();
#pragma unroll
        for (int t2 = 0; t2 < 2; ++t2)
#pragma unroll
            for (int rg = 0; rg < 4; ++rg) S[(16 * vb + 4 * lq + rg) * 68 + 16 * (kb0 + t2) + l15] = acc[t2][rg];
        if (c + 1 < 32) { const float* MPc = MPb + (size_t)(c + 1) * 4096; const float* NPc = NPb + (size_t)(c + 1) * 4096;
#pragma unroll
            for (int t2 = 0; t2 < 2; ++t2) {
#pragma unroll
                for (int ks = 0; ks < 16; ++ks) Bm[t2][ks] = MPc[(4 * ks + lq) * 64 + 16 * (kb0 + t2) + l15];
#pragma unroll
                for (int rg = 0; rg < 4; ++rg) acc[t2][rg] = NPc[(16 * vb + 4 * lq + rg) * 64 + 16 * (kb0 + t2) + l15]; } }
        __syncthreads();
    }
}

__device__ __forceinline__ void phase_rwkv_out(const Args& a, int l) {
    const int tid = otid(), lane = tid & 63, wave = tid >> 6, r32 = lane & 31, hi = lane >> 5;
    unsigned char* ws = a.ws;
    const bf16_t* SSg = (const bf16_t*)(ws + WS_SS); const bf16_t* QAg = (const bf16_t*)(ws + WS_QA); const float* Y0g = (const float*)(ws + WS_Y0);
    const bf16_t* RV = (const bf16_t*)(ws + WS_RV);
    const bf16_t* GG = (const bf16_t*)(ws + WS_GG); bf16_t* OB = (bf16_t*)(ws + WS_OA) + 256;
    const float* lng = a.in[I_LNG] + (size_t)l * RW; const float* lnb = a.in[I_LNB] + (size_t)l * RW;
    for (int wt = blockIdx.x * 8 + wave; wt < 6144; wt += gridDim.x * 8) {
        const int tq = wt & 63, bh = wt >> 6, h = bh % 12, b = bh / 12, c = tq >> 1, tn = tq & 1, tnb = 1 - tn;
        const size_t ctf = ((size_t)bh * 2 + 0) * 32 + c, ctb = ((size_t)bh * 2 + 1) * 32 + (31 - c);
        const size_t t = (size_t)b * NT + 64 * c + 32 * tn + r32;
        const int srcl = (lane & 32) + 31 - r32;
        float y[2][16];
#pragma unroll
        for (int tm = 0; tm < 2; ++tm) {
            f32x16 af, ab;
            const float* y0f = Y0g + ctf * 4096 + (tm * 2 + tn) * 1024 + lane; const float* y0b = Y0g + ctb * 4096 + (tm * 2 + tnb) * 1024 + lane;
#pragma unroll
            for (int rg = 0; rg < 16; ++rg) { af[rg] = y0f[rg * 64]; ab[rg] = y0b[rg * 64]; }
#pragma unroll
            for (int s4 = 0; s4 < 4; ++s4) {
                const bf16x8 xf = *(const bf16x8*)(SSg + ctf * 4096 + (32 * tm + r32) * 64 + 16 * s4 + 8 * hi);
                const bf16x8 yf = *(const bf16x8*)(QAg + ctf * 4096 + ((tn * 4 + s4) * 64 + lane) * 8);
                af = __builtin_amdgcn_mfma_f32_32x32x16_bf16(xf, yf, af, 0, 0, 0);
                const bf16x8 xb = *(const bf16x8*)(SSg + ctb * 4096 + (32 * tm + r32) * 64 + 16 * s4 + 8 * hi);
                const bf16x8 yb = *(const bf16x8*)(QAg + ctb * 4096 + ((tnb * 4 + s4) * 64 + lane) * 8);
                ab = __builtin_amdgcn_mfma_f32_32x32x16_bf16(xb, yb, ab, 0, 0, 0);
            }
#pragma unroll
            for (int rg = 0; rg < 16; ++rg) y[tm][rg] = af[rg] + __shfl(ab[rg], srcl);
        }
        float sm = 0.f;
#pragma unroll
        for (int tm = 0; tm < 2; ++tm)
#pragma unroll
            for (int rg = 0; rg < 16; ++rg) sm += y[tm][rg];
        sm += __shfl_xor(sm, 32);
        const float mean = sm * (1.f / 64.f);
        float sv = 0.f;
#pragma unroll
        for (int tm = 0; tm < 2; ++tm)
#pragma unroll
            for (int rg = 0; rg < 16; ++rg) { const float d = y[tm][rg] - mean; y[tm][rg] = d; sv += d * d; }
        sv += __shfl_xor(sv, 32);
        const float rstd = rsqrtf(sv * (1.f / 64.f) + 64e-5f);
        const float* BS = (const float*)(ws + WS_RR);
        const float s0 = BS[t * 12 + h] + BS[((size_t)NTOK + t) * 12 + h];
#pragma unroll
        for (int tm = 0; tm < 2; ++tm)
#pragma unroll
            for (int q = 0; q < 4; ++q) { const int cc = h * 64 + 32 * tm + 8 * q + 4 * hi;
                const f32x4 g4 = *(const f32x4*)(lng + cc), b4 = *(const f32x4*)(lnb + cc); const u32x2 vv = *(const u32x2*)(RV + t * RW + cc);
                const f32x4 v4 = (f32x4){bflo(vv.x), bfhi(vv.x), bflo(vv.y), bfhi(vv.y)};
                const u32x2 gg = *(const u32x2*)(GG + t * RW + cc);
                const float o0 = (y[tm][4 * q] * rstd * g4.x + b4.x + s0 * v4.x) * bflo(gg.x), o1 = (y[tm][4 * q + 1] * rstd * g4.y + b4.y + s0 * v4.y) * bfhi(gg.x);
                const float o2 = (y[tm][4 * q + 2] * rstd * g4.z + b4.z + s0 * v4.z) * bflo(gg.y), o3 = (y[tm][4 * q + 3] * rstd * g4.w + b4.w + s0 * v4.w) * bfhi(gg.y);
                u32x2 w; w.x = pk2(o0, o1); w.y = pk2(o2, o3);
                *(u32x2*)(OB + t * 1792 + cc) = w; }
    }
    const float* OAG = (const float*)(ws + WS_OAG); const float* LSE = (const float*)(ws + WS_LSE); bf16_t* OA = (bf16_t*)(ws + WS_OA);
    for (int task = blockIdx.x * 8 + wave; task < NTOK / 4; task += gridDim.x * 8) {
#pragma unroll
        for (int tk = 0; tk < 4; ++tk) { const size_t t = (size_t)task * 4 + tk; const int hh = lane >> 4;
            const float l0 = LSE[((size_t)0 * NTOK + t) * 4 + hh], l1 = LSE[((size_t)1 * NTOK + t) * 4 + hh], l2 = LSE[((size_t)2 * NTOK + t) * 4 + hh];
            const float mx = fmaxf(l0, fmaxf(l1, l2));
            const float w0 = __builtin_amdgcn_exp2f(l0 - mx), w1 = __builtin_amdgcn_exp2f(l1 - mx), w2 = __builtin_amdgcn_exp2f(l2 - mx);
            const float inv = 1.f / (w0 + w1 + w2);
            const f32x4 o0 = *(const f32x4*)(OAG + ((size_t)0 * NTOK + t) * 256 + lane * 4), o1 = *(const f32x4*)(OAG + ((size_t)1 * NTOK + t) * 256 + lane * 4), o2 = *(const f32x4*)(OAG + ((size_t)2 * NTOK + t) * 256 + lane * 4);
            const f32x4 r = (o0 * w0 + o1 * w1 + o2 * w2) * inv;
            u32x2 w; w.x = pk2(r.x, r.y); w.y = pk2(r.z, r.w);
            *(u32x2*)(OA + t * 1792 + lane * 4) = w; }
    }
}

__device__ __forceinline__ int vk_off(int row, int ch) { return 2048 * (row >> 3) + 512 * (ch >> 2) + 64 * (row & 7) + 16 * ((ch & 3) ^ ((row >> 2) & 3)); }
__device__ __forceinline__ void diffattn_unit(const Args& a, int l, int unit, LAS unsigned char* lds) {
    constexpr int TB = 16384;
    const int b = unit / 96; const int rem = unit - b * 96; const int h = rem >> 4, qb = rem & 15;
    const int tid = otid(), lane = tid & 63, wave = __builtin_amdgcn_readfirstlane(tid >> 6), r32 = lane & 31, hi = lane >> 5;
    const int c = wave & 1, qblk = wave >> 1;
    const int q0 = qb * 128 + qblk * 32;
    const bf16_t* P = (const bf16_t*)(a.ws + WS_PROJ);
    const size_t rowb = (size_t)b * NT;
    bf16x8 qf[4];
    { const bf16_t* qp = P + (rowb + q0 + r32) * PLD + C_CQ + h * 128 + c * 64 + 8 * hi;
#pragma unroll
      for (int s4 = 0; s4 < 4; ++s4) qf[s4] = *(const bf16x8*)(qp + 16 * s4); }
    LAS float* biasL = (LAS float*)(lds + 69632);
    { const float* bC = (const float*)(a.ws + WS_MISC + MISC_BIASC) + h * 257;
      for (int i = tid; i < 257; i += 512) biasL[i] = bC[i]; }
    const int srow0 = tid >> 4, sch = tid & 15;
    const bf16_t* kg = P + (rowb + srow0) * PLD + C_CK + h * 128 + sch * 8;
    const bf16_t* vg = P + (rowb + srow0) * PLD + C_CV + h * 128 + sch * 8;
    u32x4 kr[2], vr[2];
#pragma unroll
    for (int i = 0; i < 2; ++i) { kr[i] = *(const u32x4*)(kg + (size_t)(32 * i) * PLD); vr[i] = *(const u32x4*)(vg + (size_t)(32 * i) * PLD); }
#pragma unroll
    for (int i = 0; i < 2; ++i) { *(LAS u32x4*)(lds + vk_off(srow0 + 32 * i, sch)) = kr[i]; *(LAS u32x4*)(lds + 2 * TB + vk_off(srow0 + 32 * i, sch)) = vr[i]; }
    __syncthreads();
    f32x16 o[4];
#pragma unroll
    for (int db = 0; db < 4; ++db) o[db] = (f32x16){};
    float m = -1e30f, lsum = 0.f;
    const float SC = 0.125f * LOG2E;
    const int chlo = 2 * ((lane >> 4) & 1) + ((lane & 3) >> 1);
    const int trb0 = 64 * (4 * hi + ((lane & 15) >> 2)) + 16 * (chlo ^ (hi & 3)) + 8 * (lane & 1);
    const int trb1 = 64 * (4 * hi + ((lane & 15) >> 2)) + 16 * (chlo ^ ((2 + hi) & 3)) + 8 * (lane & 1) + 2048;
    const int qabs = q0 + r32;
    for (int t = 0; t < 32; ++t) {
        if (t + 1 < 32) {
#pragma unroll
            for (int i = 0; i < 2; ++i) { kr[i] = *(const u32x4*)(kg + (size_t)(64 * (t + 1) + 32 * i) * PLD); vr[i] = *(const u32x4*)(vg + (size_t)(64 * (t + 1) + 32 * i) * PLD); } }
        const LAS unsigned char* Kb = lds + (t & 1) * TB;
        const LAS unsigned char* Vb = lds + 2 * TB + (t & 1) * TB;
        f32x16 sa0 = (f32x16){}, sa1 = (f32x16){};
#pragma unroll
        for (int s4 = 0; s4 < 4; ++s4) {
            const bf16x8 kf0 = *(const LAS bf16x8*)(Kb + vk_off(r32, 8 * c + 2 * s4 + hi));
            const bf16x8 kf1 = *(const LAS bf16x8*)(Kb + vk_off(32 + r32, 8 * c + 2 * s4 + hi));
            sa0 = __builtin_amdgcn_mfma_f32_32x32x16_bf16(kf0, qf[s4], sa0, 0, 0, 0);
            sa1 = __builtin_amdgcn_mfma_f32_32x32x16_bf16(kf1, qf[s4], sa1, 0, 0, 0);
        }
        float x0[16], x1[16];
        const int kv0 = 64 * t;
        const bool farp = (kv0 >= q0 + 31 + 128), farn = (kv0 + 63 + 128 <= q0);
        if (farp || farn) { const float cb = farp ? biasL[256] : biasL[0];
#pragma unroll
            for (int rg = 0; rg < 16; ++rg) { x0[rg] = sa0[rg] * SC + cb; x1[rg] = sa1[rg] * SC + cb; }
        } else {
#pragma unroll
            for (int rg = 0; rg < 16; ++rg) { int rel = kv0 + crow(rg, hi) - qabs; int rc = rel < -128 ? -128 : (rel > 128 ? 128 : rel);
                x0[rg] = sa0[rg] * SC + biasL[rc + 128];
                rel += 32; rc = rel < -128 ? -128 : (rel > 128 ? 128 : rel);
                x1[rg] = sa1[rg] * SC + biasL[rc + 128]; }
        }
        float mx = fmaxf(x0[0], x1[0]);
#pragma unroll
        for (int rg = 1; rg < 16; ++rg) mx = fmaxf(mx, fmaxf(x0[rg], x1[rg]));
        mx = fmaxf(mx, __shfl_xor(mx, 32));
        const float mn = fmaxf(m, mx), alpha = __builtin_amdgcn_exp2f(m - mn); m = mn;
        float ps = 0.f;
#pragma unroll
        for (int rg = 0; rg < 16; ++rg) { x0[rg] = __builtin_amdgcn_exp2f(x0[rg] - mn); x1[rg] = __builtin_amdgcn_exp2f(x1[rg] - mn); ps += x0[rg] + x1[rg]; }
        lsum = lsum * alpha + ps;
#pragma unroll
        for (int db = 0; db < 4; ++db)
#pragma unroll
            for (int rg = 0; rg < 16; ++rg) o[db][rg] *= alpha;
        u32x4 pw[4];
#pragma unroll
        for (int s2 = 0; s2 < 2; ++s2) {
            pw[s2].x = pk2(x0[8 * s2 + 0], x0[8 * s2 + 1]); pw[s2].y = pk2(x0[8 * s2 + 2], x0[8 * s2 + 3]); pw[s2].z = pk2(x0[8 * s2 + 4], x0[8 * s2 + 5]); pw[s2].w = pk2(x0[8 * s2 + 6], x0[8 * s2 + 7]);
            pw[2 + s2].x = pk2(x1[8 * s2 + 0], x1[8 * s2 + 1]); pw[2 + s2].y = pk2(x1[8 * s2 + 2], x1[8 * s2 + 3]); pw[2 + s2].z = pk2(x1[8 * s2 + 4], x1[8 * s2 + 5]); pw[2 + s2].w = pk2(x1[8 * s2 + 6], x1[8 * s2 + 7]); }
#pragma unroll
        for (int db = 0; db < 4; ++db)
#pragma unroll
            for (int s = 0; s < 4; ++s) {
                const s16x4 lo = vtr(Vb + trb0 + 4096 * s + 512 * db);
                const s16x4 hi4 = vtr(Vb + trb1 + 4096 * s + 512 * db);
                const bf16x8 af = (bf16x8){lo[0], lo[1], lo[2], lo[3], hi4[0], hi4[1], hi4[2], hi4[3]};
                o[db] = __builtin_amdgcn_mfma_f32_32x32x16_bf16(af, __builtin_bit_cast(bf16x8, pw[s]), o[db], 0, 0, 0);
            }
        if (t + 1 < 32) { LAS unsigned char* Kn = lds + ((t + 1) & 1) * TB; LAS unsigned char* Vn = lds + 2 * TB + ((t + 1) & 1) * TB;
#pragma unroll
            for (int i = 0; i < 2; ++i) { *(LAS u32x4*)(Kn + vk_off(srow0 + 32 * i, sch)) = kr[i]; *(LAS u32x4*)(Vn + vk_off(srow0 + 32 * i, sch)) = vr[i]; } }
        __syncthreads();
    }
    const float lt = lsum + __shfl_xor(lsum, 32);
    const float inv = 1.f / lt;
    const float* lamp = (const float*)(a.ws + WS_MISC + MISC_LAM);
    const float lam = lamp[l], linit = lamp[2 + l];
    LAS float* XO = (LAS float*)lds;
    if (c == 1) {
        const float f = inv * lam;
#pragma unroll
        for (int db = 0; db < 4; ++db)
#pragma unroll
            for (int rg = 0; rg < 16; ++rg) XO[(qblk * 64 + db * 16 + rg) * 64 + lane] = o[db][rg] * f;
    }
    __syncthreads();
    if (c == 0) {
        float ss = 0.f;
#pragma unroll
        for (int db = 0; db < 4; ++db)
#pragma unroll
            for (int rg = 0; rg < 16; ++rg) { const float v = o[db][rg] * inv - XO[(qblk * 64 + db * 16 + rg) * 64 + lane]; o[db][rg] = v; ss += v * v; }
        ss += __shfl_xor(ss, 32);
        const float sc = rsqrtf(ss * (1.f / 128.f) + 1e-5f) * (1.f - linit);
        const float* sg = a.in[I_SUBG] + (size_t)l * 128;
        bf16_t* op = (bf16_t*)(a.ws + WS_OA) + (rowb + q0 + r32) * 1792 + 1024 + h * 128;
#pragma unroll
        for (int db = 0; db < 4; ++db)
#pragma unroll
            for (int i = 0; i < 4; ++i) { const int d = db * 32 + 8 * i + 4 * hi; const f32x4 g4 = *(const f32x4*)(sg + d);
                u32x2 w; w.x = pk2(o[db][4 * i] * sc * g4.x, o[db][4 * i + 1] * sc * g4.y); w.y = pk2(o[db][4 * i + 2] * sc * g4.z, o[db][4 * i + 3] * sc * g4.w);
                *(u32x2*)(op + d) = w; }
    }
    __syncthreads();
}

__device__ __forceinline__ void phase_route(const Args& a, int l, LAS unsigned char* lds, bool commit = true) {
    const int tid = otid(), lane = tid & 63, wave = __builtin_amdgcn_readfirstlane(tid >> 6), r32 = lane & 31, hi = lane >> 5;
    unsigned char* ws = a.ws;
    LAS float* hb = (LAS float*)lds;
    LAS float* lg = (LAS float*)(lds + 131200);
    volatile LAS int* sel = (volatile LAS int*)(lds + 131200 + 4224);
    const float* X = (const float*)(ws + WS_X);
    const float* mod = (const float*)(ws + WS_MISC + MISC_MOD) + (size_t)l * 8 * 6144;
    bf16_t* H = (bf16_t*)(ws + WS_H);
    unsigned* cnt = (unsigned*)(ws + WS_CTL) + CW_CNT + l * 512;
    int* LIST = (int*)(ws + WS_LIST); unsigned* TOKE = (unsigned*)(ws + WS_TOKE); float* TOKP = (float*)(ws + WS_TOKP);
    const float* g2 = a.in[I_N2G] + (size_t)l * DM; const float* rb = a.in[I_RB] + (size_t)l * NE;
    float Bw[64];
    { const float* rw = a.in[I_RW] + (size_t)l * DM * NE + (size_t)(128 * wave + hi) * NE + r32;
#pragma unroll
      for (int s2 = 0; s2 < 64; ++s2) Bw[s2] = rw[(size_t)(2 * s2) * NE]; }
    for (int tb = blockIdx.x; tb < NTOK / 64; tb += gridDim.x) {
        for (int rnd = 0; rnd < 2; ++rnd) {
            const int tbase = tb * 64 + rnd * 32;
            const float* mb = mod + (size_t)(tbase >> 11) * 6144;
#pragma unroll 1
            for (int q = 0; q < 4; ++q) {
                const int tl = 4 * wave + q; const size_t t = (size_t)tbase + tl;
                f32x4 v[4];
#pragma unroll
                for (int j = 0; j < 4; ++j) v[j] = *(const f32x4*)(X + t * DM + 4 * lane + 256 * j);
                const float rstd = row_rstd(v, 1e-6f);
#pragma unroll
                for (int j = 0; j < 4; ++j) { const int c = 4 * lane + 256 * j;
                    const f32x4 gv = *(const f32x4*)(g2 + c), scv = *(const f32x4*)(mb + 4096 + c), shv = *(const f32x4*)(mb + 3072 + c);
                    const f32x4 hv = v[j] * rstd * gv * (scv + 1.0f) + shv;
                    u32x2 w; w.x = pk2(hv.x, hv.y); w.y = pk2(hv.z, hv.w);
                    *(u32x2*)(H + t * DM + c) = w;
                    LAS float* hp = hb + tl * 1025 + c; hp[0] = hv.x; hp[1] = hv.y; hp[2] = hv.z; hp[3] = hv.w; }
            }
            __syncthreads();
            f32x16 d = (f32x16){};
            { const LAS float* ap = hb + r32 * 1025 + 128 * wave + hi;
#pragma unroll
              for (int s2 = 0; s2 < 64; ++s2) d = __builtin_amdgcn_mfma_f32_32x32x2f32(ap[2 * s2], Bw[s2], d, 0, 0, 0); }
            __syncthreads();
#pragma unroll
            for (int rg = 0; rg < 16; ++rg) hb[(wave * 16 + rg) * 64 + lane] = d[rg];
            __syncthreads();
#pragma unroll
            for (int j = 0; j < 2; ++j) { const int idx = tid + 512 * j, rg = idx >> 6, ln = idx & 63; float sm = 0.f;
#pragma unroll
                for (int w8 = 0; w8 < 8; ++w8) sm += hb[(w8 * 16 + rg) * 64 + ln];
                lg[crow(rg, ln >> 5) * 33 + (ln & 31)] = sm + rb[ln & 31]; }
            __syncthreads();
#pragma unroll 1
            for (int q = 0; q < 4; ++q) {
                const int tl = 4 * wave + q; const int t = tbase + tl;
                const int myidx = lane & 31;
                float cur = lg[tl * 33 + myidx];
                float tv[4]; int ti4[4];
#pragma unroll
                for (int k = 0; k < 4; ++k) { float bv = cur; int bi = myidx;
#pragma unroll
                    for (int off = 16; off >= 1; off >>= 1) { const float ov = __shfl_xor(bv, off); const int oi = __shfl_xor(bi, off);
                        const bool take = (ov > bv) || (ov == bv && oi < bi); bv = take ? ov : bv; bi = take ? oi : bi; }
                    tv[k] = bv; ti4[k] = bi; if (myidx == bi) cur = -INFINITY; }
                const float e1 = expf(tv[1] - tv[0]), e2 = expf(tv[2] - tv[0]), e3 = expf(tv[3] - tv[0]);
                const float inv = 1.f / (1.f + e1 + e2 + e3);
                if (lane < 4) { const int e = lane == 0 ? ti4[0] : lane == 1 ? ti4[1] : lane == 2 ? ti4[2] : ti4[3];
                    const float pr = (lane == 0 ? 1.f : lane == 1 ? e1 : lane == 2 ? e2 : e3) * inv;
                    sel[(rnd * 32 + tl) * 4 + lane] = e; TOKP[(size_t)t * 4 + lane] = pr; }
            }
            __syncthreads();
        }
        if (tid < 32) { const int e = tid; int n = 0;
            for (int i = 0; i < 256; ++i) n += (sel[i] == e) ? 1 : 0;
            unsigned run = (commit && n > 0) ? __hip_atomic_fetch_add(cnt + 16 * e, (unsigned)n, __ATOMIC_RELAXED, __HIP_MEMORY_SCOPE_AGENT) : 0u;
            for (int i = 0; i < 256; ++i) if (sel[i] == e) { const int t = tb * 64 + (i >> 2);
                if (commit) LIST[(size_t)e * NTOK + run] = t;
                TOKE[(size_t)t * 4 + (i & 3)] = ((unsigned)e << 16) | (run & 0xffffu); ++run; } }
        __syncthreads();
    }
}

__device__ __forceinline__ void build_moe_tab(const Args& a, int l, volatile LAS int* tab) {
    const unsigned* cnt = (const unsigned*)(a.ws + WS_CTL) + CW_CNT + l * 512;
    const int tid = otid();
    __syncthreads();
    if (tid < 32) tab[64 + tid] = (int)__hip_atomic_load(cnt + 16 * tid, __ATOMIC_RELAXED, __HIP_MEMORY_SCOPE_AGENT);
    __syncthreads();
    if (tid == 0) { int s = 0; for (int e = 0; e < 32; ++e) { tab[e] = s; s += (tab[64 + e] + 255) >> 8; } tab[32] = s; }
    __syncthreads();
}

__device__ __forceinline__ void phase_combine(const Args& a, int l, const LAS int* tab, bool dry = false) {
    const int tid = otid(), lane = tid & 63, wave = tid >> 6;
    unsigned char* ws = a.ws;
    float* X = (float*)(ws + WS_X);
    const bf16_t* YM = (const bf16_t*)(ws + WS_YMOE);
    const unsigned* TOKE = (const unsigned*)(ws + WS_TOKE); const float* TOKP = (const float*)(ws + WS_TOKP);
    const float* modl = (const float*)(ws + WS_MISC + MISC_MOD) + (size_t)l * 8 * 6144;
    for (int t = blockIdx.x * 8 + wave; t < NTOK; t += gridDim.x * 8) {
        f32x4 v[4], acc[4];
#pragma unroll
        for (int j = 0; j < 4; ++j) { v[j] = *(const f32x4*)(X + (size_t)t * DM + 4 * lane + 256 * j); acc[j] = (f32x4){0.f, 0.f, 0.f, 0.f}; }
#pragma unroll
        for (int k = 0; k < 4; ++k) { const unsigned ep = TOKE[(size_t)t * 4 + k]; const float pr = TOKP[(size_t)t * 4 + k];
            const int e = ep >> 16, pos = ep & 0xffff; const size_t srow = (size_t)tab[e] * 256 + pos;
#pragma unroll
            for (int j = 0; j < 4; ++j) { const u32x2 y = *(const u32x2*)(YM + srow * DM + 4 * lane + 256 * j);
                acc[j].x += pr * bflo(y.x); acc[j].y += pr * bfhi(y.x); acc[j].z += pr * bflo(y.y); acc[j].w += pr * bfhi(y.y); } }
        const float* mb = modl + (size_t)(t >> 11) * 6144;
#pragma unroll
        for (int j = 0; j < 4; ++j) { const f32x4 gt = *(const f32x4*)(mb + 5120 + 4 * lane + 256 * j); v[j] = v[j] + gt * acc[j]; }
        const float rstd = row_rstd(v, 1e-6f);
        float* Xo = dry ? (float*)(ws + WS_QA) : X; bf16_t* Ho = dry ? (bf16_t*)(ws + WS_QA + (size_t)NTOK * DM * 4) : (bf16_t*)(ws + WS_H); float* Oo = dry ? (float*)(ws + WS_QA) : a.out;
        if (l + 1 < DEPTH) {
#pragma unroll
            for (int j = 0; j < 4; ++j) *(f32x4*)(Xo + (size_t)t * DM + 4 * lane + 256 * j) = v[j];
            const float* mn = modl + (size_t)8 * 6144 + (size_t)(t >> 11) * 6144;
            norm_mod_store(v, rstd, a.in[I_N1G] + (size_t)(l + 1) * DM, mn + 1024, mn, Ho + (size_t)t * DM, lane);
        } else {
#pragma unroll
            for (int j = 0; j < 4; ++j) { const int c = 4 * lane + 256 * j; const f32x4 g = *(const f32x4*)(a.in[I_FNG] + c);
                *(f32x4*)(Oo + (size_t)t * DM + c) = v[j] * rstd * g; }
        }
    }
}

constexpr int NPL = 9;
constexpr int N_PHASES = 2 + NPL * DEPTH;
__global__ void __launch_bounds__(512, 2) fwd(Args a) {
    extern __shared__ __attribute__((aligned(16))) unsigned char smem[];
    LAS unsigned char* lds = (LAS unsigned char*)smem;
    const int tid = threadIdx.x;
    unsigned* ctl = (unsigned*)(a.ws + WS_CTL);
    volatile LAS unsigned* xbw = (volatile LAS unsigned*)(lds + LDS_CTL_OFF);
    volatile LAS int* tab = (volatile LAS int*)(lds + LDS_CTL_OFF + 256);
    volatile LAS int* qw = (volatile LAS int*)(lds + LDS_CTL_OFF + 1024);
    if (tid < 4) xbw[tid] = 0u;
    __syncthreads();
    const int lo = a.ph_lo, hi = a.ph_hi;
    XcdBarrier bar; bar.bar = ctl + CW_BAR; bar.x = 0; bar.st = xbw;
    if (hi - lo > 1) bar = xcd_barrier_post(ctl + CW_BAR, xbw);
#ifndef DUPMASK
#define DUPMASK 0
#endif
#define NREP(k) (((DUPMASK >> PHSEL(k)) & 1) ? 2 : 1)
#ifndef BRMASK
#define BRMASK 7
#endif
#ifndef PHMASK
#define PHMASK 0xFFFFF
#endif
#define PHSEL(k) ((k) < 2 ? (k) : 2 + ((k) - 2) % NPL)
#define IN(k) (((PHMASK >> PHSEL(k)) & 1) && lo <= (k) && (k) < hi)
#define SEAM(k) do { if (IN(k) && IN((k) + 1)) { xcd_barrier(bar); } } while (0)
    unsigned char* ws = a.ws;
    if (IN(0)) { for (int rep = 0; rep < NREP(0); ++rep) { phase_p0(a, lds); __syncthreads(); } SEAM(0); }
    if (IN(1)) { phase_norm1(a, 0); SEAM(1); }
    for (int l = 0; l < DEPTH; ++l) {
        const int pb = 2 + NPL * l;
        if (IN(pb + 0)) {
          for (int rep = 0; rep < NREP(pb + 0); ++rep) {
            pg8::StaticOrder S; S.init(NTOK, PLD, gridDim.x, blockIdx.x);
            pg8::EpiProj E{(bf16_t*)(ws + WS_PROJ), PLD, 29};
            pg8::gemm_phase<pg8::EpiProj, pg8::StaticOrder>(lds, (const bf16_t*)(ws + WS_H), (const bf16_t*)(ws + WS_WIN) + (size_t)l * PLD * DM, DM, 0, S, E);
          }
            SEAM(pb + 0);
        }
        if (IN(pb + 1)) { for (int rep = 0; rep < NREP(pb + 1) + ((DUPMASK >> 17) & 1); ++rep) { phase_rwkv_r1(a, l, lds); } for (int rep = 0; rep < NREP(pb + 1) + ((DUPMASK >> 16) & 1); ++rep) phase_swa(a, lds); SEAM(pb + 1); }
        if (IN(pb + 2)) {
          for (int rep = 0; rep < NREP(pb + 2); ++rep) {
            {
                pg8::StaticOrder S; S.init(NTOK, RW, gridDim.x, blockIdx.x);
                pg8::EpiProj E{(bf16_t*)(ws + WS_GG), RW, 1 << 30};
                pg8::gemm_phase<pg8::EpiProj, pg8::StaticOrder>(lds, (const bf16_t*)(ws + WS_GS), (const bf16_t*)(ws + WS_MISC + MISC_GUPT) + (size_t)l * RW * 256, 256, 0, S, E);
            }
            for (int u = blockIdx.x; u < 192; u += gridDim.x) rwkv_r2_unit(a, u, lds);
            for (;;) {
                if (tid == 0) *qw = (int)__hip_atomic_fetch_add(ctl + CW_QH + 64 * (2 * l + rep), 1u, __ATOMIC_RELAXED, __HIP_MEMORY_SCOPE_AGENT);
                __syncthreads();
                const int item = *qw;
                __syncthreads();
                if (item >= 768) break;
                diffattn_unit(a, l, item, lds);
            }
          }
            SEAM(pb + 2);
        }
        if (IN(pb + 3)) { for (int rep = 0; rep < NREP(pb + 3); ++rep) phase_rwkv_out(a, l); SEAM(pb + 3); }
        if (IN(pb + 4)) {
          for (int rep = 0; rep < NREP(pb + 4); ++rep) {
            pg8::StaticOrder S; S.init(NTOK, DM, gridDim.x, blockIdx.x);
            const bf16_t* P = (const bf16_t*)(ws + WS_PROJ); float* MF = (float*)(ws + WS_MF); bf16_t* MG = (bf16_t*)(ws + WS_MERGED);
            { pg8::EpiBranchM E{P, MG}; pg8::gemm_phase<pg8::EpiBranchM, pg8::StaticOrder>(lds, (const bf16_t*)(ws + WS_OA), (const bf16_t*)(ws + WS_WA) + (size_t)l * DM * 1792, 1792, 0, S, E); }
          }
            SEAM(pb + 4);
        }
        if (IN(pb + 5)) {
            pg8::StaticOrder S; S.init(NTOK, DM, gridDim.x, blockIdx.x);
            pg8::EpiOut E{l == 0 ? a.in[I_X] : (const float*)(ws + WS_X), (float*)(ws + WS_X), (const float*)(ws + WS_MISC + MISC_MOD) + (size_t)l * 8 * 6144 + 2048};
            pg8::gemm_phase<pg8::EpiOut, pg8::StaticOrder>(lds, (const bf16_t*)(ws + WS_MERGED), (const bf16_t*)(ws + WS_WO) + (size_t)l * DM * DM, DM, 0, S, E);
            SEAM(pb + 5);
        }
        if (IN(pb + 6)) { for (int rep = 0; rep < NREP(pb + 6); ++rep) phase_route(a, l, lds, rep == NREP(pb + 6) - 1); SEAM(pb + 6); }
        if (IN(pb + 7)) {
          for (int rep = 0; rep < NREP(pb + 7); ++rep) {
            build_moe_tab(a, l, tab);
            unsigned* rtc = ctl + CW_RT + (l * 2 + rep) * 2048;
            {
                pg8::MoeOrder<true> S{(const LAS int*)tab, (const int*)(ws + WS_LIST), 8, (int)gridDim.x, (int)blockIdx.x, rtc};
                pg8::EpiMoe1 E{(bf16_t*)(ws + WS_ACT), a.in[I_B1] + (size_t)l * NE * 2 * FF};
                pg8::gemm_phase<pg8::EpiMoe1, pg8::MoeOrder<true>>(lds, (const bf16_t*)(ws + WS_H), (const bf16_t*)(ws + WS_W1) + (size_t)l * NE * 2 * FF * DM, DM, (size_t)2 * FF * DM * 2, S, E);
            }
            {
                pg8::MoeOrder<false> S{(const LAS int*)tab, nullptr, 4, (int)gridDim.x, (int)(gridDim.x - 1 - blockIdx.x), rtc};
                pg8::EpiMoe2 E{(bf16_t*)(ws + WS_YMOE), a.in[I_B2] + (size_t)l * NE * DM};
                pg8::gemm_phase<pg8::EpiMoe2, pg8::MoeOrder<false>>(lds, (const bf16_t*)(ws + WS_ACT), (const bf16_t*)(ws + WS_W2) + (size_t)l * NE * DM * FF, FF, (size_t)DM * FF * 2, S, E);
            }
          }
            SEAM(pb + 7);
        }
        if (IN(pb + 8)) { build_moe_tab(a, l, tab); for (int rep = 0; rep < NREP(pb + 8); ++rep) phase_combine(a, l, (const LAS int*)tab, rep != NREP(pb + 8) - 1); SEAM(pb + 8); }
    }
#undef IN
#undef SEAM
}

#ifndef MK_ONE_LAUNCH
#define MK_ONE_LAUNCH 1
#endif
extern "C" void kernel_launch(void* const* d_in, const int* in_sizes, int n_in, void* d_out, int out_size, void* d_ws, size_t ws_size, hipStream_t stream) {
    static int grid = 0;
    if (grid == 0) {
        if (n_in != 32 || ws_size < WS_END) { fprintf(stderr, "kernel_launch: unexpected n_in %d or ws %zu < %zu\n", n_in, ws_size, (size_t)WS_END); grid = -1; return; }
        int dev = 0, cus = 0;
        if (hipGetDevice(&dev) != hipSuccess || hipDeviceGetAttribute(&cus, hipDeviceAttributeMultiprocessorCount, dev) != hipSuccess) { grid = -1; return; }
        if (hipFuncSetAttribute((const void*)fwd, hipFuncAttributeMaxDynamicSharedMemorySize, LDS_BYTES) != hipSuccess) { fprintf(stderr, "kernel_launch: hipFuncSetAttribute failed\n"); grid = -1; return; }
        int per_cu = 0;
        if (hipOccupancyMaxActiveBlocksPerMultiprocessor(&per_cu, (const void*)fwd, 512, LDS_BYTES) != hipSuccess || per_cu < 1) fprintf(stderr, "kernel_launch: occupancy query says %d\n", per_cu);
        (void)hipGetLastError();
        grid = cus;
    }
    if (grid < 0) return;
    (void)hipMemsetAsync((char*)d_ws + WS_CTL, 0, CTL_BYTES, stream);
    Args a{};
    for (int i = 0; i < 32; ++i) a.in[i] = (const float*)d_in[i];
    a.out = (float*)d_out; a.ws = (unsigned char*)d_ws;
#if MK_ONE_LAUNCH
    a.ph_lo = 0; a.ph_hi = N_PHASES;
    hipLaunchKernelGGL(fwd, dim3(grid), dim3(512), LDS_BYTES, stream, a);
#else
    for (int p = 0; p < N_PHASES; ++p) { a.ph_lo = p; a.ph_hi = p + 1; hipLaunchKernelGGL(fwd, dim3(grid), dim3(512), LDS_BYTES, stream, a); }
#endif
}
```

```cpp
#include <hip/hip_runtime.h>
#include <stdint.h>
#include <stdio.h>

#define LAS __attribute__((address_space(3)))
typedef unsigned short bf16_t;
typedef short bf16x8 __attribute__((ext_vector_type(8)));
typedef short s16x4 __attribute__((ext_vector_type(4)));
typedef float f32x2 __attribute__((ext_vector_type(2)));
typedef float f32x4 __attribute__((ext_vector_type(4)));
typedef float f32x16 __attribute__((ext_vector_type(16)));
typedef unsigned u32x2 __attribute__((ext_vector_type(2)));
typedef unsigned u32x4 __attribute__((ext_vector_type(4)));
typedef __bf16 bf16x2_t __attribute__((ext_vector_type(2)));
typedef short v4i16_t __attribute__((ext_vector_type(4)));

constexpr int NB = 8, NT = 2048, DM = 1024, NTOK = NB * NT, DEPTH = 2;
constexpr int IN_COLS = 10368, PLD = 10496;
constexpr int C_AQ = 0, C_AK = 768, C_AV = 1536, C_BS = 2304, C_CQ = 5120, C_CK = 5888, C_CV = 6656, C_G = 7424;
constexpr int RSTR = 2688, RW = 768, NE = 32, FF = 1024;
constexpr float LOG2E = 1.4426950408889634f;

constexpr size_t al256(size_t x) { return (x + 255) & ~(size_t)255; }
constexpr size_t WS_CTL = 0;
constexpr size_t CTL_BYTES = 65536;
constexpr size_t WS_MISC = WS_CTL + CTL_BYTES;
constexpr size_t MISC_MOD = 0, MISC_LAM = 393216, MISC_BIASA = 393472, MISC_BIASC = 399872, MISC_WUPT = 409600, MISC_AUPT = 409600 + 393216, MISC_GUPT = 409600 + 2 * 393216, MISC_BYTES = 2 << 20;
constexpr size_t WS_WIN = WS_MISC + MISC_BYTES;
constexpr size_t WS_WA = WS_WIN + (size_t)DEPTH * PLD * DM * 2;
constexpr size_t WS_WB = WS_WA + (size_t)DEPTH * DM * 256 * 2;
constexpr size_t WS_WC = WS_WB + (size_t)DEPTH * DM * 768 * 2;
constexpr size_t WS_WO = WS_WC + (size_t)DEPTH * DM * 768 * 2;
constexpr size_t WS_W1 = WS_WO + (size_t)DEPTH * DM * DM * 2;
constexpr size_t WS_W2 = WS_W1 + (size_t)DEPTH * NE * 2 * FF * DM * 2;
constexpr size_t WS_H = WS_W2 + (size_t)DEPTH * NE * DM * FF * 2;
constexpr size_t WS_X = WS_H + (size_t)NTOK * DM * 2;
constexpr size_t WS_OA = WS_X + (size_t)NTOK * DM * 4;
constexpr size_t WS_OB = WS_OA + (size_t)NTOK * 256 * 2;
constexpr size_t WS_OC = WS_OB + (size_t)NTOK * 768 * 2;
constexpr size_t WS_MERGED = WS_OC + (size_t)NTOK * 768 * 2;
constexpr size_t WS_LIST = WS_MERGED + (size_t)NTOK * DM * 2;
constexpr size_t WS_TOKE = WS_LIST + (size_t)NE * NTOK * 4;
constexpr size_t WS_TOKP = WS_TOKE + (size_t)NTOK * 4 * 4;
constexpr size_t WS_U = WS_TOKP + (size_t)NTOK * 4 * 4;
constexpr size_t WS_PROJ = WS_U;
constexpr size_t WS_RR = WS_PROJ + (size_t)NTOK * PLD * 2;
constexpr size_t WS_RV = WS_RR + (size_t)NTOK * RW * 4;
constexpr size_t WS_RWD = WS_RV + (size_t)NTOK * RW * 4;
constexpr size_t WS_RKK = WS_RWD + (size_t)2 * NTOK * RW * 4;
constexpr size_t WS_RKKA = WS_RKK + (size_t)2 * NTOK * RW * 4;
constexpr size_t WS_RKD = WS_RKKA + (size_t)2 * NTOK * RW * 4;
constexpr size_t WS_GS = WS_RKD + (size_t)2 * NTOK * RW * 4;
constexpr size_t WS_Y = WS_GS + (size_t)NTOK * 128 * 4;
constexpr size_t WS_OAG = WS_Y + (size_t)2 * NTOK * RW * 4;
constexpr size_t WS_LSE = WS_OAG + (size_t)3 * NTOK * 256 * 4;
constexpr size_t WS_MF = WS_LSE + (size_t)3 * NTOK * 4 * 4;
constexpr size_t WS_QA = WS_MF + (size_t)NTOK * DM * 4;
constexpr size_t WS_SS = WS_QA + (size_t)6144 * 4096 * 2;
constexpr size_t WS_END1 = WS_SS + (size_t)6144 * 4096 * 2;
constexpr size_t WS_GG = WS_Y;
constexpr size_t WS_MP = WS_RWD, WS_NP = WS_RKK, WS_Y0 = WS_RKKA;
constexpr int SLOT_ROWS = 4 * NTOK + NE * 256;
constexpr size_t WS_ACT = WS_U;
constexpr size_t WS_YMOE = WS_ACT + (size_t)SLOT_ROWS * FF * 2;
constexpr size_t WS_END2 = WS_YMOE + (size_t)SLOT_ROWS * DM * 2;
constexpr size_t WS_END = WS_END1 > WS_END2 ? WS_END1 : WS_END2;

constexpr int CW_BAR = 0;
constexpr int CW_CNT = 13312;
constexpr int CW_QH = 4224;
constexpr int CW_RT = 5120;

constexpr int LDS_STAGE = 155648;
constexpr int LDS_CTL_OFF = LDS_STAGE;
constexpr int LDS_BYTES = LDS_STAGE + 4096;

__device__ __forceinline__ int otid() { int t = threadIdx.x; asm volatile("" : "+v"(t)); return t; }
__device__ __forceinline__ int obid() { int t = blockIdx.x; asm volatile("" : "+s"(t)); return t; }
__device__ __forceinline__ unsigned pk2(float lo, float hi) { f32x2 v = {lo, hi}; bf16x2_t b = __builtin_convertvector(v, bf16x2_t); return __builtin_bit_cast(unsigned, b); }
__device__ __forceinline__ u32x4 pack8(const float (&x)[8]) { u32x4 w; w.x = pk2(x[0], x[1]); w.y = pk2(x[2], x[3]); w.z = pk2(x[4], x[5]); w.w = pk2(x[6], x[7]); return w; }
__device__ __forceinline__ bf16_t f2bf(float x) { return (bf16_t)(pk2(x, 0.f) & 0xffffu); }
__device__ __forceinline__ float bflo(unsigned u) { return __builtin_bit_cast(float, u << 16); }
__device__ __forceinline__ float bfhi(unsigned u) { return __builtin_bit_cast(float, u & 0xffff0000u); }
__device__ __forceinline__ float bf2f(bf16_t h) { return __builtin_bit_cast(float, (unsigned)h << 16); }
__device__ __forceinline__ float wave_sum(float v) {
#pragma unroll
    for (int o = 1; o < 64; o <<= 1) v += __shfl_xor(v, o);
    return v;
}
__device__ __forceinline__ float sigmoidf_(float x) { return __builtin_amdgcn_rcpf(1.f + __builtin_amdgcn_exp2f(-LOG2E * x)); }
__device__ __forceinline__ int crow(int r, int hi) { return (r & 3) + 8 * (r >> 2) + 4 * hi; }
__device__ __forceinline__ s16x4 vtr(const LAS unsigned char* p) { return __builtin_bit_cast(s16x4, __builtin_amdgcn_ds_read_tr16_b64_v4i16((LAS v4i16_t*)p)); }
__device__ __forceinline__ float dpp_sum8(float x) {
    int v = __builtin_bit_cast(int, x);
    x += __builtin_bit_cast(float, __builtin_amdgcn_update_dpp(0, v, 0xB1, 0xF, 0xF, true));
    v = __builtin_bit_cast(int, x);
    x += __builtin_bit_cast(float, __builtin_amdgcn_update_dpp(0, v, 0x4E, 0xF, 0xF, true));
    v = __builtin_bit_cast(int, x);
    x += __builtin_bit_cast(float, __builtin_amdgcn_update_dpp(0, v, 0x141, 0xF, 0xF, true));
    return x;
}

#define XB_TMO      128
#define XB_XCNT(j)  (256  + 64 * (j))
#define XB_XSUB(j)  (1280 + 64 * (j))
#define XB_XGEN(j)  (2304 + 64 * (j))
#define XB_TOP      3328
#define XB_TOPGEN   3392
#define XCD_BAR_WORDS 3456
#define XB_SPIN_CAP (1u << 18)
__device__ __forceinline__ unsigned xb_ld(unsigned* p)              { return __hip_atomic_load(p, __ATOMIC_RELAXED, __HIP_MEMORY_SCOPE_AGENT); }
__device__ __forceinline__ unsigned xb_add(unsigned* p, unsigned v) { return __hip_atomic_fetch_add(p, v, __ATOMIC_RELAXED, __HIP_MEMORY_SCOPE_AGENT); }
__device__ __forceinline__ unsigned xb_xcc_id() { return (unsigned)__builtin_amdgcn_s_getreg((3 << 11) | 20) & 0xFu; }
#define XB_SPIN(cond, bar) do { unsigned _sp = 0; while (cond) { __builtin_amdgcn_s_sleep(1); \
    if ((++_sp & 255u) == 0u) { if (xb_ld(&(bar)[XB_TMO])) break; if (_sp > XB_SPIN_CAP) { atomicAdd(&(bar)[XB_TMO], 1u); break; } } } } while (0)
struct XcdBarrier { unsigned* bar; unsigned x; volatile LAS unsigned* st; };
__device__ __forceinline__ XcdBarrier xcd_barrier_post(unsigned* bar, volatile LAS unsigned* st) {
    XcdBarrier b; b.bar = bar; b.x = xb_xcc_id(); b.st = st;
    if (threadIdx.x == 0) (void)xb_add(&bar[XB_XCNT(b.x)], 1u);
    return b;
}
__device__ __forceinline__ void xcd_barrier_complete(unsigned* bar, unsigned x, unsigned& nloc, unsigned& nx) {
    const unsigned G = gridDim.x * gridDim.y * gridDim.z;
    unsigned sum, cnt, mine, sp = 0u;
    for (;;) {
        sum = 0u; cnt = 0u; mine = 0u;
#pragma unroll
        for (unsigned j = 0; j < 16; ++j) { const unsigned c = xb_ld(&bar[XB_XCNT(j)]); sum += c; cnt += (c > 0u) ? 1u : 0u; mine = (j == x) ? c : mine; }
        if (sum == G) break;
        __builtin_amdgcn_s_sleep(1);
        if ((++sp & 255u) == 0u) { if (xb_ld(&bar[XB_TMO])) break; if (sp > XB_SPIN_CAP) { atomicAdd(&bar[XB_TMO], 1u); break; } }
    }
    nloc = mine > 0u ? mine : 1u; nx = cnt > 0u ? cnt : 1u;
}
__device__ __forceinline__ void xcd_barrier(const XcdBarrier& b) {
    asm volatile("s_waitcnt vmcnt(0)" ::: "memory");
    __syncthreads();
    if (threadIdx.x == 0) {
        unsigned* bar = b.bar;
        __builtin_amdgcn_s_waitcnt(0);
        unsigned nloc = b.st[0], nx = b.st[1];
        if (nloc == 0u) { xcd_barrier_complete(bar, b.x, nloc, nx); b.st[0] = nloc; b.st[1] = nx; }
        const unsigned old = xb_add(&bar[XB_XSUB(b.x)], 1u);
        const unsigned gen = old / nloc;
        if (old + 1u == (gen + 1u) * nloc) {
            __builtin_amdgcn_fence(__ATOMIC_RELEASE, "agent");
            asm volatile("s_waitcnt vmcnt(0)" ::: "memory");
            const unsigned og = xb_add(&bar[XB_TOP], 1u);
            const unsigned tg = og / nx;
            if (og + 1u == (tg + 1u) * nx) xb_add(&bar[XB_TOPGEN], 1u);
            else XB_SPIN(xb_ld(&bar[XB_TOPGEN]) == tg, bar);
            __builtin_amdgcn_fence(__ATOMIC_ACQUIRE, "agent");
            xb_add(&bar[XB_XGEN(b.x)], 1u);
            asm volatile("s_waitcnt vmcnt(0)" ::: "memory");
        } else {
            XB_SPIN(xb_ld(&bar[XB_XGEN(b.x)]) == gen, bar);
            __builtin_amdgcn_fence(__ATOMIC_ACQUIRE, "agent");
            asm volatile("s_waitcnt vmcnt(0)" ::: "memory");
        }
    }
    __syncthreads();
}

namespace pg8 {
constexpr int BM = 256, BK = 64, HALF = 128, HTB = HALF * BK * 2, STAGE_BYTES = 8 * HTB, NXCD = 8, WGM = 8;
__device__ __forceinline__ int lds_byte(int r, int c) { const int st = (r >> 4) * 2 + (c >> 5), rr = r & 15, cc = c & 31, ob = rr * 64 + cc * 2; return st * 1024 + (ob ^ (((ob >> 9) & 1) << 5)); }
__device__ __forceinline__ void stage_rc(int b, int& R, int& C) { const int st = b / 1024, sb = b % 1024, swz = sb ^ (((sb >> 9) & 1) << 5); R = (st >> 1) * 16 + swz / 64; C = (st & 1) * 32 + (swz % 64) / 2; }
__device__ __forceinline__ int perm32(int rho) { const int n = rho >> 4, i = rho & 15; return 8 * (i >> 2) + 4 * n + (i & 3); }

struct Unit { int pm, pn, e, lt; };

struct StaticOrder {
    static constexpr bool GATHER = false;
    int nM, nN, nwg, G, c;
    __device__ void init(int M, int N, int G_, int c_) { nM = M / BM; nN = N / BM; nwg = nM * nN; G = G_; c = c_; }
    __device__ __forceinline__ bool next(int i, Unit& u) const {
        const long L = (long)i * G + c; if (L >= nwg) return false;
        int wgid = (int)L; { const int q = nwg / NXCD, r = nwg % NXCD, xcd = wgid % NXCD, off = wgid / NXCD; wgid = (xcd < r ? xcd * (q + 1) : r * (q + 1) + (xcd - r) * q) + off; }
        const int nig = WGM * nN, gid = wgid / nig, fm = gid * WGM, gsz = (nM - fm) < WGM ? (nM - fm) : WGM;
        u.pm = fm + ((wgid % nig) % gsz); u.pn = (wgid % nig) / gsz; u.e = 0; u.lt = 0; return true;
    }
    __device__ __forceinline__ int arow(const Unit& u, int r) const { return u.pm * BM + r; }
    __device__ __forceinline__ void a_ready(const Unit&) const {}
    __device__ __forceinline__ void done(const Unit&) const {}
};
template <bool GATHER_> struct MoeOrder {
    static constexpr bool GATHER = GATHER_;
    const LAS int* tab;
    const int* list;
    int ncol, G, c;
    __device__ __forceinline__ bool next(int i, Unit& u) const {
        if (true) {
            const int L = i * G + c; const int total = tab[32] * ncol; if (L >= total) return false;
            const int rt = L / ncol; u.pn = L - rt * ncol; u.pm = rt;
            int e = 0;
#pragma unroll 1
            for (int j = 1; j < 32; ++j) e = (tab[j] <= rt) ? j : e;
            u.e = e; u.lt = rt - tab[e]; return true;
        }
        const int x = c & 7, W = G >> 3; int q = i * W + (c >> 3);
#pragma unroll 1
        for (int k = 0; k < 4; ++k) { const int e = x + 8 * k; const int nt_e = tab[e + 1] - tab[e], sz = nt_e * ncol;
            if (q < sz) { const int lt = q / ncol; u.pn = q - lt * ncol; u.lt = lt; u.e = e; u.pm = tab[e] + lt; return true; }
            q -= sz; }
        return false;
    }
    __device__ __forceinline__ int arow(const Unit& u, int r) const {
        if (!GATHER_) return u.pm * BM + r;
        const int pos = u.lt * BM + r; const int cnt = tab[64 + u.e];
        return pos < cnt ? list[(size_t)u.e * NTOK + pos] : 0;
    }
    unsigned* rtc;
    __device__ __forceinline__ void done(const Unit& u) const {
        if (GATHER_) { asm volatile("s_waitcnt vmcnt(0)" ::: "memory");
            if ((threadIdx.x & 63) == 0) __hip_atomic_fetch_add(rtc + 16 * u.pm, 1u, __ATOMIC_RELAXED, __HIP_MEMORY_SCOPE_AGENT); }
    }
    __device__ __forceinline__ void a_ready(const Unit& u) const {
        if (!GATHER_) {
            if (threadIdx.x < 64) {
                unsigned sp = 0;
                while ((unsigned)__builtin_amdgcn_readfirstlane(__hip_atomic_load(rtc + 16 * u.pm, __ATOMIC_RELAXED, __HIP_MEMORY_SCOPE_AGENT)) < 64u) {
                    __builtin_amdgcn_s_sleep(2); if (++sp > (1u << 22)) break; }
                __builtin_amdgcn_fence(__ATOMIC_ACQUIRE, "agent");
                asm volatile("s_waitcnt vmcnt(0)" ::: "memory");
            }
            asm volatile("" ::: "memory"); __builtin_amdgcn_s_barrier(); asm volatile("" ::: "memory");
        }
    }
};

template <class Epi, class Sched>
__device__ __forceinline__ void gemm_phase(LAS unsigned char* lds, const bf16_t* A, const bf16_t* Bt, const int K, const size_t b_estride_bytes, const Sched& S, const Epi& E) {
    constexpr bool GATHER = Sched::GATHER;
    const int tid = otid(), wid = __builtin_amdgcn_readfirstlane(tid >> 6), lane = tid & 63, wr = wid >> 2, wc = wid & 3, fr = lane & 15, fq = lane >> 4;
    const int nt = K / BK;
    int Rr[2], Cc[2]; unsigned voffA[2], voffB[2];
#pragma unroll
    for (int i = 0; i < 2; ++i) { int R, C; stage_rc(tid * 16 + i * 8192, R, C); const int Rb = Epi::PERM ? ((R & ~31) + perm32(R & 31)) : R;
        Rr[i] = R; Cc[i] = C; voffA[i] = (unsigned)(R * K + C) * 2u; voffB[i] = (unsigned)(Rb * K + C) * 2u; }
    const size_t kstep = (size_t)(BK * 2);
    const size_t hstep = (size_t)HALF * K * 2;
    const size_t tstep = 2 * hstep;
    const unsigned ldsw = (unsigned)wid * 1024u;
    const int aoff = lds_byte(wr * 64 + fr, fq * 8), boff = lds_byte(wc * 32 + fr, fq * 8);
#define PG8_SA(b, h) (((b) * 2 + (h)) * HTB)
#define PG8_SB(b, h) ((4 + (b) * 2 + (h)) * HTB)
#define PG8_STAGE(bufoff, gbase, voff) do { _Pragma("unroll") for (int _i = 0; _i < 2; ++_i) \
        __builtin_amdgcn_global_load_lds((const unsigned*)((const char*)(gbase) + (voff)[_i]), (LAS unsigned*)(lds + (bufoff) + ldsw + _i * 8192), 16, 0, 0); } while (0)
#define PG8_STAGEA(bufoff, uptr, offs, h, kb) do { _Pragma("unroll") for (int _i = 0; _i < 2; ++_i) { const char* _src; \
        if constexpr (GATHER) _src = (const char*)A + (size_t)(offs)[h][_i] + (size_t)(kb); else _src = (uptr) + (size_t)(h) * hstep + (size_t)(kb) + voffA[_i]; \
        __builtin_amdgcn_global_load_lds((const unsigned*)_src, (LAS unsigned*)(lds + (bufoff) + ldsw + _i * 8192), 16, 0, 0); } } while (0)
#define PG8_LDA(dst, b, h) do { _Pragma("unroll") for (int m = 0; m < 4; ++m) _Pragma("unroll") for (int k = 0; k < 2; ++k) dst[m][k] = *(const LAS bf16x8*)(lds + PG8_SA(b, h) + aoff + m * 2048 + k * 1024); } while (0)
#define PG8_LDB(dst, b, h) do { _Pragma("unroll") for (int n = 0; n < 2; ++n) _Pragma("unroll") for (int k = 0; k < 2; ++k) dst[n][k] = *(const LAS bf16x8*)(lds + PG8_SB(b, h) + boff + n * 2048 + k * 1024); } while (0)
#define PG8_MMA(ai, bj, At, Bt_) do { __builtin_amdgcn_s_setprio(1); _Pragma("unroll") for (int m = 0; m < 4; ++m) _Pragma("unroll") for (int n = 0; n < 2; ++n) _Pragma("unroll") for (int k = 0; k < 2; ++k) \
        acc[ai][bj][m][n] = __builtin_amdgcn_mfma_f32_16x16x32_bf16(Bt_[n][k], At[m][k], acc[ai][bj][m][n], 0, 0, 0); __builtin_amdgcn_s_setprio(0); } while (0)
#define PG8_WAIT_V(n) asm volatile("s_waitcnt vmcnt(" #n ")" ::: "memory")
#define PG8_WAIT_L(n) asm volatile("s_waitcnt lgkmcnt(" #n ")" ::: "memory")
#define PG8_BAR __builtin_amdgcn_s_barrier()
#define PG8_SCHED __builtin_amdgcn_sched_barrier(0)
#define PG8_AOFFS(dst, u) do { if constexpr (GATHER) { _Pragma("unroll") for (int _h = 0; _h < 2; ++_h) _Pragma("unroll") for (int _i = 0; _i < 2; ++_i) \
        dst[_h][_i] = ((unsigned)S.arow(u, _h * HALF + Rr[_i]) * (unsigned)K + (unsigned)Cc[_i]) * 2u; } } while (0)
    Unit cur, nxt; int ui = 0;
    if (!S.next(0, cur)) return;
    f32x4 acc[2][2][4][2];
#pragma unroll
    for (int a = 0; a < 2; ++a)
#pragma unroll
        for (int b = 0; b < 2; ++b)
#pragma unroll
            for (int m = 0; m < 4; ++m)
#pragma unroll
                for (int n = 0; n < 2; ++n) acc[a][b][m][n] = (f32x4){0.f, 0.f, 0.f, 0.f};
    bf16x8 At[4][2], B0[2][2], B1[2][2];
    unsigned aoc[2][2] = {{0u, 0u}, {0u, 0u}}, aon[2][2] = {{0u, 0u}, {0u, 0u}};
    PG8_AOFFS(aoc, cur);
    const char* cA = (const char*)A + (size_t)cur.pm * tstep;
    const char* cB = (const char*)Bt + (size_t)cur.e * b_estride_bytes + (size_t)cur.pn * tstep;
    S.a_ready(cur);
    PG8_STAGE(PG8_SB(0, 0), cB, voffB); PG8_STAGEA(PG8_SA(0, 0), cA, aoc, 0, 0); PG8_STAGE(PG8_SB(0, 1), cB + hstep, voffB); PG8_STAGEA(PG8_SA(0, 1), cA, aoc, 1, 0);
    if (wr == 1) PG8_BAR;
    PG8_WAIT_V(4); PG8_BAR;
    PG8_STAGE(PG8_SB(1, 0), cB + kstep, voffB); PG8_STAGEA(PG8_SA(1, 0), cA, aoc, 0, kstep); PG8_STAGE(PG8_SB(1, 1), cB + hstep + kstep, voffB);
    PG8_WAIT_V(6); PG8_BAR;
    for (;;) {
        const bool has_next = S.next(ui + 1, nxt);
        const char* nA = has_next ? (const char*)A + (size_t)nxt.pm * tstep : cA;
        const char* nB = has_next ? (const char*)Bt + (size_t)nxt.e * b_estride_bytes + (size_t)nxt.pn * tstep : cB;
        if constexpr (GATHER) {
            if (has_next) { PG8_AOFFS(aon, nxt); } else {
#pragma unroll
                for (int h = 0; h < 2; ++h)
#pragma unroll
                    for (int i = 0; i < 2; ++i) aon[h][i] = aoc[h][i]; } }
#define PG8_KITER(t) do { \
            const bool last = (t == nt - 2); \
            const size_t k1 = (size_t)(t + 1) * kstep; \
            const size_t k2 = last ? (size_t)0 : (size_t)(t + 2) * kstep; \
            const size_t k3 = k2 + kstep; \
            const char* a2p = last ? nA : cA; \
            unsigned a2o[2][2]; \
_Pragma("unroll") \
            for (int h = 0; h < 2; ++h) \
_Pragma("unroll") \
                for (int i = 0; i < 2; ++i) a2o[h][i] = last ? aon[h][i] : aoc[h][i]; \
            const char* b2 = last ? nB : cB + (size_t)(t + 2) * kstep; const char* b3 = b2 + kstep; \
            if (last && has_next) S.a_ready(nxt); \
            PG8_LDB(B0, 0, 0); PG8_SCHED; PG8_LDA(At, 0, 0); PG8_STAGEA(PG8_SA(1, 1), cA, aoc, 1, k1); \
            PG8_WAIT_L(8); PG8_BAR; PG8_WAIT_L(0); PG8_MMA(0, 0, At, B0); PG8_BAR; PG8_SCHED; \
            PG8_LDB(B1, 0, 1); PG8_STAGE(PG8_SB(0, 0), b2, voffB); \
            PG8_BAR; PG8_WAIT_L(0); PG8_MMA(0, 1, At, B1); PG8_BAR; \
            PG8_LDA(At, 0, 1); PG8_STAGEA(PG8_SA(0, 0), a2p, a2o, 0, k2); \
            PG8_BAR; PG8_WAIT_L(0); PG8_MMA(1, 0, At, B0); PG8_BAR; PG8_SCHED; \
            PG8_STAGE(PG8_SB(0, 1), b2 + hstep, voffB); \
            PG8_WAIT_V(6); PG8_BAR; PG8_MMA(1, 1, At, B1); PG8_BAR; \
            PG8_LDB(B0, 1, 0); PG8_SCHED; PG8_LDA(At, 1, 0); PG8_STAGEA(PG8_SA(0, 1), a2p, a2o, 1, k2); \
            PG8_WAIT_L(8); PG8_BAR; PG8_WAIT_L(0); PG8_MMA(0, 0, At, B0); PG8_BAR; PG8_SCHED; \
            PG8_LDB(B1, 1, 1); PG8_STAGE(PG8_SB(1, 0), b3, voffB); \
            PG8_BAR; PG8_WAIT_L(0); PG8_MMA(0, 1, At, B1); PG8_BAR; \
            PG8_LDA(At, 1, 1); PG8_STAGEA(PG8_SA(1, 0), a2p, a2o, 0, k3); \
            PG8_BAR; PG8_WAIT_L(0); PG8_MMA(1, 0, At, B0); PG8_BAR; PG8_SCHED; \
            PG8_STAGE(PG8_SB(1, 1), b3 + hstep, voffB); \
            PG8_WAIT_V(6); PG8_BAR; PG8_MMA(1, 1, At, B1); PG8_BAR; \
        } while (0)
        if constexpr (Epi::MIDHOOK) {
#pragma unroll 1
            for (int t = 0; t < Epi::T1; t += 2) PG8_KITER(t);
            asm volatile("" ::: "memory"); __builtin_amdgcn_sched_barrier(0); E.mid(acc, cur, 0, wr, wc, fr, fq); asm volatile("" ::: "memory"); __builtin_amdgcn_sched_barrier(0);
#pragma unroll 1
            for (int t = Epi::T1; t < Epi::T2; t += 2) PG8_KITER(t);
            asm volatile("" ::: "memory"); __builtin_amdgcn_sched_barrier(0); E.mid(acc, cur, 1, wr, wc, fr, fq); asm volatile("" ::: "memory"); __builtin_amdgcn_sched_barrier(0);
#pragma unroll 1
            for (int t = Epi::T2; t < nt; t += 2) PG8_KITER(t);
        } else {
#pragma unroll 1
            for (int t = 0; t < nt; t += 2) PG8_KITER(t);
        }
#undef PG8_KITER
        E(acc, cur, wr, wc, fr, fq); S.done(cur);
        if (!has_next) break;
#pragma unroll
        for (int a = 0; a < 2; ++a)
#pragma unroll
            for (int b = 0; b < 2; ++b)
#pragma unroll
                for (int m = 0; m < 4; ++m)
#pragma unroll
                    for (int n = 0; n < 2; ++n) acc[a][b][m][n] = (f32x4){0.f, 0.f, 0.f, 0.f};
        cur = nxt; cA = nA; cB = nB; ++ui;
#pragma unroll
        for (int h = 0; h < 2; ++h)
#pragma unroll
            for (int i = 0; i < 2; ++i) aoc[h][i] = aon[h][i];
    }
    PG8_WAIT_V(0);
    if (wr == 0) PG8_BAR;
    PG8_BAR;
#undef PG8_SA
#undef PG8_SB
#undef PG8_STAGE
#undef PG8_STAGEA
#undef PG8_LDA
#undef PG8_LDB
#undef PG8_MMA
#undef PG8_WAIT_V
#undef PG8_WAIT_L
#undef PG8_BAR
#undef PG8_SCHED
#undef PG8_AOFFS
}

typedef f32x4 Acc[2][2][4][2];

struct EpiProj {
    static constexpr bool PERM = true, MIDHOOK = false;
    bf16_t* O; int ld; int sg_from;
    __device__ __forceinline__ void operator()(const Acc& acc, const Unit& u, int wr, int wc, int fr, int fq) const {
        const int row0 = u.pm * BM + wr * 64 + fr, col0 = u.pn * BM + wc * 32 + 8 * fq; const bool sg = u.pn >= sg_from;
#pragma unroll
        for (int ai = 0; ai < 2; ++ai)
#pragma unroll
            for (int m = 0; m < 4; ++m) { bf16_t* rowp = O + (size_t)(row0 + ai * HALF + m * 16) * ld + col0;
#pragma unroll
                for (int bj = 0; bj < 2; ++bj) { f32x4 v0 = acc[ai][bj][m][0], v1 = acc[ai][bj][m][1];
                    if (sg) {
#pragma unroll
                        for (int j = 0; j < 4; ++j) { v0[j] = sigmoidf_(v0[j]); v1[j] = sigmoidf_(v1[j]); } }
                    u32x4 w; w.x = pk2(v0[0], v0[1]); w.y = pk2(v0[2], v0[3]); w.z = pk2(v1[0], v1[1]); w.w = pk2(v1[2], v1[3]);
                    *(u32x4*)(rowp + bj * HALF) = w; } }
    }
};
template <int SEG> struct EpiBranch {
    static constexpr bool PERM = true, MIDHOOK = false;
    const bf16_t* P; float* MF; bf16_t* MG;
    __device__ __forceinline__ void operator()(const Acc& acc, const Unit& u, int wr, int wc, int fr, int fq) const {
        const int row0 = u.pm * BM + wr * 64 + fr, col0 = u.pn * BM + wc * 32 + 8 * fq;
#pragma unroll
        for (int ai = 0; ai < 2; ++ai)
#pragma unroll
            for (int m = 0; m < 4; ++m) { const size_t r = (size_t)(row0 + ai * HALF + m * 16);
                asm volatile("" ::: "memory");
#pragma unroll
                for (int bj = 0; bj < 2; ++bj) { const int c = col0 + bj * HALF;
                    const u32x4 g = *(const u32x4*)(P + r * PLD + C_G + SEG * 1024 + c);
                    f32x4 v0 = acc[ai][bj][m][0], v1 = acc[ai][bj][m][1];
                    v0[0] *= bflo(g.x); v0[1] *= bfhi(g.x); v0[2] *= bflo(g.y); v0[3] *= bfhi(g.y);
                    v1[0] *= bflo(g.z); v1[1] *= bfhi(g.z); v1[2] *= bflo(g.w); v1[3] *= bfhi(g.w);
                    float* mp = MF + r * DM + c;
                    if (SEG > 0) { v0 += *(const f32x4*)mp; v1 += *(const f32x4*)(mp + 4); }
                    if (SEG < 2) { *(f32x4*)mp = v0; *(f32x4*)(mp + 4) = v1; }
                    else { u32x4 w; w.x = pk2(v0[0], v0[1]); w.y = pk2(v0[2], v0[3]); w.z = pk2(v1[0], v1[1]); w.w = pk2(v1[2], v1[3]); *(u32x4*)(MG + r * DM + c) = w; } } }
    }
};
struct EpiBranchM {
    static constexpr bool PERM = true, MIDHOOK = true;
    static constexpr int T1 = 4, T2 = 16;
    const bf16_t* P; bf16_t* MG;
    __device__ __forceinline__ void mid(Acc& acc, const Unit& u, int seg, int wr, int wc, int fr, int fq) const {
        const unsigned off0 = ((unsigned)(u.pm * BM + wr * 64 + fr) * (unsigned)PLD + (unsigned)(C_G + seg * 1024 + u.pn * BM + wc * 32 + 8 * fq)) * 2u;
        const char* Pb = (const char*)P;
#pragma unroll
        for (int ai = 0; ai < 2; ++ai)
#pragma unroll
            for (int m = 0; m < 4; ++m) {
#pragma unroll
                for (int bj = 0; bj < 2; ++bj) { const unsigned off = off0 + (unsigned)(((ai * HALF + m * 16) * PLD + bj * HALF) * 2);
                    const u32x4 gp = *(const u32x4*)(Pb + off), gn = *(const u32x4*)(Pb + off + 2048u);
#pragma unroll
                    for (int q = 0; q < 4; ++q) { const float r0 = bflo(gp[q]) * __builtin_amdgcn_rcpf(fmaxf(bflo(gn[q]), 1e-30f)), r1 = bfhi(gp[q]) * __builtin_amdgcn_rcpf(fmaxf(bfhi(gn[q]), 1e-30f));
                        acc[ai][bj][m][q >> 1][2 * (q & 1)] *= r0; acc[ai][bj][m][q >> 1][2 * (q & 1) + 1] *= r1; }
                    asm volatile("" : "+v"(acc[ai][bj][m][0]), "+v"(acc[ai][bj][m][1]) :: "memory"); } }
    }
    __device__ __forceinline__ void operator()(const Acc& acc, const Unit& u, int wr, int wc, int fr, int fq) const {
        const int row0 = u.pm * BM + wr * 64 + fr, col0 = u.pn * BM + wc * 32 + 8 * fq;
#pragma unroll
        for (int ai = 0; ai < 2; ++ai)
#pragma unroll
            for (int m = 0; m < 4; ++m) { const size_t r = (size_t)(row0 + ai * HALF + m * 16);
                asm volatile("" ::: "memory");
#pragma unroll
                for (int bj = 0; bj < 2; ++bj) { const int c = col0 + bj * HALF;
                    const u32x4 g = *(const u32x4*)(P + r * PLD + C_G + 2 * 1024 + c);
                    f32x4 v0 = acc[ai][bj][m][0], v1 = acc[ai][bj][m][1];
                    v0[0] *= bflo(g.x); v0[1] *= bfhi(g.x); v0[2] *= bflo(g.y); v0[3] *= bfhi(g.y);
                    v1[0] *= bflo(g.z); v1[1] *= bfhi(g.z); v1[2] *= bflo(g.w); v1[3] *= bfhi(g.w);
                    u32x4 w; w.x = pk2(v0[0], v0[1]); w.y = pk2(v0[2], v0[3]); w.z = pk2(v1[0], v1[1]); w.w = pk2(v1[2], v1[3]); *(u32x4*)(MG + r * DM + c) = w; } }
    }
};
struct EpiOut {
    static constexpr bool PERM = false, MIDHOOK = false;
    const float* xsrc; float* X; const float* gt;
    __device__ __forceinline__ void operator()(const Acc& acc, const Unit& u, int wr, int wc, int fr, int fq) const {
        const int row0 = u.pm * BM + wr * 64 + fr, col0 = u.pn * BM + wc * 32 + 4 * fq;
        const float* gp = gt + (size_t)((u.pm * BM) >> 11) * 6144 + col0;
        f32x4 gv[2][2];
#pragma unroll
        for (int bj = 0; bj < 2; ++bj)
#pragma unroll
            for (int n = 0; n < 2; ++n) gv[bj][n] = *(const f32x4*)(gp + bj * HALF + n * 16);
#pragma unroll
        for (int ai = 0; ai < 2; ++ai)
#pragma unroll
            for (int m = 0; m < 4; ++m) { const size_t o = (size_t)(row0 + ai * HALF + m * 16) * DM + col0;
#pragma unroll
                for (int bj = 0; bj < 2; ++bj)
#pragma unroll
                    for (int n = 0; n < 2; ++n) { const f32x4 xv = *(const f32x4*)(xsrc + o + bj * HALF + n * 16);
                        *(f32x4*)(X + o + bj * HALF + n * 16) = xv + gv[bj][n] * acc[ai][bj][m][n]; } }
    }
};
struct EpiMoe1 {
    static constexpr bool PERM = true, MIDHOOK = false;
    bf16_t* ACT; const float* b1;
    __device__ __forceinline__ void operator()(const Acc& acc, const Unit& u, int wr, int wc, int fr, int fq) const {
        const int row0 = u.pm * BM + wr * 64 + fr, col0 = u.pn * BM + wc * 32 + 8 * fq;
        const float* bp = b1 + (size_t)u.e * (2 * FF) + col0;
        f32x4 bv[2][2];
#pragma unroll
        for (int bj = 0; bj < 2; ++bj)
#pragma unroll
            for (int n = 0; n < 2; ++n) bv[bj][n] = *(const f32x4*)(bp + bj * HALF + 4 * n);
#pragma unroll
        for (int ai = 0; ai < 2; ++ai)
#pragma unroll
            for (int m = 0; m < 4; ++m) { bf16_t* rowp = ACT + (size_t)(row0 + ai * HALF + m * 16) * FF + (col0 >> 1);
#pragma unroll
                for (int bj = 0; bj < 2; ++bj) { const f32x4 v0 = acc[ai][bj][m][0] + bv[bj][0], v1 = acc[ai][bj][m][1] + bv[bj][1];
                    float a[4];
#pragma unroll
                    for (int q = 0; q < 4; ++q) { const float gl = (q < 2) ? v0[2 * q] : v1[2 * q - 4], ln = (q < 2) ? v0[2 * q + 1] : v1[2 * q - 3];
                        const float xg = fminf(gl, 7.0f), xl = fminf(fmaxf(ln, -7.0f), 7.0f);
                        a[q] = xg * sigmoidf_(1.702f * xg) * (xl + 1.0f); }
                    const unsigned long long w = (unsigned long long)pk2(a[0], a[1]) | ((unsigned long long)pk2(a[2], a[3]) << 32);
                    __hip_atomic_store((unsigned long long*)(rowp + bj * (HALF / 2)), w, __ATOMIC_RELAXED, __HIP_MEMORY_SCOPE_AGENT); } }
    }
};
struct EpiMoe2 {
    static constexpr bool PERM = true, MIDHOOK = false;
    bf16_t* Y; const float* b2;
    __device__ __forceinline__ void operator()(const Acc& acc, const Unit& u, int wr, int wc, int fr, int fq) const {
        const int row0 = u.pm * BM + wr * 64 + fr, col0 = u.pn * BM + wc * 32 + 8 * fq;
        const float* bp = b2 + (size_t)u.e * DM + col0;
        f32x4 bv[2][2];
#pragma unroll
        for (int bj = 0; bj < 2; ++bj)
#pragma unroll
            for (int n = 0; n < 2; ++n) bv[bj][n] = *(const f32x4*)(bp + bj * HALF + 4 * n);
#pragma unroll
        for (int ai = 0; ai < 2; ++ai)
#pragma unroll
            for (int m = 0; m < 4; ++m) { bf16_t* rowp = Y + (size_t)(row0 + ai * HALF + m * 16) * DM + col0;
#pragma unroll
                for (int bj = 0; bj < 2; ++bj) { const f32x4 v0 = acc[ai][bj][m][0] + bv[bj][0], v1 = acc[ai][bj][m][1] + bv[bj][1];
                    u32x4 w; w.x = pk2(v0[0], v0[1]); w.y = pk2(v0[2], v0[3]); w.z = pk2(v1[0], v1[1]); w.w = pk2(v1[2], v1[3]);
                    *(u32x4*)(rowp + bj * HALF) = w; } }
    }
};
}

struct Args { const float* in[32]; float* out; unsigned char* ws; int ph_lo, ph_hi; };
enum { I_X = 0, I_C, I_WMOD, I_BMOD, I_N1G, I_N2G, I_WIN, I_MU, I_W0, I_WUP, I_A0, I_AUP, I_GUP, I_KK, I_KA, I_RK, I_LNG, I_LNB, I_DLAM, I_SUBG, I_RELB, I_WBA, I_WBB, I_WBC, I_WOUT, I_RW, I_RB, I_W1, I_B1, I_W2, I_B2, I_FNG };

__device__ __forceinline__ void lds_fence() { asm volatile("s_waitcnt lgkmcnt(0)" ::: "memory"); }

__device__ __forceinline__ void tr_item(const float* W, int ldw, int ncols, bf16_t* WT, int K, LAS float* scr, int item, int lane) {
    const int nblk = ncols >> 5, kb = item / nblk, nb = item - kb * nblk, k0 = 64 * kb, n0 = 32 * nb;
#pragma unroll 8
    for (int i = 0; i < 32; ++i) { const int kk = 2 * i + (lane >> 5); scr[kk * 33 + (lane & 31)] = W[(size_t)(k0 + kk) * ldw + n0 + (lane & 31)]; }
    lds_fence();
    const int c = lane & 7;
#pragma unroll
    for (int j = 0; j < 4; ++j) { const int n = (lane >> 3) + 8 * j; const LAS float* s = scr + (8 * c) * 33 + n;
        u32x4 o; o.x = pk2(s[0 * 33], s[1 * 33]); o.y = pk2(s[2 * 33], s[3 * 33]); o.z = pk2(s[4 * 33], s[5 * 33]); o.w = pk2(s[6 * 33], s[7 * 33]);
        *(u32x4*)(WT + (size_t)(n0 + n) * K + k0 + 8 * c) = o; }
    lds_fence();
}
__device__ __forceinline__ int t5_bucket(int rel) {
    const int ret = rel > 0 ? 16 : 0; const int n = rel < 0 ? -rel : rel;
    int v;
    if (n < 8) v = n; else if (n < 12) v = 8; else if (n < 16) v = 9; else if (n < 23) v = 10; else if (n < 32) v = 11;
    else if (n < 46) v = 12; else if (n < 64) v = 13; else if (n < 91) v = 14; else v = 15;
    return ret + v;
}
__device__ __forceinline__ void phase_p0(const Args& a, LAS unsigned char* lds) {
    const int tid = otid(), lane = tid & 63, wave = tid >> 6, G = gridDim.x;
    unsigned char* ws = a.ws;
    {
        LAS float* scr = (LAS float*)(lds + wave * 8448);
        const int gw = blockIdx.x * 8 + wave, NGW = G * 8;
        constexpr int NITEMS = 65536 + 32768 + 2 * 6592;
        for (int it = gw; it < NITEMS; it += NGW) {
            int r = it;
            if (r < 65536) { const int mat = r >> 10; tr_item(a.in[I_W1] + (size_t)mat * DM * 2 * FF, 2 * FF, 2 * FF, (bf16_t*)(ws + WS_W1) + (size_t)mat * 2 * FF * DM, DM, scr, r & 1023, lane); continue; }
            r -= 65536;
            if (r < 32768) { const int mat = r >> 9; tr_item(a.in[I_W2] + (size_t)mat * FF * DM, DM, DM, (bf16_t*)(ws + WS_W2) + (size_t)mat * DM * FF, FF, scr, r & 511, lane); continue; }
            r -= 32768;
            const int l = r / 6592; r -= l * 6592;
            if (r < 2496) { tr_item(a.in[I_WIN] + (size_t)l * DM * IN_COLS, IN_COLS, 4992, (bf16_t*)(ws + WS_WIN) + (size_t)l * PLD * DM, DM, scr, r, lane); continue; }
            r -= 2496;
            if (r < 2688) { tr_item(a.in[I_WIN] + (size_t)l * DM * IN_COLS + 4992, IN_COLS, 5376, (bf16_t*)(ws + WS_WIN) + (size_t)l * PLD * DM + (size_t)5120 * DM, DM, scr, r, lane); continue; }
            r -= 2688;
            if (r < 128) { tr_item(a.in[I_WBA] + (size_t)l * 256 * DM, DM, DM, (bf16_t*)(ws + WS_WA) + (size_t)l * DM * 1792, 1792, scr, r, lane); continue; }
            r -= 128;
            if (r < 384) { tr_item(a.in[I_WBB] + (size_t)l * 768 * DM, DM, DM, (bf16_t*)(ws + WS_WA) + (size_t)l * DM * 1792 + 256, 1792, scr, r, lane); continue; }
            r -= 384;
            if (r < 384) { tr_item(a.in[I_WBC] + (size_t)l * 768 * DM, DM, DM, (bf16_t*)(ws + WS_WA) + (size_t)l * DM * 1792 + 1024, 1792, scr, r, lane); continue; }
            r -= 384;
            tr_item(a.in[I_WOUT] + (size_t)l * DM * DM, DM, DM, (bf16_t*)(ws + WS_WO) + (size_t)l * DM * DM, DM, scr, r, lane);
        }
        for (int i = blockIdx.x * 512 + tid; i < 2 * 128 * DM / 8; i += G * 512) {
            const int l = i / (128 * DM / 8), o = i - l * (128 * DM / 8);
            *(u32x4*)((bf16_t*)(ws + WS_WIN) + (size_t)l * PLD * DM + (size_t)4992 * DM + (size_t)o * 8) = (u32x4){0u, 0u, 0u, 0u};
        }
    }
    {
        bf16_t* WT = (bf16_t*)(ws + WS_MISC + MISC_WUPT); bf16_t* AT = (bf16_t*)(ws + WS_MISC + MISC_AUPT);
        for (int i = blockIdx.x * 512 + tid; i < 2 * 2 * 12 * 4096; i += G * 512) {
            const int j = i & 63, k = (i >> 6) & 63, hd = (i >> 12) % 12, ld = i / (12 * 4096);
            const size_t src = ((size_t)ld * 64 + j) * RW + hd * 64 + k;
            WT[i] = (bf16_t)(pk2(a.in[I_WUP][src], 0.f) & 0xffffu); AT[i] = (bf16_t)(pk2(a.in[I_AUP][src], 0.f) & 0xffffu);
        }
    }
    {
        bf16_t* GT = (bf16_t*)(ws + WS_MISC + MISC_GUPT);
        for (int i = blockIdx.x * 512 + tid; i < 2 * 768 * 256; i += G * 512) {
            const int k = i & 255, n = (i >> 8) % 768, l2 = i / (768 * 256);
            GT[i] = k < 128 ? f2bf(a.in[I_GUP][((size_t)l2 * 128 + k) * RW + n]) : (bf16_t)0;
        }
    }
    __syncthreads();
    if ((int)blockIdx.x < 192) {
        LAS float* sc = (LAS float*)(lds + 69632);
        LAS float* red = (LAS float*)(lds + 102400);
        for (int i = tid; i < NB * DM; i += 512) { const float v = a.in[I_C][i]; sc[i] = v / (1.f + expf(-v)); }
        __syncthreads();
        float* mod = (float*)(ws + WS_MISC + MISC_MOD);
        for (int j = blockIdx.x; j < 192; j += G) {
            const int l = j / 96, n0 = (j - l * 96) * 64, jj = tid & 63, ks = tid >> 6;
            float acc[8];
#pragma unroll
            for (int b = 0; b < 8; ++b) acc[b] = 0.f;
            const float* wp = a.in[I_WMOD] + ((size_t)l * DM + ks * 128) * 6144 + n0 + jj;
            for (int k = 0; k < 128; ++k) { const float w = wp[(size_t)k * 6144];
#pragma unroll
                for (int b = 0; b < 8; ++b) acc[b] += sc[b * DM + ks * 128 + k] * w; }
#pragma unroll
            for (int b = 0; b < 8; ++b) red[(ks * 8 + b) * 64 + jj] = acc[b];
            __syncthreads();
            { const int b = tid >> 6; float s = 0.f;
#pragma unroll
              for (int k2 = 0; k2 < 8; ++k2) s += red[(k2 * 8 + b) * 64 + jj];
              mod[((size_t)l * 8 + b) * 6144 + n0 + jj] = s + a.in[I_BMOD][(size_t)l * 6144 + n0 + jj]; }
            __syncthreads();
        }
    }
    if ((int)blockIdx.x == G - 1) {
        float* lam = (float*)(ws + WS_MISC + MISC_LAM);
        if (tid < 2) { const int l = tid; const float* dl = a.in[I_DLAM] + (size_t)l * 256; float s01 = 0.f, s23 = 0.f;
            for (int d = 0; d < 64; ++d) { s01 += dl[d] * dl[64 + d]; s23 += dl[128 + d] * dl[192 + d]; }
            const float li = 0.8f - 0.6f * expf(-0.3f * (float)l);
            lam[l] = expf(s01) - expf(s23) + li; lam[2 + l] = li; }
        float* bA = (float*)(ws + WS_MISC + MISC_BIASA);
        for (int i = tid; i < 12 * 129; i += 512) { const int head = i / 129, jj = i - head * 129, g = head >> 2; const int dil = (g == 0) ? 1 : (g == 1) ? 4 : 16;
            bA[i] = a.in[I_RELB][t5_bucket((jj - 64) * dil) * 18 + head] * LOG2E; }
        float* bC = (float*)(ws + WS_MISC + MISC_BIASC);
        for (int i = tid; i < 6 * 257; i += 512) { const int h = i / 257, rel = i - h * 257 - 128;
            bC[i] = a.in[I_RELB][t5_bucket(rel) * 18 + 12 + h] * LOG2E; }
    }
}

__device__ __forceinline__ float row_rstd(const f32x4 (&v)[4], float eps) {
    float s = 0.f;
#pragma unroll
    for (int j = 0; j < 4; ++j) s += (v[j].x * v[j].x + v[j].y * v[j].y) + (v[j].z * v[j].z + v[j].w * v[j].w);
    return rsqrtf(wave_sum(s) * (1.f / DM) + eps);
}
__device__ __forceinline__ void norm_mod_store(const f32x4 (&v)[4], float rstd, const float* g, const float* sc, const float* sh, bf16_t* orow, int lane) {
#pragma unroll
    for (int j = 0; j < 4; ++j) { const int c = 4 * lane + 256 * j;
        const f32x4 gv = *(const f32x4*)(g + c), scv = *(const f32x4*)(sc + c), shv = *(const f32x4*)(sh + c);
        const f32x4 y = v[j] * rstd * gv * (scv + 1.0f) + shv;
        u32x2 w; w.x = pk2(y.x, y.y); w.y = pk2(y.z, y.w);
        *(u32x2*)(orow + c) = w; }
}
__device__ __forceinline__ void phase_norm1(const Args& a, int l) {
    const int tid = otid(), lane = tid & 63, wave = tid >> 6;
    const float* mod = (const float*)(a.ws + WS_MISC + MISC_MOD) + (size_t)l * 8 * 6144;
    bf16_t* H = (bf16_t*)(a.ws + WS_H);
    for (int t = blockIdx.x * 8 + wave; t < NTOK; t += gridDim.x * 8) {
        const float* xr = a.in[I_X] + (size_t)t * DM; f32x4 v[4];
#pragma unroll
        for (int j = 0; j < 4; ++j) v[j] = *(const f32x4*)(xr + 4 * lane + 256 * j);
        const float rstd = row_rstd(v, 1e-6f);
        const float* mb = mod + (size_t)(t >> 11) * 6144;
        norm_mod_store(v, rstd, a.in[I_N1G] + (size_t)l * DM, mb + 1024, mb, H + (size_t)t * DM, lane);
    }
}

__device__ __forceinline__ void swa_wave_unit(const bf16_t* P, float* OAG, float* LSE, const LAS float* biasA, LAS unsigned char* vbuf, int u, int lane) {
    const int b = u / 768; const int rem = u - b * 768; const int head = rem >> 6, s = rem & 63;
    const int g = head >> 2, hh = head & 3;
    const int dsh = (g == 0) ? 0 : (g == 1) ? 2 : 4;
    const int L = NT >> dsh, nmbsh = 6 - dsh;
    const int r = s >> nmbsh, mb = s & ((1 << nmbsh) - 1);
    const int r32 = lane & 31, hi = lane >> 5;
    const size_t tq = (size_t)b * NT + ((mb * 32 + r32) << dsh) + r;
    bf16x8 qf[4];
    { const bf16_t* qp = P + tq * PLD + C_AQ + head * 64 + 8 * hi;
#pragma unroll
      for (int s4 = 0; s4 < 4; ++s4) qf[s4] = *(const bf16x8*)(qp + 16 * s4); }
    f32x16 o[2]; o[0] = (f32x16){}; o[1] = (f32x16){};
    float m = -1e30f, lsum = 0.f;
    const float SC = 0.125f * LOG2E;
    const LAS float* bh = biasA + head * 129 + 64;
    const int trbase = (4 * hi + ((lane & 15) >> 2)) * 144 + (16 * ((lane >> 4) & 1) + 4 * (lane & 3)) * 2;
    const int kt_lo = (-mb > -2) ? -mb : -2, kt_hi = ((L >> 5) - 1 - mb < 2) ? (L >> 5) - 1 - mb : 2;
    bf16x8 kfn[4]; u32x4 vn[4];
#define SWA_LOAD(ktx) do { const int _m0 = mb * 32 + (ktx) * 32; \
        { int km = _m0 + r32; km = km < 0 ? 0 : (km > L - 1 ? L - 1 : km); \
          const bf16_t* kp = P + ((size_t)b * NT + (km << dsh) + r) * PLD + C_AK + head * 64 + 8 * hi; \
          _Pragma("unroll") for (int s4 = 0; s4 < 4; ++s4) kfn[s4] = *(const bf16x8*)(kp + 16 * s4); } \
        _Pragma("unroll") for (int c4 = 0; c4 < 4; ++c4) { const int id = lane + 64 * c4, row = id >> 3, ch = id & 7; \
            int vm = _m0 + row; vm = vm < 0 ? 0 : (vm > L - 1 ? L - 1 : vm); \
            vn[c4] = *(const u32x4*)(P + ((size_t)b * NT + (vm << dsh) + r) * PLD + C_AV + head * 64 + ch * 8); } } while (0)
    SWA_LOAD(kt_lo);
    for (int kt = kt_lo; kt <= kt_hi; ++kt) {
        const int m0 = mb * 32 + kt * 32;
        bf16x8 kf[4];
#pragma unroll
        for (int s4 = 0; s4 < 4; ++s4) kf[s4] = kfn[s4];
        asm volatile("" ::: "memory");
#pragma unroll
        for (int c4 = 0; c4 < 4; ++c4) { const int id = lane + 64 * c4, row = id >> 3, ch = id & 7; *(LAS u32x4*)(vbuf + row * 144 + ch * 16) = vn[c4]; }
        if (kt < kt_hi) SWA_LOAD(kt + 1);
        f32x16 sacc = (f32x16){};
#pragma unroll
        for (int s4 = 0; s4 < 4; ++s4) sacc = __builtin_amdgcn_mfma_f32_32x32x16_bf16(kf[s4], qf[s4], sacc, 0, 0, 0);
        float x[16]; float mx = -1e30f;
#pragma unroll
        for (int rg = 0; rg < 16; ++rg) { const int kvl = crow(rg, hi), km = m0 + kvl, j = kt * 32 + kvl - r32;
            const bool valid = (km >= 0) && (km < L) && (j >= -64) && (j <= 64);
            const int jc = j < -64 ? -64 : (j > 64 ? 64 : j);
            const float xv = sacc[rg] * SC + bh[jc];
            x[rg] = valid ? xv : -1e30f; mx = fmaxf(mx, x[rg]); }
        mx = fmaxf(mx, __shfl_xor(mx, 32));
        const float mn = fmaxf(m, mx), alpha = __builtin_amdgcn_exp2f(m - mn); m = mn;
        float ps = 0.f;
#pragma unroll
        for (int rg = 0; rg < 16; ++rg) { x[rg] = __builtin_amdgcn_exp2f(x[rg] - mn); ps += x[rg]; }
        lsum = lsum * alpha + ps;
#pragma unroll
        for (int rg = 0; rg < 16; ++rg) { o[0][rg] *= alpha; o[1][rg] *= alpha; }
        u32x4 pw[2];
#pragma unroll
        for (int s2 = 0; s2 < 2; ++s2) { pw[s2].x = pk2(x[8 * s2 + 0], x[8 * s2 + 1]); pw[s2].y = pk2(x[8 * s2 + 2], x[8 * s2 + 3]); pw[s2].z = pk2(x[8 * s2 + 4], x[8 * s2 + 5]); pw[s2].w = pk2(x[8 * s2 + 6], x[8 * s2 + 7]); }
        lds_fence();
#pragma unroll
        for (int db = 0; db < 2; ++db)
#pragma unroll
            for (int s2 = 0; s2 < 2; ++s2) {
                const s16x4 lo = vtr(vbuf + trbase + (16 * s2) * 144 + db * 64);
                const s16x4 hi4 = vtr(vbuf + trbase + (16 * s2 + 8) * 144 + db * 64);
                const bf16x8 af = (bf16x8){lo[0], lo[1], lo[2], lo[3], hi4[0], hi4[1], hi4[2], hi4[3]};
                o[db] = __builtin_amdgcn_mfma_f32_32x32x16_bf16(af, __builtin_bit_cast(bf16x8, pw[s2]), o[db], 0, 0, 0);
            }
        asm volatile("" ::: "memory");
    }
#undef SWA_LOAD
    const float lt = lsum + __shfl_xor(lsum, 32);
    const float inv = 1.f / lt;
    bf16_t* op = (bf16_t*)OAG + ((size_t)g * NTOK + tq) * 256 + hh * 64;
#pragma unroll
    for (int db = 0; db < 2; ++db)
#pragma unroll
        for (int i = 0; i < 4; ++i) { u32x2 w; w.x = pk2(o[db][4 * i] * inv, o[db][4 * i + 1] * inv); w.y = pk2(o[db][4 * i + 2] * inv, o[db][4 * i + 3] * inv);
            *(u32x2*)(op + db * 32 + 8 * i + 4 * hi) = w; }
    if (hi == 0) LSE[((size_t)g * NTOK + tq) * 4 + hh] = m + __log2f(lt);
}
__device__ __forceinline__ void phase_swa(const Args& a, LAS unsigned char* lds) {
    const int tid = otid(), lane = tid & 63, wave = tid >> 6;
    LAS float* bA = (LAS float*)(lds + 40960);
    const float* bAg = (const float*)(a.ws + WS_MISC + MISC_BIASA);
    for (int i = tid; i < 12 * 129; i += 512) bA[i] = bAg[i];
    __syncthreads();
    for (int item = blockIdx.x; item < 768; item += gridDim.x)
        swa_wave_unit((const bf16_t*)(a.ws + WS_PROJ), (float*)(a.ws + WS_OAG), (float*)(a.ws + WS_LSE), bA, lds + wave * 4608, item * 8 + wave, lane);
    __syncthreads();
}

constexpr int RLD = 144, RMAT = 64 * RLD;
constexpr int R_P = 0, R_Q = 4 * RMAT, R_M = R_Q + 2 * 17408;
constexpr int R_WD = R_P, R_AD = R_P + RMAT, R_WUP = R_P + 2 * RMAT, R_AUP = R_P + 3 * RMAT;
constexpr int R_LK = R_P, R_RK = R_P + RMAT, R_RB = R_P + 2 * RMAT, R_TT = R_P + 3 * RMAT;
constexpr int R_ZW = R_Q, R_ZA = R_Q + 17408, R_LBF = R_Q, R_SEG = R_ZA, R_GC = R_ZA + 2048, R_W1T = R_ZA + 4096;
constexpr int R_A = R_M, R_B = R_M + 2 * RMAT, R_BP = R_M + 3 * RMAT, R_K = R_M + 4 * RMAT, R_KP = R_M + 5 * RMAT, R_RHO = R_M + 6 * RMAT, R_V = R_M + 7 * RMAT;
constexpr int R_UT = R_B, R_TAT = R_K;
constexpr int R_TMP0 = R_SEG, R_TMP1 = R_ZA + 13312, R_TMP2 = R_ZA + 13312 + 2048;
constexpr int R_PAR = R_M + 8 * RMAT, NPAR = 960;
static_assert(R_PAR + 2 * NPAR * 4 <= LDS_STAGE, "R1 LDS");

template <bool XT, bool YT>
__device__ __forceinline__ f32x16 tile64x(const LAS unsigned char* XM, int x0, const LAS unsigned char* YM, int y0, int lane, f32x16 acc) {
    const int r32 = lane & 31, hi = lane >> 5;
    const int trofs = ((lane & 15) >> 2) * RLD + (16 * ((lane >> 4) & 1) + 4 * (lane & 3)) * 2;
#pragma unroll
    for (int s4 = 0; s4 < 4; ++s4) {
        bf16x8 xa, yb;
        if (!XT) xa = *(const LAS bf16x8*)(XM + (x0 + r32) * RLD + 32 * s4 + 16 * hi);
        else { const s16x4 lo = vtr(XM + (16 * s4 + 8 * hi) * RLD + trofs + 2 * x0), h4 = vtr(XM + (16 * s4 + 8 * hi + 4) * RLD + trofs + 2 * x0);
               xa = (bf16x8){lo[0], lo[1], lo[2], lo[3], h4[0], h4[1], h4[2], h4[3]}; }
        if (!YT) yb = *(const LAS bf16x8*)(YM + (y0 + r32) * RLD + 32 * s4 + 16 * hi);
        else { const s16x4 lo = vtr(YM + (16 * s4 + 8 * hi) * RLD + trofs + 2 * y0), h4 = vtr(YM + (16 * s4 + 8 * hi + 4) * RLD + trofs + 2 * y0);
               yb = (bf16x8){lo[0], lo[1], lo[2], lo[3], h4[0], h4[1], h4[2], h4[3]}; }
        acc = __builtin_amdgcn_mfma_f32_32x32x16_bf16(xa, yb, acc, 0, 0, 0);
    }
    return acc;
}
template <class MP>
__device__ __forceinline__ void shift8r(const u32x4 c, u32x4 m, u32x4 n, bool hm, bool hn, MP mu0, MP mu1, float (&o)[8]) {
    const unsigned mm = hm ? 0xffffffffu : 0u, nm = hn ? 0xffffffffu : 0u;
    m = m & mm; n = n & nm;
#pragma unroll
    for (int q = 0; q < 4; ++q) {
        const float pl = bflo(c[q]), ph = bfhi(c[q]);
        o[2 * q] = pl + mu0[2 * q] * (bflo(m[q]) - pl) + mu1[2 * q] * (bflo(n[q]) - pl);
        o[2 * q + 1] = ph + mu0[2 * q + 1] * (bfhi(m[q]) - ph) + mu1[2 * q + 1] * (bfhi(n[q]) - ph);
    }
}
__device__ __forceinline__ float r1_param(const Args& a, int l, int h, int dir, int idx) {
    const int j = idx & 63, row = idx >> 6;
    if (row < 10) { const int g = row >> 1, which = row & 1; const int col = (g < 3 ? g * 768 + h * 64 : (g == 3 ? 2304 : 2432) + dir * 64) + j;
        return a.in[I_MU][(size_t)l * 2 * RSTR + (size_t)which * RSTR + col]; }
    const int cb = (l * 2 + dir) * RW + h * 64 + j;
    if (row == 10) return a.in[I_W0][cb];
    if (row == 11) return a.in[I_A0][cb];
    if (row == 12) return a.in[I_KK][cb];
    if (row == 13) return a.in[I_KA][cb];
    return a.in[I_RK][(size_t)l * RW + h * 64 + j];
}
__device__ __forceinline__ int r1_col(int g, int h, int dir, int seg) { return (g < 3 ? g * 768 + h * 64 : (g == 3 ? 2304 : 2432) + dir * 64) + 8 * seg; }
__device__ __forceinline__ void r1_issue(const bf16_t* P, int ct, int tid, u32x4 (&raw)[15]) {
    const int c = ct & 31, dir = (ct >> 5) & 1, bh = ct >> 6, h = bh % 12, b = bh / 12, ti = tid >> 3, seg = tid & 7;
    const int tseq = dir ? (NT - 1 - 64 * c - ti) : (64 * c + ti);
    const bf16_t* p0 = P + ((size_t)b * NT + tseq) * PLD + C_BS;
    const int dm = tseq > 0 ? PLD : 0, dn = tseq < NT - 1 ? PLD : 0;
#pragma unroll
    for (int g = 0; g < 5; ++g) { const int col = r1_col(g, h, dir, seg);
        raw[3 * g] = *(const u32x4*)(p0 + col); raw[3 * g + 1] = *(const u32x4*)(p0 + col - dm); raw[3 * g + 2] = *(const u32x4*)(p0 + col + dn); }
}

__device__ __forceinline__ void phase_rwkv_r1(const Args& a, int l, LAS unsigned char* lds) {
    const int tid0 = otid();
    unsigned char* ws = a.ws;
    const bf16_t* P = (const bf16_t*)(ws + WS_PROJ);
    const float* mu = a.in[I_MU] + (size_t)l * 2 * RSTR;
    const int G = gridDim.x;
    u32x4 raw[15], wup4, aup4;
    if ((int)blockIdx.x < 6144) { r1_issue(P, blockIdx.x, tid0, raw);
        { const int c0 = blockIdx.x; const size_t wofs = ((size_t)(l * 2 + ((c0 >> 5) & 1)) * 12 + ((c0 >> 6) % 12)) * 4096 + (size_t)(tid0 >> 3) * 64 + 8 * (tid0 & 7);
          wup4 = *(const u32x4*)((const bf16_t*)(ws + WS_MISC + MISC_WUPT) + wofs); aup4 = *(const u32x4*)((const bf16_t*)(ws + WS_MISC + MISC_AUPT) + wofs); }
        const int ct0 = blockIdx.x, bh0 = ct0 >> 6;
        LAS float* pt = (LAS float*)(lds + R_PAR);
        pt[tid0] = r1_param(a, l, bh0 % 12, (ct0 >> 5) & 1, tid0); if (tid0 + 512 < NPAR) pt[tid0 + 512] = r1_param(a, l, bh0 % 12, (ct0 >> 5) & 1, tid0 + 512); }
    __syncthreads();
    int itn = 0;
    f32x16 po0 = (f32x16){}, po1 = (f32x16){}; int ctp = -1;
#define R1_FLUSH(ctq, LANE, WAVE) do { const int _r32 = (LANE) & 31, _hi = (LANE) >> 5, _tt = (WAVE) & 3, _tm = _tt >> 1, _tn = _tt & 1; const size_t _cto = (size_t)(ctq) * 4096; \
        if ((WAVE) < 4) { bf16_t* QA = (bf16_t*)(ws + WS_QA) + _cto; float* MP = (float*)(ws + WS_MP) + _cto; \
            _Pragma("unroll") for (int q = 0; q < 4; ++q) { u32x2 w; w.x = pk2(po0[4 * q], po0[4 * q + 1]); w.y = pk2(po0[4 * q + 2], po0[4 * q + 3]); \
                *(u32x2*)(QA + ((_tn * 4 + 2 * _tm + (q >> 1)) * 64 + (q & 1) * 32 + _r32) * 8 + 4 * _hi) = w; \
                *(f32x4*)(MP + (32 * _tn + _r32) * 64 + 32 * _tm + 8 * q + 4 * _hi) = (f32x4){po1[4 * q], po1[4 * q + 1], po1[4 * q + 2], po1[4 * q + 3]}; } \
        } else { unsigned* Y0 = (unsigned*)(ws + WS_Y0) + (size_t)(ctq) * 2048 + _tt * 512 + (LANE); float* NP = (float*)(ws + WS_NP) + _cto; \
            _Pragma("unroll") for (int p = 0; p < 8; ++p) Y0[p * 64] = pk2(po0[2 * p], po0[2 * p + 1]); \
            _Pragma("unroll") for (int q = 0; q < 4; ++q) *(f32x4*)(NP + (32 * _tn + _r32) * 64 + 32 * _tm + 8 * q + 4 * _hi) = (f32x4){po1[4 * q], po1[4 * q + 1], po1[4 * q + 2], po1[4 * q + 3]}; } } while (0)
  for (int ct = blockIdx.x; ct < 6144; ct += G, ++itn) {
    int tid = tid0; asm volatile("" : "+v"(tid));
    const int lane = tid & 63, wave = __builtin_amdgcn_readfirstlane(tid >> 6), r32 = lane & 31, hi = lane >> 5;
    const int ti = tid >> 3, seg = tid & 7;
    const int c = ct & 31, dir = (ct >> 5) & 1, bh = ct >> 6, h = bh % 12, b = bh / 12;
    const int tseq = dir ? (NT - 1 - 64 * c - ti) : (64 * c + ti);
    const size_t trow = (size_t)b * NT + tseq;
    const bool hm = tseq > 0, hn = tseq < NT - 1;
    const LAS float* PT = (const LAS float*)(lds + R_PAR) + (itn & 1) * NPAR;
    float pnx0 = 0.f, pnx1 = 0.f;
    float r8[8], k8[8], v8[8];
    {
        shift8r(raw[0], raw[1], raw[2], hm, hn, PT + 0 * 64 + 8 * seg, PT + 1 * 64 + 8 * seg, r8);
        shift8r(raw[3], raw[4], raw[5], hm, hn, PT + 2 * 64 + 8 * seg, PT + 3 * 64 + 8 * seg, k8);
        shift8r(raw[6], raw[7], raw[8], hm, hn, PT + 4 * 64 + 8 * seg, PT + 5 * 64 + 8 * seg, v8);
        float t8[8];
        shift8r(raw[9], raw[10], raw[11], hm, hn, PT + 6 * 64 + 8 * seg, PT + 7 * 64 + 8 * seg, t8);
#pragma unroll
        for (int q = 0; q < 8; ++q) { const float e2 = __expf(2.f * t8[q]); t8[q] = 1.f - 2.f / (e2 + 1.f); }
        *(LAS u32x4*)(lds + R_WD + ti * RLD + 16 * seg) = pack8(t8);
        shift8r(raw[12], raw[13], raw[14], hm, hn, PT + 8 * 64 + 8 * seg, PT + 9 * 64 + 8 * seg, t8);
        *(LAS u32x4*)(lds + R_AD + ti * RLD + 16 * seg) = pack8(t8);
        if (h == 0 && dir == 0) {
            const bf16_t* p0 = P + trow * PLD + C_BS;
            bf16_t* GS = (bf16_t*)(ws + WS_GS) + trow * 256;
#pragma unroll
            for (int hf = 0; hf < 2; ++hf) { const int col = 2560 + 64 * hf + 8 * seg;
                shift8r(*(const u32x4*)(p0 + col), *(const u32x4*)(p0 + col - (hm ? PLD : 0)), *(const u32x4*)(p0 + col + (hn ? PLD : 0)), hm, hn, mu + col, mu + RSTR + col, t8);
#pragma unroll
                for (int q = 0; q < 8; ++q) t8[q] = sigmoidf_(t8[q]);
                *(u32x4*)(GS + 64 * hf + 8 * seg) = pack8(t8);
                *(u32x4*)(GS + 128 + 64 * hf + 8 * seg) = (u32x4){0u, 0u, 0u, 0u}; }
        }
        *(LAS u32x4*)(lds + R_WUP + ti * RLD + 16 * seg) = wup4;
        *(LAS u32x4*)(lds + R_AUP + ti * RLD + 16 * seg) = aup4;
        if (dir == 0) *(u32x4*)((bf16_t*)(ws + WS_RV) + trow * RW + h * 64 + 8 * seg) = pack8(v8);
    }
    if (ctp >= 0) R1_FLUSH(ctp, lane, wave);
    if (ct + G < 6144) { r1_issue(P, ct + G, tid, raw);
        const int ctn = ct + G, bhn = ctn >> 6;
        { const size_t wofs = ((size_t)(l * 2 + ((ctn >> 5) & 1)) * 12 + (bhn % 12)) * 4096 + (size_t)ti * 64 + 8 * seg;
          wup4 = *(const u32x4*)((const bf16_t*)(ws + WS_MISC + MISC_WUPT) + wofs); aup4 = *(const u32x4*)((const bf16_t*)(ws + WS_MISC + MISC_AUPT) + wofs); }
        pnx0 = r1_param(a, l, bhn % 12, (ctn >> 5) & 1, tid); if (tid + 512 < NPAR) pnx1 = r1_param(a, l, bhn % 12, (ctn >> 5) & 1, tid + 512); }
    __syncthreads();
    {
        const int p = wave >> 2, tt = wave & 3, tm = tt >> 1, tn = tt & 1;
        f32x16 acc = (f32x16){};
        acc = tile64x<false, false>(lds + (p ? R_AUP : R_WUP), 32 * tm, lds + (p ? R_AD : R_WD), 32 * tn, lane, acc);
        LAS float* Z = (LAS float*)(lds + (p ? R_ZA : R_ZW));
#pragma unroll
        for (int q = 0; q < 4; ++q) *(LAS f32x4*)(Z + (32 * tn + r32) * 68 + 32 * tm + 8 * q + 4 * hi) = (f32x4){acc[4 * q], acc[4 * q + 1], acc[4 * q + 2], acc[4 * q + 3]};
    }
    __syncthreads();
    float kka8[8], kk8[8], kd8[8];
    {
        const LAS float* w0 = PT + 10 * 64 + 8 * seg; const LAS float* a0 = PT + 11 * 64 + 8 * seg;
        const LAS float* kkp = PT + 12 * 64 + 8 * seg; const LAS float* kap = PT + 13 * 64 + 8 * seg;
        LAS float* Zw = (LAS float*)(lds + R_ZW) + ti * 68 + 8 * seg; const LAS float* Za = (const LAS float*)(lds + R_ZA) + ti * 68 + 8 * seg;
        float nrm = 0.f, av[8], e8[8];
#pragma unroll
        for (int q = 0; q < 8; ++q) {
            const float z = w0[q] + Zw[q];
            const float u = -z; const float sp = fmaxf(u, 0.f) + __logf(1.f + __expf(-fabsf(u)));
            e8[q] = __expf(-sp - 0.5f);
            av[q] = sigmoidf_(a0[q] + Za[q]);
            const float kr = k8[q] * kkp[q]; kk8[q] = kr; nrm += kr * kr;
            kd8[q] = k8[q] * (1.f + (av[q] - 1.f) * kap[q]);
        }
        nrm = dpp_sum8(nrm);
        const float rn = rsqrtf(fmaxf(nrm, 1e-24f));
#pragma unroll
        for (int q = 0; q < 8; ++q) { kk8[q] *= rn; kka8[q] = kk8[q] * av[q]; Zw[q] = e8[q]; }
        { const LAS float* rkp = PT + 14 * 64 + 8 * seg; float bs = 0.f;
#pragma unroll
          for (int q = 0; q < 8; ++q) bs += r8[q] * kd8[q] * rkp[q];
          bs = dpp_sum8(bs);
          if (seg == 0) ((float*)(ws + WS_RR))[((size_t)dir * NTOK + trow) * 12 + h] = bs; }
    }
    __syncthreads();
    {
        const int kc = tid & 63, sg = tid >> 6;
        LAS float* Zw = (LAS float*)(lds + R_ZW); LAS float* SEG = (LAS float*)(lds + R_SEG);
        float run = 0.f;
#pragma unroll
        for (int q = 0; q < 8; ++q) { run += Zw[(8 * sg + q) * 68 + kc]; Zw[(8 * sg + q) * 68 + kc] = run; }
        SEG[sg * 64 + kc] = run;
        __syncthreads();
        float off = 0.f;
        for (int s2 = 0; s2 < sg; ++s2) off += SEG[s2 * 64 + kc];
#pragma unroll
        for (int q = 0; q < 8; ++q) Zw[(8 * sg + q) * 68 + kc] += off;
    }
    __syncthreads();
    {
        const LAS float* Gp = (const LAS float*)(lds + R_ZW);
        float al[8], be[8], bp[8], ka[8], kp[8], rh[8];
#pragma unroll
        for (int q = 0; q < 8; ++q) {
            const float gi = Gp[ti * 68 + 8 * seg + q], gm = ti > 0 ? Gp[(ti - 1) * 68 + 8 * seg + q] : 0.f, g63 = Gp[63 * 68 + 8 * seg + q];
            const float ig = __expf(gi), tl = __expf(gi - g63);
            al[q] = __expf(-gm) * kk8[q]; be[q] = kka8[q] * ig; bp[q] = kka8[q] * tl; ka[q] = kd8[q] * ig; kp[q] = kd8[q] * tl; rh[q] = r8[q] * __expf(-gi);
            if (ti == 63) ((LAS float*)(lds + R_GC))[8 * seg + q] = __expf(-g63);
        }
        const int o = ti * RLD + 16 * seg;
        *(LAS u32x4*)(lds + R_A + o) = pack8(al); *(LAS u32x4*)(lds + R_B + o) = pack8(be); *(LAS u32x4*)(lds + R_K + o) = pack8(ka); *(LAS u32x4*)(lds + R_RHO + o) = pack8(rh);
        *(LAS u32x4*)(lds + R_BP + o) = pack8(bp); *(LAS u32x4*)(lds + R_KP + o) = pack8(kp); *(LAS u32x4*)(lds + R_V + o) = pack8(v8);
    }
    __syncthreads();
    {
        const int tt = wave & 3, tm = tt >> 1, tn = tt & 1;
        const int jb = 32 * tm, ib = 32 * tn, i = ib + r32;
        f32x16 acc0 = (f32x16){}, acc1 = (f32x16){};
        if (tm <= tn) {
            acc0 = tile64x<false, false>(lds + (wave < 4 ? R_B : R_K), jb, lds + (wave < 4 ? R_A : R_RHO), ib, lane, acc0);
            acc1 = tile64x<false, false>(lds + (wave < 4 ? R_K : R_B), jb, lds + (wave < 4 ? R_A : R_RHO), ib, lane, acc1);
        }
#pragma unroll
        for (int rg = 0; rg < 16; ++rg) { const int j = jb + crow(rg, hi); const bool keep = (wave < 4) ? (j < i) : (j <= i);
            acc0[rg] = keep ? acc0[rg] : 0.f; acc1[rg] = keep ? acc1[rg] : 0.f; }
#pragma unroll
        for (int q = 0; q < 4; ++q) { const int jo = jb + 8 * q + 4 * hi;
            u32x2 w1; w1.x = pk2(acc1[4 * q], acc1[4 * q + 1]); w1.y = pk2(acc1[4 * q + 2], acc1[4 * q + 3]);
            if (wave < 4) {
                *(LAS f32x4*)((LAS float*)(lds + R_LBF) + i * 68 + jo) = (f32x4){acc0[4 * q], acc0[4 * q + 1], acc0[4 * q + 2], acc0[4 * q + 3]};
                *(LAS u32x2*)(lds + R_LK + i * RLD + 2 * jo) = w1;
                if (wave == 1) { u32x2 wl; wl.x = pk2(acc0[4 * q], acc0[4 * q + 1]); wl.y = pk2(acc0[4 * q + 2], acc0[4 * q + 3]);
                    *(LAS u32x2*)(lds + R_TMP0 + r32 * 64 + 2 * (8 * q + 4 * hi)) = wl; }
            } else {
                u32x2 w0; w0.x = pk2(acc0[4 * q], acc0[4 * q + 1]); w0.y = pk2(acc0[4 * q + 2], acc0[4 * q + 3]);
                *(LAS u32x2*)(lds + R_RK + i * RLD + 2 * jo) = w0;
                *(LAS u32x2*)(lds + R_RB + i * RLD + 2 * jo) = w1;
            } }
    }
    __syncthreads();
    if (wave < 2) {
        const int blk = wave, col = r32;
        const LAS float* Lf = (const LAS float*)(lds + R_LBF) + (32 * blk) * 68 + 32 * blk;
        float Tm[32];
        f32x4 cur[8], nxt[8];
#pragma unroll
        for (int m4 = 0; m4 < 8; ++m4) { cur[m4] = (f32x4){0.f, 0.f, 0.f, 0.f}; nxt[m4] = (f32x4){0.f, 0.f, 0.f, 0.f}; }
        cur[0] = *(const LAS f32x4*)(Lf + 68);
        Tm[0] = (col == 0) ? 1.f : 0.f;
#pragma unroll
        for (int i = 1; i < 32; ++i) {
            if (i + 1 < 32) {
#pragma unroll
                for (int m4 = 0; m4 < (i + 4) / 4; ++m4) nxt[m4] = *(const LAS f32x4*)(Lf + (i + 1) * 68 + 4 * m4);
            }
            float c0 = (col == i) ? 1.f : 0.f, c1 = 0.f, c2 = 0.f, c3 = 0.f;
#pragma unroll
            for (int m4 = 0; m4 < (i + 3) / 4; ++m4) {
                if (4 * m4 + 0 < i) c0 -= cur[m4][0] * Tm[4 * m4 + 0];
                if (4 * m4 + 1 < i) c1 -= cur[m4][1] * Tm[4 * m4 + 1];
                if (4 * m4 + 2 < i) c2 -= cur[m4][2] * Tm[4 * m4 + 2];
                if (4 * m4 + 3 < i) c3 -= cur[m4][3] * Tm[4 * m4 + 3]; }
            Tm[i] = (c0 + c1) + (c2 + c3);
#pragma unroll
            for (int m4 = 0; m4 < 8; ++m4) cur[m4] = nxt[m4];
            asm volatile("" : "+v"(Tm[i]) :: "memory");
        }
        if (hi == 0) {
#pragma unroll
            for (int i = 0; i < 32; ++i) {
                *(LAS bf16_t*)(lds + R_TT + (32 * blk + i) * RLD + 2 * (32 * blk + col)) = f2bf(Tm[i]);
                if (blk == 0) *(LAS bf16_t*)(lds + R_TT + i * RLD + 2 * (32 + col)) = (bf16_t)0;
            }
            if (blk == 0) {
#pragma unroll
                for (int q = 0; q < 4; ++q) { float x8[8];
#pragma unroll
                    for (int e = 0; e < 8; ++e) x8[e] = Tm[8 * q + e];
                    *(LAS u32x4*)(lds + R_TMP1 + col * 64 + 16 * q) = pack8(x8); } }
        }
    } else if (wave >= 4) {
        const int tt = wave & 3, tm = tt >> 1, tn = tt & 1;
        f32x16 acc = (f32x16){};
        acc = tile64x<false, true>(lds + R_LK, 32 * tm, lds + R_V, 32 * tn, lane, acc);
#pragma unroll
        for (int q = 0; q < 4; ++q) { u32x2 w; w.x = pk2(acc[4 * q], acc[4 * q + 1]); w.y = pk2(acc[4 * q + 2], acc[4 * q + 3]);
            *(LAS u32x2*)(lds + R_W1T + (32 * tn + r32) * RLD + 2 * (32 * tm + 8 * q + 4 * hi)) = w; }
    }
    __syncthreads();
    if (wave == 0) {
        f32x16 x1 = (f32x16){};
#pragma unroll
        for (int s2 = 0; s2 < 2; ++s2) x1 = __builtin_amdgcn_mfma_f32_32x32x16_bf16(*(const LAS bf16x8*)(lds + R_TMP0 + r32 * 64 + 32 * s2 + 16 * hi), *(const LAS bf16x8*)(lds + R_TMP1 + r32 * 64 + 32 * s2 + 16 * hi), x1, 0, 0, 0);
#pragma unroll
        for (int q = 0; q < 4; ++q) { u32x2 w; w.x = pk2(x1[4 * q], x1[4 * q + 1]); w.y = pk2(x1[4 * q + 2], x1[4 * q + 3]);
            *(LAS u32x2*)(lds + R_TMP2 + r32 * 64 + 2 * (8 * q + 4 * hi)) = w; }
        lds_fence();
        f32x16 t21 = (f32x16){};
#pragma unroll
        for (int s2 = 0; s2 < 2; ++s2) t21 = __builtin_amdgcn_mfma_f32_32x32x16_bf16(*(const LAS bf16x8*)(lds + R_TT + (32 + r32) * RLD + 64 + 32 * s2 + 16 * hi), *(const LAS bf16x8*)(lds + R_TMP2 + r32 * 64 + 32 * s2 + 16 * hi), t21, 0, 0, 0);
#pragma unroll
        for (int rg = 0; rg < 16; ++rg) *(LAS bf16_t*)(lds + R_TT + (32 + crow(rg, hi)) * RLD + 2 * r32) = f2bf(-t21[rg]);
    }
    __syncthreads();
    {
        const int tt = wave & 3, tm = tt >> 1, tn = tt & 1;
        f32x16 acc = (f32x16){};
        if (wave < 4) acc = tile64x<false, false>(lds + R_TT, 32 * tm, lds + R_W1T, 32 * tn, lane, acc);
        else          acc = tile64x<false, true>(lds + R_TT, 32 * tm, lds + R_A, 32 * tn, lane, acc);
        LAS unsigned char* dst = lds + (wave < 4 ? R_UT : R_TAT);
#pragma unroll
        for (int q = 0; q < 4; ++q) { u32x2 w; w.x = pk2(acc[4 * q], acc[4 * q + 1]); w.y = pk2(acc[4 * q + 2], acc[4 * q + 3]);
            *(LAS u32x2*)(dst + (32 * tn + r32) * RLD + 2 * (32 * tm + 8 * q + 4 * hi)) = w; }
    }
    __syncthreads();
    {
        const int tt = wave & 3, tm = tt >> 1, tn = tt & 1;
        if (wave < 4) {
            f32x16 acc = (f32x16){};
            acc = tile64x<false, false>(lds + R_TAT, 32 * tm, lds + R_RB, 32 * tn, lane, acc);
#pragma unroll
            for (int q = 0; q < 4; ++q) { const int i = 32 * tn + r32, k = 32 * tm + 8 * q + 4 * hi;
                const u32x2 rv = *(const LAS u32x2*)(lds + R_RHO + i * RLD + 2 * k);
                po0[4 * q] = bflo(rv.x) - acc[4 * q]; po0[4 * q + 1] = bfhi(rv.x) - acc[4 * q + 1]; po0[4 * q + 2] = bflo(rv.y) - acc[4 * q + 2]; po0[4 * q + 3] = bfhi(rv.y) - acc[4 * q + 3]; }
            f32x16 am = (f32x16){};
            am = tile64x<true, false>(lds + R_BP, 32 * tm, lds + R_TAT, 32 * tn, lane, am);
            const LAS float* GC = (const LAS float*)(lds + R_GC);
#pragma unroll
            for (int q = 0; q < 4; ++q) { const int k = 32 * tn + r32, kp0 = 32 * tm + 8 * q + 4 * hi;
#pragma unroll
                for (int e = 0; e < 4; ++e) po1[4 * q + e] = ((kp0 + e == k) ? GC[kp0 + e] : 0.f) - am[4 * q + e]; }
        } else {
            f32x16 a1 = (f32x16){}, a2 = (f32x16){};
            a1 = tile64x<true, false>(lds + R_V, 32 * tm, lds + R_RK, 32 * tn, lane, a1);
            a2 = tile64x<false, false>(lds + R_UT, 32 * tm, lds + R_RB, 32 * tn, lane, a2);
            po0 = a1 - a2;
            f32x16 n1 = (f32x16){}, n2 = (f32x16){};
            n1 = tile64x<true, true>(lds + R_KP, 32 * tm, lds + R_V, 32 * tn, lane, n1);
            n2 = tile64x<true, false>(lds + R_BP, 32 * tm, lds + R_UT, 32 * tn, lane, n2);
            po1 = n1 - n2;
        }
        ctp = ct;
    }
    if (ct + G < 6144) { LAS float* pn = (LAS float*)(lds + R_PAR) + ((itn + 1) & 1) * NPAR; pn[tid] = pnx0; if (tid + 512 < NPAR) pn[tid + 512] = pnx1; }
    __syncthreads();
  }
    if (ctp >= 0) { const int lane = tid0 & 63, wave = __builtin_amdgcn_readfirstlane(tid0 >> 6); R1_FLUSH(ctp, lane, wave); }
#undef R1_FLUSH
}

__device__ __forceinline__ void rwkv_r2_unit(const Args& a, int unit, LAS unsigned char* lds) {
    const int tid = otid(), lane = tid & 63, wave = __builtin_amdgcn_readfirstlane(tid >> 6);
    unsigned char* ws = a.ws;
    LAS float* S = (LAS float*)lds;
    const int vb = wave >> 1, kb0 = 2 * (wave & 1), l15 = lane & 15, lq = lane >> 4;
    for (int i = tid; i < 64 * 68; i += 512) S[i] = 0.f;
    const float* MPb = (const float*)(ws + WS_MP) + (size_t)unit * 32 * 4096; const float* NPb = (const float*)(ws + WS_NP) + (size_t)unit * 32 * 4096;
    bf16_t* SSb = (bf16_t*)(ws + WS_SS) + (size_t)unit * 32 * 4096;
    float Bm[2][16]; f32x4 acc[2];
#pragma unroll
    for (int t2 = 0; t2 < 2; ++t2) {
#pragma unroll
        for (int ks = 0; ks < 16; ++ks) Bm[t2][ks] = MPb[(4 * ks + lq) * 64 + 16 * (kb0 + t2) + l15];
#pragma unroll
        for (int rg = 0; rg < 4; ++rg) acc[t2][rg] = NPb[(16 * vb + 4 * lq + rg) * 64 + 16 * (kb0 + t2) + l15]; }
    __syncthreads();
    for (int c = 0; c < 32; ++c) {
        { const int v = tid >> 3, sg = tid & 7; const LAS float* sp = S + v * 68 + 8 * sg; float x[8];
#pragma unroll
          for (int q = 0; q < 8; ++q) x[q] = sp[q];
          *(u32x4*)(SSb + (size_t)c * 4096 + v * 64 + 8 * sg) = pack8(x); }
#pragma unroll
        for (int ks = 0; ks < 16; ++ks) { const float av = S[(16 * vb + l15) * 68 + 4 * ks + lq];
            acc[0] = __builtin_amdgcn_mfma_f32_16x16x4f32(av, Bm[0][ks], acc[0], 0, 0, 0);
            acc[1] = __builtin_amdgcn_mfma_f32_16x16x4f32(av, Bm[1][ks], acc[1], 0, 0, 0); }
        __syncthreads();
#pragma unroll
        for (int t2 = 0; t2 < 2; ++t2)
#pragma unroll
            for (int rg = 0; rg < 4; ++rg) S[(16 * vb + 4 * lq + rg) * 68 + 16 * (kb0 + t2) + l15] = acc[t2][rg];
        if (c + 1 < 32) { const float* MPc = MPb + (size_t)(c + 1) * 4096; const float* NPc = NPb + (size_t)(c + 1) * 4096;
#pragma unroll
            for (int t2 = 0; t2 < 2; ++t2) {
#pragma unroll
                for (int ks = 0; ks < 16; ++ks) Bm[t2][ks] = MPc[(4 * ks + lq) * 64 + 16 * (kb0 + t2) + l15];
#pragma unroll
                for (int rg = 0; rg < 4; ++rg) acc[t2][rg] = NPc[(16 * vb + 4 * lq + rg) * 64 + 16 * (kb0 + t2) + l15]; } }
        __syncthreads();
    }
}

__device__ __forceinline__ void phase_rwkv_out(const Args& a, int l) {
    const int tid = otid(), lane = tid & 63, wave = tid >> 6, r32 = lane & 31, hi = lane >> 5;
    unsigned char* ws = a.ws;
    const bf16_t* SSg = (const bf16_t*)(ws + WS_SS); const bf16_t* QAg = (const bf16_t*)(ws + WS_QA); const unsigned* Y0g = (const unsigned*)(ws + WS_Y0);
    const bf16_t* RV = (const bf16_t*)(ws + WS_RV);
    const bf16_t* GG = (const bf16_t*)(ws + WS_GG); bf16_t* OB = (bf16_t*)(ws + WS_OA) + 256;
    const float* lng = a.in[I_LNG] + (size_t)l * RW; const float* lnb = a.in[I_LNB] + (size_t)l * RW;
    for (int wt = blockIdx.x * 8 + wave; wt < 6144; wt += gridDim.x * 8) {
        const int tq = wt & 63, bh = wt >> 6, h = bh % 12, b = bh / 12, c = tq >> 1, tn = tq & 1, tnb = 1 - tn;
        const size_t ctf = ((size_t)bh * 2 + 0) * 32 + c, ctb = ((size_t)bh * 2 + 1) * 32 + (31 - c);
        const size_t t = (size_t)b * NT + 64 * c + 32 * tn + r32;
        const int srcl = (lane & 32) + 31 - r32;
        float y[2][16];
#pragma unroll
        for (int tm = 0; tm < 2; ++tm) {
            f32x16 af, ab;
            const unsigned* y0f = Y0g + ctf * 2048 + (tm * 2 + tn) * 512 + lane; const unsigned* y0b = Y0g + ctb * 2048 + (tm * 2 + tnb) * 512 + lane;
#pragma unroll
            for (int p = 0; p < 8; ++p) { const unsigned uf = y0f[p * 64], ub = y0b[p * 64]; af[2 * p] = bflo(uf); af[2 * p + 1] = bfhi(uf); ab[2 * p] = bflo(ub); ab[2 * p + 1] = bfhi(ub); }
#pragma unroll
            for (int s4 = 0; s4 < 4; ++s4) {
                const bf16x8 xf = *(const bf16x8*)(SSg + ctf * 4096 + (32 * tm + r32) * 64 + 16 * s4 + 8 * hi);
                const bf16x8 yf = *(const bf16x8*)(QAg + ctf * 4096 + ((tn * 4 + s4) * 64 + lane) * 8);
                af = __builtin_amdgcn_mfma_f32_32x32x16_bf16(xf, yf, af, 0, 0, 0);
                const bf16x8 xb = *(const bf16x8*)(SSg + ctb * 4096 + (32 * tm + r32) * 64 + 16 * s4 + 8 * hi);
                const bf16x8 yb = *(const bf16x8*)(QAg + ctb * 4096 + ((tnb * 4 + s4) * 64 + lane) * 8);
                ab = __builtin_amdgcn_mfma_f32_32x32x16_bf16(xb, yb, ab, 0, 0, 0);
            }
#pragma unroll
            for (int rg = 0; rg < 16; ++rg) y[tm][rg] = af[rg] + __shfl(ab[rg], srcl);
        }
        float sm = 0.f;
#pragma unroll
        for (int tm = 0; tm < 2; ++tm)
#pragma unroll
            for (int rg = 0; rg < 16; ++rg) sm += y[tm][rg];
        sm += __shfl_xor(sm, 32);
        const float mean = sm * (1.f / 64.f);
        float sv = 0.f;
#pragma unroll
        for (int tm = 0; tm < 2; ++tm)
#pragma unroll
            for (int rg = 0; rg < 16; ++rg) { const float d = y[tm][rg] - mean; y[tm][rg] = d; sv += d * d; }
        sv += __shfl_xor(sv, 32);
        const float rstd = rsqrtf(sv * (1.f / 64.f) + 64e-5f);
        const float* BS = (const float*)(ws + WS_RR);
        const float s0 = BS[t * 12 + h] + BS[((size_t)NTOK + t) * 12 + h];
#pragma unroll
        for (int tm = 0; tm < 2; ++tm)
#pragma unroll
            for (int q = 0; q < 4; ++q) { const int cc = h * 64 + 32 * tm + 8 * q + 4 * hi;
                const f32x4 g4 = *(const f32x4*)(lng + cc), b4 = *(const f32x4*)(lnb + cc); const u32x2 vv = *(const u32x2*)(RV + t * RW + cc);
                const f32x4 v4 = (f32x4){bflo(vv.x), bfhi(vv.x), bflo(vv.y), bfhi(vv.y)};
                const u32x2 gg = *(const u32x2*)(GG + t * RW + cc);
                const float o0 = (y[tm][4 * q] * rstd * g4.x + b4.x + s0 * v4.x) * bflo(gg.x), o1 = (y[tm][4 * q + 1] * rstd * g4.y + b4.y + s0 * v4.y) * bfhi(gg.x);
                const float o2 = (y[tm][4 * q + 2] * rstd * g4.z + b4.z + s0 * v4.z) * bflo(gg.y), o3 = (y[tm][4 * q + 3] * rstd * g4.w + b4.w + s0 * v4.w) * bfhi(gg.y);
                u32x2 w; w.x = pk2(o0, o1); w.y = pk2(o2, o3);
                *(u32x2*)(OB + t * 1792 + cc) = w; }
    }
    const float* OAG = (const float*)(ws + WS_OAG); const float* LSE = (const float*)(ws + WS_LSE); bf16_t* OA = (bf16_t*)(ws + WS_OA);
    for (int task = blockIdx.x * 8 + wave; task < NTOK / 4; task += gridDim.x * 8) {
#pragma unroll
        for (int tk = 0; tk < 4; ++tk) { const size_t t = (size_t)task * 4 + tk; const int hh = lane >> 4;
            const float l0 = LSE[((size_t)0 * NTOK + t) * 4 + hh], l1 = LSE[((size_t)1 * NTOK + t) * 4 + hh], l2 = LSE[((size_t)2 * NTOK + t) * 4 + hh];
            const float mx = fmaxf(l0, fmaxf(l1, l2));
            const float w0 = __builtin_amdgcn_exp2f(l0 - mx), w1 = __builtin_amdgcn_exp2f(l1 - mx), w2 = __builtin_amdgcn_exp2f(l2 - mx);
            const float inv = 1.f / (w0 + w1 + w2);
            const bf16_t* OAb = (const bf16_t*)OAG;
            const u32x2 u0 = *(const u32x2*)(OAb + ((size_t)0 * NTOK + t) * 256 + lane * 4), u1 = *(const u32x2*)(OAb + ((size_t)1 * NTOK + t) * 256 + lane * 4), u2 = *(const u32x2*)(OAb + ((size_t)2 * NTOK + t) * 256 + lane * 4);
            const f32x4 o0 = (f32x4){bflo(u0.x), bfhi(u0.x), bflo(u0.y), bfhi(u0.y)}, o1 = (f32x4){bflo(u1.x), bfhi(u1.x), bflo(u1.y), bfhi(u1.y)}, o2 = (f32x4){bflo(u2.x), bfhi(u2.x), bflo(u2.y), bfhi(u2.y)};
            const f32x4 r = (o0 * w0 + o1 * w1 + o2 * w2) * inv;
            u32x2 w; w.x = pk2(r.x, r.y); w.y = pk2(r.z, r.w);
            *(u32x2*)(OA + t * 1792 + lane * 4) = w; }
    }
}

__device__ __forceinline__ int vk_off(int row, int ch) { return 2048 * (row >> 3) + 512 * (ch >> 2) + 64 * (row & 7) + 16 * ((ch & 3) ^ ((row >> 2) & 3)); }
__device__ __forceinline__ void diffattn_unit(const Args& a, int l, int unit, LAS unsigned char* lds) {
    constexpr int TB = 16384;
    const int b = unit / 96; const int rem = unit - b * 96; const int h = rem >> 4, qb = rem & 15;
    const int tid = otid(), lane = tid & 63, wave = __builtin_amdgcn_readfirstlane(tid >> 6), r32 = lane & 31, hi = lane >> 5;
    const int c = wave & 1, qblk = wave >> 1;
    const int q0 = qb * 128 + qblk * 32;
    const bf16_t* P = (const bf16_t*)(a.ws + WS_PROJ);
    const size_t rowb = (size_t)b * NT;
    bf16x8 qf[4];
    { const bf16_t* qp = P + (rowb + q0 + r32) * PLD + C_CQ + h * 128 + c * 64 + 8 * hi;
#pragma unroll
      for (int s4 = 0; s4 < 4; ++s4) qf[s4] = *(const bf16x8*)(qp + 16 * s4); }
    LAS float* biasL = (LAS float*)(lds + 69632);
    { const float* bC = (const float*)(a.ws + WS_MISC + MISC_BIASC) + h * 257;
      for (int i = tid; i < 257; i += 512) biasL[i] = bC[i]; }
    const int srow0 = tid >> 4, sch = tid & 15;
    const bf16_t* kg = P + (rowb + srow0) * PLD + C_CK + h * 128 + sch * 8;
    const bf16_t* vg = P + (rowb + srow0) * PLD + C_CV + h * 128 + sch * 8;
    u32x4 kr[2], vr[2];
#pragma unroll
    for (int i = 0; i < 2; ++i) { kr[i] = *(const u32x4*)(kg + (size_t)(32 * i) * PLD); vr[i] = *(const u32x4*)(vg + (size_t)(32 * i) * PLD); }
#pragma unroll
    for (int i = 0; i < 2; ++i) { *(LAS u32x4*)(lds + vk_off(srow0 + 32 * i, sch)) = kr[i]; *(LAS u32x4*)(lds + 2 * TB + vk_off(srow0 + 32 * i, sch)) = vr[i]; }
#pragma unroll
    for (int i = 0; i < 2; ++i) kr[i] = *(const u32x4*)(kg + (size_t)(64 + 32 * i) * PLD);
#pragma unroll
    for (int i = 0; i < 2; ++i) *(LAS u32x4*)(lds + TB + vk_off(srow0 + 32 * i, sch)) = kr[i];
    __syncthreads();
    f32x16 o[4];
#pragma unroll
    for (int db = 0; db < 4; ++db) o[db] = (f32x16){};
    float m = -1e30f, lsum = 0.f;
    const float SC = 0.125f * LOG2E;
    const int chlo = 2 * ((lane >> 4) & 1) + ((lane & 3) >> 1);
    const int trb0 = 64 * (4 * hi + ((lane & 15) >> 2)) + 16 * (chlo ^ (hi & 3)) + 8 * (lane & 1);
    const int trb1 = 64 * (4 * hi + ((lane & 15) >> 2)) + 16 * (chlo ^ ((2 + hi) & 3)) + 8 * (lane & 1) + 2048;
    const int qabs = q0 + r32;
    const int ko0 = vk_off(r32, 8 * c + hi), ko1 = vk_off(32 + r32, 8 * c + hi);
#define DA_QK(SA0, SA1, Kb) do { SA0 = (f32x16){}; SA1 = (f32x16){}; bf16x8 _kf0[4], _kf1[4]; \
        _Pragma("unroll") for (int s4 = 0; s4 < 4; ++s4) { _kf0[s4] = *(const LAS bf16x8*)((Kb) + vk_off(r32, 8 * c + 2 * s4 + hi)); _kf1[s4] = *(const LAS bf16x8*)((Kb) + vk_off(32 + r32, 8 * c + 2 * s4 + hi)); } \
        _Pragma("unroll") for (int s4 = 0; s4 < 4; ++s4) { \
            SA0 = __builtin_amdgcn_mfma_f32_32x32x16_bf16(_kf0[s4], qf[s4], SA0, 0, 0, 0); \
            SA1 = __builtin_amdgcn_mfma_f32_32x32x16_bf16(_kf1[s4], qf[s4], SA1, 0, 0, 0); } } while (0)
    f32x16 sa0, sa1, sn0 = (f32x16){}, sn1 = (f32x16){};
    DA_QK(sa0, sa1, lds);
    (void)ko0; (void)ko1;
    asm volatile("s_waitcnt lgkmcnt(0)" ::: "memory"); __syncthreads();
    for (int t = 0; t < 32; ++t) {
        if (t + 2 < 32) {
#pragma unroll
            for (int i = 0; i < 2; ++i) kr[i] = *(const u32x4*)(kg + (size_t)(64 * (t + 2) + 32 * i) * PLD); }
        if (t + 1 < 32) {
#pragma unroll
            for (int i = 0; i < 2; ++i) vr[i] = *(const u32x4*)(vg + (size_t)(64 * (t + 1) + 32 * i) * PLD); }
        const LAS unsigned char* Vb = lds + 2 * TB + (t & 1) * TB;
        if (t + 1 < 32) { DA_QK(sn0, sn1, lds + ((t + 1) & 1) * TB); }
        __builtin_amdgcn_sched_barrier(0);
        float x0[16], x1[16];
        const int kv0 = 64 * t;
        const bool farp = (kv0 >= q0 + 31 + 128), farn = (kv0 + 63 + 128 <= q0);
        if (farp || farn) { const float cb = farp ? biasL[256] : biasL[0];
#pragma unroll
            for (int rg = 0; rg < 16; ++rg) { x0[rg] = sa0[rg] * SC + cb; x1[rg] = sa1[rg] * SC + cb; }
        } else {
#pragma unroll
            for (int rg = 0; rg < 16; ++rg) { int rel = kv0 + crow(rg, hi) - qabs; int rc = rel < -128 ? -128 : (rel > 128 ? 128 : rel);
                x0[rg] = sa0[rg] * SC + biasL[rc + 128];
                rel += 32; rc = rel < -128 ? -128 : (rel > 128 ? 128 : rel);
                x1[rg] = sa1[rg] * SC + biasL[rc + 128]; }
        }
        float mx = fmaxf(x0[0], x1[0]);
#pragma unroll
        for (int rg = 1; rg < 16; ++rg) mx = fmaxf(mx, fmaxf(x0[rg], x1[rg]));
        mx = fmaxf(mx, __shfl_xor(mx, 32));
        const float mn = fmaxf(m, mx), alpha = __builtin_amdgcn_exp2f(m - mn); m = mn;
        float ps = 0.f;
#pragma unroll
        for (int rg = 0; rg < 16; ++rg) { x0[rg] = __builtin_amdgcn_exp2f(x0[rg] - mn); x1[rg] = __builtin_amdgcn_exp2f(x1[rg] - mn); ps += x0[rg] + x1[rg]; }
        lsum = lsum * alpha + ps;
#pragma unroll
        for (int db = 0; db < 4; ++db)
#pragma unroll
            for (int rg = 0; rg < 16; ++rg) o[db][rg] *= alpha;
        u32x4 pw[4];
#pragma unroll
        for (int s2 = 0; s2 < 2; ++s2) {
            pw[s2].x = pk2(x0[8 * s2 + 0], x0[8 * s2 + 1]); pw[s2].y = pk2(x0[8 * s2 + 2], x0[8 * s2 + 3]); pw[s2].z = pk2(x0[8 * s2 + 4], x0[8 * s2 + 5]); pw[s2].w = pk2(x0[8 * s2 + 6], x0[8 * s2 + 7]);
            pw[2 + s2].x = pk2(x1[8 * s2 + 0], x1[8 * s2 + 1]); pw[2 + s2].y = pk2(x1[8 * s2 + 2], x1[8 * s2 + 3]); pw[2 + s2].z = pk2(x1[8 * s2 + 4], x1[8 * s2 + 5]); pw[2 + s2].w = pk2(x1[8 * s2 + 6], x1[8 * s2 + 7]); }
        {
            s16x4 vl[2][4], vh[2][4];
#pragma unroll
            for (int db = 0; db < 4; ++db) { vl[0][db] = vtr(Vb + trb0 + 512 * db); vh[0][db] = vtr(Vb + trb1 + 512 * db); }
#pragma unroll
            for (int s = 0; s < 4; ++s) {
                if (s < 3) {
#pragma unroll
                    for (int db = 0; db < 4; ++db) { vl[(s + 1) & 1][db] = vtr(Vb + trb0 + 4096 * (s + 1) + 512 * db); vh[(s + 1) & 1][db] = vtr(Vb + trb1 + 4096 * (s + 1) + 512 * db); } }
#pragma unroll
                for (int db = 0; db < 4; ++db) { const s16x4 lo = vl[s & 1][db], hi4 = vh[s & 1][db];
                    const bf16x8 af = (bf16x8){lo[0], lo[1], lo[2], lo[3], hi4[0], hi4[1], hi4[2], hi4[3]};
                    o[db] = __builtin_amdgcn_mfma_f32_32x32x16_bf16(af, __builtin_bit_cast(bf16x8, pw[s]), o[db], 0, 0, 0); }
            }
        }
        if (t + 2 < 32) { LAS unsigned char* Kn = lds + (t & 1) * TB;
#pragma unroll
            for (int i = 0; i < 2; ++i) *(LAS u32x4*)(Kn + vk_off(srow0 + 32 * i, sch)) = kr[i]; }
        if (t + 1 < 32) { LAS unsigned char* Vn = lds + 2 * TB + ((t + 1) & 1) * TB;
#pragma unroll
            for (int i = 0; i < 2; ++i) *(LAS u32x4*)(Vn + vk_off(srow0 + 32 * i, sch)) = vr[i]; }
        __syncthreads();
        sa0 = sn0; sa1 = sn1;
    }
#undef DA_QK
    const float lt = lsum + __shfl_xor(lsum, 32);
    const float inv = 1.f / lt;
    const float* lamp = (const float*)(a.ws + WS_MISC + MISC_LAM);
    const float lam = lamp[l], linit = lamp[2 + l];
    LAS float* XO = (LAS float*)lds;
    if (c == 1) {
        const float f = inv * lam;
#pragma unroll
        for (int db = 0; db < 4; ++db)
#pragma unroll
            for (int rg = 0; rg < 16; ++rg) XO[(qblk * 64 + db * 16 + rg) * 64 + lane] = o[db][rg] * f;
    }
    __syncthreads();
    if (c == 0) {
        float ss = 0.f;
#pragma unroll
        for (int db = 0; db < 4; ++db)
#pragma unroll
            for (int rg = 0; rg < 16; ++rg) { const float v = o[db][rg] * inv - XO[(qblk * 64 + db * 16 + rg) * 64 + lane]; o[db][rg] = v; ss += v * v; }
        ss += __shfl_xor(ss, 32);
        const float sc = rsqrtf(ss * (1.f / 128.f) + 1e-5f) * (1.f - linit);
        const float* sg = a.in[I_SUBG] + (size_t)l * 128;
        bf16_t* op = (bf16_t*)(a.ws + WS_OA) + (rowb + q0 + r32) * 1792 + 1024 + h * 128;
#pragma unroll
        for (int db = 0; db < 4; ++db)
#pragma unroll
            for (int i = 0; i < 4; ++i) { const int d = db * 32 + 8 * i + 4 * hi; const f32x4 g4 = *(const f32x4*)(sg + d);
                u32x2 w; w.x = pk2(o[db][4 * i] * sc * g4.x, o[db][4 * i + 1] * sc * g4.y); w.y = pk2(o[db][4 * i + 2] * sc * g4.z, o[db][4 * i + 3] * sc * g4.w);
                *(u32x2*)(op + d) = w; }
    }
    __syncthreads();
}

__device__ __forceinline__ void phase_route(const Args& a, int l, LAS unsigned char* lds, bool commit = true) {
    const int tid = otid(), lane = tid & 63, wave = __builtin_amdgcn_readfirstlane(tid >> 6), r32 = lane & 31, hi = lane >> 5;
    unsigned char* ws = a.ws;
    LAS float* hb = (LAS float*)lds;
    LAS float* lg = (LAS float*)(lds + 131200);
    volatile LAS int* sel = (volatile LAS int*)(lds + 131200 + 4224);
    const float* X = (const float*)(ws + WS_X);
    const float* mod = (const float*)(ws + WS_MISC + MISC_MOD) + (size_t)l * 8 * 6144;
    bf16_t* H = (bf16_t*)(ws + WS_H);
    unsigned* cnt = (unsigned*)(ws + WS_CTL) + CW_CNT + l * 512;
    int* LIST = (int*)(ws + WS_LIST); unsigned* TOKE = (unsigned*)(ws + WS_TOKE); float* TOKP = (float*)(ws + WS_TOKP);
    const float* g2 = a.in[I_N2G] + (size_t)l * DM; const float* rb = a.in[I_RB] + (size_t)l * NE;
    float Bw[64];
    { const float* rw = a.in[I_RW] + (size_t)l * DM * NE + (size_t)(128 * wave + hi) * NE + r32;
#pragma unroll
      for (int s2 = 0; s2 < 64; ++s2) Bw[s2] = rw[(size_t)(2 * s2) * NE]; }
    for (int tb = blockIdx.x; tb < NTOK / 64; tb += gridDim.x) {
        for (int rnd = 0; rnd < 2; ++rnd) {
            const int tbase = tb * 64 + rnd * 32;
            const float* mb = mod + (size_t)(tbase >> 11) * 6144;
#pragma unroll 1
            for (int q = 0; q < 4; ++q) {
                const int tl = 4 * wave + q; const size_t t = (size_t)tbase + tl;
                f32x4 v[4];
#pragma unroll
                for (int j = 0; j < 4; ++j) v[j] = *(const f32x4*)(X + t * DM + 4 * lane + 256 * j);
                const float rstd = row_rstd(v, 1e-6f);
#pragma unroll
                for (int j = 0; j < 4; ++j) { const int c = 4 * lane + 256 * j;
                    const f32x4 gv = *(const f32x4*)(g2 + c), scv = *(const f32x4*)(mb + 4096 + c), shv = *(const f32x4*)(mb + 3072 + c);
                    const f32x4 hv = v[j] * rstd * gv * (scv + 1.0f) + shv;
                    u32x2 w; w.x = pk2(hv.x, hv.y); w.y = pk2(hv.z, hv.w);
                    *(u32x2*)(H + t * DM + c) = w;
                    LAS float* hp = hb + tl * 1025 + c; hp[0] = hv.x; hp[1] = hv.y; hp[2] = hv.z; hp[3] = hv.w; }
            }
            __syncthreads();
            f32x16 d = (f32x16){};
            { const LAS float* ap = hb + r32 * 1025 + 128 * wave + hi;
#pragma unroll
              for (int s2 = 0; s2 < 64; ++s2) d = __builtin_amdgcn_mfma_f32_32x32x2f32(ap[2 * s2], Bw[s2], d, 0, 0, 0); }
            __syncthreads();
#pragma unroll
            for (int rg = 0; rg < 16; ++rg) hb[(wave * 16 + rg) * 64 + lane] = d[rg];
            __syncthreads();
#pragma unroll
            for (int j = 0; j < 2; ++j) { const int idx = tid + 512 * j, rg = idx >> 6, ln = idx & 63; float sm = 0.f;
#pragma unroll
                for (int w8 = 0; w8 < 8; ++w8) sm += hb[(w8 * 16 + rg) * 64 + ln];
                lg[crow(rg, ln >> 5) * 33 + (ln & 31)] = sm + rb[ln & 31]; }
            __syncthreads();
#pragma unroll 1
            for (int q = 0; q < 4; ++q) {
                const int tl = 4 * wave + q; const int t = tbase + tl;
                const int myidx = lane & 31;
                float cur = lg[tl * 33 + myidx];
                float tv[4]; int ti4[4];
#pragma unroll
                for (int k = 0; k < 4; ++k) { float bv = cur; int bi = myidx;
#pragma unroll
                    for (int off = 16; off >= 1; off >>= 1) { const float ov = __shfl_xor(bv, off); const int oi = __shfl_xor(bi, off);
                        const bool take = (ov > bv) || (ov == bv && oi < bi); bv = take ? ov : bv; bi = take ? oi : bi; }
                    tv[k] = bv; ti4[k] = bi; if (myidx == bi) cur = -INFINITY; }
                const float e1 = expf(tv[1] - tv[0]), e2 = expf(tv[2] - tv[0]), e3 = expf(tv[3] - tv[0]);
                const float inv = 1.f / (1.f + e1 + e2 + e3);
                if (lane < 4) { const int e = lane == 0 ? ti4[0] : lane == 1 ? ti4[1] : lane == 2 ? ti4[2] : ti4[3];
                    const float pr = (lane == 0 ? 1.f : lane == 1 ? e1 : lane == 2 ? e2 : e3) * inv;
                    sel[(rnd * 32 + tl) * 4 + lane] = e; TOKP[(size_t)t * 4 + lane] = pr; }
            }
            __syncthreads();
        }
        if (tid < 32) { const int e = tid; int n = 0;
            for (int i = 0; i < 256; ++i) n += (sel[i] == e) ? 1 : 0;
            unsigned run = (commit && n > 0) ? __hip_atomic_fetch_add(cnt + 16 * e, (unsigned)n, __ATOMIC_RELAXED, __HIP_MEMORY_SCOPE_AGENT) : 0u;
            for (int i = 0; i < 256; ++i) if (sel[i] == e) { const int t = tb * 64 + (i >> 2);
                if (commit) LIST[(size_t)e * NTOK + run] = t;
                TOKE[(size_t)t * 4 + (i & 3)] = ((unsigned)e << 16) | (run & 0xffffu); ++run; } }
        __syncthreads();
    }
}

__device__ __forceinline__ void build_moe_tab(const Args& a, int l, volatile LAS int* tab) {
    const unsigned* cnt = (const unsigned*)(a.ws + WS_CTL) + CW_CNT + l * 512;
    const int tid = otid();
    __syncthreads();
    if (tid < 32) tab[64 + tid] = (int)__hip_atomic_load(cnt + 16 * tid, __ATOMIC_RELAXED, __HIP_MEMORY_SCOPE_AGENT);
    __syncthreads();
    if (tid == 0) { int s = 0; for (int e = 0; e < 32; ++e) { tab[e] = s; s += (tab[64 + e] + 255) >> 8; } tab[32] = s; }
    __syncthreads();
}

__device__ __forceinline__ void phase_combine(const Args& a, int l, const LAS int* tab, bool dry = false) {
    const int tid = otid(), lane = tid & 63, wave = tid >> 6;
    unsigned char* ws = a.ws;
    float* X = (float*)(ws + WS_X);
    const bf16_t* YM = (const bf16_t*)(ws + WS_YMOE);
    const unsigned* TOKE = (const unsigned*)(ws + WS_TOKE); const float* TOKP = (const float*)(ws + WS_TOKP);
    const float* modl = (const float*)(ws + WS_MISC + MISC_MOD) + (size_t)l * 8 * 6144;
    for (int t = blockIdx.x * 8 + wave; t < NTOK; t += gridDim.x * 8) {
        f32x4 v[4], acc[4];
#pragma unroll
        for (int j = 0; j < 4; ++j) { v[j] = *(const f32x4*)(X + (size_t)t * DM + 4 * lane + 256 * j); acc[j] = (f32x4){0.f, 0.f, 0.f, 0.f}; }
#pragma unroll
        for (int k = 0; k < 4; ++k) { const unsigned ep = TOKE[(size_t)t * 4 + k]; const float pr = TOKP[(size_t)t * 4 + k];
            const int e = ep >> 16, pos = ep & 0xffff; const size_t srow = (size_t)tab[e] * 256 + pos;
#pragma unroll
            for (int j = 0; j < 4; ++j) { const u32x2 y = *(const u32x2*)(YM + srow * DM + 4 * lane + 256 * j);
                acc[j].x += pr * bflo(y.x); acc[j].y += pr * bfhi(y.x); acc[j].z += pr * bflo(y.y); acc[j].w += pr * bfhi(y.y); } }
        const float* mb = modl + (size_t)(t >> 11) * 6144;
#pragma unroll
        for (int j = 0; j < 4; ++j) { const f32x4 gt = *(const f32x4*)(mb + 5120 + 4 * lane + 256 * j); v[j] = v[j] + gt * acc[j]; }
        const float rstd = row_rstd(v, 1e-6f);
        float* Xo = dry ? (float*)(ws + WS_QA) : X; bf16_t* Ho = dry ? (bf16_t*)(ws + WS_QA + (size_t)NTOK * DM * 4) : (bf16_t*)(ws + WS_H); float* Oo = dry ? (float*)(ws + WS_QA) : a.out;
        if (l + 1 < DEPTH) {
#pragma unroll
            for (int j = 0; j < 4; ++j) *(f32x4*)(Xo + (size_t)t * DM + 4 * lane + 256 * j) = v[j];
            const float* mn = modl + (size_t)8 * 6144 + (size_t)(t >> 11) * 6144;
            norm_mod_store(v, rstd, a.in[I_N1G] + (size_t)(l + 1) * DM, mn + 1024, mn, Ho + (size_t)t * DM, lane);
        } else {
#pragma unroll
            for (int j = 0; j < 4; ++j) { const int c = 4 * lane + 256 * j; const f32x4 g = *(const f32x4*)(a.in[I_FNG] + c);
                *(f32x4*)(Oo + (size_t)t * DM + c) = v[j] * rstd * g; }
        }
    }
}

constexpr int NPL = 9;
constexpr int N_PHASES = 2 + NPL * DEPTH;
__global__ void __launch_bounds__(512, 2) fwd(Args a) {
    extern __shared__ __attribute__((aligned(16))) unsigned char smem[];
    LAS unsigned char* lds = (LAS unsigned char*)smem;
    const int tid = threadIdx.x;
    unsigned* ctl = (unsigned*)(a.ws + WS_CTL);
    volatile LAS unsigned* xbw = (volatile LAS unsigned*)(lds + LDS_CTL_OFF);
    volatile LAS int* tab = (volatile LAS int*)(lds + LDS_CTL_OFF + 256);
    volatile LAS int* qw = (volatile LAS int*)(lds + LDS_CTL_OFF + 1024);
    if (tid < 4) xbw[tid] = 0u;
    __syncthreads();
    const int lo = a.ph_lo, hi = a.ph_hi;
    XcdBarrier bar; bar.bar = ctl + CW_BAR; bar.x = 0; bar.st = xbw;
    if (hi - lo > 1) bar = xcd_barrier_post(ctl + CW_BAR, xbw);
#ifndef DUPMASK
#define DUPMASK 0
#endif
#define NREP(k) (((DUPMASK >> PHSEL(k)) & 1) ? 2 : 1)
#ifndef BRMASK
#define BRMASK 7
#endif
#ifndef PHMASK
#define PHMASK 0xFFFFF
#endif
#define PHSEL(k) ((k) < 2 ? (k) : 2 + ((k) - 2) % NPL)
#define IN(k) (((PHMASK >> PHSEL(k)) & 1) && lo <= (k) && (k) < hi)
#define SEAM(k) do { if (IN(k) && IN((k) + 1)) { xcd_barrier(bar); } } while (0)
    unsigned char* ws = a.ws;
    if (IN(0)) { for (int rep = 0; rep < NREP(0); ++rep) { phase_p0(a, lds); __syncthreads(); } SEAM(0); }
    if (IN(1)) { phase_norm1(a, 0); SEAM(1); }
    for (int l = 0; l < DEPTH; ++l) {
        const int pb = 2 + NPL * l;
        if (IN(pb + 0)) {
          for (int rep = 0; rep < NREP(pb + 0); ++rep) {
            pg8::StaticOrder S; S.init(NTOK, PLD, gridDim.x, blockIdx.x);
            pg8::EpiProj E{(bf16_t*)(ws + WS_PROJ), PLD, 29};
            pg8::gemm_phase<pg8::EpiProj, pg8::StaticOrder>(lds, (const bf16_t*)(ws + WS_H), (const bf16_t*)(ws + WS_WIN) + (size_t)l * PLD * DM, DM, 0, S, E);
          }
            SEAM(pb + 0);
        }
        if (IN(pb + 1)) { for (int rep = 0; rep < NREP(pb + 1) + ((DUPMASK >> 17) & 1); ++rep) { phase_rwkv_r1(a, l, lds); } for (int rep = 0; rep < NREP(pb + 1) + ((DUPMASK >> 16) & 1); ++rep) phase_swa(a, lds); SEAM(pb + 1); }
        if (IN(pb + 2)) {
          for (int rep = 0; rep < NREP(pb + 2); ++rep) {
            {
                pg8::StaticOrder S; S.init(NTOK, RW, gridDim.x, blockIdx.x);
                pg8::EpiProj E{(bf16_t*)(ws + WS_GG), RW, 1 << 30};
                pg8::gemm_phase<pg8::EpiProj, pg8::StaticOrder>(lds, (const bf16_t*)(ws + WS_GS), (const bf16_t*)(ws + WS_MISC + MISC_GUPT) + (size_t)l * RW * 256, 256, 0, S, E);
            }
            for (int u = blockIdx.x; u < 192; u += gridDim.x) rwkv_r2_unit(a, u, lds);
            for (;;) {
                if (tid == 0) *qw = (int)__hip_atomic_fetch_add(ctl + CW_QH + 64 * (2 * l + rep), 1u, __ATOMIC_RELAXED, __HIP_MEMORY_SCOPE_AGENT);
                __syncthreads();
                const int item = *qw;
                __syncthreads();
                if (item >= 768) break;
                diffattn_unit(a, l, item, lds);
            }
          }
            SEAM(pb + 2);
        }
        if (IN(pb + 3)) { for (int rep = 0; rep < NREP(pb + 3); ++rep) phase_rwkv_out(a, l); SEAM(pb + 3); }
        if (IN(pb + 4)) {
          for (int rep = 0; rep < NREP(pb + 4); ++rep) {
            pg8::StaticOrder S; S.init(NTOK, DM, gridDim.x, blockIdx.x);
            const bf16_t* P = (const bf16_t*)(ws + WS_PROJ); float* MF = (float*)(ws + WS_MF); bf16_t* MG = (bf16_t*)(ws + WS_MERGED);
            { pg8::EpiBranchM E{P, MG}; pg8::gemm_phase<pg8::EpiBranchM, pg8::StaticOrder>(lds, (const bf16_t*)(ws + WS_OA), (const bf16_t*)(ws + WS_WA) + (size_t)l * DM * 1792, 1792, 0, S, E); }
          }
            SEAM(pb + 4);
        }
        if (IN(pb + 5)) {
            pg8::StaticOrder S; S.init(NTOK, DM, gridDim.x, blockIdx.x);
            pg8::EpiOut E{l == 0 ? a.in[I_X] : (const float*)(ws + WS_X), (float*)(ws + WS_X), (const float*)(ws + WS_MISC + MISC_MOD) + (size_t)l * 8 * 6144 + 2048};
            pg8::gemm_phase<pg8::EpiOut, pg8::StaticOrder>(lds, (const bf16_t*)(ws + WS_MERGED), (const bf16_t*)(ws + WS_WO) + (size_t)l * DM * DM, DM, 0, S, E);
            SEAM(pb + 5);
        }
        if (IN(pb + 6)) { for (int rep = 0; rep < NREP(pb + 6); ++rep) phase_route(a, l, lds, rep == NREP(pb + 6) - 1); SEAM(pb + 6); }
        if (IN(pb + 7)) {
          for (int rep = 0; rep < NREP(pb + 7); ++rep) {
            build_moe_tab(a, l, tab);
            unsigned* rtc = ctl + CW_RT + (l * 2 + rep) * 2048;
            {
                pg8::MoeOrder<true> S{(const LAS int*)tab, (const int*)(ws + WS_LIST), 8, (int)gridDim.x, (int)blockIdx.x, rtc};
                pg8::EpiMoe1 E{(bf16_t*)(ws + WS_ACT), a.in[I_B1] + (size_t)l * NE * 2 * FF};
                pg8::gemm_phase<pg8::EpiMoe1, pg8::MoeOrder<true>>(lds, (const bf16_t*)(ws + WS_H), (const bf16_t*)(ws + WS_W1) + (size_t)l * NE * 2 * FF * DM, DM, (size_t)2 * FF * DM * 2, S, E);
            }
            {
                pg8::MoeOrder<false> S{(const LAS int*)tab, nullptr, 4, (int)gridDim.x, (int)(gridDim.x - 1 - blockIdx.x), rtc};
                pg8::EpiMoe2 E{(bf16_t*)(ws + WS_YMOE), a.in[I_B2] + (size_t)l * NE * DM};
                pg8::gemm_phase<pg8::EpiMoe2, pg8::MoeOrder<false>>(lds, (const bf16_t*)(ws + WS_ACT), (const bf16_t*)(ws + WS_W2) + (size_t)l * NE * DM * FF, FF, (size_t)DM * FF * 2, S, E);
            }
          }
            SEAM(pb + 7);
        }
        if (IN(pb + 8)) { build_moe_tab(a, l, tab); for (int rep = 0; rep < NREP(pb + 8); ++rep) phase_combine(a, l, (const LAS int*)tab, rep != NREP(pb + 8) - 1); SEAM(pb + 8); }
    }
#undef IN
#undef SEAM
}

#ifndef MK_ONE_LAUNCH
#define MK_ONE_LAUNCH 1
#endif
extern "C" void kernel_launch(void* const* d_in, const int* in_sizes, int n_in, void* d_out, int out_size, void* d_ws, size_t ws_size, hipStream_t stream) {
    static int grid = 0;
    if (grid == 0) {
        if (n_in != 32 || ws_size < WS_END) { fprintf(stderr, "kernel_launch: unexpected n_in %d or ws %zu < %zu\n", n_in, ws_size, (size_t)WS_END); grid = -1; return; }
        int dev = 0, cus = 0;
        if (hipGetDevice(&dev) != hipSuccess || hipDeviceGetAttribute(&cus, hipDeviceAttributeMultiprocessorCount, dev) != hipSuccess) { grid = -1; return; }
        if (hipFuncSetAttribute((const void*)fwd, hipFuncAttributeMaxDynamicSharedMemorySize, LDS_BYTES) != hipSuccess) { fprintf(stderr, "kernel_launch: hipFuncSetAttribute failed\n"); grid = -1; return; }
        int per_cu = 0;
        if (hipOccupancyMaxActiveBlocksPerMultiprocessor(&per_cu, (const void*)fwd, 512, LDS_BYTES) != hipSuccess || per_cu < 1) fprintf(stderr, "kernel_launch: occupancy query says %d\n", per_cu);
        (void)hipGetLastError();
        grid = cus;
    }
    if (grid < 0) return;
    (void)hipMemsetAsync((char*)d_ws + WS_CTL, 0, CTL_BYTES, stream);
    Args a{};
    for (int i = 0; i < 32; ++i) a.in[i] = (const float*)d_in[i];
    a.out = (float*)d_out; a.ws = (unsigned char*)d_ws;
#if MK_ONE_LAUNCH
    a.ph_lo = 0; a.ph_hi = N_PHASES;
    hipLaunchKernelGGL(fwd, dim3(grid), dim3(512), LDS_BYTES, stream, a);
#else
    for (int p = 0; p < N_PHASES; ++p) { a.ph_lo = p; a.ph_hi = p + 1; hipLaunchKernelGGL(fwd, dim3(grid), dim3(512), LDS_BYTES, stream, a); }
#endif
}
```

```cpp
#include <hip/hip_runtime.h>
#include <stdint.h>
#include <stdio.h>

#define LAS __attribute__((address_space(3)))
typedef unsigned short bf16_t;
typedef short bf16x8 __attribute__((ext_vector_type(8)));
typedef short s16x4 __attribute__((ext_vector_type(4)));
typedef float f32x2 __attribute__((ext_vector_type(2)));
typedef float f32x4 __attribute__((ext_vector_type(4)));
typedef float f32x16 __attribute__((ext_vector_type(16)));
typedef unsigned u32x2 __attribute__((ext_vector_type(2)));
typedef unsigned u32x4 __attribute__((ext_vector_type(4)));
typedef __bf16 bf16x2_t __attribute__((ext_vector_type(2)));
typedef short v4i16_t __attribute__((ext_vector_type(4)));

constexpr int NB = 8, NT = 2048, DM = 1024, NTOK = NB * NT, DEPTH = 2;
constexpr int IN_COLS = 10368, PLD = 10496;
constexpr int C_AQ = 0, C_AK = 768, C_AV = 1536, C_BS = 2304, C_CQ = 5120, C_CK = 5888, C_CV = 6656, C_G = 7424;
constexpr int RSTR = 2688, RW = 768, NE = 32, FF = 1024;
constexpr float LOG2E = 1.4426950408889634f;

constexpr size_t al256(size_t x) { return (x + 255) & ~(size_t)255; }
constexpr size_t WS_CTL = 0;
constexpr size_t CTL_BYTES = 65536;
constexpr size_t WS_MISC = WS_CTL + CTL_BYTES;
constexpr size_t MISC_MOD = 0, MISC_LAM = 393216, MISC_BIASA = 393472, MISC_BIASC = 399872, MISC_WUPT = 409600, MISC_AUPT = 409600 + 393216, MISC_GUPT = 409600 + 2 * 393216, MISC_BYTES = 2 << 20;
constexpr size_t WS_WIN = WS_MISC + MISC_BYTES;
constexpr size_t WS_WA = WS_WIN + (size_t)DEPTH * PLD * DM * 2;
constexpr size_t WS_WB = WS_WA + (size_t)DEPTH * DM * 256 * 2;
constexpr size_t WS_WC = WS_WB + (size_t)DEPTH * DM * 768 * 2;
constexpr size_t WS_WO = WS_WC + (size_t)DEPTH * DM * 768 * 2;
constexpr size_t WS_W1 = WS_WO + (size_t)DEPTH * DM * DM * 2;
constexpr size_t WS_W2 = WS_W1 + (size_t)DEPTH * NE * 2 * FF * DM * 2;
constexpr size_t WS_H = WS_W2 + (size_t)DEPTH * NE * DM * FF * 2;
constexpr size_t WS_X = WS_H + (size_t)NTOK * DM * 2;
constexpr size_t WS_OA = WS_X + (size_t)NTOK * DM * 4;
constexpr size_t WS_OB = WS_OA + (size_t)NTOK * 256 * 2;
constexpr size_t WS_OC = WS_OB + (size_t)NTOK * 768 * 2;
constexpr size_t WS_MERGED = WS_OC + (size_t)NTOK * 768 * 2;
constexpr size_t WS_LIST = WS_MERGED + (size_t)NTOK * DM * 2;
constexpr size_t WS_TOKE = WS_LIST + (size_t)NE * NTOK * 4;
constexpr size_t WS_TOKP = WS_TOKE + (size_t)NTOK * 4 * 4;
constexpr size_t WS_U = WS_TOKP + (size_t)NTOK * 4 * 4;
constexpr size_t WS_PROJ = WS_U;
constexpr size_t WS_RR = WS_PROJ + (size_t)NTOK * PLD * 2;
constexpr size_t WS_RV = WS_RR + (size_t)NTOK * RW * 4;
constexpr size_t WS_RWD = WS_RV + (size_t)NTOK * RW * 4;
constexpr size_t WS_RKK = WS_RWD + (size_t)2 * NTOK * RW * 4;
constexpr size_t WS_RKKA = WS_RKK + (size_t)2 * NTOK * RW * 4;
constexpr size_t WS_RKD = WS_RKKA + (size_t)2 * NTOK * RW * 4;
constexpr size_t WS_GS = WS_RKD + (size_t)2 * NTOK * RW * 4;
constexpr size_t WS_Y = WS_GS + (size_t)NTOK * 128 * 4;
constexpr size_t WS_OAG = WS_Y + (size_t)2 * NTOK * RW * 4;
constexpr size_t WS_LSE = WS_OAG + (size_t)3 * NTOK * 256 * 4;
constexpr size_t WS_MF = WS_LSE + (size_t)3 * NTOK * 4 * 4;
constexpr size_t WS_QA = WS_MF + (size_t)NTOK * DM * 4;
constexpr size_t WS_SS = WS_QA + (size_t)6144 * 4096 * 2;
constexpr size_t WS_END1 = WS_SS + (size_t)6144 * 4096 * 2;
constexpr size_t WS_GG = WS_Y;
constexpr size_t WS_MP = WS_RWD, WS_NP = WS_RKK, WS_Y0 = WS_RKKA;
constexpr int SLOT_ROWS = 4 * NTOK + NE * 256;
constexpr size_t WS_ACT = WS_U;
constexpr size_t WS_YMOE = WS_ACT + (size_t)SLOT_ROWS * FF * 2;
constexpr size_t WS_END2 = WS_YMOE + (size_t)SLOT_ROWS * DM * 2;
constexpr size_t WS_END = WS_END1 > WS_END2 ? WS_END1 : WS_END2;

constexpr int CW_BAR = 0;
constexpr int CW_CNT = 13312;
constexpr int CW_QH = 4224;
constexpr int CW_RT = 5120;

constexpr int LDS_STAGE = 155648;
constexpr int LDS_CTL_OFF = LDS_STAGE;
constexpr int LDS_BYTES = LDS_STAGE + 4096;

__device__ __forceinline__ int otid() { int t = threadIdx.x; asm volatile("" : "+v"(t)); return t; }
__device__ __forceinline__ int obid() { int t = blockIdx.x; asm volatile("" : "+s"(t)); return t; }
__device__ __forceinline__ unsigned pk2(float lo, float hi) { f32x2 v = {lo, hi}; bf16x2_t b = __builtin_convertvector(v, bf16x2_t); return __builtin_bit_cast(unsigned, b); }
__device__ __forceinline__ u32x4 pack8(const float (&x)[8]) { u32x4 w; w.x = pk2(x[0], x[1]); w.y = pk2(x[2], x[3]); w.z = pk2(x[4], x[5]); w.w = pk2(x[6], x[7]); return w; }
__device__ __forceinline__ bf16_t f2bf(float x) { return (bf16_t)(pk2(x, 0.f) & 0xffffu); }
__device__ __forceinline__ float bflo(unsigned u) { return __builtin_bit_cast(float, u << 16); }
__device__ __forceinline__ float bfhi(unsigned u) { return __builtin_bit_cast(float, u & 0xffff0000u); }
__device__ __forceinline__ float bf2f(bf16_t h) { return __builtin_bit_cast(float, (unsigned)h << 16); }
__device__ __forceinline__ float wave_sum(float v) {
#pragma unroll
    for (int o = 1; o < 64; o <<= 1) v += __shfl_xor(v, o);
    return v;
}
__device__ __forceinline__ float sigmoidf_(float x) { return __builtin_amdgcn_rcpf(1.f + __builtin_amdgcn_exp2f(-LOG2E * x)); }
__device__ __forceinline__ int crow(int r, int hi) { return (r & 3) + 8 * (r >> 2) + 4 * hi; }
__device__ __forceinline__ s16x4 vtr(const LAS unsigned char* p) { return __builtin_bit_cast(s16x4, __builtin_amdgcn_ds_read_tr16_b64_v4i16((LAS v4i16_t*)p)); }
__device__ __forceinline__ float dpp_sum8(float x) {
    int v = __builtin_bit_cast(int, x);
    x += __builtin_bit_cast(float, __builtin_amdgcn_update_dpp(0, v, 0xB1, 0xF, 0xF, true));
    v = __builtin_bit_cast(int, x);
    x += __builtin_bit_cast(float, __builtin_amdgcn_update_dpp(0, v, 0x4E, 0xF, 0xF, true));
    v = __builtin_bit_cast(int, x);
    x += __builtin_bit_cast(float, __builtin_amdgcn_update_dpp(0, v, 0x141, 0xF, 0xF, true));
    return x;
}

#define XB_TMO      128
#define XB_XCNT(j)  (256  + 64 * (j))
#define XB_XSUB(j)  (1280 + 64 * (j))
#define XB_XGEN(j)  (2304 + 64 * (j))
#define XB_TOP      3328
#define XB_TOPGEN   3392
#define XCD_BAR_WORDS 3456
#define XB_SPIN_CAP (1u << 18)
__device__ __forceinline__ unsigned xb_ld(unsigned* p)              { return __hip_atomic_load(p, __ATOMIC_RELAXED, __HIP_MEMORY_SCOPE_AGENT); }
__device__ __forceinline__ unsigned xb_add(unsigned* p, unsigned v) { return __hip_atomic_fetch_add(p, v, __ATOMIC_RELAXED, __HIP_MEMORY_SCOPE_AGENT); }
__device__ __forceinline__ unsigned xb_xcc_id() { return (unsigned)__builtin_amdgcn_s_getreg((3 << 11) | 20) & 0xFu; }
#define XB_SPIN(cond, bar) do { unsigned _sp = 0; while (cond) { __builtin_amdgcn_s_sleep(1); \
    if ((++_sp & 255u) == 0u) { if (xb_ld(&(bar)[XB_TMO])) break; if (_sp > XB_SPIN_CAP) { atomicAdd(&(bar)[XB_TMO], 1u); break; } } } } while (0)
struct XcdBarrier { unsigned* bar; unsigned x; volatile LAS unsigned* st; };
__device__ __forceinline__ XcdBarrier xcd_barrier_post(unsigned* bar, volatile LAS unsigned* st) {
    XcdBarrier b; b.bar = bar; b.x = xb_xcc_id(); b.st = st;
    if (threadIdx.x == 0) (void)xb_add(&bar[XB_XCNT(b.x)], 1u);
    return b;
}
__device__ __forceinline__ void xcd_barrier_complete(unsigned* bar, unsigned x, unsigned& nloc, unsigned& nx) {
    const unsigned G = gridDim.x * gridDim.y * gridDim.z;
    unsigned sum, cnt, mine, sp = 0u;
    for (;;) {
        sum = 0u; cnt = 0u; mine = 0u;
#pragma unroll
        for (unsigned j = 0; j < 16; ++j) { const unsigned c = xb_ld(&bar[XB_XCNT(j)]); sum += c; cnt += (c > 0u) ? 1u : 0u; mine = (j == x) ? c : mine; }
        if (sum == G) break;
        __builtin_amdgcn_s_sleep(1);
        if ((++sp & 255u) == 0u) { if (xb_ld(&bar[XB_TMO])) break; if (sp > XB_SPIN_CAP) { atomicAdd(&bar[XB_TMO], 1u); break; } }
    }
    nloc = mine > 0u ? mine : 1u; nx = cnt > 0u ? cnt : 1u;
}
__device__ __forceinline__ void xcd_barrier(const XcdBarrier& b) {
    asm volatile("s_waitcnt vmcnt(0)" ::: "memory");
    __syncthreads();
    if (threadIdx.x == 0) {
        unsigned* bar = b.bar;
        __builtin_amdgcn_s_waitcnt(0);
        unsigned nloc = b.st[0], nx = b.st[1];
        if (nloc == 0u) { xcd_barrier_complete(bar, b.x, nloc, nx); b.st[0] = nloc; b.st[1] = nx; }
        const unsigned old = xb_add(&bar[XB_XSUB(b.x)], 1u);
        const unsigned gen = old / nloc;
        if (old + 1u == (gen + 1u) * nloc) {
            __builtin_amdgcn_fence(__ATOMIC_RELEASE, "agent");
            asm volatile("s_waitcnt vmcnt(0)" ::: "memory");
            const unsigned og = xb_add(&bar[XB_TOP], 1u);
            const unsigned tg = og / nx;
            if (og + 1u == (tg + 1u) * nx) xb_add(&bar[XB_TOPGEN], 1u);
            else XB_SPIN(xb_ld(&bar[XB_TOPGEN]) == tg, bar);
            __builtin_amdgcn_fence(__ATOMIC_ACQUIRE, "agent");
            xb_add(&bar[XB_XGEN(b.x)], 1u);
            asm volatile("s_waitcnt vmcnt(0)" ::: "memory");
        } else {
            XB_SPIN(xb_ld(&bar[XB_XGEN(b.x)]) == gen, bar);
            __builtin_amdgcn_fence(__ATOMIC_ACQUIRE, "agent");
            asm volatile("s_waitcnt vmcnt(0)" ::: "memory");
        }
    }
    __syncthreads();
}

namespace pg8 {
constexpr int BM = 256, BK = 64, HALF = 128, HTB = HALF * BK * 2, STAGE_BYTES = 8 * HTB, NXCD = 8, WGM = 8;
__device__ __forceinline__ int lds_byte(int r, int c) { const int st = (r >> 4) * 2 + (c >> 5), rr = r & 15, cc = c & 31, ob = rr * 64 + cc * 2; return st * 1024 + (ob ^ (((ob >> 9) & 1) << 5)); }
__device__ __forceinline__ void stage_rc(int b, int& R, int& C) { const int st = b / 1024, sb = b % 1024, swz = sb ^ (((sb >> 9) & 1) << 5); R = (st >> 1) * 16 + swz / 64; C = (st & 1) * 32 + (swz % 64) / 2; }
__device__ __forceinline__ int perm32(int rho) { const int n = rho >> 4, i = rho & 15; return 8 * (i >> 2) + 4 * n + (i & 3); }

struct Unit { int pm, pn, e, lt; };

struct StaticOrder {
    static constexpr bool GATHER = false;
    int nM, nN, nwg, G, c;
    __device__ void init(int M, int N, int G_, int c_) { nM = M / BM; nN = N / BM; nwg = nM * nN; G = G_; c = c_; }
    __device__ __forceinline__ bool next(int i, Unit& u) const {
        const long L = (long)i * G + c; if (L >= nwg) return false;
        int wgid = (int)L; { const int q = nwg / NXCD, r = nwg % NXCD, xcd = wgid % NXCD, off = wgid / NXCD; wgid = (xcd < r ? xcd * (q + 1) : r * (q + 1) + (xcd - r) * q) + off; }
        const int nig = WGM * nN, gid = wgid / nig, fm = gid * WGM, gsz = (nM - fm) < WGM ? (nM - fm) : WGM;
        u.pm = fm + ((wgid % nig) % gsz); u.pn = (wgid % nig) / gsz; u.e = 0; u.lt = 0; return true;
    }
    __device__ __forceinline__ int arow(const Unit& u, int r) const { return u.pm * BM + r; }
    __device__ __forceinline__ void a_ready(const Unit&) const {}
    __device__ __forceinline__ void done(const Unit&) const {}
};
template <bool GATHER_> struct MoeOrder {
    static constexpr bool GATHER = GATHER_;
    const LAS int* tab;
    const int* list;
    int ncol, G, c;
    __device__ __forceinline__ bool next(int i, Unit& u) const {
        if (true) {
            const int L = i * G + c; const int total = tab[32] * ncol; if (L >= total) return false;
            const int rt = (ncol == 8) ? (L >> 3) : (L >> 2); u.pn = L - rt * ncol; u.pm = rt;
            const int ln = threadIdx.x & 63; const int tv = tab[ln < 32 ? ln : 32];
            const unsigned long long bal = __ballot(ln < 32 && tv <= rt);
            const int e = __builtin_popcountll(bal) - 1;
            u.e = e; u.lt = rt - __builtin_amdgcn_readlane(tv, e); return true;
        }
        const int x = c & 7, W = G >> 3; int q = i * W + (c >> 3);
#pragma unroll 1
        for (int k = 0; k < 4; ++k) { const int e = x + 8 * k; const int nt_e = tab[e + 1] - tab[e], sz = nt_e * ncol;
            if (q < sz) { const int lt = q / ncol; u.pn = q - lt * ncol; u.lt = lt; u.e = e; u.pm = tab[e] + lt; return true; }
            q -= sz; }
        return false;
    }
    __device__ __forceinline__ int arow(const Unit& u, int r) const {
        if (!GATHER_) return u.pm * BM + r;
        const int pos = u.lt * BM + r; const int cnt = tab[64 + u.e];
        return pos < cnt ? list[(size_t)u.e * NTOK + pos] : 0;
    }
    unsigned* rtc;
    __device__ __forceinline__ void done(const Unit& u) const {
        if (GATHER_) { asm volatile("s_waitcnt vmcnt(0)" ::: "memory");
            if ((threadIdx.x & 63) == 0) __hip_atomic_fetch_add(rtc + 16 * u.pm, 1u, __ATOMIC_RELAXED, __HIP_MEMORY_SCOPE_AGENT); }
    }
    __device__ __forceinline__ void a_ready(const Unit& u) const {
        if (!GATHER_) {
            if (threadIdx.x < 64) {
                unsigned sp = 0;
                while ((unsigned)__builtin_amdgcn_readfirstlane(__hip_atomic_load(rtc + 16 * u.pm, __ATOMIC_RELAXED, __HIP_MEMORY_SCOPE_AGENT)) < 64u) {
                    __builtin_amdgcn_s_sleep(2); if (++sp > (1u << 22)) break; }
                __builtin_amdgcn_fence(__ATOMIC_ACQUIRE, "agent");
                asm volatile("s_waitcnt vmcnt(0)" ::: "memory");
            }
            asm volatile("" ::: "memory"); __builtin_amdgcn_s_barrier(); asm volatile("" ::: "memory");
        }
    }
};

template <class Epi, class Sched>
__device__ __forceinline__ void gemm_phase(LAS unsigned char* lds, const bf16_t* A, const bf16_t* Bt, const int K, const size_t b_estride_bytes, const Sched& S, const Epi& E) {
    constexpr bool GATHER = Sched::GATHER;
    const int tid = otid(), wid = __builtin_amdgcn_readfirstlane(tid >> 6), lane = tid & 63, wr = wid >> 2, wc = wid & 3, fr = lane & 15, fq = lane >> 4;
    const int nt = K / BK;
    int Rr[2], Cc[2]; unsigned voffA[2], voffB[2];
#pragma unroll
    for (int i = 0; i < 2; ++i) { int R, C; stage_rc(tid * 16 + i * 8192, R, C); const int Rb = Epi::PERM ? ((R & ~31) + perm32(R & 31)) : R;
        Rr[i] = R; Cc[i] = C; voffA[i] = (unsigned)(R * K + C) * 2u; voffB[i] = (unsigned)(Rb * K + C) * 2u; }
    const size_t kstep = (size_t)(BK * 2);
    const size_t hstep = (size_t)HALF * K * 2;
    const size_t tstep = 2 * hstep;
    const unsigned ldsw = (unsigned)wid * 1024u;
    const int aoff = lds_byte(wr * 64 + fr, fq * 8), boff = lds_byte(wc * 32 + fr, fq * 8);
#define PG8_SA(b, h) (((b) * 2 + (h)) * HTB)
#define PG8_SB(b, h) ((4 + (b) * 2 + (h)) * HTB)
#define PG8_STAGE(bufoff, gbase, voff) do { _Pragma("unroll") for (int _i = 0; _i < 2; ++_i) \
        __builtin_amdgcn_global_load_lds((const unsigned*)((const char*)(gbase) + (voff)[_i]), (LAS unsigned*)(lds + (bufoff) + ldsw + _i * 8192), 16, 0, 0); } while (0)
#define PG8_STAGEA(bufoff, uptr, offs, h, kb) do { _Pragma("unroll") for (int _i = 0; _i < 2; ++_i) { const char* _src; \
        if constexpr (GATHER) _src = (const char*)A + (size_t)(offs)[h][_i] + (size_t)(kb); else _src = (uptr) + (size_t)(h) * hstep + (size_t)(kb) + voffA[_i]; \
        __builtin_amdgcn_global_load_lds((const unsigned*)_src, (LAS unsigned*)(lds + (bufoff) + ldsw + _i * 8192), 16, 0, 0); } } while (0)
#define PG8_LDA(dst, b, h) do { _Pragma("unroll") for (int m = 0; m < 4; ++m) _Pragma("unroll") for (int k = 0; k < 2; ++k) dst[m][k] = *(const LAS bf16x8*)(lds + PG8_SA(b, h) + aoff + m * 2048 + k * 1024); } while (0)
#define PG8_LDB(dst, b, h) do { _Pragma("unroll") for (int n = 0; n < 2; ++n) _Pragma("unroll") for (int k = 0; k < 2; ++k) dst[n][k] = *(const LAS bf16x8*)(lds + PG8_SB(b, h) + boff + n * 2048 + k * 1024); } while (0)
#define PG8_MMA(ai, bj, At, Bt_) do { __builtin_amdgcn_s_setprio(1); _Pragma("unroll") for (int m = 0; m < 4; ++m) _Pragma("unroll") for (int n = 0; n < 2; ++n) _Pragma("unroll") for (int k = 0; k < 2; ++k) \
        acc[ai][bj][m][n] = __builtin_amdgcn_mfma_f32_16x16x32_bf16(Bt_[n][k], At[m][k], acc[ai][bj][m][n], 0, 0, 0); __builtin_amdgcn_s_setprio(0); } while (0)
#define PG8_WAIT_V(n) asm volatile("s_waitcnt vmcnt(" #n ")" ::: "memory")
#define PG8_WAIT_L(n) asm volatile("s_waitcnt lgkmcnt(" #n ")" ::: "memory")
#define PG8_BAR __builtin_amdgcn_s_barrier()
#define PG8_SCHED __builtin_amdgcn_sched_barrier(0)
#define PG8_AOFFS(dst, u) do { if constexpr (GATHER) { _Pragma("unroll") for (int _h = 0; _h < 2; ++_h) _Pragma("unroll") for (int _i = 0; _i < 2; ++_i) \
        dst[_h][_i] = ((unsigned)S.arow(u, _h * HALF + Rr[_i]) * (unsigned)K + (unsigned)Cc[_i]) * 2u; } } while (0)
    Unit cur, nxt; int ui = 0;
    if (!S.next(0, cur)) return;
    f32x4 acc[2][2][4][2];
#pragma unroll
    for (int a = 0; a < 2; ++a)
#pragma unroll
        for (int b = 0; b < 2; ++b)
#pragma unroll
            for (int m = 0; m < 4; ++m)
#pragma unroll
                for (int n = 0; n < 2; ++n) acc[a][b][m][n] = (f32x4){0.f, 0.f, 0.f, 0.f};
    bf16x8 At[4][2], B0[2][2], B1[2][2];
    unsigned aoc[2][2] = {{0u, 0u}, {0u, 0u}}, aon[2][2] = {{0u, 0u}, {0u, 0u}};
    PG8_AOFFS(aoc, cur);
    const char* cA = (const char*)A + (size_t)cur.pm * tstep;
    const char* cB = (const char*)Bt + (size_t)cur.e * b_estride_bytes + (size_t)cur.pn * tstep;
    S.a_ready(cur);
    PG8_STAGE(PG8_SB(0, 0), cB, voffB); PG8_STAGEA(PG8_SA(0, 0), cA, aoc, 0, 0); PG8_STAGE(PG8_SB(0, 1), cB + hstep, voffB); PG8_STAGEA(PG8_SA(0, 1), cA, aoc, 1, 0);
    if (wr == 1) PG8_BAR;
    PG8_WAIT_V(4); PG8_BAR;
    PG8_STAGE(PG8_SB(1, 0), cB + kstep, voffB); PG8_STAGEA(PG8_SA(1, 0), cA, aoc, 0, kstep); PG8_STAGE(PG8_SB(1, 1), cB + hstep + kstep, voffB);
    PG8_WAIT_V(6); PG8_BAR;
    for (;;) {
        const bool has_next = S.next(ui + 1, nxt);
        const char* nA = has_next ? (const char*)A + (size_t)nxt.pm * tstep : cA;
        const char* nB = has_next ? (const char*)Bt + (size_t)nxt.e * b_estride_bytes + (size_t)nxt.pn * tstep : cB;
        if constexpr (GATHER) {
            if (has_next) { PG8_AOFFS(aon, nxt); } else {
#pragma unroll
                for (int h = 0; h < 2; ++h)
#pragma unroll
                    for (int i = 0; i < 2; ++i) aon[h][i] = aoc[h][i]; } }
#define PG8_KITER(t) do { \
            const bool last = (t == nt - 2); \
            const size_t k1 = (size_t)(t + 1) * kstep; \
            const size_t k2 = last ? (size_t)0 : (size_t)(t + 2) * kstep; \
            const size_t k3 = k2 + kstep; \
            const char* a2p = last ? nA : cA; \
            unsigned a2o[2][2]; \
_Pragma("unroll") \
            for (int h = 0; h < 2; ++h) \
_Pragma("unroll") \
                for (int i = 0; i < 2; ++i) a2o[h][i] = last ? aon[h][i] : aoc[h][i]; \
            const char* b2 = last ? nB : cB + (size_t)(t + 2) * kstep; const char* b3 = b2 + kstep; \
            if (last && has_next) S.a_ready(nxt); \
            PG8_LDB(B0, 0, 0); PG8_SCHED; PG8_LDA(At, 0, 0); PG8_STAGEA(PG8_SA(1, 1), cA, aoc, 1, k1); \
            PG8_WAIT_L(8); PG8_BAR; PG8_WAIT_L(0); PG8_MMA(0, 0, At, B0); PG8_BAR; PG8_SCHED; \
            PG8_LDB(B1, 0, 1); PG8_STAGE(PG8_SB(0, 0), b2, voffB); \
            PG8_BAR; PG8_WAIT_L(0); PG8_MMA(0, 1, At, B1); PG8_BAR; \
            PG8_LDA(At, 0, 1); PG8_STAGEA(PG8_SA(0, 0), a2p, a2o, 0, k2); \
            PG8_BAR; PG8_WAIT_L(0); PG8_MMA(1, 0, At, B0); PG8_BAR; PG8_SCHED; \
            PG8_STAGE(PG8_SB(0, 1), b2 + hstep, voffB); \
            PG8_WAIT_V(6); PG8_BAR; PG8_MMA(1, 1, At, B1); PG8_BAR; \
            PG8_LDB(B0, 1, 0); PG8_SCHED; PG8_LDA(At, 1, 0); PG8_STAGEA(PG8_SA(0, 1), a2p, a2o, 1, k2); \
            PG8_WAIT_L(8); PG8_BAR; PG8_WAIT_L(0); PG8_MMA(0, 0, At, B0); PG8_BAR; PG8_SCHED; \
            PG8_LDB(B1, 1, 1); PG8_STAGE(PG8_SB(1, 0), b3, voffB); \
            PG8_BAR; PG8_WAIT_L(0); PG8_MMA(0, 1, At, B1); PG8_BAR; \
            PG8_LDA(At, 1, 1); PG8_STAGEA(PG8_SA(1, 0), a2p, a2o, 0, k3); \
            PG8_BAR; PG8_WAIT_L(0); PG8_MMA(1, 0, At, B0); PG8_BAR; PG8_SCHED; \
            PG8_STAGE(PG8_SB(1, 1), b3 + hstep, voffB); \
            PG8_WAIT_V(6); PG8_BAR; PG8_MMA(1, 1, At, B1); PG8_BAR; \
        } while (0)
        if constexpr (Epi::MIDHOOK) {
#pragma unroll 1
            for (int t = 0; t < Epi::T1; t += 2) PG8_KITER(t);
            asm volatile("" ::: "memory"); __builtin_amdgcn_sched_barrier(0); E.mid(acc, cur, 0, wr, wc, fr, fq); asm volatile("" ::: "memory"); __builtin_amdgcn_sched_barrier(0);
#pragma unroll 1
            for (int t = Epi::T1; t < Epi::T2; t += 2) PG8_KITER(t);
            asm volatile("" ::: "memory"); __builtin_amdgcn_sched_barrier(0); E.mid(acc, cur, 1, wr, wc, fr, fq); asm volatile("" ::: "memory"); __builtin_amdgcn_sched_barrier(0);
#pragma unroll 1
            for (int t = Epi::T2; t < nt; t += 2) PG8_KITER(t);
        } else {
#pragma unroll 1
            for (int t = 0; t < nt; t += 2) PG8_KITER(t);
        }
#undef PG8_KITER
        E(acc, cur, wr, wc, fr, fq); S.done(cur);
        if (!has_next) break;
#pragma unroll
        for (int a = 0; a < 2; ++a)
#pragma unroll
            for (int b = 0; b < 2; ++b)
#pragma unroll
                for (int m = 0; m < 4; ++m)
#pragma unroll
                    for (int n = 0; n < 2; ++n) acc[a][b][m][n] = (f32x4){0.f, 0.f, 0.f, 0.f};
        cur = nxt; cA = nA; cB = nB; ++ui;
#pragma unroll
        for (int h = 0; h < 2; ++h)
#pragma unroll
            for (int i = 0; i < 2; ++i) aoc[h][i] = aon[h][i];
    }
    PG8_WAIT_V(0);
    if (wr == 0) PG8_BAR;
    PG8_BAR;
#undef PG8_SA
#undef PG8_SB
#undef PG8_STAGE
#undef PG8_STAGEA
#undef PG8_LDA
#undef PG8_LDB
#undef PG8_MMA
#undef PG8_WAIT_V
#undef PG8_WAIT_L
#undef PG8_BAR
#undef PG8_SCHED
#undef PG8_AOFFS
}

typedef f32x4 Acc[2][2][4][2];

struct EpiProj {
    static constexpr bool PERM = true, MIDHOOK = false;
    bf16_t* O; int ld; int sg_from;
    __device__ __forceinline__ void operator()(const Acc& acc, const Unit& u, int wr, int wc, int fr, int fq) const {
        const int row0 = u.pm * BM + wr * 64 + fr, col0 = u.pn * BM + wc * 32 + 8 * fq; const bool sg = u.pn >= sg_from;
#pragma unroll
        for (int ai = 0; ai < 2; ++ai)
#pragma unroll
            for (int m = 0; m < 4; ++m) { bf16_t* rowp = O + (size_t)(row0 + ai * HALF + m * 16) * ld + col0;
#pragma unroll
                for (int bj = 0; bj < 2; ++bj) { f32x4 v0 = acc[ai][bj][m][0], v1 = acc[ai][bj][m][1];
                    if (sg) {
#pragma unroll
                        for (int j = 0; j < 4; ++j) { v0[j] = sigmoidf_(v0[j]); v1[j] = sigmoidf_(v1[j]); } }
                    u32x4 w; w.x = pk2(v0[0], v0[1]); w.y = pk2(v0[2], v0[3]); w.z = pk2(v1[0], v1[1]); w.w = pk2(v1[2], v1[3]);
                    *(u32x4*)(rowp + bj * HALF) = w; } }
    }
};
template <int SEG> struct EpiBranch {
    static constexpr bool PERM = true, MIDHOOK = false;
    const bf16_t* P; float* MF; bf16_t* MG;
    __device__ __forceinline__ void operator()(const Acc& acc, const Unit& u, int wr, int wc, int fr, int fq) const {
        const int row0 = u.pm * BM + wr * 64 + fr, col0 = u.pn * BM + wc * 32 + 8 * fq;
#pragma unroll
        for (int ai = 0; ai < 2; ++ai)
#pragma unroll
            for (int m = 0; m < 4; ++m) { const size_t r = (size_t)(row0 + ai * HALF + m * 16);
                asm volatile("" ::: "memory");
#pragma unroll
                for (int bj = 0; bj < 2; ++bj) { const int c = col0 + bj * HALF;
                    const u32x4 g = *(const u32x4*)(P + r * PLD + C_G + SEG * 1024 + c);
                    f32x4 v0 = acc[ai][bj][m][0], v1 = acc[ai][bj][m][1];
                    v0[0] *= bflo(g.x); v0[1] *= bfhi(g.x); v0[2] *= bflo(g.y); v0[3] *= bfhi(g.y);
                    v1[0] *= bflo(g.z); v1[1] *= bfhi(g.z); v1[2] *= bflo(g.w); v1[3] *= bfhi(g.w);
                    float* mp = MF + r * DM + c;
                    if (SEG > 0) { v0 += *(const f32x4*)mp; v1 += *(const f32x4*)(mp + 4); }
                    if (SEG < 2) { *(f32x4*)mp = v0; *(f32x4*)(mp + 4) = v1; }
                    else { u32x4 w; w.x = pk2(v0[0], v0[1]); w.y = pk2(v0[2], v0[3]); w.z = pk2(v1[0], v1[1]); w.w = pk2(v1[2], v1[3]); *(u32x4*)(MG + r * DM + c) = w; } } }
    }
};
struct EpiBranchM {
    static constexpr bool PERM = true, MIDHOOK = true;
    static constexpr int T1 = 4, T2 = 16;
    const bf16_t* P; bf16_t* MG;
    __device__ __forceinline__ void mid(Acc& acc, const Unit& u, int seg, int wr, int wc, int fr, int fq) const {
        const unsigned off0 = ((unsigned)(u.pm * BM + wr * 64 + fr) * (unsigned)PLD + (unsigned)(C_G + seg * 1024 + u.pn * BM + wc * 32 + 8 * fq)) * 2u;
        const char* Pb = (const char*)P;
#pragma unroll
        for (int ai = 0; ai < 2; ++ai)
#pragma unroll
            for (int m = 0; m < 4; ++m) {
#pragma unroll
                for (int bj = 0; bj < 2; ++bj) { const unsigned off = off0 + (unsigned)(((ai * HALF + m * 16) * PLD + bj * HALF) * 2);
                    const u32x4 gp = *(const u32x4*)(Pb + off), gn = *(const u32x4*)(Pb + off + 2048u);
#pragma unroll
                    for (int q = 0; q < 4; ++q) { const float r0 = bflo(gp[q]) * __builtin_amdgcn_rcpf(fmaxf(bflo(gn[q]), 1e-30f)), r1 = bfhi(gp[q]) * __builtin_amdgcn_rcpf(fmaxf(bfhi(gn[q]), 1e-30f));
                        acc[ai][bj][m][q >> 1][2 * (q & 1)] *= r0; acc[ai][bj][m][q >> 1][2 * (q & 1) + 1] *= r1; }
                    asm volatile("" : "+v"(acc[ai][bj][m][0]), "+v"(acc[ai][bj][m][1]) :: "memory"); } }
    }
    __device__ __forceinline__ void operator()(const Acc& acc, const Unit& u, int wr, int wc, int fr, int fq) const {
        const int row0 = u.pm * BM + wr * 64 + fr, col0 = u.pn * BM + wc * 32 + 8 * fq;
#pragma unroll
        for (int ai = 0; ai < 2; ++ai)
#pragma unroll
            for (int m = 0; m < 4; ++m) { const size_t r = (size_t)(row0 + ai * HALF + m * 16);
                asm volatile("" ::: "memory");
#pragma unroll
                for (int bj = 0; bj < 2; ++bj) { const int c = col0 + bj * HALF;
                    const u32x4 g = *(const u32x4*)(P + r * PLD + C_G + 2 * 1024 + c);
                    f32x4 v0 = acc[ai][bj][m][0], v1 = acc[ai][bj][m][1];
                    v0[0] *= bflo(g.x); v0[1] *= bfhi(g.x); v0[2] *= bflo(g.y); v0[3] *= bfhi(g.y);
                    v1[0] *= bflo(g.z); v1[1] *= bfhi(g.z); v1[2] *= bflo(g.w); v1[3] *= bfhi(g.w);
                    u32x4 w; w.x = pk2(v0[0], v0[1]); w.y = pk2(v0[2], v0[3]); w.z = pk2(v1[0], v1[1]); w.w = pk2(v1[2], v1[3]); *(u32x4*)(MG + r * DM + c) = w; } }
    }
};
struct EpiOut {
    static constexpr bool PERM = false, MIDHOOK = false;
    const float* xsrc; float* X; const float* gt;
    __device__ __forceinline__ void operator()(const Acc& acc, const Unit& u, int wr, int wc, int fr, int fq) const {
        const int row0 = u.pm * BM + wr * 64 + fr, col0 = u.pn * BM + wc * 32 + 4 * fq;
        const float* gp = gt + (size_t)((u.pm * BM) >> 11) * 6144 + col0;
        f32x4 gv[2][2];
#pragma unroll
        for (int bj = 0; bj < 2; ++bj)
#pragma unroll
            for (int n = 0; n < 2; ++n) gv[bj][n] = *(const f32x4*)(gp + bj * HALF + n * 16);
#pragma unroll
        for (int ai = 0; ai < 2; ++ai)
#pragma unroll
            for (int m = 0; m < 4; ++m) { const size_t o = (size_t)(row0 + ai * HALF + m * 16) * DM + col0;
#pragma unroll
                for (int bj = 0; bj < 2; ++bj)
#pragma unroll
                    for (int n = 0; n < 2; ++n) { const f32x4 xv = *(const f32x4*)(xsrc + o + bj * HALF + n * 16);
                        *(f32x4*)(X + o + bj * HALF + n * 16) = xv + gv[bj][n] * acc[ai][bj][m][n]; } }
    }
};
struct EpiMoe1 {
    static constexpr bool PERM = true, MIDHOOK = false;
    bf16_t* ACT; const float* b1;
    __device__ __forceinline__ void operator()(const Acc& acc, const Unit& u, int wr, int wc, int fr, int fq) const {
        const int row0 = u.pm * BM + wr * 64 + fr, col0 = u.pn * BM + wc * 32 + 8 * fq;
        const float* bp = b1 + (size_t)u.e * (2 * FF) + col0;
        f32x4 bv[2][2];
#pragma unroll
        for (int bj = 0; bj < 2; ++bj)
#pragma unroll
            for (int n = 0; n < 2; ++n) bv[bj][n] = *(const f32x4*)(bp + bj * HALF + 4 * n);
#pragma unroll
        for (int ai = 0; ai < 2; ++ai)
#pragma unroll
            for (int m = 0; m < 4; ++m) { bf16_t* rowp = ACT + (size_t)(row0 + ai * HALF + m * 16) * FF + (col0 >> 1);
#pragma unroll
                for (int bj = 0; bj < 2; ++bj) { const f32x4 v0 = acc[ai][bj][m][0] + bv[bj][0], v1 = acc[ai][bj][m][1] + bv[bj][1];
                    float a[4];
#pragma unroll
                    for (int q = 0; q < 4; ++q) { const float gl = (q < 2) ? v0[2 * q] : v1[2 * q - 4], ln = (q < 2) ? v0[2 * q + 1] : v1[2 * q - 3];
                        const float xg = fminf(gl, 7.0f), xl = fminf(fmaxf(ln, -7.0f), 7.0f);
                        a[q] = xg * sigmoidf_(1.702f * xg) * (xl + 1.0f); }
                    const unsigned long long w = (unsigned long long)pk2(a[0], a[1]) | ((unsigned long long)pk2(a[2], a[3]) << 32);
                    __hip_atomic_store((unsigned long long*)(rowp + bj * (HALF / 2)), w, __ATOMIC_RELAXED, __HIP_MEMORY_SCOPE_AGENT); } }
    }
};
struct EpiMoe2 {
    static constexpr bool PERM = true, MIDHOOK = false;
    bf16_t* Y; const float* b2;
    __device__ __forceinline__ void operator()(const Acc& acc, const Unit& u, int wr, int wc, int fr, int fq) const {
        const int row0 = u.pm * BM + wr * 64 + fr, col0 = u.pn * BM + wc * 32 + 8 * fq;
        const float* bp = b2 + (size_t)u.e * DM + col0;
        f32x4 bv[2][2];
#pragma unroll
        for (int bj = 0; bj < 2; ++bj)
#pragma unroll
            for (int n = 0; n < 2; ++n) bv[bj][n] = *(const f32x4*)(bp + bj * HALF + 4 * n);
#pragma unroll
        for (int ai = 0; ai < 2; ++ai)
#pragma unroll
            for (int m = 0; m < 4; ++m) { bf16_t* rowp = Y + (size_t)(row0 + ai * HALF + m * 16) * DM + col0;
#pragma unroll
                for (int bj = 0; bj < 2; ++bj) { const f32x4 v0 = acc[ai][bj][m][0] + bv[bj][0], v1 = acc[ai][bj][m][1] + bv[bj][1];
                    u32x4 w; w.x = pk2(v0[0], v0[1]); w.y = pk2(v0[2], v0[3]); w.z = pk2(v1[0], v1[1]); w.w = pk2(v1[2], v1[3]);
                    *(u32x4*)(rowp + bj * HALF) = w; } }
    }
};
}

struct Args { const float* in[32]; float* out; unsigned char* ws; int ph_lo, ph_hi; };
enum { I_X = 0, I_C, I_WMOD, I_BMOD, I_N1G, I_N2G, I_WIN, I_MU, I_W0, I_WUP, I_A0, I_AUP, I_GUP, I_KK, I_KA, I_RK, I_LNG, I_LNB, I_DLAM, I_SUBG, I_RELB, I_WBA, I_WBB, I_WBC, I_WOUT, I_RW, I_RB, I_W1, I_B1, I_W2, I_B2, I_FNG };

__device__ __forceinline__ void lds_fence() { asm volatile("s_waitcnt lgkmcnt(0)" ::: "memory"); }

__device__ __forceinline__ void tr_item(const float* W, int ldw, int ncols, bf16_t* WT, int K, LAS float* scr, int item, int lane) {
    const int nblk = ncols >> 5, kb = item / nblk, nb = item - kb * nblk, k0 = 64 * kb, n0 = 32 * nb;
#pragma unroll 8
    for (int i = 0; i < 32; ++i) { const int kk = 2 * i + (lane >> 5); scr[kk * 33 + (lane & 31)] = W[(size_t)(k0 + kk) * ldw + n0 + (lane & 31)]; }
    lds_fence();
    const int c = lane & 7;
#pragma unroll
    for (int j = 0; j < 4; ++j) { const int n = (lane >> 3) + 8 * j; const LAS float* s = scr + (8 * c) * 33 + n;
        u32x4 o; o.x = pk2(s[0 * 33], s[1 * 33]); o.y = pk2(s[2 * 33], s[3 * 33]); o.z = pk2(s[4 * 33], s[5 * 33]); o.w = pk2(s[6 * 33], s[7 * 33]);
        *(u32x4*)(WT + (size_t)(n0 + n) * K + k0 + 8 * c) = o; }
    lds_fence();
}
__device__ __forceinline__ int t5_bucket(int rel) {
    const int ret = rel > 0 ? 16 : 0; const int n = rel < 0 ? -rel : rel;
    int v;
    if (n < 8) v = n; else if (n < 12) v = 8; else if (n < 16) v = 9; else if (n < 23) v = 10; else if (n < 32) v = 11;
    else if (n < 46) v = 12; else if (n < 64) v = 13; else if (n < 91) v = 14; else v = 15;
    return ret + v;
}
__device__ __forceinline__ void phase_p0(const Args& a, LAS unsigned char* lds) {
    const int tid = otid(), lane = tid & 63, wave = tid >> 6, G = gridDim.x;
    unsigned char* ws = a.ws;
    {
        LAS float* scr = (LAS float*)(lds + wave * 8448);
        const int gw = blockIdx.x * 8 + wave, NGW = G * 8;
        constexpr int NITEMS = 65536 + 32768 + 2 * 6592;
        for (int it = gw; it < NITEMS; it += NGW) {
            int r = it;
            if (r < 65536) { const int mat = r >> 10; tr_item(a.in[I_W1] + (size_t)mat * DM * 2 * FF, 2 * FF, 2 * FF, (bf16_t*)(ws + WS_W1) + (size_t)mat * 2 * FF * DM, DM, scr, r & 1023, lane); continue; }
            r -= 65536;
            if (r < 32768) { const int mat = r >> 9; tr_item(a.in[I_W2] + (size_t)mat * FF * DM, DM, DM, (bf16_t*)(ws + WS_W2) + (size_t)mat * DM * FF, FF, scr, r & 511, lane); continue; }
            r -= 32768;
            const int l = r / 6592; r -= l * 6592;
            if (r < 2496) { tr_item(a.in[I_WIN] + (size_t)l * DM * IN_COLS, IN_COLS, 4992, (bf16_t*)(ws + WS_WIN) + (size_t)l * PLD * DM, DM, scr, r, lane); continue; }
            r -= 2496;
            if (r < 2688) { tr_item(a.in[I_WIN] + (size_t)l * DM * IN_COLS + 4992, IN_COLS, 5376, (bf16_t*)(ws + WS_WIN) + (size_t)l * PLD * DM + (size_t)5120 * DM, DM, scr, r, lane); continue; }
            r -= 2688;
            if (r < 128) { tr_item(a.in[I_WBA] + (size_t)l * 256 * DM, DM, DM, (bf16_t*)(ws + WS_WA) + (size_t)l * DM * 1792, 1792, scr, r, lane); continue; }
            r -= 128;
            if (r < 384) { tr_item(a.in[I_WBB] + (size_t)l * 768 * DM, DM, DM, (bf16_t*)(ws + WS_WA) + (size_t)l * DM * 1792 + 256, 1792, scr, r, lane); continue; }
            r -= 384;
            if (r < 384) { tr_item(a.in[I_WBC] + (size_t)l * 768 * DM, DM, DM, (bf16_t*)(ws + WS_WA) + (size_t)l * DM * 1792 + 1024, 1792, scr, r, lane); continue; }
            r -= 384;
            tr_item(a.in[I_WOUT] + (size_t)l * DM * DM, DM, DM, (bf16_t*)(ws + WS_WO) + (size_t)l * DM * DM, DM, scr, r, lane);
        }
        for (int i = blockIdx.x * 512 + tid; i < 2 * 128 * DM / 8; i += G * 512) {
            const int l = i / (128 * DM / 8), o = i - l * (128 * DM / 8);
            *(u32x4*)((bf16_t*)(ws + WS_WIN) + (size_t)l * PLD * DM + (size_t)4992 * DM + (size_t)o * 8) = (u32x4){0u, 0u, 0u, 0u};
        }
    }
    {
        bf16_t* WT = (bf16_t*)(ws + WS_MISC + MISC_WUPT); bf16_t* AT = (bf16_t*)(ws + WS_MISC + MISC_AUPT);
        for (int i = blockIdx.x * 512 + tid; i < 2 * 2 * 12 * 4096; i += G * 512) {
            const int j = i & 63, k = (i >> 6) & 63, hd = (i >> 12) % 12, ld = i / (12 * 4096);
            const size_t src = ((size_t)ld * 64 + j) * RW + hd * 64 + k;
            WT[i] = (bf16_t)(pk2(a.in[I_WUP][src], 0.f) & 0xffffu); AT[i] = (bf16_t)(pk2(a.in[I_AUP][src], 0.f) & 0xffffu);
        }
    }
    {
        bf16_t* GT = (bf16_t*)(ws + WS_MISC + MISC_GUPT);
        for (int i = blockIdx.x * 512 + tid; i < 2 * 768 * 256; i += G * 512) {
            const int k = i & 255, n = (i >> 8) % 768, l2 = i / (768 * 256);
            GT[i] = k < 128 ? f2bf(a.in[I_GUP][((size_t)l2 * 128 + k) * RW + n]) : (bf16_t)0;
        }
    }
    __syncthreads();
    if ((int)blockIdx.x < 192) {
        LAS float* sc = (LAS float*)(lds + 69632);
        LAS float* red = (LAS float*)(lds + 102400);
        for (int i = tid; i < NB * DM; i += 512) { const float v = a.in[I_C][i]; sc[i] = v / (1.f + expf(-v)); }
        __syncthreads();
        float* mod = (float*)(ws + WS_MISC + MISC_MOD);
        for (int j = blockIdx.x; j < 192; j += G) {
            const int l = j / 96, n0 = (j - l * 96) * 64, jj = tid & 63, ks = tid >> 6;
            float acc[8];
#pragma unroll
            for (int b = 0; b < 8; ++b) acc[b] = 0.f;
            const float* wp = a.in[I_WMOD] + ((size_t)l * DM + ks * 128) * 6144 + n0 + jj;
            for (int k = 0; k < 128; ++k) { const float w = wp[(size_t)k * 6144];
#pragma unroll
                for (int b = 0; b < 8; ++b) acc[b] += sc[b * DM + ks * 128 + k] * w; }
#pragma unroll
            for (int b = 0; b < 8; ++b) red[(ks * 8 + b) * 64 + jj] = acc[b];
            __syncthreads();
            { const int b = tid >> 6; float s = 0.f;
#pragma unroll
              for (int k2 = 0; k2 < 8; ++k2) s += red[(k2 * 8 + b) * 64 + jj];
              mod[((size_t)l * 8 + b) * 6144 + n0 + jj] = s + a.in[I_BMOD][(size_t)l * 6144 + n0 + jj]; }
            __syncthreads();
        }
    }
    if ((int)blockIdx.x == G - 1) {
        float* lam = (float*)(ws + WS_MISC + MISC_LAM);
        if (tid < 2) { const int l = tid; const float* dl = a.in[I_DLAM] + (size_t)l * 256; float s01 = 0.f, s23 = 0.f;
            for (int d = 0; d < 64; ++d) { s01 += dl[d] * dl[64 + d]; s23 += dl[128 + d] * dl[192 + d]; }
            const float li = 0.8f - 0.6f * expf(-0.3f * (float)l);
            lam[l] = expf(s01) - expf(s23) + li; lam[2 + l] = li; }
        float* bA = (float*)(ws + WS_MISC + MISC_BIASA);
        for (int i = tid; i < 12 * 129; i += 512) { const int head = i / 129, jj = i - head * 129, g = head >> 2; const int dil = (g == 0) ? 1 : (g == 1) ? 4 : 16;
            bA[i] = a.in[I_RELB][t5_bucket((jj - 64) * dil) * 18 + head] * LOG2E; }
        float* bC = (float*)(ws + WS_MISC + MISC_BIASC);
        for (int i = tid; i < 6 * 257; i += 512) { const int h = i / 257, rel = i - h * 257 - 128;
            bC[i] = a.in[I_RELB][t5_bucket(rel) * 18 + 12 + h] * LOG2E; }
    }
}

__device__ __forceinline__ float row_rstd(const f32x4 (&v)[4], float eps) {
    float s = 0.f;
#pragma unroll
    for (int j = 0; j < 4; ++j) s += (v[j].x * v[j].x + v[j].y * v[j].y) + (v[j].z * v[j].z + v[j].w * v[j].w);
    return rsqrtf(wave_sum(s) * (1.f / DM) + eps);
}
__device__ __forceinline__ void norm_mod_store(const f32x4 (&v)[4], float rstd, const float* g, const float* sc, const float* sh, bf16_t* orow, int lane) {
#pragma unroll
    for (int j = 0; j < 4; ++j) { const int c = 4 * lane + 256 * j;
        const f32x4 gv = *(const f32x4*)(g + c), scv = *(const f32x4*)(sc + c), shv = *(const f32x4*)(sh + c);
        const f32x4 y = v[j] * rstd * gv * (scv + 1.0f) + shv;
        u32x2 w; w.x = pk2(y.x, y.y); w.y = pk2(y.z, y.w);
        *(u32x2*)(orow + c) = w; }
}
__device__ __forceinline__ void phase_norm1(const Args& a, int l) {
    const int tid = otid(), lane = tid & 63, wave = tid >> 6;
    const float* mod = (const float*)(a.ws + WS_MISC + MISC_MOD) + (size_t)l * 8 * 6144;
    bf16_t* H = (bf16_t*)(a.ws + WS_H);
    for (int t = blockIdx.x * 8 + wave; t < NTOK; t += gridDim.x * 8) {
        const float* xr = a.in[I_X] + (size_t)t * DM; f32x4 v[4];
#pragma unroll
        for (int j = 0; j < 4; ++j) v[j] = *(const f32x4*)(xr + 4 * lane + 256 * j);
        const float rstd = row_rstd(v, 1e-6f);
        const float* mb = mod + (size_t)(t >> 11) * 6144;
        norm_mod_store(v, rstd, a.in[I_N1G] + (size_t)l * DM, mb + 1024, mb, H + (size_t)t * DM, lane);
    }
}

__device__ __forceinline__ void swa_wave_unit(const bf16_t* P, float* OAG, float* LSE, const LAS float* biasA, LAS unsigned char* vbuf, int u, int lane) {
    const int b = u / 768; const int rem = u - b * 768; const int head = rem >> 6, s = rem & 63;
    const int g = head >> 2, hh = head & 3;
    const int dsh = (g == 0) ? 0 : (g == 1) ? 2 : 4;
    const int L = NT >> dsh, nmbsh = 6 - dsh;
    const int r = s >> nmbsh, mb = s & ((1 << nmbsh) - 1);
    const int r32 = lane & 31, hi = lane >> 5;
    const size_t tq = (size_t)b * NT + ((mb * 32 + r32) << dsh) + r;
    bf16x8 qf[4];
    { const bf16_t* qp = P + tq * PLD + C_AQ + head * 64 + 8 * hi;
#pragma unroll
      for (int s4 = 0; s4 < 4; ++s4) qf[s4] = *(const bf16x8*)(qp + 16 * s4); }
    f32x16 o[2]; o[0] = (f32x16){}; o[1] = (f32x16){};
    float m = -1e30f, lsum = 0.f;
    const float SC = 0.125f * LOG2E;
    const LAS float* bh = biasA + head * 129 + 64;
    const int trbase = (4 * hi + ((lane & 15) >> 2)) * 144 + (16 * ((lane >> 4) & 1) + 4 * (lane & 3)) * 2;
    const int kt_lo = (-mb > -2) ? -mb : -2, kt_hi = ((L >> 5) - 1 - mb < 2) ? (L >> 5) - 1 - mb : 2;
    bf16x8 kfn[4]; u32x4 vn[4];
#define SWA_LOAD(ktx) do { const int _m0 = mb * 32 + (ktx) * 32; \
        { int km = _m0 + r32; km = km < 0 ? 0 : (km > L - 1 ? L - 1 : km); \
          const bf16_t* kp = P + ((size_t)b * NT + (km << dsh) + r) * PLD + C_AK + head * 64 + 8 * hi; \
          _Pragma("unroll") for (int s4 = 0; s4 < 4; ++s4) kfn[s4] = *(const bf16x8*)(kp + 16 * s4); } \
        _Pragma("unroll") for (int c4 = 0; c4 < 4; ++c4) { const int id = lane + 64 * c4, row = id >> 3, ch = id & 7; \
            int vm = _m0 + row; vm = vm < 0 ? 0 : (vm > L - 1 ? L - 1 : vm); \
            vn[c4] = *(const u32x4*)(P + ((size_t)b * NT + (vm << dsh) + r) * PLD + C_AV + head * 64 + ch * 8); } } while (0)
    SWA_LOAD(kt_lo);
    for (int kt = kt_lo; kt <= kt_hi; ++kt) {
        const int m0 = mb * 32 + kt * 32;
        bf16x8 kf[4];
#pragma unroll
        for (int s4 = 0; s4 < 4; ++s4) kf[s4] = kfn[s4];
        asm volatile("" ::: "memory");
#pragma unroll
        for (int c4 = 0; c4 < 4; ++c4) { const int id = lane + 64 * c4, row = id >> 3, ch = id & 7; *(LAS u32x4*)(vbuf + row * 144 + ch * 16) = vn[c4]; }
        if (kt < kt_hi) SWA_LOAD(kt + 1);
        f32x16 sacc = (f32x16){};
#pragma unroll
        for (int s4 = 0; s4 < 4; ++s4) sacc = __builtin_amdgcn_mfma_f32_32x32x16_bf16(kf[s4], qf[s4], sacc, 0, 0, 0);
        float x[16]; float mx = -1e30f;
#pragma unroll
        for (int rg = 0; rg < 16; ++rg) { const int kvl = crow(rg, hi), km = m0 + kvl, j = kt * 32 + kvl - r32;
            const bool valid = (km >= 0) && (km < L) && (j >= -64) && (j <= 64);
            const int jc = j < -64 ? -64 : (j > 64 ? 64 : j);
            const float xv = sacc[rg] * SC + bh[jc];
            x[rg] = valid ? xv : -1e30f; mx = fmaxf(mx, x[rg]); }
        mx = fmaxf(mx, __shfl_xor(mx, 32));
        const float mn = fmaxf(m, mx), alpha = __builtin_amdgcn_exp2f(m - mn); m = mn;
        float ps = 0.f;
#pragma unroll
        for (int rg = 0; rg < 16; ++rg) { x[rg] = __builtin_amdgcn_exp2f(x[rg] - mn); ps += x[rg]; }
        lsum = lsum * alpha + ps;
#pragma unroll
        for (int rg = 0; rg < 16; ++rg) { o[0][rg] *= alpha; o[1][rg] *= alpha; }
        u32x4 pw[2];
#pragma unroll
        for (int s2 = 0; s2 < 2; ++s2) { pw[s2].x = pk2(x[8 * s2 + 0], x[8 * s2 + 1]); pw[s2].y = pk2(x[8 * s2 + 2], x[8 * s2 + 3]); pw[s2].z = pk2(x[8 * s2 + 4], x[8 * s2 + 5]); pw[s2].w = pk2(x[8 * s2 + 6], x[8 * s2 + 7]); }
        lds_fence();
#pragma unroll
        for (int db = 0; db < 2; ++db)
#pragma unroll
            for (int s2 = 0; s2 < 2; ++s2) {
                const s16x4 lo = vtr(vbuf + trbase + (16 * s2) * 144 + db * 64);
                const s16x4 hi4 = vtr(vbuf + trbase + (16 * s2 + 8) * 144 + db * 64);
                const bf16x8 af = (bf16x8){lo[0], lo[1], lo[2], lo[3], hi4[0], hi4[1], hi4[2], hi4[3]};
                o[db] = __builtin_amdgcn_mfma_f32_32x32x16_bf16(af, __builtin_bit_cast(bf16x8, pw[s2]), o[db], 0, 0, 0);
            }
        asm volatile("" ::: "memory");
    }
#undef SWA_LOAD
    const float lt = lsum + __shfl_xor(lsum, 32);
    const float inv = 1.f / lt;
    bf16_t* op = (bf16_t*)OAG + ((size_t)g * NTOK + tq) * 256 + hh * 64;
#pragma unroll
    for (int db = 0; db < 2; ++db)
#pragma unroll
        for (int i = 0; i < 4; ++i) { u32x2 w; w.x = pk2(o[db][4 * i] * inv, o[db][4 * i + 1] * inv); w.y = pk2(o[db][4 * i + 2] * inv, o[db][4 * i + 3] * inv);
            *(u32x2*)(op + db * 32 + 8 * i + 4 * hi) = w; }
    if (hi == 0) LSE[((size_t)g * NTOK + tq) * 4 + hh] = m + __log2f(lt);
}
__device__ __forceinline__ void phase_swa(const Args& a, LAS unsigned char* lds) {
    const int tid = otid(), lane = tid & 63, wave = tid >> 6;
    LAS float* bA = (LAS float*)(lds + 40960);
    const float* bAg = (const float*)(a.ws + WS_MISC + MISC_BIASA);
    for (int i = tid; i < 12 * 129; i += 512) bA[i] = bAg[i];
    __syncthreads();
    for (int item = blockIdx.x; item < 768; item += gridDim.x)
        swa_wave_unit((const bf16_t*)(a.ws + WS_PROJ), (float*)(a.ws + WS_OAG), (float*)(a.ws + WS_LSE), bA, lds + wave * 4608, item * 8 + wave, lane);
    __syncthreads();
}

constexpr int RLD = 144, RMAT = 64 * RLD;
constexpr int R_P = 0, R_Q = 4 * RMAT, R_M = R_Q + 2 * 17408;
constexpr int R_WD = R_P, R_AD = R_P + RMAT, R_WUP = R_P + 2 * RMAT, R_AUP = R_P + 3 * RMAT;
constexpr int R_LK = R_P, R_RK = R_P + RMAT, R_RB = R_P + 2 * RMAT, R_TT = R_P + 3 * RMAT;
constexpr int R_ZW = R_Q, R_ZA = R_Q + 17408, R_LBF = R_Q, R_SEG = R_ZA, R_GC = R_ZA + 2048, R_W1T = R_ZA + 4096;
constexpr int R_A = R_M, R_B = R_M + 2 * RMAT, R_BP = R_M + 3 * RMAT, R_K = R_M + 4 * RMAT, R_KP = R_M + 5 * RMAT, R_RHO = R_M + 6 * RMAT, R_V = R_M + 7 * RMAT;
constexpr int R_UT = R_B, R_TAT = R_K;
constexpr int R_TMP0 = R_SEG, R_TMP1 = R_ZA + 13312, R_TMP2 = R_ZA + 13312 + 2048;
constexpr int R_PAR = R_M + 8 * RMAT, NPAR = 960;
static_assert(R_PAR + 2 * NPAR * 4 <= LDS_STAGE, "R1 LDS");

template <bool XT, bool YT>
__device__ __forceinline__ f32x16 tile64x(const LAS unsigned char* XM, int x0, const LAS unsigned char* YM, int y0, int lane, f32x16 acc) {
    const int r32 = lane & 31, hi = lane >> 5;
    const int trofs = ((lane & 15) >> 2) * RLD + (16 * ((lane >> 4) & 1) + 4 * (lane & 3)) * 2;
#pragma unroll
    for (int s4 = 0; s4 < 4; ++s4) {
        bf16x8 xa, yb;
        if (!XT) xa = *(const LAS bf16x8*)(XM + (x0 + r32) * RLD + 32 * s4 + 16 * hi);
        else { const s16x4 lo = vtr(XM + (16 * s4 + 8 * hi) * RLD + trofs + 2 * x0), h4 = vtr(XM + (16 * s4 + 8 * hi + 4) * RLD + trofs + 2 * x0);
               xa = (bf16x8){lo[0], lo[1], lo[2], lo[3], h4[0], h4[1], h4[2], h4[3]}; }
        if (!YT) yb = *(const LAS bf16x8*)(YM + (y0 + r32) * RLD + 32 * s4 + 16 * hi);
        else { const s16x4 lo = vtr(YM + (16 * s4 + 8 * hi) * RLD + trofs + 2 * y0), h4 = vtr(YM + (16 * s4 + 8 * hi + 4) * RLD + trofs + 2 * y0);
               yb = (bf16x8){lo[0], lo[1], lo[2], lo[3], h4[0], h4[1], h4[2], h4[3]}; }
        acc = __builtin_amdgcn_mfma_f32_32x32x16_bf16(xa, yb, acc, 0, 0, 0);
    }
    return acc;
}
template <class MP>
__device__ __forceinline__ void shift8r(const u32x4 c, u32x4 m, u32x4 n, bool hm, bool hn, MP mu0, MP mu1, float (&o)[8]) {
    const unsigned mm = hm ? 0xffffffffu : 0u, nm = hn ? 0xffffffffu : 0u;
    m = m & mm; n = n & nm;
#pragma unroll
    for (int q = 0; q < 4; ++q) {
        const float pl = bflo(c[q]), ph = bfhi(c[q]);
        o[2 * q] = pl + mu0[2 * q] * (bflo(m[q]) - pl) + mu1[2 * q] * (bflo(n[q]) - pl);
        o[2 * q + 1] = ph + mu0[2 * q + 1] * (bfhi(m[q]) - ph) + mu1[2 * q + 1] * (bfhi(n[q]) - ph);
    }
}
__device__ __forceinline__ float r1_param(const Args& a, int l, int h, int dir, int idx) {
    const int j = idx & 63, row = idx >> 6;
    if (row < 10) { const int g = row >> 1, which = row & 1; const int col = (g < 3 ? g * 768 + h * 64 : (g == 3 ? 2304 : 2432) + dir * 64) + j;
        return a.in[I_MU][(size_t)l * 2 * RSTR + (size_t)which * RSTR + col]; }
    const int cb = (l * 2 + dir) * RW + h * 64 + j;
    if (row == 10) return a.in[I_W0][cb];
    if (row == 11) return a.in[I_A0][cb];
    if (row == 12) return a.in[I_KK][cb];
    if (row == 13) return a.in[I_KA][cb];
    return a.in[I_RK][(size_t)l * RW + h * 64 + j];
}
__device__ __forceinline__ int r1_col(int g, int h, int dir, int seg) { return (g < 3 ? g * 768 + h * 64 : (g == 3 ? 2304 : 2432) + dir * 64) + 8 * seg; }
__device__ __forceinline__ void r1_issue(const bf16_t* P, int ct, int tid, u32x4 (&raw)[15]) {
    const int c = ct & 31, dir = (ct >> 5) & 1, bh = ct >> 6, h = bh % 12, b = bh / 12, ti = tid >> 3, seg = tid & 7;
    const int tseq = dir ? (NT - 1 - 64 * c - ti) : (64 * c + ti);
    const bf16_t* p0 = P + ((size_t)b * NT + tseq) * PLD + C_BS;
    const int dm = tseq > 0 ? PLD : 0, dn = tseq < NT - 1 ? PLD : 0;
#pragma unroll
    for (int g = 0; g < 5; ++g) { const int col = r1_col(g, h, dir, seg);
        raw[3 * g] = *(const u32x4*)(p0 + col); raw[3 * g + 1] = *(const u32x4*)(p0 + col - dm); raw[3 * g + 2] = *(const u32x4*)(p0 + col + dn); }
}

__device__ __forceinline__ void phase_rwkv_r1(const Args& a, int l, LAS unsigned char* lds) {
    const int tid0 = otid();
    unsigned char* ws = a.ws;
    const bf16_t* P = (const bf16_t*)(ws + WS_PROJ);
    const float* mu = a.in[I_MU] + (size_t)l * 2 * RSTR;
    const int G = gridDim.x;
    u32x4 raw[15], wup4, aup4;
    if ((int)blockIdx.x < 6144) { r1_issue(P, blockIdx.x, tid0, raw);
        { const int c0 = blockIdx.x; const size_t wofs = ((size_t)(l * 2 + ((c0 >> 5) & 1)) * 12 + ((c0 >> 6) % 12)) * 4096 + (size_t)(tid0 >> 3) * 64 + 8 * (tid0 & 7);
          wup4 = *(const u32x4*)((const bf16_t*)(ws + WS_MISC + MISC_WUPT) + wofs); aup4 = *(const u32x4*)((const bf16_t*)(ws + WS_MISC + MISC_AUPT) + wofs); }
        const int ct0 = blockIdx.x, bh0 = ct0 >> 6;
        LAS float* pt = (LAS float*)(lds + R_PAR);
        pt[tid0] = r1_param(a, l, bh0 % 12, (ct0 >> 5) & 1, tid0); if (tid0 + 512 < NPAR) pt[tid0 + 512] = r1_param(a, l, bh0 % 12, (ct0 >> 5) & 1, tid0 + 512); }
    __syncthreads();
    int itn = 0;
    f32x16 po0 = (f32x16){}, po1 = (f32x16){}; int ctp = -1;
#define R1_FLUSH(ctq, LANE, WAVE) do { const int _r32 = (LANE) & 31, _hi = (LANE) >> 5, _tt = (WAVE) & 3, _tm = _tt >> 1, _tn = _tt & 1; const size_t _cto = (size_t)(ctq) * 4096; \
        if ((WAVE) < 4) { bf16_t* QA = (bf16_t*)(ws + WS_QA) + _cto; float* MP = (float*)(ws + WS_MP) + _cto; \
            _Pragma("unroll") for (int q = 0; q < 4; ++q) { u32x2 w; w.x = pk2(po0[4 * q], po0[4 * q + 1]); w.y = pk2(po0[4 * q + 2], po0[4 * q + 3]); \
                *(u32x2*)(QA + ((_tn * 4 + 2 * _tm + (q >> 1)) * 64 + (q & 1) * 32 + _r32) * 8 + 4 * _hi) = w; \
                *(f32x4*)(MP + (32 * _tn + _r32) * 64 + 32 * _tm + 8 * q + 4 * _hi) = (f32x4){po1[4 * q], po1[4 * q + 1], po1[4 * q + 2], po1[4 * q + 3]}; } \
        } else { unsigned* Y0 = (unsigned*)(ws + WS_Y0) + (size_t)(ctq) * 2048 + _tt * 512 + (LANE); float* NP = (float*)(ws + WS_NP) + _cto; \
            _Pragma("unroll") for (int p = 0; p < 8; ++p) Y0[p * 64] = pk2(po0[2 * p], po0[2 * p + 1]); \
            _Pragma("unroll") for (int q = 0; q < 4; ++q) *(f32x4*)(NP + (32 * _tn + _r32) * 64 + 32 * _tm + 8 * q + 4 * _hi) = (f32x4){po1[4 * q], po1[4 * q + 1], po1[4 * q + 2], po1[4 * q + 3]}; } } while (0)
  for (int ct = blockIdx.x; ct < 6144; ct += G, ++itn) {
    int tid = tid0; asm volatile("" : "+v"(tid));
    const int lane = tid & 63, wave = __builtin_amdgcn_readfirstlane(tid >> 6), r32 = lane & 31, hi = lane >> 5;
    const int ti = tid >> 3, seg = tid & 7;
    const int c = ct & 31, dir = (ct >> 5) & 1, bh = ct >> 6, h = bh % 12, b = bh / 12;
    const int tseq = dir ? (NT - 1 - 64 * c - ti) : (64 * c + ti);
    const size_t trow = (size_t)b * NT + tseq;
    const bool hm = tseq > 0, hn = tseq < NT - 1;
    const LAS float* PT = (const LAS float*)(lds + R_PAR) + (itn & 1) * NPAR;
    float pnx0 = 0.f, pnx1 = 0.f;
    float r8[8], k8[8], v8[8];
    {
        shift8r(raw[0], raw[1], raw[2], hm, hn, PT + 0 * 64 + 8 * seg, PT + 1 * 64 + 8 * seg, r8);
        shift8r(raw[3], raw[4], raw[5], hm, hn, PT + 2 * 64 + 8 * seg, PT + 3 * 64 + 8 * seg, k8);
        shift8r(raw[6], raw[7], raw[8], hm, hn, PT + 4 * 64 + 8 * seg, PT + 5 * 64 + 8 * seg, v8);
        float t8[8];
        shift8r(raw[9], raw[10], raw[11], hm, hn, PT + 6 * 64 + 8 * seg, PT + 7 * 64 + 8 * seg, t8);
#pragma unroll
        for (int q = 0; q < 8; ++q) { const float e2 = __expf(2.f * t8[q]); t8[q] = 1.f - 2.f / (e2 + 1.f); }
        *(LAS u32x4*)(lds + R_WD + ti * RLD + 16 * seg) = pack8(t8);
        shift8r(raw[12], raw[13], raw[14], hm, hn, PT + 8 * 64 + 8 * seg, PT + 9 * 64 + 8 * seg, t8);
        *(LAS u32x4*)(lds + R_AD + ti * RLD + 16 * seg) = pack8(t8);
        if (h == 0 && dir == 0) {
            const bf16_t* p0 = P + trow * PLD + C_BS;
            bf16_t* GS = (bf16_t*)(ws + WS_GS) + trow * 256;
#pragma unroll
            for (int hf = 0; hf < 2; ++hf) { const int col = 2560 + 64 * hf + 8 * seg;
                shift8r(*(const u32x4*)(p0 + col), *(const u32x4*)(p0 + col - (hm ? PLD : 0)), *(const u32x4*)(p0 + col + (hn ? PLD : 0)), hm, hn, mu + col, mu + RSTR + col, t8);
#pragma unroll
                for (int q = 0; q < 8; ++q) t8[q] = sigmoidf_(t8[q]);
                *(u32x4*)(GS + 64 * hf + 8 * seg) = pack8(t8);
                *(u32x4*)(GS + 128 + 64 * hf + 8 * seg) = (u32x4){0u, 0u, 0u, 0u}; }
        }
        *(LAS u32x4*)(lds + R_WUP + ti * RLD + 16 * seg) = wup4;
        *(LAS u32x4*)(lds + R_AUP + ti * RLD + 16 * seg) = aup4;
        if (dir == 0) *(u32x4*)((bf16_t*)(ws + WS_RV) + trow * RW + h * 64 + 8 * seg) = pack8(v8);
    }
    if (ctp >= 0) R1_FLUSH(ctp, lane, wave);
    if (ct + G < 6144) { r1_issue(P, ct + G, tid, raw);
        const int ctn = ct + G, bhn = ctn >> 6;
        { const size_t wofs = ((size_t)(l * 2 + ((ctn >> 5) & 1)) * 12 + (bhn % 12)) * 4096 + (size_t)ti * 64 + 8 * seg;
          wup4 = *(const u32x4*)((const bf16_t*)(ws + WS_MISC + MISC_WUPT) + wofs); aup4 = *(const u32x4*)((const bf16_t*)(ws + WS_MISC + MISC_AUPT) + wofs); }
        pnx0 = r1_param(a, l, bhn % 12, (ctn >> 5) & 1, tid); if (tid + 512 < NPAR) pnx1 = r1_param(a, l, bhn % 12, (ctn >> 5) & 1, tid + 512); }
    __syncthreads();
    {
        const int p = wave >> 2, tt = wave & 3, tm = tt >> 1, tn = tt & 1;
        f32x16 acc = (f32x16){};
        acc = tile64x<false, false>(lds + (p ? R_AUP : R_WUP), 32 * tm, lds + (p ? R_AD : R_WD), 32 * tn, lane, acc);
        LAS float* Z = (LAS float*)(lds + (p ? R_ZA : R_ZW));
#pragma unroll
        for (int q = 0; q < 4; ++q) *(LAS f32x4*)(Z + (32 * tn + r32) * 68 + 32 * tm + 8 * q + 4 * hi) = (f32x4){acc[4 * q], acc[4 * q + 1], acc[4 * q + 2], acc[4 * q + 3]};
    }
    __syncthreads();
    float kka8[8], kk8[8], kd8[8];
    {
        const LAS float* w0 = PT + 10 * 64 + 8 * seg; const LAS float* a0 = PT + 11 * 64 + 8 * seg;
        const LAS float* kkp = PT + 12 * 64 + 8 * seg; const LAS float* kap = PT + 13 * 64 + 8 * seg;
        LAS float* Zw = (LAS float*)(lds + R_ZW) + ti * 68 + 8 * seg; const LAS float* Za = (const LAS float*)(lds + R_ZA) + ti * 68 + 8 * seg;
        float nrm = 0.f, av[8], e8[8];
#pragma unroll
        for (int q = 0; q < 8; ++q) {
            const float z = w0[q] + Zw[q];
            const float u = -z; const float sp = fmaxf(u, 0.f) + __logf(1.f + __expf(-fabsf(u)));
            e8[q] = __expf(-sp - 0.5f);
            av[q] = sigmoidf_(a0[q] + Za[q]);
            const float kr = k8[q] * kkp[q]; kk8[q] = kr; nrm += kr * kr;
            kd8[q] = k8[q] * (1.f + (av[q] - 1.f) * kap[q]);
        }
        nrm = dpp_sum8(nrm);
        const float rn = rsqrtf(fmaxf(nrm, 1e-24f));
#pragma unroll
        for (int q = 0; q < 8; ++q) { kk8[q] *= rn; kka8[q] = kk8[q] * av[q]; Zw[q] = e8[q]; }
        { const LAS float* rkp = PT + 14 * 64 + 8 * seg; float bs = 0.f;
#pragma unroll
          for (int q = 0; q < 8; ++q) bs += r8[q] * kd8[q] * rkp[q];
          bs = dpp_sum8(bs);
          if (seg == 0) ((float*)(ws + WS_RR))[((size_t)dir * NTOK + trow) * 12 + h] = bs; }
    }
    __syncthreads();
    {
        const int kc = tid & 63, sg = tid >> 6;
        LAS float* Zw = (LAS float*)(lds + R_ZW); LAS float* SEG = (LAS float*)(lds + R_SEG);
        float run = 0.f;
#pragma unroll
        for (int q = 0; q < 8; ++q) { run += Zw[(8 * sg + q) * 68 + kc]; Zw[(8 * sg + q) * 68 + kc] = run; }
        SEG[sg * 64 + kc] = run;
        __syncthreads();
        float off = 0.f;
        for (int s2 = 0; s2 < sg; ++s2) off += SEG[s2 * 64 + kc];
#pragma unroll
        for (int q = 0; q < 8; ++q) Zw[(8 * sg + q) * 68 + kc] += off;
    }
    __syncthreads();
    {
        const LAS float* Gp = (const LAS float*)(lds + R_ZW);
        float al[8], be[8], bp[8], ka[8], kp[8], rh[8];
#pragma unroll
        for (int q = 0; q < 8; ++q) {
            const float gi = Gp[ti * 68 + 8 * seg + q], gm = ti > 0 ? Gp[(ti - 1) * 68 + 8 * seg + q] : 0.f, g63 = Gp[63 * 68 + 8 * seg + q];
            const float ig = __expf(gi), tl = __expf(gi - g63);
            al[q] = __expf(-gm) * kk8[q]; be[q] = kka8[q] * ig; bp[q] = kka8[q] * tl; ka[q] = kd8[q] * ig; kp[q] = kd8[q] * tl; rh[q] = r8[q] * __expf(-gi);
            if (ti == 63) ((LAS float*)(lds + R_GC))[8 * seg + q] = __expf(-g63);
        }
        const int o = ti * RLD + 16 * seg;
        *(LAS u32x4*)(lds + R_A + o) = pack8(al); *(LAS u32x4*)(lds + R_B + o) = pack8(be); *(LAS u32x4*)(lds + R_K + o) = pack8(ka); *(LAS u32x4*)(lds + R_RHO + o) = pack8(rh);
        *(LAS u32x4*)(lds + R_BP + o) = pack8(bp); *(LAS u32x4*)(lds + R_KP + o) = pack8(kp); *(LAS u32x4*)(lds + R_V + o) = pack8(v8);
    }
    __syncthreads();
    {
        const int tt = wave & 3, tm = tt >> 1, tn = tt & 1;
        const int jb = 32 * tm, ib = 32 * tn, i = ib + r32;
        f32x16 acc0 = (f32x16){}, acc1 = (f32x16){};
        if (tm <= tn) {
            acc0 = tile64x<false, false>(lds + (wave < 4 ? R_B : R_K), jb, lds + (wave < 4 ? R_A : R_RHO), ib, lane, acc0);
            acc1 = tile64x<false, false>(lds + (wave < 4 ? R_K : R_B), jb, lds + (wave < 4 ? R_A : R_RHO), ib, lane, acc1);
        }
#pragma unroll
        for (int rg = 0; rg < 16; ++rg) { const int j = jb + crow(rg, hi); const bool keep = (wave < 4) ? (j < i) : (j <= i);
            acc0[rg] = keep ? acc0[rg] : 0.f; acc1[rg] = keep ? acc1[rg] : 0.f; }
#pragma unroll
        for (int q = 0; q < 4; ++q) { const int jo = jb + 8 * q + 4 * hi;
            u32x2 w1; w1.x = pk2(acc1[4 * q], acc1[4 * q + 1]); w1.y = pk2(acc1[4 * q + 2], acc1[4 * q + 3]);
            if (wave < 4) {
                *(LAS f32x4*)((LAS float*)(lds + R_LBF) + i * 68 + jo) = (f32x4){acc0[4 * q], acc0[4 * q + 1], acc0[4 * q + 2], acc0[4 * q + 3]};
                *(LAS u32x2*)(lds + R_LK + i * RLD + 2 * jo) = w1;
                if (wave == 1) { u32x2 wl; wl.x = pk2(acc0[4 * q], acc0[4 * q + 1]); wl.y = pk2(acc0[4 * q + 2], acc0[4 * q + 3]);
                    *(LAS u32x2*)(lds + R_TMP0 + r32 * 64 + 2 * (8 * q + 4 * hi)) = wl; }
            } else {
                u32x2 w0; w0.x = pk2(acc0[4 * q], acc0[4 * q + 1]); w0.y = pk2(acc0[4 * q + 2], acc0[4 * q + 3]);
                *(LAS u32x2*)(lds + R_RK + i * RLD + 2 * jo) = w0;
                *(LAS u32x2*)(lds + R_RB + i * RLD + 2 * jo) = w1;
            } }
    }
    __syncthreads();
    if (wave < 2) {
        const int blk = wave, col = r32;
        const LAS float* Lf = (const LAS float*)(lds + R_LBF) + (32 * blk) * 68 + 32 * blk;
        float Tm[32];
        f32x4 cur[8], nxt[8];
#pragma unroll
        for (int m4 = 0; m4 < 8; ++m4) { cur[m4] = (f32x4){0.f, 0.f, 0.f, 0.f}; nxt[m4] = (f32x4){0.f, 0.f, 0.f, 0.f}; }
        cur[0] = *(const LAS f32x4*)(Lf + 68);
        Tm[0] = (col == 0) ? 1.f : 0.f;
#pragma unroll
        for (int i = 1; i < 32; ++i) {
            if (i + 1 < 32) {
#pragma unroll
                for (int m4 = 0; m4 < (i + 4) / 4; ++m4) nxt[m4] = *(const LAS f32x4*)(Lf + (i + 1) * 68 + 4 * m4);
            }
            float c0 = (col == i) ? 1.f : 0.f, c1 = 0.f, c2 = 0.f, c3 = 0.f;
#pragma unroll
            for (int m4 = 0; m4 < (i + 3) / 4; ++m4) {
                if (4 * m4 + 0 < i) c0 -= cur[m4][0] * Tm[4 * m4 + 0];
                if (4 * m4 + 1 < i) c1 -= cur[m4][1] * Tm[4 * m4 + 1];
                if (4 * m4 + 2 < i) c2 -= cur[m4][2] * Tm[4 * m4 + 2];
                if (4 * m4 + 3 < i) c3 -= cur[m4][3] * Tm[4 * m4 + 3]; }
            Tm[i] = (c0 + c1) + (c2 + c3);
#pragma unroll
            for (int m4 = 0; m4 < 8; ++m4) cur[m4] = nxt[m4];
            asm volatile("" : "+v"(Tm[i]) :: "memory");
        }
        if (hi == 0) {
#pragma unroll
            for (int i = 0; i < 32; ++i) {
                *(LAS bf16_t*)(lds + R_TT + (32 * blk + i) * RLD + 2 * (32 * blk + col)) = f2bf(Tm[i]);
                if (blk == 0) *(LAS bf16_t*)(lds + R_TT + i * RLD + 2 * (32 + col)) = (bf16_t)0;
            }
            if (blk == 0) {
#pragma unroll
                for (int q = 0; q < 4; ++q) { float x8[8];
#pragma unroll
                    for (int e = 0; e < 8; ++e) x8[e] = Tm[8 * q + e];
                    *(LAS u32x4*)(lds + R_TMP1 + col * 64 + 16 * q) = pack8(x8); } }
        }
    } else if (wave >= 4) {
        const int tt = wave & 3, tm = tt >> 1, tn = tt & 1;
        f32x16 acc = (f32x16){};
        acc = tile64x<false, true>(lds + R_LK, 32 * tm, lds + R_V, 32 * tn, lane, acc);
#pragma unroll
        for (int q = 0; q < 4; ++q) { u32x2 w; w.x = pk2(acc[4 * q], acc[4 * q + 1]); w.y = pk2(acc[4 * q + 2], acc[4 * q + 3]);
            *(LAS u32x2*)(lds + R_W1T + (32 * tn + r32) * RLD + 2 * (32 * tm + 8 * q + 4 * hi)) = w; }
    }
    __syncthreads();
    if (wave == 0) {
        f32x16 x1 = (f32x16){};
#pragma unroll
        for (int s2 = 0; s2 < 2; ++s2) x1 = __builtin_amdgcn_mfma_f32_32x32x16_bf16(*(const LAS bf16x8*)(lds + R_TMP0 + r32 * 64 + 32 * s2 + 16 * hi), *(const LAS bf16x8*)(lds + R_TMP1 + r32 * 64 + 32 * s2 + 16 * hi), x1, 0, 0, 0);
#pragma unroll
        for (int q = 0; q < 4; ++q) { u32x2 w; w.x = pk2(x1[4 * q], x1[4 * q + 1]); w.y = pk2(x1[4 * q + 2], x1[4 * q + 3]);
            *(LAS u32x2*)(lds + R_TMP2 + r32 * 64 + 2 * (8 * q + 4 * hi)) = w; }
        lds_fence();
        f32x16 t21 = (f32x16){};
#pragma unroll
        for (int s2 = 0; s2 < 2; ++s2) t21 = __builtin_amdgcn_mfma_f32_32x32x16_bf16(*(const LAS bf16x8*)(lds + R_TT + (32 + r32) * RLD + 64 + 32 * s2 + 16 * hi), *(const LAS bf16x8*)(lds + R_TMP2 + r32 * 64 + 32 * s2 + 16 * hi), t21, 0, 0, 0);
#pragma unroll
        for (int rg = 0; rg < 16; ++rg) *(LAS bf16_t*)(lds + R_TT + (32 + crow(rg, hi)) * RLD + 2 * r32) = f2bf(-t21[rg]);
    }
    __syncthreads();
    {
        const int tt = wave & 3, tm = tt >> 1, tn = tt & 1;
        f32x16 acc = (f32x16){};
        if (wave < 4) acc = tile64x<false, false>(lds + R_TT, 32 * tm, lds + R_W1T, 32 * tn, lane, acc);
        else          acc = tile64x<false, true>(lds + R_TT, 32 * tm, lds + R_A, 32 * tn, lane, acc);
        LAS unsigned char* dst = lds + (wave < 4 ? R_UT : R_TAT);
#pragma unroll
        for (int q = 0; q < 4; ++q) { u32x2 w; w.x = pk2(acc[4 * q], acc[4 * q + 1]); w.y = pk2(acc[4 * q + 2], acc[4 * q + 3]);
            *(LAS u32x2*)(dst + (32 * tn + r32) * RLD + 2 * (32 * tm + 8 * q + 4 * hi)) = w; }
    }
    __syncthreads();
    {
        const int tt = wave & 3, tm = tt >> 1, tn = tt & 1;
        if (wave < 4) {
            f32x16 acc = (f32x16){};
            acc = tile64x<false, false>(lds + R_TAT, 32 * tm, lds + R_RB, 32 * tn, lane, acc);
#pragma unroll
            for (int q = 0; q < 4; ++q) { const int i = 32 * tn + r32, k = 32 * tm + 8 * q + 4 * hi;
                const u32x2 rv = *(const LAS u32x2*)(lds + R_RHO + i * RLD + 2 * k);
                po0[4 * q] = bflo(rv.x) - acc[4 * q]; po0[4 * q + 1] = bfhi(rv.x) - acc[4 * q + 1]; po0[4 * q + 2] = bflo(rv.y) - acc[4 * q + 2]; po0[4 * q + 3] = bfhi(rv.y) - acc[4 * q + 3]; }
            f32x16 am = (f32x16){};
            am = tile64x<true, false>(lds + R_BP, 32 * tm, lds + R_TAT, 32 * tn, lane, am);
            const LAS float* GC = (const LAS float*)(lds + R_GC);
#pragma unroll
            for (int q = 0; q < 4; ++q) { const int k = 32 * tn + r32, kp0 = 32 * tm + 8 * q + 4 * hi;
#pragma unroll
                for (int e = 0; e < 4; ++e) po1[4 * q + e] = ((kp0 + e == k) ? GC[kp0 + e] : 0.f) - am[4 * q + e]; }
        } else {
            f32x16 a1 = (f32x16){}, a2 = (f32x16){};
            a1 = tile64x<true, false>(lds + R_V, 32 * tm, lds + R_RK, 32 * tn, lane, a1);
            a2 = tile64x<false, false>(lds + R_UT, 32 * tm, lds + R_RB, 32 * tn, lane, a2);
            po0 = a1 - a2;
            f32x16 n1 = (f32x16){}, n2 = (f32x16){};
            n1 = tile64x<true, true>(lds + R_KP, 32 * tm, lds + R_V, 32 * tn, lane, n1);
            n2 = tile64x<true, false>(lds + R_BP, 32 * tm, lds + R_UT, 32 * tn, lane, n2);
            po1 = n1 - n2;
        }
        ctp = ct;
    }
    if (ct + G < 6144) { LAS float* pn = (LAS float*)(lds + R_PAR) + ((itn + 1) & 1) * NPAR; pn[tid] = pnx0; if (tid + 512 < NPAR) pn[tid + 512] = pnx1; }
    __syncthreads();
  }
    if (ctp >= 0) { const int lane = tid0 & 63, wave = __builtin_amdgcn_readfirstlane(tid0 >> 6); R1_FLUSH(ctp, lane, wave); }
#undef R1_FLUSH
}

__device__ __forceinline__ void rwkv_r2_unit(const Args& a, int unit, LAS unsigned char* lds) {
    const int tid = otid(), lane = tid & 63, wave = __builtin_amdgcn_readfirstlane(tid >> 6);
    unsigned char* ws = a.ws;
    LAS float* S = (LAS float*)lds;
    const int vb = wave >> 1, kb0 = 2 * (wave & 1), l15 = lane & 15, lq = lane >> 4;
    for (int i = tid; i < 64 * 68; i += 512) S[i] = 0.f;
    const float* MPb = (const float*)(ws + WS_MP) + (size_t)unit * 32 * 4096; const float* NPb = (const float*)(ws + WS_NP) + (size_t)unit * 32 * 4096;
    bf16_t* SSb = (bf16_t*)(ws + WS_SS) + (size_t)unit * 32 * 4096;
    float Bm[2][16]; f32x4 acc[2];
#pragma unroll
    for (int t2 = 0; t2 < 2; ++t2) {
#pragma unroll
        for (int ks = 0; ks < 16; ++ks) Bm[t2][ks] = MPb[(4 * ks + lq) * 64 + 16 * (kb0 + t2) + l15];
#pragma unroll
        for (int rg = 0; rg < 4; ++rg) acc[t2][rg] = NPb[(16 * vb + 4 * lq + rg) * 64 + 16 * (kb0 + t2) + l15]; }
    __syncthreads();
    for (int c = 0; c < 32; ++c) {
        { const int v = tid >> 3, sg = tid & 7; const LAS float* sp = S + v * 68 + 8 * sg; float x[8];
#pragma unroll
          for (int q = 0; q < 8; ++q) x[q] = sp[q];
          *(u32x4*)(SSb + (size_t)c * 4096 + v * 64 + 8 * sg) = pack8(x); }
#pragma unroll
        for (int ks = 0; ks < 16; ++ks) { const float av = S[(16 * vb + l15) * 68 + 4 * ks + lq];
            acc[0] = __builtin_amdgcn_mfma_f32_16x16x4f32(av, Bm[0][ks], acc[0], 0, 0, 0);
            acc[1] = __builtin_amdgcn_mfma_f32_16x16x4f32(av, Bm[1][ks], acc[1], 0, 0, 0); }
        __syncthreads();
#pragma unroll
        for (int t2 = 0; t2 < 2; ++t2)
#pragma unroll
            for (int rg = 0; rg < 4; ++rg) S[(16 * vb + 4 * lq + rg) * 68 + 16 * (kb0 + t2) + l15] = acc[t2][rg];
        if (c + 1 < 32) { const float* MPc = MPb + (size_t)(c + 1) * 4096; const float* NPc = NPb + (size_t)(c + 1) * 4096;
#pragma unroll
            for (int t2 = 0; t2 < 2; ++t2) {
#pragma unroll
                for (int ks = 0; ks < 16; ++ks) Bm[t2][ks] = MPc[(4 * ks + lq) * 64 + 16 * (kb0 + t2) + l15];
#pragma unroll
                for (int rg = 0; rg < 4; ++rg) acc[t2][rg] = NPc[(16 * vb + 4 * lq + rg) * 64 + 16 * (kb0 + t2) + l15]; } }
        __syncthreads();
    }
}

__device__ __forceinline__ void phase_rwkv_out(const Args& a, int l) {
    const int tid = otid(), lane = tid & 63, wave = tid >> 6, r32 = lane & 31, hi = lane >> 5;
    unsigned char* ws = a.ws;
    const bf16_t* SSg = (const bf16_t*)(ws + WS_SS); const bf16_t* QAg = (const bf16_t*)(ws + WS_QA); const unsigned* Y0g = (const unsigned*)(ws + WS_Y0);
    const bf16_t* RV = (const bf16_t*)(ws + WS_RV);
    const bf16_t* GG = (const bf16_t*)(ws + WS_GG); bf16_t* OB = (bf16_t*)(ws + WS_OA) + 256;
    const float* lng = a.in[I_LNG] + (size_t)l * RW; const float* lnb = a.in[I_LNB] + (size_t)l * RW;
    for (int wt = blockIdx.x * 8 + wave; wt < 6144; wt += gridDim.x * 8) {
        const int tq = wt & 63, bh = wt >> 6, h = bh % 12, b = bh / 12, c = tq >> 1, tn = tq & 1, tnb = 1 - tn;
        const size_t ctf = ((size_t)bh * 2 + 0) * 32 + c, ctb = ((size_t)bh * 2 + 1) * 32 + (31 - c);
        const size_t t = (size_t)b * NT + 64 * c + 32 * tn + r32;
        const int srcl = (lane & 32) + 31 - r32;
        float y[2][16];
#pragma unroll
        for (int tm = 0; tm < 2; ++tm) {
            f32x16 af, ab;
            const unsigned* y0f = Y0g + ctf * 2048 + (tm * 2 + tn) * 512 + lane; const unsigned* y0b = Y0g + ctb * 2048 + (tm * 2 + tnb) * 512 + lane;
#pragma unroll
            for (int p = 0; p < 8; ++p) { const unsigned uf = y0f[p * 64], ub = y0b[p * 64]; af[2 * p] = bflo(uf); af[2 * p + 1] = bfhi(uf); ab[2 * p] = bflo(ub); ab[2 * p + 1] = bfhi(ub); }
#pragma unroll
            for (int s4 = 0; s4 < 4; ++s4) {
                const bf16x8 xf = *(const bf16x8*)(SSg + ctf * 4096 + (32 * tm + r32) * 64 + 16 * s4 + 8 * hi);
                const bf16x8 yf = *(const bf16x8*)(QAg + ctf * 4096 + ((tn * 4 + s4) * 64 + lane) * 8);
                af = __builtin_amdgcn_mfma_f32_32x32x16_bf16(xf, yf, af, 0, 0, 0);
                const bf16x8 xb = *(const bf16x8*)(SSg + ctb * 4096 + (32 * tm + r32) * 64 + 16 * s4 + 8 * hi);
                const bf16x8 yb = *(const bf16x8*)(QAg + ctb * 4096 + ((tnb * 4 + s4) * 64 + lane) * 8);
                ab = __builtin_amdgcn_mfma_f32_32x32x16_bf16(xb, yb, ab, 0, 0, 0);
            }
#pragma unroll
            for (int rg = 0; rg < 16; ++rg) y[tm][rg] = af[rg] + __shfl(ab[rg], srcl);
        }
        float sm = 0.f;
#pragma unroll
        for (int tm = 0; tm < 2; ++tm)
#pragma unroll
            for (int rg = 0; rg < 16; ++rg) sm += y[tm][rg];
        sm += __shfl_xor(sm, 32);
        const float mean = sm * (1.f / 64.f);
        float sv = 0.f;
#pragma unroll
        for (int tm = 0; tm < 2; ++tm)
#pragma unroll
            for (int rg = 0; rg < 16; ++rg) { const float d = y[tm][rg] - mean; y[tm][rg] = d; sv += d * d; }
        sv += __shfl_xor(sv, 32);
        const float rstd = rsqrtf(sv * (1.f / 64.f) + 64e-5f);
        const float* BS = (const float*)(ws + WS_RR);
        const float s0 = BS[t * 12 + h] + BS[((size_t)NTOK + t) * 12 + h];
#pragma unroll
        for (int tm = 0; tm < 2; ++tm)
#pragma unroll
            for (int q = 0; q < 4; ++q) { const int cc = h * 64 + 32 * tm + 8 * q + 4 * hi;
                const f32x4 g4 = *(const f32x4*)(lng + cc), b4 = *(const f32x4*)(lnb + cc); const u32x2 vv = *(const u32x2*)(RV + t * RW + cc);
                const f32x4 v4 = (f32x4){bflo(vv.x), bfhi(vv.x), bflo(vv.y), bfhi(vv.y)};
                const u32x2 gg = *(const u32x2*)(GG + t * RW + cc);
                const float o0 = (y[tm][4 * q] * rstd * g4.x + b4.x + s0 * v4.x) * bflo(gg.x), o1 = (y[tm][4 * q + 1] * rstd * g4.y + b4.y + s0 * v4.y) * bfhi(gg.x);
                const float o2 = (y[tm][4 * q + 2] * rstd * g4.z + b4.z + s0 * v4.z) * bflo(gg.y), o3 = (y[tm][4 * q + 3] * rstd * g4.w + b4.w + s0 * v4.w) * bfhi(gg.y);
                u32x2 w; w.x = pk2(o0, o1); w.y = pk2(o2, o3);
                *(u32x2*)(OB + t * 1792 + cc) = w; }
    }
    const float* OAG = (const float*)(ws + WS_OAG); const float* LSE = (const float*)(ws + WS_LSE); bf16_t* OA = (bf16_t*)(ws + WS_OA);
    for (int task = blockIdx.x * 8 + wave; task < NTOK / 4; task += gridDim.x * 8) {
#pragma unroll
        for (int tk = 0; tk < 4; ++tk) { const size_t t = (size_t)task * 4 + tk; const int hh = lane >> 4;
            const float l0 = LSE[((size_t)0 * NTOK + t) * 4 + hh], l1 = LSE[((size_t)1 * NTOK + t) * 4 + hh], l2 = LSE[((size_t)2 * NTOK + t) * 4 + hh];
            const float mx = fmaxf(l0, fmaxf(l1, l2));
            const float w0 = __builtin_amdgcn_exp2f(l0 - mx), w1 = __builtin_amdgcn_exp2f(l1 - mx), w2 = __builtin_amdgcn_exp2f(l2 - mx);
            const float inv = 1.f / (w0 + w1 + w2);
            const bf16_t* OAb = (const bf16_t*)OAG;
            const u32x2 u0 = *(const u32x2*)(OAb + ((size_t)0 * NTOK + t) * 256 + lane * 4), u1 = *(const u32x2*)(OAb + ((size_t)1 * NTOK + t) * 256 + lane * 4), u2 = *(const u32x2*)(OAb + ((size_t)2 * NTOK + t) * 256 + lane * 4);
            const f32x4 o0 = (f32x4){bflo(u0.x), bfhi(u0.x), bflo(u0.y), bfhi(u0.y)}, o1 = (f32x4){bflo(u1.x), bfhi(u1.x), bflo(u1.y), bfhi(u1.y)}, o2 = (f32x4){bflo(u2.x), bfhi(u2.x), bflo(u2.y), bfhi(u2.y)};
            const f32x4 r = (o0 * w0 + o1 * w1 + o2 * w2) * inv;
            u32x2 w; w.x = pk2(r.x, r.y); w.y = pk2(r.z, r.w);
            *(u32x2*)(OA + t * 1792 + lane * 4) = w; }
    }
}

__device__ __forceinline__ int vk_off(int row, int ch) { return 2048 * (row >> 3) + 512 * (ch >> 2) + 64 * (row & 7) + 16 * ((ch & 3) ^ ((row >> 2) & 3)); }
__device__ __forceinline__ void diffattn_unit(const Args& a, int l, int unit, LAS unsigned char* lds) {
    constexpr int TB = 16384;
    const int b = unit / 96; const int rem = unit - b * 96; const int h = rem >> 4, qb = rem & 15;
    const int tid = otid(), lane = tid & 63, wave = __builtin_amdgcn_readfirstlane(tid >> 6), r32 = lane & 31, hi = lane >> 5;
    const int c = wave & 1, qblk = wave >> 1;
    const int q0 = qb * 128 + qblk * 32;
    const bf16_t* P = (const bf16_t*)(a.ws + WS_PROJ);
    const size_t rowb = (size_t)b * NT;
    bf16x8 qf[4];
    { const bf16_t* qp = P + (rowb + q0 + r32) * PLD + C_CQ + h * 128 + c * 64 + 8 * hi;
#pragma unroll
      for (int s4 = 0; s4 < 4; ++s4) qf[s4] = *(const bf16x8*)(qp + 16 * s4); }
    LAS float* biasL = (LAS float*)(lds + 69632);
    { const float* bC = (const float*)(a.ws + WS_MISC + MISC_BIASC) + h * 257;
      for (int i = tid; i < 257; i += 512) biasL[i] = bC[i]; }
    const bf16_t* kgd[2]; const bf16_t* vgd[2];
#pragma unroll
    for (int jj = 0; jj < 2; ++jj) { const int r7 = (lane >> 2) & 7, row = 8 * wave + r7, chv = 4 * (2 * jj + (lane >> 5)) + ((lane & 3) ^ ((2 * wave + (r7 >> 2)) & 3));
        kgd[jj] = P + (rowb + row) * PLD + C_CK + h * 128 + chv * 8; vgd[jj] = P + (rowb + row) * PLD + C_CV + h * 128 + chv * 8; }
#define DA_DMA(src, tt, dstoff) do { _Pragma("unroll") for (int jj = 0; jj < 2; ++jj) \
        __builtin_amdgcn_global_load_lds((const unsigned*)((src)[jj] + (size_t)(64 * (tt)) * PLD), (LAS unsigned*)(lds + (dstoff) + 1024 * (2 * wave + jj)), 16, 0, 0); } while (0)
    DA_DMA(kgd, 0, 0); DA_DMA(vgd, 0, 2 * TB); DA_DMA(kgd, 1, TB);
    asm volatile("s_waitcnt vmcnt(0)" ::: "memory"); __syncthreads();
    f32x16 o[4];
#pragma unroll
    for (int db = 0; db < 4; ++db) o[db] = (f32x16){};
    float m = -1e30f, lsum = 0.f;
    const float SC = 0.125f * LOG2E;
    const int chlo = 2 * ((lane >> 4) & 1) + ((lane & 3) >> 1);
    const int trb0 = 64 * (4 * hi + ((lane & 15) >> 2)) + 16 * (chlo ^ (hi & 3)) + 8 * (lane & 1);
    const int trb1 = 64 * (4 * hi + ((lane & 15) >> 2)) + 16 * (chlo ^ ((2 + hi) & 3)) + 8 * (lane & 1) + 2048;
    const int qabs = q0 + r32;
    const int ko0 = vk_off(r32, 8 * c + hi), ko1 = vk_off(32 + r32, 8 * c + hi);
#define DA_QK(SA0, SA1, Kb) do { SA0 = (f32x16){}; SA1 = (f32x16){}; bf16x8 _kf0[4], _kf1[4]; \
        _Pragma("unroll") for (int s4 = 0; s4 < 4; ++s4) { _kf0[s4] = *(const LAS bf16x8*)((Kb) + vk_off(r32, 8 * c + 2 * s4 + hi)); _kf1[s4] = *(const LAS bf16x8*)((Kb) + vk_off(32 + r32, 8 * c + 2 * s4 + hi)); } \
        _Pragma("unroll") for (int s4 = 0; s4 < 4; ++s4) { \
            SA0 = __builtin_amdgcn_mfma_f32_32x32x16_bf16(_kf0[s4], qf[s4], SA0, 0, 0, 0); \
            SA1 = __builtin_amdgcn_mfma_f32_32x32x16_bf16(_kf1[s4], qf[s4], SA1, 0, 0, 0); } } while (0)
    f32x16 sa0, sa1, sn0 = (f32x16){}, sn1 = (f32x16){};
    DA_QK(sa0, sa1, lds);
    (void)ko0; (void)ko1;
    asm volatile("s_waitcnt lgkmcnt(0)" ::: "memory"); __syncthreads();
    for (int t = 0; t < 32; ++t) {
        if (t + 2 < 32) DA_DMA(kgd, t + 2, (t & 1) * TB);
        if (t + 1 < 32) DA_DMA(vgd, t + 1, 2 * TB + ((t + 1) & 1) * TB);
        const LAS unsigned char* Vb = lds + 2 * TB + (t & 1) * TB;
        if (t + 1 < 32) { DA_QK(sn0, sn1, lds + ((t + 1) & 1) * TB); }
        __builtin_amdgcn_sched_barrier(0);
        float x0[16], x1[16];
        const int kv0 = 64 * t;
        const bool farp = (kv0 >= q0 + 31 + 128), farn = (kv0 + 63 + 128 <= q0);
        if (farp || farn) { const float cb = farp ? biasL[256] : biasL[0];
#pragma unroll
            for (int rg = 0; rg < 16; ++rg) { x0[rg] = sa0[rg] * SC + cb; x1[rg] = sa1[rg] * SC + cb; }
        } else {
#pragma unroll
            for (int rg = 0; rg < 16; ++rg) { int rel = kv0 + crow(rg, hi) - qabs; int rc = rel < -128 ? -128 : (rel > 128 ? 128 : rel);
                x0[rg] = sa0[rg] * SC + biasL[rc + 128];
                rel += 32; rc = rel < -128 ? -128 : (rel > 128 ? 128 : rel);
                x1[rg] = sa1[rg] * SC + biasL[rc + 128]; }
        }
        float mx = fmaxf(x0[0], x1[0]);
#pragma unroll
        for (int rg = 1; rg < 16; ++rg) mx = fmaxf(mx, fmaxf(x0[rg], x1[rg]));
        mx = fmaxf(mx, __shfl_xor(mx, 32));
        const float mn = fmaxf(m, mx), alpha = __builtin_amdgcn_exp2f(m - mn); m = mn;
        float ps = 0.f;
#pragma unroll
        for (int rg = 0; rg < 16; ++rg) { x0[rg] = __builtin_amdgcn_exp2f(x0[rg] - mn); x1[rg] = __builtin_amdgcn_exp2f(x1[rg] - mn); ps += x0[rg] + x1[rg]; }
        lsum = lsum * alpha + ps;
#pragma unroll
        for (int db = 0; db < 4; ++db)
#pragma unroll
            for (int rg = 0; rg < 16; ++rg) o[db][rg] *= alpha;
        u32x4 pw[4];
#pragma unroll
        for (int s2 = 0; s2 < 2; ++s2) {
            pw[s2].x = pk2(x0[8 * s2 + 0], x0[8 * s2 + 1]); pw[s2].y = pk2(x0[8 * s2 + 2], x0[8 * s2 + 3]); pw[s2].z = pk2(x0[8 * s2 + 4], x0[8 * s2 + 5]); pw[s2].w = pk2(x0[8 * s2 + 6], x0[8 * s2 + 7]);
            pw[2 + s2].x = pk2(x1[8 * s2 + 0], x1[8 * s2 + 1]); pw[2 + s2].y = pk2(x1[8 * s2 + 2], x1[8 * s2 + 3]); pw[2 + s2].z = pk2(x1[8 * s2 + 4], x1[8 * s2 + 5]); pw[2 + s2].w = pk2(x1[8 * s2 + 6], x1[8 * s2 + 7]); }
        {
            s16x4 vl[2][4], vh[2][4];
#pragma unroll
            for (int db = 0; db < 4; ++db) { vl[0][db] = vtr(Vb + trb0 + 512 * db); vh[0][db] = vtr(Vb + trb1 + 512 * db); }
#pragma unroll
            for (int s = 0; s < 4; ++s) {
                if (s < 3) {
#pragma unroll
                    for (int db = 0; db < 4; ++db) { vl[(s + 1) & 1][db] = vtr(Vb + trb0 + 4096 * (s + 1) + 512 * db); vh[(s + 1) & 1][db] = vtr(Vb + trb1 + 4096 * (s + 1) + 512 * db); } }
#pragma unroll
                for (int db = 0; db < 4; ++db) { const s16x4 lo = vl[s & 1][db], hi4 = vh[s & 1][db];
                    const bf16x8 af = (bf16x8){lo[0], lo[1], lo[2], lo[3], hi4[0], hi4[1], hi4[2], hi4[3]};
                    o[db] = __builtin_amdgcn_mfma_f32_32x32x16_bf16(af, __builtin_bit_cast(bf16x8, pw[s]), o[db], 0, 0, 0); }
            }
        }
        asm volatile("s_waitcnt vmcnt(0)" ::: "memory"); __syncthreads();
        sa0 = sn0; sa1 = sn1;
    }
#undef DA_QK
#undef DA_DMA
    const float lt = lsum + __shfl_xor(lsum, 32);
    const float inv = 1.f / lt;
    const float* lamp = (const float*)(a.ws + WS_MISC + MISC_LAM);
    const float lam = lamp[l], linit = lamp[2 + l];
    LAS float* XO = (LAS float*)lds;
    if (c == 1) {
        const float f = inv * lam;
#pragma unroll
        for (int db = 0; db < 4; ++db)
#pragma unroll
            for (int rg = 0; rg < 16; ++rg) XO[(qblk * 64 + db * 16 + rg) * 64 + lane] = o[db][rg] * f;
    }
    __syncthreads();
    if (c == 0) {
        float ss = 0.f;
#pragma unroll
        for (int db = 0; db < 4; ++db)
#pragma unroll
            for (int rg = 0; rg < 16; ++rg) { const float v = o[db][rg] * inv - XO[(qblk * 64 + db * 16 + rg) * 64 + lane]; o[db][rg] = v; ss += v * v; }
        ss += __shfl_xor(ss, 32);
        const float sc = rsqrtf(ss * (1.f / 128.f) + 1e-5f) * (1.f - linit);
        const float* sg = a.in[I_SUBG] + (size_t)l * 128;
        bf16_t* op = (bf16_t*)(a.ws + WS_OA) + (rowb + q0 + r32) * 1792 + 1024 + h * 128;
#pragma unroll
        for (int db = 0; db < 4; ++db)
#pragma unroll
            for (int i = 0; i < 4; ++i) { const int d = db * 32 + 8 * i + 4 * hi; const f32x4 g4 = *(const f32x4*)(sg + d);
                u32x2 w; w.x = pk2(o[db][4 * i] * sc * g4.x, o[db][4 * i + 1] * sc * g4.y); w.y = pk2(o[db][4 * i + 2] * sc * g4.z, o[db][4 * i + 3] * sc * g4.w);
                *(u32x2*)(op + d) = w; }
    }
    __syncthreads();
}

__device__ __forceinline__ void phase_route(const Args& a, int l, LAS unsigned char* lds, bool commit = true) {
    const int tid = otid(), lane = tid & 63, wave = __builtin_amdgcn_readfirstlane(tid >> 6), r32 = lane & 31, hi = lane >> 5;
    unsigned char* ws = a.ws;
    LAS float* hb = (LAS float*)lds;
    LAS float* lg = (LAS float*)(lds + 131200);
    volatile LAS int* sel = (volatile LAS int*)(lds + 131200 + 4224);
    const float* X = (const float*)(ws + WS_X);
    const float* mod = (const float*)(ws + WS_MISC + MISC_MOD) + (size_t)l * 8 * 6144;
    bf16_t* H = (bf16_t*)(ws + WS_H);
    unsigned* cnt = (unsigned*)(ws + WS_CTL) + CW_CNT + l * 512;
    int* LIST = (int*)(ws + WS_LIST); unsigned* TOKE = (unsigned*)(ws + WS_TOKE); float* TOKP = (float*)(ws + WS_TOKP);
    const float* g2 = a.in[I_N2G] + (size_t)l * DM; const float* rb = a.in[I_RB] + (size_t)l * NE;
    float Bw[64];
    { const float* rw = a.in[I_RW] + (size_t)l * DM * NE + (size_t)(128 * wave + hi) * NE + r32;
#pragma unroll
      for (int s2 = 0; s2 < 64; ++s2) Bw[s2] = rw[(size_t)(2 * s2) * NE]; }
    for (int tb = blockIdx.x; tb < NTOK / 64; tb += gridDim.x) {
        for (int rnd = 0; rnd < 2; ++rnd) {
            const int tbase = tb * 64 + rnd * 32;
            const float* mb = mod + (size_t)(tbase >> 11) * 6144;
#pragma unroll 1
            for (int q = 0; q < 4; ++q) {
                const int tl = 4 * wave + q; const size_t t = (size_t)tbase + tl;
                f32x4 v[4];
#pragma unroll
                for (int j = 0; j < 4; ++j) v[j] = *(const f32x4*)(X + t * DM + 4 * lane + 256 * j);
                const float rstd = row_rstd(v, 1e-6f);
#pragma unroll
                for (int j = 0; j < 4; ++j) { const int c = 4 * lane + 256 * j;
                    const f32x4 gv = *(const f32x4*)(g2 + c), scv = *(const f32x4*)(mb + 4096 + c), shv = *(const f32x4*)(mb + 3072 + c);
                    const f32x4 hv = v[j] * rstd * gv * (scv + 1.0f) + shv;
                    u32x2 w; w.x = pk2(hv.x, hv.y); w.y = pk2(hv.z, hv.w);
                    *(u32x2*)(H + t * DM + c) = w;
                    LAS float* hp = hb + tl * 1025 + c; hp[0] = hv.x; hp[1] = hv.y; hp[2] = hv.z; hp[3] = hv.w; }
            }
            __syncthreads();
            f32x16 d = (f32x16){};
            { const LAS float* ap = hb + r32 * 1025 + 128 * wave + hi;
#pragma unroll
              for (int s2 = 0; s2 < 64; ++s2) d = __builtin_amdgcn_mfma_f32_32x32x2f32(ap[2 * s2], Bw[s2], d, 0, 0, 0); }
            __syncthreads();
#pragma unroll
            for (int rg = 0; rg < 16; ++rg) hb[(wave * 16 + rg) * 64 + lane] = d[rg];
            __syncthreads();
#pragma unroll
            for (int j = 0; j < 2; ++j) { const int idx = tid + 512 * j, rg = idx >> 6, ln = idx & 63; float sm = 0.f;
#pragma unroll
                for (int w8 = 0; w8 < 8; ++w8) sm += hb[(w8 * 16 + rg) * 64 + ln];
                lg[crow(rg, ln >> 5) * 33 + (ln & 31)] = sm + rb[ln & 31]; }
            __syncthreads();
#pragma unroll 1
            for (int q = 0; q < 4; ++q) {
                const int tl = 4 * wave + q; const int t = tbase + tl;
                const int myidx = lane & 31;
                float cur = lg[tl * 33 + myidx];
                float tv[4]; int ti4[4];
#pragma unroll
                for (int k = 0; k < 4; ++k) { float bv = cur; int bi = myidx;
#pragma unroll
                    for (int off = 16; off >= 1; off >>= 1) { const float ov = __shfl_xor(bv, off); const int oi = __shfl_xor(bi, off);
                        const bool take = (ov > bv) || (ov == bv && oi < bi); bv = take ? ov : bv; bi = take ? oi : bi; }
                    tv[k] = bv; ti4[k] = bi; if (myidx == bi) cur = -INFINITY; }
                const float e1 = expf(tv[1] - tv[0]), e2 = expf(tv[2] - tv[0]), e3 = expf(tv[3] - tv[0]);
                const float inv = 1.f / (1.f + e1 + e2 + e3);
                if (lane < 4) { const int e = lane == 0 ? ti4[0] : lane == 1 ? ti4[1] : lane == 2 ? ti4[2] : ti4[3];
                    const float pr = (lane == 0 ? 1.f : lane == 1 ? e1 : lane == 2 ? e2 : e3) * inv;
                    sel[(rnd * 32 + tl) * 4 + lane] = e; TOKP[(size_t)t * 4 + lane] = pr; }
            }
            __syncthreads();
        }
        if (tid < 32) { const int e = tid; int n = 0;
            for (int i = 0; i < 256; ++i) n += (sel[i] == e) ? 1 : 0;
            unsigned run = (commit && n > 0) ? __hip_atomic_fetch_add(cnt + 16 * e, (unsigned)n, __ATOMIC_RELAXED, __HIP_MEMORY_SCOPE_AGENT) : 0u;
            for (int i = 0; i < 256; ++i) if (sel[i] == e) { const int t = tb * 64 + (i >> 2);
                if (commit) LIST[(size_t)e * NTOK + run] = t;
                TOKE[(size_t)t * 4 + (i & 3)] = ((unsigned)e << 16) | (run & 0xffffu); ++run; } }
        __syncthreads();
    }
}

__device__ __forceinline__ void build_moe_tab(const Args& a, int l, volatile LAS int* tab) {
    const unsigned* cnt = (const unsigned*)(a.ws + WS_CTL) + CW_CNT + l * 512;
    const int tid = otid();
    __syncthreads();
    if (tid < 32) tab[64 + tid] = (int)__hip_atomic_load(cnt + 16 * tid, __ATOMIC_RELAXED, __HIP_MEMORY_SCOPE_AGENT);
    __syncthreads();
    if (tid == 0) { int s = 0; for (int e = 0; e < 32; ++e) { tab[e] = s; s += (tab[64 + e] + 255) >> 8; } tab[32] = s; }
    __syncthreads();
}

__device__ __forceinline__ void phase_combine(const Args& a, int l, const LAS int* tab, bool dry = false) {
    const int tid = otid(), lane = tid & 63, wave = tid >> 6;
    unsigned char* ws = a.ws;
    float* X = (float*)(ws + WS_X);
    const bf16_t* YM = (const bf16_t*)(ws + WS_YMOE);
    const unsigned* TOKE = (const unsigned*)(ws + WS_TOKE); const float* TOKP = (const float*)(ws + WS_TOKP);
    const float* modl = (const float*)(ws + WS_MISC + MISC_MOD) + (size_t)l * 8 * 6144;
    for (int t = blockIdx.x * 8 + wave; t < NTOK; t += gridDim.x * 8) {
        f32x4 v[4], acc[4];
#pragma unroll
        for (int j = 0; j < 4; ++j) { v[j] = *(const f32x4*)(X + (size_t)t * DM + 4 * lane + 256 * j); acc[j] = (f32x4){0.f, 0.f, 0.f, 0.f}; }
#pragma unroll
        for (int k = 0; k < 4; ++k) { const unsigned ep = TOKE[(size_t)t * 4 + k]; const float pr = TOKP[(size_t)t * 4 + k];
            const int e = ep >> 16, pos = ep & 0xffff; const size_t srow = (size_t)tab[e] * 256 + pos;
#pragma unroll
            for (int j = 0; j < 4; ++j) { const u32x2 y = *(const u32x2*)(YM + srow * DM + 4 * lane + 256 * j);
                acc[j].x += pr * bflo(y.x); acc[j].y += pr * bfhi(y.x); acc[j].z += pr * bflo(y.y); acc[j].w += pr * bfhi(y.y); } }
        const float* mb = modl + (size_t)(t >> 11) * 6144;
#pragma unroll
        for (int j = 0; j < 4; ++j) { const f32x4 gt = *(const f32x4*)(mb + 5120 + 4 * lane + 256 * j); v[j] = v[j] + gt * acc[j]; }
        const float rstd = row_rstd(v, 1e-6f);
        float* Xo = dry ? (float*)(ws + WS_QA) : X; bf16_t* Ho = dry ? (bf16_t*)(ws + WS_QA + (size_t)NTOK * DM * 4) : (bf16_t*)(ws + WS_H); float* Oo = dry ? (float*)(ws + WS_QA) : a.out;
        if (l + 1 < DEPTH) {
#pragma unroll
            for (int j = 0; j < 4; ++j) *(f32x4*)(Xo + (size_t)t * DM + 4 * lane + 256 * j) = v[j];
            const float* mn = modl + (size_t)8 * 6144 + (size_t)(t >> 11) * 6144;
            norm_mod_store(v, rstd, a.in[I_N1G] + (size_t)(l + 1) * DM, mn + 1024, mn, Ho + (size_t)t * DM, lane);
        } else {
#pragma unroll
            for (int j = 0; j < 4; ++j) { const int c = 4 * lane + 256 * j; const f32x4 g = *(const f32x4*)(a.in[I_FNG] + c);
                *(f32x4*)(Oo + (size_t)t * DM + c) = v[j] * rstd * g; }
        }
    }
}

constexpr int NPL = 9;
constexpr int N_PHASES = 2 + NPL * DEPTH;
__global__ void __launch_bounds__(512, 2) fwd(Args a) {
    extern __shared__ __attribute__((aligned(16))) unsigned char smem[];
    LAS unsigned char* lds = (LAS unsigned char*)smem;
    const int tid = threadIdx.x;
    unsigned* ctl = (unsigned*)(a.ws + WS_CTL);
    volatile LAS unsigned* xbw = (volatile LAS unsigned*)(lds + LDS_CTL_OFF);
    volatile LAS int* tab = (volatile LAS int*)(lds + LDS_CTL_OFF + 256);
    volatile LAS int* qw = (volatile LAS int*)(lds + LDS_CTL_OFF + 1024);
    if (tid < 4) xbw[tid] = 0u;
    __syncthreads();
    const int lo = a.ph_lo, hi = a.ph_hi;
    XcdBarrier bar; bar.bar = ctl + CW_BAR; bar.x = 0; bar.st = xbw;
    if (hi - lo > 1) bar = xcd_barrier_post(ctl + CW_BAR, xbw);
#ifndef DUPMASK
#define DUPMASK 0
#endif
#define NREP(k) (((DUPMASK >> PHSEL(k)) & 1) ? 2 : 1)
#ifndef BRMASK
#define BRMASK 7
#endif
#ifndef PHMASK
#define PHMASK 0xFFFFF
#endif
#define PHSEL(k) ((k) < 2 ? (k) : 2 + ((k) - 2) % NPL)
#define IN(k) (((PHMASK >> PHSEL(k)) & 1) && lo <= (k) && (k) < hi)
#define SEAM(k) do { if (IN(k) && IN((k) + 1)) { xcd_barrier(bar); } } while (0)
    unsigned char* ws = a.ws;
    if (IN(0)) { for (int rep = 0; rep < NREP(0); ++rep) { phase_p0(a, lds); __syncthreads(); } SEAM(0); }
    if (IN(1)) { phase_norm1(a, 0); SEAM(1); }
    for (int l = 0; l < DEPTH; ++l) {
        const int pb = 2 + NPL * l;
        if (IN(pb + 0)) {
          for (int rep = 0; rep < NREP(pb + 0); ++rep) {
            pg8::StaticOrder S; S.init(NTOK, PLD, gridDim.x, blockIdx.x);
            pg8::EpiProj E{(bf16_t*)(ws + WS_PROJ), PLD, 29};
            pg8::gemm_phase<pg8::EpiProj, pg8::StaticOrder>(lds, (const bf16_t*)(ws + WS_H), (const bf16_t*)(ws + WS_WIN) + (size_t)l * PLD * DM, DM, 0, S, E);
          }
            SEAM(pb + 0);
        }
        if (IN(pb + 1)) { for (int rep = 0; rep < NREP(pb + 1) + ((DUPMASK >> 17) & 1); ++rep) { phase_rwkv_r1(a, l, lds); } SEAM(pb + 1); }
        if (IN(pb + 2)) {
          for (int rep = 0; rep < NREP(pb + 2); ++rep) {
            {
                pg8::StaticOrder S; S.init(NTOK, RW, gridDim.x, blockIdx.x);
                pg8::EpiProj E{(bf16_t*)(ws + WS_GG), RW, 1 << 30};
                pg8::gemm_phase<pg8::EpiProj, pg8::StaticOrder>(lds, (const bf16_t*)(ws + WS_GS), (const bf16_t*)(ws + WS_MISC + MISC_GUPT) + (size_t)l * RW * 256, 256, 0, S, E);
            }
            for (int u = blockIdx.x; u < 192; u += gridDim.x) rwkv_r2_unit(a, u, lds);
            bool swa_tab = false;
            for (;;) {
                if (tid == 0) *qw = (int)__hip_atomic_fetch_add(ctl + CW_QH + 64 * (2 * l + rep), 1u, __ATOMIC_RELAXED, __HIP_MEMORY_SCOPE_AGENT);
                __syncthreads();
                const int item = *qw;
                __syncthreads();
                if (item >= 768 + 768) break;
                if (item < 768) { diffattn_unit(a, l, item, lds); continue; }
                { const int ztid = otid(), zlane = ztid & 63, zwave = ztid >> 6;
                  LAS float* bA = (LAS float*)(lds + 40960);
                  if (!swa_tab) { const float* bAg = (const float*)(ws + WS_MISC + MISC_BIASA);
                      for (int i = ztid; i < 12 * 129; i += 512) bA[i] = bAg[i];
                      __syncthreads(); swa_tab = true; }
                  swa_wave_unit((const bf16_t*)(ws + WS_PROJ), (float*)(ws + WS_OAG), (float*)(ws + WS_LSE), bA, lds + zwave * 4608, (item - 768) * 8 + zwave, zlane); }
            }
          }
            SEAM(pb + 2);
        }
        if (IN(pb + 3)) { for (int rep = 0; rep < NREP(pb + 3); ++rep) phase_rwkv_out(a, l); SEAM(pb + 3); }
        if (IN(pb + 4)) {
          for (int rep = 0; rep < NREP(pb + 4); ++rep) {
            pg8::StaticOrder S; S.init(NTOK, DM, gridDim.x, blockIdx.x);
            const bf16_t* P = (const bf16_t*)(ws + WS_PROJ); float* MF = (float*)(ws + WS_MF); bf16_t* MG = (bf16_t*)(ws + WS_MERGED);
            { pg8::EpiBranchM E{P, MG}; pg8::gemm_phase<pg8::EpiBranchM, pg8::StaticOrder>(lds, (const bf16_t*)(ws + WS_OA), (const bf16_t*)(ws + WS_WA) + (size_t)l * DM * 1792, 1792, 0, S, E); }
          }
            SEAM(pb + 4);
        }
        if (IN(pb + 5)) {
            pg8::StaticOrder S; S.init(NTOK, DM, gridDim.x, blockIdx.x);
            pg8::EpiOut E{l == 0 ? a.in[I_X] : (const float*)(ws + WS_X), (float*)(ws + WS_X), (const float*)(ws + WS_MISC + MISC_MOD) + (size_t)l * 8 * 6144 + 2048};
            pg8::gemm_phase<pg8::EpiOut, pg8::StaticOrder>(lds, (const bf16_t*)(ws + WS_MERGED), (const bf16_t*)(ws + WS_WO) + (size_t)l * DM * DM, DM, 0, S, E);
            SEAM(pb + 5);
        }
        if (IN(pb + 6)) { for (int rep = 0; rep < NREP(pb + 6); ++rep) phase_route(a, l, lds, rep == NREP(pb + 6) - 1); SEAM(pb + 6); }
        if (IN(pb + 7)) {
          for (int rep = 0; rep < NREP(pb + 7); ++rep) {
            build_moe_tab(a, l, tab);
            unsigned* rtc = ctl + CW_RT + (l * 2 + rep) * 2048;
            {
                pg8::MoeOrder<true> S{(const LAS int*)tab, (const int*)(ws + WS_LIST), 8, (int)gridDim.x, (int)blockIdx.x, rtc};
                pg8::EpiMoe1 E{(bf16_t*)(ws + WS_ACT), a.in[I_B1] + (size_t)l * NE * 2 * FF};
                pg8::gemm_phase<pg8::EpiMoe1, pg8::MoeOrder<true>>(lds, (const bf16_t*)(ws + WS_H), (const bf16_t*)(ws + WS_W1) + (size_t)l * NE * 2 * FF * DM, DM, (size_t)2 * FF * DM * 2, S, E);
            }
            {
                pg8::MoeOrder<false> S{(const LAS int*)tab, nullptr, 4, (int)gridDim.x, (int)(gridDim.x - 1 - blockIdx.x), rtc};
                pg8::EpiMoe2 E{(bf16_t*)(ws + WS_YMOE), a.in[I_B2] + (size_t)l * NE * DM};
                pg8::gemm_phase<pg8::EpiMoe2, pg8::MoeOrder<false>>(lds, (const bf16_t*)(ws + WS_ACT), (const bf16_t*)(ws + WS_W2) + (size_t)l * NE * DM * FF, FF, (size_t)DM * FF * 2, S, E);
            }
          }
            SEAM(pb + 7);
        }
        if (IN(pb + 8)) { build_moe_tab(a, l, tab); for (int rep = 0; rep < NREP(pb + 8); ++rep) phase_combine(a, l, (const LAS int*)tab, rep != NREP(pb + 8) - 1); SEAM(pb + 8); }
    }
#undef IN
#undef SEAM
}

#ifndef MK_ONE_LAUNCH
#define MK_ONE_LAUNCH 1
#endif
extern "C" void kernel_launch(void* const* d_in, const int* in_sizes, int n_in, void* d_out, int out_size, void* d_ws, size_t ws_size, hipStream_t stream) {
    static int grid = 0;
    if (grid == 0) {
        if (n_in != 32 || ws_size < WS_END) { fprintf(stderr, "kernel_launch: unexpected n_in %d or ws %zu < %zu\n", n_in, ws_size, (size_t)WS_END); grid = -1; return; }
        int dev = 0, cus = 0;
        if (hipGetDevice(&dev) != hipSuccess || hipDeviceGetAttribute(&cus, hipDeviceAttributeMultiprocessorCount, dev) != hipSuccess) { grid = -1; return; }
        if (hipFuncSetAttribute((const void*)fwd, hipFuncAttributeMaxDynamicSharedMemorySize, LDS_BYTES) != hipSuccess) { fprintf(stderr, "kernel_launch: hipFuncSetAttribute failed\n"); grid = -1; return; }
        int per_cu = 0;
        if (hipOccupancyMaxActiveBlocksPerMultiprocessor(&per_cu, (const void*)fwd, 512, LDS_BYTES) != hipSuccess || per_cu < 1) fprintf(stderr, "kernel_launch: occupancy query says %d\n", per_cu);
        (void)hipGetLastError();
        grid = cus;
    }
    if (grid < 0) return;
    (void)hipMemsetAsync((char*)d_ws + WS_CTL, 0, CTL_BYTES, stream);
    Args a{};
    for (int i = 0; i < 32; ++i) a.in[i] = (const float*)d_in[i];
    a.out = (float*)d_out; a.ws = (unsigned char*)d_ws;
#if MK_ONE_LAUNCH
    a.ph_lo = 0; a.ph_hi = N_PHASES;
    hipLaunchKernelGGL(fwd, dim3(grid), dim3(512), LDS_BYTES, stream, a);
#else
    for (int p = 0; p < N_PHASES; ++p) { a.ph_lo = p; a.ph_hi = p + 1; hipLaunchKernelGGL(fwd, dim3(grid), dim3(512), LDS_BYTES, stream, a); }
#endif
}
```

```cpp
#include <hip/hip_runtime.h>
#include <stdint.h>
#include <stdio.h>

#define LAS __attribute__((address_space(3)))
typedef unsigned short bf16_t;
typedef short bf16x8 __attribute__((ext_vector_type(8)));
typedef short s16x4 __attribute__((ext_vector_type(4)));
typedef float f32x2 __attribute__((ext_vector_type(2)));
typedef float f32x4 __attribute__((ext_vector_type(4)));
typedef float f32x16 __attribute__((ext_vector_type(16)));
typedef unsigned u32x2 __attribute__((ext_vector_type(2)));
typedef unsigned u32x4 __attribute__((ext_vector_type(4)));
typedef __bf16 bf16x2_t __attribute__((ext_vector_type(2)));
typedef short v4i16_t __attribute__((ext_vector_type(4)));

constexpr int NB = 8, NT = 2048, DM = 1024, NTOK = NB * NT, DEPTH = 2;
constexpr int IN_COLS = 10368, PLD = 10496;
constexpr int C_AQ = 0, C_AK = 768, C_AV = 1536, C_BS = 2304, C_CQ = 5120, C_CK = 5888, C_CV = 6656, C_G = 7424;
constexpr int RSTR = 2688, RW = 768, NE = 32, FF = 1024;
constexpr float LOG2E = 1.4426950408889634f;

constexpr size_t al256(size_t x) { return (x + 255) & ~(size_t)255; }
constexpr size_t WS_CTL = 0;
constexpr size_t CTL_BYTES = 65536;
constexpr size_t WS_MISC = WS_CTL + CTL_BYTES;
constexpr size_t MISC_MOD = 0, MISC_LAM = 393216, MISC_BIASA = 393472, MISC_BIASC = 399872, MISC_WUPT = 409600, MISC_AUPT = 409600 + 393216, MISC_GUPT = 409600 + 2 * 393216, MISC_BYTES = 2 << 20;
constexpr size_t WS_WIN = WS_MISC + MISC_BYTES;
constexpr size_t WS_WA = WS_WIN + (size_t)DEPTH * PLD * DM * 2;
constexpr size_t WS_WB = WS_WA + (size_t)DEPTH * DM * 256 * 2;
constexpr size_t WS_WC = WS_WB + (size_t)DEPTH * DM * 768 * 2;
constexpr size_t WS_WO = WS_WC + (size_t)DEPTH * DM * 768 * 2;
constexpr size_t WS_W1 = WS_WO + (size_t)DEPTH * DM * DM * 2;
constexpr size_t WS_W2 = WS_W1 + (size_t)DEPTH * NE * 2 * FF * DM * 2;
constexpr size_t WS_H = WS_W2 + (size_t)DEPTH * NE * DM * FF * 2;
constexpr size_t WS_X = WS_H + (size_t)NTOK * DM * 2;
constexpr size_t WS_OA = WS_X + (size_t)NTOK * DM * 4;
constexpr size_t WS_OB = WS_OA + (size_t)NTOK * 256 * 2;
constexpr size_t WS_OC = WS_OB + (size_t)NTOK * 768 * 2;
constexpr size_t WS_MERGED = WS_OC + (size_t)NTOK * 768 * 2;
constexpr size_t WS_LIST = WS_MERGED + (size_t)NTOK * DM * 2;
constexpr size_t WS_TOKE = WS_LIST + (size_t)NE * NTOK * 4;
constexpr size_t WS_TOKP = WS_TOKE + (size_t)NTOK * 4 * 4;
constexpr size_t WS_U = WS_TOKP + (size_t)NTOK * 4 * 4;
constexpr size_t WS_PROJ = WS_U;
constexpr size_t WS_RR = WS_PROJ + (size_t)NTOK * PLD * 2;
constexpr size_t WS_RV = WS_RR + (size_t)NTOK * RW * 4;
constexpr size_t WS_RWD = WS_RV + (size_t)NTOK * RW * 4;
constexpr size_t WS_RKK = WS_RWD + (size_t)2 * NTOK * RW * 4;
constexpr size_t WS_RKKA = WS_RKK + (size_t)2 * NTOK * RW * 4;
constexpr size_t WS_RKD = WS_RKKA + (size_t)2 * NTOK * RW * 4;
constexpr size_t WS_GS = WS_RKD + (size_t)2 * NTOK * RW * 4;
constexpr size_t WS_Y = WS_GS + (size_t)NTOK * 128 * 4;
constexpr size_t WS_OAG = WS_Y + (size_t)2 * NTOK * RW * 4;
constexpr size_t WS_LSE = WS_OAG + (size_t)3 * NTOK * 256 * 4;
constexpr size_t WS_MF = WS_LSE + (size_t)3 * NTOK * 4 * 4;
constexpr size_t WS_QA = WS_MF + (size_t)NTOK * DM * 4;
constexpr size_t WS_SS = WS_QA + (size_t)6144 * 4096 * 2;
constexpr size_t WS_END1 = WS_SS + (size_t)6144 * 4096 * 2;
constexpr size_t WS_GG = WS_Y;
constexpr size_t WS_MP = WS_RWD, WS_NP = WS_RKK, WS_Y0 = WS_RKKA;
constexpr int SLOT_ROWS = 4 * NTOK + NE * 256;
constexpr size_t WS_ACT = WS_U;
constexpr size_t WS_YMOE = WS_ACT + (size_t)SLOT_ROWS * FF * 2;
constexpr size_t WS_END2 = WS_YMOE + (size_t)SLOT_ROWS * DM * 2;
constexpr size_t WS_END = WS_END1 > WS_END2 ? WS_END1 : WS_END2;

constexpr int CW_BAR = 0;
constexpr int CW_CNT = 13312;
constexpr int CW_QH = 4224;
constexpr int CW_RT = 5120;

constexpr int LDS_STAGE = 155648;
constexpr int LDS_CTL_OFF = LDS_STAGE;
constexpr int LDS_BYTES = LDS_STAGE + 4096;

__device__ __forceinline__ int otid() { int t = threadIdx.x; asm volatile("" : "+v"(t)); return t; }
__device__ __forceinline__ int obid() { int t = blockIdx.x; asm volatile("" : "+s"(t)); return t; }
__device__ __forceinline__ unsigned pk2(float lo, float hi) { f32x2 v = {lo, hi}; bf16x2_t b = __builtin_convertvector(v, bf16x2_t); return __builtin_bit_cast(unsigned, b); }
__device__ __forceinline__ u32x4 pack8(const float (&x)[8]) { u32x4 w; w.x = pk2(x[0], x[1]); w.y = pk2(x[2], x[3]); w.z = pk2(x[4], x[5]); w.w = pk2(x[6], x[7]); return w; }
__device__ __forceinline__ bf16_t f2bf(float x) { return (bf16_t)(pk2(x, 0.f) & 0xffffu); }
__device__ __forceinline__ float bflo(unsigned u) { return __builtin_bit_cast(float, u << 16); }
__device__ __forceinline__ float bfhi(unsigned u) { return __builtin_bit_cast(float, u & 0xffff0000u); }
__device__ __forceinline__ float bf2f(bf16_t h) { return __builtin_bit_cast(float, (unsigned)h << 16); }
__device__ __forceinline__ float wave_sum(float v) {
#pragma unroll
    for (int o = 1; o < 64; o <<= 1) v += __shfl_xor(v, o);
    return v;
}
__device__ __forceinline__ float sigmoidf_(float x) { return __builtin_amdgcn_rcpf(1.f + __builtin_amdgcn_exp2f(-LOG2E * x)); }
__device__ __forceinline__ int crow(int r, int hi) { return (r & 3) + 8 * (r >> 2) + 4 * hi; }
__device__ __forceinline__ s16x4 vtr(const LAS unsigned char* p) { return __builtin_bit_cast(s16x4, __builtin_amdgcn_ds_read_tr16_b64_v4i16((LAS v4i16_t*)p)); }
__device__ __forceinline__ float dpp_sum8(float x) {
    int v = __builtin_bit_cast(int, x);
    x += __builtin_bit_cast(float, __builtin_amdgcn_update_dpp(0, v, 0xB1, 0xF, 0xF, true));
    v = __builtin_bit_cast(int, x);
    x += __builtin_bit_cast(float, __builtin_amdgcn_update_dpp(0, v, 0x4E, 0xF, 0xF, true));
    v = __builtin_bit_cast(int, x);
    x += __builtin_bit_cast(float, __builtin_amdgcn_update_dpp(0, v, 0x141, 0xF, 0xF, true));
    return x;
}

#define XB_TMO      128
#define XB_XCNT(j)  (256  + 64 * (j))
#define XB_XSUB(j)  (1280 + 64 * (j))
#define XB_XGEN(j)  (2304 + 64 * (j))
#define XB_TOP      3328
#define XB_TOPGEN   3392
#define XCD_BAR_WORDS 3456
#define XB_SPIN_CAP (1u << 18)
__device__ __forceinline__ unsigned xb_ld(unsigned* p)              { return __hip_atomic_load(p, __ATOMIC_RELAXED, __HIP_MEMORY_SCOPE_AGENT); }
__device__ __forceinline__ unsigned xb_add(unsigned* p, unsigned v) { return __hip_atomic_fetch_add(p, v, __ATOMIC_RELAXED, __HIP_MEMORY_SCOPE_AGENT); }
__device__ __forceinline__ unsigned xb_xcc_id() { return (unsigned)__builtin_amdgcn_s_getreg((3 << 11) | 20) & 0xFu; }
#define XB_SPIN(cond, bar) do { unsigned _sp = 0; while (cond) { __builtin_amdgcn_s_sleep(1); \
    if ((++_sp & 255u) == 0u) { if (xb_ld(&(bar)[XB_TMO])) break; if (_sp > XB_SPIN_CAP) { atomicAdd(&(bar)[XB_TMO], 1u); break; } } } } while (0)
struct XcdBarrier { unsigned* bar; unsigned x; volatile LAS unsigned* st; };
__device__ __forceinline__ XcdBarrier xcd_barrier_post(unsigned* bar, volatile LAS unsigned* st) {
    XcdBarrier b; b.bar = bar; b.x = xb_xcc_id(); b.st = st;
    if (threadIdx.x == 0) (void)xb_add(&bar[XB_XCNT(b.x)], 1u);
    return b;
}
__device__ __forceinline__ void xcd_barrier_complete(unsigned* bar, unsigned x, unsigned& nloc, unsigned& nx) {
    const unsigned G = gridDim.x * gridDim.y * gridDim.z;
    unsigned sum, cnt, mine, sp = 0u;
    for (;;) {
        sum = 0u; cnt = 0u; mine = 0u;
#pragma unroll
        for (unsigned j = 0; j < 16; ++j) { const unsigned c = xb_ld(&bar[XB_XCNT(j)]); sum += c; cnt += (c > 0u) ? 1u : 0u; mine = (j == x) ? c : mine; }
        if (sum == G) break;
        __builtin_amdgcn_s_sleep(1);
        if ((++sp & 255u) == 0u) { if (xb_ld(&bar[XB_TMO])) break; if (sp > XB_SPIN_CAP) { atomicAdd(&bar[XB_TMO], 1u); break; } }
    }
    nloc = mine > 0u ? mine : 1u; nx = cnt > 0u ? cnt : 1u;
}
__device__ __forceinline__ void xcd_barrier(const XcdBarrier& b) {
    asm volatile("s_waitcnt vmcnt(0)" ::: "memory");
    __syncthreads();
    if (threadIdx.x == 0) {
        unsigned* bar = b.bar;
        __builtin_amdgcn_s_waitcnt(0);
        unsigned nloc = b.st[0], nx = b.st[1];
        if (nloc == 0u) { xcd_barrier_complete(bar, b.x, nloc, nx); b.st[0] = nloc; b.st[1] = nx; }
        const unsigned old = xb_add(&bar[XB_XSUB(b.x)], 1u);
        const unsigned gen = old / nloc;
        if (old + 1u == (gen + 1u) * nloc) {
            __builtin_amdgcn_fence(__ATOMIC_RELEASE, "agent");
            asm volatile("s_waitcnt vmcnt(0)" ::: "memory");
            const unsigned og = xb_add(&bar[XB_TOP], 1u);
            const unsigned tg = og / nx;
            if (og + 1u == (tg + 1u) * nx) xb_add(&bar[XB_TOPGEN], 1u);
            else XB_SPIN(xb_ld(&bar[XB_TOPGEN]) == tg, bar);
            __builtin_amdgcn_fence(__ATOMIC_ACQUIRE, "agent");
            xb_add(&bar[XB_XGEN(b.x)], 1u);
            asm volatile("s_waitcnt vmcnt(0)" ::: "memory");
        } else {
            XB_SPIN(xb_ld(&bar[XB_XGEN(b.x)]) == gen, bar);
            __builtin_amdgcn_fence(__ATOMIC_ACQUIRE, "agent");
            asm volatile("s_waitcnt vmcnt(0)" ::: "memory");
        }
    }
    __syncthreads();
}

namespace pg8 {
constexpr int BM = 256, BK = 64, HALF = 128, HTB = HALF * BK * 2, STAGE_BYTES = 8 * HTB, NXCD = 8, WGM = 8;
__device__ __forceinline__ int lds_byte(int r, int c) { const int st = (r >> 4) * 2 + (c >> 5), rr = r & 15, cc = c & 31, ob = rr * 64 + cc * 2; return st * 1024 + (ob ^ (((ob >> 9) & 1) << 5)); }
__device__ __forceinline__ void stage_rc(int b, int& R, int& C) { const int st = b / 1024, sb = b % 1024, swz = sb ^ (((sb >> 9) & 1) << 5); R = (st >> 1) * 16 + swz / 64; C = (st & 1) * 32 + (swz % 64) / 2; }
__device__ __forceinline__ int perm32(int rho) { const int n = rho >> 4, i = rho & 15; return 8 * (i >> 2) + 4 * n + (i & 3); }

struct Unit { int pm, pn, e, lt; };

struct StaticOrder {
    static constexpr bool GATHER = false;
    int nM, nN, nwg, G, c;
    __device__ void init(int M, int N, int G_, int c_) { nM = M / BM; nN = N / BM; nwg = nM * nN; G = G_; c = c_; }
    __device__ __forceinline__ bool next(int i, Unit& u) const {
        const long L = (long)i * G + c; if (L >= nwg) return false;
        int wgid = (int)L; { const int q = nwg / NXCD, r = nwg % NXCD, xcd = wgid % NXCD, off = wgid / NXCD; wgid = (xcd < r ? xcd * (q + 1) : r * (q + 1) + (xcd - r) * q) + off; }
        const int nig = WGM * nN, gid = wgid / nig, fm = gid * WGM, gsz = (nM - fm) < WGM ? (nM - fm) : WGM;
        u.pm = fm + ((wgid % nig) % gsz); u.pn = (wgid % nig) / gsz; u.e = 0; u.lt = 0; return true;
    }
    __device__ __forceinline__ int arow(const Unit& u, int r) const { return u.pm * BM + r; }
    __device__ __forceinline__ void a_ready(const Unit&) const {}
    __device__ __forceinline__ void done(const Unit&) const {}
};
template <bool GATHER_> struct MoeOrder {
    static constexpr bool GATHER = GATHER_;
    const LAS int* tab;
    const int* list;
    int ncol, G, c;
    __device__ __forceinline__ bool next(int i, Unit& u) const {
        if (true) {
            const int L = i * G + c; const int total = tab[32] * ncol; if (L >= total) return false;
            const int rt = (ncol == 8) ? (L >> 3) : (L >> 2); u.pn = L - rt * ncol; u.pm = rt;
            const int ln = threadIdx.x & 63; const int tv = tab[ln < 32 ? ln : 32];
            const unsigned long long bal = __ballot(ln < 32 && tv <= rt);
            const int e = __builtin_popcountll(bal) - 1;
            u.e = e; u.lt = rt - __builtin_amdgcn_readlane(tv, e); return true;
        }
        const int x = c & 7, W = G >> 3; int q = i * W + (c >> 3);
#pragma unroll 1
        for (int k = 0; k < 4; ++k) { const int e = x + 8 * k; const int nt_e = tab[e + 1] - tab[e], sz = nt_e * ncol;
            if (q < sz) { const int lt = q / ncol; u.pn = q - lt * ncol; u.lt = lt; u.e = e; u.pm = tab[e] + lt; return true; }
            q -= sz; }
        return false;
    }
    __device__ __forceinline__ int arow(const Unit& u, int r) const {
        if (!GATHER_) return u.pm * BM + r;
        const int pos = u.lt * BM + r; const int cnt = tab[64 + u.e];
        return pos < cnt ? list[(size_t)u.e * NTOK + pos] : 0;
    }
    unsigned* rtc;
    __device__ __forceinline__ void done(const Unit& u) const {
        if (GATHER_) { asm volatile("s_waitcnt vmcnt(0)" ::: "memory");
            if ((threadIdx.x & 63) == 0) __hip_atomic_fetch_add(rtc + 16 * u.pm, 1u, __ATOMIC_RELAXED, __HIP_MEMORY_SCOPE_AGENT); }
    }
    __device__ __forceinline__ void a_ready(const Unit& u) const {
        if (!GATHER_) {
            if (threadIdx.x < 64) {
                unsigned sp = 0;
                while ((unsigned)__builtin_amdgcn_readfirstlane(__hip_atomic_load(rtc + 16 * u.pm, __ATOMIC_RELAXED, __HIP_MEMORY_SCOPE_AGENT)) < 64u) {
                    __builtin_amdgcn_s_sleep(2); if (++sp > (1u << 22)) break; }
                __builtin_amdgcn_fence(__ATOMIC_ACQUIRE, "agent");
                asm volatile("s_waitcnt vmcnt(0)" ::: "memory");
            }
            asm volatile("" ::: "memory"); __builtin_amdgcn_s_barrier(); asm volatile("" ::: "memory");
        }
    }
};

template <class Epi, class Sched>
__device__ __forceinline__ void gemm_phase(LAS unsigned char* lds, const bf16_t* A, const bf16_t* Bt, const int K, const size_t b_estride_bytes, const Sched& S, const Epi& E) {
    constexpr bool GATHER = Sched::GATHER;
    const int tid = otid(), wid = __builtin_amdgcn_readfirstlane(tid >> 6), lane = tid & 63, wr = wid >> 2, wc = wid & 3, fr = lane & 15, fq = lane >> 4;
    const int nt = K / BK;
    int Rr[2], Cc[2]; unsigned voffA[2], voffB[2];
#pragma unroll
    for (int i = 0; i < 2; ++i) { int R, C; stage_rc(tid * 16 + i * 8192, R, C); const int Rb = Epi::PERM ? ((R & ~31) + perm32(R & 31)) : R;
        Rr[i] = R; Cc[i] = C; voffA[i] = (unsigned)(R * K + C) * 2u; voffB[i] = (unsigned)(Rb * K + C) * 2u; }
    const size_t kstep = (size_t)(BK * 2);
    const size_t hstep = (size_t)HALF * K * 2;
    const size_t tstep = 2 * hstep;
    const unsigned ldsw = (unsigned)wid * 1024u;
    const int aoff = lds_byte(wr * 64 + fr, fq * 8), boff = lds_byte(wc * 32 + fr, fq * 8);
#define PG8_SA(b, h) (((b) * 2 + (h)) * HTB)
#define PG8_SB(b, h) ((4 + (b) * 2 + (h)) * HTB)
#define PG8_STAGE(bufoff, gbase, voff) do { _Pragma("unroll") for (int _i = 0; _i < 2; ++_i) \
        __builtin_amdgcn_global_load_lds((const unsigned*)((const char*)(gbase) + (voff)[_i]), (LAS unsigned*)(lds + (bufoff) + ldsw + _i * 8192), 16, 0, 0); } while (0)
#define PG8_STAGEA(bufoff, uptr, offs, h, kb) do { _Pragma("unroll") for (int _i = 0; _i < 2; ++_i) { const char* _src; \
        if constexpr (GATHER) _src = (const char*)A + (size_t)(offs)[h][_i] + (size_t)(kb); else _src = (uptr) + (size_t)(h) * hstep + (size_t)(kb) + voffA[_i]; \
        __builtin_amdgcn_global_load_lds((const unsigned*)_src, (LAS unsigned*)(lds + (bufoff) + ldsw + _i * 8192), 16, 0, 0); } } while (0)
#define PG8_LDA(dst, b, h) do { _Pragma("unroll") for (int m = 0; m < 4; ++m) _Pragma("unroll") for (int k = 0; k < 2; ++k) dst[m][k] = *(const LAS bf16x8*)(lds + PG8_SA(b, h) + aoff + m * 2048 + k * 1024); } while (0)
#define PG8_LDB(dst, b, h) do { _Pragma("unroll") for (int n = 0; n < 2; ++n) _Pragma("unroll") for (int k = 0; k < 2; ++k) dst[n][k] = *(const LAS bf16x8*)(lds + PG8_SB(b, h) + boff + n * 2048 + k * 1024); } while (0)
#define PG8_MMA(ai, bj, At, Bt_) do { __builtin_amdgcn_s_setprio(1); _Pragma("unroll") for (int m = 0; m < 4; ++m) _Pragma("unroll") for (int n = 0; n < 2; ++n) _Pragma("unroll") for (int k = 0; k < 2; ++k) \
        acc[ai][bj][m][n] = __builtin_amdgcn_mfma_f32_16x16x32_bf16(Bt_[n][k], At[m][k], acc[ai][bj][m][n], 0, 0, 0); __builtin_amdgcn_s_setprio(0); } while (0)
#define PG8_WAIT_V(n) asm volatile("s_waitcnt vmcnt(" #n ")" ::: "memory")
#define PG8_WAIT_L(n) asm volatile("s_waitcnt lgkmcnt(" #n ")" ::: "memory")
#define PG8_BAR __builtin_amdgcn_s_barrier()
#define PG8_SCHED __builtin_amdgcn_sched_barrier(0)
#define PG8_AOFFS(dst, u) do { if constexpr (GATHER) { _Pragma("unroll") for (int _h = 0; _h < 2; ++_h) _Pragma("unroll") for (int _i = 0; _i < 2; ++_i) \
        dst[_h][_i] = ((unsigned)S.arow(u, _h * HALF + Rr[_i]) * (unsigned)K + (unsigned)Cc[_i]) * 2u; } } while (0)
    Unit cur, nxt; int ui = 0;
    if (!S.next(0, cur)) return;
    f32x4 acc[2][2][4][2];
#pragma unroll
    for (int a = 0; a < 2; ++a)
#pragma unroll
        for (int b = 0; b < 2; ++b)
#pragma unroll
            for (int m = 0; m < 4; ++m)
#pragma unroll
                for (int n = 0; n < 2; ++n) acc[a][b][m][n] = (f32x4){0.f, 0.f, 0.f, 0.f};
    bf16x8 At[4][2], B0[2][2], B1[2][2];
    unsigned aoc[2][2] = {{0u, 0u}, {0u, 0u}}, aon[2][2] = {{0u, 0u}, {0u, 0u}};
    PG8_AOFFS(aoc, cur);
    const char* cA = (const char*)A + (size_t)cur.pm * tstep;
    const char* cB = (const char*)Bt + (size_t)cur.e * b_estride_bytes + (size_t)cur.pn * tstep;
    S.a_ready(cur);
    PG8_STAGE(PG8_SB(0, 0), cB, voffB); PG8_STAGEA(PG8_SA(0, 0), cA, aoc, 0, 0); PG8_STAGE(PG8_SB(0, 1), cB + hstep, voffB); PG8_STAGEA(PG8_SA(0, 1), cA, aoc, 1, 0);
    if (wr == 1) PG8_BAR;
    PG8_WAIT_V(4); PG8_BAR;
    PG8_STAGE(PG8_SB(1, 0), cB + kstep, voffB); PG8_STAGEA(PG8_SA(1, 0), cA, aoc, 0, kstep); PG8_STAGE(PG8_SB(1, 1), cB + hstep + kstep, voffB);
    PG8_WAIT_V(6); PG8_BAR;
    for (;;) {
        const bool has_next = S.next(ui + 1, nxt);
        const char* nA = has_next ? (const char*)A + (size_t)nxt.pm * tstep : cA;
        const char* nB = has_next ? (const char*)Bt + (size_t)nxt.e * b_estride_bytes + (size_t)nxt.pn * tstep : cB;
        if constexpr (GATHER) {
            if (has_next) { PG8_AOFFS(aon, nxt); } else {
#pragma unroll
                for (int h = 0; h < 2; ++h)
#pragma unroll
                    for (int i = 0; i < 2; ++i) aon[h][i] = aoc[h][i]; } }
#define PG8_KITER(t) do { \
            const bool last = (t == nt - 2); \
            const size_t k1 = (size_t)(t + 1) * kstep; \
            const size_t k2 = last ? (size_t)0 : (size_t)(t + 2) * kstep; \
            const size_t k3 = k2 + kstep; \
            const char* a2p = last ? nA : cA; \
            unsigned a2o[2][2]; \
_Pragma("unroll") \
            for (int h = 0; h < 2; ++h) \
_Pragma("unroll") \
                for (int i = 0; i < 2; ++i) a2o[h][i] = last ? aon[h][i] : aoc[h][i]; \
            const char* b2 = last ? nB : cB + (size_t)(t + 2) * kstep; const char* b3 = b2 + kstep; \
            if (last && has_next) S.a_ready(nxt); \
            PG8_LDB(B0, 0, 0); PG8_SCHED; PG8_LDA(At, 0, 0); PG8_STAGEA(PG8_SA(1, 1), cA, aoc, 1, k1); \
            PG8_WAIT_L(8); PG8_BAR; PG8_WAIT_L(0); PG8_MMA(0, 0, At, B0); PG8_BAR; PG8_SCHED; \
            PG8_LDB(B1, 0, 1); PG8_STAGE(PG8_SB(0, 0), b2, voffB); \
            PG8_BAR; PG8_WAIT_L(0); PG8_MMA(0, 1, At, B1); PG8_BAR; \
            PG8_LDA(At, 0, 1); PG8_STAGEA(PG8_SA(0, 0), a2p, a2o, 0, k2); \
            PG8_BAR; PG8_WAIT_L(0); PG8_MMA(1, 0, At, B0); PG8_BAR; PG8_SCHED; \
            PG8_STAGE(PG8_SB(0, 1), b2 + hstep, voffB); \
            PG8_WAIT_V(6); PG8_BAR; PG8_MMA(1, 1, At, B1); PG8_BAR; \
            PG8_LDB(B0, 1, 0); PG8_SCHED; PG8_LDA(At, 1, 0); PG8_STAGEA(PG8_SA(0, 1), a2p, a2o, 1, k2); \
            PG8_WAIT_L(8); PG8_BAR; PG8_WAIT_L(0); PG8_MMA(0, 0, At, B0); PG8_BAR; PG8_SCHED; \
            PG8_LDB(B1, 1, 1); PG8_STAGE(PG8_SB(1, 0), b3, voffB); \
            PG8_BAR; PG8_WAIT_L(0); PG8_MMA(0, 1, At, B1); PG8_BAR; \
            PG8_LDA(At, 1, 1); PG8_STAGEA(PG8_SA(1, 0), a2p, a2o, 0, k3); \
            PG8_BAR; PG8_WAIT_L(0); PG8_MMA(1, 0, At, B0); PG8_BAR; PG8_SCHED; \
            PG8_STAGE(PG8_SB(1, 1), b3 + hstep, voffB); \
            PG8_WAIT_V(6); PG8_BAR; PG8_MMA(1, 1, At, B1); PG8_BAR; \
        } while (0)
        if constexpr (Epi::MIDHOOK) {
#pragma unroll 1
            for (int t = 0; t < Epi::T1; t += 2) PG8_KITER(t);
            asm volatile("" ::: "memory"); __builtin_amdgcn_sched_barrier(0); E.mid(acc, cur, 0, wr, wc, fr, fq); asm volatile("" ::: "memory"); __builtin_amdgcn_sched_barrier(0);
#pragma unroll 1
            for (int t = Epi::T1; t < Epi::T2; t += 2) PG8_KITER(t);
            asm volatile("" ::: "memory"); __builtin_amdgcn_sched_barrier(0); E.mid(acc, cur, 1, wr, wc, fr, fq); asm volatile("" ::: "memory"); __builtin_amdgcn_sched_barrier(0);
#pragma unroll 1
            for (int t = Epi::T2; t < nt; t += 2) PG8_KITER(t);
        } else {
#pragma unroll 1
            for (int t = 0; t < nt; t += 2) PG8_KITER(t);
        }
#undef PG8_KITER
        E(acc, cur, wr, wc, fr, fq); S.done(cur);
        if (!has_next) break;
#pragma unroll
        for (int a = 0; a < 2; ++a)
#pragma unroll
            for (int b = 0; b < 2; ++b)
#pragma unroll
                for (int m = 0; m < 4; ++m)
#pragma unroll
                    for (int n = 0; n < 2; ++n) acc[a][b][m][n] = (f32x4){0.f, 0.f, 0.f, 0.f};
        cur = nxt; cA = nA; cB = nB; ++ui;
#pragma unroll
        for (int h = 0; h < 2; ++h)
#pragma unroll
            for (int i = 0; i < 2; ++i) aoc[h][i] = aon[h][i];
    }
    PG8_WAIT_V(0);
    if (wr == 0) PG8_BAR;
    PG8_BAR;
#undef PG8_SA
#undef PG8_SB
#undef PG8_STAGE
#undef PG8_STAGEA
#undef PG8_LDA
#undef PG8_LDB
#undef PG8_MMA
#undef PG8_WAIT_V
#undef PG8_WAIT_L
#undef PG8_BAR
#undef PG8_SCHED
#undef PG8_AOFFS
}

typedef f32x4 Acc[2][2][4][2];

struct EpiProj {
    static constexpr bool PERM = true, MIDHOOK = false;
    bf16_t* O; int ld; int sg_from;
    __device__ __forceinline__ void operator()(const Acc& acc, const Unit& u, int wr, int wc, int fr, int fq) const {
        const int row0 = u.pm * BM + wr * 64 + fr, col0 = u.pn * BM + wc * 32 + 8 * fq; const bool sg = u.pn >= sg_from;
#pragma unroll
        for (int ai = 0; ai < 2; ++ai)
#pragma unroll
            for (int m = 0; m < 4; ++m) { bf16_t* rowp = O + (size_t)(row0 + ai * HALF + m * 16) * ld + col0;
#pragma unroll
                for (int bj = 0; bj < 2; ++bj) { f32x4 v0 = acc[ai][bj][m][0], v1 = acc[ai][bj][m][1];
                    if (sg) {
#pragma unroll
                        for (int j = 0; j < 4; ++j) { v0[j] = sigmoidf_(v0[j]); v1[j] = sigmoidf_(v1[j]); } }
                    u32x4 w; w.x = pk2(v0[0], v0[1]); w.y = pk2(v0[2], v0[3]); w.z = pk2(v1[0], v1[1]); w.w = pk2(v1[2], v1[3]);
                    *(u32x4*)(rowp + bj * HALF) = w; } }
    }
};
template <int SEG> struct EpiBranch {
    static constexpr bool PERM = true, MIDHOOK = false;
    const bf16_t* P; float* MF; bf16_t* MG;
    __device__ __forceinline__ void operator()(const Acc& acc, const Unit& u, int wr, int wc, int fr, int fq) const {
        const int row0 = u.pm * BM + wr * 64 + fr, col0 = u.pn * BM + wc * 32 + 8 * fq;
#pragma unroll
        for (int ai = 0; ai < 2; ++ai)
#pragma unroll
            for (int m = 0; m < 4; ++m) { const size_t r = (size_t)(row0 + ai * HALF + m * 16);
                asm volatile("" ::: "memory");
#pragma unroll
                for (int bj = 0; bj < 2; ++bj) { const int c = col0 + bj * HALF;
                    const u32x4 g = *(const u32x4*)(P + r * PLD + C_G + SEG * 1024 + c);
                    f32x4 v0 = acc[ai][bj][m][0], v1 = acc[ai][bj][m][1];
                    v0[0] *= bflo(g.x); v0[1] *= bfhi(g.x); v0[2] *= bflo(g.y); v0[3] *= bfhi(g.y);
                    v1[0] *= bflo(g.z); v1[1] *= bfhi(g.z); v1[2] *= bflo(g.w); v1[3] *= bfhi(g.w);
                    float* mp = MF + r * DM + c;
                    if (SEG > 0) { v0 += *(const f32x4*)mp; v1 += *(const f32x4*)(mp + 4); }
                    if (SEG < 2) { *(f32x4*)mp = v0; *(f32x4*)(mp + 4) = v1; }
                    else { u32x4 w; w.x = pk2(v0[0], v0[1]); w.y = pk2(v0[2], v0[3]); w.z = pk2(v1[0], v1[1]); w.w = pk2(v1[2], v1[3]); *(u32x4*)(MG + r * DM + c) = w; } } }
    }
};
struct EpiBranchM {
    static constexpr bool PERM = true, MIDHOOK = true;
    static constexpr int T1 = 4, T2 = 16;
    const bf16_t* P; bf16_t* MG;
    __device__ __forceinline__ void mid(Acc& acc, const Unit& u, int seg, int wr, int wc, int fr, int fq) const {
        const unsigned off0 = ((unsigned)(u.pm * BM + wr * 64 + fr) * (unsigned)PLD + (unsigned)(C_G + seg * 1024 + u.pn * BM + wc * 32 + 8 * fq)) * 2u;
        const char* Pb = (const char*)P;
#pragma unroll
        for (int ai = 0; ai < 2; ++ai)
#pragma unroll
            for (int m = 0; m < 4; ++m) {
#pragma unroll
                for (int bj = 0; bj < 2; ++bj) { const unsigned off = off0 + (unsigned)(((ai * HALF + m * 16) * PLD + bj * HALF) * 2);
                    const u32x4 gp = *(const u32x4*)(Pb + off), gn = *(const u32x4*)(Pb + off + 2048u);
#pragma unroll
                    for (int q = 0; q < 4; ++q) { const float r0 = bflo(gp[q]) * __builtin_amdgcn_rcpf(fmaxf(bflo(gn[q]), 1e-30f)), r1 = bfhi(gp[q]) * __builtin_amdgcn_rcpf(fmaxf(bfhi(gn[q]), 1e-30f));
                        acc[ai][bj][m][q >> 1][2 * (q & 1)] *= r0; acc[ai][bj][m][q >> 1][2 * (q & 1) + 1] *= r1; }
                    asm volatile("" : "+v"(acc[ai][bj][m][0]), "+v"(acc[ai][bj][m][1]) :: "memory"); } }
    }
    __device__ __forceinline__ void operator()(const Acc& acc, const Unit& u, int wr, int wc, int fr, int fq) const {
        const int row0 = u.pm * BM + wr * 64 + fr, col0 = u.pn * BM + wc * 32 + 8 * fq;
#pragma unroll
        for (int ai = 0; ai < 2; ++ai)
#pragma unroll
            for (int m = 0; m < 4; ++m) { const size_t r = (size_t)(row0 + ai * HALF + m * 16);
                asm volatile("" ::: "memory");
#pragma unroll
                for (int bj = 0; bj < 2; ++bj) { const int c = col0 + bj * HALF;
                    const u32x4 g = *(const u32x4*)(P + r * PLD + C_G + 2 * 1024 + c);
                    f32x4 v0 = acc[ai][bj][m][0], v1 = acc[ai][bj][m][1];
                    v0[0] *= bflo(g.x); v0[1] *= bfhi(g.x); v0[2] *= bflo(g.y); v0[3] *= bfhi(g.y);
                    v1[0] *= bflo(g.z); v1[1] *= bfhi(g.z); v1[2] *= bflo(g.w); v1[3] *= bfhi(g.w);
                    u32x4 w; w.x = pk2(v0[0], v0[1]); w.y = pk2(v0[2], v0[3]); w.z = pk2(v1[0], v1[1]); w.w = pk2(v1[2], v1[3]); *(u32x4*)(MG + r * DM + c) = w; } }
    }
};
struct EpiOut {
    static constexpr bool PERM = false, MIDHOOK = false;
    const float* xsrc; float* X; const float* gt;
    __device__ __forceinline__ void operator()(const Acc& acc, const Unit& u, int wr, int wc, int fr, int fq) const {
        const int row0 = u.pm * BM + wr * 64 + fr, col0 = u.pn * BM + wc * 32 + 4 * fq;
        const float* gp = gt + (size_t)((u.pm * BM) >> 11) * 6144 + col0;
        f32x4 gv[2][2];
#pragma unroll
        for (int bj = 0; bj < 2; ++bj)
#pragma unroll
            for (int n = 0; n < 2; ++n) gv[bj][n] = *(const f32x4*)(gp + bj * HALF + n * 16);
#pragma unroll
        for (int ai = 0; ai < 2; ++ai)
#pragma unroll
            for (int m = 0; m < 4; ++m) { const size_t o = (size_t)(row0 + ai * HALF + m * 16) * DM + col0;
#pragma unroll
                for (int bj = 0; bj < 2; ++bj)
#pragma unroll
                    for (int n = 0; n < 2; ++n) { const f32x4 xv = *(const f32x4*)(xsrc + o + bj * HALF + n * 16);
                        *(f32x4*)(X + o + bj * HALF + n * 16) = xv + gv[bj][n] * acc[ai][bj][m][n]; } }
    }
};
struct EpiMoe1 {
    static constexpr bool PERM = true, MIDHOOK = false;
    bf16_t* ACT; const float* b1;
    __device__ __forceinline__ void operator()(const Acc& acc, const Unit& u, int wr, int wc, int fr, int fq) const {
        const int row0 = u.pm * BM + wr * 64 + fr, col0 = u.pn * BM + wc * 32 + 8 * fq;
        const float* bp = b1 + (size_t)u.e * (2 * FF) + col0;
        f32x4 bv[2][2];
#pragma unroll
        for (int bj = 0; bj < 2; ++bj)
#pragma unroll
            for (int n = 0; n < 2; ++n) bv[bj][n] = *(const f32x4*)(bp + bj * HALF + 4 * n);
#pragma unroll
        for (int ai = 0; ai < 2; ++ai)
#pragma unroll
            for (int m = 0; m < 4; ++m) { bf16_t* rowp = ACT + (size_t)(row0 + ai * HALF + m * 16) * FF + (col0 >> 1);
#pragma unroll
                for (int bj = 0; bj < 2; ++bj) { const f32x4 v0 = acc[ai][bj][m][0] + bv[bj][0], v1 = acc[ai][bj][m][1] + bv[bj][1];
                    float a[4];
#pragma unroll
                    for (int q = 0; q < 4; ++q) { const float gl = (q < 2) ? v0[2 * q] : v1[2 * q - 4], ln = (q < 2) ? v0[2 * q + 1] : v1[2 * q - 3];
                        const float xg = fminf(gl, 7.0f), xl = fminf(fmaxf(ln, -7.0f), 7.0f);
                        a[q] = xg * sigmoidf_(1.702f * xg) * (xl + 1.0f); }
                    const unsigned long long w = (unsigned long long)pk2(a[0], a[1]) | ((unsigned long long)pk2(a[2], a[3]) << 32);
                    __hip_atomic_store((unsigned long long*)(rowp + bj * (HALF / 2)), w, __ATOMIC_RELAXED, __HIP_MEMORY_SCOPE_AGENT); } }
    }
};
struct EpiMoe2 {
    static constexpr bool PERM = true, MIDHOOK = false;
    bf16_t* Y; const float* b2;
    __device__ __forceinline__ void operator()(const Acc& acc, const Unit& u, int wr, int wc, int fr, int fq) const {
        const int row0 = u.pm * BM + wr * 64 + fr, col0 = u.pn * BM + wc * 32 + 8 * fq;
        const float* bp = b2 + (size_t)u.e * DM + col0;
        f32x4 bv[2][2];
#pragma unroll
        for (int bj = 0; bj < 2; ++bj)
#pragma unroll
            for (int n = 0; n < 2; ++n) bv[bj][n] = *(const f32x4*)(bp + bj * HALF + 4 * n);
#pragma unroll
        for (int ai = 0; ai < 2; ++ai)
#pragma unroll
            for (int m = 0; m < 4; ++m) { bf16_t* rowp = Y + (size_t)(row0 + ai * HALF + m * 16) * DM + col0;
#pragma unroll
                for (int bj = 0; bj < 2; ++bj) { const f32x4 v0 = acc[ai][bj][m][0] + bv[bj][0], v1 = acc[ai][bj][m][1] + bv[bj][1];
                    u32x4 w; w.x = pk2(v0[0], v0[1]); w.y = pk2(v0[2], v0[3]); w.z = pk2(v1[0], v1[1]); w.w = pk2(v1[2], v1[3]);
                    *(u32x4*)(rowp + bj * HALF) = w; } }
    }
};
}

struct Args { const float* in[32]; float* out; unsigned char* ws; int ph_lo, ph_hi; };
enum { I_X = 0, I_C, I_WMOD, I_BMOD, I_N1G, I_N2G, I_WIN, I_MU, I_W0, I_WUP, I_A0, I_AUP, I_GUP, I_KK, I_KA, I_RK, I_LNG, I_LNB, I_DLAM, I_SUBG, I_RELB, I_WBA, I_WBB, I_WBC, I_WOUT, I_RW, I_RB, I_W1, I_B1, I_W2, I_B2, I_FNG };

__device__ __forceinline__ void lds_fence() { asm volatile("s_waitcnt lgkmcnt(0)" ::: "memory"); }

__device__ __forceinline__ void tr_item(const float* W, int ldw, int ncols, bf16_t* WT, int K, LAS float* scr, int item, int lane) {
    const int nblk = ncols >> 5, kb = item / nblk, nb = item - kb * nblk, k0 = 64 * kb, n0 = 32 * nb;
#pragma unroll 8
    for (int i = 0; i < 32; ++i) { const int kk = 2 * i + (lane >> 5); scr[kk * 33 + (lane & 31)] = W[(size_t)(k0 + kk) * ldw + n0 + (lane & 31)]; }
    lds_fence();
    const int c = lane & 7;
#pragma unroll
    for (int j = 0; j < 4; ++j) { const int n = (lane >> 3) + 8 * j; const LAS float* s = scr + (8 * c) * 33 + n;
        u32x4 o; o.x = pk2(s[0 * 33], s[1 * 33]); o.y = pk2(s[2 * 33], s[3 * 33]); o.z = pk2(s[4 * 33], s[5 * 33]); o.w = pk2(s[6 * 33], s[7 * 33]);
        *(u32x4*)(WT + (size_t)(n0 + n) * K + k0 + 8 * c) = o; }
    lds_fence();
}
__device__ __forceinline__ int t5_bucket(int rel) {
    const int ret = rel > 0 ? 16 : 0; const int n = rel < 0 ? -rel : rel;
    int v;
    if (n < 8) v = n; else if (n < 12) v = 8; else if (n < 16) v = 9; else if (n < 23) v = 10; else if (n < 32) v = 11;
    else if (n < 46) v = 12; else if (n < 64) v = 13; else if (n < 91) v = 14; else v = 15;
    return ret + v;
}
__device__ __forceinline__ void phase_p0(const Args& a, LAS unsigned char* lds) {
    const int tid = otid(), lane = tid & 63, wave = tid >> 6, G = gridDim.x;
    unsigned char* ws = a.ws;
    {
        LAS float* scr = (LAS float*)(lds + wave * 8448);
        const int gw = blockIdx.x * 8 + wave, NGW = G * 8;
        constexpr int NITEMS = 65536 + 32768 + 2 * 6592;
        for (int it = gw; it < NITEMS; it += NGW) {
            int r = it;
            if (r < 65536) { const int mat = r >> 10; tr_item(a.in[I_W1] + (size_t)mat * DM * 2 * FF, 2 * FF, 2 * FF, (bf16_t*)(ws + WS_W1) + (size_t)mat * 2 * FF * DM, DM, scr, r & 1023, lane); continue; }
            r -= 65536;
            if (r < 32768) { const int mat = r >> 9; tr_item(a.in[I_W2] + (size_t)mat * FF * DM, DM, DM, (bf16_t*)(ws + WS_W2) + (size_t)mat * DM * FF, FF, scr, r & 511, lane); continue; }
            r -= 32768;
            const int l = r / 6592; r -= l * 6592;
            if (r < 2496) { tr_item(a.in[I_WIN] + (size_t)l * DM * IN_COLS, IN_COLS, 4992, (bf16_t*)(ws + WS_WIN) + (size_t)l * PLD * DM, DM, scr, r, lane); continue; }
            r -= 2496;
            if (r < 2688) { tr_item(a.in[I_WIN] + (size_t)l * DM * IN_COLS + 4992, IN_COLS, 5376, (bf16_t*)(ws + WS_WIN) + (size_t)l * PLD * DM + (size_t)5120 * DM, DM, scr, r, lane); continue; }
            r -= 2688;
            if (r < 128) { tr_item(a.in[I_WBA] + (size_t)l * 256 * DM, DM, DM, (bf16_t*)(ws + WS_WA) + (size_t)l * DM * 1792, 1792, scr, r, lane); continue; }
            r -= 128;
            if (r < 384) { tr_item(a.in[I_WBB] + (size_t)l * 768 * DM, DM, DM, (bf16_t*)(ws + WS_WA) + (size_t)l * DM * 1792 + 256, 1792, scr, r, lane); continue; }
            r -= 384;
            if (r < 384) { tr_item(a.in[I_WBC] + (size_t)l * 768 * DM, DM, DM, (bf16_t*)(ws + WS_WA) + (size_t)l * DM * 1792 + 1024, 1792, scr, r, lane); continue; }
            r -= 384;
            tr_item(a.in[I_WOUT] + (size_t)l * DM * DM, DM, DM, (bf16_t*)(ws + WS_WO) + (size_t)l * DM * DM, DM, scr, r, lane);
        }
        for (int i = blockIdx.x * 512 + tid; i < 2 * 128 * DM / 8; i += G * 512) {
            const int l = i / (128 * DM / 8), o = i - l * (128 * DM / 8);
            *(u32x4*)((bf16_t*)(ws + WS_WIN) + (size_t)l * PLD * DM + (size_t)4992 * DM + (size_t)o * 8) = (u32x4){0u, 0u, 0u, 0u};
        }
    }
    {
        bf16_t* WT = (bf16_t*)(ws + WS_MISC + MISC_WUPT); bf16_t* AT = (bf16_t*)(ws + WS_MISC + MISC_AUPT);
        for (int i = blockIdx.x * 512 + tid; i < 2 * 2 * 12 * 4096; i += G * 512) {
            const int j = i & 63, k = (i >> 6) & 63, hd = (i >> 12) % 12, ld = i / (12 * 4096);
            const size_t src = ((size_t)ld * 64 + j) * RW + hd * 64 + k;
            WT[i] = (bf16_t)(pk2(a.in[I_WUP][src], 0.f) & 0xffffu); AT[i] = (bf16_t)(pk2(a.in[I_AUP][src], 0.f) & 0xffffu);
        }
    }
    {
        bf16_t* GT = (bf16_t*)(ws + WS_MISC + MISC_GUPT);
        for (int i = blockIdx.x * 512 + tid; i < 2 * 768 * 256; i += G * 512) {
            const int k = i & 255, n = (i >> 8) % 768, l2 = i / (768 * 256);
            GT[i] = k < 128 ? f2bf(a.in[I_GUP][((size_t)l2 * 128 + k) * RW + n]) : (bf16_t)0;
        }
    }
    __syncthreads();
    if ((int)blockIdx.x < 192) {
        LAS float* sc = (LAS float*)(lds + 69632);
        LAS float* red = (LAS float*)(lds + 102400);
        for (int i = tid; i < NB * DM; i += 512) { const float v = a.in[I_C][i]; sc[i] = v / (1.f + expf(-v)); }
        __syncthreads();
        float* mod = (float*)(ws + WS_MISC + MISC_MOD);
        for (int j = blockIdx.x; j < 192; j += G) {
            const int l = j / 96, n0 = (j - l * 96) * 64, jj = tid & 63, ks = tid >> 6;
            float acc[8];
#pragma unroll
            for (int b = 0; b < 8; ++b) acc[b] = 0.f;
            const float* wp = a.in[I_WMOD] + ((size_t)l * DM + ks * 128) * 6144 + n0 + jj;
            for (int k = 0; k < 128; ++k) { const float w = wp[(size_t)k * 6144];
#pragma unroll
                for (int b = 0; b < 8; ++b) acc[b] += sc[b * DM + ks * 128 + k] * w; }
#pragma unroll
            for (int b = 0; b < 8; ++b) red[(ks * 8 + b) * 64 + jj] = acc[b];
            __syncthreads();
            { const int b = tid >> 6; float s = 0.f;
#pragma unroll
              for (int k2 = 0; k2 < 8; ++k2) s += red[(k2 * 8 + b) * 64 + jj];
              mod[((size_t)l * 8 + b) * 6144 + n0 + jj] = s + a.in[I_BMOD][(size_t)l * 6144 + n0 + jj]; }
            __syncthreads();
        }
    }
    if ((int)blockIdx.x == G - 1) {
        float* lam = (float*)(ws + WS_MISC + MISC_LAM);
        if (tid < 2) { const int l = tid; const float* dl = a.in[I_DLAM] + (size_t)l * 256; float s01 = 0.f, s23 = 0.f;
            for (int d = 0; d < 64; ++d) { s01 += dl[d] * dl[64 + d]; s23 += dl[128 + d] * dl[192 + d]; }
            const float li = 0.8f - 0.6f * expf(-0.3f * (float)l);
            lam[l] = expf(s01) - expf(s23) + li; lam[2 + l] = li; }
        float* bA = (float*)(ws + WS_MISC + MISC_BIASA);
        for (int i = tid; i < 12 * 129; i += 512) { const int head = i / 129, jj = i - head * 129, g = head >> 2; const int dil = (g == 0) ? 1 : (g == 1) ? 4 : 16;
            bA[i] = a.in[I_RELB][t5_bucket((jj - 64) * dil) * 18 + head] * LOG2E; }
        float* bC = (float*)(ws + WS_MISC + MISC_BIASC);
        for (int i = tid; i < 6 * 257; i += 512) { const int h = i / 257, rel = i - h * 257 - 128;
            bC[i] = a.in[I_RELB][t5_bucket(rel) * 18 + 12 + h] * LOG2E; }
    }
}

__device__ __forceinline__ float row_rstd(const f32x4 (&v)[4], float eps) {
    float s = 0.f;
#pragma unroll
    for (int j = 0; j < 4; ++j) s += (v[j].x * v[j].x + v[j].y * v[j].y) + (v[j].z * v[j].z + v[j].w * v[j].w);
    return rsqrtf(wave_sum(s) * (1.f / DM) + eps);
}
__device__ __forceinline__ void norm_mod_store(const f32x4 (&v)[4], float rstd, const float* g, const float* sc, const float* sh, bf16_t* orow, int lane) {
#pragma unroll
    for (int j = 0; j < 4; ++j) { const int c = 4 * lane + 256 * j;
        const f32x4 gv = *(const f32x4*)(g + c), scv = *(const f32x4*)(sc + c), shv = *(const f32x4*)(sh + c);
        const f32x4 y = v[j] * rstd * gv * (scv + 1.0f) + shv;
        u32x2 w; w.x = pk2(y.x, y.y); w.y = pk2(y.z, y.w);
        *(u32x2*)(orow + c) = w; }
}
__device__ __forceinline__ void phase_norm1(const Args& a, int l) {
    const int tid = otid(), lane = tid & 63, wave = tid >> 6;
    const float* mod = (const float*)(a.ws + WS_MISC + MISC_MOD) + (size_t)l * 8 * 6144;
    bf16_t* H = (bf16_t*)(a.ws + WS_H);
    for (int t = blockIdx.x * 8 + wave; t < NTOK; t += gridDim.x * 8) {
        const float* xr = a.in[I_X] + (size_t)t * DM; f32x4 v[4];
#pragma unroll
        for (int j = 0; j < 4; ++j) v[j] = *(const f32x4*)(xr + 4 * lane + 256 * j);
        const float rstd = row_rstd(v, 1e-6f);
        const float* mb = mod + (size_t)(t >> 11) * 6144;
        norm_mod_store(v, rstd, a.in[I_N1G] + (size_t)l * DM, mb + 1024, mb, H + (size_t)t * DM, lane);
    }
}

__device__ __forceinline__ void swa_wave_unit(const bf16_t* P, float* OAG, float* LSE, const LAS float* biasA, LAS unsigned char* vbuf, int u, int lane) {
    const int b = u / 768; const int rem = u - b * 768; const int head = rem >> 6, s = rem & 63;
    const int g = head >> 2, hh = head & 3;
    const int dsh = (g == 0) ? 0 : (g == 1) ? 2 : 4;
    const int L = NT >> dsh, nmbsh = 6 - dsh;
    const int r = s >> nmbsh, mb = s & ((1 << nmbsh) - 1);
    const int r32 = lane & 31, hi = lane >> 5;
    const size_t tq = (size_t)b * NT + ((mb * 32 + r32) << dsh) + r;
    bf16x8 qf[4];
    { const bf16_t* qp = P + tq * PLD + C_AQ + head * 64 + 8 * hi;
#pragma unroll
      for (int s4 = 0; s4 < 4; ++s4) qf[s4] = *(const bf16x8*)(qp + 16 * s4); }
    f32x16 o[2]; o[0] = (f32x16){}; o[1] = (f32x16){};
    float m = -1e30f, lsum = 0.f;
    const float SC = 0.125f * LOG2E;
    const LAS float* bh = biasA + head * 129 + 64;
    const int trbase = (4 * hi + ((lane & 15) >> 2)) * 144 + (16 * ((lane >> 4) & 1) + 4 * (lane & 3)) * 2;
    const int kt_lo = (-mb > -2) ? -mb : -2, kt_hi = ((L >> 5) - 1 - mb < 2) ? (L >> 5) - 1 - mb : 2;
    bf16x8 kfn[4]; u32x4 vn[4];
#define SWA_LOAD(ktx) do { const int _m0 = mb * 32 + (ktx) * 32; \
        { int km = _m0 + r32; km = km < 0 ? 0 : (km > L - 1 ? L - 1 : km); \
          const bf16_t* kp = P + ((size_t)b * NT + (km << dsh) + r) * PLD + C_AK + head * 64 + 8 * hi; \
          _Pragma("unroll") for (int s4 = 0; s4 < 4; ++s4) kfn[s4] = *(const bf16x8*)(kp + 16 * s4); } \
        _Pragma("unroll") for (int c4 = 0; c4 < 4; ++c4) { const int id = lane + 64 * c4, row = id >> 3, ch = id & 7; \
            int vm = _m0 + row; vm = vm < 0 ? 0 : (vm > L - 1 ? L - 1 : vm); \
            vn[c4] = *(const u32x4*)(P + ((size_t)b * NT + (vm << dsh) + r) * PLD + C_AV + head * 64 + ch * 8); } } while (0)
    SWA_LOAD(kt_lo);
    for (int kt = kt_lo; kt <= kt_hi; ++kt) {
        const int m0 = mb * 32 + kt * 32;
        bf16x8 kf[4];
#pragma unroll
        for (int s4 = 0; s4 < 4; ++s4) kf[s4] = kfn[s4];
        asm volatile("" ::: "memory");
#pragma unroll
        for (int c4 = 0; c4 < 4; ++c4) { const int id = lane + 64 * c4, row = id >> 3, ch = id & 7; *(LAS u32x4*)(vbuf + row * 144 + ch * 16) = vn[c4]; }
        if (kt < kt_hi) SWA_LOAD(kt + 1);
        f32x16 sacc = (f32x16){};
#pragma unroll
        for (int s4 = 0; s4 < 4; ++s4) sacc = __builtin_amdgcn_mfma_f32_32x32x16_bf16(kf[s4], qf[s4], sacc, 0, 0, 0);
        float x[16]; float mx = -1e30f;
#pragma unroll
        for (int rg = 0; rg < 16; ++rg) { const int kvl = crow(rg, hi), km = m0 + kvl, j = kt * 32 + kvl - r32;
            const bool valid = (km >= 0) && (km < L) && (j >= -64) && (j <= 64);
            const int jc = j < -64 ? -64 : (j > 64 ? 64 : j);
            const float xv = sacc[rg] * SC + bh[jc];
            x[rg] = valid ? xv : -1e30f; mx = fmaxf(mx, x[rg]); }
        mx = fmaxf(mx, __shfl_xor(mx, 32));
        const float mn = fmaxf(m, mx), alpha = __builtin_amdgcn_exp2f(m - mn); m = mn;
        float ps = 0.f;
#pragma unroll
        for (int rg = 0; rg < 16; ++rg) { x[rg] = __builtin_amdgcn_exp2f(x[rg] - mn); ps += x[rg]; }
        lsum = lsum * alpha + ps;
#pragma unroll
        for (int rg = 0; rg < 16; ++rg) { o[0][rg] *= alpha; o[1][rg] *= alpha; }
        u32x4 pw[2];
#pragma unroll
        for (int s2 = 0; s2 < 2; ++s2) { pw[s2].x = pk2(x[8 * s2 + 0], x[8 * s2 + 1]); pw[s2].y = pk2(x[8 * s2 + 2], x[8 * s2 + 3]); pw[s2].z = pk2(x[8 * s2 + 4], x[8 * s2 + 5]); pw[s2].w = pk2(x[8 * s2 + 6], x[8 * s2 + 7]); }
        lds_fence();
#pragma unroll
        for (int db = 0; db < 2; ++db)
#pragma unroll
            for (int s2 = 0; s2 < 2; ++s2) {
                const s16x4 lo = vtr(vbuf + trbase + (16 * s2) * 144 + db * 64);
                const s16x4 hi4 = vtr(vbuf + trbase + (16 * s2 + 8) * 144 + db * 64);
                const bf16x8 af = (bf16x8){lo[0], lo[1], lo[2], lo[3], hi4[0], hi4[1], hi4[2], hi4[3]};
                o[db] = __builtin_amdgcn_mfma_f32_32x32x16_bf16(af, __builtin_bit_cast(bf16x8, pw[s2]), o[db], 0, 0, 0);
            }
        asm volatile("" ::: "memory");
    }
#undef SWA_LOAD
    const float lt = lsum + __shfl_xor(lsum, 32);
    const float inv = 1.f / lt;
    bf16_t* op = (bf16_t*)OAG + ((size_t)g * NTOK + tq) * 256 + hh * 64;
#pragma unroll
    for (int db = 0; db < 2; ++db)
#pragma unroll
        for (int i = 0; i < 4; ++i) { u32x2 w; w.x = pk2(o[db][4 * i] * inv, o[db][4 * i + 1] * inv); w.y = pk2(o[db][4 * i + 2] * inv, o[db][4 * i + 3] * inv);
            *(u32x2*)(op + db * 32 + 8 * i + 4 * hi) = w; }
    if (hi == 0) LSE[((size_t)g * NTOK + tq) * 4 + hh] = m + __log2f(lt);
}
__device__ __forceinline__ void phase_swa(const Args& a, LAS unsigned char* lds) {
    const int tid = otid(), lane = tid & 63, wave = tid >> 6;
    LAS float* bA = (LAS float*)(lds + 40960);
    const float* bAg = (const float*)(a.ws + WS_MISC + MISC_BIASA);
    for (int i = tid; i < 12 * 129; i += 512) bA[i] = bAg[i];
    __syncthreads();
    for (int item = blockIdx.x; item < 768; item += gridDim.x)
        swa_wave_unit((const bf16_t*)(a.ws + WS_PROJ), (float*)(a.ws + WS_OAG), (float*)(a.ws + WS_LSE), bA, lds + wave * 4608, item * 8 + wave, lane);
    __syncthreads();
}

constexpr int RLD = 144, RMAT = 64 * RLD;
constexpr int R_P = 0, R_Q = 4 * RMAT, R_M = R_Q + 2 * 17408;
constexpr int R_WD = R_P, R_AD = R_P + RMAT, R_WUP = R_P + 2 * RMAT, R_AUP = R_P + 3 * RMAT;
constexpr int R_LK = R_P, R_RK = R_P + RMAT, R_RB = R_P + 2 * RMAT, R_TT = R_P + 3 * RMAT;
constexpr int R_ZW = R_Q, R_ZA = R_Q + 17408, R_LBF = R_Q, R_SEG = R_ZA, R_GC = R_ZA + 2048, R_W1T = R_ZA + 4096;
constexpr int R_A = R_M, R_B = R_M + 2 * RMAT, R_BP = R_M + 3 * RMAT, R_K = R_M + 4 * RMAT, R_KP = R_M + 5 * RMAT, R_RHO = R_M + 6 * RMAT, R_V = R_M + 7 * RMAT;
constexpr int R_UT = R_B, R_TAT = R_K;
constexpr int R_TMP0 = R_SEG, R_TMP1 = R_ZA + 13312, R_TMP2 = R_ZA + 13312 + 2048;
constexpr int R_PAR = R_M + 8 * RMAT, NPAR = 960;
static_assert(R_PAR + 2 * NPAR * 4 <= LDS_STAGE, "R1 LDS");

template <bool XT, bool YT>
__device__ __forceinline__ f32x16 tile64x(const LAS unsigned char* XM, int x0, const LAS unsigned char* YM, int y0, int lane, f32x16 acc) {
    const int r32 = lane & 31, hi = lane >> 5;
    const int trofs = ((lane & 15) >> 2) * RLD + (16 * ((lane >> 4) & 1) + 4 * (lane & 3)) * 2;
#pragma unroll
    for (int s4 = 0; s4 < 4; ++s4) {
        bf16x8 xa, yb;
        if (!XT) xa = *(const LAS bf16x8*)(XM + (x0 + r32) * RLD + 32 * s4 + 16 * hi);
        else { const s16x4 lo = vtr(XM + (16 * s4 + 8 * hi) * RLD + trofs + 2 * x0), h4 = vtr(XM + (16 * s4 + 8 * hi + 4) * RLD + trofs + 2 * x0);
               xa = (bf16x8){lo[0], lo[1], lo[2], lo[3], h4[0], h4[1], h4[2], h4[3]}; }
        if (!YT) yb = *(const LAS bf16x8*)(YM + (y0 + r32) * RLD + 32 * s4 + 16 * hi);
        else { const s16x4 lo = vtr(YM + (16 * s4 + 8 * hi) * RLD + trofs + 2 * y0), h4 = vtr(YM + (16 * s4 + 8 * hi + 4) * RLD + trofs + 2 * y0);
               yb = (bf16x8){lo[0], lo[1], lo[2], lo[3], h4[0], h4[1], h4[2], h4[3]}; }
        acc = __builtin_amdgcn_mfma_f32_32x32x16_bf16(xa, yb, acc, 0, 0, 0);
    }
    return acc;
}
template <class MP>
__device__ __forceinline__ void shift8r(const u32x4 c, u32x4 m, u32x4 n, bool hm, bool hn, MP mu0, MP mu1, float (&o)[8]) {
    const unsigned mm = hm ? 0xffffffffu : 0u, nm = hn ? 0xffffffffu : 0u;
    m = m & mm; n = n & nm;
#pragma unroll
    for (int q = 0; q < 4; ++q) {
        const float pl = bflo(c[q]), ph = bfhi(c[q]);
        o[2 * q] = pl + mu0[2 * q] * (bflo(m[q]) - pl) + mu1[2 * q] * (bflo(n[q]) - pl);
        o[2 * q + 1] = ph + mu0[2 * q + 1] * (bfhi(m[q]) - ph) + mu1[2 * q + 1] * (bfhi(n[q]) - ph);
    }
}
__device__ __forceinline__ float r1_param(const Args& a, int l, int h, int dir, int idx) {
    const int j = idx & 63, row = idx >> 6;
    if (row < 10) { const int g = row >> 1, which = row & 1; const int col = (g < 3 ? g * 768 + h * 64 : (g == 3 ? 2304 : 2432) + dir * 64) + j;
        return a.in[I_MU][(size_t)l * 2 * RSTR + (size_t)which * RSTR + col]; }
    const int cb = (l * 2 + dir) * RW + h * 64 + j;
    if (row == 10) return a.in[I_W0][cb];
    if (row == 11) return a.in[I_A0][cb];
    if (row == 12) return a.in[I_KK][cb];
    if (row == 13) return a.in[I_KA][cb];
    return a.in[I_RK][(size_t)l * RW + h * 64 + j];
}
__device__ __forceinline__ int r1_col(int g, int h, int dir, int seg) { return (g < 3 ? g * 768 + h * 64 : (g == 3 ? 2304 : 2432) + dir * 64) + 8 * seg; }
__device__ __forceinline__ void r1_issue(const bf16_t* P, int ct, int tid, u32x4 (&raw)[15]) {
    const int c = ct & 31, dir = (ct >> 5) & 1, bh = ct >> 6, h = bh % 12, b = bh / 12, ti = tid >> 3, seg = tid & 7;
    const int tseq = dir ? (NT - 1 - 64 * c - ti) : (64 * c + ti);
    const bf16_t* p0 = P + ((size_t)b * NT + tseq) * PLD + C_BS;
    const int dm = tseq > 0 ? PLD : 0, dn = tseq < NT - 1 ? PLD : 0;
#pragma unroll
    for (int g = 0; g < 5; ++g) { const int col = r1_col(g, h, dir, seg);
        raw[3 * g] = *(const u32x4*)(p0 + col); raw[3 * g + 1] = *(const u32x4*)(p0 + col - dm); raw[3 * g + 2] = *(const u32x4*)(p0 + col + dn); }
}

__device__ __forceinline__ void phase_rwkv_r1(const Args& a, int l, LAS unsigned char* lds) {
    const int tid0 = otid();
    unsigned char* ws = a.ws;
    const bf16_t* P = (const bf16_t*)(ws + WS_PROJ);
    const float* mu = a.in[I_MU] + (size_t)l * 2 * RSTR;
    const int G = gridDim.x;
    u32x4 raw[15], wup4, aup4;
    if ((int)blockIdx.x < 6144) { r1_issue(P, blockIdx.x, tid0, raw);
        { const int c0 = blockIdx.x; const size_t wofs = ((size_t)(l * 2 + ((c0 >> 5) & 1)) * 12 + ((c0 >> 6) % 12)) * 4096 + (size_t)(tid0 >> 3) * 64 + 8 * (tid0 & 7);
          wup4 = *(const u32x4*)((const bf16_t*)(ws + WS_MISC + MISC_WUPT) + wofs); aup4 = *(const u32x4*)((const bf16_t*)(ws + WS_MISC + MISC_AUPT) + wofs); }
        const int ct0 = blockIdx.x, bh0 = ct0 >> 6;
        LAS float* pt = (LAS float*)(lds + R_PAR);
        pt[tid0] = r1_param(a, l, bh0 % 12, (ct0 >> 5) & 1, tid0); if (tid0 + 512 < NPAR) pt[tid0 + 512] = r1_param(a, l, bh0 % 12, (ct0 >> 5) & 1, tid0 + 512); }
    __syncthreads();
    int itn = 0;
    f32x16 po0 = (f32x16){}, po1 = (f32x16){}; int ctp = -1;
#define R1_FLUSH(ctq, LANE, WAVE) do { const int _r32 = (LANE) & 31, _hi = (LANE) >> 5, _tt = (WAVE) & 3, _tm = _tt >> 1, _tn = _tt & 1; const size_t _cto = (size_t)(ctq) * 4096; \
        if ((WAVE) < 4) { bf16_t* QA = (bf16_t*)(ws + WS_QA) + _cto; float* MP = (float*)(ws + WS_MP) + _cto; \
            _Pragma("unroll") for (int q = 0; q < 4; ++q) { u32x2 w; w.x = pk2(po0[4 * q], po0[4 * q + 1]); w.y = pk2(po0[4 * q + 2], po0[4 * q + 3]); \
                *(u32x2*)(QA + ((_tn * 4 + 2 * _tm + (q >> 1)) * 64 + (q & 1) * 32 + _r32) * 8 + 4 * _hi) = w; \
                { const int _k = 32 * _tn + _r32, _kp = 32 * _tm + 8 * q + 4 * _hi;     \
                  *(f32x4*)(MP + (_kp >> 5) * 2048 + (((_kp >> 4) & 1) * 16 + (_k >> 2)) * 64 + (_k & 3) * 16 + (_kp & 15)) = (f32x4){po1[4 * q], po1[4 * q + 1], po1[4 * q + 2], po1[4 * q + 3]}; } } \
        } else { unsigned* Y0 = (unsigned*)(ws + WS_Y0) + (size_t)(ctq) * 2048 + _tt * 512 + (LANE); float* NP = (float*)(ws + WS_NP) + _cto; \
            _Pragma("unroll") for (int p = 0; p < 8; ++p) Y0[p * 64] = pk2(po0[2 * p], po0[2 * p + 1]); \
            _Pragma("unroll") for (int q = 0; q < 4; ++q) { const int _v = 32 * _tn + _r32, _kp = 32 * _tm + 8 * q + 4 * _hi;     \
                *(f32x4*)(NP + (((_v >> 4) * 2 + (_kp >> 5)) * 512) + ((((_kp >> 4) & 1) * 4 + (_v & 3)) * 64) + ((_v & 15) >> 2) * 16 + (_kp & 15)) = (f32x4){po1[4 * q], po1[4 * q + 1], po1[4 * q + 2], po1[4 * q + 3]}; } } } while (0)
  for (int ct = blockIdx.x; ct < 6144; ct += G, ++itn) {
    int tid = tid0; asm volatile("" : "+v"(tid));
    const int lane = tid & 63, wave = __builtin_amdgcn_readfirstlane(tid >> 6), r32 = lane & 31, hi = lane >> 5;
    const int ti = tid >> 3, seg = tid & 7;
    const int c = ct & 31, dir = (ct >> 5) & 1, bh = ct >> 6, h = bh % 12, b = bh / 12;
    const int tseq = dir ? (NT - 1 - 64 * c - ti) : (64 * c + ti);
    const size_t trow = (size_t)b * NT + tseq;
    const bool hm = tseq > 0, hn = tseq < NT - 1;
    const LAS float* PT = (const LAS float*)(lds + R_PAR) + (itn & 1) * NPAR;
    float pnx0 = 0.f, pnx1 = 0.f;
    float r8[8], k8[8], v8[8];
    {
        shift8r(raw[0], raw[1], raw[2], hm, hn, PT + 0 * 64 + 8 * seg, PT + 1 * 64 + 8 * seg, r8);
        shift8r(raw[3], raw[4], raw[5], hm, hn, PT + 2 * 64 + 8 * seg, PT + 3 * 64 + 8 * seg, k8);
        shift8r(raw[6], raw[7], raw[8], hm, hn, PT + 4 * 64 + 8 * seg, PT + 5 * 64 + 8 * seg, v8);
        float t8[8];
        shift8r(raw[9], raw[10], raw[11], hm, hn, PT + 6 * 64 + 8 * seg, PT + 7 * 64 + 8 * seg, t8);
#pragma unroll
        for (int q = 0; q < 8; ++q) { const float e2 = __expf(2.f * t8[q]); t8[q] = 1.f - 2.f / (e2 + 1.f); }
        *(LAS u32x4*)(lds + R_WD + ti * RLD + 16 * seg) = pack8(t8);
        shift8r(raw[12], raw[13], raw[14], hm, hn, PT + 8 * 64 + 8 * seg, PT + 9 * 64 + 8 * seg, t8);
        *(LAS u32x4*)(lds + R_AD + ti * RLD + 16 * seg) = pack8(t8);
        if (h == 0 && dir == 0) {
            const bf16_t* p0 = P + trow * PLD + C_BS;
            bf16_t* GS = (bf16_t*)(ws + WS_GS) + trow * 256;
#pragma unroll
            for (int hf = 0; hf < 2; ++hf) { const int col = 2560 + 64 * hf + 8 * seg;
                shift8r(*(const u32x4*)(p0 + col), *(const u32x4*)(p0 + col - (hm ? PLD : 0)), *(const u32x4*)(p0 + col + (hn ? PLD : 0)), hm, hn, mu + col, mu + RSTR + col, t8);
#pragma unroll
                for (int q = 0; q < 8; ++q) t8[q] = sigmoidf_(t8[q]);
                *(u32x4*)(GS + 64 * hf + 8 * seg) = pack8(t8);
                *(u32x4*)(GS + 128 + 64 * hf + 8 * seg) = (u32x4){0u, 0u, 0u, 0u}; }
        }
        *(LAS u32x4*)(lds + R_WUP + ti * RLD + 16 * seg) = wup4;
        *(LAS u32x4*)(lds + R_AUP + ti * RLD + 16 * seg) = aup4;
        if (dir == 0) *(u32x4*)((bf16_t*)(ws + WS_RV) + trow * RW + h * 64 + 8 * seg) = pack8(v8);
    }
    if (ctp >= 0) R1_FLUSH(ctp, lane, wave);
    if (ct + G < 6144) { r1_issue(P, ct + G, tid, raw);
        const int ctn = ct + G, bhn = ctn >> 6;
        { const size_t wofs = ((size_t)(l * 2 + ((ctn >> 5) & 1)) * 12 + (bhn % 12)) * 4096 + (size_t)ti * 64 + 8 * seg;
          wup4 = *(const u32x4*)((const bf16_t*)(ws + WS_MISC + MISC_WUPT) + wofs); aup4 = *(const u32x4*)((const bf16_t*)(ws + WS_MISC + MISC_AUPT) + wofs); }
        pnx0 = r1_param(a, l, bhn % 12, (ctn >> 5) & 1, tid); if (tid + 512 < NPAR) pnx1 = r1_param(a, l, bhn % 12, (ctn >> 5) & 1, tid + 512); }
    __syncthreads();
    {
        const int p = wave >> 2, tt = wave & 3, tm = tt >> 1, tn = tt & 1;
        f32x16 acc = (f32x16){};
        acc = tile64x<false, false>(lds + (p ? R_AUP : R_WUP), 32 * tm, lds + (p ? R_AD : R_WD), 32 * tn, lane, acc);
        LAS float* Z = (LAS float*)(lds + (p ? R_ZA : R_ZW));
#pragma unroll
        for (int q = 0; q < 4; ++q) *(LAS f32x4*)(Z + (32 * tn + r32) * 68 + 32 * tm + 8 * q + 4 * hi) = (f32x4){acc[4 * q], acc[4 * q + 1], acc[4 * q + 2], acc[4 * q + 3]};
    }
    __syncthreads();
    float kka8[8], kk8[8], kd8[8];
    {
        const LAS float* w0 = PT + 10 * 64 + 8 * seg; const LAS float* a0 = PT + 11 * 64 + 8 * seg;
        const LAS float* kkp = PT + 12 * 64 + 8 * seg; const LAS float* kap = PT + 13 * 64 + 8 * seg;
        LAS float* Zw = (LAS float*)(lds + R_ZW) + ti * 68 + 8 * seg; const LAS float* Za = (const LAS float*)(lds + R_ZA) + ti * 68 + 8 * seg;
        float nrm = 0.f, av[8], e8[8];
#pragma unroll
        for (int q = 0; q < 8; ++q) {
            const float z = w0[q] + Zw[q];
            const float u = -z; const float sp = fmaxf(u, 0.f) + __logf(1.f + __expf(-fabsf(u)));
            e8[q] = __expf(-sp - 0.5f);
            av[q] = sigmoidf_(a0[q] + Za[q]);
            const float kr = k8[q] * kkp[q]; kk8[q] = kr; nrm += kr * kr;
            kd8[q] = k8[q] * (1.f + (av[q] - 1.f) * kap[q]);
        }
        nrm = dpp_sum8(nrm);
        const float rn = rsqrtf(fmaxf(nrm, 1e-24f));
#pragma unroll
        for (int q = 0; q < 8; ++q) { kk8[q] *= rn; kka8[q] = kk8[q] * av[q]; Zw[q] = e8[q]; }
        { const LAS float* rkp = PT + 14 * 64 + 8 * seg; float bs = 0.f;
#pragma unroll
          for (int q = 0; q < 8; ++q) bs += r8[q] * kd8[q] * rkp[q];
          bs = dpp_sum8(bs);
          if (seg == 0) ((float*)(ws + WS_RR))[((size_t)dir * NTOK + trow) * 12 + h] = bs; }
    }
    __syncthreads();
    {
        const int kc = tid & 63, sg = tid >> 6;
        LAS float* Zw = (LAS float*)(lds + R_ZW); LAS float* SEG = (LAS float*)(lds + R_SEG);
        float run = 0.f;
#pragma unroll
        for (int q = 0; q < 8; ++q) { run += Zw[(8 * sg + q) * 68 + kc]; Zw[(8 * sg + q) * 68 + kc] = run; }
        SEG[sg * 64 + kc] = run;
        __syncthreads();
        float off = 0.f;
        for (int s2 = 0; s2 < sg; ++s2) off += SEG[s2 * 64 + kc];
#pragma unroll
        for (int q = 0; q < 8; ++q) Zw[(8 * sg + q) * 68 + kc] += off;
    }
    __syncthreads();
    {
        const LAS float* Gp = (const LAS float*)(lds + R_ZW);
        float al[8], be[8], bp[8], ka[8], kp[8], rh[8];
#pragma unroll
        for (int q = 0; q < 8; ++q) {
            const float gi = Gp[ti * 68 + 8 * seg + q], gm = ti > 0 ? Gp[(ti - 1) * 68 + 8 * seg + q] : 0.f, g63 = Gp[63 * 68 + 8 * seg + q];
            const float ig = __expf(gi), tl = __expf(gi - g63);
            al[q] = __expf(-gm) * kk8[q]; be[q] = kka8[q] * ig; bp[q] = kka8[q] * tl; ka[q] = kd8[q] * ig; kp[q] = kd8[q] * tl; rh[q] = r8[q] * __expf(-gi);
            if (ti == 63) ((LAS float*)(lds + R_GC))[8 * seg + q] = __expf(-g63);
        }
        const int o = ti * RLD + 16 * seg;
        *(LAS u32x4*)(lds + R_A + o) = pack8(al); *(LAS u32x4*)(lds + R_B + o) = pack8(be); *(LAS u32x4*)(lds + R_K + o) = pack8(ka); *(LAS u32x4*)(lds + R_RHO + o) = pack8(rh);
        *(LAS u32x4*)(lds + R_BP + o) = pack8(bp); *(LAS u32x4*)(lds + R_KP + o) = pack8(kp); *(LAS u32x4*)(lds + R_V + o) = pack8(v8);
    }
    __syncthreads();
    {
        const int tt = wave & 3, tm = tt >> 1, tn = tt & 1;
        const int jb = 32 * tm, ib = 32 * tn, i = ib + r32;
        f32x16 acc0 = (f32x16){}, acc1 = (f32x16){};
        if (tm <= tn) {
            acc0 = tile64x<false, false>(lds + (wave < 4 ? R_B : R_K), jb, lds + (wave < 4 ? R_A : R_RHO), ib, lane, acc0);
            acc1 = tile64x<false, false>(lds + (wave < 4 ? R_K : R_B), jb, lds + (wave < 4 ? R_A : R_RHO), ib, lane, acc1);
        }
#pragma unroll
        for (int rg = 0; rg < 16; ++rg) { const int j = jb + crow(rg, hi); const bool keep = (wave < 4) ? (j < i) : (j <= i);
            acc0[rg] = keep ? acc0[rg] : 0.f; acc1[rg] = keep ? acc1[rg] : 0.f; }
#pragma unroll
        for (int q = 0; q < 4; ++q) { const int jo = jb + 8 * q + 4 * hi;
            u32x2 w1; w1.x = pk2(acc1[4 * q], acc1[4 * q + 1]); w1.y = pk2(acc1[4 * q + 2], acc1[4 * q + 3]);
            if (wave < 4) {
                *(LAS f32x4*)((LAS float*)(lds + R_LBF) + i * 68 + jo) = (f32x4){acc0[4 * q], acc0[4 * q + 1], acc0[4 * q + 2], acc0[4 * q + 3]};
                *(LAS u32x2*)(lds + R_LK + i * RLD + 2 * jo) = w1;
                if (wave == 1) { u32x2 wl; wl.x = pk2(acc0[4 * q], acc0[4 * q + 1]); wl.y = pk2(acc0[4 * q + 2], acc0[4 * q + 3]);
                    *(LAS u32x2*)(lds + R_TMP0 + r32 * 64 + 2 * (8 * q + 4 * hi)) = wl; }
            } else {
                u32x2 w0; w0.x = pk2(acc0[4 * q], acc0[4 * q + 1]); w0.y = pk2(acc0[4 * q + 2], acc0[4 * q + 3]);
                *(LAS u32x2*)(lds + R_RK + i * RLD + 2 * jo) = w0;
                *(LAS u32x2*)(lds + R_RB + i * RLD + 2 * jo) = w1;
            } }
    }
    __syncthreads();
    if (wave < 2) {
        const int blk = wave, col = r32;
        const LAS float* Lf = (const LAS float*)(lds + R_LBF) + (32 * blk) * 68 + 32 * blk;
        float Tm[32];
        f32x4 cur[8], nxt[8];
#pragma unroll
        for (int m4 = 0; m4 < 8; ++m4) { cur[m4] = (f32x4){0.f, 0.f, 0.f, 0.f}; nxt[m4] = (f32x4){0.f, 0.f, 0.f, 0.f}; }
        cur[0] = *(const LAS f32x4*)(Lf + 68);
        Tm[0] = (col == 0) ? 1.f : 0.f;
#pragma unroll
        for (int i = 1; i < 32; ++i) {
            if (i + 1 < 32) {
#pragma unroll
                for (int m4 = 0; m4 < (i + 4) / 4; ++m4) nxt[m4] = *(const LAS f32x4*)(Lf + (i + 1) * 68 + 4 * m4);
            }
            float c0 = (col == i) ? 1.f : 0.f, c1 = 0.f, c2 = 0.f, c3 = 0.f;
#pragma unroll
            for (int m4 = 0; m4 < (i + 3) / 4; ++m4) {
                if (4 * m4 + 0 < i) c0 -= cur[m4][0] * Tm[4 * m4 + 0];
                if (4 * m4 + 1 < i) c1 -= cur[m4][1] * Tm[4 * m4 + 1];
                if (4 * m4 + 2 < i) c2 -= cur[m4][2] * Tm[4 * m4 + 2];
                if (4 * m4 + 3 < i) c3 -= cur[m4][3] * Tm[4 * m4 + 3]; }
            Tm[i] = (c0 + c1) + (c2 + c3);
#pragma unroll
            for (int m4 = 0; m4 < 8; ++m4) cur[m4] = nxt[m4];
            asm volatile("" : "+v"(Tm[i]) :: "memory");
        }
        if (hi == 0) {
#pragma unroll
            for (int i = 0; i < 32; ++i) {
                *(LAS bf16_t*)(lds + R_TT + (32 * blk + i) * RLD + 2 * (32 * blk + col)) = f2bf(Tm[i]);
                if (blk == 0) *(LAS bf16_t*)(lds + R_TT + i * RLD + 2 * (32 + col)) = (bf16_t)0;
            }
            if (blk == 0) {
#pragma unroll
                for (int q = 0; q < 4; ++q) { float x8[8];
#pragma unroll
                    for (int e = 0; e < 8; ++e) x8[e] = Tm[8 * q + e];
                    *(LAS u32x4*)(lds + R_TMP1 + col * 64 + 16 * q) = pack8(x8); } }
        }
    } else if (wave >= 4) {
        const int tt = wave & 3, tm = tt >> 1, tn = tt & 1;
        f32x16 acc = (f32x16){};
        acc = tile64x<false, true>(lds + R_LK, 32 * tm, lds + R_V, 32 * tn, lane, acc);
#pragma unroll
        for (int q = 0; q < 4; ++q) { u32x2 w; w.x = pk2(acc[4 * q], acc[4 * q + 1]); w.y = pk2(acc[4 * q + 2], acc[4 * q + 3]);
            *(LAS u32x2*)(lds + R_W1T + (32 * tn + r32) * RLD + 2 * (32 * tm + 8 * q + 4 * hi)) = w; }
    }
    __syncthreads();
    if (wave == 0) {
        f32x16 x1 = (f32x16){};
#pragma unroll
        for (int s2 = 0; s2 < 2; ++s2) x1 = __builtin_amdgcn_mfma_f32_32x32x16_bf16(*(const LAS bf16x8*)(lds + R_TMP0 + r32 * 64 + 32 * s2 + 16 * hi), *(const LAS bf16x8*)(lds + R_TMP1 + r32 * 64 + 32 * s2 + 16 * hi), x1, 0, 0, 0);
#pragma unroll
        for (int q = 0; q < 4; ++q) { u32x2 w; w.x = pk2(x1[4 * q], x1[4 * q + 1]); w.y = pk2(x1[4 * q + 2], x1[4 * q + 3]);
            *(LAS u32x2*)(lds + R_TMP2 + r32 * 64 + 2 * (8 * q + 4 * hi)) = w; }
        lds_fence();
        f32x16 t21 = (f32x16){};
#pragma unroll
        for (int s2 = 0; s2 < 2; ++s2) t21 = __builtin_amdgcn_mfma_f32_32x32x16_bf16(*(const LAS bf16x8*)(lds + R_TT + (32 + r32) * RLD + 64 + 32 * s2 + 16 * hi), *(const LAS bf16x8*)(lds + R_TMP2 + r32 * 64 + 32 * s2 + 16 * hi), t21, 0, 0, 0);
#pragma unroll
        for (int rg = 0; rg < 16; ++rg) *(LAS bf16_t*)(lds + R_TT + (32 + crow(rg, hi)) * RLD + 2 * r32) = f2bf(-t21[rg]);
    }
    __syncthreads();
    {
        const int tt = wave & 3, tm = tt >> 1, tn = tt & 1;
        f32x16 acc = (f32x16){};
        if (wave < 4) acc = tile64x<false, false>(lds + R_TT, 32 * tm, lds + R_W1T, 32 * tn, lane, acc);
        else          acc = tile64x<false, true>(lds + R_TT, 32 * tm, lds + R_A, 32 * tn, lane, acc);
        LAS unsigned char* dst = lds + (wave < 4 ? R_UT : R_TAT);
#pragma unroll
        for (int q = 0; q < 4; ++q) { u32x2 w; w.x = pk2(acc[4 * q], acc[4 * q + 1]); w.y = pk2(acc[4 * q + 2], acc[4 * q + 3]);
            *(LAS u32x2*)(dst + (32 * tn + r32) * RLD + 2 * (32 * tm + 8 * q + 4 * hi)) = w; }
    }
    __syncthreads();
    {
        const int tt = wave & 3, tm = tt >> 1, tn = tt & 1;
        if (wave < 4) {
            f32x16 acc = (f32x16){};
            acc = tile64x<false, false>(lds + R_TAT, 32 * tm, lds + R_RB, 32 * tn, lane, acc);
#pragma unroll
            for (int q = 0; q < 4; ++q) { const int i = 32 * tn + r32, k = 32 * tm + 8 * q + 4 * hi;
                const u32x2 rv = *(const LAS u32x2*)(lds + R_RHO + i * RLD + 2 * k);
                po0[4 * q] = bflo(rv.x) - acc[4 * q]; po0[4 * q + 1] = bfhi(rv.x) - acc[4 * q + 1]; po0[4 * q + 2] = bflo(rv.y) - acc[4 * q + 2]; po0[4 * q + 3] = bfhi(rv.y) - acc[4 * q + 3]; }
            f32x16 am = (f32x16){};
            am = tile64x<true, false>(lds + R_BP, 32 * tm, lds + R_TAT, 32 * tn, lane, am);
            const LAS float* GC = (const LAS float*)(lds + R_GC);
#pragma unroll
            for (int q = 0; q < 4; ++q) { const int k = 32 * tn + r32, kp0 = 32 * tm + 8 * q + 4 * hi;
#pragma unroll
                for (int e = 0; e < 4; ++e) po1[4 * q + e] = ((kp0 + e == k) ? GC[kp0 + e] : 0.f) - am[4 * q + e]; }
        } else {
            f32x16 a1 = (f32x16){}, a2 = (f32x16){};
            a1 = tile64x<true, false>(lds + R_V, 32 * tm, lds + R_RK, 32 * tn, lane, a1);
            a2 = tile64x<false, false>(lds + R_UT, 32 * tm, lds + R_RB, 32 * tn, lane, a2);
            po0 = a1 - a2;
            f32x16 n1 = (f32x16){}, n2 = (f32x16){};
            n1 = tile64x<true, true>(lds + R_KP, 32 * tm, lds + R_V, 32 * tn, lane, n1);
            n2 = tile64x<true, false>(lds + R_BP, 32 * tm, lds + R_UT, 32 * tn, lane, n2);
            po1 = n1 - n2;
        }
        ctp = ct;
    }
    if (ct + G < 6144) { LAS float* pn = (LAS float*)(lds + R_PAR) + ((itn + 1) & 1) * NPAR; pn[tid] = pnx0; if (tid + 512 < NPAR) pn[tid + 512] = pnx1; }
    __syncthreads();
  }
    if (ctp >= 0) { const int lane = tid0 & 63, wave = __builtin_amdgcn_readfirstlane(tid0 >> 6); R1_FLUSH(ctp, lane, wave); }
#undef R1_FLUSH
}

__device__ __forceinline__ void rwkv_r2_pair(const Args& a, int pair, LAS unsigned char* lds) {
    const int tid = otid(), lane = tid & 63, wave = __builtin_amdgcn_readfirstlane(tid >> 6);
    unsigned char* ws = a.ws;
    const int grp = wave >> 2, wg = wave & 3, unit = 2 * pair + grp;
    LAS float* S = (LAS float*)(lds + grp * 17408);
    const int vb = wg, l15 = lane & 15, lq = lane >> 4;
    for (int i = tid; i < 2 * 64 * 68; i += 512) ((LAS float*)lds)[i] = 0.f;
    const float* MPb = (const float*)(ws + WS_MP) + (size_t)unit * 32 * 4096 + lane; const float* NPb = (const float*)(ws + WS_NP) + (size_t)unit * 32 * 4096 + vb * 1024 + lane;
    const int ytt = wg, ytm = ytt >> 1, ytn = ytt & 1, r32 = lane & 31, hi = lane >> 5;
    const int ydir = grp, yh = pair % 12, yb = pair / 12;
    const bf16_t* QAb = (const bf16_t*)(ws + WS_QA) + (size_t)unit * 32 * 4096 + (ytn * 4 * 64 + lane) * 8; const unsigned* Y0b = (const unsigned*)(ws + WS_Y0) + (size_t)unit * 32 * 2048 + ytt * 512 + lane;
    bf16_t* YB = (bf16_t*)(ws + WS_SS) + ((size_t)ydir * NTOK + (size_t)yb * NT) * RW + yh * 64 + 32 * ytm;
    bf16x8 qaf[4]; unsigned y0p[8]; float Bm[4][16]; f32x4 acc[4];
#define R2_LOAD(cc) do { const float* MPc = MPb + (size_t)(cc) * 4096; const float* NPc = NPb + (size_t)(cc) * 4096; \
        _Pragma("unroll") for (int kb = 0; kb < 4; ++kb) { \
            _Pragma("unroll") for (int ks = 0; ks < 16; ++ks) Bm[kb][ks] = MPc[(kb * 16 + ks) * 64]; \
            _Pragma("unroll") for (int rg = 0; rg < 4; ++rg) acc[kb][rg] = NPc[(kb * 4 + rg) * 64]; } \
        _Pragma("unroll") for (int s4 = 0; s4 < 4; ++s4) qaf[s4] = *(const bf16x8*)(QAb + (size_t)(cc) * 4096 + s4 * 512); \
        _Pragma("unroll") for (int p = 0; p < 8; ++p) y0p[p] = Y0b[(size_t)(cc) * 2048 + p * 64]; } while (0)
    R2_LOAD(0);
    __syncthreads();
#pragma unroll 1
    for (int c = 0; c < 32; ++c) {
        f32x16 ya;
#pragma unroll
        for (int p = 0; p < 8; ++p) { ya[2 * p] = bflo(y0p[p]); ya[2 * p + 1] = bfhi(y0p[p]); }
#pragma unroll
        for (int ks = 0; ks < 16; ++ks) { const float av = S[(16 * vb + l15) * 68 + 4 * ks + lq];
#pragma unroll
            for (int kb = 0; kb < 4; ++kb) acc[kb] = __builtin_amdgcn_mfma_f32_16x16x4f32(av, Bm[kb][ks], acc[kb], 0, 0, 0); }
#pragma unroll
        for (int s4 = 0; s4 < 4; ++s4) { const LAS float* sp = S + (32 * ytm + r32) * 68 + 16 * s4 + 8 * hi;
            const f32x4 s0 = *(const LAS f32x4*)sp, s1 = *(const LAS f32x4*)(sp + 4);
            u32x4 xw; xw.x = pk2(s0.x, s0.y); xw.y = pk2(s0.z, s0.w); xw.z = pk2(s1.x, s1.y); xw.w = pk2(s1.z, s1.w);
            ya = __builtin_amdgcn_mfma_f32_32x32x16_bf16(__builtin_bit_cast(bf16x8, xw), qaf[s4], ya, 0, 0, 0); }
        { const int il = 32 * ytn + r32; const int tseq = ydir ? (NT - 1 - 64 * c - il) : (64 * c + il);
#pragma unroll
          for (int q = 0; q < 4; ++q) { u32x2 w; w.x = pk2(ya[4 * q], ya[4 * q + 1]); w.y = pk2(ya[4 * q + 2], ya[4 * q + 3]);
              *(u32x2*)(YB + (size_t)tseq * RW + 8 * q + 4 * hi) = w; } }
        __syncthreads();
#pragma unroll
        for (int kb = 0; kb < 4; ++kb)
#pragma unroll
            for (int rg = 0; rg < 4; ++rg) S[(16 * vb + 4 * lq + rg) * 68 + 16 * kb + l15] = acc[kb][rg];
        if (c + 1 < 32) R2_LOAD(c + 1);
        __syncthreads();
    }
#undef R2_LOAD
}

__device__ __forceinline__ void phase_rwkv_out(const Args& a, int l) {
    const int tid = otid(), lane = tid & 63, wave = tid >> 6;
    unsigned char* ws = a.ws;
    const bf16_t* YB = (const bf16_t*)(ws + WS_SS); const bf16_t* RV = (const bf16_t*)(ws + WS_RV); const float* BS = (const float*)(ws + WS_RR);
    const bf16_t* GG = (const bf16_t*)(ws + WS_GG); bf16_t* OB = (bf16_t*)(ws + WS_OA) + 256;
    const float* lng = a.in[I_LNG] + (size_t)l * RW; const float* lnb = a.in[I_LNB] + (size_t)l * RW;
    for (int t = blockIdx.x * 8 + wave; t < NTOK; t += gridDim.x * 8) {
#pragma unroll
        for (int it = 0; it < 3; ++it) { const int c0 = it * 256 + lane * 4, hd = c0 >> 6;
            const u32x2 uf = *(const u32x2*)(YB + (size_t)t * RW + c0), ub = *(const u32x2*)(YB + ((size_t)NTOK + t) * RW + c0);
            float y0 = bflo(uf.x) + bflo(ub.x), y1 = bfhi(uf.x) + bfhi(ub.x), y2 = bflo(uf.y) + bflo(ub.y), y3 = bfhi(uf.y) + bfhi(ub.y);
            float sm = (y0 + y1) + (y2 + y3);
#pragma unroll
            for (int o = 1; o < 16; o <<= 1) sm += __shfl_xor(sm, o);
            const float mean = sm * (1.f / 64.f);
            y0 -= mean; y1 -= mean; y2 -= mean; y3 -= mean;
            float sv = (y0 * y0 + y1 * y1) + (y2 * y2 + y3 * y3);
#pragma unroll
            for (int o = 1; o < 16; o <<= 1) sv += __shfl_xor(sv, o);
            const float rstd = rsqrtf(sv * (1.f / 64.f) + 64e-5f);
            const float s0 = BS[(size_t)t * 12 + hd] + BS[((size_t)NTOK + t) * 12 + hd];
            const f32x4 g4 = *(const f32x4*)(lng + c0), b4 = *(const f32x4*)(lnb + c0);
            const u32x2 vv = *(const u32x2*)(RV + (size_t)t * RW + c0), gg = *(const u32x2*)(GG + (size_t)t * RW + c0);
            const float o0 = (y0 * rstd * g4.x + b4.x + s0 * bflo(vv.x)) * bflo(gg.x), o1 = (y1 * rstd * g4.y + b4.y + s0 * bfhi(vv.x)) * bfhi(gg.x);
            const float o2 = (y2 * rstd * g4.z + b4.z + s0 * bflo(vv.y)) * bflo(gg.y), o3 = (y3 * rstd * g4.w + b4.w + s0 * bfhi(vv.y)) * bfhi(gg.y);
            u32x2 w; w.x = pk2(o0, o1); w.y = pk2(o2, o3);
            *(u32x2*)(OB + (size_t)t * 1792 + c0) = w; }
    }
    const float* OAG = (const float*)(ws + WS_OAG); const float* LSE = (const float*)(ws + WS_LSE); bf16_t* OA = (bf16_t*)(ws + WS_OA);
    for (int task = blockIdx.x * 8 + wave; task < NTOK / 4; task += gridDim.x * 8) {
#pragma unroll
        for (int tk = 0; tk < 4; ++tk) { const size_t t = (size_t)task * 4 + tk; const int hh = lane >> 4;
            const float l0 = LSE[((size_t)0 * NTOK + t) * 4 + hh], l1 = LSE[((size_t)1 * NTOK + t) * 4 + hh], l2 = LSE[((size_t)2 * NTOK + t) * 4 + hh];
            const float mx = fmaxf(l0, fmaxf(l1, l2));
            const float w0 = __builtin_amdgcn_exp2f(l0 - mx), w1 = __builtin_amdgcn_exp2f(l1 - mx), w2 = __builtin_amdgcn_exp2f(l2 - mx);
            const float inv = 1.f / (w0 + w1 + w2);
            const bf16_t* OAb = (const bf16_t*)OAG;
            const u32x2 u0 = *(const u32x2*)(OAb + ((size_t)0 * NTOK + t) * 256 + lane * 4), u1 = *(const u32x2*)(OAb + ((size_t)1 * NTOK + t) * 256 + lane * 4), u2 = *(const u32x2*)(OAb + ((size_t)2 * NTOK + t) * 256 + lane * 4);
            const f32x4 o0 = (f32x4){bflo(u0.x), bfhi(u0.x), bflo(u0.y), bfhi(u0.y)}, o1 = (f32x4){bflo(u1.x), bfhi(u1.x), bflo(u1.y), bfhi(u1.y)}, o2 = (f32x4){bflo(u2.x), bfhi(u2.x), bflo(u2.y), bfhi(u2.y)};
            const f32x4 r = (o0 * w0 + o1 * w1 + o2 * w2) * inv;
            u32x2 w; w.x = pk2(r.x, r.y); w.y = pk2(r.z, r.w);
            *(u32x2*)(OA + t * 1792 + lane * 4) = w; }
    }
}

__device__ __forceinline__ int vk_off(int row, int ch) { return 2048 * (row >> 3) + 512 * (ch >> 2) + 64 * (row & 7) + 16 * ((ch & 3) ^ ((row >> 2) & 3)); }
__device__ __forceinline__ void diffattn_unit(const Args& a, int l, int unit, LAS unsigned char* lds) {
    constexpr int TB = 16384;
    const int b = unit / 96; const int rem = unit - b * 96; const int h = rem >> 4, qb = rem & 15;
    const int tid = otid(), lane = tid & 63, wave = __builtin_amdgcn_readfirstlane(tid >> 6), r32 = lane & 31, hi = lane >> 5;
    const int c = wave & 1, qblk = wave >> 1;
    const int q0 = qb * 128 + qblk * 32;
    const bf16_t* P = (const bf16_t*)(a.ws + WS_PROJ);
    const size_t rowb = (size_t)b * NT;
    bf16x8 qf[4];
    { const bf16_t* qp = P + (rowb + q0 + r32) * PLD + C_CQ + h * 128 + c * 64 + 8 * hi;
#pragma unroll
      for (int s4 = 0; s4 < 4; ++s4) qf[s4] = *(const bf16x8*)(qp + 16 * s4); }
    LAS float* biasL = (LAS float*)(lds + 69632);
    { const float* bC = (const float*)(a.ws + WS_MISC + MISC_BIASC) + h * 257;
      for (int i = tid; i < 257; i += 512) biasL[i] = bC[i]; }
    const bf16_t* kgd[2]; const bf16_t* vgd[2];
#pragma unroll
    for (int jj = 0; jj < 2; ++jj) { const int r7 = (lane >> 2) & 7, row = 8 * wave + r7, chv = 4 * (2 * jj + (lane >> 5)) + ((lane & 3) ^ ((2 * wave + (r7 >> 2)) & 3));
        kgd[jj] = P + (rowb + row) * PLD + C_CK + h * 128 + chv * 8; vgd[jj] = P + (rowb + row) * PLD + C_CV + h * 128 + chv * 8; }
#define DA_DMA(src, tt, dstoff) do { _Pragma("unroll") for (int jj = 0; jj < 2; ++jj) \
        __builtin_amdgcn_global_load_lds((const unsigned*)((src)[jj] + (size_t)(64 * (tt)) * PLD), (LAS unsigned*)(lds + (dstoff) + 1024 * (2 * wave + jj)), 16, 0, 0); } while (0)
    DA_DMA(kgd, 0, 0); DA_DMA(vgd, 0, 2 * TB); DA_DMA(kgd, 1, TB);
    asm volatile("s_waitcnt vmcnt(0)" ::: "memory"); __syncthreads();
    f32x16 o[4];
#pragma unroll
    for (int db = 0; db < 4; ++db) o[db] = (f32x16){};
    float m = -1e30f, lsum = 0.f;
    const float SC = 0.125f * LOG2E;
    const int chlo = 2 * ((lane >> 4) & 1) + ((lane & 3) >> 1);
    const int trb0 = 64 * (4 * hi + ((lane & 15) >> 2)) + 16 * (chlo ^ (hi & 3)) + 8 * (lane & 1);
    const int trb1 = 64 * (4 * hi + ((lane & 15) >> 2)) + 16 * (chlo ^ ((2 + hi) & 3)) + 8 * (lane & 1) + 2048;
    const int qabs = q0 + r32;
    const int ko0 = vk_off(r32, 8 * c + hi), ko1 = vk_off(32 + r32, 8 * c + hi);
#define DA_QK(SA0, SA1, Kb) do { SA0 = (f32x16){}; SA1 = (f32x16){}; bf16x8 _kf0[4], _kf1[4]; \
        _Pragma("unroll") for (int s4 = 0; s4 < 4; ++s4) { _kf0[s4] = *(const LAS bf16x8*)((Kb) + vk_off(r32, 8 * c + 2 * s4 + hi)); _kf1[s4] = *(const LAS bf16x8*)((Kb) + vk_off(32 + r32, 8 * c + 2 * s4 + hi)); } \
        _Pragma("unroll") for (int s4 = 0; s4 < 4; ++s4) { \
            SA0 = __builtin_amdgcn_mfma_f32_32x32x16_bf16(_kf0[s4], qf[s4], SA0, 0, 0, 0); \
            SA1 = __builtin_amdgcn_mfma_f32_32x32x16_bf16(_kf1[s4], qf[s4], SA1, 0, 0, 0); } } while (0)
    f32x16 sa0, sa1, sn0 = (f32x16){}, sn1 = (f32x16){};
    DA_QK(sa0, sa1, lds);
    (void)ko0; (void)ko1;
    asm volatile("s_waitcnt lgkmcnt(0)" ::: "memory"); __syncthreads();
    for (int t = 0; t < 32; ++t) {
        if (t + 2 < 32) DA_DMA(kgd, t + 2, (t & 1) * TB);
        if (t + 1 < 32) DA_DMA(vgd, t + 1, 2 * TB + ((t + 1) & 1) * TB);
        const LAS unsigned char* Vb = lds + 2 * TB + (t & 1) * TB;
        if (t + 1 < 32) { DA_QK(sn0, sn1, lds + ((t + 1) & 1) * TB); }
        __builtin_amdgcn_sched_barrier(0);
        float x0[16], x1[16];
        const int kv0 = 64 * t;
        const bool farp = (kv0 >= q0 + 31 + 128), farn = (kv0 + 63 + 128 <= q0);
        if (farp || farn) { const float cb = farp ? biasL[256] : biasL[0];
#pragma unroll
            for (int rg = 0; rg < 16; ++rg) { x0[rg] = sa0[rg] * SC + cb; x1[rg] = sa1[rg] * SC + cb; }
        } else {
#pragma unroll
            for (int rg = 0; rg < 16; ++rg) { int rel = kv0 + crow(rg, hi) - qabs; int rc = rel < -128 ? -128 : (rel > 128 ? 128 : rel);
                x0[rg] = sa0[rg] * SC + biasL[rc + 128];
                rel += 32; rc = rel < -128 ? -128 : (rel > 128 ? 128 : rel);
                x1[rg] = sa1[rg] * SC + biasL[rc + 128]; }
        }
        float mx = fmaxf(x0[0], x1[0]);
#pragma unroll
        for (int rg = 1; rg < 16; ++rg) mx = fmaxf(mx, fmaxf(x0[rg], x1[rg]));
        mx = fmaxf(mx, __shfl_xor(mx, 32));
        const float mn = fmaxf(m, mx), alpha = __builtin_amdgcn_exp2f(m - mn); m = mn;
        float ps = 0.f;
#pragma unroll
        for (int rg = 0; rg < 16; ++rg) { x0[rg] = __builtin_amdgcn_exp2f(x0[rg] - mn); x1[rg] = __builtin_amdgcn_exp2f(x1[rg] - mn); ps += x0[rg] + x1[rg]; }
        lsum = lsum * alpha + ps;
#pragma unroll
        for (int db = 0; db < 4; ++db)
#pragma unroll
            for (int rg = 0; rg < 16; ++rg) o[db][rg] *= alpha;
        u32x4 pw[4];
#pragma unroll
        for (int s2 = 0; s2 < 2; ++s2) {
            pw[s2].x = pk2(x0[8 * s2 + 0], x0[8 * s2 + 1]); pw[s2].y = pk2(x0[8 * s2 + 2], x0[8 * s2 + 3]); pw[s2].z = pk2(x0[8 * s2 + 4], x0[8 * s2 + 5]); pw[s2].w = pk2(x0[8 * s2 + 6], x0[8 * s2 + 7]);
            pw[2 + s2].x = pk2(x1[8 * s2 + 0], x1[8 * s2 + 1]); pw[2 + s2].y = pk2(x1[8 * s2 + 2], x1[8 * s2 + 3]); pw[2 + s2].z = pk2(x1[8 * s2 + 4], x1[8 * s2 + 5]); pw[2 + s2].w = pk2(x1[8 * s2 + 6], x1[8 * s2 + 7]); }
        {
            s16x4 vl[2][4], vh[2][4];
#pragma unroll
            for (int db = 0; db < 4; ++db) { vl[0][db] = vtr(Vb + trb0 + 512 * db); vh[0][db] = vtr(Vb + trb1 + 512 * db); }
#pragma unroll
            for (int s = 0; s < 4; ++s) {
                if (s < 3) {
#pragma unroll
                    for (int db = 0; db < 4; ++db) { vl[(s + 1) & 1][db] = vtr(Vb + trb0 + 4096 * (s + 1) + 512 * db); vh[(s + 1) & 1][db] = vtr(Vb + trb1 + 4096 * (s + 1) + 512 * db); } }
#pragma unroll
                for (int db = 0; db < 4; ++db) { const s16x4 lo = vl[s & 1][db], hi4 = vh[s & 1][db];
                    const bf16x8 af = (bf16x8){lo[0], lo[1], lo[2], lo[3], hi4[0], hi4[1], hi4[2], hi4[3]};
                    o[db] = __builtin_amdgcn_mfma_f32_32x32x16_bf16(af, __builtin_bit_cast(bf16x8, pw[s]), o[db], 0, 0, 0); }
            }
        }
        asm volatile("s_waitcnt vmcnt(0)" ::: "memory"); __syncthreads();
        sa0 = sn0; sa1 = sn1;
    }
#undef DA_QK
#undef DA_DMA
    const float lt = lsum + __shfl_xor(lsum, 32);
    const float inv = 1.f / lt;
    const float* lamp = (const float*)(a.ws + WS_MISC + MISC_LAM);
    const float lam = lamp[l], linit = lamp[2 + l];
    LAS float* XO = (LAS float*)lds;
    if (c == 1) {
        const float f = inv * lam;
#pragma unroll
        for (int db = 0; db < 4; ++db)
#pragma unroll
            for (int rg = 0; rg < 16; ++rg) XO[(qblk * 64 + db * 16 + rg) * 64 + lane] = o[db][rg] * f;
    }
    __syncthreads();
    if (c == 0) {
        float ss = 0.f;
#pragma unroll
        for (int db = 0; db < 4; ++db)
#pragma unroll
            for (int rg = 0; rg < 16; ++rg) { const float v = o[db][rg] * inv - XO[(qblk * 64 + db * 16 + rg) * 64 + lane]; o[db][rg] = v; ss += v * v; }
        ss += __shfl_xor(ss, 32);
        const float sc = rsqrtf(ss * (1.f / 128.f) + 1e-5f) * (1.f - linit);
        const float* sg = a.in[I_SUBG] + (size_t)l * 128;
        bf16_t* op = (bf16_t*)(a.ws + WS_OA) + (rowb + q0 + r32) * 1792 + 1024 + h * 128;
#pragma unroll
        for (int db = 0; db < 4; ++db)
#pragma unroll
            for (int i = 0; i < 4; ++i) { const int d = db * 32 + 8 * i + 4 * hi; const f32x4 g4 = *(const f32x4*)(sg + d);
                u32x2 w; w.x = pk2(o[db][4 * i] * sc * g4.x, o[db][4 * i + 1] * sc * g4.y); w.y = pk2(o[db][4 * i + 2] * sc * g4.z, o[db][4 * i + 3] * sc * g4.w);
                *(u32x2*)(op + d) = w; }
    }
    __syncthreads();
}

__device__ __forceinline__ void phase_route(const Args& a, int l, LAS unsigned char* lds, bool commit = true) {
    const int tid = otid(), lane = tid & 63, wave = __builtin_amdgcn_readfirstlane(tid >> 6), r32 = lane & 31, hi = lane >> 5;
    unsigned char* ws = a.ws;
    LAS float* hb = (LAS float*)lds;
    LAS float* lg = (LAS float*)(lds + 131200);
    volatile LAS int* sel = (volatile LAS int*)(lds + 131200 + 4224);
    const float* X = (const float*)(ws + WS_X);
    const float* mod = (const float*)(ws + WS_MISC + MISC_MOD) + (size_t)l * 8 * 6144;
    bf16_t* H = (bf16_t*)(ws + WS_H);
    unsigned* cnt = (unsigned*)(ws + WS_CTL) + CW_CNT + l * 512;
    int* LIST = (int*)(ws + WS_LIST); unsigned* TOKE = (unsigned*)(ws + WS_TOKE); float* TOKP = (float*)(ws + WS_TOKP);
    const float* g2 = a.in[I_N2G] + (size_t)l * DM; const float* rb = a.in[I_RB] + (size_t)l * NE;
    float Bw[64];
    { const float* rw = a.in[I_RW] + (size_t)l * DM * NE + (size_t)(128 * wave + hi) * NE + r32;
#pragma unroll
      for (int s2 = 0; s2 < 64; ++s2) Bw[s2] = rw[(size_t)(2 * s2) * NE]; }
    for (int tb = blockIdx.x; tb < NTOK / 64; tb += gridDim.x) {
        for (int rnd = 0; rnd < 2; ++rnd) {
            const int tbase = tb * 64 + rnd * 32;
            const float* mb = mod + (size_t)(tbase >> 11) * 6144;
#pragma unroll 1
            for (int q = 0; q < 4; ++q) {
                const int tl = 4 * wave + q; const size_t t = (size_t)tbase + tl;
                f32x4 v[4];
#pragma unroll
                for (int j = 0; j < 4; ++j) v[j] = *(const f32x4*)(X + t * DM + 4 * lane + 256 * j);
                const float rstd = row_rstd(v, 1e-6f);
#pragma unroll
                for (int j = 0; j < 4; ++j) { const int c = 4 * lane + 256 * j;
                    const f32x4 gv = *(const f32x4*)(g2 + c), scv = *(const f32x4*)(mb + 4096 + c), shv = *(const f32x4*)(mb + 3072 + c);
                    const f32x4 hv = v[j] * rstd * gv * (scv + 1.0f) + shv;
                    u32x2 w; w.x = pk2(hv.x, hv.y); w.y = pk2(hv.z, hv.w);
                    *(u32x2*)(H + t * DM + c) = w;
                    LAS float* hp = hb + tl * 1025 + c; hp[0] = hv.x; hp[1] = hv.y; hp[2] = hv.z; hp[3] = hv.w; }
            }
            __syncthreads();
            f32x16 d = (f32x16){};
            { const LAS float* ap = hb + r32 * 1025 + 128 * wave + hi;
#pragma unroll
              for (int s2 = 0; s2 < 64; ++s2) d = __builtin_amdgcn_mfma_f32_32x32x2f32(ap[2 * s2], Bw[s2], d, 0, 0, 0); }
            __syncthreads();
#pragma unroll
            for (int rg = 0; rg < 16; ++rg) hb[(wave * 16 + rg) * 64 + lane] = d[rg];
            __syncthreads();
#pragma unroll
            for (int j = 0; j < 2; ++j) { const int idx = tid + 512 * j, rg = idx >> 6, ln = idx & 63; float sm = 0.f;
#pragma unroll
                for (int w8 = 0; w8 < 8; ++w8) sm += hb[(w8 * 16 + rg) * 64 + ln];
                lg[crow(rg, ln >> 5) * 33 + (ln & 31)] = sm + rb[ln & 31]; }
            __syncthreads();
#pragma unroll 1
            for (int q = 0; q < 4; ++q) {
                const int tl = 4 * wave + q; const int t = tbase + tl;
                const int myidx = lane & 31;
                float cur = lg[tl * 33 + myidx];
                float tv[4]; int ti4[4];
#pragma unroll
                for (int k = 0; k < 4; ++k) { float bv = cur; int bi = myidx;
#pragma unroll
                    for (int off = 16; off >= 1; off >>= 1) { const float ov = __shfl_xor(bv, off); const int oi = __shfl_xor(bi, off);
                        const bool take = (ov > bv) || (ov == bv && oi < bi); bv = take ? ov : bv; bi = take ? oi : bi; }
                    tv[k] = bv; ti4[k] = bi; if (myidx == bi) cur = -INFINITY; }
                const float e1 = expf(tv[1] - tv[0]), e2 = expf(tv[2] - tv[0]), e3 = expf(tv[3] - tv[0]);
                const float inv = 1.f / (1.f + e1 + e2 + e3);
                if (lane < 4) { const int e = lane == 0 ? ti4[0] : lane == 1 ? ti4[1] : lane == 2 ? ti4[2] : ti4[3];
                    const float pr = (lane == 0 ? 1.f : lane == 1 ? e1 : lane == 2 ? e2 : e3) * inv;
                    sel[(rnd * 32 + tl) * 4 + lane] = e; TOKP[(size_t)t * 4 + lane] = pr; }
            }
            __syncthreads();
        }
        if (tid < 32) { const int e = tid; int n = 0;
            for (int i = 0; i < 256; ++i) n += (sel[i] == e) ? 1 : 0;
            unsigned run = (commit && n > 0) ? __hip_atomic_fetch_add(cnt + 16 * e, (unsigned)n, __ATOMIC_RELAXED, __HIP_MEMORY_SCOPE_AGENT) : 0u;
            for (int i = 0; i < 256; ++i) if (sel[i] == e) { const int t = tb * 64 + (i >> 2);
                if (commit) LIST[(size_t)e * NTOK + run] = t;
                TOKE[(size_t)t * 4 + (i & 3)] = ((unsigned)e << 16) | (run & 0xffffu); ++run; } }
        __syncthreads();
    }
}

__device__ __forceinline__ void build_moe_tab(const Args& a, int l, volatile LAS int* tab) {
    const unsigned* cnt = (const unsigned*)(a.ws + WS_CTL) + CW_CNT + l * 512;
    const int tid = otid();
    __syncthreads();
    if (tid < 32) tab[64 + tid] = (int)__hip_atomic_load(cnt + 16 * tid, __ATOMIC_RELAXED, __HIP_MEMORY_SCOPE_AGENT);
    __syncthreads();
    if (tid == 0) { int s = 0; for (int e = 0; e < 32; ++e) { tab[e] = s; s += (tab[64 + e] + 255) >> 8; } tab[32] = s; }
    __syncthreads();
}

__device__ __forceinline__ void phase_combine(const Args& a, int l, const LAS int* tab, bool dry = false) {
    const int tid = otid(), lane = tid & 63, wave = tid >> 6;
    unsigned char* ws = a.ws;
    float* X = (float*)(ws + WS_X);
    const bf16_t* YM = (const bf16_t*)(ws + WS_YMOE);
    const unsigned* TOKE = (const unsigned*)(ws + WS_TOKE); const float* TOKP = (const float*)(ws + WS_TOKP);
    const float* modl = (const float*)(ws + WS_MISC + MISC_MOD) + (size_t)l * 8 * 6144;
    for (int t = blockIdx.x * 8 + wave; t < NTOK; t += gridDim.x * 8) {
        f32x4 v[4], acc[4];
#pragma unroll
        for (int j = 0; j < 4; ++j) { v[j] = *(const f32x4*)(X + (size_t)t * DM + 4 * lane + 256 * j); acc[j] = (f32x4){0.f, 0.f, 0.f, 0.f}; }
#pragma unroll
        for (int k = 0; k < 4; ++k) { const unsigned ep = TOKE[(size_t)t * 4 + k]; const float pr = TOKP[(size_t)t * 4 + k];
            const int e = ep >> 16, pos = ep & 0xffff; const size_t srow = (size_t)tab[e] * 256 + pos;
#pragma unroll
            for (int j = 0; j < 4; ++j) { const u32x2 y = *(const u32x2*)(YM + srow * DM + 4 * lane + 256 * j);
                acc[j].x += pr * bflo(y.x); acc[j].y += pr * bfhi(y.x); acc[j].z += pr * bflo(y.y); acc[j].w += pr * bfhi(y.y); } }
        const float* mb = modl + (size_t)(t >> 11) * 6144;
#pragma unroll
        for (int j = 0; j < 4; ++j) { const f32x4 gt = *(const f32x4*)(mb + 5120 + 4 * lane + 256 * j); v[j] = v[j] + gt * acc[j]; }
        const float rstd = row_rstd(v, 1e-6f);
        float* Xo = dry ? (float*)(ws + WS_QA) : X; bf16_t* Ho = dry ? (bf16_t*)(ws + WS_QA + (size_t)NTOK * DM * 4) : (bf16_t*)(ws + WS_H); float* Oo = dry ? (float*)(ws + WS_QA) : a.out;
        if (l + 1 < DEPTH) {
#pragma unroll
            for (int j = 0; j < 4; ++j) *(f32x4*)(Xo + (size_t)t * DM + 4 * lane + 256 * j) = v[j];
            const float* mn = modl + (size_t)8 * 6144 + (size_t)(t >> 11) * 6144;
            norm_mod_store(v, rstd, a.in[I_N1G] + (size_t)(l + 1) * DM, mn + 1024, mn, Ho + (size_t)t * DM, lane);
        } else {
#pragma unroll
            for (int j = 0; j < 4; ++j) { const int c = 4 * lane + 256 * j; const f32x4 g = *(const f32x4*)(a.in[I_FNG] + c);
                *(f32x4*)(Oo + (size_t)t * DM + c) = v[j] * rstd * g; }
        }
    }
}

constexpr int NPL = 9;
constexpr int N_PHASES = 2 + NPL * DEPTH;
__global__ void __launch_bounds__(512, 2) fwd(Args a) {
    extern __shared__ __attribute__((aligned(16))) unsigned char smem[];
    LAS unsigned char* lds = (LAS unsigned char*)smem;
    const int tid = threadIdx.x;
    unsigned* ctl = (unsigned*)(a.ws + WS_CTL);
    volatile LAS unsigned* xbw = (volatile LAS unsigned*)(lds + LDS_CTL_OFF);
    volatile LAS int* tab = (volatile LAS int*)(lds + LDS_CTL_OFF + 256);
    volatile LAS int* qw = (volatile LAS int*)(lds + LDS_CTL_OFF + 1024);
    if (tid < 4) xbw[tid] = 0u;
    __syncthreads();
    const int lo = a.ph_lo, hi = a.ph_hi;
    XcdBarrier bar; bar.bar = ctl + CW_BAR; bar.x = 0; bar.st = xbw;
    if (hi - lo > 1) bar = xcd_barrier_post(ctl + CW_BAR, xbw);
#ifndef DUPMASK
#define DUPMASK 0
#endif
#define NREP(k) (((DUPMASK >> PHSEL(k)) & 1) ? 2 : 1)
#ifndef BRMASK
#define BRMASK 7
#endif
#ifndef PHMASK
#define PHMASK 0xFFFFF
#endif
#define PHSEL(k) ((k) < 2 ? (k) : 2 + ((k) - 2) % NPL)
#define IN(k) (((PHMASK >> PHSEL(k)) & 1) && lo <= (k) && (k) < hi)
#define SEAM(k) do { if (IN(k) && IN((k) + 1)) { xcd_barrier(bar); } } while (0)
    unsigned char* ws = a.ws;
    if (IN(0)) { for (int rep = 0; rep < NREP(0); ++rep) { phase_p0(a, lds); __syncthreads(); } SEAM(0); }
    if (IN(1)) { phase_norm1(a, 0); SEAM(1); }
    for (int l = 0; l < DEPTH; ++l) {
        const int pb = 2 + NPL * l;
        if (IN(pb + 0)) {
          for (int rep = 0; rep < NREP(pb + 0); ++rep) {
            pg8::StaticOrder S; S.init(NTOK, PLD, gridDim.x, blockIdx.x);
            pg8::EpiProj E{(bf16_t*)(ws + WS_PROJ), PLD, 29};
            pg8::gemm_phase<pg8::EpiProj, pg8::StaticOrder>(lds, (const bf16_t*)(ws + WS_H), (const bf16_t*)(ws + WS_WIN) + (size_t)l * PLD * DM, DM, 0, S, E);
          }
            SEAM(pb + 0);
        }
        if (IN(pb + 1)) { for (int rep = 0; rep < NREP(pb + 1) + ((DUPMASK >> 17) & 1); ++rep) { phase_rwkv_r1(a, l, lds); } SEAM(pb + 1); }
        if (IN(pb + 2)) {
          for (int rep = 0; rep < NREP(pb + 2); ++rep) {
            {
                pg8::StaticOrder S; S.init(NTOK, RW, gridDim.x, blockIdx.x);
                pg8::EpiProj E{(bf16_t*)(ws + WS_GG), RW, 1 << 30};
                pg8::gemm_phase<pg8::EpiProj, pg8::StaticOrder>(lds, (const bf16_t*)(ws + WS_GS), (const bf16_t*)(ws + WS_MISC + MISC_GUPT) + (size_t)l * RW * 256, 256, 0, S, E);
            }
            for (int u = blockIdx.x; u < 96; u += gridDim.x) rwkv_r2_pair(a, u, lds);
            bool swa_tab = false;
            for (;;) {
                if (tid == 0) *qw = (int)__hip_atomic_fetch_add(ctl + CW_QH + 64 * (2 * l + rep), 1u, __ATOMIC_RELAXED, __HIP_MEMORY_SCOPE_AGENT);
                __syncthreads();
                const int item = *qw;
                __syncthreads();
                if (item >= 768 + 768) break;
                if (item < 768) { diffattn_unit(a, l, item, lds); continue; }
                { const int ztid = otid(), zlane = ztid & 63, zwave = ztid >> 6;
                  LAS float* bA = (LAS float*)(lds + 40960);
                  if (!swa_tab) { const float* bAg = (const float*)(ws + WS_MISC + MISC_BIASA);
                      for (int i = ztid; i < 12 * 129; i += 512) bA[i] = bAg[i];
                      __syncthreads(); swa_tab = true; }
                  swa_wave_unit((const bf16_t*)(ws + WS_PROJ), (float*)(ws + WS_OAG), (float*)(ws + WS_LSE), bA, lds + zwave * 4608, (item - 768) * 8 + zwave, zlane); }
            }
          }
            SEAM(pb + 2);
        }
        if (IN(pb + 3)) { for (int rep = 0; rep < NREP(pb + 3); ++rep) phase_rwkv_out(a, l); SEAM(pb + 3); }
        if (IN(pb + 4)) {
          for (int rep = 0; rep < NREP(pb + 4); ++rep) {
            pg8::StaticOrder S; S.init(NTOK, DM, gridDim.x, blockIdx.x);
            const bf16_t* P = (const bf16_t*)(ws + WS_PROJ); float* MF = (float*)(ws + WS_MF); bf16_t* MG = (bf16_t*)(ws + WS_MERGED);
            { pg8::EpiBranchM E{P, MG}; pg8::gemm_phase<pg8::EpiBranchM, pg8::StaticOrder>(lds, (const bf16_t*)(ws + WS_OA), (const bf16_t*)(ws + WS_WA) + (size_t)l * DM * 1792, 1792, 0, S, E); }
          }
            SEAM(pb + 4);
        }
        if (IN(pb + 5)) {
            pg8::StaticOrder S; S.init(NTOK, DM, gridDim.x, blockIdx.x);
            pg8::EpiOut E{l == 0 ? a.in[I_X] : (const float*)(ws + WS_X), (float*)(ws + WS_X), (const float*)(ws + WS_MISC + MISC_MOD) + (size_t)l * 8 * 6144 + 2048};
            pg8::gemm_phase<pg8::EpiOut, pg8::StaticOrder>(lds, (const bf16_t*)(ws + WS_MERGED), (const bf16_t*)(ws + WS_WO) + (size_t)l * DM * DM, DM, 0, S, E);
            SEAM(pb + 5);
        }
        if (IN(pb + 6)) { for (int rep = 0; rep < NREP(pb + 6); ++rep) phase_route(a, l, lds, rep == NREP(pb + 6) - 1); SEAM(pb + 6); }
        if (IN(pb + 7)) {
          for (int rep = 0; rep < NREP(pb + 7); ++rep) {
            build_moe_tab(a, l, tab);
            unsigned* rtc = ctl + CW_RT + (l * 2 + rep) * 2048;
            {
                pg8::MoeOrder<true> S{(const LAS int*)tab, (const int*)(ws + WS_LIST), 8, (int)gridDim.x, (int)blockIdx.x, rtc};
                pg8::EpiMoe1 E{(bf16_t*)(ws + WS_ACT), a.in[I_B1] + (size_t)l * NE * 2 * FF};
                pg8::gemm_phase<pg8::EpiMoe1, pg8::MoeOrder<true>>(lds, (const bf16_t*)(ws + WS_H), (const bf16_t*)(ws + WS_W1) + (size_t)l * NE * 2 * FF * DM, DM, (size_t)2 * FF * DM * 2, S, E);
            }
            {
                pg8::MoeOrder<false> S{(const LAS int*)tab, nullptr, 4, (int)gridDim.x, (int)(gridDim.x - 1 - blockIdx.x), rtc};
                pg8::EpiMoe2 E{(bf16_t*)(ws + WS_YMOE), a.in[I_B2] + (size_t)l * NE * DM};
                pg8::gemm_phase<pg8::EpiMoe2, pg8::MoeOrder<false>>(lds, (const bf16_t*)(ws + WS_ACT), (const bf16_t*)(ws + WS_W2) + (size_t)l * NE * DM * FF, FF, (size_t)DM * FF * 2, S, E);
            }
          }
            SEAM(pb + 7);
        }
        if (IN(pb + 8)) { build_moe_tab(a, l, tab); for (int rep = 0; rep < NREP(pb + 8); ++rep) phase_combine(a, l, (const LAS int*)tab, rep != NREP(pb + 8) - 1); SEAM(pb + 8); }
    }
#undef IN
#undef SEAM
}

#ifndef MK_ONE_LAUNCH
#define MK_ONE_LAUNCH 1
#endif
extern "C" void kernel_launch(void* const* d_in, const int* in_sizes, int n_in, void* d_out, int out_size, void* d_ws, size_t ws_size, hipStream_t stream) {
    static int grid = 0;
    if (grid == 0) {
        if (n_in != 32 || ws_size < WS_END) { fprintf(stderr, "kernel_launch: unexpected n_in %d or ws %zu < %zu\n", n_in, ws_size, (size_t)WS_END); grid = -1; return; }
        int dev = 0, cus = 0;
        if (hipGetDevice(&dev) != hipSuccess || hipDeviceGetAttribute(&cus, hipDeviceAttributeMultiprocessorCount, dev) != hipSuccess) { grid = -1; return; }
        if (hipFuncSetAttribute((const void*)fwd, hipFuncAttributeMaxDynamicSharedMemorySize, LDS_BYTES) != hipSuccess) { fprintf(stderr, "kernel_launch: hipFuncSetAttribute failed\n"); grid = -1; return; }
        int per_cu = 0;
        if (hipOccupancyMaxActiveBlocksPerMultiprocessor(&per_cu, (const void*)fwd, 512, LDS_BYTES) != hipSuccess || per_cu < 1) fprintf(stderr, "kernel_launch: occupancy query says %d\n", per_cu);
        (void)hipGetLastError();
        grid = cus;
    }
    if (grid < 0) return;
    (void)hipMemsetAsync((char*)d_ws + WS_CTL, 0, CTL_BYTES, stream);
    Args a{};
    for (int i = 0; i < 32; ++i) a.in[i] = (const float*)d_in[i];
    a.out = (float*)d_out; a.ws = (unsigned char*)d_ws;
#if MK_ONE_LAUNCH
    a.ph_lo = 0; a.ph_hi = N_PHASES;
    hipLaunchKernelGGL(fwd, dim3(grid), dim3(512), LDS_BYTES, stream, a);
#else
    for (int p = 0; p < N_PHASES; ++p) { a.ph_lo = p; a.ph_hi = p + 1; hipLaunchKernelGGL(fwd, dim3(grid), dim3(512), LDS_BYTES, stream, a); }
#endif
}
```

```cpp
#include <hip/hip_runtime.h>
#include <stdint.h>
#include <stdio.h>

#define LAS __attribute__((address_space(3)))
typedef unsigned short bf16_t;
typedef short bf16x8 __attribute__((ext_vector_type(8)));
typedef short s16x4 __attribute__((ext_vector_type(4)));
typedef float f32x2 __attribute__((ext_vector_type(2)));
typedef float f32x4 __attribute__((ext_vector_type(4)));
typedef float f32x16 __attribute__((ext_vector_type(16)));
typedef unsigned u32x2 __attribute__((ext_vector_type(2)));
typedef unsigned u32x4 __attribute__((ext_vector_type(4)));
typedef __bf16 bf16x2_t __attribute__((ext_vector_type(2)));
typedef short v4i16_t __attribute__((ext_vector_type(4)));

constexpr int NB = 8, NT = 2048, DM = 1024, NTOK = NB * NT, DEPTH = 2;
constexpr int IN_COLS = 10368, PLD = 10496;
constexpr int C_AQ = 0, C_AK = 768, C_AV = 1536, C_BS = 2304, C_CQ = 5120, C_CK = 5888, C_CV = 6656, C_G = 7424;
constexpr int RSTR = 2688, RW = 768, NE = 32, FF = 1024;
constexpr float LOG2E = 1.4426950408889634f;

constexpr size_t al256(size_t x) { return (x + 255) & ~(size_t)255; }
constexpr size_t WS_CTL = 0;
constexpr size_t CTL_BYTES = 65536;
constexpr size_t WS_MISC = WS_CTL + CTL_BYTES;
constexpr size_t MISC_MOD = 0, MISC_LAM = 393216, MISC_BIASA = 393472, MISC_BIASC = 399872, MISC_WUPT = 409600, MISC_AUPT = 409600 + 393216, MISC_GUPT = 409600 + 2 * 393216, MISC_BYTES = 2 << 20;
constexpr size_t WS_WIN = WS_MISC + MISC_BYTES;
constexpr size_t WS_WA = WS_WIN + (size_t)DEPTH * PLD * DM * 2;
constexpr size_t WS_WB = WS_WA + (size_t)DEPTH * DM * 256 * 2;
constexpr size_t WS_WC = WS_WB + (size_t)DEPTH * DM * 768 * 2;
constexpr size_t WS_WO = WS_WC + (size_t)DEPTH * DM * 768 * 2;
constexpr size_t WS_W1 = WS_WO + (size_t)DEPTH * DM * DM * 2;
constexpr size_t WS_W2 = WS_W1 + (size_t)DEPTH * NE * 2 * FF * DM * 2;
constexpr size_t WS_H = WS_W2 + (size_t)DEPTH * NE * DM * FF * 2;
constexpr size_t WS_X = WS_H + (size_t)NTOK * DM * 2;
constexpr size_t WS_OA = WS_X + (size_t)NTOK * DM * 4;
constexpr size_t WS_OB = WS_OA + (size_t)NTOK * 256 * 2;
constexpr size_t WS_OC = WS_OB + (size_t)NTOK * 768 * 2;
constexpr size_t WS_MERGED = WS_OC + (size_t)NTOK * 768 * 2;
constexpr size_t WS_LIST = WS_MERGED + (size_t)NTOK * DM * 2;
constexpr size_t WS_TOKE = WS_LIST + (size_t)NE * NTOK * 4;
constexpr size_t WS_TOKP = WS_TOKE + (size_t)NTOK * 4 * 4;
constexpr size_t WS_U = WS_TOKP + (size_t)NTOK * 4 * 4;
constexpr size_t WS_PROJ = WS_U;
constexpr size_t WS_RR = WS_PROJ + (size_t)NTOK * PLD * 2;
constexpr size_t WS_RV = WS_RR + (size_t)NTOK * RW * 4;
constexpr size_t WS_RWD = WS_RV + (size_t)NTOK * RW * 4;
constexpr size_t WS_RKK = WS_RWD + (size_t)2 * NTOK * RW * 4;
constexpr size_t WS_RKKA = WS_RKK + (size_t)2 * NTOK * RW * 4;
constexpr size_t WS_RKD = WS_RKKA + (size_t)2 * NTOK * RW * 4;
constexpr size_t WS_GS = WS_RKD + (size_t)2 * NTOK * RW * 4;
constexpr size_t WS_Y = WS_GS + (size_t)NTOK * 128 * 4;
constexpr size_t WS_OAG = WS_Y + (size_t)2 * NTOK * RW * 4;
constexpr size_t WS_LSE = WS_OAG + (size_t)3 * NTOK * 256 * 4;
constexpr size_t WS_MF = WS_LSE + (size_t)3 * NTOK * 4 * 4;
constexpr size_t WS_QA = WS_MF + (size_t)NTOK * DM * 4;
constexpr size_t WS_SS = WS_QA + (size_t)6144 * 4096 * 2;
constexpr size_t WS_END1 = WS_SS + (size_t)6144 * 4096 * 2;
constexpr size_t WS_GG = WS_Y;
constexpr size_t WS_MP = WS_RWD, WS_NP = WS_RKK, WS_Y0 = WS_RKKA;
constexpr int SLOT_ROWS = 4 * NTOK + NE * 256;
constexpr size_t WS_ACT = WS_U;
constexpr size_t WS_YMOE = WS_ACT + (size_t)SLOT_ROWS * FF * 2;
constexpr size_t WS_END2 = WS_YMOE + (size_t)SLOT_ROWS * DM * 2;
constexpr size_t WS_END = WS_END1 > WS_END2 ? WS_END1 : WS_END2;

constexpr int CW_BAR = 0;
constexpr int CW_CNT = 13312;
constexpr int CW_QH = 4224;
constexpr int CW_QR = 4608;
constexpr int CW_RT = 5120;

constexpr int LDS_STAGE = 155648;
constexpr int LDS_CTL_OFF = LDS_STAGE;
constexpr int LDS_BYTES = LDS_STAGE + 4096;

__device__ __forceinline__ int otid() { int t = threadIdx.x; asm volatile("" : "+v"(t)); return t; }
__device__ __forceinline__ int obid() { int t = blockIdx.x; asm volatile("" : "+s"(t)); return t; }
__device__ __forceinline__ unsigned pk2(float lo, float hi) { f32x2 v = {lo, hi}; bf16x2_t b = __builtin_convertvector(v, bf16x2_t); return __builtin_bit_cast(unsigned, b); }
__device__ __forceinline__ u32x4 pack8(const float (&x)[8]) { u32x4 w; w.x = pk2(x[0], x[1]); w.y = pk2(x[2], x[3]); w.z = pk2(x[4], x[5]); w.w = pk2(x[6], x[7]); return w; }
__device__ __forceinline__ bf16_t f2bf(float x) { return (bf16_t)(pk2(x, 0.f) & 0xffffu); }
__device__ __forceinline__ float bflo(unsigned u) { return __builtin_bit_cast(float, u << 16); }
__device__ __forceinline__ float bfhi(unsigned u) { return __builtin_bit_cast(float, u & 0xffff0000u); }
__device__ __forceinline__ float bf2f(bf16_t h) { return __builtin_bit_cast(float, (unsigned)h << 16); }
__device__ __forceinline__ float wave_sum(float v) {
#pragma unroll
    for (int o = 1; o < 64; o <<= 1) v += __shfl_xor(v, o);
    return v;
}
__device__ __forceinline__ float sigmoidf_(float x) { return __builtin_amdgcn_rcpf(1.f + __builtin_amdgcn_exp2f(-LOG2E * x)); }
__device__ __forceinline__ int crow(int r, int hi) { return (r & 3) + 8 * (r >> 2) + 4 * hi; }
__device__ __forceinline__ s16x4 vtr(const LAS unsigned char* p) { return __builtin_bit_cast(s16x4, __builtin_amdgcn_ds_read_tr16_b64_v4i16((LAS v4i16_t*)p)); }
__device__ __forceinline__ float dpp_sum8(float x) {
    int v = __builtin_bit_cast(int, x);
    x += __builtin_bit_cast(float, __builtin_amdgcn_update_dpp(0, v, 0xB1, 0xF, 0xF, true));
    v = __builtin_bit_cast(int, x);
    x += __builtin_bit_cast(float, __builtin_amdgcn_update_dpp(0, v, 0x4E, 0xF, 0xF, true));
    v = __builtin_bit_cast(int, x);
    x += __builtin_bit_cast(float, __builtin_amdgcn_update_dpp(0, v, 0x141, 0xF, 0xF, true));
    return x;
}

#define XB_TMO      128
#define XB_XCNT(j)  (256  + 64 * (j))
#define XB_XSUB(j)  (1280 + 64 * (j))
#define XB_XGEN(j)  (2304 + 64 * (j))
#define XB_TOP      3328
#define XB_TOPGEN   3392
#define XCD_BAR_WORDS 3456
#define XB_SPIN_CAP (1u << 18)
__device__ __forceinline__ unsigned xb_ld(unsigned* p)              { return __hip_atomic_load(p, __ATOMIC_RELAXED, __HIP_MEMORY_SCOPE_AGENT); }
__device__ __forceinline__ unsigned xb_add(unsigned* p, unsigned v) { return __hip_atomic_fetch_add(p, v, __ATOMIC_RELAXED, __HIP_MEMORY_SCOPE_AGENT); }
__device__ __forceinline__ unsigned xb_xcc_id() { return (unsigned)__builtin_amdgcn_s_getreg((3 << 11) | 20) & 0xFu; }
#define XB_SPIN(cond, bar) do { unsigned _sp = 0; while (cond) { __builtin_amdgcn_s_sleep(1); \
    if ((++_sp & 255u) == 0u) { if (xb_ld(&(bar)[XB_TMO])) break; if (_sp > XB_SPIN_CAP) { atomicAdd(&(bar)[XB_TMO], 1u); break; } } } } while (0)
struct XcdBarrier { unsigned* bar; unsigned x; volatile LAS unsigned* st; };
__device__ __forceinline__ XcdBarrier xcd_barrier_post(unsigned* bar, volatile LAS unsigned* st) {
    XcdBarrier b; b.bar = bar; b.x = xb_xcc_id(); b.st = st;
    if (threadIdx.x == 0) (void)xb_add(&bar[XB_XCNT(b.x)], 1u);
    return b;
}
__device__ __forceinline__ void xcd_barrier_complete(unsigned* bar, unsigned x, unsigned& nloc, unsigned& nx) {
    const unsigned G = gridDim.x * gridDim.y * gridDim.z;
    unsigned sum, cnt, mine, sp = 0u;
    for (;;) {
        sum = 0u; cnt = 0u; mine = 0u;
#pragma unroll
        for (unsigned j = 0; j < 16; ++j) { const unsigned c = xb_ld(&bar[XB_XCNT(j)]); sum += c; cnt += (c > 0u) ? 1u : 0u; mine = (j == x) ? c : mine; }
        if (sum == G) break;
        __builtin_amdgcn_s_sleep(1);
        if ((++sp & 255u) == 0u) { if (xb_ld(&bar[XB_TMO])) break; if (sp > XB_SPIN_CAP) { atomicAdd(&bar[XB_TMO], 1u); break; } }
    }
    nloc = mine > 0u ? mine : 1u; nx = cnt > 0u ? cnt : 1u;
}
__device__ __forceinline__ void xcd_barrier(const XcdBarrier& b) {
    asm volatile("s_waitcnt vmcnt(0)" ::: "memory");
    __syncthreads();
    if (threadIdx.x == 0) {
        unsigned* bar = b.bar;
        __builtin_amdgcn_s_waitcnt(0);
        unsigned nloc = b.st[0], nx = b.st[1];
        if (nloc == 0u) { xcd_barrier_complete(bar, b.x, nloc, nx); b.st[0] = nloc; b.st[1] = nx; }
        const unsigned old = xb_add(&bar[XB_XSUB(b.x)], 1u);
        const unsigned gen = old / nloc;
        if (old + 1u == (gen + 1u) * nloc) {
            __builtin_amdgcn_fence(__ATOMIC_RELEASE, "agent");
            asm volatile("s_waitcnt vmcnt(0)" ::: "memory");
            const unsigned og = xb_add(&bar[XB_TOP], 1u);
            const unsigned tg = og / nx;
            if (og + 1u == (tg + 1u) * nx) xb_add(&bar[XB_TOPGEN], 1u);
            else XB_SPIN(xb_ld(&bar[XB_TOPGEN]) == tg, bar);
            __builtin_amdgcn_fence(__ATOMIC_ACQUIRE, "agent");
            xb_add(&bar[XB_XGEN(b.x)], 1u);
            asm volatile("s_waitcnt vmcnt(0)" ::: "memory");
        } else {
            XB_SPIN(xb_ld(&bar[XB_XGEN(b.x)]) == gen, bar);
            __builtin_amdgcn_fence(__ATOMIC_ACQUIRE, "agent");
            asm volatile("s_waitcnt vmcnt(0)" ::: "memory");
        }
    }
    __syncthreads();
}

namespace pg8 {
constexpr int BM = 256, BK = 64, HALF = 128, HTB = HALF * BK * 2, STAGE_BYTES = 8 * HTB, NXCD = 8, WGM = 8;
__device__ __forceinline__ int lds_byte(int r, int c) { const int st = (r >> 4) * 2 + (c >> 5), rr = r & 15, cc = c & 31, ob = rr * 64 + cc * 2; return st * 1024 + (ob ^ (((ob >> 9) & 1) << 5)); }
__device__ __forceinline__ void stage_rc(int b, int& R, int& C) { const int st = b / 1024, sb = b % 1024, swz = sb ^ (((sb >> 9) & 1) << 5); R = (st >> 1) * 16 + swz / 64; C = (st & 1) * 32 + (swz % 64) / 2; }
__device__ __forceinline__ int perm32(int rho) { const int n = rho >> 4, i = rho & 15; return 8 * (i >> 2) + 4 * n + (i & 3); }

struct Unit { int pm, pn, e, lt; };

struct StaticOrder {
    static constexpr bool GATHER = false;
    int nM, nN, nwg, G, c;
    __device__ void init(int M, int N, int G_, int c_) { nM = M / BM; nN = N / BM; nwg = nM * nN; G = G_; c = c_; }
    __device__ __forceinline__ bool next(int i, Unit& u) const { return at((long)i * G + c, u); }
    __device__ __forceinline__ bool at(long L, Unit& u) const {
        if (L >= nwg) return false;
        int wgid = (int)L; { const int q = nwg / NXCD, r = nwg % NXCD, xcd = wgid % NXCD, off = wgid / NXCD; wgid = (xcd < r ? xcd * (q + 1) : r * (q + 1) + (xcd - r) * q) + off; }
        const int nig = WGM * nN, gid = wgid / nig, fm = gid * WGM, gsz = (nM - fm) < WGM ? (nM - fm) : WGM;
        u.pm = fm + ((wgid % nig) % gsz); u.pn = (wgid % nig) / gsz; u.e = 0; u.lt = 0; return true;
    }
    __device__ __forceinline__ int arow(const Unit& u, int r) const { return u.pm * BM + r; }
    __device__ __forceinline__ void a_ready(const Unit&) const {}
    __device__ __forceinline__ void done(const Unit&) const {}
};
struct ProjOrder {
    static constexpr bool GATHER = false;
    StaticOrder so; long limit;
    __device__ __forceinline__ bool next(int i, Unit& u) const { const long L = (long)i * so.G + so.c; return L < limit && so.at(L, u); }
    __device__ __forceinline__ int arow(const Unit& u, int r) const { return u.pm * BM + r; }
    __device__ __forceinline__ void a_ready(const Unit&) const {}
    __device__ __forceinline__ void done(const Unit&) const {}
};
struct LeftOrder {
    static constexpr bool GATHER = false;
    StaticOrder so; long L;
    __device__ __forceinline__ bool next(int i, Unit& u) const { return i == 0 && so.at(L, u); }
    __device__ __forceinline__ int arow(const Unit& u, int r) const { return u.pm * BM + r; }
    __device__ __forceinline__ void a_ready(const Unit&) const {}
    __device__ __forceinline__ void done(const Unit&) const {}
};
template <bool GATHER_> struct MoeOrder {
    static constexpr bool GATHER = GATHER_;
    const LAS int* tab;
    const int* list;
    int ncol, G, c;
    __device__ __forceinline__ bool next(int i, Unit& u) const {
        if (true) {
            const int L = i * G + c; const int total = tab[32] * ncol; if (L >= total) return false;
            const int rt = (ncol == 8) ? (L >> 3) : (L >> 2); u.pn = L - rt * ncol; u.pm = rt;
            const int ln = threadIdx.x & 63; const int tv = tab[ln < 32 ? ln : 32];
            const unsigned long long bal = __ballot(ln < 32 && tv <= rt);
            const int e = __builtin_popcountll(bal) - 1;
            u.e = e; u.lt = rt - __builtin_amdgcn_readlane(tv, e); return true;
        }
        const int x = c & 7, W = G >> 3; int q = i * W + (c >> 3);
#pragma unroll 1
        for (int k = 0; k < 4; ++k) { const int e = x + 8 * k; const int nt_e = tab[e + 1] - tab[e], sz = nt_e * ncol;
            if (q < sz) { const int lt = q / ncol; u.pn = q - lt * ncol; u.lt = lt; u.e = e; u.pm = tab[e] + lt; return true; }
            q -= sz; }
        return false;
    }
    __device__ __forceinline__ int arow(const Unit& u, int r) const {
        if (!GATHER_) return u.pm * BM + r;
        const int pos = u.lt * BM + r; const int cnt = tab[64 + u.e];
        return pos < cnt ? list[(size_t)u.e * NTOK + pos] : 0;
    }
    unsigned* rtc;
    __device__ __forceinline__ void done(const Unit& u) const {
        if (GATHER_) { asm volatile("s_waitcnt vmcnt(0)" ::: "memory");
            if ((threadIdx.x & 63) == 0) __hip_atomic_fetch_add(rtc + 8 * u.pm, 1u, __ATOMIC_RELAXED, __HIP_MEMORY_SCOPE_AGENT); }
    }
    __device__ __forceinline__ void a_ready(const Unit& u) const {
        if (!GATHER_) {
            if (threadIdx.x < 64) {
                unsigned sp = 0;
                while ((unsigned)__builtin_amdgcn_readfirstlane(__hip_atomic_load(rtc + 8 * u.pm, __ATOMIC_RELAXED, __HIP_MEMORY_SCOPE_AGENT)) < 64u) {
                    __builtin_amdgcn_s_sleep(2); if (++sp > (1u << 22)) break; }
                __builtin_amdgcn_fence(__ATOMIC_ACQUIRE, "agent");
                asm volatile("s_waitcnt vmcnt(0)" ::: "memory");
            }
            asm volatile("" ::: "memory"); __builtin_amdgcn_s_barrier(); asm volatile("" ::: "memory");
        }
    }
};

template <class Epi, class Sched>
__device__ __forceinline__ void gemm_phase(LAS unsigned char* lds, const bf16_t* A, const bf16_t* Bt, const int K, const size_t b_estride_bytes, const Sched& S, const Epi& E) {
    constexpr bool GATHER = Sched::GATHER;
    const int tid = otid(), wid = __builtin_amdgcn_readfirstlane(tid >> 6), lane = tid & 63, wr = wid >> 2, wc = wid & 3, fr = lane & 15, fq = lane >> 4;
    const int nt = K / BK;
    int Rr[2], Cc[2]; unsigned voffA[2], voffB[2];
#pragma unroll
    for (int i = 0; i < 2; ++i) { int R, C; stage_rc(tid * 16 + i * 8192, R, C); const int Rb = Epi::PERM ? ((R & ~31) + perm32(R & 31)) : R;
        Rr[i] = R; Cc[i] = C; voffA[i] = (unsigned)(R * K + C) * 2u; voffB[i] = (unsigned)(Rb * K + C) * 2u; }
    const size_t kstep = (size_t)(BK * 2);
    const size_t hstep = (size_t)HALF * K * 2;
    const size_t tstep = 2 * hstep;
    const unsigned ldsw = (unsigned)wid * 1024u;
    const int aoff = lds_byte(wr * 64 + fr, fq * 8), boff = lds_byte(wc * 32 + fr, fq * 8);
#define PG8_SA(b, h) (((b) * 2 + (h)) * HTB)
#define PG8_SB(b, h) ((4 + (b) * 2 + (h)) * HTB)
#define PG8_STAGE(bufoff, gbase, voff) do { _Pragma("unroll") for (int _i = 0; _i < 2; ++_i) \
        __builtin_amdgcn_global_load_lds((const unsigned*)((const char*)(gbase) + (voff)[_i]), (LAS unsigned*)(lds + (bufoff) + ldsw + _i * 8192), 16, 0, 0); } while (0)
#define PG8_STAGEA(bufoff, uptr, offs, h, kb) do { _Pragma("unroll") for (int _i = 0; _i < 2; ++_i) { const char* _src; \
        if constexpr (GATHER) _src = (const char*)A + (size_t)(offs)[h][_i] + (size_t)(kb); else _src = (uptr) + (size_t)(h) * hstep + (size_t)(kb) + voffA[_i]; \
        __builtin_amdgcn_global_load_lds((const unsigned*)_src, (LAS unsigned*)(lds + (bufoff) + ldsw + _i * 8192), 16, 0, 0); } } while (0)
#define PG8_LDA(dst, b, h) do { _Pragma("unroll") for (int m = 0; m < 4; ++m) _Pragma("unroll") for (int k = 0; k < 2; ++k) dst[m][k] = *(const LAS bf16x8*)(lds + PG8_SA(b, h) + aoff + m * 2048 + k * 1024); } while (0)
#define PG8_LDB(dst, b, h) do { _Pragma("unroll") for (int n = 0; n < 2; ++n) _Pragma("unroll") for (int k = 0; k < 2; ++k) dst[n][k] = *(const LAS bf16x8*)(lds + PG8_SB(b, h) + boff + n * 2048 + k * 1024); } while (0)
#define PG8_MMA(ai, bj, At, Bt_) do { __builtin_amdgcn_s_setprio(1); _Pragma("unroll") for (int m = 0; m < 4; ++m) _Pragma("unroll") for (int n = 0; n < 2; ++n) _Pragma("unroll") for (int k = 0; k < 2; ++k) \
        acc[ai][bj][m][n] = __builtin_amdgcn_mfma_f32_16x16x32_bf16(Bt_[n][k], At[m][k], acc[ai][bj][m][n], 0, 0, 0); __builtin_amdgcn_s_setprio(0); } while (0)
#define PG8_WAIT_V(n) asm volatile("s_waitcnt vmcnt(" #n ")" ::: "memory")
#define PG8_WAIT_L(n) asm volatile("s_waitcnt lgkmcnt(" #n ")" ::: "memory")
#define PG8_BAR __builtin_amdgcn_s_barrier()
#define PG8_SCHED __builtin_amdgcn_sched_barrier(0)
#define PG8_TOKISSUE(u, buf) do { if constexpr (GATHER) { if (wid < 4) __builtin_amdgcn_global_load_lds((const unsigned*)(S.list + (size_t)(u).e * NTOK + (u).lt * BM + wid * 64 + lane), \
        (LAS unsigned*)(lds + STAGE_BYTES + (buf) * 1024 + wid * 256), 4, 0, 0); } } while (0)
#define PG8_AOFFS(dst, u, buf) do { if constexpr (GATHER) { const int _cnt = S.tab[64 + (u).e] - (u).lt * BM; _Pragma("unroll") for (int _h = 0; _h < 2; ++_h) _Pragma("unroll") for (int _i = 0; _i < 2; ++_i) { \
        const int _r = _h * HALF + Rr[_i]; const int _tk = *(const LAS int*)(lds + STAGE_BYTES + (buf) * 1024 + _r * 4); \
        dst[_h][_i] = ((unsigned)(_r < _cnt ? _tk : 0) * (unsigned)K + (unsigned)Cc[_i]) * 2u; } } } while (0)
    Unit cur, nxt; int ui = 0;
    if (!S.next(0, cur)) return;
    f32x4 acc[2][2][4][2];
#pragma unroll
    for (int a = 0; a < 2; ++a)
#pragma unroll
        for (int b = 0; b < 2; ++b)
#pragma unroll
            for (int m = 0; m < 4; ++m)
#pragma unroll
                for (int n = 0; n < 2; ++n) acc[a][b][m][n] = (f32x4){0.f, 0.f, 0.f, 0.f};
    bf16x8 At[4][2], B0[2][2], B1[2][2];
    unsigned aoc[2][2] = {{0u, 0u}, {0u, 0u}}, aon[2][2] = {{0u, 0u}, {0u, 0u}};
    if constexpr (GATHER) { PG8_TOKISSUE(cur, 0); asm volatile("s_waitcnt vmcnt(0)" ::: "memory"); __builtin_amdgcn_s_barrier(); asm volatile("" ::: "memory"); PG8_AOFFS(aoc, cur, 0); }
    const char* cA = (const char*)A + (size_t)cur.pm * tstep;
    const char* cB = (const char*)Bt + (size_t)cur.e * b_estride_bytes + (size_t)cur.pn * tstep;
    S.a_ready(cur);
    PG8_STAGE(PG8_SB(0, 0), cB, voffB); PG8_STAGEA(PG8_SA(0, 0), cA, aoc, 0, 0); PG8_STAGE(PG8_SB(0, 1), cB + hstep, voffB); PG8_STAGEA(PG8_SA(0, 1), cA, aoc, 1, 0);
    if (wr == 1) PG8_BAR;
    PG8_WAIT_V(4); PG8_BAR;
    PG8_STAGE(PG8_SB(1, 0), cB + kstep, voffB); PG8_STAGEA(PG8_SA(1, 0), cA, aoc, 0, kstep); PG8_STAGE(PG8_SB(1, 1), cB + hstep + kstep, voffB);
    PG8_WAIT_V(6); PG8_BAR;
    for (;;) {
        const bool has_next = S.next(ui + 1, nxt);
        const char* nA = has_next ? (const char*)A + (size_t)nxt.pm * tstep : cA;
        const char* nB = has_next ? (const char*)Bt + (size_t)nxt.e * b_estride_bytes + (size_t)nxt.pn * tstep : cB;
        if constexpr (GATHER) { if (has_next) PG8_TOKISSUE(nxt, (ui + 1) & 1); }
#define PG8_KITER(t, LASTX) do { \
            const bool last = (LASTX); \
            const size_t k1 = (size_t)(t + 1) * kstep; \
            const size_t k2 = last ? (size_t)0 : (size_t)(t + 2) * kstep; \
            const size_t k3 = k2 + kstep; \
            const char* a2p = last ? nA : cA; \
            unsigned a2o[2][2]; \
_Pragma("unroll") \
            for (int h = 0; h < 2; ++h) \
_Pragma("unroll") \
                for (int i = 0; i < 2; ++i) a2o[h][i] = aoc[h][i]; \
            if constexpr (GATHER) { if (last) { if (has_next) PG8_AOFFS(a2o, nxt, (ui + 1) & 1); \
_Pragma("unroll") \
                for (int h = 0; h < 2; ++h) \
_Pragma("unroll") \
                    for (int i = 0; i < 2; ++i) aon[h][i] = a2o[h][i]; } } \
            const char* b2 = last ? nB : cB + (size_t)(t + 2) * kstep; const char* b3 = b2 + kstep; \
            if (last && has_next) S.a_ready(nxt); \
            PG8_LDB(B0, 0, 0); PG8_SCHED; PG8_LDA(At, 0, 0); PG8_STAGEA(PG8_SA(1, 1), cA, aoc, 1, k1); \
            PG8_WAIT_L(8); PG8_BAR; PG8_WAIT_L(0); PG8_MMA(0, 0, At, B0); PG8_BAR; PG8_SCHED; \
            PG8_LDB(B1, 0, 1); PG8_STAGE(PG8_SB(0, 0), b2, voffB); \
            PG8_BAR; PG8_WAIT_L(0); PG8_MMA(0, 1, At, B1); PG8_BAR; \
            PG8_LDA(At, 0, 1); PG8_STAGEA(PG8_SA(0, 0), a2p, a2o, 0, k2); \
            PG8_BAR; PG8_WAIT_L(0); PG8_MMA(1, 0, At, B0); PG8_BAR; PG8_SCHED; \
            PG8_STAGE(PG8_SB(0, 1), b2 + hstep, voffB); \
            PG8_WAIT_V(6); PG8_BAR; PG8_MMA(1, 1, At, B1); PG8_BAR; \
            PG8_LDB(B0, 1, 0); PG8_SCHED; PG8_LDA(At, 1, 0); PG8_STAGEA(PG8_SA(0, 1), a2p, a2o, 1, k2); \
            PG8_WAIT_L(8); PG8_BAR; PG8_WAIT_L(0); PG8_MMA(0, 0, At, B0); PG8_BAR; PG8_SCHED; \
            PG8_LDB(B1, 1, 1); PG8_STAGE(PG8_SB(1, 0), b3, voffB); \
            PG8_BAR; PG8_WAIT_L(0); PG8_MMA(0, 1, At, B1); PG8_BAR; \
            PG8_LDA(At, 1, 1); PG8_STAGEA(PG8_SA(1, 0), a2p, a2o, 0, k3); \
            PG8_BAR; PG8_WAIT_L(0); PG8_MMA(1, 0, At, B0); PG8_BAR; PG8_SCHED; \
            PG8_STAGE(PG8_SB(1, 1), b3 + hstep, voffB); \
            PG8_WAIT_V(6); PG8_BAR; PG8_MMA(1, 1, At, B1); PG8_BAR; \
        } while (0)
        if constexpr (Epi::MIDHOOK) {
#pragma unroll 1
            for (int t = 0; t < Epi::T1; t += 2) PG8_KITER(t, false);
            asm volatile("" ::: "memory"); __builtin_amdgcn_sched_barrier(0); E.mid(acc, cur, 0, wr, wc, fr, fq); asm volatile("" ::: "memory"); __builtin_amdgcn_sched_barrier(0);
#pragma unroll 1
            for (int t = Epi::T1; t < Epi::T2; t += 2) PG8_KITER(t, false);
            asm volatile("" ::: "memory"); __builtin_amdgcn_sched_barrier(0); E.mid(acc, cur, 1, wr, wc, fr, fq); asm volatile("" ::: "memory"); __builtin_amdgcn_sched_barrier(0);
#pragma unroll 1
            for (int t = Epi::T2; t < nt; t += 2) PG8_KITER(t, t == nt - 2);
        } else {
#pragma unroll 1
            for (int t = 0; t < nt; t += 2) PG8_KITER(t, t == nt - 2);
        }
#undef PG8_KITER
        E(acc, cur, wr, wc, fr, fq); S.done(cur);
        if (!has_next) break;
#pragma unroll
        for (int a = 0; a < 2; ++a)
#pragma unroll
            for (int b = 0; b < 2; ++b)
#pragma unroll
                for (int m = 0; m < 4; ++m)
#pragma unroll
                    for (int n = 0; n < 2; ++n) acc[a][b][m][n] = (f32x4){0.f, 0.f, 0.f, 0.f};
        cur = nxt; cA = nA; cB = nB; ++ui;
#pragma unroll
        for (int h = 0; h < 2; ++h)
#pragma unroll
            for (int i = 0; i < 2; ++i) aoc[h][i] = aon[h][i];
    }
    PG8_WAIT_V(0);
    if (wr == 0) PG8_BAR;
    PG8_BAR;
#undef PG8_SA
#undef PG8_SB
#undef PG8_STAGE
#undef PG8_STAGEA
#undef PG8_LDA
#undef PG8_LDB
#undef PG8_MMA
#undef PG8_WAIT_V
#undef PG8_WAIT_L
#undef PG8_BAR
#undef PG8_SCHED
#undef PG8_AOFFS
#undef PG8_TOKISSUE
}

typedef f32x4 Acc[2][2][4][2];

struct EpiProj {
    static constexpr bool PERM = true, MIDHOOK = false;
    bf16_t* O; int ld; int sg_from;
    __device__ __forceinline__ void operator()(const Acc& acc, const Unit& u, int wr, int wc, int fr, int fq) const {
        const int row0 = u.pm * BM + wr * 64 + fr, col0 = u.pn * BM + wc * 32 + 8 * fq; const bool sg = u.pn >= sg_from;
#pragma unroll
        for (int ai = 0; ai < 2; ++ai)
#pragma unroll
            for (int m = 0; m < 4; ++m) { bf16_t* rowp = O + (size_t)(row0 + ai * HALF + m * 16) * ld + col0;
#pragma unroll
                for (int bj = 0; bj < 2; ++bj) { f32x4 v0 = acc[ai][bj][m][0], v1 = acc[ai][bj][m][1];
                    if (sg) {
#pragma unroll
                        for (int j = 0; j < 4; ++j) { v0[j] = sigmoidf_(v0[j]); v1[j] = sigmoidf_(v1[j]); } }
                    u32x4 w; w.x = pk2(v0[0], v0[1]); w.y = pk2(v0[2], v0[3]); w.z = pk2(v1[0], v1[1]); w.w = pk2(v1[2], v1[3]);
                    *(u32x4*)(rowp + bj * HALF) = w; } }
    }
};
template <int SEG> struct EpiBranch {
    static constexpr bool PERM = true, MIDHOOK = false;
    const bf16_t* P; float* MF; bf16_t* MG;
    __device__ __forceinline__ void operator()(const Acc& acc, const Unit& u, int wr, int wc, int fr, int fq) const {
        const int row0 = u.pm * BM + wr * 64 + fr, col0 = u.pn * BM + wc * 32 + 8 * fq;
#pragma unroll
        for (int ai = 0; ai < 2; ++ai)
#pragma unroll
            for (int m = 0; m < 4; ++m) { const size_t r = (size_t)(row0 + ai * HALF + m * 16);
                asm volatile("" ::: "memory");
#pragma unroll
                for (int bj = 0; bj < 2; ++bj) { const int c = col0 + bj * HALF;
                    const u32x4 g = *(const u32x4*)(P + r * PLD + C_G + SEG * 1024 + c);
                    f32x4 v0 = acc[ai][bj][m][0], v1 = acc[ai][bj][m][1];
                    v0[0] *= bflo(g.x); v0[1] *= bfhi(g.x); v0[2] *= bflo(g.y); v0[3] *= bfhi(g.y);
                    v1[0] *= bflo(g.z); v1[1] *= bfhi(g.z); v1[2] *= bflo(g.w); v1[3] *= bfhi(g.w);
                    float* mp = MF + r * DM + c;
                    if (SEG > 0) { v0 += *(const f32x4*)mp; v1 += *(const f32x4*)(mp + 4); }
                    if (SEG < 2) { *(f32x4*)mp = v0; *(f32x4*)(mp + 4) = v1; }
                    else { u32x4 w; w.x = pk2(v0[0], v0[1]); w.y = pk2(v0[2], v0[3]); w.z = pk2(v1[0], v1[1]); w.w = pk2(v1[2], v1[3]); *(u32x4*)(MG + r * DM + c) = w; } } }
    }
};
struct EpiBranchM {
    static constexpr bool PERM = true, MIDHOOK = true;
    static constexpr int T1 = 4, T2 = 16;
    const bf16_t* P; bf16_t* MG;
    __device__ __forceinline__ void mid(Acc& acc, const Unit& u, int seg, int wr, int wc, int fr, int fq) const {
        const unsigned off0 = ((unsigned)(u.pm * BM + wr * 64 + fr) * (unsigned)PLD + (unsigned)(C_G + seg * 1024 + u.pn * BM + wc * 32 + 8 * fq)) * 2u;
        const char* Pb = (const char*)P;
#pragma unroll
        for (int ai = 0; ai < 2; ++ai)
#pragma unroll
            for (int m = 0; m < 4; ++m) {
#pragma unroll
                for (int bj = 0; bj < 2; ++bj) { const unsigned off = off0 + (unsigned)(((ai * HALF + m * 16) * PLD + bj * HALF) * 2);
                    const u32x4 gp = *(const u32x4*)(Pb + off), gn = *(const u32x4*)(Pb + off + 2048u);
#pragma unroll
                    for (int q = 0; q < 4; ++q) { const float r0 = bflo(gp[q]) * __builtin_amdgcn_rcpf(fmaxf(bflo(gn[q]), 1e-30f)), r1 = bfhi(gp[q]) * __builtin_amdgcn_rcpf(fmaxf(bfhi(gn[q]), 1e-30f));
                        acc[ai][bj][m][q >> 1][2 * (q & 1)] *= r0; acc[ai][bj][m][q >> 1][2 * (q & 1) + 1] *= r1; }
                    asm volatile("" : "+v"(acc[ai][bj][m][0]), "+v"(acc[ai][bj][m][1]) :: "memory"); } }
    }
    __device__ __forceinline__ void operator()(const Acc& acc, const Unit& u, int wr, int wc, int fr, int fq) const {
        const int row0 = u.pm * BM + wr * 64 + fr, col0 = u.pn * BM + wc * 32 + 8 * fq;
#pragma unroll
        for (int ai = 0; ai < 2; ++ai)
#pragma unroll
            for (int m = 0; m < 4; ++m) { const size_t r = (size_t)(row0 + ai * HALF + m * 16);
                asm volatile("" ::: "memory");
#pragma unroll
                for (int bj = 0; bj < 2; ++bj) { const int c = col0 + bj * HALF;
                    const u32x4 g = *(const u32x4*)(P + r * PLD + C_G + 2 * 1024 + c);
                    f32x4 v0 = acc[ai][bj][m][0], v1 = acc[ai][bj][m][1];
                    v0[0] *= bflo(g.x); v0[1] *= bfhi(g.x); v0[2] *= bflo(g.y); v0[3] *= bfhi(g.y);
                    v1[0] *= bflo(g.z); v1[1] *= bfhi(g.z); v1[2] *= bflo(g.w); v1[3] *= bfhi(g.w);
                    u32x4 w; w.x = pk2(v0[0], v0[1]); w.y = pk2(v0[2], v0[3]); w.z = pk2(v1[0], v1[1]); w.w = pk2(v1[2], v1[3]); *(u32x4*)(MG + r * DM + c) = w; } }
    }
};
struct EpiOut {
    static constexpr bool PERM = false, MIDHOOK = false;
    const float* xsrc; float* X; const float* gt;
    __device__ __forceinline__ void operator()(const Acc& acc, const Unit& u, int wr, int wc, int fr, int fq) const {
        const int row0 = u.pm * BM + wr * 64 + fr, col0 = u.pn * BM + wc * 32 + 4 * fq;
        const float* gp = gt + (size_t)((u.pm * BM) >> 11) * 6144 + col0;
        f32x4 gv[2][2];
#pragma unroll
        for (int bj = 0; bj < 2; ++bj)
#pragma unroll
            for (int n = 0; n < 2; ++n) gv[bj][n] = *(const f32x4*)(gp + bj * HALF + n * 16);
#pragma unroll
        for (int ai = 0; ai < 2; ++ai)
#pragma unroll
            for (int m = 0; m < 4; ++m) { const size_t o = (size_t)(row0 + ai * HALF + m * 16) * DM + col0;
#pragma unroll
                for (int bj = 0; bj < 2; ++bj)
#pragma unroll
                    for (int n = 0; n < 2; ++n) { const f32x4 xv = *(const f32x4*)(xsrc + o + bj * HALF + n * 16);
                        *(f32x4*)(X + o + bj * HALF + n * 16) = xv + gv[bj][n] * acc[ai][bj][m][n]; } }
    }
};
struct EpiMoe1 {
    static constexpr bool PERM = true, MIDHOOK = false;
    bf16_t* ACT; const float* b1;
    __device__ __forceinline__ void operator()(const Acc& acc, const Unit& u, int wr, int wc, int fr, int fq) const {
        const int row0 = u.pm * BM + wr * 64 + fr, col0 = u.pn * BM + wc * 32 + 8 * fq;
        const float* bp = b1 + (size_t)u.e * (2 * FF) + col0;
        f32x4 bv[2][2];
#pragma unroll
        for (int bj = 0; bj < 2; ++bj)
#pragma unroll
            for (int n = 0; n < 2; ++n) bv[bj][n] = *(const f32x4*)(bp + bj * HALF + 4 * n);
#pragma unroll
        for (int ai = 0; ai < 2; ++ai)
#pragma unroll
            for (int m = 0; m < 4; ++m) { bf16_t* rowp = ACT + (size_t)(row0 + ai * HALF + m * 16) * FF + (col0 >> 1);
#pragma unroll
                for (int bj = 0; bj < 2; ++bj) { const f32x4 v0 = acc[ai][bj][m][0] + bv[bj][0], v1 = acc[ai][bj][m][1] + bv[bj][1];
                    float a[4];
#pragma unroll
                    for (int q = 0; q < 4; ++q) { const float gl = (q < 2) ? v0[2 * q] : v1[2 * q - 4], ln = (q < 2) ? v0[2 * q + 1] : v1[2 * q - 3];
                        const float xg = fminf(gl, 7.0f), xl = fminf(fmaxf(ln, -7.0f), 7.0f);
                        a[q] = xg * sigmoidf_(1.702f * xg) * (xl + 1.0f); }
                    const unsigned long long w = (unsigned long long)pk2(a[0], a[1]) | ((unsigned long long)pk2(a[2], a[3]) << 32);
                    __hip_atomic_store((unsigned long long*)(rowp + bj * (HALF / 2)), w, __ATOMIC_RELAXED, __HIP_MEMORY_SCOPE_AGENT); } }
    }
};
struct EpiMoe2 {
    static constexpr bool PERM = true, MIDHOOK = false;
    bf16_t* Y; const float* b2;
    __device__ __forceinline__ void operator()(const Acc& acc, const Unit& u, int wr, int wc, int fr, int fq) const {
        const int row0 = u.pm * BM + wr * 64 + fr, col0 = u.pn * BM + wc * 32 + 8 * fq;
        const float* bp = b2 + (size_t)u.e * DM + col0;
        f32x4 bv[2][2];
#pragma unroll
        for (int bj = 0; bj < 2; ++bj)
#pragma unroll
            for (int n = 0; n < 2; ++n) bv[bj][n] = *(const f32x4*)(bp + bj * HALF + 4 * n);
#pragma unroll
        for (int ai = 0; ai < 2; ++ai)
#pragma unroll
            for (int m = 0; m < 4; ++m) { bf16_t* rowp = Y + (size_t)(row0 + ai * HALF + m * 16) * DM + col0;
#pragma unroll
                for (int bj = 0; bj < 2; ++bj) { const f32x4 v0 = acc[ai][bj][m][0] + bv[bj][0], v1 = acc[ai][bj][m][1] + bv[bj][1];
                    u32x4 w; w.x = pk2(v0[0], v0[1]); w.y = pk2(v0[2], v0[3]); w.z = pk2(v1[0], v1[1]); w.w = pk2(v1[2], v1[3]);
                    *(u32x4*)(rowp + bj * HALF) = w; } }
    }
};
}

struct Args { const float* in[32]; float* out; unsigned char* ws; int ph_lo, ph_hi; };
enum { I_X = 0, I_C, I_WMOD, I_BMOD, I_N1G, I_N2G, I_WIN, I_MU, I_W0, I_WUP, I_A0, I_AUP, I_GUP, I_KK, I_KA, I_RK, I_LNG, I_LNB, I_DLAM, I_SUBG, I_RELB, I_WBA, I_WBB, I_WBC, I_WOUT, I_RW, I_RB, I_W1, I_B1, I_W2, I_B2, I_FNG };

__device__ __forceinline__ void lds_fence() { asm volatile("s_waitcnt lgkmcnt(0)" ::: "memory"); }

__device__ __forceinline__ void tr_item(const float* W, int ldw, int ncols, bf16_t* WT, int K, LAS float* scr, int item, int lane) {
    const int nblk = ncols >> 5, kb = item / nblk, nb = item - kb * nblk, k0 = 64 * kb, n0 = 32 * nb;
#pragma unroll 8
    for (int i = 0; i < 32; ++i) { const int kk = 2 * i + (lane >> 5); scr[kk * 33 + (lane & 31)] = __builtin_nontemporal_load(&W[(size_t)(k0 + kk) * ldw + n0 + (lane & 31)]); }
    lds_fence();
    const int c = lane & 7;
#pragma unroll
    for (int j = 0; j < 4; ++j) { const int n = (lane >> 3) + 8 * j; const LAS float* s = scr + (8 * c) * 33 + n;
        u32x4 o; o.x = pk2(s[0 * 33], s[1 * 33]); o.y = pk2(s[2 * 33], s[3 * 33]); o.z = pk2(s[4 * 33], s[5 * 33]); o.w = pk2(s[6 * 33], s[7 * 33]);
        __builtin_nontemporal_store(o, (u32x4*)(WT + (size_t)(n0 + n) * K + k0 + 8 * c)); }
    lds_fence();
}
__device__ __forceinline__ int t5_bucket(int rel) {
    const int ret = rel > 0 ? 16 : 0; const int n = rel < 0 ? -rel : rel;
    int v;
    if (n < 8) v = n; else if (n < 12) v = 8; else if (n < 16) v = 9; else if (n < 23) v = 10; else if (n < 32) v = 11;
    else if (n < 46) v = 12; else if (n < 64) v = 13; else if (n < 91) v = 14; else v = 15;
    return ret + v;
}
__device__ __forceinline__ void phase_p0(const Args& a, LAS unsigned char* lds) {
    const int tid = otid(), lane = tid & 63, wave = tid >> 6, G = gridDim.x;
    unsigned char* ws = a.ws;
    {
        LAS float* scr = (LAS float*)(lds + wave * 8448);
        const int gw = blockIdx.x * 8 + wave, NGW = G * 8;
        constexpr int NITEMS = 65536 + 32768 + 2 * 6592;
        for (int it = gw; it < NITEMS; it += NGW) {
            int r = it;
            if (r < 65536) { const int mat = r >> 10; tr_item(a.in[I_W1] + (size_t)mat * DM * 2 * FF, 2 * FF, 2 * FF, (bf16_t*)(ws + WS_W1) + (size_t)mat * 2 * FF * DM, DM, scr, r & 1023, lane); continue; }
            r -= 65536;
            if (r < 32768) { const int mat = r >> 9; tr_item(a.in[I_W2] + (size_t)mat * FF * DM, DM, DM, (bf16_t*)(ws + WS_W2) + (size_t)mat * DM * FF, FF, scr, r & 511, lane); continue; }
            r -= 32768;
            const int l = r / 6592; r -= l * 6592;
            if (r < 2496) { tr_item(a.in[I_WIN] + (size_t)l * DM * IN_COLS, IN_COLS, 4992, (bf16_t*)(ws + WS_WIN) + (size_t)l * PLD * DM, DM, scr, r, lane); continue; }
            r -= 2496;
            if (r < 2688) { tr_item(a.in[I_WIN] + (size_t)l * DM * IN_COLS + 4992, IN_COLS, 5376, (bf16_t*)(ws + WS_WIN) + (size_t)l * PLD * DM + (size_t)5120 * DM, DM, scr, r, lane); continue; }
            r -= 2688;
            if (r < 128) { tr_item(a.in[I_WBA] + (size_t)l * 256 * DM, DM, DM, (bf16_t*)(ws + WS_WA) + (size_t)l * DM * 1792, 1792, scr, r, lane); continue; }
            r -= 128;
            if (r < 384) { tr_item(a.in[I_WBB] + (size_t)l * 768 * DM, DM, DM, (bf16_t*)(ws + WS_WA) + (size_t)l * DM * 1792 + 256, 1792, scr, r, lane); continue; }
            r -= 384;
            if (r < 384) { tr_item(a.in[I_WBC] + (size_t)l * 768 * DM, DM, DM, (bf16_t*)(ws + WS_WA) + (size_t)l * DM * 1792 + 1024, 1792, scr, r, lane); continue; }
            r -= 384;
            tr_item(a.in[I_WOUT] + (size_t)l * DM * DM, DM, DM, (bf16_t*)(ws + WS_WO) + (size_t)l * DM * DM, DM, scr, r, lane);
        }
        for (int i = blockIdx.x * 512 + tid; i < 2 * 128 * DM / 8; i += G * 512) {
            const int l = i / (128 * DM / 8), o = i - l * (128 * DM / 8);
            *(u32x4*)((bf16_t*)(ws + WS_WIN) + (size_t)l * PLD * DM + (size_t)4992 * DM + (size_t)o * 8) = (u32x4){0u, 0u, 0u, 0u};
        }
    }
    {
        bf16_t* WT = (bf16_t*)(ws + WS_MISC + MISC_WUPT); bf16_t* AT = (bf16_t*)(ws + WS_MISC + MISC_AUPT);
        for (int i = blockIdx.x * 512 + tid; i < 2 * 2 * 12 * 4096; i += G * 512) {
            const int j = i & 63, k = (i >> 6) & 63, hd = (i >> 12) % 12, ld = i / (12 * 4096);
            const size_t src = ((size_t)ld * 64 + j) * RW + hd * 64 + k;
            WT[i] = (bf16_t)(pk2(a.in[I_WUP][src], 0.f) & 0xffffu); AT[i] = (bf16_t)(pk2(a.in[I_AUP][src], 0.f) & 0xffffu);
        }
    }
    {
        bf16_t* GT = (bf16_t*)(ws + WS_MISC + MISC_GUPT);
        for (int i = blockIdx.x * 512 + tid; i < 2 * 768 * 128; i += G * 512) {
            const int k = i & 127, n = (i >> 7) % 768, l2 = i / (768 * 128);
            GT[i] = f2bf(a.in[I_GUP][((size_t)l2 * 128 + k) * RW + n]);
        }
    }
    __syncthreads();
    if ((int)blockIdx.x < 192) {
        LAS float* sc = (LAS float*)(lds + 69632);
        LAS float* red = (LAS float*)(lds + 102400);
        for (int i = tid; i < NB * DM; i += 512) { const float v = a.in[I_C][i]; sc[i] = v / (1.f + expf(-v)); }
        __syncthreads();
        float* mod = (float*)(ws + WS_MISC + MISC_MOD);
        for (int j = blockIdx.x; j < 192; j += G) {
            const int l = j / 96, n0 = (j - l * 96) * 64, jj = tid & 63, ks = tid >> 6;
            float acc[8];
#pragma unroll
            for (int b = 0; b < 8; ++b) acc[b] = 0.f;
            const float* wp = a.in[I_WMOD] + ((size_t)l * DM + ks * 128) * 6144 + n0 + jj;
            for (int k = 0; k < 128; ++k) { const float w = __builtin_nontemporal_load(wp + (size_t)k * 6144);
#pragma unroll
                for (int b = 0; b < 8; ++b) acc[b] += sc[b * DM + ks * 128 + k] * w; }
#pragma unroll
            for (int b = 0; b < 8; ++b) red[(ks * 8 + b) * 64 + jj] = acc[b];
            __syncthreads();
            { const int b = tid >> 6; float s = 0.f;
#pragma unroll
              for (int k2 = 0; k2 < 8; ++k2) s += red[(k2 * 8 + b) * 64 + jj];
              mod[((size_t)l * 8 + b) * 6144 + n0 + jj] = s + a.in[I_BMOD][(size_t)l * 6144 + n0 + jj]; }
            __syncthreads();
        }
    }
    if ((int)blockIdx.x == G - 1) {
        float* lam = (float*)(ws + WS_MISC + MISC_LAM);
        if (tid < 2) { const int l = tid; const float* dl = a.in[I_DLAM] + (size_t)l * 256; float s01 = 0.f, s23 = 0.f;
            for (int d = 0; d < 64; ++d) { s01 += dl[d] * dl[64 + d]; s23 += dl[128 + d] * dl[192 + d]; }
            const float li = 0.8f - 0.6f * expf(-0.3f * (float)l);
            lam[l] = expf(s01) - expf(s23) + li; lam[2 + l] = li; }
        float* bA = (float*)(ws + WS_MISC + MISC_BIASA);
        for (int i = tid; i < 12 * 129; i += 512) { const int head = i / 129, jj = i - head * 129, g = head >> 2; const int dil = (g == 0) ? 1 : (g == 1) ? 4 : 16;
            bA[i] = a.in[I_RELB][t5_bucket((jj - 64) * dil) * 18 + head] * LOG2E; }
        float* bC = (float*)(ws + WS_MISC + MISC_BIASC);
        for (int i = tid; i < 6 * 257; i += 512) { const int h = i / 257, rel = i - h * 257 - 128;
            bC[i] = a.in[I_RELB][t5_bucket(rel) * 18 + 12 + h] * LOG2E; }
    }
}

__device__ __forceinline__ float row_rstd(const f32x4 (&v)[4], float eps) {
    float s = 0.f;
#pragma unroll
    for (int j = 0; j < 4; ++j) s += (v[j].x * v[j].x + v[j].y * v[j].y) + (v[j].z * v[j].z + v[j].w * v[j].w);
    return rsqrtf(wave_sum(s) * (1.f / DM) + eps);
}
__device__ __forceinline__ void norm_mod_store(const f32x4 (&v)[4], float rstd, const float* g, const float* sc, const float* sh, bf16_t* orow, int lane) {
#pragma unroll
    for (int j = 0; j < 4; ++j) { const int c = 4 * lane + 256 * j;
        const f32x4 gv = *(const f32x4*)(g + c), scv = *(const f32x4*)(sc + c), shv = *(const f32x4*)(sh + c);
        const f32x4 y = v[j] * rstd * gv * (scv + 1.0f) + shv;
        u32x2 w; w.x = pk2(y.x, y.y); w.y = pk2(y.z, y.w);
        *(u32x2*)(orow + c) = w; }
}
__device__ __forceinline__ void phase_norm1(const Args& a, int l) {
    const int tid = otid(), lane = tid & 63, wave = tid >> 6;
    const float* mod = (const float*)(a.ws + WS_MISC + MISC_MOD) + (size_t)l * 8 * 6144;
    bf16_t* H = (bf16_t*)(a.ws + WS_H);
    for (int t = blockIdx.x * 8 + wave; t < NTOK; t += gridDim.x * 8) {
        const float* xr = a.in[I_X] + (size_t)t * DM; f32x4 v[4];
#pragma unroll
        for (int j = 0; j < 4; ++j) v[j] = *(const f32x4*)(xr + 4 * lane + 256 * j);
        const float rstd = row_rstd(v, 1e-6f);
        const float* mb = mod + (size_t)(t >> 11) * 6144;
        norm_mod_store(v, rstd, a.in[I_N1G] + (size_t)l * DM, mb + 1024, mb, H + (size_t)t * DM, lane);
    }
}

__device__ __forceinline__ void swa_wave_unit(const bf16_t* P, float* OAG, float* LSE, const LAS float* biasA, LAS unsigned char* vbuf, int u, int lane) {
    const int b = u / 768; const int rem = u - b * 768; const int head = rem >> 6, s = rem & 63;
    const int g = head >> 2, hh = head & 3;
    const int dsh = (g == 0) ? 0 : (g == 1) ? 2 : 4;
    const int L = NT >> dsh, nmbsh = 6 - dsh;
    const int r = s >> nmbsh, mb = s & ((1 << nmbsh) - 1);
    const int r32 = lane & 31, hi = lane >> 5;
    const size_t tq = (size_t)b * NT + ((mb * 32 + r32) << dsh) + r;
    bf16x8 qf[4];
    { const bf16_t* qp = P + tq * PLD + C_AQ + head * 64 + 8 * hi;
#pragma unroll
      for (int s4 = 0; s4 < 4; ++s4) qf[s4] = *(const bf16x8*)(qp + 16 * s4); }
    f32x16 o[2]; o[0] = (f32x16){}; o[1] = (f32x16){};
    float m = -1e30f, lsum = 0.f;
    const float SC = 0.125f * LOG2E;
    const LAS float* bh = biasA + head * 129 + 64;
    const int trbase = (4 * hi + ((lane & 15) >> 2)) * 144 + (16 * ((lane >> 4) & 1) + 4 * (lane & 3)) * 2;
    const int kt_lo = (-mb > -2) ? -mb : -2, kt_hi = ((L >> 5) - 1 - mb < 2) ? (L >> 5) - 1 - mb : 2;
    bf16x8 kfn[4]; u32x4 vn[4];
#define SWA_LOAD(ktx) do { const int _m0 = mb * 32 + (ktx) * 32; \
        { int km = _m0 + r32; km = km < 0 ? 0 : (km > L - 1 ? L - 1 : km); \
          const bf16_t* kp = P + ((size_t)b * NT + (km << dsh) + r) * PLD + C_AK + head * 64 + 8 * hi; \
          _Pragma("unroll") for (int s4 = 0; s4 < 4; ++s4) kfn[s4] = *(const bf16x8*)(kp + 16 * s4); } \
        _Pragma("unroll") for (int c4 = 0; c4 < 4; ++c4) { const int id = lane + 64 * c4, row = id >> 3, ch = id & 7; \
            int vm = _m0 + row; vm = vm < 0 ? 0 : (vm > L - 1 ? L - 1 : vm); \
            vn[c4] = *(const u32x4*)(P + ((size_t)b * NT + (vm << dsh) + r) * PLD + C_AV + head * 64 + ch * 8); } } while (0)
    SWA_LOAD(kt_lo);
    for (int kt = kt_lo; kt <= kt_hi; ++kt) {
        const int m0 = mb * 32 + kt * 32;
        bf16x8 kf[4];
#pragma unroll
        for (int s4 = 0; s4 < 4; ++s4) kf[s4] = kfn[s4];
        asm volatile("" ::: "memory");
#pragma unroll
        for (int c4 = 0; c4 < 4; ++c4) { const int id = lane + 64 * c4, row = id >> 3, ch = id & 7; *(LAS u32x4*)(vbuf + row * 144 + ch * 16) = vn[c4]; }
        if (kt < kt_hi) SWA_LOAD(kt + 1);
        f32x16 sacc = (f32x16){};
#pragma unroll
        for (int s4 = 0; s4 < 4; ++s4) sacc = __builtin_amdgcn_mfma_f32_32x32x16_bf16(kf[s4], qf[s4], sacc, 0, 0, 0);
        float x[16]; float mx = -1e30f;
        if (kt >= -1 && kt <= 1 && m0 >= 0 && m0 + 32 <= L) {
            const LAS float* bp = bh + (kt * 32 - r32 + 4 * hi);
#pragma unroll
            for (int rg = 0; rg < 16; ++rg) { x[rg] = sacc[rg] * SC + bp[(rg & 3) + 8 * (rg >> 2)]; mx = fmaxf(mx, x[rg]); }
        } else {
#pragma unroll
            for (int rg = 0; rg < 16; ++rg) { const int kvl = crow(rg, hi), km = m0 + kvl, j = kt * 32 + kvl - r32;
                const bool valid = (km >= 0) && (km < L) && (j >= -64) && (j <= 64);
                const int jc = j < -64 ? -64 : (j > 64 ? 64 : j);
                const float xv = sacc[rg] * SC + bh[jc];
                x[rg] = valid ? xv : -1e30f; mx = fmaxf(mx, x[rg]); }
        }
        mx = fmaxf(mx, __shfl_xor(mx, 32));
        if (__ballot(mx > m + 8.f) != 0ull) {
            const float mn = fmaxf(m, mx), alpha = __builtin_amdgcn_exp2f(m - mn); m = mn;
            lsum *= alpha;
#pragma unroll
            for (int rg = 0; rg < 16; ++rg) { o[0][rg] *= alpha; o[1][rg] *= alpha; }
        }
        float ps = 0.f;
#pragma unroll
        for (int rg = 0; rg < 16; ++rg) { x[rg] = __builtin_amdgcn_exp2f(x[rg] - m); ps += x[rg]; }
        lsum += ps;
        u32x4 pw[2];
#pragma unroll
        for (int s2 = 0; s2 < 2; ++s2) { pw[s2].x = pk2(x[8 * s2 + 0], x[8 * s2 + 1]); pw[s2].y = pk2(x[8 * s2 + 2], x[8 * s2 + 3]); pw[s2].z = pk2(x[8 * s2 + 4], x[8 * s2 + 5]); pw[s2].w = pk2(x[8 * s2 + 6], x[8 * s2 + 7]); }
        lds_fence();
#pragma unroll
        for (int db = 0; db < 2; ++db)
#pragma unroll
            for (int s2 = 0; s2 < 2; ++s2) {
                const s16x4 lo = vtr(vbuf + trbase + (16 * s2) * 144 + db * 64);
                const s16x4 hi4 = vtr(vbuf + trbase + (16 * s2 + 8) * 144 + db * 64);
                const bf16x8 af = (bf16x8){lo[0], lo[1], lo[2], lo[3], hi4[0], hi4[1], hi4[2], hi4[3]};
                o[db] = __builtin_amdgcn_mfma_f32_32x32x16_bf16(af, __builtin_bit_cast(bf16x8, pw[s2]), o[db], 0, 0, 0);
            }
        asm volatile("" ::: "memory");
    }
#undef SWA_LOAD
    const float lt = lsum + __shfl_xor(lsum, 32);
    const float inv = 1.f / lt;
    bf16_t* op = (bf16_t*)OAG + ((size_t)g * NTOK + tq) * 256 + hh * 64;
#pragma unroll
    for (int db = 0; db < 2; ++db)
#pragma unroll
        for (int i = 0; i < 4; ++i) { u32x2 w; w.x = pk2(o[db][4 * i] * inv, o[db][4 * i + 1] * inv); w.y = pk2(o[db][4 * i + 2] * inv, o[db][4 * i + 3] * inv);
            *(u32x2*)(op + db * 32 + 8 * i + 4 * hi) = w; }
    if (hi == 0) LSE[((size_t)g * NTOK + tq) * 4 + hh] = m + __log2f(lt);
}
__device__ __forceinline__ void phase_swa(const Args& a, LAS unsigned char* lds) {
    const int tid = otid(), lane = tid & 63, wave = tid >> 6;
    LAS float* bA = (LAS float*)(lds + 40960);
    const float* bAg = (const float*)(a.ws + WS_MISC + MISC_BIASA);
    for (int i = tid; i < 12 * 129; i += 512) bA[i] = bAg[i];
    __syncthreads();
    for (int item = blockIdx.x; item < 768; item += gridDim.x)
        swa_wave_unit((const bf16_t*)(a.ws + WS_PROJ), (float*)(a.ws + WS_OAG), (float*)(a.ws + WS_LSE), bA, lds + wave * 4608, item * 8 + wave, lane);
    __syncthreads();
}

constexpr int RLD = 144, RMAT = 64 * RLD;
constexpr int R_P = 0, R_Q = 4 * RMAT, R_M = R_Q + 2 * 17408;
constexpr int R_WD = R_P, R_AD = R_P + RMAT, R_WUP = R_P + 2 * RMAT, R_AUP = R_P + 3 * RMAT;
constexpr int R_LK = R_P, R_RK = R_P + RMAT, R_RB = R_P + 2 * RMAT, R_TT = R_P + 3 * RMAT;
constexpr int R_EI = R_P;
constexpr int R_ZW = R_Q, R_ZA = R_Q + 17408, R_LBF = R_Q, R_SEG = R_ZA, R_GC = R_ZA + 2048, R_W1T = R_ZA + 4096;
constexpr int R_A = R_M, R_B = R_M + 2 * RMAT, R_BP = R_M + 3 * RMAT, R_K = R_M + 4 * RMAT, R_KP = R_M + 5 * RMAT, R_RHO = R_M + 6 * RMAT, R_V = R_M + 7 * RMAT;
constexpr int R_UT = R_B, R_TAT = R_K;
constexpr int R_TMP0 = R_SEG, R_TMP1 = R_ZA + 13312, R_TMP2 = R_ZA + 13312 + 2048;
constexpr int R_PAR = R_M + 8 * RMAT, NPAR = 960;
static_assert(R_PAR + 2 * NPAR * 4 <= LDS_STAGE, "R1 LDS");

template <bool XT, bool YT>
__device__ __forceinline__ f32x16 tile64x(const LAS unsigned char* XM, int x0, const LAS unsigned char* YM, int y0, int lane, f32x16 acc) {
    const int r32 = lane & 31, hi = lane >> 5;
    const int trofs = ((lane & 15) >> 2) * RLD + (16 * ((lane >> 4) & 1) + 4 * (lane & 3)) * 2;
#pragma unroll
    for (int s4 = 0; s4 < 4; ++s4) {
        bf16x8 xa, yb;
        if (!XT) xa = *(const LAS bf16x8*)(XM + (x0 + r32) * RLD + 32 * s4 + 16 * hi);
        else { const s16x4 lo = vtr(XM + (16 * s4 + 8 * hi) * RLD + trofs + 2 * x0), h4 = vtr(XM + (16 * s4 + 8 * hi + 4) * RLD + trofs + 2 * x0);
               xa = (bf16x8){lo[0], lo[1], lo[2], lo[3], h4[0], h4[1], h4[2], h4[3]}; }
        if (!YT) yb = *(const LAS bf16x8*)(YM + (y0 + r32) * RLD + 32 * s4 + 16 * hi);
        else { const s16x4 lo = vtr(YM + (16 * s4 + 8 * hi) * RLD + trofs + 2 * y0), h4 = vtr(YM + (16 * s4 + 8 * hi + 4) * RLD + trofs + 2 * y0);
               yb = (bf16x8){lo[0], lo[1], lo[2], lo[3], h4[0], h4[1], h4[2], h4[3]}; }
        acc = __builtin_amdgcn_mfma_f32_32x32x16_bf16(xa, yb, acc, 0, 0, 0);
    }
    return acc;
}
template <bool MASK, class MP>
__device__ __forceinline__ void shift8r(const u32x4 c, u32x4 m, u32x4 n, bool hm, bool hn, MP mu0, MP mu1, float (&o)[8]) {
    if (MASK) { const unsigned mm = hm ? 0xffffffffu : 0u, nm = hn ? 0xffffffffu : 0u; m = m & mm; n = n & nm; }
#pragma unroll
    for (int q = 0; q < 4; ++q) {
        const f32x2 p = (f32x2){bflo(c[q]), bfhi(c[q])}, pm = (f32x2){bflo(m[q]), bfhi(m[q])}, pn = (f32x2){bflo(n[q]), bfhi(n[q])};
        const f32x2 u0 = (f32x2){mu0[2 * q], mu0[2 * q + 1]}, u1 = (f32x2){mu1[2 * q], mu1[2 * q + 1]};
        const f32x2 r = p + u0 * (pm - p) + u1 * (pn - p);
        o[2 * q] = r[0]; o[2 * q + 1] = r[1];
    }
}
__device__ __forceinline__ float r1_param(const Args& a, int l, int h, int dir, int row, int j) {
    if (row < 10) { const int g = row >> 1, which = row & 1; const int col = (g < 3 ? g * 768 + h * 64 : (g == 3 ? 2304 : 2432) + dir * 64) + j;
        return a.in[I_MU][(size_t)l * 2 * RSTR + (size_t)which * RSTR + col]; }
    const int cb = (l * 2 + dir) * RW + h * 64 + j;
    if (row == 10) return a.in[I_W0][cb];
    if (row == 11) return a.in[I_A0][cb];
    if (row == 12) return a.in[I_KK][cb];
    if (row == 13) return a.in[I_KA][cb];
    return a.in[I_RK][(size_t)l * RW + h * 64 + j];
}
__device__ __forceinline__ int r1_col(int g, int h, int dir, int seg) { return (g < 3 ? g * 768 + h * 64 : (g == 3 ? 2304 : 2432) + dir * 64) + 8 * seg; }
__device__ __forceinline__ void r1_issue(const bf16_t* P, int ct, int tid, u32x4 (&raw)[15]) {
    const int c = ct & 31, dir = (ct >> 5) & 1, bh = ct >> 6, h = bh % 12, b = bh / 12, ti = tid >> 3, seg = tid & 7;
    const int tseq = dir ? (NT - 1 - 64 * c - ti) : (64 * c + ti);
    const char* Pb = (const char*)(P + C_BS);
    const unsigned oc = (unsigned)((b * NT + tseq) * PLD + h * 64 + 8 * seg) * 2u;
    const unsigned dm = tseq > 0 ? (unsigned)PLD * 2u : 0u, dn = tseq < NT - 1 ? (unsigned)PLD * 2u : 0u;
    const unsigned og = oc + (unsigned)(2304 + dir * 64 - h * 64) * 2u;
    const unsigned o0[3] = {oc, oc - dm, oc + dn}, o1[3] = {og, og - dm, og + dn};
#pragma unroll
    for (int g = 0; g < 3; ++g)
#pragma unroll
        for (int w = 0; w < 3; ++w) raw[3 * g + w] = *(const u32x4*)(Pb + (size_t)o0[w] + g * 1536);
#pragma unroll
    for (int g = 3; g < 5; ++g)
#pragma unroll
        for (int w = 0; w < 3; ++w) raw[3 * g + w] = *(const u32x4*)(Pb + (size_t)o1[w] + (g - 3) * 256);
}

__device__ __forceinline__ void phase_rwkv_r1(const Args& a, int l, LAS unsigned char* lds) {
    const int tid0 = otid();
    unsigned char* ws = a.ws;
    const bf16_t* P = (const bf16_t*)(ws + WS_PROJ);
    const float* mu = a.in[I_MU] + (size_t)l * 2 * RSTR;
    const int G = gridDim.x;
    {
        const int glane = tid0 & 63, gwave = tid0 >> 6;
        const float m0a = mu[2560 + 2 * glane], m0b = mu[2560 + 2 * glane + 1], m1a = mu[RSTR + 2560 + 2 * glane], m1b = mu[RSTR + 2560 + 2 * glane + 1];
        unsigned* GSo = (unsigned*)(ws + WS_GS);
#pragma unroll 4
        for (int t = blockIdx.x * 8 + gwave; t < NTOK; t += G * 8) {
            const int ts = t & (NT - 1);
            const unsigned* pc = (const unsigned*)(P + (size_t)t * PLD + C_BS + 2560) + glane;
            const unsigned uc = pc[0], um = ts > 0 ? pc[-(PLD / 2)] : 0u, un = ts < NT - 1 ? pc[PLD / 2] : 0u;
            const float pl = bflo(uc), ph = bfhi(uc);
            const float ga = pl + m0a * (bflo(um) - pl) + m1a * (bflo(un) - pl), gb = ph + m0b * (bfhi(um) - ph) + m1b * (bfhi(un) - ph);
            GSo[(size_t)t * 64 + glane] = pk2(sigmoidf_(ga), sigmoidf_(gb));
        }
    }
    unsigned* qhead = (unsigned*)(ws + WS_CTL) + CW_QR + 128 * l;
    volatile LAS int* qx = (volatile LAS int*)(lds + LDS_CTL_OFF + 1152);
    if (tid0 == 0) { qx[0] = (int)__hip_atomic_fetch_add(qhead, 1u, __ATOMIC_RELAXED, __HIP_MEMORY_SCOPE_AGENT); qx[1] = (int)__hip_atomic_fetch_add(qhead, 1u, __ATOMIC_RELAXED, __HIP_MEMORY_SCOPE_AGENT); }
    __syncthreads();
    int ct = qx[0], ctn = qx[1];
    u32x4 raw[15], wup4, aup4;
    if (ct < 6144) { r1_issue(P, ct, tid0, raw);
        { const int c0 = ct; const size_t wofs = ((size_t)(l * 2 + ((c0 >> 5) & 1)) * 12 + ((c0 >> 6) % 12)) * 4096 + (size_t)(tid0 >> 3) * 64 + 8 * (tid0 & 7);
          wup4 = *(const u32x4*)((const bf16_t*)(ws + WS_MISC + MISC_WUPT) + wofs); aup4 = *(const u32x4*)((const bf16_t*)(ws + WS_MISC + MISC_AUPT) + wofs); }
        const int ct0 = ct, bh0 = ct0 >> 6;
        LAS float* pt = (LAS float*)(lds + R_PAR);
        const int w0_ = __builtin_amdgcn_readfirstlane(tid0 >> 6), j0_ = tid0 & 63;
        pt[tid0] = r1_param(a, l, bh0 % 12, (ct0 >> 5) & 1, w0_, j0_); if (w0_ < 7) pt[tid0 + 512] = r1_param(a, l, bh0 % 12, (ct0 >> 5) & 1, w0_ + 8, j0_); }
    __syncthreads();
    int itn = 0;
    f32x16 po0 = (f32x16){}, po1 = (f32x16){}; int ctp = -1;
#define R1_SWAP(A, B) do { auto _r = __builtin_amdgcn_permlane32_swap((A), (B), false, false); (A) = _r[0]; (B) = _r[1]; } while (0)
#define R1_FLUSH(ctq, LANE, WAVE) do { const int _tt = (WAVE) & 3, _tm = _tt >> 1, _tn = _tt & 1; const size_t _cto = (size_t)(ctq) * 4096; \
        if ((WAVE) < 4) { bf16_t* QA = (bf16_t*)(ws + WS_QA) + _cto; char* MPc = (char*)(ws + WS_MP) + (size_t)(ctq) * 16384; \
            _Pragma("unroll") for (int j = 0; j < 2; ++j) { \
                unsigned ax = pk2(po0[8 * j], po0[8 * j + 1]), ay = pk2(po0[8 * j + 2], po0[8 * j + 3]), bx = pk2(po0[8 * j + 4], po0[8 * j + 5]), by = pk2(po0[8 * j + 6], po0[8 * j + 7]); \
                R1_SWAP(ax, bx); R1_SWAP(ay, by); \
                { u32x4 w; w.x = ax; w.y = ay; w.z = bx; w.w = by; *(u32x4*)(QA + ((_tn * 4 + 2 * _tm + j) * 64 + (LANE)) * 8) = w; } \
                  \
                unsigned hx = pk2(po1[8 * j], po1[8 * j + 1]), hy = pk2(po1[8 * j + 2], po1[8 * j + 3]), gx = pk2(po1[8 * j + 4], po1[8 * j + 5]), gy = pk2(po1[8 * j + 6], po1[8 * j + 7]); \
                unsigned lx = pk2(po1[8 * j] - bflo(hx), po1[8 * j + 1] - bfhi(hx)), ly = pk2(po1[8 * j + 2] - bflo(hy), po1[8 * j + 3] - bfhi(hy)); \
                unsigned mx_ = pk2(po1[8 * j + 4] - bflo(gx), po1[8 * j + 5] - bfhi(gx)), my_ = pk2(po1[8 * j + 6] - bflo(gy), po1[8 * j + 7] - bfhi(gy)); \
                R1_SWAP(hx, gx); R1_SWAP(hy, gy); R1_SWAP(lx, mx_); R1_SWAP(ly, my_); \
                char* _mp = MPc + (size_t)((((_tn * 4 + 2 * _tm + j) * 2) * 64 + (LANE)) * 16); \
                { u32x4 w; w.x = hx; w.y = hy; w.z = gx; w.w = gy; *(u32x4*)_mp = w; } \
                { u32x4 w; w.x = lx; w.y = ly; w.z = mx_; w.w = my_; *(u32x4*)(_mp + 1024) = w; } } \
        } else { unsigned* Y0 = (unsigned*)(ws + WS_Y0) + (size_t)(ctq) * 2048 + (_tt * 64 + (LANE)) * 8;     \
            _Pragma("unroll") for (int p4 = 0; p4 < 2; ++p4) { u32x4 w; w.x = pk2(po0[8 * p4], po0[8 * p4 + 1]); w.y = pk2(po0[8 * p4 + 2], po0[8 * p4 + 3]); w.z = pk2(po0[8 * p4 + 4], po0[8 * p4 + 5]); w.w = pk2(po0[8 * p4 + 6], po0[8 * p4 + 7]); \
                *(u32x4*)(Y0 + 4 * p4) = w; } \
              \
            char* NPc = (char*)(ws + WS_NP) + (size_t)(ctq) * 8192 + (_tt * 64 + (LANE)) * 32; \
            _Pragma("unroll") for (int p4 = 0; p4 < 2; ++p4) { u32x4 w; w.x = pk2(po1[8 * p4], po1[8 * p4 + 1]); w.y = pk2(po1[8 * p4 + 2], po1[8 * p4 + 3]); w.z = pk2(po1[8 * p4 + 4], po1[8 * p4 + 5]); w.w = pk2(po1[8 * p4 + 6], po1[8 * p4 + 7]); \
                *(u32x4*)(NPc + 16 * p4) = w; } } } while (0)
  for (; ct < 6144; ++itn) {
    int tid = tid0; asm volatile("" : "+v"(tid));
    if (tid == 0) qx[0] = (int)__hip_atomic_fetch_add(qhead, 1u, __ATOMIC_RELAXED, __HIP_MEMORY_SCOPE_AGENT);
    const int lane = tid & 63, wave = __builtin_amdgcn_readfirstlane(tid >> 6), r32 = lane & 31, hi = lane >> 5;
    const int ti = tid >> 3, seg = tid & 7;
    const int c = ct & 31, dir = (ct >> 5) & 1, bh = ct >> 6, h = bh % 12, b = bh / 12;
    const int tseq = dir ? (NT - 1 - 64 * c - ti) : (64 * c + ti);
    const size_t trow = (size_t)b * NT + tseq;
    const bool hm = tseq > 0, hn = tseq < NT - 1;
    const LAS float* PT = (const LAS float*)(lds + R_PAR) + (itn & 1) * NPAR;
    float pnx0 = 0.f, pnx1 = 0.f;
    float r8[8], k8[8], v8[8];
    {
        float t8[8], u8[8];
        if (c == 0 || c == 31) {
            shift8r<true>(raw[0], raw[1], raw[2], hm, hn, PT + 0 * 64 + 8 * seg, PT + 1 * 64 + 8 * seg, r8);
            shift8r<true>(raw[3], raw[4], raw[5], hm, hn, PT + 2 * 64 + 8 * seg, PT + 3 * 64 + 8 * seg, k8);
            shift8r<true>(raw[6], raw[7], raw[8], hm, hn, PT + 4 * 64 + 8 * seg, PT + 5 * 64 + 8 * seg, v8);
            shift8r<true>(raw[9], raw[10], raw[11], hm, hn, PT + 6 * 64 + 8 * seg, PT + 7 * 64 + 8 * seg, t8);
            shift8r<true>(raw[12], raw[13], raw[14], hm, hn, PT + 8 * 64 + 8 * seg, PT + 9 * 64 + 8 * seg, u8);
        } else {
            shift8r<false>(raw[0], raw[1], raw[2], hm, hn, PT + 0 * 64 + 8 * seg, PT + 1 * 64 + 8 * seg, r8);
            shift8r<false>(raw[3], raw[4], raw[5], hm, hn, PT + 2 * 64 + 8 * seg, PT + 3 * 64 + 8 * seg, k8);
            shift8r<false>(raw[6], raw[7], raw[8], hm, hn, PT + 4 * 64 + 8 * seg, PT + 5 * 64 + 8 * seg, v8);
            shift8r<false>(raw[9], raw[10], raw[11], hm, hn, PT + 6 * 64 + 8 * seg, PT + 7 * 64 + 8 * seg, t8);
            shift8r<false>(raw[12], raw[13], raw[14], hm, hn, PT + 8 * 64 + 8 * seg, PT + 9 * 64 + 8 * seg, u8);
        }
#pragma unroll
        for (int q = 0; q < 8; ++q) { const float e2 = __expf(2.f * t8[q]); t8[q] = 1.f - 2.f / (e2 + 1.f); }
        *(LAS u32x4*)(lds + R_WD + ti * RLD + 16 * seg) = pack8(t8);
        *(LAS u32x4*)(lds + R_AD + ti * RLD + 16 * seg) = pack8(u8);
        *(LAS u32x4*)(lds + R_WUP + ti * RLD + 16 * seg) = wup4;
        *(LAS u32x4*)(lds + R_AUP + ti * RLD + 16 * seg) = aup4;
        if (dir == 0) *(u32x4*)((bf16_t*)(ws + WS_RV) + trow * RW + h * 64 + 8 * seg) = pack8(v8);
    }
    if (ctp >= 0) R1_FLUSH(ctp, lane, wave);
    if (ctn < 6144) { r1_issue(P, ctn, tid, raw);
        const int bhn = ctn >> 6;
        { const size_t wofs = ((size_t)(l * 2 + ((ctn >> 5) & 1)) * 12 + (bhn % 12)) * 4096 + (size_t)ti * 64 + 8 * seg;
          wup4 = *(const u32x4*)((const bf16_t*)(ws + WS_MISC + MISC_WUPT) + wofs); aup4 = *(const u32x4*)((const bf16_t*)(ws + WS_MISC + MISC_AUPT) + wofs); }
        pnx0 = r1_param(a, l, bhn % 12, (ctn >> 5) & 1, wave, lane); if (wave < 7) pnx1 = r1_param(a, l, bhn % 12, (ctn >> 5) & 1, wave + 8, lane); }
    __syncthreads();
    const int ctnn = qx[0];
    {
        const int p = wave >> 2, tt = wave & 3, tm = tt >> 1, tn = tt & 1;
        f32x16 acc = (f32x16){};
        acc = tile64x<false, false>(lds + (p ? R_AUP : R_WUP), 32 * tm, lds + (p ? R_AD : R_WD), 32 * tn, lane, acc);
        LAS float* Z = (LAS float*)(lds + (p ? R_ZA : R_ZW));
#pragma unroll
        for (int q = 0; q < 4; ++q) *(LAS f32x4*)(Z + (32 * tn + r32) * 68 + 32 * tm + 8 * q + 4 * hi) = (f32x4){acc[4 * q], acc[4 * q + 1], acc[4 * q + 2], acc[4 * q + 3]};
    }
    __syncthreads();
    float kka8[8], kk8[8], kd8[8];
    {
        const LAS float* w0 = PT + 10 * 64 + 8 * seg; const LAS float* a0 = PT + 11 * 64 + 8 * seg;
        const LAS float* kkp = PT + 12 * 64 + 8 * seg; const LAS float* kap = PT + 13 * 64 + 8 * seg;
        LAS float* Zw = (LAS float*)(lds + R_ZW) + ti * 68 + 8 * seg; const LAS float* Za = (const LAS float*)(lds + R_ZA) + ti * 68 + 8 * seg;
        float nrm = 0.f, av[8], e8[8];
#pragma unroll
        for (int q = 0; q < 8; ++q) {
            e8[q] = 0.60653066f * sigmoidf_(w0[q] + Zw[q]);
            av[q] = sigmoidf_(a0[q] + Za[q]);
            const float kr = k8[q] * kkp[q]; kk8[q] = kr; nrm += kr * kr;
            kd8[q] = k8[q] * (1.f + (av[q] - 1.f) * kap[q]);
        }
        nrm = dpp_sum8(nrm);
        const float rn = rsqrtf(fmaxf(nrm, 1e-24f));
#pragma unroll
        for (int q = 0; q < 8; ++q) { kk8[q] *= rn; kka8[q] = kk8[q] * av[q]; Zw[q] = e8[q]; }
        { const LAS float* rkp = PT + 14 * 64 + 8 * seg; float bs = 0.f;
#pragma unroll
          for (int q = 0; q < 8; ++q) bs += r8[q] * kd8[q] * rkp[q];
          bs = dpp_sum8(bs);
          if (seg == 0) ((float*)(ws + WS_RR))[((size_t)dir * NTOK + trow) * 12 + h] = bs; }
    }
    __syncthreads();
    {
        const int kc = tid & 63, sg = tid >> 6;
        LAS float* Zw = (LAS float*)(lds + R_ZW); LAS float* SEG = (LAS float*)(lds + R_SEG);
        float run = 0.f;
#pragma unroll
        for (int q = 0; q < 8; ++q) { run += Zw[(8 * sg + q) * 68 + kc]; Zw[(8 * sg + q) * 68 + kc] = run; }
        SEG[sg * 64 + kc] = run;
        __syncthreads();
        float off = 0.f;
        for (int s2 = 0; s2 < sg; ++s2) off += SEG[s2 * 64 + kc];
        LAS float* EI = (LAS float*)(lds + R_EI);
        float eg = 1.f;
#pragma unroll
        for (int q = 0; q < 8; ++q) { const float g = Zw[(8 * sg + q) * 68 + kc] + off; Zw[(8 * sg + q) * 68 + kc] = g; eg = __expf(-g); EI[(8 * sg + q) * 68 + kc] = eg; }
        if (sg == 7) ((LAS float*)(lds + R_GC))[kc] = eg;
    }
    __syncthreads();
    {
        const LAS float* Gp = (const LAS float*)(lds + R_ZW); const LAS float* EI = (const LAS float*)(lds + R_EI); const LAS float* GCp = (const LAS float*)(lds + R_GC);
        float al[8], be[8], bp[8], ka[8], kp[8], rh[8];
#pragma unroll
        for (int q = 0; q < 8; ++q) {
            const float gi = Gp[ti * 68 + 8 * seg + q], ei = EI[ti * 68 + 8 * seg + q], em = ti > 0 ? EI[(ti - 1) * 68 + 8 * seg + q] : 1.f;
            const float ig = __expf(gi), tl = ig * GCp[8 * seg + q];
            al[q] = em * kk8[q]; be[q] = kka8[q] * ig; bp[q] = kka8[q] * tl; ka[q] = kd8[q] * ig; kp[q] = kd8[q] * tl; rh[q] = r8[q] * ei;
        }
        const int o = ti * RLD + 16 * seg;
        *(LAS u32x4*)(lds + R_A + o) = pack8(al); *(LAS u32x4*)(lds + R_B + o) = pack8(be); *(LAS u32x4*)(lds + R_K + o) = pack8(ka); *(LAS u32x4*)(lds + R_RHO + o) = pack8(rh);
        *(LAS u32x4*)(lds + R_BP + o) = pack8(bp); *(LAS u32x4*)(lds + R_KP + o) = pack8(kp); *(LAS u32x4*)(lds + R_V + o) = pack8(v8);
    }
    __syncthreads();
    {
        const int tt = wave & 3, tm = tt >> 1, tn = tt & 1;
        const int jb = 32 * tm, ib = 32 * tn, i = ib + r32;
        f32x16 acc0 = (f32x16){}, acc1 = (f32x16){};
        if (tm <= tn) {
            acc0 = tile64x<false, false>(lds + (wave < 4 ? R_B : R_K), jb, lds + (wave < 4 ? R_A : R_RHO), ib, lane, acc0);
            acc1 = tile64x<false, false>(lds + (wave < 4 ? R_K : R_B), jb, lds + (wave < 4 ? R_A : R_RHO), ib, lane, acc1);
        }
#pragma unroll
        for (int rg = 0; rg < 16; ++rg) { const int j = jb + crow(rg, hi); const bool keep = (wave < 4) ? (j < i) : (j <= i);
            acc0[rg] = keep ? acc0[rg] : 0.f; acc1[rg] = keep ? acc1[rg] : 0.f; }
#pragma unroll
        for (int q = 0; q < 4; ++q) { const int jo = jb + 8 * q + 4 * hi;
            u32x2 w1; w1.x = pk2(acc1[4 * q], acc1[4 * q + 1]); w1.y = pk2(acc1[4 * q + 2], acc1[4 * q + 3]);
            if (wave < 4) {
                *(LAS f32x4*)((LAS float*)(lds + R_LBF) + i * 68 + jo) = (f32x4){acc0[4 * q], acc0[4 * q + 1], acc0[4 * q + 2], acc0[4 * q + 3]};
                *(LAS u32x2*)(lds + R_LK + i * RLD + 2 * jo) = w1;
                if (wave == 1) { u32x2 wl; wl.x = pk2(acc0[4 * q], acc0[4 * q + 1]); wl.y = pk2(acc0[4 * q + 2], acc0[4 * q + 3]);
                    *(LAS u32x2*)(lds + R_TMP0 + r32 * 64 + 2 * (8 * q + 4 * hi)) = wl; }
            } else {
                u32x2 w0; w0.x = pk2(acc0[4 * q], acc0[4 * q + 1]); w0.y = pk2(acc0[4 * q + 2], acc0[4 * q + 3]);
                *(LAS u32x2*)(lds + R_RK + i * RLD + 2 * jo) = w0;
                *(LAS u32x2*)(lds + R_RB + i * RLD + 2 * jo) = w1;
            } }
    }
    __syncthreads();
    f32x16 ea1 = (f32x16){}, en1 = (f32x16){};
    if (wave < 2) {
        const int blk = wave, col = r32;
        const LAS float* Lf = (const LAS float*)(lds + R_LBF) + (32 * blk) * 68 + 32 * blk;
        f32x2 Tp[16];
#pragma unroll
        for (int j = 0; j < 16; ++j) Tp[j] = (f32x2){0.f, 0.f};
        f32x4 rb[4][8];
#pragma unroll
        for (int r = 1; r <= 3; ++r)
#pragma unroll
            for (int m4 = 0; m4 < (r + 3) / 4; ++m4) rb[r & 3][m4] = *(const LAS f32x4*)(Lf + r * 68 + 4 * m4);
        Tp[0][0] = (col == 0) ? 1.f : 0.f;
#pragma unroll
        for (int i = 1; i < 32; ++i) {
            {
                const int r = (i <= 13) ? i + 3 : ((i >= 16) ? i + 1 : 0);
                if (r > 0 && r < 32) {
#pragma unroll
                    for (int m4 = 0; m4 < (r + 3) / 4; ++m4) rb[r & 3][m4] = *(const LAS f32x4*)(Lf + r * 68 + 4 * m4); }
            }
            f32x2 c01 = (f32x2){(col == i) ? 1.f : 0.f, 0.f}, c23 = (f32x2){0.f, 0.f};
#pragma unroll
            for (int m4 = 0; m4 < (i + 3) / 4; ++m4) { const f32x4 lv = rb[i & 3][m4];
                c01 -= (f32x2){lv[0], lv[1]} * Tp[2 * m4]; c23 -= (f32x2){lv[2], lv[3]} * Tp[2 * m4 + 1]; }
            float ti_ = (c01[0] + c01[1]) + (c23[0] + c23[1]);
            asm volatile("" : "+v"(ti_) :: "memory");
            Tp[i >> 1][i & 1] = ti_;
        }
        float Tm[32];
#pragma unroll
        for (int i = 0; i < 32; ++i) Tm[i] = Tp[i >> 1][i & 1];
        if (hi == 0) {
#pragma unroll
            for (int i = 0; i < 32; ++i) {
                *(LAS bf16_t*)(lds + R_TT + (32 * blk + i) * RLD + 2 * (32 * blk + col)) = f2bf(Tm[i]);
                if (blk == 0) *(LAS bf16_t*)(lds + R_TT + i * RLD + 2 * (32 + col)) = (bf16_t)0;
            }
            if (blk == 0) {
#pragma unroll
                for (int q = 0; q < 4; ++q) { float x8[8];
#pragma unroll
                    for (int e = 0; e < 8; ++e) x8[e] = Tm[8 * q + e];
                    *(LAS u32x4*)(lds + R_TMP1 + col * 64 + 16 * q) = pack8(x8); } }
        }
    } else if (wave >= 4) {
        const int tt = wave & 3, tm = tt >> 1, tn = tt & 1;
        f32x16 acc = (f32x16){};
        acc = tile64x<false, true>(lds + R_LK, 32 * tm, lds + R_V, 32 * tn, lane, acc);
#pragma unroll
        for (int q = 0; q < 4; ++q) { u32x2 w; w.x = pk2(acc[4 * q], acc[4 * q + 1]); w.y = pk2(acc[4 * q + 2], acc[4 * q + 3]);
            *(LAS u32x2*)(lds + R_W1T + (32 * tn + r32) * RLD + 2 * (32 * tm + 8 * q + 4 * hi)) = w; }
        ea1 = tile64x<true, false>(lds + R_V, 32 * tm, lds + R_RK, 32 * tn, lane, ea1);
        en1 = tile64x<true, true>(lds + R_V, 32 * tm, lds + R_KP, 32 * tn, lane, en1);
    }
    __syncthreads();
    if (wave == 0) {
        f32x16 x1 = (f32x16){};
#pragma unroll
        for (int s2 = 0; s2 < 2; ++s2) x1 = __builtin_amdgcn_mfma_f32_32x32x16_bf16(*(const LAS bf16x8*)(lds + R_TMP0 + r32 * 64 + 32 * s2 + 16 * hi), *(const LAS bf16x8*)(lds + R_TMP1 + r32 * 64 + 32 * s2 + 16 * hi), x1, 0, 0, 0);
#pragma unroll
        for (int q = 0; q < 4; ++q) { u32x2 w; w.x = pk2(x1[4 * q], x1[4 * q + 1]); w.y = pk2(x1[4 * q + 2], x1[4 * q + 3]);
            *(LAS u32x2*)(lds + R_TMP2 + r32 * 64 + 2 * (8 * q + 4 * hi)) = w; }
        lds_fence();
        f32x16 t21 = (f32x16){};
#pragma unroll
        for (int s2 = 0; s2 < 2; ++s2) t21 = __builtin_amdgcn_mfma_f32_32x32x16_bf16(*(const LAS bf16x8*)(lds + R_TT + (32 + r32) * RLD + 64 + 32 * s2 + 16 * hi), *(const LAS bf16x8*)(lds + R_TMP2 + r32 * 64 + 32 * s2 + 16 * hi), t21, 0, 0, 0);
#pragma unroll
        for (int rg = 0; rg < 16; ++rg) *(LAS bf16_t*)(lds + R_TT + (32 + crow(rg, hi)) * RLD + 2 * r32) = f2bf(-t21[rg]);
    }
    __syncthreads();
    {
        const int tt = wave & 3, tm = tt >> 1, tn = tt & 1;
        f32x16 acc = (f32x16){};
        if (wave < 4) acc = tile64x<false, false>(lds + R_TT, 32 * tm, lds + R_W1T, 32 * tn, lane, acc);
        else          acc = tile64x<false, true>(lds + R_TT, 32 * tm, lds + R_A, 32 * tn, lane, acc);
        LAS unsigned char* dst = lds + (wave < 4 ? R_UT : R_TAT);
#pragma unroll
        for (int q = 0; q < 4; ++q) { u32x2 w; w.x = pk2(acc[4 * q], acc[4 * q + 1]); w.y = pk2(acc[4 * q + 2], acc[4 * q + 3]);
            *(LAS u32x2*)(dst + (32 * tn + r32) * RLD + 2 * (32 * tm + 8 * q + 4 * hi)) = w; }
    }
    __syncthreads();
    {
        const int tt = wave & 3, tm = tt >> 1, tn = tt & 1;
        if (wave < 4) {
            f32x16 acc = (f32x16){};
            acc = tile64x<false, false>(lds + R_TAT, 32 * tm, lds + R_RB, 32 * tn, lane, acc);
#pragma unroll
            for (int q = 0; q < 4; ++q) { const int i = 32 * tn + r32, k = 32 * tm + 8 * q + 4 * hi;
                const u32x2 rv = *(const LAS u32x2*)(lds + R_RHO + i * RLD + 2 * k);
                po0[4 * q] = bflo(rv.x) - acc[4 * q]; po0[4 * q + 1] = bfhi(rv.x) - acc[4 * q + 1]; po0[4 * q + 2] = bflo(rv.y) - acc[4 * q + 2]; po0[4 * q + 3] = bfhi(rv.y) - acc[4 * q + 3]; }
            f32x16 am = (f32x16){};
            am = tile64x<false, true>(lds + R_TAT, 32 * tm, lds + R_BP, 32 * tn, lane, am);
            const LAS float* GC = (const LAS float*)(lds + R_GC);
            { const int kp = 32 * tn + r32; const float gck = GC[kp];
#pragma unroll
              for (int q = 0; q < 4; ++q) { const int k0 = 32 * tm + 8 * q + 4 * hi;
#pragma unroll
                for (int e = 0; e < 4; ++e) po1[4 * q + e] = ((k0 + e == kp) ? gck : 0.f) - am[4 * q + e]; } }
        } else {
            f32x16 a2 = (f32x16){};
            a2 = tile64x<false, false>(lds + R_UT, 32 * tm, lds + R_RB, 32 * tn, lane, a2);
            po0 = ea1 - a2;
            f32x16 n2 = (f32x16){};
            n2 = tile64x<false, true>(lds + R_UT, 32 * tm, lds + R_BP, 32 * tn, lane, n2);
            po1 = en1 - n2;
        }
        ctp = ct;
    }
    if (ctn < 6144) { LAS float* pn = (LAS float*)(lds + R_PAR) + ((itn + 1) & 1) * NPAR; pn[tid] = pnx0; if (tid + 512 < NPAR) pn[tid + 512] = pnx1; }
    __syncthreads();
    ct = ctn; ctn = ctnn;
  }
    if (ctp >= 0) { const int lane = tid0 & 63, wave = __builtin_amdgcn_readfirstlane(tid0 >> 6); R1_FLUSH(ctp, lane, wave); }
#undef R1_FLUSH
#undef R1_SWAP
}

__device__ __forceinline__ void rwkv_r2_pair(const Args& a, int pair, LAS unsigned char* lds) {
    const int tid = otid(), lane = tid & 63, wave = __builtin_amdgcn_readfirstlane(tid >> 6);
    unsigned char* ws = a.ws;
    const int grp = wave >> 2, wg = wave & 3, unit = 2 * pair + grp;
    LAS float* S = (LAS float*)(lds + grp * 17408);
    const int vt = wg >> 1, kt = wg & 1, r32 = lane & 31, hi = lane >> 5;
    for (int i = tid; i < 2 * 64 * 68; i += 512) ((LAS float*)lds)[i] = 0.f;
    const char* Mgd = (const char*)(ws + WS_MP) + (size_t)unit * 32 * 16384 + wg * 4096 + lane * 16;
    const char* Qgd = (const char*)(ws + WS_QA) + (size_t)unit * 32 * 8192 + wg * 2048 + lane * 16;
    const char* Ng = (const char*)(ws + WS_NP) + (size_t)unit * 32 * 8192 + (wg * 64 + lane) * 32;
    const int ydir = grp, yh = pair % 12, yb = pair / 12;
    const unsigned* Y0b = (const unsigned*)(ws + WS_Y0) + (size_t)unit * 32 * 2048 + (wg * 64 + lane) * 8;
    bf16_t* YB = (bf16_t*)(ws + WS_SS) + ((size_t)ydir * NTOK + (size_t)yb * NT) * RW + yh * 64 + 32 * vt;
    LAS unsigned char* obuf = lds + 36864 + grp * 24576;
#define R2_DMA(cc) do { const char* _m = Mgd + (size_t)(cc) * 16384; const char* _q = Qgd + (size_t)(cc) * 8192; LAS unsigned char* _b = obuf + ((cc) & 1) * 49152; \
        _Pragma("unroll") for (int j = 0; j < 4; ++j) __builtin_amdgcn_global_load_lds((const unsigned*)(_m + j * 1024), (LAS unsigned*)(_b + wg * 4096 + j * 1024), 16, 0, 0); \
        _Pragma("unroll") for (int j = 0; j < 2; ++j) __builtin_amdgcn_global_load_lds((const unsigned*)(_q + j * 1024), (LAS unsigned*)(_b + 16384 + wg * 2048 + j * 1024), 16, 0, 0); } while (0)
#define R2_DECL(X) u32x2 np##X[4]; unsigned y0##X[8]
#define R2_LOADR(X, cc) do { \
        { const u32x4 _n0 = *(const u32x4*)(Ng + (size_t)(cc) * 8192), _n1 = *(const u32x4*)(Ng + (size_t)(cc) * 8192 + 16); \
          np##X[0].x = _n0.x; np##X[0].y = _n0.y; np##X[1].x = _n0.z; np##X[1].y = _n0.w; np##X[2].x = _n1.x; np##X[2].y = _n1.y; np##X[3].x = _n1.z; np##X[3].y = _n1.w; } \
        { const u32x4 _y0 = *(const u32x4*)(Y0b + (size_t)(cc) * 2048), _y1 = *(const u32x4*)(Y0b + (size_t)(cc) * 2048 + 4); \
          y0##X[0] = _y0.x; y0##X[1] = _y0.y; y0##X[2] = _y0.z; y0##X[3] = _y0.w; y0##X[4] = _y1.x; y0##X[5] = _y1.y; y0##X[6] = _y1.z; y0##X[7] = _y1.w; } } while (0)
#define R2_STEP(X, XN, cc) do { \
        if ((cc) + 1 < 32) { R2_DMA((cc) + 1); R2_LOADR(XN, (cc) + 1); } \
        asm volatile("" ::: "memory"); \
        f32x16 ya = (f32x16){}, a0, a1 = (f32x16){}; \
        _Pragma("unroll") for (int q = 0; q < 4; ++q) { a0[4 * q] = bflo(np##X[q].x); a0[4 * q + 1] = bfhi(np##X[q].x); a0[4 * q + 2] = bflo(np##X[q].y); a0[4 * q + 3] = bfhi(np##X[q].y); } \
        bf16x8 xh[4], xl[4]; \
        _Pragma("unroll") for (int s4 = 0; s4 < 4; ++s4) { const LAS float* sp = S + (32 * vt + r32) * 68 + 16 * s4 + 8 * hi; \
            const f32x4 s0 = *(const LAS f32x4*)sp, s1 = *(const LAS f32x4*)(sp + 4); \
            u32x4 hw; hw.x = pk2(s0.x, s0.y); hw.y = pk2(s0.z, s0.w); hw.z = pk2(s1.x, s1.y); hw.w = pk2(s1.z, s1.w); \
            u32x4 lw; lw.x = pk2(s0.x - bflo(hw.x), s0.y - bfhi(hw.x)); lw.y = pk2(s0.z - bflo(hw.y), s0.w - bfhi(hw.y)); \
            lw.z = pk2(s1.x - bflo(hw.z), s1.y - bfhi(hw.z)); lw.w = pk2(s1.z - bflo(hw.w), s1.w - bfhi(hw.w)); \
            xh[s4] = __builtin_bit_cast(bf16x8, hw); xl[s4] = __builtin_bit_cast(bf16x8, lw); } \
        { const LAS unsigned char* _mb = obuf + ((cc) & 1) * 49152 + lane * 16; \
          _Pragma("unroll") for (int s4 = 0; s4 < 4; ++s4) { \
            const bf16x8 mh = *(const LAS bf16x8*)(_mb + ((kt * 4 + s4) * 2) * 1024), ml = *(const LAS bf16x8*)(_mb + ((kt * 4 + s4) * 2 + 1) * 1024); \
            const bf16x8 qa = *(const LAS bf16x8*)(_mb + 16384 + (kt * 4 + s4) * 1024); \
            a0 = __builtin_amdgcn_mfma_f32_32x32x16_bf16(xh[s4], mh, a0, 0, 0, 0); \
            a1 = __builtin_amdgcn_mfma_f32_32x32x16_bf16(xl[s4], mh, a1, 0, 0, 0); \
            ya = __builtin_amdgcn_mfma_f32_32x32x16_bf16(xh[s4], qa, ya, 0, 0, 0); \
            a1 = __builtin_amdgcn_mfma_f32_32x32x16_bf16(xh[s4], ml, a1, 0, 0, 0); } } \
        _Pragma("unroll") for (int p = 0; p < 8; ++p) { ya[2 * p] += bflo(y0##X[p]); ya[2 * p + 1] += bfhi(y0##X[p]); } \
        { const int il = 32 * kt + r32; const int tseq = ydir ? (NT - 1 - 64 * (cc) - il) : (64 * (cc) + il); \
            \
          _Pragma("unroll") for (int p = 0; p < 2; ++p) { \
              unsigned ax = pk2(ya[8 * p], ya[8 * p + 1]), ay = pk2(ya[8 * p + 2], ya[8 * p + 3]), bx = pk2(ya[8 * p + 4], ya[8 * p + 5]), by = pk2(ya[8 * p + 6], ya[8 * p + 7]); \
              { auto _r = __builtin_amdgcn_permlane32_swap(ax, bx, false, false); ax = _r[0]; bx = _r[1]; } \
              { auto _r = __builtin_amdgcn_permlane32_swap(ay, by, false, false); ay = _r[0]; by = _r[1]; } \
              u32x4 w; w.x = ax; w.y = ay; w.z = bx; w.w = by; \
              *(u32x4*)(YB + (size_t)tseq * RW + 8 * (2 * p + hi)) = w; } } \
        a0 += a1; \
          \
          \
        asm volatile("s_waitcnt vmcnt(4) lgkmcnt(0)" ::: "memory"); __builtin_amdgcn_s_barrier(); asm volatile("" ::: "memory"); \
        _Pragma("unroll") for (int rg = 0; rg < 16; ++rg) S[(32 * vt + crow(rg, hi)) * 68 + 32 * kt + r32] = a0[rg]; \
        asm volatile("s_waitcnt lgkmcnt(0)" ::: "memory"); __builtin_amdgcn_s_barrier(); asm volatile("" ::: "memory"); } while (0)
    R2_DECL(A); R2_DECL(B);
    R2_DMA(0); R2_LOADR(A, 0);
    asm volatile("s_waitcnt vmcnt(0)" ::: "memory");
    __syncthreads();
#pragma unroll 1
    for (int c = 0; c < 32; c += 2) {
        R2_STEP(A, B, c);
        R2_STEP(B, A, c + 1);
    }
#undef R2_DMA
#undef R2_DECL
#undef R2_LOADR
#undef R2_STEP
}

__device__ __forceinline__ void phase_rwkv_out(const Args& a, int l) {
    const int tid = otid(), lane = tid & 63, wave = tid >> 6;
    unsigned char* ws = a.ws;
    const bf16_t* YB = (const bf16_t*)(ws + WS_SS); const bf16_t* RV = (const bf16_t*)(ws + WS_RV); const float* BS = (const float*)(ws + WS_RR);
    const bf16_t* GG = (const bf16_t*)(ws + WS_GG); bf16_t* OB = (bf16_t*)(ws + WS_OA) + 256;
    const float* lng = a.in[I_LNG] + (size_t)l * RW; const float* lnb = a.in[I_LNB] + (size_t)l * RW;
    for (int t = blockIdx.x * 8 + wave; t < NTOK; t += gridDim.x * 8) {
#pragma unroll
        for (int it = 0; it < 3; ++it) { const int c0 = it * 256 + lane * 4, hd = c0 >> 6;
            const u32x2 uf = *(const u32x2*)(YB + (size_t)t * RW + c0), ub = *(const u32x2*)(YB + ((size_t)NTOK + t) * RW + c0);
            float y0 = bflo(uf.x) + bflo(ub.x), y1 = bfhi(uf.x) + bfhi(ub.x), y2 = bflo(uf.y) + bflo(ub.y), y3 = bfhi(uf.y) + bfhi(ub.y);
            float sm = (y0 + y1) + (y2 + y3);
#pragma unroll
            for (int o = 1; o < 16; o <<= 1) sm += __shfl_xor(sm, o);
            const float mean = sm * (1.f / 64.f);
            y0 -= mean; y1 -= mean; y2 -= mean; y3 -= mean;
            float sv = (y0 * y0 + y1 * y1) + (y2 * y2 + y3 * y3);
#pragma unroll
            for (int o = 1; o < 16; o <<= 1) sv += __shfl_xor(sv, o);
            const float rstd = rsqrtf(sv * (1.f / 64.f) + 64e-5f);
            const float s0 = BS[(size_t)t * 12 + hd] + BS[((size_t)NTOK + t) * 12 + hd];
            const f32x4 g4 = *(const f32x4*)(lng + c0), b4 = *(const f32x4*)(lnb + c0);
            const u32x2 vv = *(const u32x2*)(RV + (size_t)t * RW + c0), gg = *(const u32x2*)(GG + (size_t)t * RW + c0);
            const float o0 = (y0 * rstd * g4.x + b4.x + s0 * bflo(vv.x)) * bflo(gg.x), o1 = (y1 * rstd * g4.y + b4.y + s0 * bfhi(vv.x)) * bfhi(gg.x);
            const float o2 = (y2 * rstd * g4.z + b4.z + s0 * bflo(vv.y)) * bflo(gg.y), o3 = (y3 * rstd * g4.w + b4.w + s0 * bfhi(vv.y)) * bfhi(gg.y);
            u32x2 w; w.x = pk2(o0, o1); w.y = pk2(o2, o3);
            *(u32x2*)(OB + (size_t)t * 1792 + c0) = w; }
    }
    const float* OAG = (const float*)(ws + WS_OAG); const float* LSE = (const float*)(ws + WS_LSE); bf16_t* OA = (bf16_t*)(ws + WS_OA);
    for (int task = blockIdx.x * 8 + wave; task < NTOK / 4; task += gridDim.x * 8) {
#pragma unroll
        for (int tk = 0; tk < 4; ++tk) { const size_t t = (size_t)task * 4 + tk; const int hh = lane >> 4;
            const float l0 = LSE[((size_t)0 * NTOK + t) * 4 + hh], l1 = LSE[((size_t)1 * NTOK + t) * 4 + hh], l2 = LSE[((size_t)2 * NTOK + t) * 4 + hh];
            const float mx = fmaxf(l0, fmaxf(l1, l2));
            const float w0 = __builtin_amdgcn_exp2f(l0 - mx), w1 = __builtin_amdgcn_exp2f(l1 - mx), w2 = __builtin_amdgcn_exp2f(l2 - mx);
            const float inv = 1.f / (w0 + w1 + w2);
            const bf16_t* OAb = (const bf16_t*)OAG;
            const u32x2 u0 = *(const u32x2*)(OAb + ((size_t)0 * NTOK + t) * 256 + lane * 4), u1 = *(const u32x2*)(OAb + ((size_t)1 * NTOK + t) * 256 + lane * 4), u2 = *(const u32x2*)(OAb + ((size_t)2 * NTOK + t) * 256 + lane * 4);
            const f32x4 o0 = (f32x4){bflo(u0.x), bfhi(u0.x), bflo(u0.y), bfhi(u0.y)}, o1 = (f32x4){bflo(u1.x), bfhi(u1.x), bflo(u1.y), bfhi(u1.y)}, o2 = (f32x4){bflo(u2.x), bfhi(u2.x), bflo(u2.y), bfhi(u2.y)};
            const f32x4 r = (o0 * w0 + o1 * w1 + o2 * w2) * inv;
            u32x2 w; w.x = pk2(r.x, r.y); w.y = pk2(r.z, r.w);
            *(u32x2*)(OA + t * 1792 + lane * 4) = w; }
    }
}

__device__ __forceinline__ int vk_off(int row, int ch) { return 2048 * (row >> 3) + 512 * (ch >> 2) + 64 * (row & 7) + 16 * ((ch & 3) ^ ((row >> 2) & 3)); }
__device__ __forceinline__ void diffattn_unit(const Args& a, int l, int unit, LAS unsigned char* lds) {
    constexpr int TB = 16384;
    const int b = unit / 96; const int rem = unit - b * 96; const int h = rem >> 4, qb = rem & 15;
    const int tid = otid(), lane = tid & 63, wave = __builtin_amdgcn_readfirstlane(tid >> 6), r32 = lane & 31, hi = lane >> 5;
    const int c = wave & 1, qblk = wave >> 1;
    const int q0 = qb * 128 + qblk * 32;
    const bf16_t* P = (const bf16_t*)(a.ws + WS_PROJ);
    const size_t rowb = (size_t)b * NT;
    unsigned kvo;
    { const int r7 = (lane >> 2) & 7, row = 8 * wave + r7, chv = 4 * (lane >> 5) + ((lane & 3) ^ ((2 * wave + (r7 >> 2)) & 3));
        kvo = (unsigned)(row * PLD + chv * 8) * 2u; }
    const char* kgd = (const char*)(P + rowb * PLD + C_CK + h * 128); const char* vgd = (const char*)(P + rowb * PLD + C_CV + h * 128);
#define DA_DMA(src, tt, dstoff) do { const char* _tb = (src) + (size_t)(64 * (tt)) * PLD * 2; _Pragma("unroll") for (int jj = 0; jj < 2; ++jj) \
        __builtin_amdgcn_global_load_lds((const unsigned*)(_tb + 128 * jj + kvo), (LAS unsigned*)(lds + (dstoff) + 1024 * (2 * wave + jj)), 16, 0, 0); } while (0)
    DA_DMA(kgd, 0, 0); DA_DMA(vgd, 0, 2 * TB); DA_DMA(kgd, 1, TB);
    bf16x8 qf[4];
    { const bf16_t* qp = P + (rowb + q0 + r32) * PLD + C_CQ + h * 128 + c * 64 + 8 * hi;
#pragma unroll
      for (int s4 = 0; s4 < 4; ++s4) qf[s4] = *(const bf16x8*)(qp + 16 * s4); }
    LAS float* biasL = (LAS float*)(lds + 69632);
    const float lam = ((const float*)(a.ws + WS_MISC + MISC_LAM))[l], linit = ((const float*)(a.ws + WS_MISC + MISC_LAM))[2 + l];
    { const float* bC = (const float*)(a.ws + WS_MISC + MISC_BIASC) + h * 257;
      { const int rel = tid - 256; biasL[tid] = bC[(rel < -128 ? -128 : (rel > 128 ? 128 : rel)) + 128]; }
      if (tid < 128) biasL[512 + tid] = a.in[I_SUBG][(size_t)l * 128 + tid]; }
    asm volatile("s_waitcnt vmcnt(0)" ::: "memory"); __syncthreads();
    f32x16 o[4];
#pragma unroll
    for (int db = 0; db < 4; ++db) o[db] = (f32x16){};
    float m = -1e30f, lsum = 0.f;
    const float SC = 0.125f * LOG2E;
    const int chlo = 2 * ((lane >> 4) & 1) + ((lane & 3) >> 1);
    const int trb0 = 64 * (4 * hi + ((lane & 15) >> 2)) + 16 * (chlo ^ (hi & 3)) + 8 * (lane & 1);
    const int trb1 = 64 * (4 * hi + ((lane & 15) >> 2)) + 16 * (chlo ^ ((2 + hi) & 3)) + 8 * (lane & 1) + 2048;
    const int qabs = q0 + r32;
    const int ko0 = vk_off(r32, 8 * c + hi), ko1 = vk_off(32 + r32, 8 * c + hi);
#define DA_QK(SA0, SA1, Kb) do { SA0 = (f32x16){}; SA1 = (f32x16){}; bf16x8 _kf0[4], _kf1[4]; \
        _Pragma("unroll") for (int s4 = 0; s4 < 4; ++s4) { _kf0[s4] = *(const LAS bf16x8*)((Kb) + vk_off(r32, 8 * c + 2 * s4 + hi)); _kf1[s4] = *(const LAS bf16x8*)((Kb) + vk_off(32 + r32, 8 * c + 2 * s4 + hi)); } \
        _Pragma("unroll") for (int s4 = 0; s4 < 4; ++s4) { \
            SA0 = __builtin_amdgcn_mfma_f32_32x32x16_bf16(_kf0[s4], qf[s4], SA0, 0, 0, 0); \
            SA1 = __builtin_amdgcn_mfma_f32_32x32x16_bf16(_kf1[s4], qf[s4], SA1, 0, 0, 0); } } while (0)
    f32x16 sa0, sa1, sn0 = (f32x16){}, sn1 = (f32x16){};
    DA_QK(sa0, sa1, lds);
    (void)ko0; (void)ko1;
    asm volatile("s_waitcnt lgkmcnt(0)" ::: "memory"); __syncthreads();
    for (int t = 0; t < 32; ++t) {
        if (t + 2 < 32) DA_DMA(kgd, t + 2, (t & 1) * TB);
        if (t + 1 < 32) DA_DMA(vgd, t + 1, 2 * TB + ((t + 1) & 1) * TB);
        const LAS unsigned char* Vb = lds + 2 * TB + (t & 1) * TB;
        if (t + 1 < 32) { DA_QK(sn0, sn1, lds + ((t + 1) & 1) * TB); }
        __builtin_amdgcn_sched_barrier(0);
        float x0[16], x1[16];
        const int kv0 = 64 * t;
        const bool farp = (kv0 >= q0 + 31 + 128), farn = (kv0 + 63 + 128 <= q0);
        const bool far = farp || farn;
        float cb = 0.f, mx;
        if (far) { cb = farp ? biasL[511] : biasL[0];
            float rm = fmaxf(sa0[0], sa1[0]);
#pragma unroll
            for (int rg = 1; rg < 16; ++rg) rm = fmaxf(rm, fmaxf(sa0[rg], sa1[rg]));
            mx = rm * SC + cb;
#pragma unroll
            for (int rg = 0; rg < 16; ++rg) { x0[rg] = sa0[rg]; x1[rg] = sa1[rg]; }
        } else {
            const LAS float* bp = biasL + (kv0 - qabs + 4 * hi + 256);
#pragma unroll
            for (int rg = 0; rg < 16; ++rg) { x0[rg] = sa0[rg] * SC + bp[(rg & 3) + 8 * (rg >> 2)]; x1[rg] = sa1[rg] * SC + bp[(rg & 3) + 8 * (rg >> 2) + 32]; }
            mx = fmaxf(x0[0], x1[0]);
#pragma unroll
            for (int rg = 1; rg < 16; ++rg) mx = fmaxf(mx, fmaxf(x0[rg], x1[rg]));
        }
        mx = fmaxf(mx, __shfl_xor(mx, 32));
        if (__ballot(mx > m + 8.f) != 0ull) {
            const float mn = fmaxf(m, mx), alpha = __builtin_amdgcn_exp2f(m - mn); m = mn;
            lsum *= alpha;
#pragma unroll
            for (int db = 0; db < 4; ++db)
#pragma unroll
                for (int rg = 0; rg < 16; ++rg) o[db][rg] *= alpha;
        }
        f32x2 ps2 = (f32x2){0.f, 0.f};
        if (far) { const float cc = cb - m; const f32x2 sc2 = (f32x2){SC, SC}, cc2 = (f32x2){cc, cc};
#pragma unroll
            for (int r2 = 0; r2 < 8; ++r2) {
                f32x2 e0 = (f32x2){x0[2 * r2], x0[2 * r2 + 1]} * sc2 + cc2, e1 = (f32x2){x1[2 * r2], x1[2 * r2 + 1]} * sc2 + cc2;
                e0.x = __builtin_amdgcn_exp2f(e0.x); e0.y = __builtin_amdgcn_exp2f(e0.y); e1.x = __builtin_amdgcn_exp2f(e1.x); e1.y = __builtin_amdgcn_exp2f(e1.y);
                x0[2 * r2] = e0.x; x0[2 * r2 + 1] = e0.y; x1[2 * r2] = e1.x; x1[2 * r2 + 1] = e1.y; ps2 += e0; ps2 += e1; }
        } else { const f32x2 m2 = (f32x2){m, m};
#pragma unroll
            for (int r2 = 0; r2 < 8; ++r2) {
                f32x2 e0 = (f32x2){x0[2 * r2], x0[2 * r2 + 1]} - m2, e1 = (f32x2){x1[2 * r2], x1[2 * r2 + 1]} - m2;
                e0.x = __builtin_amdgcn_exp2f(e0.x); e0.y = __builtin_amdgcn_exp2f(e0.y); e1.x = __builtin_amdgcn_exp2f(e1.x); e1.y = __builtin_amdgcn_exp2f(e1.y);
                x0[2 * r2] = e0.x; x0[2 * r2 + 1] = e0.y; x1[2 * r2] = e1.x; x1[2 * r2 + 1] = e1.y; ps2 += e0; ps2 += e1; }
        }
        const float ps = ps2.x + ps2.y;
        lsum += ps;
        u32x4 pw[4];
#pragma unroll
        for (int s2 = 0; s2 < 2; ++s2) {
            pw[s2].x = pk2(x0[8 * s2 + 0], x0[8 * s2 + 1]); pw[s2].y = pk2(x0[8 * s2 + 2], x0[8 * s2 + 3]); pw[s2].z = pk2(x0[8 * s2 + 4], x0[8 * s2 + 5]); pw[s2].w = pk2(x0[8 * s2 + 6], x0[8 * s2 + 7]);
            pw[2 + s2].x = pk2(x1[8 * s2 + 0], x1[8 * s2 + 1]); pw[2 + s2].y = pk2(x1[8 * s2 + 2], x1[8 * s2 + 3]); pw[2 + s2].z = pk2(x1[8 * s2 + 4], x1[8 * s2 + 5]); pw[2 + s2].w = pk2(x1[8 * s2 + 6], x1[8 * s2 + 7]); }
        {
            s16x4 vl[2][4], vh[2][4];
#pragma unroll
            for (int db = 0; db < 4; ++db) { vl[0][db] = vtr(Vb + trb0 + 512 * db); vh[0][db] = vtr(Vb + trb1 + 512 * db); }
#pragma unroll
            for (int s = 0; s < 4; ++s) {
                if (s < 3) {
#pragma unroll
                    for (int db = 0; db < 4; ++db) { vl[(s + 1) & 1][db] = vtr(Vb + trb0 + 4096 * (s + 1) + 512 * db); vh[(s + 1) & 1][db] = vtr(Vb + trb1 + 4096 * (s + 1) + 512 * db); } }
#pragma unroll
                for (int db = 0; db < 4; ++db) { const s16x4 lo = vl[s & 1][db], hi4 = vh[s & 1][db];
                    const bf16x8 af = (bf16x8){lo[0], lo[1], lo[2], lo[3], hi4[0], hi4[1], hi4[2], hi4[3]};
                    o[db] = __builtin_amdgcn_mfma_f32_32x32x16_bf16(af, __builtin_bit_cast(bf16x8, pw[s]), o[db], 0, 0, 0); }
            }
        }
        asm volatile("s_waitcnt vmcnt(0)" ::: "memory"); __syncthreads();
        sa0 = sn0; sa1 = sn1;
    }
#undef DA_QK
#undef DA_DMA
    const float lt = lsum + __shfl_xor(lsum, 32);
    const float inv = 1.f / lt;
    LAS float* XO = (LAS float*)lds;
    if (c == 1) {
        const float f = inv * lam;
#pragma unroll
        for (int db = 0; db < 4; ++db)
#pragma unroll
            for (int rg = 0; rg < 16; ++rg) XO[(qblk * 64 + db * 16 + rg) * 64 + lane] = o[db][rg] * f;
    }
    __syncthreads();
    if (c == 0) {
        float ss = 0.f;
#pragma unroll
        for (int db = 0; db < 4; ++db)
#pragma unroll
            for (int rg = 0; rg < 16; ++rg) { const float v = o[db][rg] * inv - XO[(qblk * 64 + db * 16 + rg) * 64 + lane]; o[db][rg] = v; ss += v * v; }
        ss += __shfl_xor(ss, 32);
        const float sc = rsqrtf(ss * (1.f / 128.f) + 1e-5f) * (1.f - linit);
        const LAS float* sg = biasL + 512;
        bf16_t* op = (bf16_t*)(a.ws + WS_OA) + (rowb + q0 + r32) * 1792 + 1024 + h * 128;
#pragma unroll
        for (int db = 0; db < 4; ++db)
#pragma unroll
            for (int i = 0; i < 4; ++i) { const int d = db * 32 + 8 * i + 4 * hi; const f32x4 g4 = *(const LAS f32x4*)(sg + d);
                u32x2 w; w.x = pk2(o[db][4 * i] * sc * g4.x, o[db][4 * i + 1] * sc * g4.y); w.y = pk2(o[db][4 * i + 2] * sc * g4.z, o[db][4 * i + 3] * sc * g4.w);
                *(u32x2*)(op + d) = w; }
    }
}

__device__ __forceinline__ void phase_route(const Args& a, int l, LAS unsigned char* lds, bool commit = true) {
    const int tid = otid(), lane = tid & 63, wave = __builtin_amdgcn_readfirstlane(tid >> 6), r32 = lane & 31, hi = lane >> 5;
    unsigned char* ws = a.ws;
    LAS float* hb = (LAS float*)lds;
    LAS float* lg = (LAS float*)(lds + 131200);
    volatile LAS int* sel = (volatile LAS int*)(lds + 131200 + 4224);
    const float* X = (const float*)(ws + WS_X);
    const float* mod = (const float*)(ws + WS_MISC + MISC_MOD) + (size_t)l * 8 * 6144;
    bf16_t* H = (bf16_t*)(ws + WS_H);
    unsigned* cnt = (unsigned*)(ws + WS_CTL) + CW_CNT + l * 512;
    int* LIST = (int*)(ws + WS_LIST); unsigned* TOKE = (unsigned*)(ws + WS_TOKE); float* TOKP = (float*)(ws + WS_TOKP);
    const float* g2 = a.in[I_N2G] + (size_t)l * DM; const float* rb = a.in[I_RB] + (size_t)l * NE;
    float Bw[64];
    { const float* rw = a.in[I_RW] + (size_t)l * DM * NE + (size_t)(128 * wave + hi) * NE + r32;
#pragma unroll
      for (int s2 = 0; s2 < 64; ++s2) Bw[s2] = rw[(size_t)(2 * s2) * NE]; }
    for (int tb = blockIdx.x; tb < NTOK / 64; tb += gridDim.x) {
        for (int rnd = 0; rnd < 2; ++rnd) {
            const int tbase = tb * 64 + rnd * 32;
            const float* mb = mod + (size_t)(tbase >> 11) * 6144;
#pragma unroll 1
            for (int q = 0; q < 4; ++q) {
                const int tl = 4 * wave + q; const size_t t = (size_t)tbase + tl;
                f32x4 v[4];
#pragma unroll
                for (int j = 0; j < 4; ++j) v[j] = *(const f32x4*)(X + t * DM + 4 * lane + 256 * j);
                const float rstd = row_rstd(v, 1e-6f);
#pragma unroll
                for (int j = 0; j < 4; ++j) { const int c = 4 * lane + 256 * j;
                    const f32x4 gv = *(const f32x4*)(g2 + c), scv = *(const f32x4*)(mb + 4096 + c), shv = *(const f32x4*)(mb + 3072 + c);
                    const f32x4 hv = v[j] * rstd * gv * (scv + 1.0f) + shv;
                    u32x2 w; w.x = pk2(hv.x, hv.y); w.y = pk2(hv.z, hv.w);
                    *(u32x2*)(H + t * DM + c) = w;
                    LAS float* hp = hb + tl * 1025 + c; hp[0] = hv.x; hp[1] = hv.y; hp[2] = hv.z; hp[3] = hv.w; }
            }
            __syncthreads();
            f32x16 d = (f32x16){};
            { const LAS float* ap = hb + r32 * 1025 + 128 * wave + hi;
#pragma unroll
              for (int s2 = 0; s2 < 64; ++s2) d = __builtin_amdgcn_mfma_f32_32x32x2f32(ap[2 * s2], Bw[s2], d, 0, 0, 0); }
            __syncthreads();
#pragma unroll
            for (int rg = 0; rg < 16; ++rg) hb[(wave * 16 + rg) * 64 + lane] = d[rg];
            __syncthreads();
#pragma unroll
            for (int j = 0; j < 2; ++j) { const int idx = tid + 512 * j, rg = idx >> 6, ln = idx & 63; float sm = 0.f;
#pragma unroll
                for (int w8 = 0; w8 < 8; ++w8) sm += hb[(w8 * 16 + rg) * 64 + ln];
                lg[crow(rg, ln >> 5) * 33 + (ln & 31)] = sm + rb[ln & 31]; }
            __syncthreads();
#pragma unroll 1
            for (int q = 0; q < 4; ++q) {
                const int tl = 4 * wave + q; const int t = tbase + tl;
                const int myidx = lane & 31;
                float cur = lg[tl * 33 + myidx];
                float tv[4]; int ti4[4];
#pragma unroll
                for (int k = 0; k < 4; ++k) { float bv = cur; int bi = myidx;
#pragma unroll
                    for (int off = 16; off >= 1; off >>= 1) { const float ov = __shfl_xor(bv, off); const int oi = __shfl_xor(bi, off);
                        const bool take = (ov > bv) || (ov == bv && oi < bi); bv = take ? ov : bv; bi = take ? oi : bi; }
                    tv[k] = bv; ti4[k] = bi; if (myidx == bi) cur = -INFINITY; }
                const float e1 = expf(tv[1] - tv[0]), e2 = expf(tv[2] - tv[0]), e3 = expf(tv[3] - tv[0]);
                const float inv = 1.f / (1.f + e1 + e2 + e3);
                if (lane < 4) { const int e = lane == 0 ? ti4[0] : lane == 1 ? ti4[1] : lane == 2 ? ti4[2] : ti4[3];
                    const float pr = (lane == 0 ? 1.f : lane == 1 ? e1 : lane == 2 ? e2 : e3) * inv;
                    sel[(rnd * 32 + tl) * 4 + lane] = e; TOKP[(size_t)t * 4 + lane] = pr; }
            }
            __syncthreads();
        }
        {
            volatile LAS int* cw = sel + 256;
            int e_i = -1, rank = 0, mycnt = 0;
            if (wave < 4) { e_i = sel[tid];
#pragma unroll 1
                for (int e = 0; e < 32; ++e) { const unsigned long long mk = __ballot(e_i == e);
                    const int below = __builtin_popcountll(mk & ((1ull << lane) - 1ull));
                    rank = (e_i == e) ? below : rank; mycnt = (lane == e) ? __builtin_popcountll(mk) : mycnt; }
                if (lane < 32) cw[wave * 32 + lane] = mycnt; }
            __syncthreads();
            if (tid < 32) { const int e = tid; const int c0 = cw[e], c1 = cw[32 + e], c2 = cw[64 + e], c3 = cw[96 + e]; const int n = c0 + c1 + c2 + c3;
                const unsigned base = (commit && n > 0) ? __hip_atomic_fetch_add(cnt + 16 * e, (unsigned)n, __ATOMIC_RELAXED, __HIP_MEMORY_SCOPE_AGENT) : 0u;
                cw[128 + e] = (int)base; cw[160 + e] = (int)base + c0; cw[192 + e] = (int)base + c0 + c1; cw[224 + e] = (int)base + c0 + c1 + c2; }
            __syncthreads();
            if (wave < 4) { const unsigned pos = (unsigned)(cw[128 + wave * 32 + e_i] + rank); const int t = tb * 64 + (tid >> 2);
                if (commit) LIST[(size_t)e_i * NTOK + pos] = t;
                TOKE[(size_t)t * 4 + (tid & 3)] = ((unsigned)e_i << 16) | (pos & 0xffffu); }
        }
        __syncthreads();
    }
}

__device__ __forceinline__ void build_moe_tab(const Args& a, int l, volatile LAS int* tab) {
    const unsigned* cnt = (const unsigned*)(a.ws + WS_CTL) + CW_CNT + l * 512;
    const int tid = otid();
    __syncthreads();
    if (tid < 32) tab[64 + tid] = (int)__hip_atomic_load(cnt + 16 * tid, __ATOMIC_RELAXED, __HIP_MEMORY_SCOPE_AGENT);
    __syncthreads();
    if (tid == 0) { int s = 0; for (int e = 0; e < 32; ++e) { tab[e] = s; s += (tab[64 + e] + 255) >> 8; } tab[32] = s; }
    __syncthreads();
}

__device__ __forceinline__ void phase_combine(const Args& a, int l, const LAS int* tab, bool dry = false) {
    const int tid = otid(), lane = tid & 63, wave = tid >> 6;
    unsigned char* ws = a.ws;
    float* X = (float*)(ws + WS_X);
    const bf16_t* YM = (const bf16_t*)(ws + WS_YMOE);
    const unsigned* TOKE = (const unsigned*)(ws + WS_TOKE); const float* TOKP = (const float*)(ws + WS_TOKP);
    const float* modl = (const float*)(ws + WS_MISC + MISC_MOD) + (size_t)l * 8 * 6144;
    const int G8 = gridDim.x * 8;
    const bool contig = (NTOK % G8 == 0) && (NT % (NTOK / G8) == 0);
    const int TPW = contig ? NTOK / G8 : 1;
    const int tbeg = contig ? (blockIdx.x * 8 + wave) * TPW : blockIdx.x * 8 + wave, tstep = contig ? 1 : G8, tend = contig ? tbeg + TPW : NTOK;
    f32x4 gth[4], gmh[4], shh[4];
    auto load_inv = [&](int t) {
        const float* mb = modl + (size_t)(t >> 11) * 6144;
#pragma unroll
        for (int j = 0; j < 4; ++j) { const int c = 4 * lane + 256 * j; gth[j] = *(const f32x4*)(mb + 5120 + c);
            if (l + 1 < DEPTH) { const float* mn = modl + (size_t)8 * 6144 + (size_t)(t >> 11) * 6144;
                const f32x4 gv = *(const f32x4*)(a.in[I_N1G] + (size_t)(l + 1) * DM + c), scv = *(const f32x4*)(mn + 1024 + c);
                gmh[j] = gv * (scv + 1.0f); shh[j] = *(const f32x4*)(mn + c); }
            else { gmh[j] = *(const f32x4*)(a.in[I_FNG] + c); shh[j] = (f32x4){0.f, 0.f, 0.f, 0.f}; } } };
    if (contig) load_inv(tbeg);
    for (int t = tbeg; t < tend; t += tstep) {
        if (!contig) load_inv(t);
        f32x4 v[4], acc[4];
#pragma unroll
        for (int j = 0; j < 4; ++j) { v[j] = *(const f32x4*)(X + (size_t)t * DM + 4 * lane + 256 * j); acc[j] = (f32x4){0.f, 0.f, 0.f, 0.f}; }
#pragma unroll
        for (int k = 0; k < 4; ++k) { const unsigned ep = TOKE[(size_t)t * 4 + k]; const float pr = TOKP[(size_t)t * 4 + k];
            const int e = ep >> 16, pos = ep & 0xffff; const size_t srow = (size_t)tab[e] * 256 + pos;
#pragma unroll
            for (int j = 0; j < 4; ++j) { const u32x2 y = *(const u32x2*)(YM + srow * DM + 4 * lane + 256 * j);
                acc[j].x += pr * bflo(y.x); acc[j].y += pr * bfhi(y.x); acc[j].z += pr * bflo(y.y); acc[j].w += pr * bfhi(y.y); } }
#pragma unroll
        for (int j = 0; j < 4; ++j) v[j] = v[j] + gth[j] * acc[j];
        const float rstd = row_rstd(v, 1e-6f);
        float* Xo = dry ? (float*)(ws + WS_QA) : X; bf16_t* Ho = dry ? (bf16_t*)(ws + WS_QA + (size_t)NTOK * DM * 4) : (bf16_t*)(ws + WS_H); float* Oo = dry ? (float*)(ws + WS_QA) : a.out;
        if (l + 1 < DEPTH) {
#pragma unroll
            for (int j = 0; j < 4; ++j) __builtin_nontemporal_store(v[j], (f32x4*)(Xo + (size_t)t * DM + 4 * lane + 256 * j));
#pragma unroll
            for (int j = 0; j < 4; ++j) { const int c = 4 * lane + 256 * j; const f32x4 y = v[j] * rstd * gmh[j] + shh[j];
                u32x2 w; w.x = pk2(y.x, y.y); w.y = pk2(y.z, y.w);
                *(u32x2*)(Ho + (size_t)t * DM + c) = w; }
        } else {
#pragma unroll
            for (int j = 0; j < 4; ++j) { const int c = 4 * lane + 256 * j;
                __builtin_nontemporal_store(v[j] * rstd * gmh[j], (f32x4*)(Oo + (size_t)t * DM + c)); }
        }
    }
}

__device__ __forceinline__ Args ld_args() {
#if defined(__HIP_DEVICE_COMPILE__)
    const __attribute__((address_space(4))) Args* p = (const __attribute__((address_space(4))) Args*)__builtin_amdgcn_kernarg_segment_ptr();
    asm volatile("" : "+s"(p));
    return *p;
#else
    return Args{};
#endif
}
#define LDA const Args a = ld_args()
constexpr int NPL = 9;
constexpr int N_PHASES = 2 + NPL * DEPTH;
__global__ void __launch_bounds__(512, 2) fwd(Args a) {
    extern __shared__ __attribute__((aligned(16))) unsigned char smem[];
    LAS unsigned char* lds = (LAS unsigned char*)smem;
    const int tid = threadIdx.x;
    unsigned* ctl = (unsigned*)(a.ws + WS_CTL);
    volatile LAS unsigned* xbw = (volatile LAS unsigned*)(lds + LDS_CTL_OFF);
    volatile LAS int* tab = (volatile LAS int*)(lds + LDS_CTL_OFF + 256);
    volatile LAS int* qw = (volatile LAS int*)(lds + LDS_CTL_OFF + 1024);
    if (tid < 4) xbw[tid] = 0u;
    __syncthreads();
    const int lo = a.ph_lo, hi = a.ph_hi;
    XcdBarrier bar; bar.bar = ctl + CW_BAR; bar.x = 0; bar.st = xbw;
    if (hi - lo > 1) bar = xcd_barrier_post(ctl + CW_BAR, xbw);
#ifndef DUPMASK
#define DUPMASK 0
#endif
#define NREP(k) (((DUPMASK >> PHSEL(k)) & 1) ? 2 : 1)
#ifndef BRMASK
#define BRMASK 7
#endif
#ifndef PHMASK
#define PHMASK 0xFFFFF
#endif
#define PHSEL(k) ((k) < 2 ? (k) : 2 + ((k) - 2) % NPL)
#define IN(k) (((PHMASK >> PHSEL(k)) & 1) && lo <= (k) && (k) < hi)
#define SEAM(k) do { if (IN(k) && IN((k) + 1)) { xcd_barrier(bar); } } while (0)
    unsigned char* ws = a.ws;
    if (IN(0)) { LDA; for (int rep = 0; rep < NREP(0); ++rep) { phase_p0(a, lds); __syncthreads(); } SEAM(0); }
    if (IN(1)) { LDA; phase_norm1(a, 0); SEAM(1); }
    for (int l = 0; l < DEPTH; ++l) {
        const int pb = 2 + NPL * l;
        if (IN(pb + 0)) { LDA;
          for (int rep = 0; rep < NREP(pb + 0); ++rep) {
            pg8::ProjOrder S; S.so.init(NTOK, PLD, gridDim.x, blockIdx.x);
            S.limit = (gridDim.x == 256) ? (long)(S.so.nwg / 256) * 256 : (long)S.so.nwg;
            pg8::EpiProj E{(bf16_t*)(ws + WS_PROJ), PLD, 29};
            pg8::gemm_phase<pg8::EpiProj, pg8::ProjOrder>(lds, (const bf16_t*)(ws + WS_H), (const bf16_t*)(ws + WS_WIN) + (size_t)l * PLD * DM, DM, 0, S, E);
          }
            SEAM(pb + 0);
        }
        if (IN(pb + 1)) { LDA;
            if (gridDim.x == 256) {
                pg8::LeftOrder S; S.so.init(NTOK, PLD, gridDim.x, 0);
                const long first = (long)(S.so.nwg / 256) * 256; const int nleft = (int)(S.so.nwg - first);
                pg8::EpiProj E{(bf16_t*)(ws + WS_PROJ), PLD, 29};
                for (;;) {
                    if (tid == 0) *qw = (int)__hip_atomic_fetch_add(ctl + CW_QR + 128 * l + 64, 1u, __ATOMIC_RELAXED, __HIP_MEMORY_SCOPE_AGENT);
                    __syncthreads();
                    const int item = *qw;
                    __syncthreads();
                    if (item >= nleft) break;
                    S.L = first + item;
                    pg8::gemm_phase<pg8::EpiProj, pg8::LeftOrder>(lds, (const bf16_t*)(ws + WS_H), (const bf16_t*)(ws + WS_WIN) + (size_t)l * PLD * DM, DM, 0, S, E);
                    __syncthreads();
                }
            }
            phase_rwkv_r1(a, l, lds); SEAM(pb + 1); }
        if (IN(pb + 2)) { LDA;
          for (int rep = 0; rep < NREP(pb + 2); ++rep) {
            {
                pg8::StaticOrder S; S.init(NTOK, RW, gridDim.x, blockIdx.x);
                pg8::EpiProj E{(bf16_t*)(ws + WS_GG), RW, 1 << 30};
                pg8::gemm_phase<pg8::EpiProj, pg8::StaticOrder>(lds, (const bf16_t*)(ws + WS_GS), (const bf16_t*)(ws + WS_MISC + MISC_GUPT) + (size_t)l * RW * 128, 128, 0, S, E);
            }
            for (int u = blockIdx.x; u < 96; u += gridDim.x) rwkv_r2_pair(a, u, lds);
            bool swa_tab = false;
            unsigned* qhd = ctl + CW_QH + 64 * (2 * l + rep);
            if (tid == 0) qw[0] = (int)__hip_atomic_fetch_add(qhd, 1u, __ATOMIC_RELAXED, __HIP_MEMORY_SCOPE_AGENT);
            __syncthreads();
            int item = qw[0];
            for (int it = 0; item < 768 + 768; ++it) {
                if (tid == 0) qw[1 + (it & 1)] = (int)__hip_atomic_fetch_add(qhd, 1u, __ATOMIC_RELAXED, __HIP_MEMORY_SCOPE_AGENT);
                if (item < 768) diffattn_unit(a, l, item, lds);
                else
                { const int ztid = otid(), zlane = ztid & 63, zwave = ztid >> 6;
                  LAS float* bA = (LAS float*)(lds + 40960);
                  if (!swa_tab) { const float* bAg = (const float*)(ws + WS_MISC + MISC_BIASA);
                      for (int i = ztid; i < 12 * 129; i += 512) bA[i] = bAg[i];
                      __syncthreads(); swa_tab = true; }
                  swa_wave_unit((const bf16_t*)(ws + WS_PROJ), (float*)(ws + WS_OAG), (float*)(ws + WS_LSE), bA, lds + zwave * 4608, (item - 768) * 8 + zwave, zlane); }
                __syncthreads();
                item = qw[1 + (it & 1)];
            }
          }
            SEAM(pb + 2);
        }
        if (IN(pb + 3)) { LDA; for (int rep = 0; rep < NREP(pb + 3); ++rep) phase_rwkv_out(a, l); SEAM(pb + 3); }
        if (IN(pb + 4)) { LDA;
          for (int rep = 0; rep < NREP(pb + 4); ++rep) {
            pg8::StaticOrder S; S.init(NTOK, DM, gridDim.x, blockIdx.x);
            const bf16_t* P = (const bf16_t*)(ws + WS_PROJ); float* MF = (float*)(ws + WS_MF); bf16_t* MG = (bf16_t*)(ws + WS_MERGED);
            { pg8::EpiBranchM E{P, MG}; pg8::gemm_phase<pg8::EpiBranchM, pg8::StaticOrder>(lds, (const bf16_t*)(ws + WS_OA), (const bf16_t*)(ws + WS_WA) + (size_t)l * DM * 1792, 1792, 0, S, E); }
          }
            SEAM(pb + 4);
        }
        if (IN(pb + 5)) { LDA;
            pg8::StaticOrder S; S.init(NTOK, DM, gridDim.x, blockIdx.x);
            pg8::EpiOut E{l == 0 ? a.in[I_X] : (const float*)(ws + WS_X), (float*)(ws + WS_X), (const float*)(ws + WS_MISC + MISC_MOD) + (size_t)l * 8 * 6144 + 2048};
            pg8::gemm_phase<pg8::EpiOut, pg8::StaticOrder>(lds, (const bf16_t*)(ws + WS_MERGED), (const bf16_t*)(ws + WS_WO) + (size_t)l * DM * DM, DM, 0, S, E);
            SEAM(pb + 5);
        }
        if (IN(pb + 6)) { LDA; for (int rep = 0; rep < NREP(pb + 6); ++rep) phase_route(a, l, lds, rep == NREP(pb + 6) - 1); SEAM(pb + 6); }
        if (IN(pb + 7)) { LDA;
          for (int rep = 0; rep < NREP(pb + 7); ++rep) {
            build_moe_tab(a, l, tab);
            unsigned* rtc = ctl + CW_RT + l * 4096;
            {
                pg8::MoeOrder<true> S{(const LAS int*)tab, (const int*)(ws + WS_LIST), 8, (int)gridDim.x, (int)blockIdx.x, rtc};
                pg8::EpiMoe1 E{(bf16_t*)(ws + WS_ACT), a.in[I_B1] + (size_t)l * NE * 2 * FF};
                pg8::gemm_phase<pg8::EpiMoe1, pg8::MoeOrder<true>>(lds, (const bf16_t*)(ws + WS_H), (const bf16_t*)(ws + WS_W1) + (size_t)l * NE * 2 * FF * DM, DM, (size_t)2 * FF * DM * 2, S, E);
            }
            {
                pg8::MoeOrder<false> S{(const LAS int*)tab, nullptr, 4, (int)gridDim.x, (int)(gridDim.x - 1 - blockIdx.x), rtc};
                pg8::EpiMoe2 E{(bf16_t*)(ws + WS_YMOE), a.in[I_B2] + (size_t)l * NE * DM};
                pg8::gemm_phase<pg8::EpiMoe2, pg8::MoeOrder<false>>(lds, (const bf16_t*)(ws + WS_ACT), (const bf16_t*)(ws + WS_W2) + (size_t)l * NE * DM * FF, FF, (size_t)DM * FF * 2, S, E);
            }
          }
            SEAM(pb + 7);
        }
        if (IN(pb + 8)) { LDA; build_moe_tab(a, l, tab); for (int rep = 0; rep < NREP(pb + 8); ++rep) phase_combine(a, l, (const LAS int*)tab, rep != NREP(pb + 8) - 1); SEAM(pb + 8); }
    }
#undef IN
#undef SEAM
}

#ifndef MK_ONE_LAUNCH
#define MK_ONE_LAUNCH 1
#endif
extern "C" void kernel_launch(void* const* d_in, const int* in_sizes, int n_in, void* d_out, int out_size, void* d_ws, size_t ws_size, hipStream_t stream) {
    static int grid = 0;
    if (grid == 0) {
        if (n_in != 32 || ws_size < WS_END) { fprintf(stderr, "kernel_launch: unexpected n_in %d or ws %zu < %zu\n", n_in, ws_size, (size_t)WS_END); grid = -1; return; }
        int dev = 0, cus = 0;
        if (hipGetDevice(&dev) != hipSuccess || hipDeviceGetAttribute(&cus, hipDeviceAttributeMultiprocessorCount, dev) != hipSuccess) { grid = -1; return; }
        if (hipFuncSetAttribute((const void*)fwd, hipFuncAttributeMaxDynamicSharedMemorySize, LDS_BYTES) != hipSuccess) { fprintf(stderr, "kernel_launch: hipFuncSetAttribute failed\n"); grid = -1; return; }
        int per_cu = 0;
        if (hipOccupancyMaxActiveBlocksPerMultiprocessor(&per_cu, (const void*)fwd, 512, LDS_BYTES) != hipSuccess || per_cu < 1) fprintf(stderr, "kernel_launch: occupancy query says %d\n", per_cu);
        (void)hipGetLastError();
        grid = cus;
    }
    if (grid < 0) return;
    (void)hipMemsetAsync((char*)d_ws + WS_CTL, 0, CTL_BYTES, stream);
    Args a{};
    for (int i = 0; i < 32; ++i) a.in[i] = (const float*)d_in[i];
    a.out = (float*)d_out; a.ws = (unsigned char*)d_ws;
#if MK_ONE_LAUNCH
    a.ph_lo = 0; a.ph_hi = N_PHASES;
    hipLaunchKernelGGL(fwd, dim3(grid), dim3(512), LDS_BYTES, stream, a);
#else
    for (int p = 0; p < N_PHASES; ++p) { a.ph_lo = p; a.ph_hi = p + 1; hipLaunchKernelGGL(fwd, dim3(grid), dim3(512), LDS_BYTES, stream, a); }
#endif
}
```
